# Optimizing an MI355X kernel written in HIP

```python
import math
import jax, jax.numpy as jnp
from jax import lax
import numpy as np

D_MODEL = 1024
BATCH = 4
SEQ = 8192
DEPTH = 1

N_META = 16
D_MIX = D_MODEL
D_ATTN = D_MIX // 2
D_CONV = D_MIX - D_ATTN
ATTN_HEADS = 4
HEAD_DIM = D_ATTN // (2 * ATTN_HEADS)
V_HEAD_DIM = 2 * HEAD_DIM
ROPE_DIM = HEAD_DIM // 4
ROPE_THETA = 500000.0
CONV_WIDTH = 31
D_FF = 4 * D_MODEL
Q_BLOCK = 128
EPS = 1e-6
N_Q_COLS = ATTN_HEADS * 2 * HEAD_DIM
N_K_COLS = ATTN_HEADS * 2 * HEAD_DIM
N_V_COLS = ATTN_HEADS * V_HEAD_DIM
N_C_COLS = 2 * D_CONV
D_IN = N_Q_COLS + N_K_COLS + N_V_COLS + N_C_COLS

kernel_name = "hymba_diffattn_conformer_hybrid"


def rms_norm(x, g):
    xf = x.astype(jnp.float32)
    y = xf * lax.rsqrt(jnp.mean(xf * xf, axis=-1, keepdims=True) + EPS)
    return (y * g.astype(jnp.float32)).astype(x.dtype)


def layer_norm(x, g, b):
    xf = x.astype(jnp.float32)
    mu = jnp.mean(xf, axis=-1, keepdims=True)
    var = jnp.mean(jnp.square(xf - mu), axis=-1, keepdims=True)
    y = (xf - mu) * lax.rsqrt(var + EPS)
    return (y * g.astype(jnp.float32) + b.astype(jnp.float32)).astype(x.dtype)


def lambda_init(layer_idx):
    return 0.8 - 0.6 * math.exp(-0.3 * layer_idx)


def rope_tables(length):
    inv_freq = ROPE_THETA ** (-jnp.arange(0, ROPE_DIM, 2, dtype=jnp.float32) / ROPE_DIM)
    ang = jnp.arange(length, dtype=jnp.float32)[:, None] * inv_freq[None, :]
    return jnp.cos(ang), jnp.sin(ang)


def apply_partial_rope(t, cos, sin):
    c = cos[None, :, None, None, :].astype(t.dtype)
    s = sin[None, :, None, None, :].astype(t.dtype)
    half = ROPE_DIM // 2
    x1 = t[..., :half]
    x2 = t[..., half:ROPE_DIM]
    rot = jnp.concatenate([x1 * c - x2 * s, x2 * c + x1 * s], axis=-1)
    return jnp.concatenate([rot, t[..., ROPE_DIM:]], axis=-1)


def diff_attention(q, k, v, q_gain, k_gain, lam_q1, lam_k1, lam_q2, lam_k2, subln_gain, lam_init):
    B, L, _ = q.shape
    n_blocks = -(-L // Q_BLOCK)
    Lp = n_blocks * Q_BLOCK
    q = q.reshape(B, L, ATTN_HEADS, 2, HEAD_DIM)
    k = k.reshape(B, L, ATTN_HEADS, 2, HEAD_DIM)
    v = v.reshape(B, L, ATTN_HEADS, V_HEAD_DIM)
    q = rms_norm(q, q_gain)
    k = rms_norm(k, k_gain)
    pad = Lp - L
    q = jnp.pad(q, ((0, 0), (0, pad), (0, 0), (0, 0), (0, 0)))
    k = jnp.pad(k, ((0, 0), (0, pad), (0, 0), (0, 0), (0, 0)))
    v32 = jnp.pad(v, ((0, 0), (0, pad), (0, 0), (0, 0))).astype(jnp.float32)
    cos, sin = rope_tables(Lp)
    q = apply_partial_rope(q, cos, sin)
    k = apply_partial_rope(k, cos, sin)
    lam = (jnp.exp(jnp.sum(lam_q1.astype(jnp.float32) * lam_k1.astype(jnp.float32)))
           - jnp.exp(jnp.sum(lam_q2.astype(jnp.float32) * lam_k2.astype(jnp.float32)))
           + lam_init)
    scale = HEAD_DIM ** -0.5
    key_pos = jnp.arange(Lp)

    def block(i):
        start = i * Q_BLOCK
        qb = lax.dynamic_slice_in_dim(q, start, Q_BLOCK, axis=1)
        s = jnp.einsum('bqhcd,bkhcd->bhcqk', qb, k).astype(jnp.float32) * scale
        q_pos = start + jnp.arange(Q_BLOCK)
        mask = key_pos[None, :] <= q_pos[:, None]
        s = jnp.where(mask[None, None, None], s, -jnp.inf)
        p = jax.nn.softmax(s, axis=-1)
        a = p[:, :, 0] - lam * p[:, :, 1]
        return jnp.einsum('bhqk,bkhe->bqhe', a, v32)

    o = lax.map(block, jnp.arange(n_blocks))
    o = jnp.transpose(o, (1, 0, 2, 3, 4)).reshape(B, Lp, ATTN_HEADS, V_HEAD_DIM)[:, :L]
    o = o.astype(v.dtype)
    o = rms_norm(o, subln_gain) * (1.0 - lam_init)
    return o.reshape(B, L, ATTN_HEADS * V_HEAD_DIM)


def conformer_conv(u, conv_w, conv_b, ln_g, ln_b):
    a, g = jnp.split(u, 2, axis=-1)
    h = a * jax.nn.sigmoid(g)
    h = lax.conv_general_dilated(
        h, conv_w[:, None, :].astype(h.dtype), window_strides=(1,),
        padding=[(CONV_WIDTH - 1, 0)],
        dimension_numbers=('NWC', 'WIO', 'NWC'),
        feature_group_count=D_CONV) + conv_b.astype(h.dtype)
    h = layer_norm(h, ln_g, ln_b)
    return jax.nn.silu(h)


def setup_inputs(seed: int = 0) -> dict:
    key = jax.random.key(seed)
    ks = jax.random.split(key, 20)
    f = jnp.float32
    n = lambda k, shape, s: (jax.random.normal(k, shape, f) * s).astype(f)
    return {
        "x": n(ks[0], (BATCH, SEQ, D_MODEL), 1.0),
        "meta_tokens": n(ks[1], (N_META, D_MODEL), 1.0),
        "norm1_gain": 1.0 + n(ks[2], (DEPTH, D_MODEL), 0.02),
        "w_in": n(ks[3], (DEPTH, D_MODEL, D_IN), D_MODEL ** -0.5),
        "q_norm_gain": 1.0 + n(ks[4], (DEPTH, HEAD_DIM), 0.02),
        "k_norm_gain": 1.0 + n(ks[5], (DEPTH, HEAD_DIM), 0.02),
        "lambda_q1": n(ks[6], (DEPTH, HEAD_DIM), 0.1),
        "lambda_k1": n(ks[7], (DEPTH, HEAD_DIM), 0.1),
        "lambda_q2": n(ks[8], (DEPTH, HEAD_DIM), 0.1),
        "lambda_k2": n(ks[9], (DEPTH, HEAD_DIM), 0.1),
        "subln_gain": 1.0 + n(ks[10], (DEPTH, V_HEAD_DIM), 0.02),
        "conv_w": n(ks[11], (DEPTH, CONV_WIDTH, D_CONV), CONV_WIDTH ** -0.5),
        "conv_b": n(ks[12], (DEPTH, D_CONV), 0.02),
        "conv_ln_gain": 1.0 + n(ks[13], (DEPTH, D_CONV), 0.02),
        "conv_ln_bias": n(ks[14], (DEPTH, D_CONV), 0.02),
        "w_out": n(ks[15], (DEPTH, D_MIX, D_MODEL), D_MIX ** -0.5),
        "norm2_gain": 1.0 + n(ks[16], (DEPTH, D_MODEL), 0.02),
        "w_up": n(ks[17], (DEPTH, D_MODEL, D_FF), D_MODEL ** -0.5),
        "w_down": n(ks[18], (DEPTH, D_FF, D_MODEL), D_FF ** -0.5),
    }


def reference(x, meta_tokens, norm1_gain, w_in, q_norm_gain, k_norm_gain,
              lambda_q1, lambda_k1, lambda_q2, lambda_k2, subln_gain,
              conv_w, conv_b, conv_ln_gain, conv_ln_bias, w_out,
              norm2_gain, w_up, w_down):
    B = x.shape[0]
    meta = jnp.broadcast_to(meta_tokens[None].astype(x.dtype), (B, N_META, D_MODEL))
    h = jnp.concatenate([meta, x], axis=1)
    for l in range(DEPTH):
        hn = rms_norm(h, norm1_gain[l])
        proj = jnp.einsum('bld,de->ble', hn, w_in[l])
        q = proj[..., :N_Q_COLS]
        k = proj[..., N_Q_COLS:N_Q_COLS + N_K_COLS]
        v = proj[..., N_Q_COLS + N_K_COLS:N_Q_COLS + N_K_COLS + N_V_COLS]
        u = proj[..., N_Q_COLS + N_K_COLS + N_V_COLS:]
        attn_out = diff_attention(q, k, v, q_norm_gain[l], k_norm_gain[l],
                                  lambda_q1[l], lambda_k1[l], lambda_q2[l], lambda_k2[l],
                                  subln_gain[l], lambda_init(l))
        conv_out = conformer_conv(u, conv_w[l], conv_b[l],
                                  conv_ln_gain[l], conv_ln_bias[l])
        mixed = jnp.concatenate([attn_out, conv_out], axis=-1)
        h = h + jnp.einsum('ble,ed->bld', mixed, w_out[l])
        hn = rms_norm(h, norm2_gain[l])
        a = jax.nn.relu(jnp.einsum('bld,df->blf', hn, w_up[l]))
        h = h + jnp.einsum('blf,fd->bld', a * a, w_down[l])
    return h[:, N_META:]
```

```cpp
#include <hip/hip_cooperative_groups.h>
#include <cmath>
#include <hip/hip_runtime.h>
#include <cstdio>
#include <cstdint>
namespace pg8 {
#define PG8_LAS __attribute__((address_space(3)))
typedef unsigned short bf16_t;
typedef short bf16x8 __attribute__((ext_vector_type(8)));
typedef float f32x4 __attribute__((ext_vector_type(4)));
typedef unsigned u32x4 __attribute__((ext_vector_type(4)));
constexpr int BM = 256, BK = 64, HALF = 128, HTB = HALF * BK * 2  , STAGE_BYTES = 8 * HTB, NXCD = 8, WGM = 8;

__host__ __device__ __forceinline__ int lds_byte(int r, int c) { const int st = (r >> 4) * 2 + (c >> 5), rr = r & 15, cc = c & 31, ob = rr * 64 + cc * 2; return st * 1024 + (ob ^ (((ob >> 9) & 1) << 5)); }
__host__ __device__ __forceinline__ void stage_rc(int b, int& R, int& C) { const int st = b / 1024, sb = b % 1024, swz = sb ^ (((sb >> 9) & 1) << 5); R = (st >> 1) * 16 + swz / 64; C = (st & 1) * 32 + (swz % 64) / 2; }
__host__ __device__ __forceinline__ int perm32(int rho) { const int n = rho >> 4, i = rho & 15; return 8 * (i >> 2) + 4 * n + (i & 3); }

struct Unit { int pm, pn; };
struct Gemm { const bf16_t* A; const bf16_t* Bt; int M, N, K; };

struct StaticOrder {
    int nM, nN, nwg, G, c;
    __host__ __device__ void init(int M, int N, int G_, int c_) { nM = M / BM; nN = N / BM; nwg = nM * nN; G = G_; c = c_; }
    __host__ __device__ bool next(int i, Unit& u) const {
        const long L = (long)i * G + c; if (L >= nwg) return false;
        int wgid = (int)L; { const int q = nwg / NXCD, r = nwg % NXCD, xcd = wgid % NXCD, off = wgid / NXCD; wgid = (xcd < r ? xcd * (q + 1) : r * (q + 1) + (xcd - r) * q) + off; }
        const int nig = WGM * nN, gid = wgid / nig, fm = gid * WGM, gsz = (nM - fm) < WGM ? (nM - fm) : WGM;
        u.pm = fm + ((wgid % nig) % gsz); u.pn = (wgid % nig) / gsz; return true;
    }
    __device__ __forceinline__ void a_ready(const Unit&) const {}
    __device__ __forceinline__ void done(const Unit&) const {}
};

__device__ __forceinline__ unsigned cvt_pk_bf16(float lo, float hi) { unsigned r; asm volatile("v_cvt_pk_bf16_f32 %0, %1, %2" : "=v"(r) : "v"(lo), "v"(hi)); return r; }
typedef float f32x2 __attribute__((ext_vector_type(2)));
__device__ __forceinline__ f32x2 gelu_pk(f32x2 v) {
    const f32x2 av = __builtin_elementwise_abs(v), d = av * 0.2316418882f + 1.0f;
    f32x2 t; t.x = __builtin_amdgcn_rcpf(d.x); t.y = __builtin_amdgcn_rcpf(d.y);
    f32x2 q = t * 0.5307027145f + (-0.7265760135f); q = q * t + 0.7107068705f; q = q * t + (-0.142248368f); q = q * t + 0.127414796f; q = q * t;
    const f32x2 s = (v * v) * (-0.72134752044f);
    f32x2 e; e.x = __builtin_amdgcn_exp2f(s.x); e.y = __builtin_amdgcn_exp2f(s.y);
    const f32x2 m = v * (q * e), r = v - m;
    f32x2 o; o.x = v.x < 0.f ? m.x : r.x; o.y = v.y < 0.f ? m.y : r.y; return o;
}

template <int ACT  > struct EpiBf16 {
    static constexpr bool PERM = true, AFTER_DRAIN = false; static_assert(ACT == 0 || ACT == 1, "EpiBf16: ACT is 0 (none) or 1 (gelu_pk)");
    bf16_t* O; int ldc; const float* bias; int split_cols; size_t split_stride; float scale0;
    __device__ __forceinline__ void operator()(const f32x4 (&acc)[2][2][4][2], const Unit& u, int wr, int wc, int fr, int fq) const {
        const int row0 = u.pm * BM + wr * 64 + fr; int colt = u.pn * BM; bf16_t* base = O;
        float sc = 1.f; if (split_cols) { const int t = colt / split_cols; base += (size_t)t * split_stride; colt -= t * split_cols; if (t == 0) sc = scale0; }
        const int col0 = colt + wc * 32 + 8 * fq, bcol0 = u.pn * BM + wc * 32 + 8 * fq;
        f32x4 bv[2][2];
#pragma unroll
        for (int bj = 0; bj < 2; ++bj)
#pragma unroll
            for (int n = 0; n < 2; ++n) bv[bj][n] = bias ? *(const f32x4*)(bias + bcol0 + bj * HALF + 4 * n) : (f32x4){0.f, 0.f, 0.f, 0.f};
#pragma unroll
        for (int ai = 0; ai < 2; ++ai)
#pragma unroll
            for (int m = 0; m < 4; ++m) { bf16_t* rowp = base + (size_t)(row0 + ai * HALF + m * 16) * ldc + col0;
#pragma unroll
                for (int bj = 0; bj < 2; ++bj) { f32x4 v0 = acc[ai][bj][m][0] + bv[bj][0], v1 = acc[ai][bj][m][1] + bv[bj][1];
                    if (ACT == 1) { f32x2 a = gelu_pk((f32x2){v0[0], v0[1]}), b = gelu_pk((f32x2){v0[2], v0[3]}), c = gelu_pk((f32x2){v1[0], v1[1]}), d = gelu_pk((f32x2){v1[2], v1[3]});
                        v0 = (f32x4){a.x, a.y, b.x, b.y}; v1 = (f32x4){c.x, c.y, d.x, d.y}; }
                    v0 = v0 * sc; v1 = v1 * sc; u32x4 w; w.x = cvt_pk_bf16(v0[0], v0[1]); w.y = cvt_pk_bf16(v0[2], v0[3]); w.z = cvt_pk_bf16(v1[0], v1[1]); w.w = cvt_pk_bf16(v1[2], v1[3]);
                    *(u32x4*)(rowp + bj * HALF) = w; } }
    }
};

constexpr int XROWS = 32768, SPAD = 8256;
constexpr float QSCALE = 0.125f * 1.4426950408889634f;
__device__ __forceinline__ f32x4 shfl_xor4(f32x4 v, int m) { f32x4 r; r[0] = __shfl_xor(v[0], m); r[1] = __shfl_xor(v[1], m); r[2] = __shfl_xor(v[2], m); r[3] = __shfl_xor(v[3], m); return r; }
__device__ __forceinline__ u32x4 pack8(f32x4 a, f32x4 b) { u32x4 w; w.x = cvt_pk_bf16(a[0], a[1]); w.y = cvt_pk_bf16(a[2], a[3]); w.z = cvt_pk_bf16(b[0], b[1]); w.w = cvt_pk_bf16(b[2], b[3]); return w; }
struct EpiInProj {
    static constexpr bool PERM = true, AFTER_DRAIN = false;
    bf16_t *Q, *K, *V, *G; const float *qg, *kg, *rope;
    __device__ __forceinline__ void operator()(const f32x4 (&acc)[2][2][4][2], const Unit& u, int wr, int wc, int fr, int fq) const {
        const int pn = u.pn; constexpr bool meta = false;
        if (meta && (wr != 0 || pn < 2)) return;
        const int rbase = u.pm * BM + wr * 64 + fr;
        if (pn < 4) {
            const bool isq = pn < 2; const float* gp = isq ? qg : kg; const float osc = isq ? QSCALE : 1.f;
            f32x4 gv[2][2];
#pragma unroll
            for (int bj = 0; bj < 2; ++bj)
#pragma unroll
                for (int n = 0; n < 2; ++n) gv[bj][n] = *(const f32x4*)(gp + 32 * bj + 8 * fq + 4 * n);
            const int colb = (pn & 1) * 256 + wc * 64 + 8 * fq;
            bf16_t* dst = isq ? Q : K;
#pragma unroll
            for (int ai = 0; ai < 2; ++ai) {
                if (meta && ai) continue;
#pragma unroll
              for (int mh = 0; mh < 2; ++mh) {
                if (meta && mh) continue;
                f32x4 rv[2][4];
                if (fq < 2) {
#pragma unroll
                    for (int m2 = 0; m2 < 2; ++m2) { const int row = rbase + ai * HALF + (2 * mh + m2) * 16; const int pos = meta ? (row - XROWS) : ((row & 8191) + 16); const f32x4* rp = (const f32x4*)(rope + (size_t)pos * 16);
#pragma unroll
                        for (int k = 0; k < 4; ++k) rv[m2][k] = rp[k]; }
                }
                asm volatile("" ::: "memory");
#pragma unroll
                for (int m = 2 * mh; m < 2 * mh + 2; ++m) {
                    if (meta && m) continue;
                    const int row = rbase + ai * HALF + m * 16;
                    float ss = 0.f;
#pragma unroll
                    for (int bj = 0; bj < 2; ++bj)
#pragma unroll
                        for (int n = 0; n < 2; ++n) { const f32x4 x = acc[ai][bj][m][n]; ss += (x[0] * x[0] + x[1] * x[1]) + (x[2] * x[2] + x[3] * x[3]); }
                    ss += __shfl_xor(ss, 16); ss += __shfl_xor(ss, 32);
                    const float rs = __builtin_amdgcn_rsqf(ss * (1.0f / 64.0f) + 1e-6f);
                    f32x4 y00 = acc[ai][0][m][0] * rs * gv[0][0], y01 = acc[ai][0][m][1] * rs * gv[0][1], y10 = acc[ai][1][m][0] * rs * gv[1][0], y11 = acc[ai][1][m][1] * rs * gv[1][1];
                    const f32x4 p0 = shfl_xor4(y00, 16), p1 = shfl_xor4(y01, 16);
                    if (fq < 2) {
                        const f32x4 c0 = rv[m & 1][0], c1 = rv[m & 1][1], s0 = rv[m & 1][2], s1 = rv[m & 1][3];
                        const float sg = fq ? 1.f : -1.f;
                        y00 = y00 * c0 + (p0 * s0) * sg; y01 = y01 * c1 + (p1 * s1) * sg;
                    }
                    const u32x4 w0 = pack8(y00 * osc, y01 * osc), w1 = pack8(y10 * osc, y11 * osc);
                    if (!meta) {
                        const size_t orow = isq ? (size_t)row : (size_t)((row >> 13) * SPAD + 64 + (row & 8191));
                        *(u32x4*)(dst + orow * 512 + colb) = w0; *(u32x4*)(dst + orow * 512 + colb + 32) = w1;
                    } else {
#pragma unroll 1
                        for (int b = 0; b < 4; ++b) { const size_t orow = (size_t)(b * SPAD + fr); *(u32x4*)(dst + orow * 512 + colb) = w0; *(u32x4*)(dst + orow * 512 + colb + 32) = w1; }
                    }
                }
              }
            }
        } else if (pn < 6) {
            const int colb = (pn - 4) * 256 + wc * 32 + 8 * fq;
#pragma unroll
            for (int ai = 0; ai < 2; ++ai)
#pragma unroll
                for (int m = 0; m < 4; ++m) {
                    if (meta && (ai || m)) continue;
                    const int row = rbase + ai * HALF + m * 16;
                    const u32x4 w0 = pack8(acc[ai][0][m][0], acc[ai][0][m][1]), w1 = pack8(acc[ai][1][m][0], acc[ai][1][m][1]);
                    if (!meta) {
                        const size_t orow = (size_t)((row >> 13) * SPAD + 64 + (row & 8191));
                        *(u32x4*)(V + orow * 512 + colb) = w0; *(u32x4*)(V + orow * 512 + colb + HALF) = w1;
                    } else {
#pragma unroll 1
                        for (int b = 0; b < 4; ++b) { const size_t orow = (size_t)(b * SPAD + fr); *(u32x4*)(V + orow * 512 + colb) = w0; *(u32x4*)(V + orow * 512 + colb + HALF) = w1; }
                    }
                }
        } else {
            const int colb = (pn - 6) * 128 + wc * 32 + 8 * fq;
#pragma unroll
            for (int ai = 0; ai < 2; ++ai)
#pragma unroll
                for (int m = 0; m < 4; ++m) {
                    if (meta && (ai || m)) continue;
                    const int row = rbase + ai * HALF + m * 16;
                    f32x4 h[2];
#pragma unroll
                    for (int n = 0; n < 2; ++n) { const f32x4 a = acc[ai][0][m][n], g = acc[ai][1][m][n];
#pragma unroll
                        for (int e = 0; e < 4; ++e) h[n][e] = a[e] * __builtin_amdgcn_rcpf(1.0f + __builtin_amdgcn_exp2f(-1.4426950408889634f * g[e])); }
                    const u32x4 w0 = pack8(h[0], h[1]);
                    if (!meta) {
                        const size_t orow = (size_t)((row >> 13) * SPAD + 64 + (row & 8191));
                        *(u32x4*)(G + orow * 512 + colb) = w0;
                    } else {
#pragma unroll 1
                        for (int b = 0; b < 4; ++b) { const size_t orow = (size_t)(b * SPAD + 48 + fr); *(u32x4*)(G + orow * 512 + colb) = w0; }
                    }
                }
        }
    }
};
struct EpiOut {
    static constexpr bool PERM = true, AFTER_DRAIN = false;
    const bf16_t* xn; const float* rn; const float* g1; bf16_t* hb; float* ssq;
    __device__ __forceinline__ void operator()(const f32x4 (&acc)[2][2][4][2], const Unit& u, int wr, int wc, int fr, int fq) const {
        const int rbase = u.pm * BM + wr * 64 + fr, colb = u.pn * BM + wc * 32 + 8 * fq;
        f32x4 ig[2][2];
#pragma unroll
        for (int bj = 0; bj < 2; ++bj)
#pragma unroll
            for (int n = 0; n < 2; ++n) { const f32x4 g = *(const f32x4*)(g1 + colb + bj * HALF + 4 * n);
#pragma unroll
                for (int e = 0; e < 4; ++e) ig[bj][n][e] = __builtin_amdgcn_rcpf(g[e]); }
#pragma unroll
        for (int ai = 0; ai < 2; ++ai) {
            u32x4 xv[4][2]; float rv[4];
#pragma unroll
            for (int m = 0; m < 4; ++m) { const int row = rbase + ai * HALF + m * 16; rv[m] = rn[row];
#pragma unroll
                for (int bj = 0; bj < 2; ++bj) xv[m][bj] = *(const u32x4*)(xn + (size_t)row * 1024 + colb + bj * HALF); }
            asm volatile("" ::: "memory");
#pragma unroll
            for (int m = 0; m < 4; ++m) {
                const int row = rbase + ai * HALF + m * 16; float ss = 0.f;
#pragma unroll
                for (int bj = 0; bj < 2; ++bj) { const size_t off = (size_t)row * 1024 + colb + bj * HALF; const u32x4 w = xv[m][bj];
                    f32x4 x0, x1;
                    x0[0] = __uint_as_float(w.x << 16); x0[1] = __uint_as_float(w.x & 0xffff0000u); x0[2] = __uint_as_float(w.y << 16); x0[3] = __uint_as_float(w.y & 0xffff0000u);
                    x1[0] = __uint_as_float(w.z << 16); x1[1] = __uint_as_float(w.z & 0xffff0000u); x1[2] = __uint_as_float(w.w << 16); x1[3] = __uint_as_float(w.w & 0xffff0000u);
                    const f32x4 h0 = x0 * rv[m] * ig[bj][0] + acc[ai][bj][m][0], h1 = x1 * rv[m] * ig[bj][1] + acc[ai][bj][m][1];
                    *(u32x4*)(hb + off) = pack8(h0, h1);
                    ss += (h0[0] * h0[0] + h0[1] * h0[1]) + (h0[2] * h0[2] + h0[3] * h0[3]) + (h1[0] * h1[0] + h1[1] * h1[1]) + (h1[2] * h1[2] + h1[3] * h1[3]); }
                ss += __shfl_xor(ss, 16); ss += __shfl_xor(ss, 32);
                if (fq == 0) ssq[(size_t)row * 16 + u.pn * 4 + wc] = ss;
            }
        }
    }
};
struct EpiUp {
    static constexpr bool PERM = true, AFTER_DRAIN = false;
    bf16_t* hb; const float* ssq;
    __device__ __forceinline__ void operator()(const f32x4 (&acc)[2][2][4][2], const Unit& u, int wr, int wc, int fr, int fq) const {
        const int rbase = u.pm * BM + wr * 64 + fr, colb = u.pn * BM + wc * 32 + 8 * fq;
#pragma unroll
        for (int ai = 0; ai < 2; ++ai) {
            f32x4 sv[4][4];
#pragma unroll
            for (int m = 0; m < 4; ++m) { const f32x4* sp = (const f32x4*)(ssq + (size_t)(rbase + ai * HALF + m * 16) * 16);
#pragma unroll
                for (int k = 0; k < 4; ++k) sv[m][k] = sp[k]; }
            asm volatile("" ::: "memory");
#pragma unroll
            for (int m = 0; m < 4; ++m) {
                const int row = rbase + ai * HALF + m * 16;
                const f32x4 s0 = sv[m][0], s1 = sv[m][1], s2 = sv[m][2], s3 = sv[m][3];
                const float tot = ((s0[0] + s0[1]) + (s0[2] + s0[3])) + ((s1[0] + s1[1]) + (s1[2] + s1[3])) + ((s2[0] + s2[1]) + (s2[2] + s2[3])) + ((s3[0] + s3[1]) + (s3[2] + s3[3]));
                const float rs = __builtin_amdgcn_rsqf(tot * (1.0f / 1024.0f) + 1e-6f);
#pragma unroll
                for (int bj = 0; bj < 2; ++bj) { f32x4 a0 = acc[ai][bj][m][0] * rs, a1 = acc[ai][bj][m][1] * rs;
#pragma unroll
                    for (int e = 0; e < 4; ++e) { const float p = fmaxf(a0[e], 0.f), q = fmaxf(a1[e], 0.f); a0[e] = p * p; a1[e] = q * q; }
                    *(u32x4*)(hb + (size_t)row * 4096 + colb + bj * HALF) = pack8(a0, a1); }
            }
        }
    }
};
struct EpiDown {
    static constexpr bool PERM = true, AFTER_DRAIN = false;
    const bf16_t* h1; float* out;
    __device__ __forceinline__ void operator()(const f32x4 (&acc)[2][2][4][2], const Unit& u, int wr, int wc, int fr, int fq) const {
        const int rbase = u.pm * BM + wr * 64 + fr, colb = u.pn * BM + wc * 32 + 8 * fq;
        u32x4 hv[2][4][2];
#pragma unroll
        for (int ai = 0; ai < 2; ++ai)
#pragma unroll
            for (int m = 0; m < 4; ++m)
#pragma unroll
                for (int bj = 0; bj < 2; ++bj) hv[ai][m][bj] = *(const u32x4*)(h1 + (size_t)(rbase + ai * HALF + m * 16) * 1024 + colb + bj * HALF);
        asm volatile("" ::: "memory");
#pragma unroll
        for (int ai = 0; ai < 2; ++ai)
#pragma unroll
            for (int m = 0; m < 4; ++m) {
                const int row = rbase + ai * HALF + m * 16;
#pragma unroll
                for (int bj = 0; bj < 2; ++bj) { const size_t off = (size_t)row * 1024 + colb + bj * HALF; const u32x4 w = hv[ai][m][bj];
                    f32x4 r0, r1;
                    r0[0] = __uint_as_float(w.x << 16); r0[1] = __uint_as_float(w.x & 0xffff0000u); r0[2] = __uint_as_float(w.y << 16); r0[3] = __uint_as_float(w.y & 0xffff0000u);
                    r1[0] = __uint_as_float(w.z << 16); r1[1] = __uint_as_float(w.z & 0xffff0000u); r1[2] = __uint_as_float(w.w << 16); r1[3] = __uint_as_float(w.w & 0xffff0000u);
                    *(f32x4*)(out + off) = r0 + acc[ai][bj][m][0]; *(f32x4*)(out + off + 4) = r1 + acc[ai][bj][m][1]; }
            }
    }
};


template <class Epi, class Sched, bool ALIGN_EPI = false, bool SP2 = false>
__device__ __forceinline__ void gemm_phase(PG8_LAS unsigned char* lds, const Gemm g, const Sched& S, const Epi& E) {
    int tid_ = threadIdx.x; asm volatile("" : "+v"(tid_));
    const int tid = tid_, wid = __builtin_amdgcn_readfirstlane(tid >> 6), lane = tid & 63, wr = wid >> 2, wc = wid & 3, fr = lane & 15, fq = lane >> 4;
    const int K = g.K, nt = K / BK;
    unsigned voffA[2], voffB[2];
#pragma unroll
    for (int i = 0; i < 2; ++i) { int R, C; stage_rc(tid * 16 + i * 8192, R, C); const int Rb = Epi::PERM ? ((R & ~31) + perm32(R & 31)) : R;
        voffA[i] = (unsigned)(R * K + C) * 2u; voffB[i] = (unsigned)(Rb * K + C) * 2u; }
    const size_t kstep = (size_t)(BK * 2);
    const size_t hstep = (size_t)HALF * K * 2;
    const size_t tstep = 2 * hstep;
    const unsigned ldsw = (unsigned)wid * 1024u;
    const int aoff = lds_byte(wr * 64 + fr, fq * 8), boff = lds_byte(wc * 32 + fr, fq * 8);
#define PG8_SA(b, h) (((b) * 2 + (h)) * HTB)
#define PG8_SB(b, h) ((4 + (b) * 2 + (h)) * HTB)
#define PG8_STAGE(bufoff, gbase, voff) do { _Pragma("unroll") for (int _i = 0; _i < 2; ++_i) \
        __builtin_amdgcn_global_load_lds((const unsigned*)((const char*)(gbase) + (voff)[_i]), (PG8_LAS unsigned*)(lds + (bufoff) + ldsw + _i * 8192), 16, 0, 0); } while (0)
#define PG8_LDA(dst, b, h) do { _Pragma("unroll") for (int m = 0; m < 4; ++m) _Pragma("unroll") for (int k = 0; k < 2; ++k) dst[m][k] = *(const PG8_LAS bf16x8*)(lds + PG8_SA(b, h) + aoff + m * 2048 + k * 1024); } while (0)
#define PG8_LDB(dst, b, h) do { _Pragma("unroll") for (int n = 0; n < 2; ++n) _Pragma("unroll") for (int k = 0; k < 2; ++k) dst[n][k] = *(const PG8_LAS bf16x8*)(lds + PG8_SB(b, h) + boff + n * 2048 + k * 1024); } while (0)
#define PG8_MMA(ai, bj, At, Bt) do { __builtin_amdgcn_s_setprio(1); _Pragma("unroll") for (int m = 0; m < 4; ++m) _Pragma("unroll") for (int n = 0; n < 2; ++n) _Pragma("unroll") for (int k = 0; k < 2; ++k) \
        acc[ai][bj][m][n] = __builtin_amdgcn_mfma_f32_16x16x32_bf16(Bt[n][k], At[m][k], acc[ai][bj][m][n], 0, 0, 0); __builtin_amdgcn_s_setprio(0); } while (0)
#define PG8_WAIT_V(n) asm volatile("s_waitcnt vmcnt(" #n ")" ::: "memory")
#define PG8_WAIT_L(n) asm volatile("s_waitcnt lgkmcnt(" #n ")" ::: "memory")
#define PG8_BAR __builtin_amdgcn_s_barrier()
#define PG8_SCHED __builtin_amdgcn_sched_barrier(0)
    Unit cur, nxt; int ui = 0;
    if (!S.next(0, cur)) return;
    f32x4 acc[2][2][4][2];
#pragma unroll
    for (int a = 0; a < 2; ++a)
#pragma unroll
        for (int b = 0; b < 2; ++b)
#pragma unroll
            for (int m = 0; m < 4; ++m)
#pragma unroll
                for (int n = 0; n < 2; ++n) acc[a][b][m][n] = (f32x4){0.f, 0.f, 0.f, 0.f};
    bf16x8 At[4][2], B0[2][2], B1[2][2];
    const char* cA = (const char*)g.A + (size_t)cur.pm * tstep; const char* cB = (const char*)g.Bt + (size_t)cur.pn * tstep;
    S.a_ready(cur);
    if constexpr (SP2) {
        PG8_STAGE(PG8_SB(0, 0), cB, voffB); PG8_STAGE(PG8_SB(0, 1), cB + hstep, voffB); PG8_STAGE(PG8_SA(0, 0), cA, voffA); PG8_STAGE(PG8_SA(0, 1), cA + hstep, voffA);
        if (wr == 1) PG8_BAR;
        PG8_WAIT_V(2); PG8_BAR;
        PG8_STAGE(PG8_SB(1, 0), cB + kstep, voffB); PG8_STAGE(PG8_SA(1, 0), cA + kstep, voffA); PG8_STAGE(PG8_SB(1, 1), cB + hstep + kstep, voffB);
        PG8_WAIT_V(6); PG8_BAR;
    } else {
        PG8_STAGE(PG8_SB(0, 0), cB, voffB); PG8_STAGE(PG8_SA(0, 0), cA, voffA); PG8_STAGE(PG8_SB(0, 1), cB + hstep, voffB); PG8_STAGE(PG8_SA(0, 1), cA + hstep, voffA);
        if (wr == 1) PG8_BAR;
        PG8_WAIT_V(4); PG8_BAR;
        PG8_STAGE(PG8_SB(1, 0), cB + kstep, voffB); PG8_STAGE(PG8_SA(1, 0), cA + kstep, voffA); PG8_STAGE(PG8_SB(1, 1), cB + hstep + kstep, voffB);
        PG8_WAIT_V(6); PG8_BAR;
    }
    for (;;) {
        const bool has_next = S.next(ui + 1, nxt);
        const char* nA = has_next ? (const char*)g.A + (size_t)nxt.pm * tstep : cA; const char* nB = has_next ? (const char*)g.Bt + (size_t)nxt.pn * tstep : cB;
        for (int t = 0; t < nt; t += 2) {
            const bool last = (t == nt - 2);
            const char* a1 = cA + (size_t)(t + 1) * kstep;
            const char* a2 = last ? nA : cA + (size_t)(t + 2) * kstep; const char* b2 = last ? nB : cB + (size_t)(t + 2) * kstep;
            const char* a3 = a2 + kstep; const char* b3 = b2 + kstep;
            if (last && has_next) S.a_ready(nxt);
            if constexpr (SP2) {
            PG8_LDB(B0, 0, 0); PG8_LDB(B1, 0, 1); PG8_SCHED; PG8_LDA(At, 0, 0); PG8_STAGE(PG8_SA(1, 1), a1 + hstep, voffA);
            PG8_WAIT_V(8); PG8_WAIT_L(0); PG8_BAR; PG8_MMA(0, 0, At, B0); PG8_MMA(0, 1, At, B1); PG8_BAR; PG8_SCHED;
            PG8_LDA(At, 0, 1); PG8_STAGE(PG8_SB(0, 0), b2, voffB); PG8_STAGE(PG8_SB(0, 1), b2 + hstep, voffB); PG8_STAGE(PG8_SA(0, 0), a2, voffA);
            PG8_WAIT_V(8); PG8_WAIT_L(0); PG8_BAR; PG8_MMA(1, 0, At, B0); PG8_MMA(1, 1, At, B1); PG8_BAR; PG8_SCHED;
            PG8_LDB(B0, 1, 0); PG8_LDB(B1, 1, 1); PG8_SCHED; PG8_LDA(At, 1, 0); PG8_STAGE(PG8_SA(0, 1), a2 + hstep, voffA);
            PG8_WAIT_V(8); PG8_WAIT_L(0); PG8_BAR; PG8_MMA(0, 0, At, B0); PG8_MMA(0, 1, At, B1); PG8_BAR; PG8_SCHED;
            PG8_LDA(At, 1, 1); PG8_STAGE(PG8_SB(1, 0), b3, voffB); PG8_STAGE(PG8_SB(1, 1), b3 + hstep, voffB); PG8_STAGE(PG8_SA(1, 0), a3, voffA);
            PG8_WAIT_V(8); PG8_WAIT_L(0); PG8_BAR; PG8_MMA(1, 0, At, B0); PG8_MMA(1, 1, At, B1); PG8_BAR; PG8_SCHED;
            } else {
            PG8_LDB(B0, 0, 0); PG8_SCHED; PG8_LDA(At, 0, 0); PG8_STAGE(PG8_SA(1, 1), a1 + hstep, voffA);
            PG8_WAIT_L(8); PG8_BAR; PG8_WAIT_L(0); PG8_MMA(0, 0, At, B0); PG8_BAR; PG8_SCHED;
            PG8_LDB(B1, 0, 1); PG8_STAGE(PG8_SB(0, 0), b2, voffB);
            PG8_BAR; PG8_WAIT_L(0); PG8_MMA(0, 1, At, B1); PG8_BAR;
            PG8_LDA(At, 0, 1); PG8_STAGE(PG8_SA(0, 0), a2, voffA);
            PG8_BAR; PG8_WAIT_L(0); PG8_MMA(1, 0, At, B0); PG8_BAR; PG8_SCHED;
            PG8_STAGE(PG8_SB(0, 1), b2 + hstep, voffB);
            PG8_WAIT_V(6); PG8_BAR; PG8_MMA(1, 1, At, B1); PG8_BAR;
            PG8_LDB(B0, 1, 0); PG8_SCHED; PG8_LDA(At, 1, 0); PG8_STAGE(PG8_SA(0, 1), a2 + hstep, voffA);
            PG8_WAIT_L(8); PG8_BAR; PG8_WAIT_L(0); PG8_MMA(0, 0, At, B0); PG8_BAR; PG8_SCHED;
            PG8_LDB(B1, 1, 1); PG8_STAGE(PG8_SB(1, 0), b3, voffB);
            PG8_BAR; PG8_WAIT_L(0); PG8_MMA(0, 1, At, B1); PG8_BAR;
            PG8_LDA(At, 1, 1); PG8_STAGE(PG8_SA(1, 0), a3, voffA);
            PG8_BAR; PG8_WAIT_L(0); PG8_MMA(1, 0, At, B0); PG8_BAR; PG8_SCHED;
            PG8_STAGE(PG8_SB(1, 1), b3 + hstep, voffB);
            PG8_WAIT_V(6); PG8_BAR; PG8_MMA(1, 1, At, B1); PG8_BAR;
            }
        }
        if constexpr (ALIGN_EPI) { if (wr == 0) PG8_BAR; }
        if constexpr (!Epi::AFTER_DRAIN) { E(acc, cur, wr, wc, fr, fq); S.done(cur); }
        if (!has_next) break;
#pragma unroll
        for (int a = 0; a < 2; ++a)
#pragma unroll
            for (int b = 0; b < 2; ++b)
#pragma unroll
                for (int m = 0; m < 4; ++m)
#pragma unroll
                    for (int n = 0; n < 2; ++n) acc[a][b][m][n] = (f32x4){0.f, 0.f, 0.f, 0.f};
        cur = nxt; cA = nA; cB = nB; ++ui;
        if constexpr (ALIGN_EPI) { if (wr == 1) PG8_BAR; }
    }
    PG8_WAIT_V(0);
    if constexpr (!ALIGN_EPI) { if (wr == 0) PG8_BAR; }
    PG8_BAR;
    if constexpr (Epi::AFTER_DRAIN) { E.fused(acc, cur, wr, wc, fr, fq, lds, wid, lane); S.done(cur); }
#undef PG8_SA
#undef PG8_SB
#undef PG8_STAGE
#undef PG8_LDA
#undef PG8_LDB
#undef PG8_MMA
#undef PG8_WAIT_V
#undef PG8_WAIT_L
#undef PG8_BAR
#undef PG8_SCHED
}
}

#ifndef PG8_SP2
#define PG8_SP2 true
#endif
#ifndef PG8_ALIGN
#define PG8_ALIGN true
#endif
#include <hip/hip_bf16.h>
#include <cmath>
namespace attn_body {
using bf16=__hip_bfloat16;
using bf16x8=__attribute__((ext_vector_type(8)))short;
using s16x4=__attribute__((ext_vector_type(4)))short;
using f32x16=__attribute__((ext_vector_type(16)))float;
using u32x4=__attribute__((ext_vector_type(4)))unsigned;
constexpr int SEQ=8192,D=64,PQ=512,PO=1024;
constexpr int NW=8,QBLK=32,QB=QBLK*NW,KVBLK=64,NQB=SEQ/QB;
constexpr int ATTN_UNIT_ROWS=QB;
__device__ __forceinline__ int crow(int r,int hi){return (r&3)+8*(r>>2)+4*hi;}
#define SBAR() __builtin_amdgcn_sched_barrier(0)
__device__ __forceinline__ void cmask(f32x16&p0,f32x16&p1,int jb,int qrel,int hi){
  const float NEG=-INFINITY; int kb=64*jb+4*hi;
  #pragma unroll
  for(int r=0;r<16;++r){int kv=kb+(r&3)+8*(r>>2); if(kv>qrel)p0[r]=NEG; if(kv+32>qrel)p1[r]=NEG;}
}

constexpr int NSLOT=3, SLOTB=8192;
constexpr int LDS_K=0, LDS_V=NSLOT*SLOTB, LDS_WS=2*NSLOT*SLOTB, LDS_OST=LDS_WS+NW*64*4, LDS_BYTES=LDS_OST+NW*4096;
constexpr float C2=0.125f*1.4426950408889634f;
__device__ __forceinline__ void glds16(const void*gsrc,unsigned lds_dst){unsigned keep;
  asm volatile("s_mov_b32 %0, m0\n\ts_mov_b32 m0, %2\n\ts_nop 0\n\tglobal_load_lds_dwordx4 %1, off\n\ts_mov_b32 m0, %0":"=&s"(keep):"v"(gsrc),"s"(lds_dst):"memory");}
__device__ __forceinline__ float max3f(float a,float b,float c){float r;asm("v_max3_f32 %0, %1, %2, %3":"=v"(r):"v"(a),"v"(b),"v"(c));return r;}
__device__ __forceinline__ float max2f(float a,float b){float r;asm("v_max_f32_e32 %0, %1, %2":"=v"(r):"v"(a),"v"(b));return r;}
__device__ __forceinline__ float fadd_s(float a,float b){float r;asm("v_add_f32_e32 %0, %1, %2":"=v"(r):"v"(a),"v"(b));return r;}
__device__ __forceinline__ float fsub_s(float a,float b){float r;asm("v_sub_f32_e32 %0, %1, %2":"=v"(r):"v"(a),"v"(b));return r;}
typedef float f32x2_t __attribute__((ext_vector_type(2))); typedef __bf16 bf16x2_t __attribute__((ext_vector_type(2)));
__device__ __forceinline__ unsigned cvtpk_s(float lo,float hi){f32x2_t v={lo,hi};bf16x2_t b=__builtin_convertvector(v,bf16x2_t);return __builtin_bit_cast(unsigned,b);}
#define WAIT_BAR(N) asm volatile("s_waitcnt vmcnt(" #N ") lgkmcnt(0)\n\ts_barrier":::"memory")

__device__ __forceinline__ void qkt(f32x16&p0,f32x16&p1,const char*Kslot,const bf16x8*qr,const f32x16&negm,int r32,int hi){
  const char*kb=Kslot+hi*1024+r32*16;
  #pragma unroll
  for(int d0=0;d0<4;++d0){
    const bf16x8 b0=*reinterpret_cast<const bf16x8*>(kb+d0*2048);
    const bf16x8 b1=*reinterpret_cast<const bf16x8*>(kb+d0*2048+512);
    if(d0==0){p0=__builtin_amdgcn_mfma_f32_32x32x16_bf16(b0,qr[0],negm,0,0,0);p1=__builtin_amdgcn_mfma_f32_32x32x16_bf16(b1,qr[0],negm,0,0,0);}
    else{p0=__builtin_amdgcn_mfma_f32_32x32x16_bf16(b0,qr[d0],p0,0,0,0);p1=__builtin_amdgcn_mfma_f32_32x32x16_bf16(b1,qr[d0],p1,0,0,0);}}
}
typedef __attribute__((address_space(3))) const char* lds_cptr;
typedef short v4i16_t __attribute__((ext_vector_type(4)));
__device__ __forceinline__ void kload8(bf16x8*kf,lds_cptr kp){
  kf[0]=*(const __attribute__((address_space(3))) bf16x8*)(kp);      kf[1]=*(const __attribute__((address_space(3))) bf16x8*)(kp+512);
  kf[2]=*(const __attribute__((address_space(3))) bf16x8*)(kp+2048); kf[3]=*(const __attribute__((address_space(3))) bf16x8*)(kp+2560);
  kf[4]=*(const __attribute__((address_space(3))) bf16x8*)(kp+4096); kf[5]=*(const __attribute__((address_space(3))) bf16x8*)(kp+4608);
  kf[6]=*(const __attribute__((address_space(3))) bf16x8*)(kp+6144); kf[7]=*(const __attribute__((address_space(3))) bf16x8*)(kp+6656);
}
__device__ __forceinline__ void kload2(bf16x8*kf,lds_cptr kp,int j){ kf[2*j]=*(const __attribute__((address_space(3))) bf16x8*)(kp+j*2048); kf[2*j+1]=*(const __attribute__((address_space(3))) bf16x8*)(kp+j*2048+512); }
__device__ __forceinline__ s16x4 vtr(lds_cptr p){ return __builtin_bit_cast(s16x4,__builtin_amdgcn_ds_read_tr16_b64_v4i16((__attribute__((address_space(3))) v4i16_t*)p)); }
__device__ __forceinline__ float rowmax(const f32x16&p0,const f32x16&p1){
  float a=max3f(p0[0],p0[1],p1[0]),b=max3f(p0[2],p0[3],p1[1]);a=max3f(a,p1[2],p1[3]);
  #pragma unroll
  for(int r=4;r<16;r+=4){a=max3f(a,p0[r],p0[r+1]);b=max3f(b,p0[r+2],p0[r+3]);a=max3f(a,p1[r],p1[r+1]);b=max3f(b,p1[r+2],p1[r+3]);}
  const float m=max2f(a,b);
  auto rr=__builtin_amdgcn_permlane32_swap(__float_as_uint(m),__float_as_uint(m),false,false);
  return max2f(__uint_as_float(rr[0]),__uint_as_float(rr[1]));
}
__device__ __forceinline__ void pv(f32x16*o,int vb,bf16x8 pa0,bf16x8 pa1,bf16x8 pa2,bf16x8 pa3){
  #pragma unroll
  for(int d0=0;d0<2;++d0){s16x4 lo[4],hi[4];
    #pragma unroll
    for(int ks=0;ks<4;++ks){
      asm volatile("ds_read_b64_tr_b16 %0,%1 offset:%c2":"=&v"(lo[ks]):"v"(vb),"i"(d0*4096+ks*1024):"memory");
      asm volatile("ds_read_b64_tr_b16 %0,%1 offset:%c2":"=&v"(hi[ks]):"v"(vb),"i"(d0*4096+ks*1024+512):"memory");}
    asm volatile("s_waitcnt lgkmcnt(0)":::"memory");SBAR();
    #define PK(k) (bf16x8){lo[k][0],lo[k][1],lo[k][2],lo[k][3],hi[k][0],hi[k][1],hi[k][2],hi[k][3]}
    o[d0]=__builtin_amdgcn_mfma_f32_32x32x16_bf16(pa0,PK(0),o[d0],0,0,0);
    o[d0]=__builtin_amdgcn_mfma_f32_32x32x16_bf16(pa1,PK(1),o[d0],0,0,0);
    o[d0]=__builtin_amdgcn_mfma_f32_32x32x16_bf16(pa2,PK(2),o[d0],0,0,0);
    o[d0]=__builtin_amdgcn_mfma_f32_32x32x16_bf16(pa3,PK(3),o[d0],0,0,0);
    #undef PK
  }
}

#ifndef ATTN_STORE16
#define ATTN_STORE16(p,v) (*(u32x4*)(p)=(v))
#endif
template<int THRL> __device__ __forceinline__ void attn_unit(int q0,const bf16*Qu,const bf16*__restrict__ Kh,const bf16*__restrict__ Vh,bf16*Ou,char*shm){
  int tid_=threadIdx.x; asm volatile("":"+v"(tid_)); const int tid=tid_,lane=tid&63,r32=lane&31,hi=lane>>5; const int wid=__builtin_amdgcn_readfirstlane(tid>>6);
  const bf16*Qw=Qu+(long)(wid*QBLK)*PQ;
  const unsigned lds0=(unsigned)(uintptr_t)shm;
  float*wsf=(float*)(shm+LDS_WS)+wid*64;
  const bf16*ksrc=Kh+(long)lane*PQ+wid*8;
  const bf16*vsrc=Vh+(long)(16*(wid&3)+(lane>>2))*PQ+(wid>>2)*32+(lane&3)*8;
  const unsigned kdst=lds0+LDS_K+wid*1024, vdst=lds0+LDS_V+wid*1024;
  #define DMA_K(t,slot) glds16(ksrc+(long)(t)*KVBLK*PQ,(unsigned)__builtin_amdgcn_readfirstlane(kdst+(slot)))
  #define DMA_V(t,slot) glds16(vsrc+(long)(t)*KVBLK*PQ,(unsigned)__builtin_amdgcn_readfirstlane(vdst+(slot)))
  const int vb0=(int)(lds0+LDS_V)+((lane>>4)&1)*32+(lane&3)*8+(4*hi+((lane&15)>>2))*64;
  const char*Kbase=shm+LDS_K; bf16x8 kf[8];
  const lds_cptr shm3=(lds_cptr)shm; const lds_cptr kp0=shm3+LDS_K+hi*1024+r32*16; const lds_cptr vp0=shm3+LDS_V+((lane>>4)&1)*32+(lane&3)*8+(4*hi+((lane&15)>>2))*64;
  const int NT=(q0+QB)/KVBLK+1;
  DMA_K(0,0);DMA_V(0,0);DMA_K(1,SLOTB);
  bf16x8 qr[4];
  #pragma unroll
  for(int d0=0;d0<4;++d0)qr[d0]=*reinterpret_cast<const bf16x8*>(&Qw[(long)r32*PQ+d0*16+hi*8]);
  float mhat=0.f,l_reg=0.f;f32x16 o[2];o[0]=f32x16{};o[1]=f32x16{};f32x16 negm=f32x16{};asm volatile("":"+v"(negm));
  const int qrel=wid*QBLK+r32;
  #define CMASK(P0,P1,t) do{int jb_=(t)-(NT-4); if(jb_>=0)cmask(P0,P1,jb_,qrel,hi);}while(0)
  bool resc=false;
  #define START(P0,P1) do{ const float rm=rowmax(P0,P1); resc=false; \
    { const float dl=rm; mhat=fadd_s(mhat,dl); \
      _Pragma("unroll") for(int r=0;r<16;++r){P0[r]=fsub_s(P0[r],dl);P1[r]=fsub_s(P1[r],dl);} \
      _Pragma("unroll") for(int r=0;r<16;++r)negm[r]=-mhat; asm volatile("":"+v"(negm)); } \
    _Pragma("unroll") for(int r=0;r<16;++r)P0[r]=__builtin_amdgcn_exp2f(P0[r]); }while(0)
  #define RESC() do{ if(resc){ asm volatile("s_waitcnt lgkmcnt(0)":::"memory"); \
      _Pragma("unroll") for(int d_=0;d_<2;++d_) _Pragma("unroll") for(int r=0;r<16;++r)o[d_][r]*=wsf[crow(r,hi)]; } }while(0)
  f32x16 pA0,pA1,pB0,pB1;
  int sl_prev=0,sl_cur=0,sl_next=SLOTB;
  #define ROT() do{sl_prev=sl_cur;sl_cur=sl_next;sl_next=(sl_next==(NSLOT-1)*SLOTB)?0:sl_next+SLOTB;}while(0)
  DMA_K(2,2*SLOTB);
  WAIT_BAR(3);
  qkt(pA0,pA1,Kbase,qr,negm,r32,hi);asm volatile("s_nop 15\n\ts_nop 7":"+v"(pA0),"+v"(pA1));
  { const float NEGI=-INFINITY; _Pragma("unroll") for(int r=8;r<16;++r)pA0[r]=NEGI; _Pragma("unroll") for(int r=0;r<16;++r)pA1[r]=NEGI; }
  START(pA0,pA1);
  _Pragma("unroll") for(int r=0;r<16;++r)pA1[r]=__builtin_amdgcn_exp2f(pA1[r]);
  WAIT_BAR(0);
  DMA_K(3,0);DMA_V(1,SLOTB);
  ROT();
  kload8(kf,kp0+sl_cur);
  WAIT_BAR(2);
  s16x4 vlo[8],vhi[8]; u32x4 pw0,pw1,pw2,pw3;
  #define PKW(P,B) cvtpk_s(P[B],P[B+1])
  #define PAF(k) __builtin_bit_cast(bf16x8,pw##k)
  #define VFR(i) (bf16x8){vlo[i][0],vlo[i][1],vlo[i][2],vlo[i][3],vhi[i][0],vhi[i][1],vhi[i][2],vhi[i][3]}
  #define PIN(x) asm volatile("":"+v"(x))
  #define MX3(a,b,c) __builtin_fmaxf(__builtin_fmaxf((a),(b)),(c))
  #define GAPA(MF,A0,A1,A2,A3,W0,W1,PW) do{ MF; sacc+=A0; sacc+=A1; sacc+=A2; sacc+=A3; PIN(sacc); W0; W1; PIN(PW); SBAR(); }while(0)
  #define EX(v) __builtin_amdgcn_exp2f(v)
  #define GAPB(MF,X,B) do{ MF; X[B]=EX(X[B]); X[B+1]=EX(X[B+1]); X[B+2]=EX(X[B+2]); X[B+3]=EX(X[B+3]); PIN(X); SBAR(); }while(0)
  #define VRD(i) do{ vlo[i]=vtr(vp_+(((i)>>2)*4096+((i)&3)*1024)); vhi[i]=vtr(vp_+(((i)>>2)*4096+((i)&3)*1024+512)); }while(0)
  #define KRD(G,j) do{ if(G){ kload2(kf,kp0+sl_next,j); SBAR(); } }while(0)
  #define STEP(C0,C1,P0,P1,t,GK,GV,GL) do{ SBAR(); \
    const lds_cptr vp_=vp0+sl_prev; \
    VRD(0); SBAR(); float sacc=(P0[0]+P0[1]); \
    GAPA(C0=__builtin_amdgcn_mfma_f32_32x32x16_bf16(kf[0],qr[0],negm,0,0,0), P0[2],P0[3],P0[4],P0[5],     pw0[0]=PKW(P0,0), pw0[1]=PKW(P0,2), pw0); \
    VRD(4); SBAR(); GAPA(C1=__builtin_amdgcn_mfma_f32_32x32x16_bf16(kf[1],qr[0],negm,0,0,0), P0[6],P0[7],P0[8],P0[9],     pw0[2]=PKW(P0,4), pw0[3]=PKW(P0,6), pw0); \
    VRD(1); SBAR(); GAPA(C0=__builtin_amdgcn_mfma_f32_32x32x16_bf16(kf[2],qr[1],C0,0,0,0),   P0[10],P0[11],P0[12],P0[13], pw1[0]=PKW(P0,8), pw1[1]=PKW(P0,10), pw1); \
    VRD(5); SBAR(); GAPA(C1=__builtin_amdgcn_mfma_f32_32x32x16_bf16(kf[3],qr[1],C1,0,0,0),   P0[14],P0[15],P1[0],P1[1],   pw1[2]=PKW(P0,12),pw1[3]=PKW(P0,14), pw1); \
    VRD(2); SBAR(); GAPA(C0=__builtin_amdgcn_mfma_f32_32x32x16_bf16(kf[4],qr[2],C0,0,0,0),   P1[2],P1[3],P1[4],P1[5],     pw2[0]=PKW(P1,0), pw2[1]=PKW(P1,2), pw2); \
    VRD(6); SBAR(); GAPA(C1=__builtin_amdgcn_mfma_f32_32x32x16_bf16(kf[5],qr[2],C1,0,0,0),   P1[6],P1[7],P1[8],P1[9],     pw2[2]=PKW(P1,4), pw2[3]=PKW(P1,6), pw2); \
    VRD(3); SBAR(); GAPA(C0=__builtin_amdgcn_mfma_f32_32x32x16_bf16(kf[6],qr[3],C0,0,0,0),   P1[10],P1[11],P1[12],P1[13], pw3[0]=PKW(P1,8), pw3[1]=PKW(P1,10), pw3); \
    VRD(7); SBAR(); GAPA(C1=__builtin_amdgcn_mfma_f32_32x32x16_bf16(kf[7],qr[3],C1,0,0,0),   P1[14],P1[15],0.f,0.f,       pw3[2]=PKW(P1,12),pw3[3]=PKW(P1,14), pw3); \
    l_reg+=sacc; \
    if(GK){DMA_K((t)+3,sl_cur);} if(GV){DMA_V((t)+1,sl_next);} \
    CMASK(C0,C1,t); \
    { float a=MX3(C0[0],C0[1],C1[0]),b=MX3(C0[2],C0[3],C1[1]); a=MX3(a,C1[2],C1[3]); \
      _Pragma("unroll") for(int r=4;r<16;r+=4){a=MX3(a,C0[r],C0[r+1]);b=MX3(b,C0[r+2],C0[r+3]);a=MX3(a,C1[r],C1[r+1]);b=MX3(b,C1[r+2],C1[r+3]);} \
      float rm=__builtin_fmaxf(a,b); { auto rr=__builtin_amdgcn_permlane32_swap(__float_as_uint(rm),__float_as_uint(rm),false,false); rm=__builtin_fmaxf(__uint_as_float(rr[0]),__uint_as_float(rr[1])); } \
      resc=false; \
      if(__builtin_expect(__any(rm>(float)THRL),0)){ const float dl=__builtin_fmaxf(rm,0.f); mhat+=dl; \
        _Pragma("unroll") for(int r=0;r<16;++r){C0[r]-=dl;C1[r]-=dl;} \
        _Pragma("unroll") for(int r=0;r<16;++r)negm[r]=-mhat; asm volatile("":"+v"(negm)); \
        const float f=__builtin_amdgcn_exp2f(-dl); l_reg*=f; if(hi==0)wsf[r32]=f; resc=true; } } \
    SBAR(); \
    GAPB(o[0]=__builtin_amdgcn_mfma_f32_32x32x16_bf16(PAF(0),VFR(0),o[0],0,0,0), C0,0); \
    GAPB(o[1]=__builtin_amdgcn_mfma_f32_32x32x16_bf16(PAF(0),VFR(4),o[1],0,0,0), C0,4); \
    KRD(GL,0); GAPB(o[0]=__builtin_amdgcn_mfma_f32_32x32x16_bf16(PAF(1),VFR(1),o[0],0,0,0), C0,8); \
    KRD(GL,1); GAPB(o[1]=__builtin_amdgcn_mfma_f32_32x32x16_bf16(PAF(1),VFR(5),o[1],0,0,0), C0,12); \
    KRD(GL,2); GAPB(o[0]=__builtin_amdgcn_mfma_f32_32x32x16_bf16(PAF(2),VFR(2),o[0],0,0,0), C1,0); \
    KRD(GL,3); GAPB(o[1]=__builtin_amdgcn_mfma_f32_32x32x16_bf16(PAF(2),VFR(6),o[1],0,0,0), C1,4); \
    GAPB(o[0]=__builtin_amdgcn_mfma_f32_32x32x16_bf16(PAF(3),VFR(3),o[0],0,0,0), C1,8); \
    GAPB(o[1]=__builtin_amdgcn_mfma_f32_32x32x16_bf16(PAF(3),VFR(7),o[1],0,0,0), C1,12); \
    }while(0)
  int t=1;
  #undef CMASK
  #define CMASK(P0,P1,t) do{}while(0)
  for(;t+5<NT;t+=2){
    STEP(pB0,pB1,pA0,pA1,t,true,true,true);     WAIT_BAR(2); RESC(); ROT();
    STEP(pA0,pA1,pB0,pB1,t+1,true,true,true);   WAIT_BAR(2); RESC(); ROT();
  }
  #undef CMASK
  #define CMASK(P0,P1,t) do{int jb_=(t)-(NT-4); if(jb_>=0)cmask(P0,P1,jb_,qrel,hi);}while(0)
  #define ENDW(tt) do{ if((tt)+3<NT){WAIT_BAR(2);} else if((tt)+2<NT){WAIT_BAR(1);} else {WAIT_BAR(0);} }while(0)
  for(;t+1<NT;t+=2){
    STEP(pB0,pB1,pA0,pA1,t,(t+3<NT),(t+1<NT),(t+1<NT));       ENDW(t);   RESC(); ROT();
    STEP(pA0,pA1,pB0,pB1,t+1,(t+4<NT),(t+2<NT),(t+2<NT));     ENDW(t+1); RESC(); ROT();
  }
  { float sacc=pA0[0]+pA0[1]; _Pragma("unroll") for(int r=2;r<16;++r)sacc+=pA0[r]; _Pragma("unroll") for(int r=0;r<16;++r)sacc+=pA1[r]; l_reg+=sacc;
    pw0=(u32x4){PKW(pA0,0),PKW(pA0,2),PKW(pA0,4),PKW(pA0,6)};pw1=(u32x4){PKW(pA0,8),PKW(pA0,10),PKW(pA0,12),PKW(pA0,14)};pw2=(u32x4){PKW(pA1,0),PKW(pA1,2),PKW(pA1,4),PKW(pA1,6)};pw3=(u32x4){PKW(pA1,8),PKW(pA1,10),PKW(pA1,12),PKW(pA1,14)};
    SBAR(); pv(o,vb0+sl_prev,PAF(0),PAF(1),PAF(2),PAF(3)); }
  #undef PKW
  #undef PAF
  #undef VFR
  #undef PIN
  #undef MX3
  #undef GAPA
  #undef GAPB
  #undef EX
  #undef VRD
  #undef KRD
  #undef STEP
  #undef ENDW
  {auto rr=__builtin_amdgcn_permlane32_swap(__float_as_uint(l_reg),__float_as_uint(l_reg),false,false);l_reg=__uint_as_float(rr[0])+__uint_as_float(rr[1]);}
  if(hi==0)wsf[32+r32]=l_reg;asm volatile("s_waitcnt lgkmcnt(0)":::"memory");
  float rli[16];
  #pragma unroll
  for(int r=0;r<16;++r)rli[r]=__builtin_amdgcn_rcpf(wsf[32+crow(r,hi)]);
  bf16*Ow=Ou+(long)(wid*QBLK)*PO;
  { bf16*stg=(bf16*)(shm+LDS_OST)+wid*2048;
    #pragma unroll
    for(int r=0;r<16;++r){const int orow=crow(r,hi);
      #pragma unroll
      for(int d0=0;d0<2;++d0)stg[orow*64+d0*32+r32]=__float2bfloat16(o[d0][r]*rli[r]);}
    asm volatile("s_waitcnt lgkmcnt(0)":::"memory");
    #pragma unroll
    for(int i=0;i<4;++i){const int row=i*8+(lane>>3),ch=lane&7; const u32x4 v=*(const u32x4*)(stg+row*64+ch*8); ATTN_STORE16(Ow+(long)row*PO+ch*8,v);} }
  asm volatile("s_waitcnt lgkmcnt(0)\n\ts_barrier":::"memory");
  #undef DMA_K
  #undef DMA_V
  #undef CMASK
  #undef START
  #undef RESC
  #undef ROT
}
constexpr int ATTN_LDS_BYTES=LDS_BYTES;
#undef SBAR
#undef WAIT_BAR
typedef float f32x4v __attribute__((ext_vector_type(4)));
constexpr int V2_SLOTV=16384, V2_LDS_K=0, V2_LDS_V=NSLOT*SLOTB, V2_LDS_WS=V2_LDS_V+NSLOT*V2_SLOTV, V2_LDS_OST=V2_LDS_WS+NW*64*4, V2_LDS_BYTES=V2_LDS_OST+NW*8192;
#define SBAR() __builtin_amdgcn_sched_barrier(0)
#define WAIT_BAR(N) asm volatile("s_waitcnt vmcnt(" #N ") lgkmcnt(0)\n\ts_barrier":::"memory")
__device__ __forceinline__ void pv4(f32x16*o,int vb,bf16x8 pa0,bf16x8 pa1,bf16x8 pa2,bf16x8 pa3){
  #pragma unroll
  for(int d0=0;d0<4;++d0){s16x4 lo[4],hi[4];
    #pragma unroll
    for(int ks=0;ks<4;++ks){
      asm volatile("ds_read_b64_tr_b16 %0,%1 offset:%c2":"=&v"(lo[ks]):"v"(vb),"i"(d0*4096+ks*1024):"memory");
      asm volatile("ds_read_b64_tr_b16 %0,%1 offset:%c2":"=&v"(hi[ks]):"v"(vb),"i"(d0*4096+ks*1024+512):"memory");}
    asm volatile("s_waitcnt lgkmcnt(0)":::"memory");SBAR();
    #define PK(k) (bf16x8){lo[k][0],lo[k][1],lo[k][2],lo[k][3],hi[k][0],hi[k][1],hi[k][2],hi[k][3]}
    o[d0]=__builtin_amdgcn_mfma_f32_32x32x16_bf16(pa0,PK(0),o[d0],0,0,0);
    o[d0]=__builtin_amdgcn_mfma_f32_32x32x16_bf16(pa1,PK(1),o[d0],0,0,0);
    o[d0]=__builtin_amdgcn_mfma_f32_32x32x16_bf16(pa2,PK(2),o[d0],0,0,0);
    o[d0]=__builtin_amdgcn_mfma_f32_32x32x16_bf16(pa3,PK(3),o[d0],0,0,0);
    #undef PK
  }
}
template<int MODE> __device__ __forceinline__ void attn_unit128(int q0,const bf16*Qu,const bf16*__restrict__ Kh,const bf16*__restrict__ Vh,bf16*Ou,char*shm,float lam,float oscale,const float*subg){
  int tid_=threadIdx.x; asm volatile("":"+v"(tid_)); const int tid=tid_,lane=tid&63,r32=lane&31,hi=lane>>5; const int wid=__builtin_amdgcn_readfirstlane(tid>>6);
  const bf16*Qw=Qu+(long)(wid*QBLK)*PQ;
  const unsigned lds0=(unsigned)(uintptr_t)shm;
  float*wsf=(float*)(shm+V2_LDS_WS)+wid*64;
  const bf16*ksrc=Kh+(long)lane*PQ+wid*8;
  const bf16*vsrc=Vh+(long)(16*(wid&3)+(lane>>2))*PQ+(wid>>2)*32+(lane&3)*8;
  const unsigned kdst=lds0+V2_LDS_K+wid*1024, vdst=lds0+V2_LDS_V+wid*1024;
  #define DMA_K(t,slot) glds16(ksrc+(long)(t)*KVBLK*PQ,(unsigned)__builtin_amdgcn_readfirstlane(kdst+(slot)))
  #define DMA_V(t,slot) do{ glds16(vsrc+(long)(t)*KVBLK*PQ,(unsigned)__builtin_amdgcn_readfirstlane(vdst+2*(slot))); glds16(vsrc+(long)(t)*KVBLK*PQ+64,(unsigned)__builtin_amdgcn_readfirstlane(vdst+2*(slot)+8192)); }while(0)
  const int vb0=(int)(lds0+V2_LDS_V)+((lane>>4)&1)*32+(lane&3)*8+(4*hi+((lane&15)>>2))*64;
  const char*Kbase=shm+V2_LDS_K; bf16x8 kf[8];
  const lds_cptr shm3=(lds_cptr)shm; const lds_cptr kp0=shm3+V2_LDS_K+hi*1024+r32*16; const lds_cptr vp0=shm3+V2_LDS_V+((lane>>4)&1)*32+(lane&3)*8+(4*hi+((lane&15)>>2))*64;
  const int NT=(q0+QB)/KVBLK+1;
  DMA_K(0,0);DMA_V(0,0);DMA_K(1,SLOTB);
  bf16x8 qr[4];
  #pragma unroll
  for(int d0=0;d0<4;++d0)qr[d0]=*reinterpret_cast<const bf16x8*>(&Qw[(long)r32*PQ+d0*16+hi*8]);
  float l_reg=0.f;f32x16 o[4];o[0]=f32x16{};o[1]=f32x16{};o[2]=f32x16{};o[3]=f32x16{};
  const f32x16 zero16=f32x16{};
  const int qrel=wid*QBLK+r32;
  #define CMASK(P0,P1,t) do{int jb_=(t)-(NT-4); if(jb_>=0)cmask(P0,P1,jb_,qrel,hi);}while(0)
  f32x16 pA0,pA1,pB0,pB1;
  int sl_prev=0,sl_cur=0,sl_next=SLOTB;
  #define ROT() do{sl_prev=sl_cur;sl_cur=sl_next;sl_next=(sl_next==(NSLOT-1)*SLOTB)?0:sl_next+SLOTB;}while(0)
  DMA_K(2,2*SLOTB);
  WAIT_BAR(3);
  qkt(pA0,pA1,Kbase,qr,zero16,r32,hi);asm volatile("s_nop 15\n\ts_nop 7":"+v"(pA0),"+v"(pA1));
  { const float NEGI=-INFINITY; _Pragma("unroll") for(int r=8;r<16;++r)pA0[r]=NEGI; _Pragma("unroll") for(int r=0;r<16;++r)pA1[r]=NEGI; }
  _Pragma("unroll") for(int r=0;r<16;++r){pA0[r]=__builtin_amdgcn_exp2f(pA0[r]);pA1[r]=__builtin_amdgcn_exp2f(pA1[r]);}
  WAIT_BAR(0);
  DMA_K(3,0);DMA_V(1,SLOTB);
  ROT();
  kload8(kf,kp0+sl_cur);
  WAIT_BAR(3);
  s16x4 vlo[8],vhi[8]; u32x4 pw0,pw1,pw2,pw3;
  #define PKW(P,B) cvtpk_s(P[B],P[B+1])
  #define PAF(k) __builtin_bit_cast(bf16x8,pw##k)
  #define VFR(i) (bf16x8){vlo[i][0],vlo[i][1],vlo[i][2],vlo[i][3],vhi[i][0],vhi[i][1],vhi[i][2],vhi[i][3]}
  #define PIN(x) asm volatile("":"+v"(x))
  #define GAPA(MF,A0,A1,A2,A3,W0,W1,PW) do{ MF; sacc+=A0; sacc+=A1; sacc+=A2; sacc+=A3; PIN(sacc); W0; W1; PIN(PW); SBAR(); }while(0)
  #define EX(v) __builtin_amdgcn_exp2f(v)
  #define GAPB(MF,X,B) do{ MF; X[B]=EX(X[B]); X[B+1]=EX(X[B+1]); PIN(X); SBAR(); }while(0)
  #define VRD(i) do{ vlo[i]=vtr(vp_+(((i)>>2)*4096+((i)&3)*1024)); vhi[i]=vtr(vp_+(((i)>>2)*4096+((i)&3)*1024+512)); }while(0)
  #define VRD2(i) do{ vlo[i]=vtr(vp_+(8192+((i)>>2)*4096+((i)&3)*1024)); vhi[i]=vtr(vp_+(8192+((i)>>2)*4096+((i)&3)*1024+512)); SBAR(); }while(0)
  #define KRD(G,j) do{ if(G){ kload2(kf,kp0+sl_next,j); SBAR(); } }while(0)
  #define MF32(a,b,c) __builtin_amdgcn_mfma_f32_32x32x16_bf16(a,b,c,0,0,0)
  #define STEP(C0,C1,P0,P1,t,GK,GV,GL) do{ SBAR(); \
    const lds_cptr vp_=vp0+2*sl_prev; \
    VRD(0); SBAR(); float sacc=(P0[0]+P0[1]); \
    GAPA(C0=MF32(kf[0],qr[0],zero16), P0[2],P0[3],P0[4],P0[5],     pw0[0]=PKW(P0,0), pw0[1]=PKW(P0,2), pw0); \
    VRD(4); SBAR(); GAPA(C1=MF32(kf[1],qr[0],zero16), P0[6],P0[7],P0[8],P0[9],     pw0[2]=PKW(P0,4), pw0[3]=PKW(P0,6), pw0); \
    VRD(1); SBAR(); GAPA(C0=MF32(kf[2],qr[1],C0),   P0[10],P0[11],P0[12],P0[13], pw1[0]=PKW(P0,8), pw1[1]=PKW(P0,10), pw1); \
    VRD(5); SBAR(); GAPA(C1=MF32(kf[3],qr[1],C1),   P0[14],P0[15],P1[0],P1[1],   pw1[2]=PKW(P0,12),pw1[3]=PKW(P0,14), pw1); \
    VRD(2); SBAR(); GAPA(C0=MF32(kf[4],qr[2],C0),   P1[2],P1[3],P1[4],P1[5],     pw2[0]=PKW(P1,0), pw2[1]=PKW(P1,2), pw2); \
    VRD(6); SBAR(); GAPA(C1=MF32(kf[5],qr[2],C1),   P1[6],P1[7],P1[8],P1[9],     pw2[2]=PKW(P1,4), pw2[3]=PKW(P1,6), pw2); \
    VRD(3); SBAR(); GAPA(C0=MF32(kf[6],qr[3],C0),   P1[10],P1[11],P1[12],P1[13], pw3[0]=PKW(P1,8), pw3[1]=PKW(P1,10), pw3); \
    VRD(7); SBAR(); GAPA(C1=MF32(kf[7],qr[3],C1),   P1[14],P1[15],0.f,0.f,       pw3[2]=PKW(P1,12),pw3[3]=PKW(P1,14), pw3); \
    l_reg+=sacc; \
    if(GK){DMA_K((t)+3,sl_cur);} if(GV){DMA_V((t)+1,sl_next);} \
    CMASK(C0,C1,t); \
    SBAR(); \
    GAPB(o[0]=MF32(PAF(0),VFR(0),o[0]), C0,0);  VRD2(0); \
    GAPB(o[1]=MF32(PAF(0),VFR(4),o[1]), C0,2);  VRD2(4); \
    KRD(GL,0); GAPB(o[0]=MF32(PAF(1),VFR(1),o[0]), C0,4);  VRD2(1); \
    KRD(GL,1); GAPB(o[1]=MF32(PAF(1),VFR(5),o[1]), C0,6);  VRD2(5); \
    KRD(GL,2); GAPB(o[0]=MF32(PAF(2),VFR(2),o[0]), C0,8);  VRD2(2); \
    KRD(GL,3); GAPB(o[1]=MF32(PAF(2),VFR(6),o[1]), C0,10); VRD2(6); \
    GAPB(o[0]=MF32(PAF(3),VFR(3),o[0]), C0,12); VRD2(3); \
    GAPB(o[1]=MF32(PAF(3),VFR(7),o[1]), C0,14); VRD2(7); \
    GAPB(o[2]=MF32(PAF(0),VFR(0),o[2]), C1,0); \
    GAPB(o[3]=MF32(PAF(0),VFR(4),o[3]), C1,2); \
    GAPB(o[2]=MF32(PAF(1),VFR(1),o[2]), C1,4); \
    GAPB(o[3]=MF32(PAF(1),VFR(5),o[3]), C1,6); \
    GAPB(o[2]=MF32(PAF(2),VFR(2),o[2]), C1,8); \
    GAPB(o[3]=MF32(PAF(2),VFR(6),o[3]), C1,10); \
    GAPB(o[2]=MF32(PAF(3),VFR(3),o[2]), C1,12); \
    GAPB(o[3]=MF32(PAF(3),VFR(7),o[3]), C1,14); \
    }while(0)
  int t=1;
  #undef CMASK
  #define CMASK(P0,P1,t) do{}while(0)
  for(;t+5<NT;t+=2){
    STEP(pB0,pB1,pA0,pA1,t,true,true,true);     WAIT_BAR(3); ROT();
    STEP(pA0,pA1,pB0,pB1,t+1,true,true,true);   WAIT_BAR(3); ROT();
  }
  #undef CMASK
  #define CMASK(P0,P1,t) do{int jb_=(t)-(NT-4); if(jb_>=0)cmask(P0,P1,jb_,qrel,hi);}while(0)
  #define ENDW(tt) do{ if((tt)+3<NT){WAIT_BAR(3);} else if((tt)+2<NT){WAIT_BAR(2);} else {WAIT_BAR(0);} }while(0)
  for(;t+1<NT;t+=2){
    STEP(pB0,pB1,pA0,pA1,t,(t+3<NT),(t+1<NT),(t+1<NT));       ENDW(t);   ROT();
    STEP(pA0,pA1,pB0,pB1,t+1,(t+4<NT),(t+2<NT),(t+2<NT));     ENDW(t+1); ROT();
  }
  { float sacc=pA0[0]+pA0[1]; _Pragma("unroll") for(int r=2;r<16;++r)sacc+=pA0[r]; _Pragma("unroll") for(int r=0;r<16;++r)sacc+=pA1[r]; l_reg+=sacc;
    pw0=(u32x4){PKW(pA0,0),PKW(pA0,2),PKW(pA0,4),PKW(pA0,6)};pw1=(u32x4){PKW(pA0,8),PKW(pA0,10),PKW(pA0,12),PKW(pA0,14)};pw2=(u32x4){PKW(pA1,0),PKW(pA1,2),PKW(pA1,4),PKW(pA1,6)};pw3=(u32x4){PKW(pA1,8),PKW(pA1,10),PKW(pA1,12),PKW(pA1,14)};
    SBAR(); pv4(o,vb0+2*sl_prev,PAF(0),PAF(1),PAF(2),PAF(3)); }
  #undef PKW
  #undef PAF
  #undef VFR
  #undef PIN
  #undef GAPA
  #undef GAPB
  #undef EX
  #undef VRD
  #undef VRD2
  #undef KRD
  #undef MF32
  #undef STEP
  #undef ENDW
  {auto rr=__builtin_amdgcn_permlane32_swap(__float_as_uint(l_reg),__float_as_uint(l_reg),false,false);l_reg=__uint_as_float(rr[0])+__uint_as_float(rr[1]);}
  if(hi==0)wsf[32+r32]=l_reg;asm volatile("s_waitcnt lgkmcnt(0)":::"memory");
  float rli[16];
  #pragma unroll
  for(int r=0;r<16;++r)rli[r]=__builtin_amdgcn_rcpf(wsf[32+crow(r,hi)]);
  { bf16*park=(bf16*)(shm+V2_LDS_OST)+wid*4096;
    if(MODE==0){
      #pragma unroll
      for(int r=0;r<16;++r){const int orow=crow(r,hi);
        #pragma unroll
        for(int d0=0;d0<4;++d0)park[orow*128+d0*32+r32]=__float2bfloat16(o[d0][r]*rli[r]);}
      asm volatile("s_waitcnt lgkmcnt(0)":::"memory");
    } else {
      #pragma unroll
      for(int r=0;r<16;++r){const int orow=crow(r,hi);
        #pragma unroll
        for(int d0=0;d0<4;++d0){const float o1=__bfloat162float(park[orow*128+d0*32+r32]); park[orow*128+d0*32+r32]=__float2bfloat16(o1-lam*(o[d0][r]*rli[r]));}}
      asm volatile("s_waitcnt lgkmcnt(0)":::"memory");
      bf16*Ow=Ou+(long)(wid*QBLK)*PO;
      const int ch=lane&15; const f32x4v g0=*(const f32x4v*)(subg+8*ch), g1=*(const f32x4v*)(subg+8*ch+4);
      #pragma unroll
      for(int i=0;i<8;++i){const int row=i*4+(lane>>4); const u32x4 v=*(const u32x4*)(park+row*128+ch*8);
        float d[8]; d[0]=__uint_as_float(v.x<<16);d[1]=__uint_as_float(v.x&0xffff0000u);d[2]=__uint_as_float(v.y<<16);d[3]=__uint_as_float(v.y&0xffff0000u);d[4]=__uint_as_float(v.z<<16);d[5]=__uint_as_float(v.z&0xffff0000u);d[6]=__uint_as_float(v.w<<16);d[7]=__uint_as_float(v.w&0xffff0000u);
        float ss=(d[0]*d[0]+d[1]*d[1])+(d[2]*d[2]+d[3]*d[3])+(d[4]*d[4]+d[5]*d[5])+(d[6]*d[6]+d[7]*d[7]);
        ss+=__shfl_xor(ss,1);ss+=__shfl_xor(ss,2);ss+=__shfl_xor(ss,4);ss+=__shfl_xor(ss,8);
        const float rs=__builtin_amdgcn_rsqf(ss*(1.0f/128.0f)+1e-6f)*oscale;
        u32x4 w; w.x=cvtpk_s(d[0]*rs*g0[0],d[1]*rs*g0[1]); w.y=cvtpk_s(d[2]*rs*g0[2],d[3]*rs*g0[3]); w.z=cvtpk_s(d[4]*rs*g1[0],d[5]*rs*g1[1]); w.w=cvtpk_s(d[6]*rs*g1[2],d[7]*rs*g1[3]);
        ATTN_STORE16(Ow+(long)row*PO+ch*8,w);}
      asm volatile("s_waitcnt lgkmcnt(0)":::"memory");
    } }
  asm volatile("s_waitcnt lgkmcnt(0)\n\ts_barrier":::"memory");
  #undef DMA_K
  #undef DMA_V
  #undef CMASK
  #undef ROT
}
#undef SBAR
#undef WAIT_BAR

}
namespace cg = cooperative_groups;
constexpr int NWAVES = 8;
constexpr int NB = 4, SEQ = 8192, DM = 1024, NMETA = 16, DIN = 2560, DFF = 4096, DCONV = 512, CONVW = 31;
constexpr int MX = NB * SEQ;
constexpr int MP = MX + 256;
constexpr int SPAD = pg8::SPAD;
constexpr float EPS = 1e-6f;
constexpr size_t MiB = 1u << 20;
constexpr size_t WS_CTL = 0, WS_WIN = 1 * MiB, WS_WOUT = 6 * MiB, WS_WUP = 8 * MiB, WS_WDN = 16 * MiB, WS_ROPE = 24 * MiB, WS_SSQ = 25 * MiB, WS_RN = 27 * MiB,
                 WS_H1B = 28 * MiB, WS_MIX = 92 * MiB, WS_HB = 156 * MiB, WS_XN = 156 * MiB, WS_O = 156 * MiB, WS_Q = 222 * MiB, WS_K = 254 * MiB, WS_V = 287 * MiB, WS_G = 320 * MiB,
                 WS_END = 412 * MiB;
static_assert(WS_XN + (size_t)MP * DM * 2 <= WS_Q && WS_K + (size_t)NB * SPAD * 512 * 2 <= WS_V && WS_G + (size_t)NB * SPAD * 512 * 2 <= WS_HB + (size_t)MX * DFF * 2 && WS_HB + (size_t)MX * DFF * 2 <= WS_END, "d_ws map");
constexpr int RING_BYTES = 131072, LDS_BYTES = 147456;

#define LAS __attribute__((address_space(3)))
typedef unsigned short bf16;
typedef unsigned v4u __attribute__((ext_vector_type(4)));
typedef float f32x4 __attribute__((ext_vector_type(4)));
typedef float f32x2 __attribute__((ext_vector_type(2)));
#define LDS_WAIT() asm volatile("s_waitcnt lgkmcnt(0)" ::: "memory")
__device__ __forceinline__ unsigned pk2(float lo, float hi) { return pg8::cvt_pk_bf16(lo, hi); }
__device__ __forceinline__ float bf_lo(unsigned u) { return __uint_as_float(u << 16); }
__device__ __forceinline__ float bf_hi(unsigned u) { return __uint_as_float(u & 0xffff0000u); }
__device__ __forceinline__ float wave_sum(float v) {
#pragma unroll
    for (int o = 1; o < 64; o <<= 1) v += __shfl_xor(v, o);
    return v;
}

#define XB_TMO      128
#define XB_XCNT(j)  (256  + 64 * (j))
#define XB_XSUB(j)  (1280 + 64 * (j))
#define XB_XGEN(j)  (2304 + 64 * (j))
#define XB_TOP      3328
#define XB_TOPGEN   3392
#define XCD_BAR_WORDS 3456
#define XB_SPIN_CAP (1u << 18)

__device__ __forceinline__ unsigned xb_ld(unsigned* p)              { return __hip_atomic_load(p, __ATOMIC_RELAXED, __HIP_MEMORY_SCOPE_AGENT); }
__device__ __forceinline__ unsigned xb_add(unsigned* p, unsigned v) { return __hip_atomic_fetch_add(p, v, __ATOMIC_RELAXED, __HIP_MEMORY_SCOPE_AGENT); }
__device__ __forceinline__ unsigned xb_xcc_id() { return (unsigned)__builtin_amdgcn_s_getreg((3 << 11) | 20) & 0xFu; }
#define XB_SPIN(cond, bar) do { unsigned _sp = 0; while (cond) { __builtin_amdgcn_s_sleep(1); \
    if ((++_sp & 255u) == 0u) { if (xb_ld(&(bar)[XB_TMO])) break; if (_sp > XB_SPIN_CAP) { atomicAdd(&(bar)[XB_TMO], 1u); break; } } } } while (0)

struct XcdBarrier {
    unsigned* bar; unsigned x;
    volatile LAS unsigned* st;
};

__device__ __forceinline__ XcdBarrier xcd_barrier_post(unsigned* bar, volatile LAS unsigned* st) {
    XcdBarrier b; b.bar = bar; b.x = xb_xcc_id(); b.st = st;
    if (threadIdx.x == 0) (void)xb_add(&bar[XB_XCNT(b.x)], 1u);
    return b;
}
__device__ __forceinline__ void xcd_barrier_complete(unsigned* bar, unsigned x, unsigned& nloc, unsigned& nx) {
    const unsigned G = gridDim.x * gridDim.y * gridDim.z;
    unsigned sum, cnt, mine, sp = 0u;
    for (;;) {
        sum = 0u; cnt = 0u; mine = 0u;
#pragma unroll
        for (unsigned j = 0; j < 16; ++j) { const unsigned c = xb_ld(&bar[XB_XCNT(j)]); sum += c; cnt += (c > 0u) ? 1u : 0u; mine = (j == x) ? c : mine; }
        if (sum == G) break;
        __builtin_amdgcn_s_sleep(1);
        if ((++sp & 255u) == 0u) { if (xb_ld(&bar[XB_TMO])) break; if (sp > XB_SPIN_CAP) { atomicAdd(&bar[XB_TMO], 1u); break; } }
    }
    nloc = mine > 0u ? mine : 1u; nx = cnt > 0u ? cnt : 1u;
}

__device__ __forceinline__ void xcd_barrier(const XcdBarrier& b) {
    asm volatile("s_waitcnt vmcnt(0)" ::: "memory");
    __syncthreads();
    if (threadIdx.x == 0) {
        unsigned* bar = b.bar;
        __builtin_amdgcn_s_waitcnt(0);
        unsigned nloc = b.st[0], nx = b.st[1];
        if (nloc == 0u) { xcd_barrier_complete(bar, b.x, nloc, nx); b.st[0] = nloc; b.st[1] = nx; }
        const unsigned old = xb_add(&bar[XB_XSUB(b.x)], 1u);
        const unsigned gen = old / nloc;
        if (old + 1u == (gen + 1u) * nloc) {
            __builtin_amdgcn_fence(__ATOMIC_RELEASE, "agent");
            asm volatile("s_waitcnt vmcnt(0)" ::: "memory");
            const unsigned og = xb_add(&bar[XB_TOP], 1u);
            const unsigned tg = og / nx;
            if (og + 1u == (tg + 1u) * nx) xb_add(&bar[XB_TOPGEN], 1u);
            else XB_SPIN(xb_ld(&bar[XB_TOPGEN]) == tg, bar);
            __builtin_amdgcn_fence(__ATOMIC_ACQUIRE, "agent");
            xb_add(&bar[XB_XGEN(b.x)], 1u);
            asm volatile("s_waitcnt vmcnt(0)" ::: "memory");
        } else {
            XB_SPIN(xb_ld(&bar[XB_XGEN(b.x)]) == gen, bar);
            __builtin_amdgcn_fence(__ATOMIC_ACQUIRE, "agent");
            asm volatile("s_waitcnt vmcnt(0)" ::: "memory");
        }
    }
    __syncthreads();
}

__device__ __forceinline__ float dpp_add(float v, const int ctrl_sel) {
    int t;
    if (ctrl_sel == 0) t = __builtin_amdgcn_update_dpp(0, __float_as_int(v), 0xB1, 0xF, 0xF, true);
    else if (ctrl_sel == 1) t = __builtin_amdgcn_update_dpp(0, __float_as_int(v), 0x4E, 0xF, 0xF, true);
    else if (ctrl_sel == 2) t = __builtin_amdgcn_update_dpp(0, __float_as_int(v), 0x141, 0xF, 0xF, true);
    else t = __builtin_amdgcn_update_dpp(0, __float_as_int(v), 0x140, 0xF, 0xF, true);
    return v + __int_as_float(t);
}
__device__ __forceinline__ float wave_sum_fast(float v) {
    v = dpp_add(v, 0); v = dpp_add(v, 1); v = dpp_add(v, 2); v = dpp_add(v, 3);
    { auto rr = __builtin_amdgcn_permlane16_swap(__float_as_uint(v), __float_as_uint(v), false, false); v = __uint_as_float(rr[0]) + __uint_as_float(rr[1]); }
    { auto rr = __builtin_amdgcn_permlane32_swap(__float_as_uint(v), __float_as_uint(v), false, false); v = __uint_as_float(rr[0]) + __uint_as_float(rr[1]); }
    return v;
}

struct Args { const float* in[19]; float* out; unsigned char* ws; float inv_freq[8]; };
enum { I_X = 0, I_META, I_G1, I_WIN, I_QG, I_KG, I_LQ1, I_LK1, I_LQ2, I_LK2, I_SUBLN, I_CW, I_CB, I_CLG, I_CLB, I_WOUT, I_G2, I_WUP, I_WDN };

__device__ __forceinline__ void p0_transpose_item(const float* W, int K, int N, bf16* WT, int out_row0, int n0, int k0, const float* kscale, LAS float* scr, int lane) {
    float tv[32], ts[32];
#pragma unroll
    for (int i = 0; i < 32; ++i) { const int kk = 2 * i + (lane >> 5); tv[i] = W[(size_t)(k0 + kk) * N + n0 + (lane & 31)]; ts[i] = kscale ? kscale[k0 + kk] : 1.0f; }
#pragma unroll
    for (int i = 0; i < 32; ++i) { const int kk = 2 * i + (lane >> 5); scr[kk * 33 + (lane & 31)] = tv[i] * ts[i]; }
    LDS_WAIT(); asm volatile("" ::: "memory");
    const int c = lane & 7;
#pragma unroll
    for (int j = 0; j < 4; ++j) { const int n = (lane >> 3) + 8 * j; const LAS float* s = scr + (8 * c) * 33 + n;
        v4u o; o.x = pk2(s[0 * 33], s[1 * 33]); o.y = pk2(s[2 * 33], s[3 * 33]); o.z = pk2(s[4 * 33], s[5 * 33]); o.w = pk2(s[6 * 33], s[7 * 33]);
        *(v4u*)(WT + (size_t)(out_row0 + n) * K + k0 + 8 * c) = o; }
    LDS_WAIT(); asm volatile("" ::: "memory");
}
__device__ __forceinline__ int win_pcol(int lc) {
    if (lc < 1024) { const int l = lc & 255; return (lc & ~255) + 128 * ((l >> 5) & 1) + 32 * (l >> 6) + (l & 31); }
    if (lc < 1536) return lc;
    if (lc < 2048) { const int ch = lc - 1536; return 1536 + 256 * (ch >> 7) + (ch & 127); }
    const int ch = lc - 2048; return 1536 + 256 * (ch >> 7) + 128 + (ch & 127);
}

__device__ __forceinline__ void p0_prologue(const Args& A, unsigned char* ws, LAS unsigned char* lds, int vcu, int G, int wave, int lane) {
    LAS float* scr = (LAS float*)(lds + wave * 16384);
    const int gw = vcu * NWAVES + wave, NGW = G * NWAVES;
    bf16* Win_t = (bf16*)(ws + WS_WIN); bf16* Wout_t = (bf16*)(ws + WS_WOUT); bf16* Wup_t = (bf16*)(ws + WS_WUP); bf16* Wdn_t = (bf16*)(ws + WS_WDN);
    constexpr int I_IN = (DM / 64) * (DIN / 32), I_OUT = (DM / 64) * (DM / 32), I_UP = (DM / 64) * (DFF / 32), I_DN = (DFF / 64) * (DM / 32);
    constexpr int NITEMS = I_IN + I_OUT + I_UP + I_DN;
    for (int it = gw; it < NITEMS; it += NGW) {
        int r = it;
        if (r < I_IN) { const int nblk = DIN / 32, kb = r / nblk, nb = r % nblk; p0_transpose_item(A.in[I_WIN], DM, DIN, Win_t, win_pcol(32 * nb), 32 * nb, 64 * kb, nullptr, scr, lane); continue; } r -= I_IN;
        if (r < I_OUT) { const int nblk = DM / 32, kb = r / nblk, nb = r % nblk; p0_transpose_item(A.in[I_WOUT], DM, DM, Wout_t, 32 * nb, 32 * nb, 64 * kb, nullptr, scr, lane); continue; } r -= I_OUT;
        if (r < I_UP) { const int nblk = DFF / 32, kb = r / nblk, nb = r % nblk; p0_transpose_item(A.in[I_WUP], DM, DFF, Wup_t, 32 * nb, 32 * nb, 64 * kb, A.in[I_G2], scr, lane); continue; } r -= I_UP;
        { const int nblk = DM / 32, kb = r / nblk, nb = r % nblk; p0_transpose_item(A.in[I_WDN], DFF, DM, Wdn_t, 32 * nb, 32 * nb, 64 * kb, nullptr, scr, lane); }
    }
    {
        bf16* XN = (bf16*)(ws + WS_XN);
        f32x4 g[4];
#pragma unroll
        for (int j = 0; j < 4; ++j) g[j] = ((const f32x4*)A.in[I_G1])[lane + 64 * j];
        for (int m0 = gw; m0 < MX + NMETA; m0 += 4 * NGW) {
            f32x4 v[4][4];
#pragma unroll
            for (int q = 0; q < 4; ++q) { const int m = m0 + q * NGW; const bool ok = m < MX + NMETA;
                const float* src = !ok ? A.in[I_X] : (m < MX) ? A.in[I_X] + (size_t)m * DM : A.in[I_META] + (size_t)(m - MX) * DM;
                const f32x4* xr = (const f32x4*)src + lane;
#pragma unroll
                for (int j = 0; j < 4; ++j) v[q][j] = xr[64 * j]; }
#pragma unroll
            for (int q = 0; q < 4; ++q) { const int m = m0 + q * NGW; if (m >= MX + NMETA) continue;
                float s = 0.f;
#pragma unroll
                for (int j = 0; j < 4; ++j) s += (v[q][j].x * v[q][j].x + v[q][j].y * v[q][j].y) + (v[q][j].z * v[q][j].z + v[q][j].w * v[q][j].w);
                const float ms = wave_sum_fast(s) * (1.f / DM) + EPS; const float rs = __builtin_amdgcn_rsqf(ms);
                if (lane == 0 && m < MX) ((float*)(ws + WS_RN))[m] = ms * rs;
                unsigned long long* o8 = (unsigned long long*)(XN + (size_t)m * DM) + lane;
#pragma unroll
                for (int j = 0; j < 4; ++j) { const f32x4 y = v[q][j] * rs * g[j]; o8[64 * j] = (unsigned long long)pk2(y.x, y.y) | ((unsigned long long)pk2(y.z, y.w) << 32); } }
        }
    }
    {
        float* rope = (float*)(ws + WS_ROPE);
        const int pos = gw * 64 + lane;
        if (pos < SEQ + NMETA) {
#pragma unroll
            for (int i = 0; i < 8; ++i) {
                const float angf = (float)pos * A.inv_freq[i];
                const double rev = (double)angf * 0.15915494309189533577; const double fr = rev - __builtin_rint(rev);
                const float f = (float)fr;
                rope[pos * 16 + i] = __builtin_amdgcn_cosf(f); rope[pos * 16 + 8 + i] = __builtin_amdgcn_sinf(f); } }
    }
    {
        bf16* KB = (bf16*)(ws + WS_K); bf16* VB = (bf16*)(ws + WS_V); bf16* GB = (bf16*)(ws + WS_G);
        for (int it = gw; it < NB * 48 * 3; it += NGW) { const int which = it / (NB * 48), r = it % (NB * 48), b = r / 48, rr = r % 48;
            bf16* p = which == 0 ? KB + (size_t)(b * SPAD + 16 + rr) * 512 : which == 1 ? VB + (size_t)(b * SPAD + 16 + rr) * 512 : GB + (size_t)(b * SPAD + rr) * 512;
            ((v4u*)p)[lane] = (v4u){0u, 0u, 0u, 0u}; }
    }
}

__device__ __forceinline__ void meta_proj(const Args& A, unsigned char* ws, LAS unsigned char* lds, int vcu, int wave, int lane) {
    typedef short bf16x8 __attribute__((ext_vector_type(8)));
    const int fr = lane & 15, fq = lane >> 4;
    const int item = vcu * 2 + (wave >> 2), kc = wave & 3;
    const int kind = item < 8 ? 0 : item < 16 ? 1 : 2, g = kind == 2 ? item - 16 : (item & 7);
    const bf16* XNm = (const bf16*)(ws + WS_XN) + (size_t)(MX + fr) * DM + 8 * fq + 256 * kc;
    const bf16* Wt = (const bf16*)(ws + WS_WIN);
    const bf16* brow[4];
#pragma unroll
    for (int nb = 0; nb < 4; ++nb) { const int lc = kind == 0 ? 512 + 64 * g + 16 * nb + fr : kind == 1 ? 1024 + 64 * g + 16 * nb + fr : (nb < 2 ? 1536 + 32 * g + 16 * nb + fr : 2048 + 32 * g + 16 * (nb - 2) + fr);
        brow[nb] = Wt + (size_t)(win_pcol(lc & ~31) + (lc & 31)) * DM + 8 * fq + 256 * kc; }
    bf16x8 af[8], bf[8][4];
#pragma unroll
    for (int ks = 0; ks < 8; ++ks) { af[ks] = *(const bf16x8*)(XNm + 32 * ks);
#pragma unroll
        for (int nb = 0; nb < 4; ++nb) bf[ks][nb] = *(const bf16x8*)(brow[nb] + 32 * ks); }
    asm volatile("" ::: "memory");
    f32x4 acc[4];
#pragma unroll
    for (int nb = 0; nb < 4; ++nb) acc[nb] = (f32x4){0.f, 0.f, 0.f, 0.f};
#pragma unroll
    for (int ks = 0; ks < 8; ++ks)
#pragma unroll
        for (int nb = 0; nb < 4; ++nb) acc[nb] = __builtin_amdgcn_mfma_f32_16x16x32_bf16(bf[ks][nb], af[ks], acc[nb], 0, 0, 0);
    LAS f32x4* red = (LAS f32x4*)lds;
#pragma unroll
    for (int nb = 0; nb < 4; ++nb) red[(wave * 4 + nb) * 64 + lane] = acc[nb];
    __syncthreads();
    if (kc == 0) {
#pragma unroll
        for (int nb = 0; nb < 4; ++nb) acc[nb] = (red[((wave + 0) * 4 + nb) * 64 + lane] + red[((wave + 1) * 4 + nb) * 64 + lane]) + (red[((wave + 2) * 4 + nb) * 64 + lane] + red[((wave + 3) * 4 + nb) * 64 + lane]);
        if (kind == 0) {
            float ss = 0.f;
#pragma unroll
            for (int nb = 0; nb < 4; ++nb) ss += (acc[nb][0] * acc[nb][0] + acc[nb][1] * acc[nb][1]) + (acc[nb][2] * acc[nb][2] + acc[nb][3] * acc[nb][3]);
            ss += __shfl_xor(ss, 16); ss += __shfl_xor(ss, 32);
            const float rs = __builtin_amdgcn_rsqf(ss * (1.0f / 64.0f) + EPS);
#pragma unroll
            for (int nb = 0; nb < 4; ++nb) acc[nb] = acc[nb] * rs * *(const f32x4*)(A.in[I_KG] + 16 * nb + 4 * fq);
            f32x4 p; p[0] = __shfl_xor(acc[0][0], 32); p[1] = __shfl_xor(acc[0][1], 32); p[2] = __shfl_xor(acc[0][2], 32); p[3] = __shfl_xor(acc[0][3], 32);
            const float* rp = (const float*)(ws + WS_ROPE) + fr * 16 + 4 * (fq & 1);
            const f32x4 c = *(const f32x4*)rp, s = *(const f32x4*)(rp + 8);
            const float sg = (fq & 2) ? 1.f : -1.f;
            acc[0] = acc[0] * c + (p * s) * sg;
        }
        if (kind == 2) {
#pragma unroll
            for (int nb = 0; nb < 2; ++nb)
#pragma unroll
                for (int e = 0; e < 4; ++e) acc[nb][e] = acc[nb][e] * __builtin_amdgcn_rcpf(1.0f + __builtin_amdgcn_exp2f(-1.4426950408889634f * acc[nb + 2][e]));
        }
        bf16* dst = kind == 0 ? (bf16*)(ws + WS_K) : kind == 1 ? (bf16*)(ws + WS_V) : (bf16*)(ws + WS_G);
        const int r0 = kind == 2 ? 48 + fr : fr, c0 = (kind == 2 ? 32 * g : 64 * g) + 4 * fq, nnb = kind == 2 ? 2 : 4;
#pragma unroll 1
        for (int b = 0; b < NB; ++b) { bf16* o = dst + (size_t)(b * SPAD + r0) * 512 + c0;
#pragma unroll
            for (int nb = 0; nb < 4; ++nb) if (nb < nnb) *(unsigned long long*)(o + 16 * nb) = (unsigned long long)pk2(acc[nb][0], acc[nb][1]) | ((unsigned long long)pk2(acc[nb][2], acc[nb][3]) << 32); }
    }
    __syncthreads();
}

constexpr int CONV_R = 32;
__device__ __forceinline__ void conv_phase(const Args& A, unsigned char* ws, LAS unsigned char* lds, int vcu, int G, int wave, int lane) {
    LAS float* cbuf = (LAS float*)lds;
    const bf16* GB = (const bf16*)(ws + WS_G); bf16* MIX = (bf16*)(ws + WS_MIX);
    const int cp = (wave & 3) * 64 + lane, half = wave >> 2;
    f32x2 w[CONVW];
#pragma unroll
    for (int j = 0; j < CONVW; ++j) w[j] = *(const f32x2*)(A.in[I_CW] + j * DCONV + 2 * cp);
    const f32x2 bias = *(const f32x2*)(A.in[I_CB] + 2 * cp);
    const f32x4 lg0 = *(const f32x4*)(A.in[I_CLG] + lane * 8), lg1 = *(const f32x4*)(A.in[I_CLG] + lane * 8 + 4), lb0 = *(const f32x4*)(A.in[I_CLB] + lane * 8), lb1 = *(const f32x4*)(A.in[I_CLB] + lane * 8 + 4);
    const int nit = (MX / (2 * CONV_R) - vcu + G - 1) / G;
#define CONV_SRC(k) (GB + (size_t)((((vcu + ((k) >> 1) * G) * 2 * CONV_R + half * CONV_R + ((k) & 1) * 16) >> 13) * SPAD + 34 + (((vcu + ((k) >> 1) * G) * 2 * CONV_R + half * CONV_R + ((k) & 1) * 16) & 8191)) * 512 + 2 * cp)
#define CONV_LOAD(buf, k) do { const bf16* gs_ = CONV_SRC(k); _Pragma("unroll") for (int i = 0; i < 46; ++i) buf[i] = *(const unsigned*)(gs_ + (size_t)i * 512); } while (0)
#define CONV_FMA(buf, k) do { f32x2 acc[16]; _Pragma("unroll") for (int o = 0; o < 16; ++o) acc[o] = bias; \
        _Pragma("unroll") for (int i = 0; i < 46; ++i) { const f32x2 x = {bf_lo(buf[i]), bf_hi(buf[i])}; _Pragma("unroll") for (int o = 0; o < 16; ++o) { const int j = i - o; if (j >= 0 && j < CONVW) acc[o] += w[j] * x; } } \
        _Pragma("unroll") for (int o = 0; o < 16; ++o) *(LAS f32x2*)(cbuf + (half * CONV_R + ((k) & 1) * 16 + o) * DCONV + 2 * cp) = acc[o]; } while (0)
    unsigned bufA[46], bufB[46];
    if (nit > 0) CONV_LOAD(bufA, 0);
#pragma unroll 1
    for (int n = 0; n < nit; ++n) {
        const int it = vcu + n * G;
        CONV_LOAD(bufB, 2 * n + 1);
        CONV_FMA(bufA, 2 * n);
        if (n + 1 < nit) CONV_LOAD(bufA, 2 * n + 2);
        CONV_FMA(bufB, 2 * n + 1);
        __syncthreads();
#pragma unroll
        for (int rr = 0; rr < 8; ++rr) { const int lr = wave * 8 + rr;
            f32x4 x0 = *(const LAS f32x4*)(cbuf + lr * DCONV + lane * 8), x1 = *(const LAS f32x4*)(cbuf + lr * DCONV + lane * 8 + 4);
            const float mu = wave_sum_fast((x0[0] + x0[1]) + (x0[2] + x0[3]) + (x1[0] + x1[1]) + (x1[2] + x1[3])) * (1.f / DCONV);
            x0 = x0 - mu; x1 = x1 - mu;
            const float var = wave_sum_fast((x0[0] * x0[0] + x0[1] * x0[1]) + (x0[2] * x0[2] + x0[3] * x0[3]) + (x1[0] * x1[0] + x1[1] * x1[1]) + (x1[2] * x1[2] + x1[3] * x1[3])) * (1.f / DCONV);
            const float rs = __builtin_amdgcn_rsqf(var + EPS);
            x0 = x0 * rs * lg0 + lb0; x1 = x1 * rs * lg1 + lb1;
#pragma unroll
            for (int e = 0; e < 4; ++e) { x0[e] = x0[e] * __builtin_amdgcn_rcpf(1.0f + __builtin_amdgcn_exp2f(-1.4426950408889634f * x0[e])); x1[e] = x1[e] * __builtin_amdgcn_rcpf(1.0f + __builtin_amdgcn_exp2f(-1.4426950408889634f * x1[e])); }
            *(v4u*)(MIX + (size_t)(it * 2 * CONV_R + lr) * DM + 512 + lane * 8) = pg8::pack8(x0, x1); }
        __syncthreads();
    }
#undef CONV_SRC
#undef CONV_LOAD
#undef CONV_FMA
}

__device__ __forceinline__ void combine_phase(const Args& A, unsigned char* ws, int vcu, int G, int wave, int lane) {
    const bf16* OB = (const bf16*)(ws + WS_O); bf16* MIX = (bf16*)(ws + WS_MIX);
    const float d1 = wave_sum(A.in[I_LQ1][lane] * A.in[I_LK1][lane]), d2 = wave_sum(A.in[I_LQ2][lane] * A.in[I_LK2][lane]);
    const float lam_init = 0.2f;
    const float lam = __builtin_amdgcn_exp2f(d1 * 1.4426950408889634f) - __builtin_amdgcn_exp2f(d2 * 1.4426950408889634f) + lam_init;
    const int h = lane >> 4, q = lane & 15;
    const f32x4 sg0 = *(const f32x4*)(A.in[I_SUBLN] + 8 * q), sg1 = *(const f32x4*)(A.in[I_SUBLN] + 8 * q + 4);
    const int gw = vcu * NWAVES + wave, NGW = G * NWAVES;
    for (int row = gw; row < MX; row += NGW) {
        const bf16* o1 = OB + (size_t)row * 1024 + h * 256 + 8 * q;
        const v4u a = *(const v4u*)o1, bq = *(const v4u*)(o1 + 128);
        f32x4 d0, d1v;
        d0[0] = bf_lo(a.x) - lam * bf_lo(bq.x); d0[1] = bf_hi(a.x) - lam * bf_hi(bq.x); d0[2] = bf_lo(a.y) - lam * bf_lo(bq.y); d0[3] = bf_hi(a.y) - lam * bf_hi(bq.y);
        d1v[0] = bf_lo(a.z) - lam * bf_lo(bq.z); d1v[1] = bf_hi(a.z) - lam * bf_hi(bq.z); d1v[2] = bf_lo(a.w) - lam * bf_lo(bq.w); d1v[3] = bf_hi(a.w) - lam * bf_hi(bq.w);
        float ss = (d0[0] * d0[0] + d0[1] * d0[1]) + (d0[2] * d0[2] + d0[3] * d0[3]) + (d1v[0] * d1v[0] + d1v[1] * d1v[1]) + (d1v[2] * d1v[2] + d1v[3] * d1v[3]);
        ss += __shfl_xor(ss, 1); ss += __shfl_xor(ss, 2); ss += __shfl_xor(ss, 4); ss += __shfl_xor(ss, 8);
        const float rs = __builtin_amdgcn_rsqf(ss * (1.f / 128.f) + EPS) * (1.0f - lam_init);
        *(v4u*)(MIX + (size_t)row * DM + h * 128 + 8 * q) = pg8::pack8(d0 * rs * sg0, d1v * rs * sg1);
    }
}

__global__ void __launch_bounds__(NWAVES * 64, 2) hymba_fwd(Args args) {
    extern __shared__ __attribute__((aligned(16))) unsigned char lds[];
    cg::grid_group grid = cg::this_grid();
    LAS unsigned char* ldsl = (LAS unsigned char*)lds;
    volatile LAS unsigned* MISC = (volatile LAS unsigned*)(ldsl + LDS_BYTES - 256);
    if (threadIdx.x < 32) MISC[threadIdx.x] = 0u;
    __syncthreads();
    const XcdBarrier bar = xcd_barrier_post((unsigned*)(args.ws + WS_CTL) + 4096, MISC + 8);
    const int G = gridDim.x; const int bx = blockIdx.x; const int vcu = (G % 8 == 0) ? (bx % 8) * (G / 8) + bx / 8 : bx;
#ifndef PROBE_DUP
#define PROBE_DUP 0
#endif
#define REP(mask) for (int rep_ = 0; rep_ < (((PROBE_DUP) & (mask)) ? 2 : 1); ++rep_)
#define PHASE_VARS() unsigned char* ws = args.ws; int tid_ = threadIdx.x; asm volatile("" : "+v"(tid_)); const int lane = tid_ & 63, wave = __builtin_amdgcn_readfirstlane(tid_ >> 6); (void)lane; (void)wave

    REP(1) { PHASE_VARS(); p0_prologue(args, ws, ldsl, vcu, G, wave, lane); }
    if (args.ws == nullptr) grid.sync();
    xcd_barrier(bar);

    REP(2) {
        PHASE_VARS();
        if (vcu < 16 && G >= 16) meta_proj(args, ws, ldsl, vcu, wave, lane);
        pg8::Gemm g{(bf16*)(ws + WS_XN), (bf16*)(ws + WS_WIN), MX, DIN, DM}; pg8::StaticOrder S; S.init(MX, DIN, G, bx);
        pg8::EpiInProj E{(bf16*)(ws + WS_Q), (bf16*)(ws + WS_K), (bf16*)(ws + WS_V), (bf16*)(ws + WS_G), args.in[I_QG], args.in[I_KG], (const float*)(ws + WS_ROPE)};
        pg8::gemm_phase<pg8::EpiInProj, pg8::StaticOrder, PG8_ALIGN, PG8_SP2>(ldsl, g, S, E);
    }
    xcd_barrier(bar);

    REP(4) { PHASE_VARS(); conv_phase(args, ws, ldsl, vcu, G, wave, lane); }
    REP(8) {
        PHASE_VARS();
        static_assert(attn_body::V2_LDS_BYTES <= LDS_BYTES - 256, "attention LDS");
        const float dq1 = wave_sum(args.in[I_LQ1][lane] * args.in[I_LK1][lane]), dq2 = wave_sum(args.in[I_LQ2][lane] * args.in[I_LK2][lane]);
        const float lam_init = 0.2f;
        const float lam = __builtin_amdgcn_exp2f(dq1 * 1.4426950408889634f) - __builtin_amdgcn_exp2f(dq2 * 1.4426950408889634f) + lam_init;
        for (int vv = vcu; vv < 256; vv += G) {
            const int bh = vv >> 4, s = vv & 15;
            const int b = bh >> 2, head = bh & 3;
            const attn_body::bf16* Kh = (const attn_body::bf16*)(ws + WS_K) + (size_t)(b * SPAD) * 512 + head * 128;
            const attn_body::bf16* Vh = (const attn_body::bf16*)(ws + WS_V) + (size_t)(b * SPAD) * 512 + head * 128;
            for (int i = 0; i < 2; ++i) {
                const int qb = i ? 31 - s : s;
                const int q0 = qb * 256;
                const attn_body::bf16* Qu = (const attn_body::bf16*)(ws + WS_Q) + (size_t)(b * SEQ + q0) * 512 + head * 128;
                attn_body::bf16* Mu = (attn_body::bf16*)(ws + WS_MIX) + (size_t)(b * SEQ + q0) * 1024 + head * 128;
                attn_body::attn_unit128<0>(q0, Qu, Kh, Vh, Mu, (char*)lds, lam, 1.0f - lam_init, args.in[I_SUBLN]);
                attn_body::attn_unit128<1>(q0, Qu + 64, Kh + 64, Vh, Mu, (char*)lds, lam, 1.0f - lam_init, args.in[I_SUBLN]);
            }
        }
    }
    xcd_barrier(bar);

    REP(32) {
        PHASE_VARS();
        pg8::Gemm g{(bf16*)(ws + WS_MIX), (bf16*)(ws + WS_WOUT), MX, DM, DM}; pg8::StaticOrder S; S.init(MX, DM, G, bx);
        pg8::EpiOut E{(const bf16*)(ws + WS_XN), (const float*)(ws + WS_RN), args.in[I_G1], (bf16*)(ws + WS_H1B), (float*)(ws + WS_SSQ)};
        pg8::gemm_phase<pg8::EpiOut, pg8::StaticOrder, PG8_ALIGN, PG8_SP2>(ldsl, g, S, E);
    }
    xcd_barrier(bar);

    REP(64) {
        PHASE_VARS();
        pg8::Gemm g{(bf16*)(ws + WS_H1B), (bf16*)(ws + WS_WUP), MX, DFF, DM}; pg8::StaticOrder S; S.init(MX, DFF, G, bx);
        pg8::EpiUp E{(bf16*)(ws + WS_HB), (const float*)(ws + WS_SSQ)};
        pg8::gemm_phase<pg8::EpiUp, pg8::StaticOrder, PG8_ALIGN, PG8_SP2>(ldsl, g, S, E);
    }
    xcd_barrier(bar);

    {
        PHASE_VARS();
        pg8::Gemm g{(bf16*)(ws + WS_HB), (bf16*)(ws + WS_WDN), MX, DM, DFF}; pg8::StaticOrder S; S.init(MX, DM, G, bx);
        pg8::EpiDown E{(const bf16*)(ws + WS_H1B), args.out};
        pg8::gemm_phase<pg8::EpiDown, pg8::StaticOrder, PG8_ALIGN, PG8_SP2>(ldsl, g, S, E);
    }
#undef PHASE_VARS
#undef REP
}

extern "C" void kernel_launch(void* const* d_in, const int* in_sizes, int n_in, void* d_out, int out_size, void* d_ws, size_t ws_size, hipStream_t stream) {
    static int grid = 0;
    if (grid == 0) {
        if (n_in != 19 || in_sizes[0] != MX * DM || out_size != MX * DM || ws_size < WS_END) { fprintf(stderr, "kernel_launch: unexpected shapes: n_in %d, in0 %d, out %d, ws %zu (need %zu); nothing launched\n", n_in, n_in > 0 ? in_sizes[0] : -1, out_size, ws_size, (size_t)WS_END); grid = -1; return; }
        int dev = 0, cus = 0, per_cu = 0;
        if (hipGetDevice(&dev) != hipSuccess || hipDeviceGetAttribute(&cus, hipDeviceAttributeMultiprocessorCount, dev) != hipSuccess) { fprintf(stderr, "kernel_launch: device query failed\n"); grid = -1; return; }
        if (hipFuncSetAttribute((const void*)hymba_fwd, hipFuncAttributeMaxDynamicSharedMemorySize, LDS_BYTES) != hipSuccess) { fprintf(stderr, "kernel_launch: hipFuncSetAttribute failed\n"); grid = -1; return; }
        if (hipOccupancyMaxActiveBlocksPerMultiprocessor(&per_cu, (const void*)hymba_fwd, NWAVES * 64, LDS_BYTES) != hipSuccess || per_cu < 1) { fprintf(stderr, "kernel_launch: occupancy query says %d\n", per_cu); per_cu = 1; }
        (void)hipGetLastError();
        grid = cus * 1;
        fprintf(stderr, "kernel_launch: grid %d (occupancy query %d per CU)\n", grid, per_cu);
    }
    if (grid < 0) return;
    Args a{};
    for (int i = 0; i < 19; ++i) a.in[i] = (const float*)d_in[i];
    a.out = (float*)d_out; a.ws = (unsigned char*)d_ws;
    for (int i = 0; i < 8; ++i) a.inv_freq[i] = (float)pow(500000.0, -(double)i / 8.0);
    if (hipMemsetAsync((char*)d_ws + WS_CTL, 0, 65536, stream) != hipSuccess) { fprintf(stderr, "kernel_launch: hipMemsetAsync failed\n"); return; }
    void* kargs[] = {&a};
    const hipError_t le = hipLaunchCooperativeKernel((const void*)hymba_fwd, dim3(grid), dim3(NWAVES * 64), kargs, LDS_BYTES, stream);
    if (le != hipSuccess) fprintf(stderr, "kernel_launch: cooperative launch failed: %s (grid %d)\n", hipGetErrorName(le), grid);
}
```

```cpp
#include <hip/hip_cooperative_groups.h>
#include <cmath>
#include <hip/hip_runtime.h>
#include <cstdio>
#include <cstdint>
namespace pg8 {
#define PG8_LAS __attribute__((address_space(3)))
typedef unsigned short bf16_t;
typedef short bf16x8 __attribute__((ext_vector_type(8)));
typedef float f32x4 __attribute__((ext_vector_type(4)));
typedef unsigned u32x4 __attribute__((ext_vector_type(4)));
constexpr int BM = 256, BK = 64, HALF = 128, HTB = HALF * BK * 2  , STAGE_BYTES = 8 * HTB, NXCD = 8, WGM = 8;

__host__ __device__ __forceinline__ int lds_byte(int r, int c) { const int st = (r >> 4) * 2 + (c >> 5), rr = r & 15, cc = c & 31, ob = rr * 64 + cc * 2; return st * 1024 + (ob ^ (((ob >> 9) & 1) << 5)); }
__host__ __device__ __forceinline__ void stage_rc(int b, int& R, int& C) { const int st = b / 1024, sb = b % 1024, swz = sb ^ (((sb >> 9) & 1) << 5); R = (st >> 1) * 16 + swz / 64; C = (st & 1) * 32 + (swz % 64) / 2; }
__host__ __device__ __forceinline__ int perm32(int rho) { const int n = rho >> 4, i = rho & 15; return 8 * (i >> 2) + 4 * n + (i & 3); }

struct Unit { int pm, pn; };
struct Gemm { const bf16_t* A; const bf16_t* Bt; int M, N, K; };

struct StaticOrder {
    int nM, nN, nwg, G, c;
    __host__ __device__ void init(int M, int N, int G_, int c_) { nM = M / BM; nN = N / BM; nwg = nM * nN; G = G_; c = c_; }
    __host__ __device__ bool next(int i, Unit& u) const {
        const long L = (long)i * G + c; if (L >= nwg) return false;
        int wgid = (int)L; { const int q = nwg / NXCD, r = nwg % NXCD, xcd = wgid % NXCD, off = wgid / NXCD; wgid = (xcd < r ? xcd * (q + 1) : r * (q + 1) + (xcd - r) * q) + off; }
        const int nig = WGM * nN, gid = wgid / nig, fm = gid * WGM, gsz = (nM - fm) < WGM ? (nM - fm) : WGM;
        u.pm = fm + ((wgid % nig) % gsz); u.pn = (wgid % nig) / gsz; return true;
    }
    __device__ __forceinline__ void a_ready(const Unit&) const {}
    __device__ __forceinline__ void done(const Unit&) const {}
};

__device__ __forceinline__ unsigned cvt_pk_bf16(float lo, float hi) { unsigned r; asm volatile("v_cvt_pk_bf16_f32 %0, %1, %2" : "=v"(r) : "v"(lo), "v"(hi)); return r; }
typedef float f32x2 __attribute__((ext_vector_type(2)));
__device__ __forceinline__ f32x2 gelu_pk(f32x2 v) {
    const f32x2 av = __builtin_elementwise_abs(v), d = av * 0.2316418882f + 1.0f;
    f32x2 t; t.x = __builtin_amdgcn_rcpf(d.x); t.y = __builtin_amdgcn_rcpf(d.y);
    f32x2 q = t * 0.5307027145f + (-0.7265760135f); q = q * t + 0.7107068705f; q = q * t + (-0.142248368f); q = q * t + 0.127414796f; q = q * t;
    const f32x2 s = (v * v) * (-0.72134752044f);
    f32x2 e; e.x = __builtin_amdgcn_exp2f(s.x); e.y = __builtin_amdgcn_exp2f(s.y);
    const f32x2 m = v * (q * e), r = v - m;
    f32x2 o; o.x = v.x < 0.f ? m.x : r.x; o.y = v.y < 0.f ? m.y : r.y; return o;
}

template <int ACT  > struct EpiBf16 {
    static constexpr bool PERM = true, AFTER_DRAIN = false; static_assert(ACT == 0 || ACT == 1, "EpiBf16: ACT is 0 (none) or 1 (gelu_pk)");
    bf16_t* O; int ldc; const float* bias; int split_cols; size_t split_stride; float scale0;
    __device__ __forceinline__ void operator()(const f32x4 (&acc)[2][2][4][2], const Unit& u, int wr, int wc, int fr, int fq) const {
        const int row0 = u.pm * BM + wr * 64 + fr; int colt = u.pn * BM; bf16_t* base = O;
        float sc = 1.f; if (split_cols) { const int t = colt / split_cols; base += (size_t)t * split_stride; colt -= t * split_cols; if (t == 0) sc = scale0; }
        const int col0 = colt + wc * 32 + 8 * fq, bcol0 = u.pn * BM + wc * 32 + 8 * fq;
        f32x4 bv[2][2];
#pragma unroll
        for (int bj = 0; bj < 2; ++bj)
#pragma unroll
            for (int n = 0; n < 2; ++n) bv[bj][n] = bias ? *(const f32x4*)(bias + bcol0 + bj * HALF + 4 * n) : (f32x4){0.f, 0.f, 0.f, 0.f};
#pragma unroll
        for (int ai = 0; ai < 2; ++ai)
#pragma unroll
            for (int m = 0; m < 4; ++m) { bf16_t* rowp = base + (size_t)(row0 + ai * HALF + m * 16) * ldc + col0;
#pragma unroll
                for (int bj = 0; bj < 2; ++bj) { f32x4 v0 = acc[ai][bj][m][0] + bv[bj][0], v1 = acc[ai][bj][m][1] + bv[bj][1];
                    if (ACT == 1) { f32x2 a = gelu_pk((f32x2){v0[0], v0[1]}), b = gelu_pk((f32x2){v0[2], v0[3]}), c = gelu_pk((f32x2){v1[0], v1[1]}), d = gelu_pk((f32x2){v1[2], v1[3]});
                        v0 = (f32x4){a.x, a.y, b.x, b.y}; v1 = (f32x4){c.x, c.y, d.x, d.y}; }
                    v0 = v0 * sc; v1 = v1 * sc; u32x4 w; w.x = cvt_pk_bf16(v0[0], v0[1]); w.y = cvt_pk_bf16(v0[2], v0[3]); w.z = cvt_pk_bf16(v1[0], v1[1]); w.w = cvt_pk_bf16(v1[2], v1[3]);
                    *(u32x4*)(rowp + bj * HALF) = w; } }
    }
};

constexpr int XROWS = 32768, SPAD = 8256;
constexpr float QSCALE = 0.125f * 1.4426950408889634f;
__device__ __forceinline__ f32x4 shfl_xor4(f32x4 v, int m) { f32x4 r; r[0] = __shfl_xor(v[0], m); r[1] = __shfl_xor(v[1], m); r[2] = __shfl_xor(v[2], m); r[3] = __shfl_xor(v[3], m); return r; }
__device__ __forceinline__ u32x4 pack8(f32x4 a, f32x4 b) { u32x4 w; w.x = cvt_pk_bf16(a[0], a[1]); w.y = cvt_pk_bf16(a[2], a[3]); w.z = cvt_pk_bf16(b[0], b[1]); w.w = cvt_pk_bf16(b[2], b[3]); return w; }
struct EpiInProj {
    static constexpr bool PERM = true, AFTER_DRAIN = false;
    bf16_t *Q, *K, *V, *G; const float *qg, *kg, *rope;
    __device__ __forceinline__ void operator()(const f32x4 (&acc)[2][2][4][2], const Unit& u, int wr, int wc, int fr, int fq) const {
        const int pn = u.pn; constexpr bool meta = false;
        if (meta && (wr != 0 || pn < 2)) return;
        const int rbase = u.pm * BM + wr * 64 + fr;
        if (pn < 4) {
            const bool isq = pn < 2; const float* gp = isq ? qg : kg; const float osc = isq ? QSCALE : 1.f;
            f32x4 gv[2][2];
#pragma unroll
            for (int bj = 0; bj < 2; ++bj)
#pragma unroll
                for (int n = 0; n < 2; ++n) gv[bj][n] = *(const f32x4*)(gp + 32 * bj + 8 * fq + 4 * n);
            const int colb = (pn & 1) * 256 + wc * 64 + 8 * fq;
            bf16_t* dst = isq ? Q : K;
#pragma unroll
            for (int ai = 0; ai < 2; ++ai) {
                if (meta && ai) continue;
#pragma unroll
              for (int mh = 0; mh < 2; ++mh) {
                if (meta && mh) continue;
                f32x4 rv[2][4];
                if (fq < 2) {
#pragma unroll
                    for (int m2 = 0; m2 < 2; ++m2) { const int row = rbase + ai * HALF + (2 * mh + m2) * 16; const int pos = meta ? (row - XROWS) : ((row & 8191) + 16); const f32x4* rp = (const f32x4*)(rope + (size_t)pos * 16);
#pragma unroll
                        for (int k = 0; k < 4; ++k) rv[m2][k] = rp[k]; }
                }
                asm volatile("" ::: "memory");
#pragma unroll
                for (int m = 2 * mh; m < 2 * mh + 2; ++m) {
                    if (meta && m) continue;
                    const int row = rbase + ai * HALF + m * 16;
                    float ss = 0.f;
#pragma unroll
                    for (int bj = 0; bj < 2; ++bj)
#pragma unroll
                        for (int n = 0; n < 2; ++n) { const f32x4 x = acc[ai][bj][m][n]; ss += (x[0] * x[0] + x[1] * x[1]) + (x[2] * x[2] + x[3] * x[3]); }
                    ss += __shfl_xor(ss, 16); ss += __shfl_xor(ss, 32);
                    const float rs = __builtin_amdgcn_rsqf(ss * (1.0f / 64.0f) + 1e-6f);
                    f32x4 y00 = acc[ai][0][m][0] * rs * gv[0][0], y01 = acc[ai][0][m][1] * rs * gv[0][1], y10 = acc[ai][1][m][0] * rs * gv[1][0], y11 = acc[ai][1][m][1] * rs * gv[1][1];
                    const f32x4 p0 = shfl_xor4(y00, 16), p1 = shfl_xor4(y01, 16);
                    if (fq < 2) {
                        const f32x4 c0 = rv[m & 1][0], c1 = rv[m & 1][1], s0 = rv[m & 1][2], s1 = rv[m & 1][3];
                        const float sg = fq ? 1.f : -1.f;
                        y00 = y00 * c0 + (p0 * s0) * sg; y01 = y01 * c1 + (p1 * s1) * sg;
                    }
                    const u32x4 w0 = pack8(y00 * osc, y01 * osc), w1 = pack8(y10 * osc, y11 * osc);
                    if (!meta) {
                        const size_t orow = isq ? (size_t)row : (size_t)((row >> 13) * SPAD + 64 + (row & 8191));
                        *(u32x4*)(dst + orow * 512 + colb) = w0; *(u32x4*)(dst + orow * 512 + colb + 32) = w1;
                    } else {
#pragma unroll 1
                        for (int b = 0; b < 4; ++b) { const size_t orow = (size_t)(b * SPAD + fr); *(u32x4*)(dst + orow * 512 + colb) = w0; *(u32x4*)(dst + orow * 512 + colb + 32) = w1; }
                    }
                }
              }
            }
        } else if (pn < 6) {
            const int colb = (pn - 4) * 256 + wc * 32 + 8 * fq;
#pragma unroll
            for (int ai = 0; ai < 2; ++ai)
#pragma unroll
                for (int m = 0; m < 4; ++m) {
                    if (meta && (ai || m)) continue;
                    const int row = rbase + ai * HALF + m * 16;
                    const u32x4 w0 = pack8(acc[ai][0][m][0], acc[ai][0][m][1]), w1 = pack8(acc[ai][1][m][0], acc[ai][1][m][1]);
                    if (!meta) {
                        const size_t orow = (size_t)((row >> 13) * SPAD + 64 + (row & 8191));
                        *(u32x4*)(V + orow * 512 + colb) = w0; *(u32x4*)(V + orow * 512 + colb + HALF) = w1;
                    } else {
#pragma unroll 1
                        for (int b = 0; b < 4; ++b) { const size_t orow = (size_t)(b * SPAD + fr); *(u32x4*)(V + orow * 512 + colb) = w0; *(u32x4*)(V + orow * 512 + colb + HALF) = w1; }
                    }
                }
        } else {
            const int colb = (pn - 6) * 128 + wc * 32 + 8 * fq;
#pragma unroll
            for (int ai = 0; ai < 2; ++ai)
#pragma unroll
                for (int m = 0; m < 4; ++m) {
                    if (meta && (ai || m)) continue;
                    const int row = rbase + ai * HALF + m * 16;
                    f32x4 h[2];
#pragma unroll
                    for (int n = 0; n < 2; ++n) { const f32x4 a = acc[ai][0][m][n], g = acc[ai][1][m][n];
#pragma unroll
                        for (int e = 0; e < 4; ++e) h[n][e] = a[e] * __builtin_amdgcn_rcpf(1.0f + __builtin_amdgcn_exp2f(-1.4426950408889634f * g[e])); }
                    const u32x4 w0 = pack8(h[0], h[1]);
                    if (!meta) {
                        const size_t orow = (size_t)((row >> 13) * SPAD + 64 + (row & 8191));
                        *(u32x4*)(G + orow * 512 + colb) = w0;
                    } else {
#pragma unroll 1
                        for (int b = 0; b < 4; ++b) { const size_t orow = (size_t)(b * SPAD + 48 + fr); *(u32x4*)(G + orow * 512 + colb) = w0; }
                    }
                }
        }
    }
};
struct EpiOut {
    static constexpr bool PERM = true, AFTER_DRAIN = false;
    const bf16_t* xn; const float* rn; const float* g1; bf16_t* hb; float* ssq;
    __device__ __forceinline__ void operator()(const f32x4 (&acc)[2][2][4][2], const Unit& u, int wr, int wc, int fr, int fq) const {
        const int rbase = u.pm * BM + wr * 64 + fr, colb = u.pn * BM + wc * 32 + 8 * fq;
        f32x4 ig[2][2];
#pragma unroll
        for (int bj = 0; bj < 2; ++bj)
#pragma unroll
            for (int n = 0; n < 2; ++n) { const f32x4 g = *(const f32x4*)(g1 + colb + bj * HALF + 4 * n);
#pragma unroll
                for (int e = 0; e < 4; ++e) ig[bj][n][e] = __builtin_amdgcn_rcpf(g[e]); }
#pragma unroll
        for (int ai = 0; ai < 2; ++ai) {
            u32x4 xv[4][2]; float rv[4];
#pragma unroll
            for (int m = 0; m < 4; ++m) { const int row = rbase + ai * HALF + m * 16; rv[m] = rn[row];
#pragma unroll
                for (int bj = 0; bj < 2; ++bj) xv[m][bj] = *(const u32x4*)(xn + (size_t)row * 1024 + colb + bj * HALF); }
            asm volatile("" ::: "memory");
#pragma unroll
            for (int m = 0; m < 4; ++m) {
                const int row = rbase + ai * HALF + m * 16; float ss = 0.f;
#pragma unroll
                for (int bj = 0; bj < 2; ++bj) { const size_t off = (size_t)row * 1024 + colb + bj * HALF; const u32x4 w = xv[m][bj];
                    f32x4 x0, x1;
                    x0[0] = __uint_as_float(w.x << 16); x0[1] = __uint_as_float(w.x & 0xffff0000u); x0[2] = __uint_as_float(w.y << 16); x0[3] = __uint_as_float(w.y & 0xffff0000u);
                    x1[0] = __uint_as_float(w.z << 16); x1[1] = __uint_as_float(w.z & 0xffff0000u); x1[2] = __uint_as_float(w.w << 16); x1[3] = __uint_as_float(w.w & 0xffff0000u);
                    const f32x4 h0 = x0 * rv[m] * ig[bj][0] + acc[ai][bj][m][0], h1 = x1 * rv[m] * ig[bj][1] + acc[ai][bj][m][1];
                    *(u32x4*)(hb + off) = pack8(h0, h1);
                    ss += (h0[0] * h0[0] + h0[1] * h0[1]) + (h0[2] * h0[2] + h0[3] * h0[3]) + (h1[0] * h1[0] + h1[1] * h1[1]) + (h1[2] * h1[2] + h1[3] * h1[3]); }
                ss += __shfl_xor(ss, 16); ss += __shfl_xor(ss, 32);
                if (fq == 0) ssq[(size_t)row * 16 + u.pn * 4 + wc] = ss;
            }
        }
    }
};
struct EpiUp {
    static constexpr bool PERM = true, AFTER_DRAIN = false;
    bf16_t* hb; const float* ssq;
    __device__ __forceinline__ void operator()(const f32x4 (&acc)[2][2][4][2], const Unit& u, int wr, int wc, int fr, int fq) const {
        const int rbase = u.pm * BM + wr * 64 + fr, colb = u.pn * BM + wc * 32 + 8 * fq;
#pragma unroll
        for (int ai = 0; ai < 2; ++ai) {
            f32x4 sv[4][4];
#pragma unroll
            for (int m = 0; m < 4; ++m) { const f32x4* sp = (const f32x4*)(ssq + (size_t)(rbase + ai * HALF + m * 16) * 16);
#pragma unroll
                for (int k = 0; k < 4; ++k) sv[m][k] = sp[k]; }
            asm volatile("" ::: "memory");
#pragma unroll
            for (int m = 0; m < 4; ++m) {
                const int row = rbase + ai * HALF + m * 16;
                const f32x4 s0 = sv[m][0], s1 = sv[m][1], s2 = sv[m][2], s3 = sv[m][3];
                const float tot = ((s0[0] + s0[1]) + (s0[2] + s0[3])) + ((s1[0] + s1[1]) + (s1[2] + s1[3])) + ((s2[0] + s2[1]) + (s2[2] + s2[3])) + ((s3[0] + s3[1]) + (s3[2] + s3[3]));
                const float rs = __builtin_amdgcn_rsqf(tot * (1.0f / 1024.0f) + 1e-6f);
#pragma unroll
                for (int bj = 0; bj < 2; ++bj) { f32x4 a0 = acc[ai][bj][m][0] * rs, a1 = acc[ai][bj][m][1] * rs;
#pragma unroll
                    for (int e = 0; e < 4; ++e) { const float p = fmaxf(a0[e], 0.f), q = fmaxf(a1[e], 0.f); a0[e] = p * p; a1[e] = q * q; }
                    *(u32x4*)(hb + (size_t)row * 4096 + colb + bj * HALF) = pack8(a0, a1); }
            }
        }
    }
};
struct EpiDown {
    static constexpr bool PERM = true, AFTER_DRAIN = false;
    const bf16_t* h1; float* out;
    __device__ __forceinline__ void operator()(const f32x4 (&acc)[2][2][4][2], const Unit& u, int wr, int wc, int fr, int fq) const {
        const int rbase = u.pm * BM + wr * 64 + fr, colb = u.pn * BM + wc * 32 + 8 * fq;
        u32x4 hv[2][4][2];
#pragma unroll
        for (int ai = 0; ai < 2; ++ai)
#pragma unroll
            for (int m = 0; m < 4; ++m)
#pragma unroll
                for (int bj = 0; bj < 2; ++bj) hv[ai][m][bj] = *(const u32x4*)(h1 + (size_t)(rbase + ai * HALF + m * 16) * 1024 + colb + bj * HALF);
        asm volatile("" ::: "memory");
#pragma unroll
        for (int ai = 0; ai < 2; ++ai)
#pragma unroll
            for (int m = 0; m < 4; ++m) {
                const int row = rbase + ai * HALF + m * 16;
#pragma unroll
                for (int bj = 0; bj < 2; ++bj) { const size_t off = (size_t)row * 1024 + colb + bj * HALF; const u32x4 w = hv[ai][m][bj];
                    f32x4 r0, r1;
                    r0[0] = __uint_as_float(w.x << 16); r0[1] = __uint_as_float(w.x & 0xffff0000u); r0[2] = __uint_as_float(w.y << 16); r0[3] = __uint_as_float(w.y & 0xffff0000u);
                    r1[0] = __uint_as_float(w.z << 16); r1[1] = __uint_as_float(w.z & 0xffff0000u); r1[2] = __uint_as_float(w.w << 16); r1[3] = __uint_as_float(w.w & 0xffff0000u);
                    *(f32x4*)(out + off) = r0 + acc[ai][bj][m][0]; *(f32x4*)(out + off + 4) = r1 + acc[ai][bj][m][1]; }
            }
    }
};


template <class Epi, class Sched, bool ALIGN_EPI = false, bool SP2 = false>
__device__ __forceinline__ void gemm_phase(PG8_LAS unsigned char* lds, const Gemm g, const Sched& S, const Epi& E) {
    int tid_ = threadIdx.x; asm volatile("" : "+v"(tid_));
    const int tid = tid_, wid = __builtin_amdgcn_readfirstlane(tid >> 6), lane = tid & 63, wr = wid >> 2, wc = wid & 3, fr = lane & 15, fq = lane >> 4;
    const int K = g.K, nt = K / BK;
    unsigned voffA[2], voffB[2];
#pragma unroll
    for (int i = 0; i < 2; ++i) { int R, C; stage_rc(tid * 16 + i * 8192, R, C); const int Rb = Epi::PERM ? ((R & ~31) + perm32(R & 31)) : R;
        voffA[i] = (unsigned)(R * K + C) * 2u; voffB[i] = (unsigned)(Rb * K + C) * 2u; }
    const size_t kstep = (size_t)(BK * 2);
    const size_t hstep = (size_t)HALF * K * 2;
    const size_t tstep = 2 * hstep;
    const unsigned ldsw = (unsigned)wid * 1024u;
    const int aoff = lds_byte(wr * 64 + fr, fq * 8), boff = lds_byte(wc * 32 + fr, fq * 8);
#define PG8_SA(b, h) (((b) * 2 + (h)) * HTB)
#define PG8_SB(b, h) ((4 + (b) * 2 + (h)) * HTB)
#define PG8_STAGE(bufoff, gbase, voff) do { _Pragma("unroll") for (int _i = 0; _i < 2; ++_i) \
        __builtin_amdgcn_global_load_lds((const unsigned*)((const char*)(gbase) + (voff)[_i]), (PG8_LAS unsigned*)(lds + (bufoff) + ldsw + _i * 8192), 16, 0, 0); } while (0)
#define PG8_LDA(dst, b, h) do { _Pragma("unroll") for (int m = 0; m < 4; ++m) _Pragma("unroll") for (int k = 0; k < 2; ++k) dst[m][k] = *(const PG8_LAS bf16x8*)(lds + PG8_SA(b, h) + aoff + m * 2048 + k * 1024); } while (0)
#define PG8_LDB(dst, b, h) do { _Pragma("unroll") for (int n = 0; n < 2; ++n) _Pragma("unroll") for (int k = 0; k < 2; ++k) dst[n][k] = *(const PG8_LAS bf16x8*)(lds + PG8_SB(b, h) + boff + n * 2048 + k * 1024); } while (0)
#define PG8_MMA(ai, bj, At, Bt) do { __builtin_amdgcn_s_setprio(1); _Pragma("unroll") for (int m = 0; m < 4; ++m) _Pragma("unroll") for (int n = 0; n < 2; ++n) _Pragma("unroll") for (int k = 0; k < 2; ++k) \
        acc[ai][bj][m][n] = __builtin_amdgcn_mfma_f32_16x16x32_bf16(Bt[n][k], At[m][k], acc[ai][bj][m][n], 0, 0, 0); __builtin_amdgcn_s_setprio(0); } while (0)
#define PG8_WAIT_V(n) asm volatile("s_waitcnt vmcnt(" #n ")" ::: "memory")
#define PG8_WAIT_L(n) asm volatile("s_waitcnt lgkmcnt(" #n ")" ::: "memory")
#define PG8_BAR __builtin_amdgcn_s_barrier()
#define PG8_SCHED __builtin_amdgcn_sched_barrier(0)
    Unit cur, nxt; int ui = 0;
    if (!S.next(0, cur)) return;
    f32x4 acc[2][2][4][2];
#pragma unroll
    for (int a = 0; a < 2; ++a)
#pragma unroll
        for (int b = 0; b < 2; ++b)
#pragma unroll
            for (int m = 0; m < 4; ++m)
#pragma unroll
                for (int n = 0; n < 2; ++n) acc[a][b][m][n] = (f32x4){0.f, 0.f, 0.f, 0.f};
    bf16x8 At[4][2], B0[2][2], B1[2][2];
    const char* cA = (const char*)g.A + (size_t)cur.pm * tstep; const char* cB = (const char*)g.Bt + (size_t)cur.pn * tstep;
    S.a_ready(cur);
    if constexpr (SP2) {
        PG8_STAGE(PG8_SB(0, 0), cB, voffB); PG8_STAGE(PG8_SB(0, 1), cB + hstep, voffB); PG8_STAGE(PG8_SA(0, 0), cA, voffA); PG8_STAGE(PG8_SA(0, 1), cA + hstep, voffA);
        if (wr == 1) PG8_BAR;
        PG8_WAIT_V(2); PG8_BAR;
        PG8_STAGE(PG8_SB(1, 0), cB + kstep, voffB); PG8_STAGE(PG8_SA(1, 0), cA + kstep, voffA); PG8_STAGE(PG8_SB(1, 1), cB + hstep + kstep, voffB);
        PG8_WAIT_V(6); PG8_BAR;
    } else {
        PG8_STAGE(PG8_SB(0, 0), cB, voffB); PG8_STAGE(PG8_SA(0, 0), cA, voffA); PG8_STAGE(PG8_SB(0, 1), cB + hstep, voffB); PG8_STAGE(PG8_SA(0, 1), cA + hstep, voffA);
        if (wr == 1) PG8_BAR;
        PG8_WAIT_V(4); PG8_BAR;
        PG8_STAGE(PG8_SB(1, 0), cB + kstep, voffB); PG8_STAGE(PG8_SA(1, 0), cA + kstep, voffA); PG8_STAGE(PG8_SB(1, 1), cB + hstep + kstep, voffB);
        PG8_WAIT_V(6); PG8_BAR;
    }
    for (;;) {
        const bool has_next = S.next(ui + 1, nxt);
        const char* nA = has_next ? (const char*)g.A + (size_t)nxt.pm * tstep : cA; const char* nB = has_next ? (const char*)g.Bt + (size_t)nxt.pn * tstep : cB;
        for (int t = 0; t < nt; t += 2) {
            const bool last = (t == nt - 2);
            const char* a1 = cA + (size_t)(t + 1) * kstep;
            const char* a2 = last ? nA : cA + (size_t)(t + 2) * kstep; const char* b2 = last ? nB : cB + (size_t)(t + 2) * kstep;
            const char* a3 = a2 + kstep; const char* b3 = b2 + kstep;
            if (last && has_next) S.a_ready(nxt);
            if constexpr (SP2) {
            PG8_LDB(B0, 0, 0); PG8_LDB(B1, 0, 1); PG8_SCHED; PG8_LDA(At, 0, 0); PG8_STAGE(PG8_SA(1, 1), a1 + hstep, voffA);
            PG8_WAIT_V(8); PG8_WAIT_L(0); PG8_BAR; PG8_MMA(0, 0, At, B0); PG8_MMA(0, 1, At, B1); PG8_BAR; PG8_SCHED;
            PG8_LDA(At, 0, 1); PG8_STAGE(PG8_SB(0, 0), b2, voffB); PG8_STAGE(PG8_SB(0, 1), b2 + hstep, voffB); PG8_STAGE(PG8_SA(0, 0), a2, voffA);
            PG8_WAIT_V(8); PG8_WAIT_L(0); PG8_BAR; PG8_MMA(1, 0, At, B0); PG8_MMA(1, 1, At, B1); PG8_BAR; PG8_SCHED;
            PG8_LDB(B0, 1, 0); PG8_LDB(B1, 1, 1); PG8_SCHED; PG8_LDA(At, 1, 0); PG8_STAGE(PG8_SA(0, 1), a2 + hstep, voffA);
            PG8_WAIT_V(8); PG8_WAIT_L(0); PG8_BAR; PG8_MMA(0, 0, At, B0); PG8_MMA(0, 1, At, B1); PG8_BAR; PG8_SCHED;
            PG8_LDA(At, 1, 1); PG8_STAGE(PG8_SB(1, 0), b3, voffB); PG8_STAGE(PG8_SB(1, 1), b3 + hstep, voffB); PG8_STAGE(PG8_SA(1, 0), a3, voffA);
            PG8_WAIT_V(8); PG8_WAIT_L(0); PG8_BAR; PG8_MMA(1, 0, At, B0); PG8_MMA(1, 1, At, B1); PG8_BAR; PG8_SCHED;
            } else {
            PG8_LDB(B0, 0, 0); PG8_SCHED; PG8_LDA(At, 0, 0); PG8_STAGE(PG8_SA(1, 1), a1 + hstep, voffA);
            PG8_WAIT_L(8); PG8_BAR; PG8_WAIT_L(0); PG8_MMA(0, 0, At, B0); PG8_BAR; PG8_SCHED;
            PG8_LDB(B1, 0, 1); PG8_STAGE(PG8_SB(0, 0), b2, voffB);
            PG8_BAR; PG8_WAIT_L(0); PG8_MMA(0, 1, At, B1); PG8_BAR;
            PG8_LDA(At, 0, 1); PG8_STAGE(PG8_SA(0, 0), a2, voffA);
            PG8_BAR; PG8_WAIT_L(0); PG8_MMA(1, 0, At, B0); PG8_BAR; PG8_SCHED;
            PG8_STAGE(PG8_SB(0, 1), b2 + hstep, voffB);
            PG8_WAIT_V(6); PG8_BAR; PG8_MMA(1, 1, At, B1); PG8_BAR;
            PG8_LDB(B0, 1, 0); PG8_SCHED; PG8_LDA(At, 1, 0); PG8_STAGE(PG8_SA(0, 1), a2 + hstep, voffA);
            PG8_WAIT_L(8); PG8_BAR; PG8_WAIT_L(0); PG8_MMA(0, 0, At, B0); PG8_BAR; PG8_SCHED;
            PG8_LDB(B1, 1, 1); PG8_STAGE(PG8_SB(1, 0), b3, voffB);
            PG8_BAR; PG8_WAIT_L(0); PG8_MMA(0, 1, At, B1); PG8_BAR;
            PG8_LDA(At, 1, 1); PG8_STAGE(PG8_SA(1, 0), a3, voffA);
            PG8_BAR; PG8_WAIT_L(0); PG8_MMA(1, 0, At, B0); PG8_BAR; PG8_SCHED;
            PG8_STAGE(PG8_SB(1, 1), b3 + hstep, voffB);
            PG8_WAIT_V(6); PG8_BAR; PG8_MMA(1, 1, At, B1); PG8_BAR;
            }
        }
        if constexpr (ALIGN_EPI) { if (wr == 0) PG8_BAR; }
        if constexpr (!Epi::AFTER_DRAIN) { E(acc, cur, wr, wc, fr, fq); S.done(cur); }
        if (!has_next) break;
#pragma unroll
        for (int a = 0; a < 2; ++a)
#pragma unroll
            for (int b = 0; b < 2; ++b)
#pragma unroll
                for (int m = 0; m < 4; ++m)
#pragma unroll
                    for (int n = 0; n < 2; ++n) acc[a][b][m][n] = (f32x4){0.f, 0.f, 0.f, 0.f};
        cur = nxt; cA = nA; cB = nB; ++ui;
        if constexpr (ALIGN_EPI) { if (wr == 1) PG8_BAR; }
    }
    PG8_WAIT_V(0);
    if constexpr (!ALIGN_EPI) { if (wr == 0) PG8_BAR; }
    PG8_BAR;
    if constexpr (Epi::AFTER_DRAIN) { E.fused(acc, cur, wr, wc, fr, fq, lds, wid, lane); S.done(cur); }
#undef PG8_SA
#undef PG8_SB
#undef PG8_STAGE
#undef PG8_LDA
#undef PG8_LDB
#undef PG8_MMA
#undef PG8_WAIT_V
#undef PG8_WAIT_L
#undef PG8_BAR
#undef PG8_SCHED
}
}

#ifndef PG8_SP2
#define PG8_SP2 true
#endif
#ifndef PG8_ALIGN
#define PG8_ALIGN true
#endif
#include <hip/hip_bf16.h>
#include <cmath>
namespace attn_body {
using bf16=__hip_bfloat16;
using bf16x8=__attribute__((ext_vector_type(8)))short;
using s16x4=__attribute__((ext_vector_type(4)))short;
using f32x16=__attribute__((ext_vector_type(16)))float;
using u32x4=__attribute__((ext_vector_type(4)))unsigned;
constexpr int SEQ=8192,D=64,PQ=512,PO=1024;
constexpr int NW=8,QBLK=32,QB=QBLK*NW,KVBLK=64,NQB=SEQ/QB;
constexpr int ATTN_UNIT_ROWS=QB;
__device__ __forceinline__ int crow(int r,int hi){return (r&3)+8*(r>>2)+4*hi;}
#define SBAR() __builtin_amdgcn_sched_barrier(0)
__device__ __forceinline__ void cmask(f32x16&p0,f32x16&p1,int jb,int qrel,int hi){
  const float NEG=-INFINITY; int kb=64*jb+4*hi;
  #pragma unroll
  for(int r=0;r<16;++r){int kv=kb+(r&3)+8*(r>>2); if(kv>qrel)p0[r]=NEG; if(kv+32>qrel)p1[r]=NEG;}
}

constexpr int NSLOT=3, SLOTB=8192;
constexpr int LDS_K=0, LDS_V=NSLOT*SLOTB, LDS_WS=2*NSLOT*SLOTB, LDS_OST=LDS_WS+NW*64*4, LDS_BYTES=LDS_OST+NW*4096;
constexpr float C2=0.125f*1.4426950408889634f;
__device__ __forceinline__ void glds16(const void*gsrc,unsigned lds_dst){unsigned keep;
  asm volatile("s_mov_b32 %0, m0\n\ts_mov_b32 m0, %2\n\ts_nop 0\n\tglobal_load_lds_dwordx4 %1, off\n\ts_mov_b32 m0, %0":"=&s"(keep):"v"(gsrc),"s"(lds_dst):"memory");}
__device__ __forceinline__ float max3f(float a,float b,float c){float r;asm("v_max3_f32 %0, %1, %2, %3":"=v"(r):"v"(a),"v"(b),"v"(c));return r;}
__device__ __forceinline__ float max2f(float a,float b){float r;asm("v_max_f32_e32 %0, %1, %2":"=v"(r):"v"(a),"v"(b));return r;}
__device__ __forceinline__ float fadd_s(float a,float b){float r;asm("v_add_f32_e32 %0, %1, %2":"=v"(r):"v"(a),"v"(b));return r;}
__device__ __forceinline__ float fsub_s(float a,float b){float r;asm("v_sub_f32_e32 %0, %1, %2":"=v"(r):"v"(a),"v"(b));return r;}
typedef float f32x2_t __attribute__((ext_vector_type(2))); typedef __bf16 bf16x2_t __attribute__((ext_vector_type(2)));
__device__ __forceinline__ unsigned cvtpk_s(float lo,float hi){f32x2_t v={lo,hi};bf16x2_t b=__builtin_convertvector(v,bf16x2_t);return __builtin_bit_cast(unsigned,b);}
#define WAIT_BAR(N) asm volatile("s_waitcnt vmcnt(" #N ") lgkmcnt(0)\n\ts_barrier":::"memory")

__device__ __forceinline__ void qkt(f32x16&p0,f32x16&p1,const char*Kslot,const bf16x8*qr,const f32x16&negm,int r32,int hi){
  const char*kb=Kslot+hi*1024+r32*16;
  #pragma unroll
  for(int d0=0;d0<4;++d0){
    const bf16x8 b0=*reinterpret_cast<const bf16x8*>(kb+d0*2048);
    const bf16x8 b1=*reinterpret_cast<const bf16x8*>(kb+d0*2048+512);
    if(d0==0){p0=__builtin_amdgcn_mfma_f32_32x32x16_bf16(b0,qr[0],negm,0,0,0);p1=__builtin_amdgcn_mfma_f32_32x32x16_bf16(b1,qr[0],negm,0,0,0);}
    else{p0=__builtin_amdgcn_mfma_f32_32x32x16_bf16(b0,qr[d0],p0,0,0,0);p1=__builtin_amdgcn_mfma_f32_32x32x16_bf16(b1,qr[d0],p1,0,0,0);}}
}
typedef __attribute__((address_space(3))) const char* lds_cptr;
typedef short v4i16_t __attribute__((ext_vector_type(4)));
__device__ __forceinline__ void kload8(bf16x8*kf,lds_cptr kp){
  kf[0]=*(const __attribute__((address_space(3))) bf16x8*)(kp);      kf[1]=*(const __attribute__((address_space(3))) bf16x8*)(kp+512);
  kf[2]=*(const __attribute__((address_space(3))) bf16x8*)(kp+2048); kf[3]=*(const __attribute__((address_space(3))) bf16x8*)(kp+2560);
  kf[4]=*(const __attribute__((address_space(3))) bf16x8*)(kp+4096); kf[5]=*(const __attribute__((address_space(3))) bf16x8*)(kp+4608);
  kf[6]=*(const __attribute__((address_space(3))) bf16x8*)(kp+6144); kf[7]=*(const __attribute__((address_space(3))) bf16x8*)(kp+6656);
}
__device__ __forceinline__ void kload2(bf16x8*kf,lds_cptr kp,int j){ kf[2*j]=*(const __attribute__((address_space(3))) bf16x8*)(kp+j*2048); kf[2*j+1]=*(const __attribute__((address_space(3))) bf16x8*)(kp+j*2048+512); }
__device__ __forceinline__ s16x4 vtr(lds_cptr p){ return __builtin_bit_cast(s16x4,__builtin_amdgcn_ds_read_tr16_b64_v4i16((__attribute__((address_space(3))) v4i16_t*)p)); }
__device__ __forceinline__ float rowmax(const f32x16&p0,const f32x16&p1){
  float a=max3f(p0[0],p0[1],p1[0]),b=max3f(p0[2],p0[3],p1[1]);a=max3f(a,p1[2],p1[3]);
  #pragma unroll
  for(int r=4;r<16;r+=4){a=max3f(a,p0[r],p0[r+1]);b=max3f(b,p0[r+2],p0[r+3]);a=max3f(a,p1[r],p1[r+1]);b=max3f(b,p1[r+2],p1[r+3]);}
  const float m=max2f(a,b);
  auto rr=__builtin_amdgcn_permlane32_swap(__float_as_uint(m),__float_as_uint(m),false,false);
  return max2f(__uint_as_float(rr[0]),__uint_as_float(rr[1]));
}
__device__ __forceinline__ void pv(f32x16*o,int vb,bf16x8 pa0,bf16x8 pa1,bf16x8 pa2,bf16x8 pa3){
  #pragma unroll
  for(int d0=0;d0<2;++d0){s16x4 lo[4],hi[4];
    #pragma unroll
    for(int ks=0;ks<4;++ks){
      asm volatile("ds_read_b64_tr_b16 %0,%1 offset:%c2":"=&v"(lo[ks]):"v"(vb),"i"(d0*4096+ks*1024):"memory");
      asm volatile("ds_read_b64_tr_b16 %0,%1 offset:%c2":"=&v"(hi[ks]):"v"(vb),"i"(d0*4096+ks*1024+512):"memory");}
    asm volatile("s_waitcnt lgkmcnt(0)":::"memory");SBAR();
    #define PK(k) (bf16x8){lo[k][0],lo[k][1],lo[k][2],lo[k][3],hi[k][0],hi[k][1],hi[k][2],hi[k][3]}
    o[d0]=__builtin_amdgcn_mfma_f32_32x32x16_bf16(pa0,PK(0),o[d0],0,0,0);
    o[d0]=__builtin_amdgcn_mfma_f32_32x32x16_bf16(pa1,PK(1),o[d0],0,0,0);
    o[d0]=__builtin_amdgcn_mfma_f32_32x32x16_bf16(pa2,PK(2),o[d0],0,0,0);
    o[d0]=__builtin_amdgcn_mfma_f32_32x32x16_bf16(pa3,PK(3),o[d0],0,0,0);
    #undef PK
  }
}

#ifndef ATTN_STORE16
#define ATTN_STORE16(p,v) (*(u32x4*)(p)=(v))
#endif
template<int THRL> __device__ __forceinline__ void attn_unit(int q0,const bf16*Qu,const bf16*__restrict__ Kh,const bf16*__restrict__ Vh,bf16*Ou,char*shm){
  int tid_=threadIdx.x; asm volatile("":"+v"(tid_)); const int tid=tid_,lane=tid&63,r32=lane&31,hi=lane>>5; const int wid=__builtin_amdgcn_readfirstlane(tid>>6);
  const bf16*Qw=Qu+(long)(wid*QBLK)*PQ;
  const unsigned lds0=(unsigned)(uintptr_t)shm;
  float*wsf=(float*)(shm+LDS_WS)+wid*64;
  const bf16*ksrc=Kh+(long)lane*PQ+wid*8;
  const bf16*vsrc=Vh+(long)(16*(wid&3)+(lane>>2))*PQ+(wid>>2)*32+(lane&3)*8;
  const unsigned kdst=lds0+LDS_K+wid*1024, vdst=lds0+LDS_V+wid*1024;
  #define DMA_K(t,slot) glds16(ksrc+(long)(t)*KVBLK*PQ,(unsigned)__builtin_amdgcn_readfirstlane(kdst+(slot)))
  #define DMA_V(t,slot) glds16(vsrc+(long)(t)*KVBLK*PQ,(unsigned)__builtin_amdgcn_readfirstlane(vdst+(slot)))
  const int vb0=(int)(lds0+LDS_V)+((lane>>4)&1)*32+(lane&3)*8+(4*hi+((lane&15)>>2))*64;
  const char*Kbase=shm+LDS_K; bf16x8 kf[8];
  const lds_cptr shm3=(lds_cptr)shm; const lds_cptr kp0=shm3+LDS_K+hi*1024+r32*16; const lds_cptr vp0=shm3+LDS_V+((lane>>4)&1)*32+(lane&3)*8+(4*hi+((lane&15)>>2))*64;
  const int NT=(q0+QB)/KVBLK+1;
  DMA_K(0,0);DMA_V(0,0);DMA_K(1,SLOTB);
  bf16x8 qr[4];
  #pragma unroll
  for(int d0=0;d0<4;++d0)qr[d0]=*reinterpret_cast<const bf16x8*>(&Qw[(long)r32*PQ+d0*16+hi*8]);
  float mhat=0.f,l_reg=0.f;f32x16 o[2];o[0]=f32x16{};o[1]=f32x16{};f32x16 negm=f32x16{};asm volatile("":"+v"(negm));
  const int qrel=wid*QBLK+r32;
  #define CMASK(P0,P1,t) do{int jb_=(t)-(NT-4); if(jb_>=0)cmask(P0,P1,jb_,qrel,hi);}while(0)
  bool resc=false;
  #define START(P0,P1) do{ const float rm=rowmax(P0,P1); resc=false; \
    { const float dl=rm; mhat=fadd_s(mhat,dl); \
      _Pragma("unroll") for(int r=0;r<16;++r){P0[r]=fsub_s(P0[r],dl);P1[r]=fsub_s(P1[r],dl);} \
      _Pragma("unroll") for(int r=0;r<16;++r)negm[r]=-mhat; asm volatile("":"+v"(negm)); } \
    _Pragma("unroll") for(int r=0;r<16;++r)P0[r]=__builtin_amdgcn_exp2f(P0[r]); }while(0)
  #define RESC() do{ if(resc){ asm volatile("s_waitcnt lgkmcnt(0)":::"memory"); \
      _Pragma("unroll") for(int d_=0;d_<2;++d_) _Pragma("unroll") for(int r=0;r<16;++r)o[d_][r]*=wsf[crow(r,hi)]; } }while(0)
  f32x16 pA0,pA1,pB0,pB1;
  int sl_prev=0,sl_cur=0,sl_next=SLOTB;
  #define ROT() do{sl_prev=sl_cur;sl_cur=sl_next;sl_next=(sl_next==(NSLOT-1)*SLOTB)?0:sl_next+SLOTB;}while(0)
  DMA_K(2,2*SLOTB);
  WAIT_BAR(3);
  qkt(pA0,pA1,Kbase,qr,negm,r32,hi);asm volatile("s_nop 15\n\ts_nop 7":"+v"(pA0),"+v"(pA1));
  { const float NEGI=-INFINITY; _Pragma("unroll") for(int r=8;r<16;++r)pA0[r]=NEGI; _Pragma("unroll") for(int r=0;r<16;++r)pA1[r]=NEGI; }
  START(pA0,pA1);
  _Pragma("unroll") for(int r=0;r<16;++r)pA1[r]=__builtin_amdgcn_exp2f(pA1[r]);
  WAIT_BAR(0);
  DMA_K(3,0);DMA_V(1,SLOTB);
  ROT();
  kload8(kf,kp0+sl_cur);
  WAIT_BAR(2);
  s16x4 vlo[8],vhi[8]; u32x4 pw0,pw1,pw2,pw3;
  #define PKW(P,B) cvtpk_s(P[B],P[B+1])
  #define PAF(k) __builtin_bit_cast(bf16x8,pw##k)
  #define VFR(i) (bf16x8){vlo[i][0],vlo[i][1],vlo[i][2],vlo[i][3],vhi[i][0],vhi[i][1],vhi[i][2],vhi[i][3]}
  #define PIN(x) asm volatile("":"+v"(x))
  #define MX3(a,b,c) __builtin_fmaxf(__builtin_fmaxf((a),(b)),(c))
  #define GAPA(MF,A0,A1,A2,A3,W0,W1,PW) do{ MF; sacc+=A0; sacc+=A1; sacc+=A2; sacc+=A3; PIN(sacc); W0; W1; PIN(PW); SBAR(); }while(0)
  #define EX(v) __builtin_amdgcn_exp2f(v)
  #define GAPB(MF,X,B) do{ MF; X[B]=EX(X[B]); X[B+1]=EX(X[B+1]); X[B+2]=EX(X[B+2]); X[B+3]=EX(X[B+3]); PIN(X); SBAR(); }while(0)
  #define VRD(i) do{ vlo[i]=vtr(vp_+(((i)>>2)*4096+((i)&3)*1024)); vhi[i]=vtr(vp_+(((i)>>2)*4096+((i)&3)*1024+512)); }while(0)
  #define KRD(G,j) do{ if(G){ kload2(kf,kp0+sl_next,j); SBAR(); } }while(0)
  #define STEP(C0,C1,P0,P1,t,GK,GV,GL) do{ SBAR(); \
    const lds_cptr vp_=vp0+sl_prev; \
    VRD(0); SBAR(); float sacc=(P0[0]+P0[1]); \
    GAPA(C0=__builtin_amdgcn_mfma_f32_32x32x16_bf16(kf[0],qr[0],negm,0,0,0), P0[2],P0[3],P0[4],P0[5],     pw0[0]=PKW(P0,0), pw0[1]=PKW(P0,2), pw0); \
    VRD(4); SBAR(); GAPA(C1=__builtin_amdgcn_mfma_f32_32x32x16_bf16(kf[1],qr[0],negm,0,0,0), P0[6],P0[7],P0[8],P0[9],     pw0[2]=PKW(P0,4), pw0[3]=PKW(P0,6), pw0); \
    VRD(1); SBAR(); GAPA(C0=__builtin_amdgcn_mfma_f32_32x32x16_bf16(kf[2],qr[1],C0,0,0,0),   P0[10],P0[11],P0[12],P0[13], pw1[0]=PKW(P0,8), pw1[1]=PKW(P0,10), pw1); \
    VRD(5); SBAR(); GAPA(C1=__builtin_amdgcn_mfma_f32_32x32x16_bf16(kf[3],qr[1],C1,0,0,0),   P0[14],P0[15],P1[0],P1[1],   pw1[2]=PKW(P0,12),pw1[3]=PKW(P0,14), pw1); \
    VRD(2); SBAR(); GAPA(C0=__builtin_amdgcn_mfma_f32_32x32x16_bf16(kf[4],qr[2],C0,0,0,0),   P1[2],P1[3],P1[4],P1[5],     pw2[0]=PKW(P1,0), pw2[1]=PKW(P1,2), pw2); \
    VRD(6); SBAR(); GAPA(C1=__builtin_amdgcn_mfma_f32_32x32x16_bf16(kf[5],qr[2],C1,0,0,0),   P1[6],P1[7],P1[8],P1[9],     pw2[2]=PKW(P1,4), pw2[3]=PKW(P1,6), pw2); \
    VRD(3); SBAR(); GAPA(C0=__builtin_amdgcn_mfma_f32_32x32x16_bf16(kf[6],qr[3],C0,0,0,0),   P1[10],P1[11],P1[12],P1[13], pw3[0]=PKW(P1,8), pw3[1]=PKW(P1,10), pw3); \
    VRD(7); SBAR(); GAPA(C1=__builtin_amdgcn_mfma_f32_32x32x16_bf16(kf[7],qr[3],C1,0,0,0),   P1[14],P1[15],0.f,0.f,       pw3[2]=PKW(P1,12),pw3[3]=PKW(P1,14), pw3); \
    l_reg+=sacc; \
    if(GK){DMA_K((t)+3,sl_cur);} if(GV){DMA_V((t)+1,sl_next);} \
    CMASK(C0,C1,t); \
    { float a=MX3(C0[0],C0[1],C1[0]),b=MX3(C0[2],C0[3],C1[1]); a=MX3(a,C1[2],C1[3]); \
      _Pragma("unroll") for(int r=4;r<16;r+=4){a=MX3(a,C0[r],C0[r+1]);b=MX3(b,C0[r+2],C0[r+3]);a=MX3(a,C1[r],C1[r+1]);b=MX3(b,C1[r+2],C1[r+3]);} \
      float rm=__builtin_fmaxf(a,b); { auto rr=__builtin_amdgcn_permlane32_swap(__float_as_uint(rm),__float_as_uint(rm),false,false); rm=__builtin_fmaxf(__uint_as_float(rr[0]),__uint_as_float(rr[1])); } \
      resc=false; \
      if(__builtin_expect(__any(rm>(float)THRL),0)){ const float dl=__builtin_fmaxf(rm,0.f); mhat+=dl; \
        _Pragma("unroll") for(int r=0;r<16;++r){C0[r]-=dl;C1[r]-=dl;} \
        _Pragma("unroll") for(int r=0;r<16;++r)negm[r]=-mhat; asm volatile("":"+v"(negm)); \
        const float f=__builtin_amdgcn_exp2f(-dl); l_reg*=f; if(hi==0)wsf[r32]=f; resc=true; } } \
    SBAR(); \
    GAPB(o[0]=__builtin_amdgcn_mfma_f32_32x32x16_bf16(PAF(0),VFR(0),o[0],0,0,0), C0,0); \
    GAPB(o[1]=__builtin_amdgcn_mfma_f32_32x32x16_bf16(PAF(0),VFR(4),o[1],0,0,0), C0,4); \
    KRD(GL,0); GAPB(o[0]=__builtin_amdgcn_mfma_f32_32x32x16_bf16(PAF(1),VFR(1),o[0],0,0,0), C0,8); \
    KRD(GL,1); GAPB(o[1]=__builtin_amdgcn_mfma_f32_32x32x16_bf16(PAF(1),VFR(5),o[1],0,0,0), C0,12); \
    KRD(GL,2); GAPB(o[0]=__builtin_amdgcn_mfma_f32_32x32x16_bf16(PAF(2),VFR(2),o[0],0,0,0), C1,0); \
    KRD(GL,3); GAPB(o[1]=__builtin_amdgcn_mfma_f32_32x32x16_bf16(PAF(2),VFR(6),o[1],0,0,0), C1,4); \
    GAPB(o[0]=__builtin_amdgcn_mfma_f32_32x32x16_bf16(PAF(3),VFR(3),o[0],0,0,0), C1,8); \
    GAPB(o[1]=__builtin_amdgcn_mfma_f32_32x32x16_bf16(PAF(3),VFR(7),o[1],0,0,0), C1,12); \
    }while(0)
  int t=1;
  #undef CMASK
  #define CMASK(P0,P1,t) do{}while(0)
  for(;t+5<NT;t+=2){
    STEP(pB0,pB1,pA0,pA1,t,true,true,true);     WAIT_BAR(2); RESC(); ROT();
    STEP(pA0,pA1,pB0,pB1,t+1,true,true,true);   WAIT_BAR(2); RESC(); ROT();
  }
  #undef CMASK
  #define CMASK(P0,P1,t) do{int jb_=(t)-(NT-4); if(jb_>=0)cmask(P0,P1,jb_,qrel,hi);}while(0)
  #define ENDW(tt) do{ if((tt)+3<NT){WAIT_BAR(2);} else if((tt)+2<NT){WAIT_BAR(1);} else {WAIT_BAR(0);} }while(0)
  for(;t+1<NT;t+=2){
    STEP(pB0,pB1,pA0,pA1,t,(t+3<NT),(t+1<NT),(t+1<NT));       ENDW(t);   RESC(); ROT();
    STEP(pA0,pA1,pB0,pB1,t+1,(t+4<NT),(t+2<NT),(t+2<NT));     ENDW(t+1); RESC(); ROT();
  }
  { float sacc=pA0[0]+pA0[1]; _Pragma("unroll") for(int r=2;r<16;++r)sacc+=pA0[r]; _Pragma("unroll") for(int r=0;r<16;++r)sacc+=pA1[r]; l_reg+=sacc;
    pw0=(u32x4){PKW(pA0,0),PKW(pA0,2),PKW(pA0,4),PKW(pA0,6)};pw1=(u32x4){PKW(pA0,8),PKW(pA0,10),PKW(pA0,12),PKW(pA0,14)};pw2=(u32x4){PKW(pA1,0),PKW(pA1,2),PKW(pA1,4),PKW(pA1,6)};pw3=(u32x4){PKW(pA1,8),PKW(pA1,10),PKW(pA1,12),PKW(pA1,14)};
    SBAR(); pv(o,vb0+sl_prev,PAF(0),PAF(1),PAF(2),PAF(3)); }
  #undef PKW
  #undef PAF
  #undef VFR
  #undef PIN
  #undef MX3
  #undef GAPA
  #undef GAPB
  #undef EX
  #undef VRD
  #undef KRD
  #undef STEP
  #undef ENDW
  {auto rr=__builtin_amdgcn_permlane32_swap(__float_as_uint(l_reg),__float_as_uint(l_reg),false,false);l_reg=__uint_as_float(rr[0])+__uint_as_float(rr[1]);}
  if(hi==0)wsf[32+r32]=l_reg;asm volatile("s_waitcnt lgkmcnt(0)":::"memory");
  float rli[16];
  #pragma unroll
  for(int r=0;r<16;++r)rli[r]=__builtin_amdgcn_rcpf(wsf[32+crow(r,hi)]);
  bf16*Ow=Ou+(long)(wid*QBLK)*PO;
  { bf16*stg=(bf16*)(shm+LDS_OST)+wid*2048;
    #pragma unroll
    for(int r=0;r<16;++r){const int orow=crow(r,hi);
      #pragma unroll
      for(int d0=0;d0<2;++d0)stg[orow*64+d0*32+r32]=__float2bfloat16(o[d0][r]*rli[r]);}
    asm volatile("s_waitcnt lgkmcnt(0)":::"memory");
    #pragma unroll
    for(int i=0;i<4;++i){const int row=i*8+(lane>>3),ch=lane&7; const u32x4 v=*(const u32x4*)(stg+row*64+ch*8); ATTN_STORE16(Ow+(long)row*PO+ch*8,v);} }
  asm volatile("s_waitcnt lgkmcnt(0)\n\ts_barrier":::"memory");
  #undef DMA_K
  #undef DMA_V
  #undef CMASK
  #undef START
  #undef RESC
  #undef ROT
}
constexpr int ATTN_LDS_BYTES=LDS_BYTES;
#undef SBAR
#undef WAIT_BAR
typedef float f32x4v __attribute__((ext_vector_type(4)));
constexpr int V2_SLOTV=16384, V2_LDS_K=0, V2_LDS_V=NSLOT*SLOTB, V2_LDS_WS=V2_LDS_V+NSLOT*V2_SLOTV, V2_LDS_OST=V2_LDS_WS+NW*64*4, V2_LDS_BYTES=V2_LDS_OST+NW*8192;
#define SBAR() __builtin_amdgcn_sched_barrier(0)
#define WAIT_BAR(N) asm volatile("s_waitcnt vmcnt(" #N ") lgkmcnt(0)\n\ts_barrier":::"memory")
__device__ __forceinline__ void pv4(f32x16*o,int vb,bf16x8 pa0,bf16x8 pa1,bf16x8 pa2,bf16x8 pa3){
  #pragma unroll
  for(int d0=0;d0<4;++d0){s16x4 lo[4],hi[4];
    #pragma unroll
    for(int ks=0;ks<4;++ks){
      asm volatile("ds_read_b64_tr_b16 %0,%1 offset:%c2":"=&v"(lo[ks]):"v"(vb),"i"(d0*4096+ks*1024):"memory");
      asm volatile("ds_read_b64_tr_b16 %0,%1 offset:%c2":"=&v"(hi[ks]):"v"(vb),"i"(d0*4096+ks*1024+512):"memory");}
    asm volatile("s_waitcnt lgkmcnt(0)":::"memory");SBAR();
    #define PK(k) (bf16x8){lo[k][0],lo[k][1],lo[k][2],lo[k][3],hi[k][0],hi[k][1],hi[k][2],hi[k][3]}
    o[d0]=__builtin_amdgcn_mfma_f32_32x32x16_bf16(pa0,PK(0),o[d0],0,0,0);
    o[d0]=__builtin_amdgcn_mfma_f32_32x32x16_bf16(pa1,PK(1),o[d0],0,0,0);
    o[d0]=__builtin_amdgcn_mfma_f32_32x32x16_bf16(pa2,PK(2),o[d0],0,0,0);
    o[d0]=__builtin_amdgcn_mfma_f32_32x32x16_bf16(pa3,PK(3),o[d0],0,0,0);
    #undef PK
  }
}
template<int MODE> __device__ __forceinline__ void attn_unit128(int q0,const bf16*Qu,const bf16*__restrict__ Kh,const bf16*__restrict__ Vh,bf16*Ou,char*shm,float lam,float oscale,const float*subg){
  int tid_=threadIdx.x; asm volatile("":"+v"(tid_)); const int tid=tid_,lane=tid&63,r32=lane&31,hi=lane>>5; const int wid=__builtin_amdgcn_readfirstlane(tid>>6);
  const bf16*Qw=Qu+(long)(wid*QBLK)*PQ;
  const unsigned lds0=(unsigned)(uintptr_t)shm;
  float*wsf=(float*)(shm+V2_LDS_WS)+wid*64;
  const bf16*ksrc=Kh+(long)lane*PQ+wid*8;
  const bf16*vsrc=Vh+(long)(16*(wid&3)+(lane>>2))*PQ+(wid>>2)*32+(lane&3)*8;
  const unsigned kdst=lds0+V2_LDS_K+wid*1024, vdst=lds0+V2_LDS_V+wid*1024;
  #define DMA_K(t,slot) glds16(ksrc+(long)(t)*KVBLK*PQ,(unsigned)__builtin_amdgcn_readfirstlane(kdst+(slot)))
  #define DMA_V(t,slot) do{ glds16(vsrc+(long)(t)*KVBLK*PQ,(unsigned)__builtin_amdgcn_readfirstlane(vdst+2*(slot))); glds16(vsrc+(long)(t)*KVBLK*PQ+64,(unsigned)__builtin_amdgcn_readfirstlane(vdst+2*(slot)+8192)); }while(0)
  const int vb0=(int)(lds0+V2_LDS_V)+((lane>>4)&1)*32+(lane&3)*8+(4*hi+((lane&15)>>2))*64;
  const char*Kbase=shm+V2_LDS_K; bf16x8 kf[8];
  const lds_cptr shm3=(lds_cptr)shm; const lds_cptr kp0=shm3+V2_LDS_K+hi*1024+r32*16; const lds_cptr vp0=shm3+V2_LDS_V+((lane>>4)&1)*32+(lane&3)*8+(4*hi+((lane&15)>>2))*64;
  const int NT=(q0+QB)/KVBLK+1;
  DMA_K(0,0);DMA_V(0,0);DMA_K(1,SLOTB);
  bf16x8 qr[4];
  #pragma unroll
  for(int d0=0;d0<4;++d0)qr[d0]=*reinterpret_cast<const bf16x8*>(&Qw[(long)r32*PQ+d0*16+hi*8]);
  float l_reg=0.f;f32x16 o[4];o[0]=f32x16{};o[1]=f32x16{};o[2]=f32x16{};o[3]=f32x16{};
  const f32x16 zero16=f32x16{};
  const int qrel=wid*QBLK+r32;
  #define CMASK(P0,P1,t) do{int jb_=(t)-(NT-4); if(jb_>=0)cmask(P0,P1,jb_,qrel,hi);}while(0)
  f32x16 pA0,pA1,pB0,pB1;
  int sl_prev=0,sl_cur=0,sl_next=SLOTB;
  #define ROT() do{sl_prev=sl_cur;sl_cur=sl_next;sl_next=(sl_next==(NSLOT-1)*SLOTB)?0:sl_next+SLOTB;}while(0)
  DMA_K(2,2*SLOTB);
  WAIT_BAR(3);
  qkt(pA0,pA1,Kbase,qr,zero16,r32,hi);asm volatile("s_nop 15\n\ts_nop 7":"+v"(pA0),"+v"(pA1));
  { const float NEGI=-INFINITY; _Pragma("unroll") for(int r=8;r<16;++r)pA0[r]=NEGI; _Pragma("unroll") for(int r=0;r<16;++r)pA1[r]=NEGI; }
  _Pragma("unroll") for(int r=0;r<16;++r){pA0[r]=__builtin_amdgcn_exp2f(pA0[r]);pA1[r]=__builtin_amdgcn_exp2f(pA1[r]);}
  WAIT_BAR(0);
  DMA_K(3,0);DMA_V(1,SLOTB);
  ROT();
  kload8(kf,kp0+sl_cur);
  WAIT_BAR(3);
  s16x4 vlo[8],vhi[8]; u32x4 pw0,pw1,pw2,pw3;
  #define PKW(P,B) cvtpk_s(P[B],P[B+1])
  #define PAF(k) __builtin_bit_cast(bf16x8,pw##k)
  #define VFR(i) (bf16x8){vlo[i][0],vlo[i][1],vlo[i][2],vlo[i][3],vhi[i][0],vhi[i][1],vhi[i][2],vhi[i][3]}
  #define PIN(x) asm volatile("":"+v"(x))
  #define GAPA(MF,A0,A1,A2,A3,W0,W1,PW) do{ MF; sacc+=A0; sacc+=A1; sacc+=A2; sacc+=A3; PIN(sacc); W0; W1; PIN(PW); SBAR(); }while(0)
  #define EX(v) __builtin_amdgcn_exp2f(v)
  #define GAPB(MF,X,B) do{ MF; X[B]=EX(X[B]); X[B+1]=EX(X[B+1]); PIN(X); SBAR(); }while(0)
  #define VRD(i) do{ vlo[i]=vtr(vp_+(((i)>>2)*4096+((i)&3)*1024)); vhi[i]=vtr(vp_+(((i)>>2)*4096+((i)&3)*1024+512)); }while(0)
  #define VRD2(i) do{ vlo[i]=vtr(vp_+(8192+((i)>>2)*4096+((i)&3)*1024)); vhi[i]=vtr(vp_+(8192+((i)>>2)*4096+((i)&3)*1024+512)); SBAR(); }while(0)
  #define KRD(G,j) do{ if(G){ kload2(kf,kp0+sl_next,j); SBAR(); } }while(0)
  #define MF32(a,b,c) __builtin_amdgcn_mfma_f32_32x32x16_bf16(a,b,c,0,0,0)
  #define STEP(C0,C1,P0,P1,t,GK,GV,GL) do{ SBAR(); \
    const lds_cptr vp_=vp0+2*sl_prev; \
    VRD(0); SBAR(); float sacc=(P0[0]+P0[1]); \
    GAPA(C0=MF32(kf[0],qr[0],zero16), P0[2],P0[3],P0[4],P0[5],     pw0[0]=PKW(P0,0), pw0[1]=PKW(P0,2), pw0); \
    VRD(4); SBAR(); GAPA(C1=MF32(kf[1],qr[0],zero16), P0[6],P0[7],P0[8],P0[9],     pw0[2]=PKW(P0,4), pw0[3]=PKW(P0,6), pw0); \
    VRD(1); SBAR(); GAPA(C0=MF32(kf[2],qr[1],C0),   P0[10],P0[11],P0[12],P0[13], pw1[0]=PKW(P0,8), pw1[1]=PKW(P0,10), pw1); \
    VRD(5); SBAR(); GAPA(C1=MF32(kf[3],qr[1],C1),   P0[14],P0[15],P1[0],P1[1],   pw1[2]=PKW(P0,12),pw1[3]=PKW(P0,14), pw1); \
    VRD(2); SBAR(); GAPA(C0=MF32(kf[4],qr[2],C0),   P1[2],P1[3],P1[4],P1[5],     pw2[0]=PKW(P1,0), pw2[1]=PKW(P1,2), pw2); \
    VRD(6); SBAR(); GAPA(C1=MF32(kf[5],qr[2],C1),   P1[6],P1[7],P1[8],P1[9],     pw2[2]=PKW(P1,4), pw2[3]=PKW(P1,6), pw2); \
    VRD(3); SBAR(); GAPA(C0=MF32(kf[6],qr[3],C0),   P1[10],P1[11],P1[12],P1[13], pw3[0]=PKW(P1,8), pw3[1]=PKW(P1,10), pw3); \
    VRD(7); SBAR(); GAPA(C1=MF32(kf[7],qr[3],C1),   P1[14],P1[15],0.f,0.f,       pw3[2]=PKW(P1,12),pw3[3]=PKW(P1,14), pw3); \
    l_reg+=sacc; \
    if(GK){DMA_K((t)+3,sl_cur);} if(GV){DMA_V((t)+1,sl_next);} \
    CMASK(C0,C1,t); \
    SBAR(); \
    GAPB(o[0]=MF32(PAF(0),VFR(0),o[0]), C0,0);  VRD2(0); \
    GAPB(o[1]=MF32(PAF(0),VFR(4),o[1]), C0,2);  VRD2(4); \
    KRD(GL,0); GAPB(o[0]=MF32(PAF(1),VFR(1),o[0]), C0,4);  VRD2(1); \
    KRD(GL,1); GAPB(o[1]=MF32(PAF(1),VFR(5),o[1]), C0,6);  VRD2(5); \
    KRD(GL,2); GAPB(o[0]=MF32(PAF(2),VFR(2),o[0]), C0,8);  VRD2(2); \
    KRD(GL,3); GAPB(o[1]=MF32(PAF(2),VFR(6),o[1]), C0,10); VRD2(6); \
    GAPB(o[0]=MF32(PAF(3),VFR(3),o[0]), C0,12); VRD2(3); \
    GAPB(o[1]=MF32(PAF(3),VFR(7),o[1]), C0,14); VRD2(7); \
    GAPB(o[2]=MF32(PAF(0),VFR(0),o[2]), C1,0); \
    GAPB(o[3]=MF32(PAF(0),VFR(4),o[3]), C1,2); \
    GAPB(o[2]=MF32(PAF(1),VFR(1),o[2]), C1,4); \
    GAPB(o[3]=MF32(PAF(1),VFR(5),o[3]), C1,6); \
    GAPB(o[2]=MF32(PAF(2),VFR(2),o[2]), C1,8); \
    GAPB(o[3]=MF32(PAF(2),VFR(6),o[3]), C1,10); \
    GAPB(o[2]=MF32(PAF(3),VFR(3),o[2]), C1,12); \
    GAPB(o[3]=MF32(PAF(3),VFR(7),o[3]), C1,14); \
    }while(0)
  int t=1;
  #undef CMASK
  #define CMASK(P0,P1,t) do{}while(0)
  for(;t+5<NT;t+=2){
    STEP(pB0,pB1,pA0,pA1,t,true,true,true);     WAIT_BAR(3); ROT();
    STEP(pA0,pA1,pB0,pB1,t+1,true,true,true);   WAIT_BAR(3); ROT();
  }
  #undef CMASK
  #define CMASK(P0,P1,t) do{int jb_=(t)-(NT-4); if(jb_>=0)cmask(P0,P1,jb_,qrel,hi);}while(0)
  #define ENDW(tt) do{ if((tt)+3<NT){WAIT_BAR(3);} else if((tt)+2<NT){WAIT_BAR(2);} else {WAIT_BAR(0);} }while(0)
  for(;t+1<NT;t+=2){
    STEP(pB0,pB1,pA0,pA1,t,(t+3<NT),(t+1<NT),(t+1<NT));       ENDW(t);   ROT();
    STEP(pA0,pA1,pB0,pB1,t+1,(t+4<NT),(t+2<NT),(t+2<NT));     ENDW(t+1); ROT();
  }
  { float sacc=pA0[0]+pA0[1]; _Pragma("unroll") for(int r=2;r<16;++r)sacc+=pA0[r]; _Pragma("unroll") for(int r=0;r<16;++r)sacc+=pA1[r]; l_reg+=sacc;
    pw0=(u32x4){PKW(pA0,0),PKW(pA0,2),PKW(pA0,4),PKW(pA0,6)};pw1=(u32x4){PKW(pA0,8),PKW(pA0,10),PKW(pA0,12),PKW(pA0,14)};pw2=(u32x4){PKW(pA1,0),PKW(pA1,2),PKW(pA1,4),PKW(pA1,6)};pw3=(u32x4){PKW(pA1,8),PKW(pA1,10),PKW(pA1,12),PKW(pA1,14)};
    SBAR(); pv4(o,vb0+2*sl_prev,PAF(0),PAF(1),PAF(2),PAF(3)); }
  #undef PKW
  #undef PAF
  #undef VFR
  #undef PIN
  #undef GAPA
  #undef GAPB
  #undef EX
  #undef VRD
  #undef VRD2
  #undef KRD
  #undef MF32
  #undef STEP
  #undef ENDW
  {auto rr=__builtin_amdgcn_permlane32_swap(__float_as_uint(l_reg),__float_as_uint(l_reg),false,false);l_reg=__uint_as_float(rr[0])+__uint_as_float(rr[1]);}
  if(hi==0)wsf[32+r32]=l_reg;asm volatile("s_waitcnt lgkmcnt(0)":::"memory");
  float rli[16];
  #pragma unroll
  for(int r=0;r<16;++r)rli[r]=__builtin_amdgcn_rcpf(wsf[32+crow(r,hi)]);
  { bf16*park=(bf16*)(shm+V2_LDS_OST)+wid*4096;
    if(MODE==0){
      #pragma unroll
      for(int r=0;r<16;++r){const int orow=crow(r,hi);
        #pragma unroll
        for(int d0=0;d0<4;++d0)park[orow*128+d0*32+r32]=__float2bfloat16(o[d0][r]*rli[r]);}
      asm volatile("s_waitcnt lgkmcnt(0)":::"memory");
    } else {
      #pragma unroll
      for(int r=0;r<16;++r){const int orow=crow(r,hi);
        #pragma unroll
        for(int d0=0;d0<4;++d0){const float o1=__bfloat162float(park[orow*128+d0*32+r32]); park[orow*128+d0*32+r32]=__float2bfloat16(o1-lam*(o[d0][r]*rli[r]));}}
      asm volatile("s_waitcnt lgkmcnt(0)":::"memory");
      bf16*Ow=Ou+(long)(wid*QBLK)*PO;
      const int ch=lane&15; const f32x4v g0=*(const f32x4v*)(subg+8*ch), g1=*(const f32x4v*)(subg+8*ch+4);
      #pragma unroll
      for(int i=0;i<8;++i){const int row=i*4+(lane>>4); const u32x4 v=*(const u32x4*)(park+row*128+ch*8);
        float d[8]; d[0]=__uint_as_float(v.x<<16);d[1]=__uint_as_float(v.x&0xffff0000u);d[2]=__uint_as_float(v.y<<16);d[3]=__uint_as_float(v.y&0xffff0000u);d[4]=__uint_as_float(v.z<<16);d[5]=__uint_as_float(v.z&0xffff0000u);d[6]=__uint_as_float(v.w<<16);d[7]=__uint_as_float(v.w&0xffff0000u);
        float ss=(d[0]*d[0]+d[1]*d[1])+(d[2]*d[2]+d[3]*d[3])+(d[4]*d[4]+d[5]*d[5])+(d[6]*d[6]+d[7]*d[7]);
        ss+=__shfl_xor(ss,1);ss+=__shfl_xor(ss,2);ss+=__shfl_xor(ss,4);ss+=__shfl_xor(ss,8);
        const float rs=__builtin_amdgcn_rsqf(ss*(1.0f/128.0f)+1e-6f)*oscale;
        u32x4 w; w.x=cvtpk_s(d[0]*rs*g0[0],d[1]*rs*g0[1]); w.y=cvtpk_s(d[2]*rs*g0[2],d[3]*rs*g0[3]); w.z=cvtpk_s(d[4]*rs*g1[0],d[5]*rs*g1[1]); w.w=cvtpk_s(d[6]*rs*g1[2],d[7]*rs*g1[3]);
        ATTN_STORE16(Ow+(long)row*PO+ch*8,w);}
      asm volatile("s_waitcnt lgkmcnt(0)":::"memory");
    } }
  asm volatile("s_waitcnt lgkmcnt(0)\n\ts_barrier":::"memory");
  #undef DMA_K
  #undef DMA_V
  #undef CMASK
  #undef ROT
}
#undef SBAR
#undef WAIT_BAR

}
namespace cg = cooperative_groups;
constexpr int NWAVES = 8;
constexpr int NB = 4, SEQ = 8192, DM = 1024, NMETA = 16, DIN = 2560, DFF = 4096, DCONV = 512, CONVW = 31;
constexpr int MX = NB * SEQ;
constexpr int MP = MX + 256;
constexpr int SPAD = pg8::SPAD;
constexpr float EPS = 1e-6f;
constexpr size_t MiB = 1u << 20;
constexpr size_t WS_CTL = 0, WS_WIN = 1 * MiB, WS_WOUT = 6 * MiB, WS_WUP = 8 * MiB, WS_WDN = 16 * MiB, WS_ROPE = 24 * MiB, WS_SSQ = 25 * MiB, WS_RN = 27 * MiB,
                 WS_H1B = 28 * MiB, WS_MIX = 92 * MiB, WS_HB = 156 * MiB, WS_XN = 156 * MiB, WS_O = 156 * MiB, WS_Q = 222 * MiB, WS_K = 254 * MiB, WS_V = 287 * MiB, WS_G = 320 * MiB,
                 WS_END = 412 * MiB;
static_assert(WS_XN + (size_t)MP * DM * 2 <= WS_Q && WS_K + (size_t)NB * SPAD * 512 * 2 <= WS_V && WS_G + (size_t)NB * SPAD * 512 * 2 <= WS_HB + (size_t)MX * DFF * 2 && WS_HB + (size_t)MX * DFF * 2 <= WS_END, "d_ws map");
constexpr int RING_BYTES = 131072, LDS_BYTES = 147456;

#define LAS __attribute__((address_space(3)))
typedef unsigned short bf16;
typedef unsigned v4u __attribute__((ext_vector_type(4)));
typedef float f32x4 __attribute__((ext_vector_type(4)));
typedef float f32x2 __attribute__((ext_vector_type(2)));
#define LDS_WAIT() asm volatile("s_waitcnt lgkmcnt(0)" ::: "memory")
__device__ __forceinline__ unsigned pk2(float lo, float hi) { return pg8::cvt_pk_bf16(lo, hi); }
__device__ __forceinline__ float bf_lo(unsigned u) { return __uint_as_float(u << 16); }
__device__ __forceinline__ float bf_hi(unsigned u) { return __uint_as_float(u & 0xffff0000u); }
__device__ __forceinline__ float wave_sum(float v) {
#pragma unroll
    for (int o = 1; o < 64; o <<= 1) v += __shfl_xor(v, o);
    return v;
}

#define XB_TMO      128
#define XB_XCNT(j)  (256  + 64 * (j))
#define XB_XSUB(j)  (1280 + 64 * (j))
#define XB_XGEN(j)  (2304 + 64 * (j))
#define XB_TOP      3328
#define XB_TOPGEN   3392
#define XCD_BAR_WORDS 3456
#define XB_SPIN_CAP (1u << 18)

__device__ __forceinline__ unsigned xb_ld(unsigned* p)              { return __hip_atomic_load(p, __ATOMIC_RELAXED, __HIP_MEMORY_SCOPE_AGENT); }
__device__ __forceinline__ unsigned xb_add(unsigned* p, unsigned v) { return __hip_atomic_fetch_add(p, v, __ATOMIC_RELAXED, __HIP_MEMORY_SCOPE_AGENT); }
__device__ __forceinline__ unsigned xb_xcc_id() { return (unsigned)__builtin_amdgcn_s_getreg((3 << 11) | 20) & 0xFu; }
#define XB_SPIN(cond, bar) do { unsigned _sp = 0; while (cond) { __builtin_amdgcn_s_sleep(1); \
    if ((++_sp & 255u) == 0u) { if (xb_ld(&(bar)[XB_TMO])) break; if (_sp > XB_SPIN_CAP) { atomicAdd(&(bar)[XB_TMO], 1u); break; } } } } while (0)

struct XcdBarrier {
    unsigned* bar; unsigned x;
    volatile LAS unsigned* st;
};

__device__ __forceinline__ XcdBarrier xcd_barrier_post(unsigned* bar, volatile LAS unsigned* st) {
    XcdBarrier b; b.bar = bar; b.x = xb_xcc_id(); b.st = st;
    if (threadIdx.x == 0) (void)xb_add(&bar[XB_XCNT(b.x)], 1u);
    return b;
}
__device__ __forceinline__ void xcd_barrier_complete(unsigned* bar, unsigned x, unsigned& nloc, unsigned& nx) {
    const unsigned G = gridDim.x * gridDim.y * gridDim.z;
    unsigned sum, cnt, mine, sp = 0u;
    for (;;) {
        sum = 0u; cnt = 0u; mine = 0u;
#pragma unroll
        for (unsigned j = 0; j < 16; ++j) { const unsigned c = xb_ld(&bar[XB_XCNT(j)]); sum += c; cnt += (c > 0u) ? 1u : 0u; mine = (j == x) ? c : mine; }
        if (sum == G) break;
        __builtin_amdgcn_s_sleep(1);
        if ((++sp & 255u) == 0u) { if (xb_ld(&bar[XB_TMO])) break; if (sp > XB_SPIN_CAP) { atomicAdd(&bar[XB_TMO], 1u); break; } }
    }
    nloc = mine > 0u ? mine : 1u; nx = cnt > 0u ? cnt : 1u;
}

__device__ __forceinline__ void xcd_barrier(const XcdBarrier& b) {
    asm volatile("s_waitcnt vmcnt(0)" ::: "memory");
    __syncthreads();
    if (threadIdx.x == 0) {
        unsigned* bar = b.bar;
        __builtin_amdgcn_s_waitcnt(0);
        unsigned nloc = b.st[0], nx = b.st[1];
        if (nloc == 0u) { xcd_barrier_complete(bar, b.x, nloc, nx); b.st[0] = nloc; b.st[1] = nx; }
        const unsigned old = xb_add(&bar[XB_XSUB(b.x)], 1u);
        const unsigned gen = old / nloc;
        if (old + 1u == (gen + 1u) * nloc) {
            __builtin_amdgcn_fence(__ATOMIC_RELEASE, "agent");
            asm volatile("s_waitcnt vmcnt(0)" ::: "memory");
            const unsigned og = xb_add(&bar[XB_TOP], 1u);
            const unsigned tg = og / nx;
            if (og + 1u == (tg + 1u) * nx) xb_add(&bar[XB_TOPGEN], 1u);
            else XB_SPIN(xb_ld(&bar[XB_TOPGEN]) == tg, bar);
            __builtin_amdgcn_fence(__ATOMIC_ACQUIRE, "agent");
            xb_add(&bar[XB_XGEN(b.x)], 1u);
            asm volatile("s_waitcnt vmcnt(0)" ::: "memory");
        } else {
            XB_SPIN(xb_ld(&bar[XB_XGEN(b.x)]) == gen, bar);
            __builtin_amdgcn_fence(__ATOMIC_ACQUIRE, "agent");
            asm volatile("s_waitcnt vmcnt(0)" ::: "memory");
        }
    }
    __syncthreads();
}

__device__ __forceinline__ float dpp_add(float v, const int ctrl_sel) {
    int t;
    if (ctrl_sel == 0) t = __builtin_amdgcn_update_dpp(0, __float_as_int(v), 0xB1, 0xF, 0xF, true);
    else if (ctrl_sel == 1) t = __builtin_amdgcn_update_dpp(0, __float_as_int(v), 0x4E, 0xF, 0xF, true);
    else if (ctrl_sel == 2) t = __builtin_amdgcn_update_dpp(0, __float_as_int(v), 0x141, 0xF, 0xF, true);
    else t = __builtin_amdgcn_update_dpp(0, __float_as_int(v), 0x140, 0xF, 0xF, true);
    return v + __int_as_float(t);
}
__device__ __forceinline__ float wave_sum_fast(float v) {
    v = dpp_add(v, 0); v = dpp_add(v, 1); v = dpp_add(v, 2); v = dpp_add(v, 3);
    { auto rr = __builtin_amdgcn_permlane16_swap(__float_as_uint(v), __float_as_uint(v), false, false); v = __uint_as_float(rr[0]) + __uint_as_float(rr[1]); }
    { auto rr = __builtin_amdgcn_permlane32_swap(__float_as_uint(v), __float_as_uint(v), false, false); v = __uint_as_float(rr[0]) + __uint_as_float(rr[1]); }
    return v;
}

struct Args { const float* in[19]; float* out; unsigned char* ws; float inv_freq[8]; };
enum { I_X = 0, I_META, I_G1, I_WIN, I_QG, I_KG, I_LQ1, I_LK1, I_LQ2, I_LK2, I_SUBLN, I_CW, I_CB, I_CLG, I_CLB, I_WOUT, I_G2, I_WUP, I_WDN };

__device__ __forceinline__ void p0_transpose_item(const float* W, int K, int N, bf16* WT, int out_row0, int n0, int k0, const float* kscale, LAS float* scr, int lane) {
    float tv[32], ts[32];
#pragma unroll
    for (int i = 0; i < 32; ++i) { const int kk = 2 * i + (lane >> 5); tv[i] = W[(size_t)(k0 + kk) * N + n0 + (lane & 31)]; ts[i] = kscale ? kscale[k0 + kk] : 1.0f; }
#pragma unroll
    for (int i = 0; i < 32; ++i) { const int kk = 2 * i + (lane >> 5); scr[kk * 33 + (lane & 31)] = tv[i] * ts[i]; }
    LDS_WAIT(); asm volatile("" ::: "memory");
    const int c = lane & 7;
#pragma unroll
    for (int j = 0; j < 4; ++j) { const int n = (lane >> 3) + 8 * j; const LAS float* s = scr + (8 * c) * 33 + n;
        v4u o; o.x = pk2(s[0 * 33], s[1 * 33]); o.y = pk2(s[2 * 33], s[3 * 33]); o.z = pk2(s[4 * 33], s[5 * 33]); o.w = pk2(s[6 * 33], s[7 * 33]);
        *(v4u*)(WT + (size_t)(out_row0 + n) * K + k0 + 8 * c) = o; }
    LDS_WAIT(); asm volatile("" ::: "memory");
}
__device__ __forceinline__ int win_pcol(int lc) {
    if (lc < 1024) { const int l = lc & 255; return (lc & ~255) + 128 * ((l >> 5) & 1) + 32 * (l >> 6) + (l & 31); }
    if (lc < 1536) return lc;
    if (lc < 2048) { const int ch = lc - 1536; return 1536 + 256 * (ch >> 7) + (ch & 127); }
    const int ch = lc - 2048; return 1536 + 256 * (ch >> 7) + 128 + (ch & 127);
}

__device__ __forceinline__ void p0_prologue(const Args& A, unsigned char* ws, LAS unsigned char* lds, int vcu, int G, int wave, int lane) {
    LAS float* scr = (LAS float*)(lds + wave * 16384);
    const int gw = vcu * NWAVES + wave, NGW = G * NWAVES;
    bf16* Win_t = (bf16*)(ws + WS_WIN); bf16* Wout_t = (bf16*)(ws + WS_WOUT); bf16* Wup_t = (bf16*)(ws + WS_WUP); bf16* Wdn_t = (bf16*)(ws + WS_WDN);
    constexpr int I_IN = (DM / 64) * (DIN / 32), I_OUT = (DM / 64) * (DM / 32), I_UP = (DM / 64) * (DFF / 32), I_DN = (DFF / 64) * (DM / 32);
    constexpr int NITEMS = I_IN + I_OUT + I_UP + I_DN;
    for (int it = gw; it < NITEMS; it += NGW) {
        int r = it;
        if (r < I_IN) { const int nblk = DIN / 32, kb = r / nblk, nb = r % nblk; p0_transpose_item(A.in[I_WIN], DM, DIN, Win_t, win_pcol(32 * nb), 32 * nb, 64 * kb, nullptr, scr, lane); continue; } r -= I_IN;
        if (r < I_OUT) { const int nblk = DM / 32, kb = r / nblk, nb = r % nblk; p0_transpose_item(A.in[I_WOUT], DM, DM, Wout_t, 32 * nb, 32 * nb, 64 * kb, nullptr, scr, lane); continue; } r -= I_OUT;
        if (r < I_UP) { const int nblk = DFF / 32, kb = r / nblk, nb = r % nblk; p0_transpose_item(A.in[I_WUP], DM, DFF, Wup_t, 32 * nb, 32 * nb, 64 * kb, A.in[I_G2], scr, lane); continue; } r -= I_UP;
        { const int nblk = DM / 32, kb = r / nblk, nb = r % nblk; p0_transpose_item(A.in[I_WDN], DFF, DM, Wdn_t, 32 * nb, 32 * nb, 64 * kb, nullptr, scr, lane); }
    }
    {
        bf16* XN = (bf16*)(ws + WS_XN);
        f32x4 g[4];
#pragma unroll
        for (int j = 0; j < 4; ++j) g[j] = ((const f32x4*)A.in[I_G1])[lane + 64 * j];
        for (int m0 = gw; m0 < MX + NMETA; m0 += 4 * NGW) {
            f32x4 v[4][4];
#pragma unroll
            for (int q = 0; q < 4; ++q) { const int m = m0 + q * NGW; const bool ok = m < MX + NMETA;
                const float* src = !ok ? A.in[I_X] : (m < MX) ? A.in[I_X] + (size_t)m * DM : A.in[I_META] + (size_t)(m - MX) * DM;
                const f32x4* xr = (const f32x4*)src + lane;
#pragma unroll
                for (int j = 0; j < 4; ++j) v[q][j] = xr[64 * j]; }
#pragma unroll
            for (int q = 0; q < 4; ++q) { const int m = m0 + q * NGW; if (m >= MX + NMETA) continue;
                float s = 0.f;
#pragma unroll
                for (int j = 0; j < 4; ++j) s += (v[q][j].x * v[q][j].x + v[q][j].y * v[q][j].y) + (v[q][j].z * v[q][j].z + v[q][j].w * v[q][j].w);
                const float ms = wave_sum_fast(s) * (1.f / DM) + EPS; const float rs = __builtin_amdgcn_rsqf(ms);
                if (lane == 0 && m < MX) ((float*)(ws + WS_RN))[m] = ms * rs;
                unsigned long long* o8 = (unsigned long long*)(XN + (size_t)m * DM) + lane;
#pragma unroll
                for (int j = 0; j < 4; ++j) { const f32x4 y = v[q][j] * rs * g[j]; o8[64 * j] = (unsigned long long)pk2(y.x, y.y) | ((unsigned long long)pk2(y.z, y.w) << 32); } }
        }
    }
    {
        float* rope = (float*)(ws + WS_ROPE);
        const int pos = gw * 64 + lane;
        if (pos < SEQ + NMETA) {
#pragma unroll
            for (int i = 0; i < 8; ++i) {
                const float angf = (float)pos * A.inv_freq[i];
                const double rev = (double)angf * 0.15915494309189533577; const double fr = rev - __builtin_rint(rev);
                const float f = (float)fr;
                rope[pos * 16 + i] = __builtin_amdgcn_cosf(f); rope[pos * 16 + 8 + i] = __builtin_amdgcn_sinf(f); } }
    }
    {
        bf16* KB = (bf16*)(ws + WS_K); bf16* VB = (bf16*)(ws + WS_V); bf16* GB = (bf16*)(ws + WS_G);
        for (int it = gw; it < NB * 48 * 3; it += NGW) { const int which = it / (NB * 48), r = it % (NB * 48), b = r / 48, rr = r % 48;
            bf16* p = which == 0 ? KB + (size_t)(b * SPAD + 16 + rr) * 512 : which == 1 ? VB + (size_t)(b * SPAD + 16 + rr) * 512 : GB + (size_t)(b * SPAD + rr) * 512;
            ((v4u*)p)[lane] = (v4u){0u, 0u, 0u, 0u}; }
    }
}

__device__ __forceinline__ void meta_proj(const Args& A, unsigned char* ws, LAS unsigned char* lds, int vcu, int wave, int lane) {
    typedef short bf16x8 __attribute__((ext_vector_type(8)));
    const int fr = lane & 15, fq = lane >> 4;
    const int item = vcu * 2 + (wave >> 2), kc = wave & 3;
    const int kind = item < 8 ? 0 : item < 16 ? 1 : 2, g = kind == 2 ? item - 16 : (item & 7);
    const bf16* XNm = (const bf16*)(ws + WS_XN) + (size_t)(MX + fr) * DM + 8 * fq + 256 * kc;
    const bf16* Wt = (const bf16*)(ws + WS_WIN);
    const bf16* brow[4];
#pragma unroll
    for (int nb = 0; nb < 4; ++nb) { const int lc = kind == 0 ? 512 + 64 * g + 16 * nb + fr : kind == 1 ? 1024 + 64 * g + 16 * nb + fr : (nb < 2 ? 1536 + 32 * g + 16 * nb + fr : 2048 + 32 * g + 16 * (nb - 2) + fr);
        brow[nb] = Wt + (size_t)(win_pcol(lc & ~31) + (lc & 31)) * DM + 8 * fq + 256 * kc; }
    bf16x8 af[8], bf[8][4];
#pragma unroll
    for (int ks = 0; ks < 8; ++ks) { af[ks] = *(const bf16x8*)(XNm + 32 * ks);
#pragma unroll
        for (int nb = 0; nb < 4; ++nb) bf[ks][nb] = *(const bf16x8*)(brow[nb] + 32 * ks); }
    asm volatile("" ::: "memory");
    f32x4 acc[4];
#pragma unroll
    for (int nb = 0; nb < 4; ++nb) acc[nb] = (f32x4){0.f, 0.f, 0.f, 0.f};
#pragma unroll
    for (int ks = 0; ks < 8; ++ks)
#pragma unroll
        for (int nb = 0; nb < 4; ++nb) acc[nb] = __builtin_amdgcn_mfma_f32_16x16x32_bf16(bf[ks][nb], af[ks], acc[nb], 0, 0, 0);
    LAS f32x4* red = (LAS f32x4*)lds;
#pragma unroll
    for (int nb = 0; nb < 4; ++nb) red[(wave * 4 + nb) * 64 + lane] = acc[nb];
    __syncthreads();
    if (kc == 0) {
#pragma unroll
        for (int nb = 0; nb < 4; ++nb) acc[nb] = (red[((wave + 0) * 4 + nb) * 64 + lane] + red[((wave + 1) * 4 + nb) * 64 + lane]) + (red[((wave + 2) * 4 + nb) * 64 + lane] + red[((wave + 3) * 4 + nb) * 64 + lane]);
        if (kind == 0) {
            float ss = 0.f;
#pragma unroll
            for (int nb = 0; nb < 4; ++nb) ss += (acc[nb][0] * acc[nb][0] + acc[nb][1] * acc[nb][1]) + (acc[nb][2] * acc[nb][2] + acc[nb][3] * acc[nb][3]);
            ss += __shfl_xor(ss, 16); ss += __shfl_xor(ss, 32);
            const float rs = __builtin_amdgcn_rsqf(ss * (1.0f / 64.0f) + EPS);
#pragma unroll
            for (int nb = 0; nb < 4; ++nb) acc[nb] = acc[nb] * rs * *(const f32x4*)(A.in[I_KG] + 16 * nb + 4 * fq);
            f32x4 p; p[0] = __shfl_xor(acc[0][0], 32); p[1] = __shfl_xor(acc[0][1], 32); p[2] = __shfl_xor(acc[0][2], 32); p[3] = __shfl_xor(acc[0][3], 32);
            const float* rp = (const float*)(ws + WS_ROPE) + fr * 16 + 4 * (fq & 1);
            const f32x4 c = *(const f32x4*)rp, s = *(const f32x4*)(rp + 8);
            const float sg = (fq & 2) ? 1.f : -1.f;
            acc[0] = acc[0] * c + (p * s) * sg;
        }
        if (kind == 2) {
#pragma unroll
            for (int nb = 0; nb < 2; ++nb)
#pragma unroll
                for (int e = 0; e < 4; ++e) acc[nb][e] = acc[nb][e] * __builtin_amdgcn_rcpf(1.0f + __builtin_amdgcn_exp2f(-1.4426950408889634f * acc[nb + 2][e]));
        }
        bf16* dst = kind == 0 ? (bf16*)(ws + WS_K) : kind == 1 ? (bf16*)(ws + WS_V) : (bf16*)(ws + WS_G);
        const int r0 = kind == 2 ? 48 + fr : fr, c0 = (kind == 2 ? 32 * g : 64 * g) + 4 * fq, nnb = kind == 2 ? 2 : 4;
#pragma unroll 1
        for (int b = 0; b < NB; ++b) { bf16* o = dst + (size_t)(b * SPAD + r0) * 512 + c0;
#pragma unroll
            for (int nb = 0; nb < 4; ++nb) if (nb < nnb) *(unsigned long long*)(o + 16 * nb) = (unsigned long long)pk2(acc[nb][0], acc[nb][1]) | ((unsigned long long)pk2(acc[nb][2], acc[nb][3]) << 32); }
    }
    __syncthreads();
}

constexpr int CONV_R = 32;
__device__ __forceinline__ void conv_phase(const Args& A, unsigned char* ws, LAS unsigned char* lds, int vcu, int G, int wave, int lane) {
    LAS float* cbuf = (LAS float*)lds;
    const bf16* GB = (const bf16*)(ws + WS_G); bf16* MIX = (bf16*)(ws + WS_MIX);
    const int cp = (wave & 3) * 64 + lane, half = wave >> 2;
    f32x2 w[CONVW];
#pragma unroll
    for (int j = 0; j < CONVW; ++j) w[j] = *(const f32x2*)(A.in[I_CW] + j * DCONV + 2 * cp);
    const f32x2 bias = *(const f32x2*)(A.in[I_CB] + 2 * cp);
    const f32x4 lg0 = *(const f32x4*)(A.in[I_CLG] + lane * 8), lg1 = *(const f32x4*)(A.in[I_CLG] + lane * 8 + 4), lb0 = *(const f32x4*)(A.in[I_CLB] + lane * 8), lb1 = *(const f32x4*)(A.in[I_CLB] + lane * 8 + 4);
    constexpr int NITEMS = MX / (2 * CONV_R);
    unsigned* cq = (unsigned*)(ws + WS_CTL) + 32;
    volatile LAS unsigned* TK = (volatile LAS unsigned*)(lds + LDS_BYTES - 256 + 64);
    if (wave == 0 && lane == 0) { TK[0] = __hip_atomic_fetch_add(cq, 1u, __ATOMIC_RELAXED, __HIP_MEMORY_SCOPE_AGENT); TK[1] = __hip_atomic_fetch_add(cq, 1u, __ATOMIC_RELAXED, __HIP_MEMORY_SCOPE_AGENT); }
    __syncthreads();
    int it = (int)TK[0], nxt = (int)TK[1];
    __syncthreads();
#define CONV_SRC(item, sub) (GB + (size_t)(((((item) * 2 * CONV_R + half * CONV_R + (sub) * 16) >> 13) * SPAD) + 34 + (((item) * 2 * CONV_R + half * CONV_R + (sub) * 16) & 8191)) * 512 + 2 * cp)
#define CONV_LOAD(buf, item, sub) do { const bf16* gs_ = CONV_SRC(item, sub); _Pragma("unroll") for (int i = 0; i < 46; ++i) buf[i] = *(const unsigned*)(gs_ + (size_t)i * 512); } while (0)
#define CONV_FMA(buf, sub) do { f32x2 acc[16]; _Pragma("unroll") for (int o = 0; o < 16; ++o) acc[o] = bias; \
        _Pragma("unroll") for (int i = 0; i < 46; ++i) { const f32x2 x = {bf_lo(buf[i]), bf_hi(buf[i])}; _Pragma("unroll") for (int o = 0; o < 16; ++o) { const int j = i - o; if (j >= 0 && j < CONVW) acc[o] += w[j] * x; } } \
        _Pragma("unroll") for (int o = 0; o < 16; ++o) *(LAS f32x2*)(cbuf + (half * CONV_R + (sub) * 16 + o) * DCONV + 2 * cp) = acc[o]; } while (0)
    unsigned bufA[46], bufB[46];
    if (it < NITEMS) CONV_LOAD(bufA, it, 0);
#pragma unroll 1
    while (it < NITEMS) {
        if (wave == 0 && lane == 0) TK[0] = __hip_atomic_fetch_add(cq, 1u, __ATOMIC_RELAXED, __HIP_MEMORY_SCOPE_AGENT);
        CONV_LOAD(bufB, it, 1);
        CONV_FMA(bufA, 0);
        if (nxt < NITEMS) CONV_LOAD(bufA, nxt, 0);
        CONV_FMA(bufB, 1);
        __syncthreads();
        const int nn = (int)TK[0];
#pragma unroll
        for (int rr = 0; rr < 8; ++rr) { const int lr = wave * 8 + rr;
            f32x4 x0 = *(const LAS f32x4*)(cbuf + lr * DCONV + lane * 8), x1 = *(const LAS f32x4*)(cbuf + lr * DCONV + lane * 8 + 4);
            const float mu = wave_sum_fast((x0[0] + x0[1]) + (x0[2] + x0[3]) + (x1[0] + x1[1]) + (x1[2] + x1[3])) * (1.f / DCONV);
            x0 = x0 - mu; x1 = x1 - mu;
            const float var = wave_sum_fast((x0[0] * x0[0] + x0[1] * x0[1]) + (x0[2] * x0[2] + x0[3] * x0[3]) + (x1[0] * x1[0] + x1[1] * x1[1]) + (x1[2] * x1[2] + x1[3] * x1[3])) * (1.f / DCONV);
            const float rs = __builtin_amdgcn_rsqf(var + EPS);
            x0 = x0 * rs * lg0 + lb0; x1 = x1 * rs * lg1 + lb1;
#pragma unroll
            for (int e = 0; e < 4; ++e) { x0[e] = x0[e] * __builtin_amdgcn_rcpf(1.0f + __builtin_amdgcn_exp2f(-1.4426950408889634f * x0[e])); x1[e] = x1[e] * __builtin_amdgcn_rcpf(1.0f + __builtin_amdgcn_exp2f(-1.4426950408889634f * x1[e])); }
            *(v4u*)(MIX + (size_t)(it * 2 * CONV_R + lr) * DM + 512 + lane * 8) = pg8::pack8(x0, x1); }
        __syncthreads();
        it = nxt; nxt = nn;
    }
#undef CONV_SRC
#undef CONV_LOAD
#undef CONV_FMA
}

__device__ __forceinline__ void combine_phase(const Args& A, unsigned char* ws, int vcu, int G, int wave, int lane) {
    const bf16* OB = (const bf16*)(ws + WS_O); bf16* MIX = (bf16*)(ws + WS_MIX);
    const float d1 = wave_sum(A.in[I_LQ1][lane] * A.in[I_LK1][lane]), d2 = wave_sum(A.in[I_LQ2][lane] * A.in[I_LK2][lane]);
    const float lam_init = 0.2f;
    const float lam = __builtin_amdgcn_exp2f(d1 * 1.4426950408889634f) - __builtin_amdgcn_exp2f(d2 * 1.4426950408889634f) + lam_init;
    const int h = lane >> 4, q = lane & 15;
    const f32x4 sg0 = *(const f32x4*)(A.in[I_SUBLN] + 8 * q), sg1 = *(const f32x4*)(A.in[I_SUBLN] + 8 * q + 4);
    const int gw = vcu * NWAVES + wave, NGW = G * NWAVES;
    for (int row = gw; row < MX; row += NGW) {
        const bf16* o1 = OB + (size_t)row * 1024 + h * 256 + 8 * q;
        const v4u a = *(const v4u*)o1, bq = *(const v4u*)(o1 + 128);
        f32x4 d0, d1v;
        d0[0] = bf_lo(a.x) - lam * bf_lo(bq.x); d0[1] = bf_hi(a.x) - lam * bf_hi(bq.x); d0[2] = bf_lo(a.y) - lam * bf_lo(bq.y); d0[3] = bf_hi(a.y) - lam * bf_hi(bq.y);
        d1v[0] = bf_lo(a.z) - lam * bf_lo(bq.z); d1v[1] = bf_hi(a.z) - lam * bf_hi(bq.z); d1v[2] = bf_lo(a.w) - lam * bf_lo(bq.w); d1v[3] = bf_hi(a.w) - lam * bf_hi(bq.w);
        float ss = (d0[0] * d0[0] + d0[1] * d0[1]) + (d0[2] * d0[2] + d0[3] * d0[3]) + (d1v[0] * d1v[0] + d1v[1] * d1v[1]) + (d1v[2] * d1v[2] + d1v[3] * d1v[3]);
        ss += __shfl_xor(ss, 1); ss += __shfl_xor(ss, 2); ss += __shfl_xor(ss, 4); ss += __shfl_xor(ss, 8);
        const float rs = __builtin_amdgcn_rsqf(ss * (1.f / 128.f) + EPS) * (1.0f - lam_init);
        *(v4u*)(MIX + (size_t)row * DM + h * 128 + 8 * q) = pg8::pack8(d0 * rs * sg0, d1v * rs * sg1);
    }
}

__global__ void __launch_bounds__(NWAVES * 64, 2) hymba_fwd(Args args) {
    extern __shared__ __attribute__((aligned(16))) unsigned char lds[];
    cg::grid_group grid = cg::this_grid();
    LAS unsigned char* ldsl = (LAS unsigned char*)lds;
    volatile LAS unsigned* MISC = (volatile LAS unsigned*)(ldsl + LDS_BYTES - 256);
    if (threadIdx.x < 32) MISC[threadIdx.x] = 0u;
    __syncthreads();
    const XcdBarrier bar = xcd_barrier_post((unsigned*)(args.ws + WS_CTL) + 4096, MISC + 8);
    const int G = gridDim.x; const int bx = blockIdx.x; const int vcu = (G % 8 == 0) ? (bx % 8) * (G / 8) + bx / 8 : bx;
#ifndef PROBE_DUP
#define PROBE_DUP 0
#endif
#define REP(mask) for (int rep_ = 0; rep_ < (((PROBE_DUP) & (mask)) ? 2 : 1); ++rep_)
#define PHASE_VARS() unsigned char* ws = args.ws; int tid_ = threadIdx.x; asm volatile("" : "+v"(tid_)); const int lane = tid_ & 63, wave = __builtin_amdgcn_readfirstlane(tid_ >> 6); (void)lane; (void)wave

    REP(1) { PHASE_VARS(); p0_prologue(args, ws, ldsl, vcu, G, wave, lane); }
    if (args.ws == nullptr) grid.sync();
    xcd_barrier(bar);

    REP(2) {
        PHASE_VARS();
        if (vcu < 16 && G >= 16) meta_proj(args, ws, ldsl, vcu, wave, lane);
        pg8::Gemm g{(bf16*)(ws + WS_XN), (bf16*)(ws + WS_WIN), MX, DIN, DM}; pg8::StaticOrder S; S.init(MX, DIN, G, bx);
        pg8::EpiInProj E{(bf16*)(ws + WS_Q), (bf16*)(ws + WS_K), (bf16*)(ws + WS_V), (bf16*)(ws + WS_G), args.in[I_QG], args.in[I_KG], (const float*)(ws + WS_ROPE)};
        pg8::gemm_phase<pg8::EpiInProj, pg8::StaticOrder, PG8_ALIGN, PG8_SP2>(ldsl, g, S, E);
    }
    xcd_barrier(bar);

    REP(8) {
        PHASE_VARS();
        static_assert(attn_body::V2_LDS_BYTES <= LDS_BYTES - 256, "attention LDS");
        const float dq1 = wave_sum(args.in[I_LQ1][lane] * args.in[I_LK1][lane]), dq2 = wave_sum(args.in[I_LQ2][lane] * args.in[I_LK2][lane]);
        const float lam_init = 0.2f;
        const float lam = __builtin_amdgcn_exp2f(dq1 * 1.4426950408889634f) - __builtin_amdgcn_exp2f(dq2 * 1.4426950408889634f) + lam_init;
        for (int vv = vcu; vv < 256; vv += G) {
            const int bh = vv >> 4, s = vv & 15;
            const int b = bh >> 2, head = bh & 3;
            const attn_body::bf16* Kh = (const attn_body::bf16*)(ws + WS_K) + (size_t)(b * SPAD) * 512 + head * 128;
            const attn_body::bf16* Vh = (const attn_body::bf16*)(ws + WS_V) + (size_t)(b * SPAD) * 512 + head * 128;
            for (int i = 0; i < 2; ++i) {
                const int qb = i ? 31 - s : s;
                const int q0 = qb * 256;
                const attn_body::bf16* Qu = (const attn_body::bf16*)(ws + WS_Q) + (size_t)(b * SEQ + q0) * 512 + head * 128;
                attn_body::bf16* Mu = (attn_body::bf16*)(ws + WS_MIX) + (size_t)(b * SEQ + q0) * 1024 + head * 128;
                attn_body::attn_unit128<0>(q0, Qu, Kh, Vh, Mu, (char*)lds, lam, 1.0f - lam_init, args.in[I_SUBLN]);
                attn_body::attn_unit128<1>(q0, Qu + 64, Kh + 64, Vh, Mu, (char*)lds, lam, 1.0f - lam_init, args.in[I_SUBLN]);
            }
        }
    }
    REP(4) { PHASE_VARS(); conv_phase(args, ws, ldsl, vcu, G, wave, lane); }
    xcd_barrier(bar);

    REP(32) {
        PHASE_VARS();
        pg8::Gemm g{(bf16*)(ws + WS_MIX), (bf16*)(ws + WS_WOUT), MX, DM, DM}; pg8::StaticOrder S; S.init(MX, DM, G, bx);
        pg8::EpiOut E{(const bf16*)(ws + WS_XN), (const float*)(ws + WS_RN), args.in[I_G1], (bf16*)(ws + WS_H1B), (float*)(ws + WS_SSQ)};
        pg8::gemm_phase<pg8::EpiOut, pg8::StaticOrder, PG8_ALIGN, PG8_SP2>(ldsl, g, S, E);
    }
    xcd_barrier(bar);

    REP(64) {
        PHASE_VARS();
        pg8::Gemm g{(bf16*)(ws + WS_H1B), (bf16*)(ws + WS_WUP), MX, DFF, DM}; pg8::StaticOrder S; S.init(MX, DFF, G, bx);
        pg8::EpiUp E{(bf16*)(ws + WS_HB), (const float*)(ws + WS_SSQ)};
        pg8::gemm_phase<pg8::EpiUp, pg8::StaticOrder, PG8_ALIGN, PG8_SP2>(ldsl, g, S, E);
    }
    xcd_barrier(bar);

    {
        PHASE_VARS();
        pg8::Gemm g{(bf16*)(ws + WS_HB), (bf16*)(ws + WS_WDN), MX, DM, DFF}; pg8::StaticOrder S; S.init(MX, DM, G, bx);
        pg8::EpiDown E{(const bf16*)(ws + WS_H1B), args.out};
        pg8::gemm_phase<pg8::EpiDown, pg8::StaticOrder, PG8_ALIGN, PG8_SP2>(ldsl, g, S, E);
    }
#undef PHASE_VARS
#undef REP
}

extern "C" void kernel_launch(void* const* d_in, const int* in_sizes, int n_in, void* d_out, int out_size, void* d_ws, size_t ws_size, hipStream_t stream) {
    static int grid = 0;
    if (grid == 0) {
        if (n_in != 19 || in_sizes[0] != MX * DM || out_size != MX * DM || ws_size < WS_END) { fprintf(stderr, "kernel_launch: unexpected shapes: n_in %d, in0 %d, out %d, ws %zu (need %zu); nothing launched\n", n_in, n_in > 0 ? in_sizes[0] : -1, out_size, ws_size, (size_t)WS_END); grid = -1; return; }
        int dev = 0, cus = 0, per_cu = 0;
        if (hipGetDevice(&dev) != hipSuccess || hipDeviceGetAttribute(&cus, hipDeviceAttributeMultiprocessorCount, dev) != hipSuccess) { fprintf(stderr, "kernel_launch: device query failed\n"); grid = -1; return; }
        if (hipFuncSetAttribute((const void*)hymba_fwd, hipFuncAttributeMaxDynamicSharedMemorySize, LDS_BYTES) != hipSuccess) { fprintf(stderr, "kernel_launch: hipFuncSetAttribute failed\n"); grid = -1; return; }
        if (hipOccupancyMaxActiveBlocksPerMultiprocessor(&per_cu, (const void*)hymba_fwd, NWAVES * 64, LDS_BYTES) != hipSuccess || per_cu < 1) { fprintf(stderr, "kernel_launch: occupancy query says %d\n", per_cu); per_cu = 1; }
        (void)hipGetLastError();
        grid = cus * 1;
        fprintf(stderr, "kernel_launch: grid %d (occupancy query %d per CU)\n", grid, per_cu);
    }
    if (grid < 0) return;
    Args a{};
    for (int i = 0; i < 19; ++i) a.in[i] = (const float*)d_in[i];
    a.out = (float*)d_out; a.ws = (unsigned char*)d_ws;
    for (int i = 0; i < 8; ++i) a.inv_freq[i] = (float)pow(500000.0, -(double)i / 8.0);
    if (hipMemsetAsync((char*)d_ws + WS_CTL, 0, 65536, stream) != hipSuccess) { fprintf(stderr, "kernel_launch: hipMemsetAsync failed\n"); return; }
    void* kargs[] = {&a};
    const hipError_t le = hipLaunchCooperativeKernel((const void*)hymba_fwd, dim3(grid), dim3(NWAVES * 64), kargs, LDS_BYTES, stream);
    if (le != hipSuccess) fprintf(stderr, "kernel_launch: cooperative launch failed: %s (grid %d)\n", hipGetErrorName(le), grid);
}
```

```cpp
#include <hip/hip_cooperative_groups.h>
#include <cmath>
#include <hip/hip_runtime.h>
#include <cstdio>
#include <cstdint>
namespace pg8 {
#define PG8_LAS __attribute__((address_space(3)))
typedef unsigned short bf16_t;
typedef short bf16x8 __attribute__((ext_vector_type(8)));
typedef float f32x4 __attribute__((ext_vector_type(4)));
typedef unsigned u32x4 __attribute__((ext_vector_type(4)));
constexpr int BM = 256, BK = 64, HALF = 128, HTB = HALF * BK * 2  , STAGE_BYTES = 8 * HTB, NXCD = 8, WGM = 8;

__host__ __device__ __forceinline__ int lds_byte(int r, int c) { const int st = (r >> 4) * 2 + (c >> 5), rr = r & 15, cc = c & 31, ob = rr * 64 + cc * 2; return st * 1024 + (ob ^ (((ob >> 9) & 1) << 5)); }
__host__ __device__ __forceinline__ void stage_rc(int b, int& R, int& C) { const int st = b / 1024, sb = b % 1024, swz = sb ^ (((sb >> 9) & 1) << 5); R = (st >> 1) * 16 + swz / 64; C = (st & 1) * 32 + (swz % 64) / 2; }
__host__ __device__ __forceinline__ int perm32(int rho) { const int n = rho >> 4, i = rho & 15; return 8 * (i >> 2) + 4 * n + (i & 3); }

struct Unit { int pm, pn; };
struct Gemm { const bf16_t* A; const bf16_t* Bt; int M, N, K; };

struct StaticOrder {
    int nM, nN, nwg, G, c, wgm;
    __host__ __device__ void init(int M, int N, int G_, int c_, int wgm_ = WGM) { nM = M / BM; nN = N / BM; nwg = nM * nN; G = G_; c = c_; wgm = wgm_; }
    __host__ __device__ bool next(int i, Unit& u) const {
        const long L = (long)i * G + c; if (L >= nwg) return false;
        int wgid = (int)L; { const int q = nwg / NXCD, r = nwg % NXCD, xcd = wgid % NXCD, off = wgid / NXCD; wgid = (xcd < r ? xcd * (q + 1) : r * (q + 1) + (xcd - r) * q) + off; }
        const int nig = wgm * nN, gid = wgid / nig, fm = gid * wgm, gsz = (nM - fm) < wgm ? (nM - fm) : wgm;
        u.pm = fm + ((wgid % nig) % gsz); u.pn = (wgid % nig) / gsz; return true;
    }
    __device__ __forceinline__ void a_ready(const Unit&) const {}
    __device__ __forceinline__ void done(const Unit&) const {}
};

__device__ __forceinline__ unsigned cvt_pk_bf16(float lo, float hi) { unsigned r; asm volatile("v_cvt_pk_bf16_f32 %0, %1, %2" : "=v"(r) : "v"(lo), "v"(hi)); return r; }
typedef float f32x2 __attribute__((ext_vector_type(2)));
__device__ __forceinline__ f32x2 gelu_pk(f32x2 v) {
    const f32x2 av = __builtin_elementwise_abs(v), d = av * 0.2316418882f + 1.0f;
    f32x2 t; t.x = __builtin_amdgcn_rcpf(d.x); t.y = __builtin_amdgcn_rcpf(d.y);
    f32x2 q = t * 0.5307027145f + (-0.7265760135f); q = q * t + 0.7107068705f; q = q * t + (-0.142248368f); q = q * t + 0.127414796f; q = q * t;
    const f32x2 s = (v * v) * (-0.72134752044f);
    f32x2 e; e.x = __builtin_amdgcn_exp2f(s.x); e.y = __builtin_amdgcn_exp2f(s.y);
    const f32x2 m = v * (q * e), r = v - m;
    f32x2 o; o.x = v.x < 0.f ? m.x : r.x; o.y = v.y < 0.f ? m.y : r.y; return o;
}

template <int ACT  > struct EpiBf16 {
    static constexpr bool PERM = true, AFTER_DRAIN = false; static_assert(ACT == 0 || ACT == 1, "EpiBf16: ACT is 0 (none) or 1 (gelu_pk)");
    bf16_t* O; int ldc; const float* bias; int split_cols; size_t split_stride; float scale0;
    __device__ __forceinline__ void operator()(const f32x4 (&acc)[2][2][4][2], const Unit& u, int wr, int wc, int fr, int fq) const {
        const int row0 = u.pm * BM + wr * 64 + fr; int colt = u.pn * BM; bf16_t* base = O;
        float sc = 1.f; if (split_cols) { const int t = colt / split_cols; base += (size_t)t * split_stride; colt -= t * split_cols; if (t == 0) sc = scale0; }
        const int col0 = colt + wc * 32 + 8 * fq, bcol0 = u.pn * BM + wc * 32 + 8 * fq;
        f32x4 bv[2][2];
#pragma unroll
        for (int bj = 0; bj < 2; ++bj)
#pragma unroll
            for (int n = 0; n < 2; ++n) bv[bj][n] = bias ? *(const f32x4*)(bias + bcol0 + bj * HALF + 4 * n) : (f32x4){0.f, 0.f, 0.f, 0.f};
#pragma unroll
        for (int ai = 0; ai < 2; ++ai)
#pragma unroll
            for (int m = 0; m < 4; ++m) { bf16_t* rowp = base + (size_t)(row0 + ai * HALF + m * 16) * ldc + col0;
#pragma unroll
                for (int bj = 0; bj < 2; ++bj) { f32x4 v0 = acc[ai][bj][m][0] + bv[bj][0], v1 = acc[ai][bj][m][1] + bv[bj][1];
                    if (ACT == 1) { f32x2 a = gelu_pk((f32x2){v0[0], v0[1]}), b = gelu_pk((f32x2){v0[2], v0[3]}), c = gelu_pk((f32x2){v1[0], v1[1]}), d = gelu_pk((f32x2){v1[2], v1[3]});
                        v0 = (f32x4){a.x, a.y, b.x, b.y}; v1 = (f32x4){c.x, c.y, d.x, d.y}; }
                    v0 = v0 * sc; v1 = v1 * sc; u32x4 w; w.x = cvt_pk_bf16(v0[0], v0[1]); w.y = cvt_pk_bf16(v0[2], v0[3]); w.z = cvt_pk_bf16(v1[0], v1[1]); w.w = cvt_pk_bf16(v1[2], v1[3]);
                    *(u32x4*)(rowp + bj * HALF) = w; } }
    }
};

constexpr int XROWS = 32768, SPAD = 8256;
constexpr float QSCALE = 0.125f * 1.4426950408889634f;
__device__ __forceinline__ f32x4 shfl_xor4(f32x4 v, int m) { f32x4 r; r[0] = __shfl_xor(v[0], m); r[1] = __shfl_xor(v[1], m); r[2] = __shfl_xor(v[2], m); r[3] = __shfl_xor(v[3], m); return r; }
__device__ __forceinline__ u32x4 pack8(f32x4 a, f32x4 b) { u32x4 w; w.x = cvt_pk_bf16(a[0], a[1]); w.y = cvt_pk_bf16(a[2], a[3]); w.z = cvt_pk_bf16(b[0], b[1]); w.w = cvt_pk_bf16(b[2], b[3]); return w; }
struct EpiInProj {
    static constexpr bool PERM = true, AFTER_DRAIN = false;
    bf16_t *Q, *K, *V, *G; const float *qg, *kg, *rope;
    __device__ __forceinline__ void operator()(const f32x4 (&acc)[2][2][4][2], const Unit& u, int wr, int wc, int fr, int fq) const {
        const int pn = u.pn; constexpr bool meta = false;
        if (meta && (wr != 0 || pn < 2)) return;
        const int rbase = u.pm * BM + wr * 64 + fr;
        if (pn < 4) {
            const bool isq = pn < 2; const float* gp = isq ? qg : kg; const float osc = isq ? QSCALE : 1.f;
            f32x4 gv[2][2];
#pragma unroll
            for (int bj = 0; bj < 2; ++bj)
#pragma unroll
                for (int n = 0; n < 2; ++n) gv[bj][n] = *(const f32x4*)(gp + 32 * bj + 8 * fq + 4 * n);
            const int colb = (pn & 1) * 256 + wc * 64 + 8 * fq;
            bf16_t* dst = isq ? Q : K;
#pragma unroll
            for (int ai = 0; ai < 2; ++ai) {
                if (meta && ai) continue;
#pragma unroll
              for (int mh = 0; mh < 2; ++mh) {
                if (meta && mh) continue;
                f32x4 rv[2][4];
                if (fq < 2) {
#pragma unroll
                    for (int m2 = 0; m2 < 2; ++m2) { const int row = rbase + ai * HALF + (2 * mh + m2) * 16; const int pos = meta ? (row - XROWS) : ((row & 8191) + 16); const f32x4* rp = (const f32x4*)(rope + (size_t)pos * 16);
#pragma unroll
                        for (int k = 0; k < 4; ++k) rv[m2][k] = rp[k]; }
                }
                asm volatile("" ::: "memory");
#pragma unroll
                for (int m = 2 * mh; m < 2 * mh + 2; ++m) {
                    if (meta && m) continue;
                    const int row = rbase + ai * HALF + m * 16;
                    float ss = 0.f;
#pragma unroll
                    for (int bj = 0; bj < 2; ++bj)
#pragma unroll
                        for (int n = 0; n < 2; ++n) { const f32x4 x = acc[ai][bj][m][n]; ss += (x[0] * x[0] + x[1] * x[1]) + (x[2] * x[2] + x[3] * x[3]); }
                    ss += __shfl_xor(ss, 16); ss += __shfl_xor(ss, 32);
                    const float rs = __builtin_amdgcn_rsqf(ss * (1.0f / 64.0f) + 1e-6f);
                    f32x4 y00 = acc[ai][0][m][0] * rs * gv[0][0], y01 = acc[ai][0][m][1] * rs * gv[0][1], y10 = acc[ai][1][m][0] * rs * gv[1][0], y11 = acc[ai][1][m][1] * rs * gv[1][1];
                    const f32x4 p0 = shfl_xor4(y00, 16), p1 = shfl_xor4(y01, 16);
                    if (fq < 2) {
                        const f32x4 c0 = rv[m & 1][0], c1 = rv[m & 1][1], s0 = rv[m & 1][2], s1 = rv[m & 1][3];
                        const float sg = fq ? 1.f : -1.f;
                        y00 = y00 * c0 + (p0 * s0) * sg; y01 = y01 * c1 + (p1 * s1) * sg;
                    }
                    const u32x4 w0 = pack8(y00 * osc, y01 * osc), w1 = pack8(y10 * osc, y11 * osc);
                    if (!meta) {
                        const size_t orow = isq ? (size_t)row : (size_t)((row >> 13) * SPAD + 64 + (row & 8191));
                        *(u32x4*)(dst + orow * 512 + colb) = w0; *(u32x4*)(dst + orow * 512 + colb + 32) = w1;
                    } else {
#pragma unroll 1
                        for (int b = 0; b < 4; ++b) { const size_t orow = (size_t)(b * SPAD + fr); *(u32x4*)(dst + orow * 512 + colb) = w0; *(u32x4*)(dst + orow * 512 + colb + 32) = w1; }
                    }
                }
              }
            }
        } else if (pn < 6) {
            const int colb = (pn - 4) * 256 + wc * 32 + 8 * fq;
#pragma unroll
            for (int ai = 0; ai < 2; ++ai)
#pragma unroll
                for (int m = 0; m < 4; ++m) {
                    if (meta && (ai || m)) continue;
                    const int row = rbase + ai * HALF + m * 16;
                    const u32x4 w0 = pack8(acc[ai][0][m][0], acc[ai][0][m][1]), w1 = pack8(acc[ai][1][m][0], acc[ai][1][m][1]);
                    if (!meta) {
                        const size_t orow = (size_t)((row >> 13) * SPAD + 64 + (row & 8191));
                        *(u32x4*)(V + orow * 512 + colb) = w0; *(u32x4*)(V + orow * 512 + colb + HALF) = w1;
                    } else {
#pragma unroll 1
                        for (int b = 0; b < 4; ++b) { const size_t orow = (size_t)(b * SPAD + fr); *(u32x4*)(V + orow * 512 + colb) = w0; *(u32x4*)(V + orow * 512 + colb + HALF) = w1; }
                    }
                }
        } else {
            const int colb = (pn - 6) * 128 + wc * 32 + 8 * fq;
#pragma unroll
            for (int ai = 0; ai < 2; ++ai)
#pragma unroll
                for (int m = 0; m < 4; ++m) {
                    if (meta && (ai || m)) continue;
                    const int row = rbase + ai * HALF + m * 16;
                    f32x4 h[2];
#pragma unroll
                    for (int n = 0; n < 2; ++n) { const f32x4 a = acc[ai][0][m][n], g = acc[ai][1][m][n];
#pragma unroll
                        for (int e = 0; e < 4; ++e) h[n][e] = a[e] * __builtin_amdgcn_rcpf(1.0f + __builtin_amdgcn_exp2f(-1.4426950408889634f * g[e])); }
                    const u32x4 w0 = pack8(h[0], h[1]);
                    if (!meta) {
                        const size_t orow = (size_t)((row >> 13) * SPAD + 64 + (row & 8191));
                        *(u32x4*)(G + orow * 512 + colb) = w0;
                    } else {
#pragma unroll 1
                        for (int b = 0; b < 4; ++b) { const size_t orow = (size_t)(b * SPAD + 48 + fr); *(u32x4*)(G + orow * 512 + colb) = w0; }
                    }
                }
        }
    }
};
struct EpiOut {
    static constexpr bool PERM = true, AFTER_DRAIN = false;
    const bf16_t* xn; const float* rn; const float* g1; bf16_t* hb; float* ssq;
    __device__ __forceinline__ void operator()(const f32x4 (&acc)[2][2][4][2], const Unit& u, int wr, int wc, int fr, int fq) const {
        const int rbase = u.pm * BM + wr * 64 + fr, colb = u.pn * BM + wc * 32 + 8 * fq;
        f32x4 ig[2][2];
#pragma unroll
        for (int bj = 0; bj < 2; ++bj)
#pragma unroll
            for (int n = 0; n < 2; ++n) { const f32x4 g = *(const f32x4*)(g1 + colb + bj * HALF + 4 * n);
#pragma unroll
                for (int e = 0; e < 4; ++e) ig[bj][n][e] = __builtin_amdgcn_rcpf(g[e]); }
#pragma unroll
        for (int ai = 0; ai < 2; ++ai) {
            u32x4 xv[4][2]; float rv[4];
#pragma unroll
            for (int m = 0; m < 4; ++m) { const int row = rbase + ai * HALF + m * 16; rv[m] = rn[row];
#pragma unroll
                for (int bj = 0; bj < 2; ++bj) xv[m][bj] = *(const u32x4*)(xn + (size_t)row * 1024 + colb + bj * HALF); }
            asm volatile("" ::: "memory");
#pragma unroll
            for (int m = 0; m < 4; ++m) {
                const int row = rbase + ai * HALF + m * 16; float ss = 0.f;
#pragma unroll
                for (int bj = 0; bj < 2; ++bj) { const size_t off = (size_t)row * 1024 + colb + bj * HALF; const u32x4 w = xv[m][bj];
                    f32x4 x0, x1;
                    x0[0] = __uint_as_float(w.x << 16); x0[1] = __uint_as_float(w.x & 0xffff0000u); x0[2] = __uint_as_float(w.y << 16); x0[3] = __uint_as_float(w.y & 0xffff0000u);
                    x1[0] = __uint_as_float(w.z << 16); x1[1] = __uint_as_float(w.z & 0xffff0000u); x1[2] = __uint_as_float(w.w << 16); x1[3] = __uint_as_float(w.w & 0xffff0000u);
                    const f32x4 h0 = x0 * rv[m] * ig[bj][0] + acc[ai][bj][m][0], h1 = x1 * rv[m] * ig[bj][1] + acc[ai][bj][m][1];
                    *(u32x4*)(hb + off) = pack8(h0, h1);
                    ss += (h0[0] * h0[0] + h0[1] * h0[1]) + (h0[2] * h0[2] + h0[3] * h0[3]) + (h1[0] * h1[0] + h1[1] * h1[1]) + (h1[2] * h1[2] + h1[3] * h1[3]); }
                ss += __shfl_xor(ss, 16); ss += __shfl_xor(ss, 32);
                if (fq == 0) ssq[(size_t)row * 16 + u.pn * 4 + wc] = ss;
            }
        }
    }
};
struct EpiUp {
    static constexpr bool PERM = true, AFTER_DRAIN = false;
    bf16_t* hb; const float* ssq;
    __device__ __forceinline__ void operator()(const f32x4 (&acc)[2][2][4][2], const Unit& u, int wr, int wc, int fr, int fq) const {
        const int rbase = u.pm * BM + wr * 64 + fr, colb = u.pn * BM + wc * 32 + 8 * fq;
#pragma unroll
        for (int ai = 0; ai < 2; ++ai) {
            f32x4 sv[4][4];
#pragma unroll
            for (int m = 0; m < 4; ++m) { const f32x4* sp = (const f32x4*)(ssq + (size_t)(rbase + ai * HALF + m * 16) * 16);
#pragma unroll
                for (int k = 0; k < 4; ++k) sv[m][k] = sp[k]; }
            asm volatile("" ::: "memory");
#pragma unroll
            for (int m = 0; m < 4; ++m) {
                const int row = rbase + ai * HALF + m * 16;
                const f32x4 s0 = sv[m][0], s1 = sv[m][1], s2 = sv[m][2], s3 = sv[m][3];
                const float tot = ((s0[0] + s0[1]) + (s0[2] + s0[3])) + ((s1[0] + s1[1]) + (s1[2] + s1[3])) + ((s2[0] + s2[1]) + (s2[2] + s2[3])) + ((s3[0] + s3[1]) + (s3[2] + s3[3]));
                const float rs = __builtin_amdgcn_rsqf(tot * (1.0f / 1024.0f) + 1e-6f);
#pragma unroll
                for (int bj = 0; bj < 2; ++bj) { f32x4 a0 = acc[ai][bj][m][0] * rs, a1 = acc[ai][bj][m][1] * rs;
#pragma unroll
                    for (int e = 0; e < 4; ++e) { const float p = fmaxf(a0[e], 0.f), q = fmaxf(a1[e], 0.f); a0[e] = p * p; a1[e] = q * q; }
                    *(u32x4*)(hb + (size_t)row * 4096 + colb + bj * HALF) = pack8(a0, a1); }
            }
        }
    }
};
struct EpiDown {
    static constexpr bool PERM = true, AFTER_DRAIN = false;
    const bf16_t* h1; float* out;
    __device__ __forceinline__ void operator()(const f32x4 (&acc)[2][2][4][2], const Unit& u, int wr, int wc, int fr, int fq) const {
        const int rbase = u.pm * BM + wr * 64 + fr, colb = u.pn * BM + wc * 32 + 8 * fq;
        u32x4 hv[2][4][2];
#pragma unroll
        for (int ai = 0; ai < 2; ++ai)
#pragma unroll
            for (int m = 0; m < 4; ++m)
#pragma unroll
                for (int bj = 0; bj < 2; ++bj) hv[ai][m][bj] = *(const u32x4*)(h1 + (size_t)(rbase + ai * HALF + m * 16) * 1024 + colb + bj * HALF);
        asm volatile("" ::: "memory");
#pragma unroll
        for (int ai = 0; ai < 2; ++ai)
#pragma unroll
            for (int m = 0; m < 4; ++m) {
                const int row = rbase + ai * HALF + m * 16;
#pragma unroll
                for (int bj = 0; bj < 2; ++bj) { const size_t off = (size_t)row * 1024 + colb + bj * HALF; const u32x4 w = hv[ai][m][bj];
                    f32x4 r0, r1;
                    r0[0] = __uint_as_float(w.x << 16); r0[1] = __uint_as_float(w.x & 0xffff0000u); r0[2] = __uint_as_float(w.y << 16); r0[3] = __uint_as_float(w.y & 0xffff0000u);
                    r1[0] = __uint_as_float(w.z << 16); r1[1] = __uint_as_float(w.z & 0xffff0000u); r1[2] = __uint_as_float(w.w << 16); r1[3] = __uint_as_float(w.w & 0xffff0000u);
                    *(f32x4*)(out + off) = r0 + acc[ai][bj][m][0]; *(f32x4*)(out + off + 4) = r1 + acc[ai][bj][m][1]; }
            }
    }
};


template <class Epi, class Sched, bool ALIGN_EPI = false, bool SP2 = false>
__device__ __forceinline__ void gemm_phase(PG8_LAS unsigned char* lds, const Gemm g, const Sched& S, const Epi& E) {
    int tid_ = threadIdx.x; asm volatile("" : "+v"(tid_));
    const int tid = tid_, wid = __builtin_amdgcn_readfirstlane(tid >> 6), lane = tid & 63, wr = wid >> 2, wc = wid & 3, fr = lane & 15, fq = lane >> 4;
    const int K = g.K, nt = K / BK;
    unsigned voffA[2], voffB[2];
#pragma unroll
    for (int i = 0; i < 2; ++i) { int R, C; stage_rc(tid * 16 + i * 8192, R, C); const int Rb = Epi::PERM ? ((R & ~31) + perm32(R & 31)) : R;
        voffA[i] = (unsigned)(R * K + C) * 2u; voffB[i] = (unsigned)(Rb * K + C) * 2u; }
    const size_t kstep = (size_t)(BK * 2);
    const size_t hstep = (size_t)HALF * K * 2;
    const size_t tstep = 2 * hstep;
    const unsigned ldsw = (unsigned)wid * 1024u;
    const int aoff = lds_byte(wr * 64 + fr, fq * 8), boff = lds_byte(wc * 32 + fr, fq * 8);
#define PG8_SA(b, h) (((b) * 2 + (h)) * HTB)
#define PG8_SB(b, h) ((4 + (b) * 2 + (h)) * HTB)
#define PG8_STAGE(bufoff, gbase, voff) do { _Pragma("unroll") for (int _i = 0; _i < 2; ++_i) \
        __builtin_amdgcn_global_load_lds((const unsigned*)((const char*)(gbase) + (voff)[_i]), (PG8_LAS unsigned*)(lds + (bufoff) + ldsw + _i * 8192), 16, 0, 0); } while (0)
#define PG8_LDA(dst, b, h) do { _Pragma("unroll") for (int m = 0; m < 4; ++m) _Pragma("unroll") for (int k = 0; k < 2; ++k) dst[m][k] = *(const PG8_LAS bf16x8*)(lds + PG8_SA(b, h) + aoff + m * 2048 + k * 1024); } while (0)
#define PG8_LDB(dst, b, h) do { _Pragma("unroll") for (int n = 0; n < 2; ++n) _Pragma("unroll") for (int k = 0; k < 2; ++k) dst[n][k] = *(const PG8_LAS bf16x8*)(lds + PG8_SB(b, h) + boff + n * 2048 + k * 1024); } while (0)
#define PG8_MMA(ai, bj, At, Bt) do { __builtin_amdgcn_s_setprio(1); _Pragma("unroll") for (int m = 0; m < 4; ++m) _Pragma("unroll") for (int n = 0; n < 2; ++n) _Pragma("unroll") for (int k = 0; k < 2; ++k) \
        acc[ai][bj][m][n] = __builtin_amdgcn_mfma_f32_16x16x32_bf16(Bt[n][k], At[m][k], acc[ai][bj][m][n], 0, 0, 0); __builtin_amdgcn_s_setprio(0); } while (0)
#define PG8_WAIT_V(n) asm volatile("s_waitcnt vmcnt(" #n ")" ::: "memory")
#define PG8_WAIT_L(n) asm volatile("s_waitcnt lgkmcnt(" #n ")" ::: "memory")
#define PG8_BAR __builtin_amdgcn_s_barrier()
#define PG8_SCHED __builtin_amdgcn_sched_barrier(0)
    Unit cur, nxt; int ui = 0;
    if (!S.next(0, cur)) return;
    f32x4 acc[2][2][4][2];
#pragma unroll
    for (int a = 0; a < 2; ++a)
#pragma unroll
        for (int b = 0; b < 2; ++b)
#pragma unroll
            for (int m = 0; m < 4; ++m)
#pragma unroll
                for (int n = 0; n < 2; ++n) acc[a][b][m][n] = (f32x4){0.f, 0.f, 0.f, 0.f};
    bf16x8 At[4][2], B0[2][2], B1[2][2];
    const char* cA = (const char*)g.A + (size_t)cur.pm * tstep; const char* cB = (const char*)g.Bt + (size_t)cur.pn * tstep;
    S.a_ready(cur);
    if constexpr (SP2) {
        PG8_STAGE(PG8_SB(0, 0), cB, voffB); PG8_STAGE(PG8_SB(0, 1), cB + hstep, voffB); PG8_STAGE(PG8_SA(0, 0), cA, voffA); PG8_STAGE(PG8_SA(0, 1), cA + hstep, voffA);
        if (wr == 1) PG8_BAR;
        PG8_WAIT_V(2); PG8_BAR;
        PG8_STAGE(PG8_SB(1, 0), cB + kstep, voffB); PG8_STAGE(PG8_SA(1, 0), cA + kstep, voffA); PG8_STAGE(PG8_SB(1, 1), cB + hstep + kstep, voffB);
        PG8_WAIT_V(6); PG8_BAR;
    } else {
        PG8_STAGE(PG8_SB(0, 0), cB, voffB); PG8_STAGE(PG8_SA(0, 0), cA, voffA); PG8_STAGE(PG8_SB(0, 1), cB + hstep, voffB); PG8_STAGE(PG8_SA(0, 1), cA + hstep, voffA);
        if (wr == 1) PG8_BAR;
        PG8_WAIT_V(4); PG8_BAR;
        PG8_STAGE(PG8_SB(1, 0), cB + kstep, voffB); PG8_STAGE(PG8_SA(1, 0), cA + kstep, voffA); PG8_STAGE(PG8_SB(1, 1), cB + hstep + kstep, voffB);
        PG8_WAIT_V(6); PG8_BAR;
    }
    for (;;) {
        const bool has_next = S.next(ui + 1, nxt);
        const char* nA = has_next ? (const char*)g.A + (size_t)nxt.pm * tstep : cA; const char* nB = has_next ? (const char*)g.Bt + (size_t)nxt.pn * tstep : cB;
        for (int t = 0; t < nt; t += 2) {
            const bool last = (t == nt - 2);
            const char* a1 = cA + (size_t)(t + 1) * kstep;
            const char* a2 = last ? nA : cA + (size_t)(t + 2) * kstep; const char* b2 = last ? nB : cB + (size_t)(t + 2) * kstep;
            const char* a3 = a2 + kstep; const char* b3 = b2 + kstep;
            if (last && has_next) S.a_ready(nxt);
            if constexpr (SP2) {
            PG8_LDB(B0, 0, 0); PG8_LDB(B1, 0, 1); PG8_SCHED; PG8_LDA(At, 0, 0); PG8_STAGE(PG8_SA(1, 1), a1 + hstep, voffA);
            PG8_WAIT_V(8); PG8_WAIT_L(0); PG8_BAR; PG8_MMA(0, 0, At, B0); PG8_MMA(0, 1, At, B1); PG8_BAR; PG8_SCHED;
            PG8_LDA(At, 0, 1); PG8_STAGE(PG8_SB(0, 0), b2, voffB); PG8_STAGE(PG8_SB(0, 1), b2 + hstep, voffB); PG8_STAGE(PG8_SA(0, 0), a2, voffA);
            PG8_WAIT_V(8); PG8_WAIT_L(0); PG8_BAR; PG8_MMA(1, 0, At, B0); PG8_MMA(1, 1, At, B1); PG8_BAR; PG8_SCHED;
            PG8_LDB(B0, 1, 0); PG8_LDB(B1, 1, 1); PG8_SCHED; PG8_LDA(At, 1, 0); PG8_STAGE(PG8_SA(0, 1), a2 + hstep, voffA);
            PG8_WAIT_V(8); PG8_WAIT_L(0); PG8_BAR; PG8_MMA(0, 0, At, B0); PG8_MMA(0, 1, At, B1); PG8_BAR; PG8_SCHED;
            PG8_LDA(At, 1, 1); PG8_STAGE(PG8_SB(1, 0), b3, voffB); PG8_STAGE(PG8_SB(1, 1), b3 + hstep, voffB); PG8_STAGE(PG8_SA(1, 0), a3, voffA);
            PG8_WAIT_V(8); PG8_WAIT_L(0); PG8_BAR; PG8_MMA(1, 0, At, B0); PG8_MMA(1, 1, At, B1); PG8_BAR; PG8_SCHED;
            } else {
            PG8_LDB(B0, 0, 0); PG8_SCHED; PG8_LDA(At, 0, 0); PG8_STAGE(PG8_SA(1, 1), a1 + hstep, voffA);
            PG8_WAIT_L(8); PG8_BAR; PG8_WAIT_L(0); PG8_MMA(0, 0, At, B0); PG8_BAR; PG8_SCHED;
            PG8_LDB(B1, 0, 1); PG8_STAGE(PG8_SB(0, 0), b2, voffB);
            PG8_BAR; PG8_WAIT_L(0); PG8_MMA(0, 1, At, B1); PG8_BAR;
            PG8_LDA(At, 0, 1); PG8_STAGE(PG8_SA(0, 0), a2, voffA);
            PG8_BAR; PG8_WAIT_L(0); PG8_MMA(1, 0, At, B0); PG8_BAR; PG8_SCHED;
            PG8_STAGE(PG8_SB(0, 1), b2 + hstep, voffB);
            PG8_WAIT_V(6); PG8_BAR; PG8_MMA(1, 1, At, B1); PG8_BAR;
            PG8_LDB(B0, 1, 0); PG8_SCHED; PG8_LDA(At, 1, 0); PG8_STAGE(PG8_SA(0, 1), a2 + hstep, voffA);
            PG8_WAIT_L(8); PG8_BAR; PG8_WAIT_L(0); PG8_MMA(0, 0, At, B0); PG8_BAR; PG8_SCHED;
            PG8_LDB(B1, 1, 1); PG8_STAGE(PG8_SB(1, 0), b3, voffB);
            PG8_BAR; PG8_WAIT_L(0); PG8_MMA(0, 1, At, B1); PG8_BAR;
            PG8_LDA(At, 1, 1); PG8_STAGE(PG8_SA(1, 0), a3, voffA);
            PG8_BAR; PG8_WAIT_L(0); PG8_MMA(1, 0, At, B0); PG8_BAR; PG8_SCHED;
            PG8_STAGE(PG8_SB(1, 1), b3 + hstep, voffB);
            PG8_WAIT_V(6); PG8_BAR; PG8_MMA(1, 1, At, B1); PG8_BAR;
            }
        }
        if constexpr (ALIGN_EPI) { if (wr == 0) PG8_BAR; }
        if constexpr (!Epi::AFTER_DRAIN) { E(acc, cur, wr, wc, fr, fq); S.done(cur); }
        if (!has_next) break;
#pragma unroll
        for (int a = 0; a < 2; ++a)
#pragma unroll
            for (int b = 0; b < 2; ++b)
#pragma unroll
                for (int m = 0; m < 4; ++m)
#pragma unroll
                    for (int n = 0; n < 2; ++n) acc[a][b][m][n] = (f32x4){0.f, 0.f, 0.f, 0.f};
        cur = nxt; cA = nA; cB = nB; ++ui;
        if constexpr (ALIGN_EPI) { if (wr == 1) PG8_BAR; }
    }
    PG8_WAIT_V(0);
    if constexpr (!ALIGN_EPI) { if (wr == 0) PG8_BAR; }
    PG8_BAR;
    if constexpr (Epi::AFTER_DRAIN) { E.fused(acc, cur, wr, wc, fr, fq, lds, wid, lane); S.done(cur); }
#undef PG8_SA
#undef PG8_SB
#undef PG8_STAGE
#undef PG8_LDA
#undef PG8_LDB
#undef PG8_MMA
#undef PG8_WAIT_V
#undef PG8_WAIT_L
#undef PG8_BAR
#undef PG8_SCHED
}
}

#ifndef PG8_SP2
#define PG8_SP2 true
#endif
#ifndef PG8_ALIGN
#define PG8_ALIGN true
#endif
#include <hip/hip_bf16.h>
#include <cmath>
namespace attn_body {
using bf16=__hip_bfloat16;
using bf16x8=__attribute__((ext_vector_type(8)))short;
using s16x4=__attribute__((ext_vector_type(4)))short;
using f32x16=__attribute__((ext_vector_type(16)))float;
using u32x4=__attribute__((ext_vector_type(4)))unsigned;
constexpr int SEQ=8192,D=64,PQ=512,PO=1024;
constexpr int NW=8,QBLK=32,QB=QBLK*NW,KVBLK=64,NQB=SEQ/QB;
constexpr int ATTN_UNIT_ROWS=QB;
__device__ __forceinline__ int crow(int r,int hi){return (r&3)+8*(r>>2)+4*hi;}
#define SBAR() __builtin_amdgcn_sched_barrier(0)
__device__ __forceinline__ void cmask(f32x16&p0,f32x16&p1,int jb,int qrel,int hi){
  const float NEG=-INFINITY; int kb=64*jb+4*hi;
  #pragma unroll
  for(int r=0;r<16;++r){int kv=kb+(r&3)+8*(r>>2); if(kv>qrel)p0[r]=NEG; if(kv+32>qrel)p1[r]=NEG;}
}

constexpr int NSLOT=3, SLOTB=8192;
constexpr int LDS_K=0, LDS_V=NSLOT*SLOTB, LDS_WS=2*NSLOT*SLOTB, LDS_OST=LDS_WS+NW*64*4, LDS_BYTES=LDS_OST+NW*4096;
constexpr float C2=0.125f*1.4426950408889634f;
__device__ __forceinline__ void glds16(const void*gsrc,unsigned lds_dst){unsigned keep;
  asm volatile("s_mov_b32 %0, m0\n\ts_mov_b32 m0, %2\n\ts_nop 0\n\tglobal_load_lds_dwordx4 %1, off\n\ts_mov_b32 m0, %0":"=&s"(keep):"v"(gsrc),"s"(lds_dst):"memory");}
__device__ __forceinline__ float max3f(float a,float b,float c){float r;asm("v_max3_f32 %0, %1, %2, %3":"=v"(r):"v"(a),"v"(b),"v"(c));return r;}
__device__ __forceinline__ float max2f(float a,float b){float r;asm("v_max_f32_e32 %0, %1, %2":"=v"(r):"v"(a),"v"(b));return r;}
__device__ __forceinline__ float fadd_s(float a,float b){float r;asm("v_add_f32_e32 %0, %1, %2":"=v"(r):"v"(a),"v"(b));return r;}
__device__ __forceinline__ float fsub_s(float a,float b){float r;asm("v_sub_f32_e32 %0, %1, %2":"=v"(r):"v"(a),"v"(b));return r;}
typedef float f32x2_t __attribute__((ext_vector_type(2))); typedef __bf16 bf16x2_t __attribute__((ext_vector_type(2)));
__device__ __forceinline__ unsigned cvtpk_s(float lo,float hi){f32x2_t v={lo,hi};bf16x2_t b=__builtin_convertvector(v,bf16x2_t);return __builtin_bit_cast(unsigned,b);}
#define WAIT_BAR(N) asm volatile("s_waitcnt vmcnt(" #N ") lgkmcnt(0)\n\ts_barrier":::"memory")

__device__ __forceinline__ void qkt(f32x16&p0,f32x16&p1,const char*Kslot,const bf16x8*qr,const f32x16&negm,int r32,int hi){
  const char*kb=Kslot+hi*1024+r32*16;
  #pragma unroll
  for(int d0=0;d0<4;++d0){
    const bf16x8 b0=*reinterpret_cast<const bf16x8*>(kb+d0*2048);
    const bf16x8 b1=*reinterpret_cast<const bf16x8*>(kb+d0*2048+512);
    if(d0==0){p0=__builtin_amdgcn_mfma_f32_32x32x16_bf16(b0,qr[0],negm,0,0,0);p1=__builtin_amdgcn_mfma_f32_32x32x16_bf16(b1,qr[0],negm,0,0,0);}
    else{p0=__builtin_amdgcn_mfma_f32_32x32x16_bf16(b0,qr[d0],p0,0,0,0);p1=__builtin_amdgcn_mfma_f32_32x32x16_bf16(b1,qr[d0],p1,0,0,0);}}
}
typedef __attribute__((address_space(3))) const char* lds_cptr;
typedef short v4i16_t __attribute__((ext_vector_type(4)));
__device__ __forceinline__ void kload8(bf16x8*kf,lds_cptr kp){
  kf[0]=*(const __attribute__((address_space(3))) bf16x8*)(kp);      kf[1]=*(const __attribute__((address_space(3))) bf16x8*)(kp+512);
  kf[2]=*(const __attribute__((address_space(3))) bf16x8*)(kp+2048); kf[3]=*(const __attribute__((address_space(3))) bf16x8*)(kp+2560);
  kf[4]=*(const __attribute__((address_space(3))) bf16x8*)(kp+4096); kf[5]=*(const __attribute__((address_space(3))) bf16x8*)(kp+4608);
  kf[6]=*(const __attribute__((address_space(3))) bf16x8*)(kp+6144); kf[7]=*(const __attribute__((address_space(3))) bf16x8*)(kp+6656);
}
__device__ __forceinline__ void kload2(bf16x8*kf,lds_cptr kp,int j){ kf[2*j]=*(const __attribute__((address_space(3))) bf16x8*)(kp+j*2048); kf[2*j+1]=*(const __attribute__((address_space(3))) bf16x8*)(kp+j*2048+512); }
__device__ __forceinline__ s16x4 vtr(lds_cptr p){ return __builtin_bit_cast(s16x4,__builtin_amdgcn_ds_read_tr16_b64_v4i16((__attribute__((address_space(3))) v4i16_t*)p)); }
__device__ __forceinline__ float rowmax(const f32x16&p0,const f32x16&p1){
  float a=max3f(p0[0],p0[1],p1[0]),b=max3f(p0[2],p0[3],p1[1]);a=max3f(a,p1[2],p1[3]);
  #pragma unroll
  for(int r=4;r<16;r+=4){a=max3f(a,p0[r],p0[r+1]);b=max3f(b,p0[r+2],p0[r+3]);a=max3f(a,p1[r],p1[r+1]);b=max3f(b,p1[r+2],p1[r+3]);}
  const float m=max2f(a,b);
  auto rr=__builtin_amdgcn_permlane32_swap(__float_as_uint(m),__float_as_uint(m),false,false);
  return max2f(__uint_as_float(rr[0]),__uint_as_float(rr[1]));
}
__device__ __forceinline__ void pv(f32x16*o,int vb,bf16x8 pa0,bf16x8 pa1,bf16x8 pa2,bf16x8 pa3){
  #pragma unroll
  for(int d0=0;d0<2;++d0){s16x4 lo[4],hi[4];
    #pragma unroll
    for(int ks=0;ks<4;++ks){
      asm volatile("ds_read_b64_tr_b16 %0,%1 offset:%c2":"=&v"(lo[ks]):"v"(vb),"i"(d0*4096+ks*1024):"memory");
      asm volatile("ds_read_b64_tr_b16 %0,%1 offset:%c2":"=&v"(hi[ks]):"v"(vb),"i"(d0*4096+ks*1024+512):"memory");}
    asm volatile("s_waitcnt lgkmcnt(0)":::"memory");SBAR();
    #define PK(k) (bf16x8){lo[k][0],lo[k][1],lo[k][2],lo[k][3],hi[k][0],hi[k][1],hi[k][2],hi[k][3]}
    o[d0]=__builtin_amdgcn_mfma_f32_32x32x16_bf16(pa0,PK(0),o[d0],0,0,0);
    o[d0]=__builtin_amdgcn_mfma_f32_32x32x16_bf16(pa1,PK(1),o[d0],0,0,0);
    o[d0]=__builtin_amdgcn_mfma_f32_32x32x16_bf16(pa2,PK(2),o[d0],0,0,0);
    o[d0]=__builtin_amdgcn_mfma_f32_32x32x16_bf16(pa3,PK(3),o[d0],0,0,0);
    #undef PK
  }
}

#ifndef ATTN_STORE16
#define ATTN_STORE16(p,v) (*(u32x4*)(p)=(v))
#endif
template<int THRL> __device__ __forceinline__ void attn_unit(int q0,const bf16*Qu,const bf16*__restrict__ Kh,const bf16*__restrict__ Vh,bf16*Ou,char*shm){
  int tid_=threadIdx.x; asm volatile("":"+v"(tid_)); const int tid=tid_,lane=tid&63,r32=lane&31,hi=lane>>5; const int wid=__builtin_amdgcn_readfirstlane(tid>>6);
  const bf16*Qw=Qu+(long)(wid*QBLK)*PQ;
  const unsigned lds0=(unsigned)(uintptr_t)shm;
  float*wsf=(float*)(shm+LDS_WS)+wid*64;
  const bf16*ksrc=Kh+(long)lane*PQ+wid*8;
  const bf16*vsrc=Vh+(long)(16*(wid&3)+(lane>>2))*PQ+(wid>>2)*32+(lane&3)*8;
  const unsigned kdst=lds0+LDS_K+wid*1024, vdst=lds0+LDS_V+wid*1024;
  #define DMA_K(t,slot) glds16(ksrc+(long)(t)*KVBLK*PQ,(unsigned)__builtin_amdgcn_readfirstlane(kdst+(slot)))
  #define DMA_V(t,slot) glds16(vsrc+(long)(t)*KVBLK*PQ,(unsigned)__builtin_amdgcn_readfirstlane(vdst+(slot)))
  const int vb0=(int)(lds0+LDS_V)+((lane>>4)&1)*32+(lane&3)*8+(4*hi+((lane&15)>>2))*64;
  const char*Kbase=shm+LDS_K; bf16x8 kf[8];
  const lds_cptr shm3=(lds_cptr)shm; const lds_cptr kp0=shm3+LDS_K+hi*1024+r32*16; const lds_cptr vp0=shm3+LDS_V+((lane>>4)&1)*32+(lane&3)*8+(4*hi+((lane&15)>>2))*64;
  const int NT=(q0+QB)/KVBLK+1;
  DMA_K(0,0);DMA_V(0,0);DMA_K(1,SLOTB);
  bf16x8 qr[4];
  #pragma unroll
  for(int d0=0;d0<4;++d0)qr[d0]=*reinterpret_cast<const bf16x8*>(&Qw[(long)r32*PQ+d0*16+hi*8]);
  float mhat=0.f,l_reg=0.f;f32x16 o[2];o[0]=f32x16{};o[1]=f32x16{};f32x16 negm=f32x16{};asm volatile("":"+v"(negm));
  const int qrel=wid*QBLK+r32;
  #define CMASK(P0,P1,t) do{int jb_=(t)-(NT-4); if(jb_>=0)cmask(P0,P1,jb_,qrel,hi);}while(0)
  bool resc=false;
  #define START(P0,P1) do{ const float rm=rowmax(P0,P1); resc=false; \
    { const float dl=rm; mhat=fadd_s(mhat,dl); \
      _Pragma("unroll") for(int r=0;r<16;++r){P0[r]=fsub_s(P0[r],dl);P1[r]=fsub_s(P1[r],dl);} \
      _Pragma("unroll") for(int r=0;r<16;++r)negm[r]=-mhat; asm volatile("":"+v"(negm)); } \
    _Pragma("unroll") for(int r=0;r<16;++r)P0[r]=__builtin_amdgcn_exp2f(P0[r]); }while(0)
  #define RESC() do{ if(resc){ asm volatile("s_waitcnt lgkmcnt(0)":::"memory"); \
      _Pragma("unroll") for(int d_=0;d_<2;++d_) _Pragma("unroll") for(int r=0;r<16;++r)o[d_][r]*=wsf[crow(r,hi)]; } }while(0)
  f32x16 pA0,pA1,pB0,pB1;
  int sl_prev=0,sl_cur=0,sl_next=SLOTB;
  #define ROT() do{sl_prev=sl_cur;sl_cur=sl_next;sl_next=(sl_next==(NSLOT-1)*SLOTB)?0:sl_next+SLOTB;}while(0)
  DMA_K(2,2*SLOTB);
  WAIT_BAR(3);
  qkt(pA0,pA1,Kbase,qr,negm,r32,hi);asm volatile("s_nop 15\n\ts_nop 7":"+v"(pA0),"+v"(pA1));
  { const float NEGI=-INFINITY; _Pragma("unroll") for(int r=8;r<16;++r)pA0[r]=NEGI; _Pragma("unroll") for(int r=0;r<16;++r)pA1[r]=NEGI; }
  START(pA0,pA1);
  _Pragma("unroll") for(int r=0;r<16;++r)pA1[r]=__builtin_amdgcn_exp2f(pA1[r]);
  WAIT_BAR(0);
  DMA_K(3,0);DMA_V(1,SLOTB);
  ROT();
  kload8(kf,kp0+sl_cur);
  WAIT_BAR(2);
  s16x4 vlo[8],vhi[8]; u32x4 pw0,pw1,pw2,pw3;
  #define PKW(P,B) cvtpk_s(P[B],P[B+1])
  #define PAF(k) __builtin_bit_cast(bf16x8,pw##k)
  #define VFR(i) (bf16x8){vlo[i][0],vlo[i][1],vlo[i][2],vlo[i][3],vhi[i][0],vhi[i][1],vhi[i][2],vhi[i][3]}
  #define PIN(x) asm volatile("":"+v"(x))
  #define MX3(a,b,c) __builtin_fmaxf(__builtin_fmaxf((a),(b)),(c))
  #define GAPA(MF,A0,A1,A2,A3,W0,W1,PW) do{ MF; sacc+=A0; sacc+=A1; sacc+=A2; sacc+=A3; PIN(sacc); W0; W1; PIN(PW); SBAR(); }while(0)
  #define EX(v) __builtin_amdgcn_exp2f(v)
  #define GAPB(MF,X,B) do{ MF; X[B]=EX(X[B]); X[B+1]=EX(X[B+1]); X[B+2]=EX(X[B+2]); X[B+3]=EX(X[B+3]); PIN(X); SBAR(); }while(0)
  #define VRD(i) do{ vlo[i]=vtr(vp_+(((i)>>2)*4096+((i)&3)*1024)); vhi[i]=vtr(vp_+(((i)>>2)*4096+((i)&3)*1024+512)); }while(0)
  #define KRD(G,j) do{ if(G){ kload2(kf,kp0+sl_next,j); SBAR(); } }while(0)
  #define STEP(C0,C1,P0,P1,t,GK,GV,GL) do{ SBAR(); \
    const lds_cptr vp_=vp0+sl_prev; \
    VRD(0); SBAR(); float sacc=(P0[0]+P0[1]); \
    GAPA(C0=__builtin_amdgcn_mfma_f32_32x32x16_bf16(kf[0],qr[0],negm,0,0,0), P0[2],P0[3],P0[4],P0[5],     pw0[0]=PKW(P0,0), pw0[1]=PKW(P0,2), pw0); \
    VRD(4); SBAR(); GAPA(C1=__builtin_amdgcn_mfma_f32_32x32x16_bf16(kf[1],qr[0],negm,0,0,0), P0[6],P0[7],P0[8],P0[9],     pw0[2]=PKW(P0,4), pw0[3]=PKW(P0,6), pw0); \
    VRD(1); SBAR(); GAPA(C0=__builtin_amdgcn_mfma_f32_32x32x16_bf16(kf[2],qr[1],C0,0,0,0),   P0[10],P0[11],P0[12],P0[13], pw1[0]=PKW(P0,8), pw1[1]=PKW(P0,10), pw1); \
    VRD(5); SBAR(); GAPA(C1=__builtin_amdgcn_mfma_f32_32x32x16_bf16(kf[3],qr[1],C1,0,0,0),   P0[14],P0[15],P1[0],P1[1],   pw1[2]=PKW(P0,12),pw1[3]=PKW(P0,14), pw1); \
    VRD(2); SBAR(); GAPA(C0=__builtin_amdgcn_mfma_f32_32x32x16_bf16(kf[4],qr[2],C0,0,0,0),   P1[2],P1[3],P1[4],P1[5],     pw2[0]=PKW(P1,0), pw2[1]=PKW(P1,2), pw2); \
    VRD(6); SBAR(); GAPA(C1=__builtin_amdgcn_mfma_f32_32x32x16_bf16(kf[5],qr[2],C1,0,0,0),   P1[6],P1[7],P1[8],P1[9],     pw2[2]=PKW(P1,4), pw2[3]=PKW(P1,6), pw2); \
    VRD(3); SBAR(); GAPA(C0=__builtin_amdgcn_mfma_f32_32x32x16_bf16(kf[6],qr[3],C0,0,0,0),   P1[10],P1[11],P1[12],P1[13], pw3[0]=PKW(P1,8), pw3[1]=PKW(P1,10), pw3); \
    VRD(7); SBAR(); GAPA(C1=__builtin_amdgcn_mfma_f32_32x32x16_bf16(kf[7],qr[3],C1,0,0,0),   P1[14],P1[15],0.f,0.f,       pw3[2]=PKW(P1,12),pw3[3]=PKW(P1,14), pw3); \
    l_reg+=sacc; \
    if(GK){DMA_K((t)+3,sl_cur);} if(GV){DMA_V((t)+1,sl_next);} \
    CMASK(C0,C1,t); \
    { float a=MX3(C0[0],C0[1],C1[0]),b=MX3(C0[2],C0[3],C1[1]); a=MX3(a,C1[2],C1[3]); \
      _Pragma("unroll") for(int r=4;r<16;r+=4){a=MX3(a,C0[r],C0[r+1]);b=MX3(b,C0[r+2],C0[r+3]);a=MX3(a,C1[r],C1[r+1]);b=MX3(b,C1[r+2],C1[r+3]);} \
      float rm=__builtin_fmaxf(a,b); { auto rr=__builtin_amdgcn_permlane32_swap(__float_as_uint(rm),__float_as_uint(rm),false,false); rm=__builtin_fmaxf(__uint_as_float(rr[0]),__uint_as_float(rr[1])); } \
      resc=false; \
      if(__builtin_expect(__any(rm>(float)THRL),0)){ const float dl=__builtin_fmaxf(rm,0.f); mhat+=dl; \
        _Pragma("unroll") for(int r=0;r<16;++r){C0[r]-=dl;C1[r]-=dl;} \
        _Pragma("unroll") for(int r=0;r<16;++r)negm[r]=-mhat; asm volatile("":"+v"(negm)); \
        const float f=__builtin_amdgcn_exp2f(-dl); l_reg*=f; if(hi==0)wsf[r32]=f; resc=true; } } \
    SBAR(); \
    GAPB(o[0]=__builtin_amdgcn_mfma_f32_32x32x16_bf16(PAF(0),VFR(0),o[0],0,0,0), C0,0); \
    GAPB(o[1]=__builtin_amdgcn_mfma_f32_32x32x16_bf16(PAF(0),VFR(4),o[1],0,0,0), C0,4); \
    KRD(GL,0); GAPB(o[0]=__builtin_amdgcn_mfma_f32_32x32x16_bf16(PAF(1),VFR(1),o[0],0,0,0), C0,8); \
    KRD(GL,1); GAPB(o[1]=__builtin_amdgcn_mfma_f32_32x32x16_bf16(PAF(1),VFR(5),o[1],0,0,0), C0,12); \
    KRD(GL,2); GAPB(o[0]=__builtin_amdgcn_mfma_f32_32x32x16_bf16(PAF(2),VFR(2),o[0],0,0,0), C1,0); \
    KRD(GL,3); GAPB(o[1]=__builtin_amdgcn_mfma_f32_32x32x16_bf16(PAF(2),VFR(6),o[1],0,0,0), C1,4); \
    GAPB(o[0]=__builtin_amdgcn_mfma_f32_32x32x16_bf16(PAF(3),VFR(3),o[0],0,0,0), C1,8); \
    GAPB(o[1]=__builtin_amdgcn_mfma_f32_32x32x16_bf16(PAF(3),VFR(7),o[1],0,0,0), C1,12); \
    }while(0)
  int t=1;
  #undef CMASK
  #define CMASK(P0,P1,t) do{}while(0)
  for(;t+5<NT;t+=2){
    STEP(pB0,pB1,pA0,pA1,t,true,true,true);     WAIT_BAR(2); RESC(); ROT();
    STEP(pA0,pA1,pB0,pB1,t+1,true,true,true);   WAIT_BAR(2); RESC(); ROT();
  }
  #undef CMASK
  #define CMASK(P0,P1,t) do{int jb_=(t)-(NT-4); if(jb_>=0)cmask(P0,P1,jb_,qrel,hi);}while(0)
  #define ENDW(tt) do{ if((tt)+3<NT){WAIT_BAR(2);} else if((tt)+2<NT){WAIT_BAR(1);} else {WAIT_BAR(0);} }while(0)
  for(;t+1<NT;t+=2){
    STEP(pB0,pB1,pA0,pA1,t,(t+3<NT),(t+1<NT),(t+1<NT));       ENDW(t);   RESC(); ROT();
    STEP(pA0,pA1,pB0,pB1,t+1,(t+4<NT),(t+2<NT),(t+2<NT));     ENDW(t+1); RESC(); ROT();
  }
  { float sacc=pA0[0]+pA0[1]; _Pragma("unroll") for(int r=2;r<16;++r)sacc+=pA0[r]; _Pragma("unroll") for(int r=0;r<16;++r)sacc+=pA1[r]; l_reg+=sacc;
    pw0=(u32x4){PKW(pA0,0),PKW(pA0,2),PKW(pA0,4),PKW(pA0,6)};pw1=(u32x4){PKW(pA0,8),PKW(pA0,10),PKW(pA0,12),PKW(pA0,14)};pw2=(u32x4){PKW(pA1,0),PKW(pA1,2),PKW(pA1,4),PKW(pA1,6)};pw3=(u32x4){PKW(pA1,8),PKW(pA1,10),PKW(pA1,12),PKW(pA1,14)};
    SBAR(); pv(o,vb0+sl_prev,PAF(0),PAF(1),PAF(2),PAF(3)); }
  #undef PKW
  #undef PAF
  #undef VFR
  #undef PIN
  #undef MX3
  #undef GAPA
  #undef GAPB
  #undef EX
  #undef VRD
  #undef KRD
  #undef STEP
  #undef ENDW
  {auto rr=__builtin_amdgcn_permlane32_swap(__float_as_uint(l_reg),__float_as_uint(l_reg),false,false);l_reg=__uint_as_float(rr[0])+__uint_as_float(rr[1]);}
  if(hi==0)wsf[32+r32]=l_reg;asm volatile("s_waitcnt lgkmcnt(0)":::"memory");
  float rli[16];
  #pragma unroll
  for(int r=0;r<16;++r)rli[r]=__builtin_amdgcn_rcpf(wsf[32+crow(r,hi)]);
  bf16*Ow=Ou+(long)(wid*QBLK)*PO;
  { bf16*stg=(bf16*)(shm+LDS_OST)+wid*2048;
    #pragma unroll
    for(int r=0;r<16;++r){const int orow=crow(r,hi);
      #pragma unroll
      for(int d0=0;d0<2;++d0)stg[orow*64+d0*32+r32]=__float2bfloat16(o[d0][r]*rli[r]);}
    asm volatile("s_waitcnt lgkmcnt(0)":::"memory");
    #pragma unroll
    for(int i=0;i<4;++i){const int row=i*8+(lane>>3),ch=lane&7; const u32x4 v=*(const u32x4*)(stg+row*64+ch*8); ATTN_STORE16(Ow+(long)row*PO+ch*8,v);} }
  asm volatile("s_waitcnt lgkmcnt(0)\n\ts_barrier":::"memory");
  #undef DMA_K
  #undef DMA_V
  #undef CMASK
  #undef START
  #undef RESC
  #undef ROT
}
constexpr int ATTN_LDS_BYTES=LDS_BYTES;
#undef SBAR
#undef WAIT_BAR
typedef float f32x4v __attribute__((ext_vector_type(4)));
constexpr int V2_SLOTV=16384, V2_LDS_K=0, V2_LDS_V=NSLOT*SLOTB, V2_LDS_WS=V2_LDS_V+NSLOT*V2_SLOTV, V2_LDS_OST=V2_LDS_WS+NW*64*4, V2_LDS_BYTES=V2_LDS_OST+NW*8192;
#define SBAR() __builtin_amdgcn_sched_barrier(0)
#define WAIT_BAR(N) asm volatile("s_waitcnt vmcnt(" #N ") lgkmcnt(0)\n\ts_barrier":::"memory")
__device__ __forceinline__ void pv4(f32x16*o,int vb,bf16x8 pa0,bf16x8 pa1,bf16x8 pa2,bf16x8 pa3){
  #pragma unroll
  for(int d0=0;d0<4;++d0){s16x4 lo[4],hi[4];
    #pragma unroll
    for(int ks=0;ks<4;++ks){
      asm volatile("ds_read_b64_tr_b16 %0,%1 offset:%c2":"=&v"(lo[ks]):"v"(vb),"i"(d0*4096+ks*1024):"memory");
      asm volatile("ds_read_b64_tr_b16 %0,%1 offset:%c2":"=&v"(hi[ks]):"v"(vb),"i"(d0*4096+ks*1024+512):"memory");}
    asm volatile("s_waitcnt lgkmcnt(0)":::"memory");SBAR();
    #define PK(k) (bf16x8){lo[k][0],lo[k][1],lo[k][2],lo[k][3],hi[k][0],hi[k][1],hi[k][2],hi[k][3]}
    o[d0]=__builtin_amdgcn_mfma_f32_32x32x16_bf16(pa0,PK(0),o[d0],0,0,0);
    o[d0]=__builtin_amdgcn_mfma_f32_32x32x16_bf16(pa1,PK(1),o[d0],0,0,0);
    o[d0]=__builtin_amdgcn_mfma_f32_32x32x16_bf16(pa2,PK(2),o[d0],0,0,0);
    o[d0]=__builtin_amdgcn_mfma_f32_32x32x16_bf16(pa3,PK(3),o[d0],0,0,0);
    #undef PK
  }
}
template<int MODE> __device__ __forceinline__ void attn_unit128(int q0,const bf16*Qu,const bf16*__restrict__ Kh,const bf16*__restrict__ Vh,bf16*Ou,char*shm,float lam,float oscale,const float*subg){
  int tid_=threadIdx.x; asm volatile("":"+v"(tid_)); const int tid=tid_,lane=tid&63,r32=lane&31,hi=lane>>5; const int wid=__builtin_amdgcn_readfirstlane(tid>>6);
  const bf16*Qw=Qu+(long)(wid*QBLK)*PQ;
  const unsigned lds0=(unsigned)(uintptr_t)shm;
  float*wsf=(float*)(shm+V2_LDS_WS)+wid*64;
  const bf16*ksrc=Kh+(long)lane*PQ+wid*8;
  const bf16*vsrc=Vh+(long)(16*(wid&3)+(lane>>2))*PQ+(wid>>2)*32+(lane&3)*8;
  const unsigned kdst=lds0+V2_LDS_K+wid*1024, vdst=lds0+V2_LDS_V+wid*1024;
  #define DMA_K(t,slot) glds16(ksrc+(long)(t)*KVBLK*PQ,(unsigned)__builtin_amdgcn_readfirstlane(kdst+(slot)))
  #define DMA_V(t,slot) do{ glds16(vsrc+(long)(t)*KVBLK*PQ,(unsigned)__builtin_amdgcn_readfirstlane(vdst+2*(slot))); glds16(vsrc+(long)(t)*KVBLK*PQ+64,(unsigned)__builtin_amdgcn_readfirstlane(vdst+2*(slot)+8192)); }while(0)
  const int vb0=(int)(lds0+V2_LDS_V)+((lane>>4)&1)*32+(lane&3)*8+(4*hi+((lane&15)>>2))*64;
  const char*Kbase=shm+V2_LDS_K; bf16x8 kf[8];
  const lds_cptr shm3=(lds_cptr)shm; const lds_cptr kp0=shm3+V2_LDS_K+hi*1024+r32*16; const lds_cptr vp0=shm3+V2_LDS_V+((lane>>4)&1)*32+(lane&3)*8+(4*hi+((lane&15)>>2))*64;
  const int NT=(q0+QB)/KVBLK+1;
  DMA_K(0,0);DMA_V(0,0);DMA_K(1,SLOTB);
  bf16x8 qr[4];
  #pragma unroll
  for(int d0=0;d0<4;++d0)qr[d0]=*reinterpret_cast<const bf16x8*>(&Qw[(long)r32*PQ+d0*16+hi*8]);
  float l_reg=0.f;f32x16 o[4];o[0]=f32x16{};o[1]=f32x16{};o[2]=f32x16{};o[3]=f32x16{};
  const f32x16 zero16=f32x16{};
  const int qrel=wid*QBLK+r32;
  #define CMASK(P0,P1,t) do{int jb_=(t)-(NT-4); if(jb_>=0)cmask(P0,P1,jb_,qrel,hi);}while(0)
  f32x16 pA0,pA1,pB0,pB1;
  int sl_prev=0,sl_cur=0,sl_next=SLOTB;
  #define ROT() do{sl_prev=sl_cur;sl_cur=sl_next;sl_next=(sl_next==(NSLOT-1)*SLOTB)?0:sl_next+SLOTB;}while(0)
  DMA_K(2,2*SLOTB);
  WAIT_BAR(3);
  qkt(pA0,pA1,Kbase,qr,zero16,r32,hi);asm volatile("s_nop 15\n\ts_nop 7":"+v"(pA0),"+v"(pA1));
  { const float NEGI=-INFINITY; _Pragma("unroll") for(int r=8;r<16;++r)pA0[r]=NEGI; _Pragma("unroll") for(int r=0;r<16;++r)pA1[r]=NEGI; }
  _Pragma("unroll") for(int r=0;r<16;++r){pA0[r]=__builtin_amdgcn_exp2f(pA0[r]);pA1[r]=__builtin_amdgcn_exp2f(pA1[r]);}
  WAIT_BAR(0);
  DMA_K(3,0);DMA_V(1,SLOTB);
  ROT();
  kload8(kf,kp0+sl_cur);
  WAIT_BAR(3);
  s16x4 vlo[8],vhi[8]; u32x4 pw0,pw1,pw2,pw3;
  #define PKW(P,B) cvtpk_s(P[B],P[B+1])
  #define PAF(k) __builtin_bit_cast(bf16x8,pw##k)
  #define VFR(i) (bf16x8){vlo[i][0],vlo[i][1],vlo[i][2],vlo[i][3],vhi[i][0],vhi[i][1],vhi[i][2],vhi[i][3]}
  #define PIN(x) asm volatile("":"+v"(x))
  #define GAPA(MF,A0,A1,A2,A3,W0,W1,PW) do{ MF; sacc+=A0; sacc+=A1; sacc+=A2; sacc+=A3; PIN(sacc); W0; W1; PIN(PW); SBAR(); }while(0)
  #define EX(v) __builtin_amdgcn_exp2f(v)
  #define GAPB(MF,X,B) do{ MF; X[B]=EX(X[B]); X[B+1]=EX(X[B+1]); PIN(X); SBAR(); }while(0)
  #define VRD(i) do{ vlo[i]=vtr(vp_+(((i)>>2)*4096+((i)&3)*1024)); vhi[i]=vtr(vp_+(((i)>>2)*4096+((i)&3)*1024+512)); }while(0)
  #define VRD2(i) do{ vlo[i]=vtr(vp_+(8192+((i)>>2)*4096+((i)&3)*1024)); vhi[i]=vtr(vp_+(8192+((i)>>2)*4096+((i)&3)*1024+512)); SBAR(); }while(0)
  #define KRD(G,j) do{ if(G){ kload2(kf,kp0+sl_next,j); SBAR(); } }while(0)
  #define MF32(a,b,c) __builtin_amdgcn_mfma_f32_32x32x16_bf16(a,b,c,0,0,0)
  #define STEP(C0,C1,P0,P1,t,GK,GV,GL) do{ SBAR(); \
    const lds_cptr vp_=vp0+2*sl_prev; \
    VRD(0); SBAR(); float sacc=(P0[0]+P0[1]); \
    GAPA(C0=MF32(kf[0],qr[0],zero16), P0[2],P0[3],P0[4],P0[5],     pw0[0]=PKW(P0,0), pw0[1]=PKW(P0,2), pw0); \
    VRD(4); SBAR(); GAPA(C1=MF32(kf[1],qr[0],zero16), P0[6],P0[7],P0[8],P0[9],     pw0[2]=PKW(P0,4), pw0[3]=PKW(P0,6), pw0); \
    VRD(1); SBAR(); GAPA(C0=MF32(kf[2],qr[1],C0),   P0[10],P0[11],P0[12],P0[13], pw1[0]=PKW(P0,8), pw1[1]=PKW(P0,10), pw1); \
    VRD(5); SBAR(); GAPA(C1=MF32(kf[3],qr[1],C1),   P0[14],P0[15],P1[0],P1[1],   pw1[2]=PKW(P0,12),pw1[3]=PKW(P0,14), pw1); \
    VRD(2); SBAR(); GAPA(C0=MF32(kf[4],qr[2],C0),   P1[2],P1[3],P1[4],P1[5],     pw2[0]=PKW(P1,0), pw2[1]=PKW(P1,2), pw2); \
    VRD(6); SBAR(); GAPA(C1=MF32(kf[5],qr[2],C1),   P1[6],P1[7],P1[8],P1[9],     pw2[2]=PKW(P1,4), pw2[3]=PKW(P1,6), pw2); \
    VRD(3); SBAR(); GAPA(C0=MF32(kf[6],qr[3],C0),   P1[10],P1[11],P1[12],P1[13], pw3[0]=PKW(P1,8), pw3[1]=PKW(P1,10), pw3); \
    VRD(7); SBAR(); GAPA(C1=MF32(kf[7],qr[3],C1),   P1[14],P1[15],0.f,0.f,       pw3[2]=PKW(P1,12),pw3[3]=PKW(P1,14), pw3); \
    l_reg+=sacc; \
    if(GK){DMA_K((t)+3,sl_cur);} if(GV){DMA_V((t)+1,sl_next);} \
    CMASK(C0,C1,t); \
    SBAR(); \
    GAPB(o[0]=MF32(PAF(0),VFR(0),o[0]), C0,0);  VRD2(0); \
    GAPB(o[1]=MF32(PAF(0),VFR(4),o[1]), C0,2);  VRD2(4); \
    KRD(GL,0); GAPB(o[0]=MF32(PAF(1),VFR(1),o[0]), C0,4);  VRD2(1); \
    KRD(GL,1); GAPB(o[1]=MF32(PAF(1),VFR(5),o[1]), C0,6);  VRD2(5); \
    KRD(GL,2); GAPB(o[0]=MF32(PAF(2),VFR(2),o[0]), C0,8);  VRD2(2); \
    KRD(GL,3); GAPB(o[1]=MF32(PAF(2),VFR(6),o[1]), C0,10); VRD2(6); \
    GAPB(o[0]=MF32(PAF(3),VFR(3),o[0]), C0,12); VRD2(3); \
    GAPB(o[1]=MF32(PAF(3),VFR(7),o[1]), C0,14); VRD2(7); \
    GAPB(o[2]=MF32(PAF(0),VFR(0),o[2]), C1,0); \
    GAPB(o[3]=MF32(PAF(0),VFR(4),o[3]), C1,2); \
    GAPB(o[2]=MF32(PAF(1),VFR(1),o[2]), C1,4); \
    GAPB(o[3]=MF32(PAF(1),VFR(5),o[3]), C1,6); \
    GAPB(o[2]=MF32(PAF(2),VFR(2),o[2]), C1,8); \
    GAPB(o[3]=MF32(PAF(2),VFR(6),o[3]), C1,10); \
    GAPB(o[2]=MF32(PAF(3),VFR(3),o[2]), C1,12); \
    GAPB(o[3]=MF32(PAF(3),VFR(7),o[3]), C1,14); \
    }while(0)
  int t=1;
  #undef CMASK
  #define CMASK(P0,P1,t) do{}while(0)
  for(;t+5<NT;t+=2){
    STEP(pB0,pB1,pA0,pA1,t,true,true,true);     WAIT_BAR(3); ROT();
    STEP(pA0,pA1,pB0,pB1,t+1,true,true,true);   WAIT_BAR(3); ROT();
  }
  #undef CMASK
  #define CMASK(P0,P1,t) do{int jb_=(t)-(NT-4); if(jb_>=0)cmask(P0,P1,jb_,qrel,hi);}while(0)
  #define ENDW(tt) do{ if((tt)+3<NT){WAIT_BAR(3);} else if((tt)+2<NT){WAIT_BAR(2);} else {WAIT_BAR(0);} }while(0)
  for(;t+1<NT;t+=2){
    STEP(pB0,pB1,pA0,pA1,t,(t+3<NT),(t+1<NT),(t+1<NT));       ENDW(t);   ROT();
    STEP(pA0,pA1,pB0,pB1,t+1,(t+4<NT),(t+2<NT),(t+2<NT));     ENDW(t+1); ROT();
  }
  { float sacc=pA0[0]+pA0[1]; _Pragma("unroll") for(int r=2;r<16;++r)sacc+=pA0[r]; _Pragma("unroll") for(int r=0;r<16;++r)sacc+=pA1[r]; l_reg+=sacc;
    pw0=(u32x4){PKW(pA0,0),PKW(pA0,2),PKW(pA0,4),PKW(pA0,6)};pw1=(u32x4){PKW(pA0,8),PKW(pA0,10),PKW(pA0,12),PKW(pA0,14)};pw2=(u32x4){PKW(pA1,0),PKW(pA1,2),PKW(pA1,4),PKW(pA1,6)};pw3=(u32x4){PKW(pA1,8),PKW(pA1,10),PKW(pA1,12),PKW(pA1,14)};
    SBAR(); pv4(o,vb0+2*sl_prev,PAF(0),PAF(1),PAF(2),PAF(3)); }
  #undef PKW
  #undef PAF
  #undef VFR
  #undef PIN
  #undef GAPA
  #undef GAPB
  #undef EX
  #undef VRD
  #undef VRD2
  #undef KRD
  #undef MF32
  #undef STEP
  #undef ENDW
  {auto rr=__builtin_amdgcn_permlane32_swap(__float_as_uint(l_reg),__float_as_uint(l_reg),false,false);l_reg=__uint_as_float(rr[0])+__uint_as_float(rr[1]);}
  if(hi==0)wsf[32+r32]=l_reg;asm volatile("s_waitcnt lgkmcnt(0)":::"memory");
  float rli[16];
  #pragma unroll
  for(int r=0;r<16;++r)rli[r]=__builtin_amdgcn_rcpf(wsf[32+crow(r,hi)]);
  { bf16*park=(bf16*)(shm+V2_LDS_OST)+wid*4096;
    if(MODE==0){
      #pragma unroll
      for(int r=0;r<16;++r){const int orow=crow(r,hi);
        #pragma unroll
        for(int d0=0;d0<4;++d0)park[orow*128+d0*32+r32]=__float2bfloat16(o[d0][r]*rli[r]);}
      asm volatile("s_waitcnt lgkmcnt(0)":::"memory");
    } else {
      #pragma unroll
      for(int r=0;r<16;++r){const int orow=crow(r,hi);
        #pragma unroll
        for(int d0=0;d0<4;++d0){const float o1=__bfloat162float(park[orow*128+d0*32+r32]); park[orow*128+d0*32+r32]=__float2bfloat16(o1-lam*(o[d0][r]*rli[r]));}}
      asm volatile("s_waitcnt lgkmcnt(0)":::"memory");
      bf16*Ow=Ou+(long)(wid*QBLK)*PO;
      const int ch=lane&15; const f32x4v g0=*(const f32x4v*)(subg+8*ch), g1=*(const f32x4v*)(subg+8*ch+4);
      #pragma unroll
      for(int i=0;i<8;++i){const int row=i*4+(lane>>4); const u32x4 v=*(const u32x4*)(park+row*128+ch*8);
        float d[8]; d[0]=__uint_as_float(v.x<<16);d[1]=__uint_as_float(v.x&0xffff0000u);d[2]=__uint_as_float(v.y<<16);d[3]=__uint_as_float(v.y&0xffff0000u);d[4]=__uint_as_float(v.z<<16);d[5]=__uint_as_float(v.z&0xffff0000u);d[6]=__uint_as_float(v.w<<16);d[7]=__uint_as_float(v.w&0xffff0000u);
        float ss=(d[0]*d[0]+d[1]*d[1])+(d[2]*d[2]+d[3]*d[3])+(d[4]*d[4]+d[5]*d[5])+(d[6]*d[6]+d[7]*d[7]);
        ss+=__shfl_xor(ss,1);ss+=__shfl_xor(ss,2);ss+=__shfl_xor(ss,4);ss+=__shfl_xor(ss,8);
        const float rs=__builtin_amdgcn_rsqf(ss*(1.0f/128.0f)+1e-6f)*oscale;
        u32x4 w; w.x=cvtpk_s(d[0]*rs*g0[0],d[1]*rs*g0[1]); w.y=cvtpk_s(d[2]*rs*g0[2],d[3]*rs*g0[3]); w.z=cvtpk_s(d[4]*rs*g1[0],d[5]*rs*g1[1]); w.w=cvtpk_s(d[6]*rs*g1[2],d[7]*rs*g1[3]);
        ATTN_STORE16(Ow+(long)row*PO+ch*8,w);}
      asm volatile("s_waitcnt lgkmcnt(0)":::"memory");
    } }
  asm volatile("s_waitcnt lgkmcnt(0)\n\ts_barrier":::"memory");
  #undef DMA_K
  #undef DMA_V
  #undef CMASK
  #undef ROT
}
#undef SBAR
#undef WAIT_BAR

}
namespace cg = cooperative_groups;
constexpr int NWAVES = 8;
constexpr int NB = 4, SEQ = 8192, DM = 1024, NMETA = 16, DIN = 2560, DFF = 4096, DCONV = 512, CONVW = 31;
constexpr int MX = NB * SEQ;
constexpr int MP = MX + 256;
constexpr int SPAD = pg8::SPAD;
constexpr float EPS = 1e-6f;
constexpr size_t MiB = 1u << 20;
constexpr size_t WS_CTL = 0, WS_WIN = 1 * MiB, WS_WOUT = 6 * MiB, WS_WUP = 8 * MiB, WS_WDN = 16 * MiB, WS_ROPE = 24 * MiB, WS_SSQ = 25 * MiB, WS_RN = 27 * MiB,
                 WS_H1B = 28 * MiB, WS_MIX = 92 * MiB, WS_HB = 156 * MiB, WS_XN = 156 * MiB, WS_O = 156 * MiB, WS_Q = 222 * MiB, WS_K = 254 * MiB, WS_V = 287 * MiB, WS_G = 320 * MiB,
                 WS_END = 412 * MiB;
static_assert(WS_XN + (size_t)MP * DM * 2 <= WS_Q && WS_K + (size_t)NB * SPAD * 512 * 2 <= WS_V && WS_G + (size_t)NB * SPAD * 512 * 2 <= WS_HB + (size_t)MX * DFF * 2 && WS_HB + (size_t)MX * DFF * 2 <= WS_END, "d_ws map");
constexpr int RING_BYTES = 131072, LDS_BYTES = 147456;
#ifndef WGM_P1
#define WGM_P1 4
#endif
#ifndef WGM_P4
#define WGM_P4 4
#endif
#ifndef WGM_P35
#define WGM_P35 4
#endif

#define LAS __attribute__((address_space(3)))
typedef unsigned short bf16;
typedef unsigned v4u __attribute__((ext_vector_type(4)));
typedef float f32x4 __attribute__((ext_vector_type(4)));
typedef float f32x2 __attribute__((ext_vector_type(2)));
#define LDS_WAIT() asm volatile("s_waitcnt lgkmcnt(0)" ::: "memory")
__device__ __forceinline__ unsigned pk2(float lo, float hi) { return pg8::cvt_pk_bf16(lo, hi); }
__device__ __forceinline__ float bf_lo(unsigned u) { return __uint_as_float(u << 16); }
__device__ __forceinline__ float bf_hi(unsigned u) { return __uint_as_float(u & 0xffff0000u); }
__device__ __forceinline__ float wave_sum(float v) {
#pragma unroll
    for (int o = 1; o < 64; o <<= 1) v += __shfl_xor(v, o);
    return v;
}

#define XB_TMO      128
#define XB_XCNT(j)  (256  + 64 * (j))
#define XB_XSUB(j)  (1280 + 64 * (j))
#define XB_XGEN(j)  (2304 + 64 * (j))
#define XB_TOP      3328
#define XB_TOPGEN   3392
#define XCD_BAR_WORDS 3456
#define XB_SPIN_CAP (1u << 18)

__device__ __forceinline__ unsigned xb_ld(unsigned* p)              { return __hip_atomic_load(p, __ATOMIC_RELAXED, __HIP_MEMORY_SCOPE_AGENT); }
__device__ __forceinline__ unsigned xb_add(unsigned* p, unsigned v) { return __hip_atomic_fetch_add(p, v, __ATOMIC_RELAXED, __HIP_MEMORY_SCOPE_AGENT); }
__device__ __forceinline__ unsigned xb_xcc_id() { return (unsigned)__builtin_amdgcn_s_getreg((3 << 11) | 20) & 0xFu; }
#define XB_SPIN(cond, bar) do { unsigned _sp = 0; while (cond) { __builtin_amdgcn_s_sleep(1); \
    if ((++_sp & 255u) == 0u) { if (xb_ld(&(bar)[XB_TMO])) break; if (_sp > XB_SPIN_CAP) { atomicAdd(&(bar)[XB_TMO], 1u); break; } } } } while (0)

struct XcdBarrier {
    unsigned* bar; unsigned x;
    volatile LAS unsigned* st;
};

__device__ __forceinline__ XcdBarrier xcd_barrier_post(unsigned* bar, volatile LAS unsigned* st) {
    XcdBarrier b; b.bar = bar; b.x = xb_xcc_id(); b.st = st;
    if (threadIdx.x == 0) (void)xb_add(&bar[XB_XCNT(b.x)], 1u);
    return b;
}
__device__ __forceinline__ void xcd_barrier_complete(unsigned* bar, unsigned x, unsigned& nloc, unsigned& nx) {
    const unsigned G = gridDim.x * gridDim.y * gridDim.z;
    unsigned sum, cnt, mine, sp = 0u;
    for (;;) {
        sum = 0u; cnt = 0u; mine = 0u;
#pragma unroll
        for (unsigned j = 0; j < 16; ++j) { const unsigned c = xb_ld(&bar[XB_XCNT(j)]); sum += c; cnt += (c > 0u) ? 1u : 0u; mine = (j == x) ? c : mine; }
        if (sum == G) break;
        __builtin_amdgcn_s_sleep(1);
        if ((++sp & 255u) == 0u) { if (xb_ld(&bar[XB_TMO])) break; if (sp > XB_SPIN_CAP) { atomicAdd(&bar[XB_TMO], 1u); break; } }
    }
    nloc = mine > 0u ? mine : 1u; nx = cnt > 0u ? cnt : 1u;
}

__device__ __forceinline__ void xcd_barrier(const XcdBarrier& b) {
    asm volatile("s_waitcnt vmcnt(0)" ::: "memory");
    __syncthreads();
    if (threadIdx.x == 0) {
        unsigned* bar = b.bar;
        __builtin_amdgcn_s_waitcnt(0);
        unsigned nloc = b.st[0], nx = b.st[1];
        if (nloc == 0u) { xcd_barrier_complete(bar, b.x, nloc, nx); b.st[0] = nloc; b.st[1] = nx; }
        const unsigned old = xb_add(&bar[XB_XSUB(b.x)], 1u);
        const unsigned gen = old / nloc;
        if (old + 1u == (gen + 1u) * nloc) {
            __builtin_amdgcn_fence(__ATOMIC_RELEASE, "agent");
            asm volatile("s_waitcnt vmcnt(0)" ::: "memory");
            const unsigned og = xb_add(&bar[XB_TOP], 1u);
            const unsigned tg = og / nx;
            if (og + 1u == (tg + 1u) * nx) xb_add(&bar[XB_TOPGEN], 1u);
            else XB_SPIN(xb_ld(&bar[XB_TOPGEN]) == tg, bar);
            __builtin_amdgcn_fence(__ATOMIC_ACQUIRE, "agent");
            xb_add(&bar[XB_XGEN(b.x)], 1u);
            asm volatile("s_waitcnt vmcnt(0)" ::: "memory");
        } else {
            XB_SPIN(xb_ld(&bar[XB_XGEN(b.x)]) == gen, bar);
            __builtin_amdgcn_fence(__ATOMIC_ACQUIRE, "agent");
            asm volatile("s_waitcnt vmcnt(0)" ::: "memory");
        }
    }
    __syncthreads();
}

__device__ __forceinline__ float dpp_add(float v, const int ctrl_sel) {
    int t;
    if (ctrl_sel == 0) t = __builtin_amdgcn_update_dpp(0, __float_as_int(v), 0xB1, 0xF, 0xF, true);
    else if (ctrl_sel == 1) t = __builtin_amdgcn_update_dpp(0, __float_as_int(v), 0x4E, 0xF, 0xF, true);
    else if (ctrl_sel == 2) t = __builtin_amdgcn_update_dpp(0, __float_as_int(v), 0x141, 0xF, 0xF, true);
    else t = __builtin_amdgcn_update_dpp(0, __float_as_int(v), 0x140, 0xF, 0xF, true);
    return v + __int_as_float(t);
}
__device__ __forceinline__ float wave_sum_fast(float v) {
    v = dpp_add(v, 0); v = dpp_add(v, 1); v = dpp_add(v, 2); v = dpp_add(v, 3);
    { auto rr = __builtin_amdgcn_permlane16_swap(__float_as_uint(v), __float_as_uint(v), false, false); v = __uint_as_float(rr[0]) + __uint_as_float(rr[1]); }
    { auto rr = __builtin_amdgcn_permlane32_swap(__float_as_uint(v), __float_as_uint(v), false, false); v = __uint_as_float(rr[0]) + __uint_as_float(rr[1]); }
    return v;
}

struct Args { const float* in[19]; float* out; unsigned char* ws; float inv_freq[8]; };
enum { I_X = 0, I_META, I_G1, I_WIN, I_QG, I_KG, I_LQ1, I_LK1, I_LQ2, I_LK2, I_SUBLN, I_CW, I_CB, I_CLG, I_CLB, I_WOUT, I_G2, I_WUP, I_WDN };

__device__ __forceinline__ void p0_transpose_item(const float* W, int K, int N, bf16* WT, int out_row0, int n0, int k0, const float* kscale, LAS float* scr, int lane) {
    float tv[32], ts[32];
#pragma unroll
    for (int i = 0; i < 32; ++i) { const int kk = 2 * i + (lane >> 5); tv[i] = W[(size_t)(k0 + kk) * N + n0 + (lane & 31)]; ts[i] = kscale ? kscale[k0 + kk] : 1.0f; }
#pragma unroll
    for (int i = 0; i < 32; ++i) { const int kk = 2 * i + (lane >> 5); scr[kk * 33 + (lane & 31)] = tv[i] * ts[i]; }
    LDS_WAIT(); asm volatile("" ::: "memory");
    const int c = lane & 7;
#pragma unroll
    for (int j = 0; j < 4; ++j) { const int n = (lane >> 3) + 8 * j; const LAS float* s = scr + (8 * c) * 33 + n;
        v4u o; o.x = pk2(s[0 * 33], s[1 * 33]); o.y = pk2(s[2 * 33], s[3 * 33]); o.z = pk2(s[4 * 33], s[5 * 33]); o.w = pk2(s[6 * 33], s[7 * 33]);
        *(v4u*)(WT + (size_t)(out_row0 + n) * K + k0 + 8 * c) = o; }
    LDS_WAIT(); asm volatile("" ::: "memory");
}
__device__ __forceinline__ int win_pcol(int lc) {
    if (lc < 1024) { const int l = lc & 255; return (lc & ~255) + 128 * ((l >> 5) & 1) + 32 * (l >> 6) + (l & 31); }
    if (lc < 1536) return lc;
    if (lc < 2048) { const int ch = lc - 1536; return 1536 + 256 * (ch >> 7) + (ch & 127); }
    const int ch = lc - 2048; return 1536 + 256 * (ch >> 7) + 128 + (ch & 127);
}

__device__ __forceinline__ void p0_prologue(const Args& A, unsigned char* ws, LAS unsigned char* lds, int vcu, int G, int wave, int lane) {
    LAS float* scr = (LAS float*)(lds + wave * 16384);
    const int gw = vcu * NWAVES + wave, NGW = G * NWAVES;
    bf16* Win_t = (bf16*)(ws + WS_WIN); bf16* Wout_t = (bf16*)(ws + WS_WOUT); bf16* Wup_t = (bf16*)(ws + WS_WUP); bf16* Wdn_t = (bf16*)(ws + WS_WDN);
    constexpr int I_IN = (DM / 64) * (DIN / 32), I_OUT = (DM / 64) * (DM / 32), I_UP = (DM / 64) * (DFF / 32), I_DN = (DFF / 64) * (DM / 32);
    constexpr int NITEMS = I_IN + I_OUT + I_UP + I_DN;
    for (int it = gw; it < NITEMS; it += NGW) {
        int r = it;
        if (r < I_IN) { const int nblk = DIN / 32, kb = r / nblk, nb = r % nblk; p0_transpose_item(A.in[I_WIN], DM, DIN, Win_t, win_pcol(32 * nb), 32 * nb, 64 * kb, nullptr, scr, lane); continue; } r -= I_IN;
        if (r < I_OUT) { const int nblk = DM / 32, kb = r / nblk, nb = r % nblk; p0_transpose_item(A.in[I_WOUT], DM, DM, Wout_t, 32 * nb, 32 * nb, 64 * kb, nullptr, scr, lane); continue; } r -= I_OUT;
        if (r < I_UP) { const int nblk = DFF / 32, kb = r / nblk, nb = r % nblk; p0_transpose_item(A.in[I_WUP], DM, DFF, Wup_t, 32 * nb, 32 * nb, 64 * kb, A.in[I_G2], scr, lane); continue; } r -= I_UP;
        { const int nblk = DM / 32, kb = r / nblk, nb = r % nblk; p0_transpose_item(A.in[I_WDN], DFF, DM, Wdn_t, 32 * nb, 32 * nb, 64 * kb, nullptr, scr, lane); }
    }
    {
        bf16* XN = (bf16*)(ws + WS_XN);
        f32x4 g[4];
#pragma unroll
        for (int j = 0; j < 4; ++j) g[j] = ((const f32x4*)A.in[I_G1])[lane + 64 * j];
        for (int m0 = gw; m0 < MX + NMETA; m0 += 4 * NGW) {
            f32x4 v[4][4];
#pragma unroll
            for (int q = 0; q < 4; ++q) { const int m = m0 + q * NGW; const bool ok = m < MX + NMETA;
                const float* src = !ok ? A.in[I_X] : (m < MX) ? A.in[I_X] + (size_t)m * DM : A.in[I_META] + (size_t)(m - MX) * DM;
                const f32x4* xr = (const f32x4*)src + lane;
#pragma unroll
                for (int j = 0; j < 4; ++j) v[q][j] = xr[64 * j]; }
#pragma unroll
            for (int q = 0; q < 4; ++q) { const int m = m0 + q * NGW; if (m >= MX + NMETA) continue;
                float s = 0.f;
#pragma unroll
                for (int j = 0; j < 4; ++j) s += (v[q][j].x * v[q][j].x + v[q][j].y * v[q][j].y) + (v[q][j].z * v[q][j].z + v[q][j].w * v[q][j].w);
                const float ms = wave_sum_fast(s) * (1.f / DM) + EPS; const float rs = __builtin_amdgcn_rsqf(ms);
                if (lane == 0 && m < MX) ((float*)(ws + WS_RN))[m] = ms * rs;
                unsigned long long* o8 = (unsigned long long*)(XN + (size_t)m * DM) + lane;
#pragma unroll
                for (int j = 0; j < 4; ++j) { const f32x4 y = v[q][j] * rs * g[j]; o8[64 * j] = (unsigned long long)pk2(y.x, y.y) | ((unsigned long long)pk2(y.z, y.w) << 32); } }
        }
    }
    {
        float* rope = (float*)(ws + WS_ROPE);
        const int pos = gw * 64 + lane;
        if (pos < SEQ + NMETA) {
#pragma unroll
            for (int i = 0; i < 8; ++i) {
                const float angf = (float)pos * A.inv_freq[i];
                const double rev = (double)angf * 0.15915494309189533577; const double fr = rev - __builtin_rint(rev);
                const float f = (float)fr;
                rope[pos * 16 + i] = __builtin_amdgcn_cosf(f); rope[pos * 16 + 8 + i] = __builtin_amdgcn_sinf(f); } }
    }
    {
        bf16* KB = (bf16*)(ws + WS_K); bf16* VB = (bf16*)(ws + WS_V); bf16* GB = (bf16*)(ws + WS_G);
        for (int it = gw; it < NB * 48 * 3; it += NGW) { const int which = it / (NB * 48), r = it % (NB * 48), b = r / 48, rr = r % 48;
            bf16* p = which == 0 ? KB + (size_t)(b * SPAD + 16 + rr) * 512 : which == 1 ? VB + (size_t)(b * SPAD + 16 + rr) * 512 : GB + (size_t)(b * SPAD + rr) * 512;
            ((v4u*)p)[lane] = (v4u){0u, 0u, 0u, 0u}; }
    }
}

__device__ __forceinline__ void meta_proj(const Args& A, unsigned char* ws, LAS unsigned char* lds, int vcu, int wave, int lane) {
    typedef short bf16x8 __attribute__((ext_vector_type(8)));
    const int fr = lane & 15, fq = lane >> 4;
    const int item = vcu * 2 + (wave >> 2), kc = wave & 3;
    const int kind = item < 8 ? 0 : item < 16 ? 1 : 2, g = kind == 2 ? item - 16 : (item & 7);
    const bf16* XNm = (const bf16*)(ws + WS_XN) + (size_t)(MX + fr) * DM + 8 * fq + 256 * kc;
    const bf16* Wt = (const bf16*)(ws + WS_WIN);
    const bf16* brow[4];
#pragma unroll
    for (int nb = 0; nb < 4; ++nb) { const int lc = kind == 0 ? 512 + 64 * g + 16 * nb + fr : kind == 1 ? 1024 + 64 * g + 16 * nb + fr : (nb < 2 ? 1536 + 32 * g + 16 * nb + fr : 2048 + 32 * g + 16 * (nb - 2) + fr);
        brow[nb] = Wt + (size_t)(win_pcol(lc & ~31) + (lc & 31)) * DM + 8 * fq + 256 * kc; }
    bf16x8 af[8], bf[8][4];
#pragma unroll
    for (int ks = 0; ks < 8; ++ks) { af[ks] = *(const bf16x8*)(XNm + 32 * ks);
#pragma unroll
        for (int nb = 0; nb < 4; ++nb) bf[ks][nb] = *(const bf16x8*)(brow[nb] + 32 * ks); }
    asm volatile("" ::: "memory");
    f32x4 acc[4];
#pragma unroll
    for (int nb = 0; nb < 4; ++nb) acc[nb] = (f32x4){0.f, 0.f, 0.f, 0.f};
#pragma unroll
    for (int ks = 0; ks < 8; ++ks)
#pragma unroll
        for (int nb = 0; nb < 4; ++nb) acc[nb] = __builtin_amdgcn_mfma_f32_16x16x32_bf16(bf[ks][nb], af[ks], acc[nb], 0, 0, 0);
    LAS f32x4* red = (LAS f32x4*)lds;
#pragma unroll
    for (int nb = 0; nb < 4; ++nb) red[(wave * 4 + nb) * 64 + lane] = acc[nb];
    __syncthreads();
    if (kc == 0) {
#pragma unroll
        for (int nb = 0; nb < 4; ++nb) acc[nb] = (red[((wave + 0) * 4 + nb) * 64 + lane] + red[((wave + 1) * 4 + nb) * 64 + lane]) + (red[((wave + 2) * 4 + nb) * 64 + lane] + red[((wave + 3) * 4 + nb) * 64 + lane]);
        if (kind == 0) {
            float ss = 0.f;
#pragma unroll
            for (int nb = 0; nb < 4; ++nb) ss += (acc[nb][0] * acc[nb][0] + acc[nb][1] * acc[nb][1]) + (acc[nb][2] * acc[nb][2] + acc[nb][3] * acc[nb][3]);
            ss += __shfl_xor(ss, 16); ss += __shfl_xor(ss, 32);
            const float rs = __builtin_amdgcn_rsqf(ss * (1.0f / 64.0f) + EPS);
#pragma unroll
            for (int nb = 0; nb < 4; ++nb) acc[nb] = acc[nb] * rs * *(const f32x4*)(A.in[I_KG] + 16 * nb + 4 * fq);
            f32x4 p; p[0] = __shfl_xor(acc[0][0], 32); p[1] = __shfl_xor(acc[0][1], 32); p[2] = __shfl_xor(acc[0][2], 32); p[3] = __shfl_xor(acc[0][3], 32);
            const float* rp = (const float*)(ws + WS_ROPE) + fr * 16 + 4 * (fq & 1);
            const f32x4 c = *(const f32x4*)rp, s = *(const f32x4*)(rp + 8);
            const float sg = (fq & 2) ? 1.f : -1.f;
            acc[0] = acc[0] * c + (p * s) * sg;
        }
        if (kind == 2) {
#pragma unroll
            for (int nb = 0; nb < 2; ++nb)
#pragma unroll
                for (int e = 0; e < 4; ++e) acc[nb][e] = acc[nb][e] * __builtin_amdgcn_rcpf(1.0f + __builtin_amdgcn_exp2f(-1.4426950408889634f * acc[nb + 2][e]));
        }
        bf16* dst = kind == 0 ? (bf16*)(ws + WS_K) : kind == 1 ? (bf16*)(ws + WS_V) : (bf16*)(ws + WS_G);
        const int r0 = kind == 2 ? 48 + fr : fr, c0 = (kind == 2 ? 32 * g : 64 * g) + 4 * fq, nnb = kind == 2 ? 2 : 4;
#pragma unroll 1
        for (int b = 0; b < NB; ++b) { bf16* o = dst + (size_t)(b * SPAD + r0) * 512 + c0;
#pragma unroll
            for (int nb = 0; nb < 4; ++nb) if (nb < nnb) *(unsigned long long*)(o + 16 * nb) = (unsigned long long)pk2(acc[nb][0], acc[nb][1]) | ((unsigned long long)pk2(acc[nb][2], acc[nb][3]) << 32); }
    }
    __syncthreads();
}

constexpr int CONV_R = 32;
__device__ __forceinline__ void conv_phase(const Args& A, unsigned char* ws, LAS unsigned char* lds, int vcu, int G, int wave, int lane) {
    LAS float* cbuf = (LAS float*)lds;
    const bf16* GB = (const bf16*)(ws + WS_G); bf16* MIX = (bf16*)(ws + WS_MIX);
    const int cp = (wave & 3) * 64 + lane, half = wave >> 2;
    f32x2 w[CONVW];
#pragma unroll
    for (int j = 0; j < CONVW; ++j) w[j] = *(const f32x2*)(A.in[I_CW] + j * DCONV + 2 * cp);
    const f32x2 bias = *(const f32x2*)(A.in[I_CB] + 2 * cp);
    const f32x4 lg0 = *(const f32x4*)(A.in[I_CLG] + lane * 8), lg1 = *(const f32x4*)(A.in[I_CLG] + lane * 8 + 4), lb0 = *(const f32x4*)(A.in[I_CLB] + lane * 8), lb1 = *(const f32x4*)(A.in[I_CLB] + lane * 8 + 4);
    constexpr int NITEMS = MX / (2 * CONV_R);
    unsigned* cq = (unsigned*)(ws + WS_CTL) + 32;
    volatile LAS unsigned* TK = (volatile LAS unsigned*)(lds + LDS_BYTES - 256 + 64);
    if (wave == 0 && lane == 0) { TK[0] = __hip_atomic_fetch_add(cq, 1u, __ATOMIC_RELAXED, __HIP_MEMORY_SCOPE_AGENT); TK[1] = __hip_atomic_fetch_add(cq, 1u, __ATOMIC_RELAXED, __HIP_MEMORY_SCOPE_AGENT); }
    __syncthreads();
    int it = (int)TK[0], nxt = (int)TK[1];
    __syncthreads();
#define CONV_SRC(item, sub) (GB + (size_t)(((((item) * 2 * CONV_R + half * CONV_R + (sub) * 16) >> 13) * SPAD) + 34 + (((item) * 2 * CONV_R + half * CONV_R + (sub) * 16) & 8191)) * 512 + 2 * cp)
#define CONV_LOAD(buf, item, sub) do { const bf16* gs_ = CONV_SRC(item, sub); _Pragma("unroll") for (int i = 0; i < 46; ++i) buf[i] = *(const unsigned*)(gs_ + (size_t)i * 512); } while (0)
#define CONV_FMA(buf, sub) do { f32x2 acc[16]; _Pragma("unroll") for (int o = 0; o < 16; ++o) acc[o] = bias; \
        _Pragma("unroll") for (int i = 0; i < 46; ++i) { const f32x2 x = {bf_lo(buf[i]), bf_hi(buf[i])}; _Pragma("unroll") for (int o = 0; o < 16; ++o) { const int j = i - o; if (j >= 0 && j < CONVW) acc[o] += w[j] * x; } } \
        _Pragma("unroll") for (int o = 0; o < 16; ++o) *(LAS f32x2*)(cbuf + (half * CONV_R + (sub) * 16 + o) * DCONV + 2 * cp) = acc[o]; } while (0)
    unsigned bufA[46], bufB[46];
    if (it < NITEMS) CONV_LOAD(bufA, it, 0);
#pragma unroll 1
    while (it < NITEMS) {
        if (wave == 0 && lane == 0) TK[0] = __hip_atomic_fetch_add(cq, 1u, __ATOMIC_RELAXED, __HIP_MEMORY_SCOPE_AGENT);
        CONV_LOAD(bufB, it, 1);
        CONV_FMA(bufA, 0);
        if (nxt < NITEMS) CONV_LOAD(bufA, nxt, 0);
        CONV_FMA(bufB, 1);
        __syncthreads();
        const int nn = (int)TK[0];
#pragma unroll
        for (int rr = 0; rr < 8; ++rr) { const int lr = wave * 8 + rr;
            f32x4 x0 = *(const LAS f32x4*)(cbuf + lr * DCONV + lane * 8), x1 = *(const LAS f32x4*)(cbuf + lr * DCONV + lane * 8 + 4);
            const float mu = wave_sum_fast((x0[0] + x0[1]) + (x0[2] + x0[3]) + (x1[0] + x1[1]) + (x1[2] + x1[3])) * (1.f / DCONV);
            x0 = x0 - mu; x1 = x1 - mu;
            const float var = wave_sum_fast((x0[0] * x0[0] + x0[1] * x0[1]) + (x0[2] * x0[2] + x0[3] * x0[3]) + (x1[0] * x1[0] + x1[1] * x1[1]) + (x1[2] * x1[2] + x1[3] * x1[3])) * (1.f / DCONV);
            const float rs = __builtin_amdgcn_rsqf(var + EPS);
            x0 = x0 * rs * lg0 + lb0; x1 = x1 * rs * lg1 + lb1;
#pragma unroll
            for (int e = 0; e < 4; ++e) { x0[e] = x0[e] * __builtin_amdgcn_rcpf(1.0f + __builtin_amdgcn_exp2f(-1.4426950408889634f * x0[e])); x1[e] = x1[e] * __builtin_amdgcn_rcpf(1.0f + __builtin_amdgcn_exp2f(-1.4426950408889634f * x1[e])); }
            *(v4u*)(MIX + (size_t)(it * 2 * CONV_R + lr) * DM + 512 + lane * 8) = pg8::pack8(x0, x1); }
        __syncthreads();
        it = nxt; nxt = nn;
    }
#undef CONV_SRC
#undef CONV_LOAD
#undef CONV_FMA
}

__device__ __forceinline__ void combine_phase(const Args& A, unsigned char* ws, int vcu, int G, int wave, int lane) {
    const bf16* OB = (const bf16*)(ws + WS_O); bf16* MIX = (bf16*)(ws + WS_MIX);
    const float d1 = wave_sum(A.in[I_LQ1][lane] * A.in[I_LK1][lane]), d2 = wave_sum(A.in[I_LQ2][lane] * A.in[I_LK2][lane]);
    const float lam_init = 0.2f;
    const float lam = __builtin_amdgcn_exp2f(d1 * 1.4426950408889634f) - __builtin_amdgcn_exp2f(d2 * 1.4426950408889634f) + lam_init;
    const int h = lane >> 4, q = lane & 15;
    const f32x4 sg0 = *(const f32x4*)(A.in[I_SUBLN] + 8 * q), sg1 = *(const f32x4*)(A.in[I_SUBLN] + 8 * q + 4);
    const int gw = vcu * NWAVES + wave, NGW = G * NWAVES;
    for (int row = gw; row < MX; row += NGW) {
        const bf16* o1 = OB + (size_t)row * 1024 + h * 256 + 8 * q;
        const v4u a = *(const v4u*)o1, bq = *(const v4u*)(o1 + 128);
        f32x4 d0, d1v;
        d0[0] = bf_lo(a.x) - lam * bf_lo(bq.x); d0[1] = bf_hi(a.x) - lam * bf_hi(bq.x); d0[2] = bf_lo(a.y) - lam * bf_lo(bq.y); d0[3] = bf_hi(a.y) - lam * bf_hi(bq.y);
        d1v[0] = bf_lo(a.z) - lam * bf_lo(bq.z); d1v[1] = bf_hi(a.z) - lam * bf_hi(bq.z); d1v[2] = bf_lo(a.w) - lam * bf_lo(bq.w); d1v[3] = bf_hi(a.w) - lam * bf_hi(bq.w);
        float ss = (d0[0] * d0[0] + d0[1] * d0[1]) + (d0[2] * d0[2] + d0[3] * d0[3]) + (d1v[0] * d1v[0] + d1v[1] * d1v[1]) + (d1v[2] * d1v[2] + d1v[3] * d1v[3]);
        ss += __shfl_xor(ss, 1); ss += __shfl_xor(ss, 2); ss += __shfl_xor(ss, 4); ss += __shfl_xor(ss, 8);
        const float rs = __builtin_amdgcn_rsqf(ss * (1.f / 128.f) + EPS) * (1.0f - lam_init);
        *(v4u*)(MIX + (size_t)row * DM + h * 128 + 8 * q) = pg8::pack8(d0 * rs * sg0, d1v * rs * sg1);
    }
}

__global__ void __launch_bounds__(NWAVES * 64, 2) hymba_fwd(Args args) {
    extern __shared__ __attribute__((aligned(16))) unsigned char lds[];
    cg::grid_group grid = cg::this_grid();
    LAS unsigned char* ldsl = (LAS unsigned char*)lds;
    volatile LAS unsigned* MISC = (volatile LAS unsigned*)(ldsl + LDS_BYTES - 256);
    if (threadIdx.x < 32) MISC[threadIdx.x] = 0u;
    __syncthreads();
    const XcdBarrier bar = xcd_barrier_post((unsigned*)(args.ws + WS_CTL) + 4096, MISC + 8);
    const int G = gridDim.x; const int bx = blockIdx.x; const int vcu = (G % 8 == 0) ? (bx % 8) * (G / 8) + bx / 8 : bx;
#ifndef PROBE_DUP
#define PROBE_DUP 0
#endif
#define REP(mask) for (int rep_ = 0; rep_ < (((PROBE_DUP) & (mask)) ? 2 : 1); ++rep_)
#define PHASE_VARS() unsigned char* ws = args.ws; int tid_ = threadIdx.x; asm volatile("" : "+v"(tid_)); const int lane = tid_ & 63, wave = __builtin_amdgcn_readfirstlane(tid_ >> 6); (void)lane; (void)wave

    REP(1) { PHASE_VARS(); p0_prologue(args, ws, ldsl, vcu, G, wave, lane); }
    if (args.ws == nullptr) grid.sync();
    xcd_barrier(bar);

    REP(2) {
        PHASE_VARS();
        if (vcu < 16 && G >= 16) meta_proj(args, ws, ldsl, vcu, wave, lane);
        pg8::Gemm g{(bf16*)(ws + WS_XN), (bf16*)(ws + WS_WIN), MX, DIN, DM}; pg8::StaticOrder S; S.init(MX, DIN, G, bx, WGM_P1);
        pg8::EpiInProj E{(bf16*)(ws + WS_Q), (bf16*)(ws + WS_K), (bf16*)(ws + WS_V), (bf16*)(ws + WS_G), args.in[I_QG], args.in[I_KG], (const float*)(ws + WS_ROPE)};
        pg8::gemm_phase<pg8::EpiInProj, pg8::StaticOrder, PG8_ALIGN, PG8_SP2>(ldsl, g, S, E);
    }
    xcd_barrier(bar);

    REP(8) {
        PHASE_VARS();
        static_assert(attn_body::V2_LDS_BYTES <= LDS_BYTES - 256, "attention LDS");
        const float dq1 = wave_sum(args.in[I_LQ1][lane] * args.in[I_LK1][lane]), dq2 = wave_sum(args.in[I_LQ2][lane] * args.in[I_LK2][lane]);
        const float lam_init = 0.2f;
        const float lam = __builtin_amdgcn_exp2f(dq1 * 1.4426950408889634f) - __builtin_amdgcn_exp2f(dq2 * 1.4426950408889634f) + lam_init;
        for (int vv = vcu; vv < 256; vv += G) {
            const int bh = vv >> 4, s = vv & 15;
            const int b = bh >> 2, head = bh & 3;
            const attn_body::bf16* Kh = (const attn_body::bf16*)(ws + WS_K) + (size_t)(b * SPAD) * 512 + head * 128;
            const attn_body::bf16* Vh = (const attn_body::bf16*)(ws + WS_V) + (size_t)(b * SPAD) * 512 + head * 128;
            for (int i = 0; i < 2; ++i) {
                const int qb = i ? 31 - s : s;
                const int q0 = qb * 256;
                const attn_body::bf16* Qu = (const attn_body::bf16*)(ws + WS_Q) + (size_t)(b * SEQ + q0) * 512 + head * 128;
                attn_body::bf16* Mu = (attn_body::bf16*)(ws + WS_MIX) + (size_t)(b * SEQ + q0) * 1024 + head * 128;
                attn_body::attn_unit128<0>(q0, Qu, Kh, Vh, Mu, (char*)lds, lam, 1.0f - lam_init, args.in[I_SUBLN]);
                attn_body::attn_unit128<1>(q0, Qu + 64, Kh + 64, Vh, Mu, (char*)lds, lam, 1.0f - lam_init, args.in[I_SUBLN]);
            }
        }
    }
    REP(4) { PHASE_VARS(); conv_phase(args, ws, ldsl, vcu, G, wave, lane); }
    xcd_barrier(bar);

    REP(32) {
        PHASE_VARS();
        pg8::Gemm g{(bf16*)(ws + WS_MIX), (bf16*)(ws + WS_WOUT), MX, DM, DM}; pg8::StaticOrder S; S.init(MX, DM, G, bx, WGM_P35);
        pg8::EpiOut E{(const bf16*)(ws + WS_XN), (const float*)(ws + WS_RN), args.in[I_G1], (bf16*)(ws + WS_H1B), (float*)(ws + WS_SSQ)};
        pg8::gemm_phase<pg8::EpiOut, pg8::StaticOrder, PG8_ALIGN, PG8_SP2>(ldsl, g, S, E);
    }
    xcd_barrier(bar);

    REP(64) {
        PHASE_VARS();
        pg8::Gemm g{(bf16*)(ws + WS_H1B), (bf16*)(ws + WS_WUP), MX, DFF, DM}; pg8::StaticOrder S; S.init(MX, DFF, G, bx, WGM_P4);
        pg8::EpiUp E{(bf16*)(ws + WS_HB), (const float*)(ws + WS_SSQ)};
        pg8::gemm_phase<pg8::EpiUp, pg8::StaticOrder, PG8_ALIGN, PG8_SP2>(ldsl, g, S, E);
    }
    xcd_barrier(bar);

    {
        PHASE_VARS();
        pg8::Gemm g{(bf16*)(ws + WS_HB), (bf16*)(ws + WS_WDN), MX, DM, DFF}; pg8::StaticOrder S; S.init(MX, DM, G, bx, WGM_P35);
        pg8::EpiDown E{(const bf16*)(ws + WS_H1B), args.out};
        pg8::gemm_phase<pg8::EpiDown, pg8::StaticOrder, PG8_ALIGN, PG8_SP2>(ldsl, g, S, E);
    }
#undef PHASE_VARS
#undef REP
}

extern "C" void kernel_launch(void* const* d_in, const int* in_sizes, int n_in, void* d_out, int out_size, void* d_ws, size_t ws_size, hipStream_t stream) {
    static int grid = 0;
    if (grid == 0) {
        if (n_in != 19 || in_sizes[0] != MX * DM || out_size != MX * DM || ws_size < WS_END) { fprintf(stderr, "kernel_launch: unexpected shapes: n_in %d, in0 %d, out %d, ws %zu (need %zu); nothing launched\n", n_in, n_in > 0 ? in_sizes[0] : -1, out_size, ws_size, (size_t)WS_END); grid = -1; return; }
        int dev = 0, cus = 0, per_cu = 0;
        if (hipGetDevice(&dev) != hipSuccess || hipDeviceGetAttribute(&cus, hipDeviceAttributeMultiprocessorCount, dev) != hipSuccess) { fprintf(stderr, "kernel_launch: device query failed\n"); grid = -1; return; }
        if (hipFuncSetAttribute((const void*)hymba_fwd, hipFuncAttributeMaxDynamicSharedMemorySize, LDS_BYTES) != hipSuccess) { fprintf(stderr, "kernel_launch: hipFuncSetAttribute failed\n"); grid = -1; return; }
        if (hipOccupancyMaxActiveBlocksPerMultiprocessor(&per_cu, (const void*)hymba_fwd, NWAVES * 64, LDS_BYTES) != hipSuccess || per_cu < 1) { fprintf(stderr, "kernel_launch: occupancy query says %d\n", per_cu); per_cu = 1; }
        (void)hipGetLastError();
        grid = cus * 1;
        fprintf(stderr, "kernel_launch: grid %d (occupancy query %d per CU)\n", grid, per_cu);
    }
    if (grid < 0) return;
    Args a{};
    for (int i = 0; i < 19; ++i) a.in[i] = (const float*)d_in[i];
    a.out = (float*)d_out; a.ws = (unsigned char*)d_ws;
    for (int i = 0; i < 8; ++i) a.inv_freq[i] = (float)pow(500000.0, -(double)i / 8.0);
    if (hipMemsetAsync((char*)d_ws + WS_CTL, 0, 65536, stream) != hipSuccess) { fprintf(stderr, "kernel_launch: hipMemsetAsync failed\n"); return; }
    void* kargs[] = {&a};
    const hipError_t le = hipLaunchCooperativeKernel((const void*)hymba_fwd, dim3(grid), dim3(NWAVES * 64), kargs, LDS_BYTES, stream);
    if (le != hipSuccess) fprintf(stderr, "kernel_launch: cooperative launch failed: %s (grid %d)\n", hipGetErrorName(le), grid);
}
```

```cpp
#include <hip/hip_cooperative_groups.h>
#include <cmath>
#include <hip/hip_runtime.h>
#include <cstdio>
#include <cstdint>
namespace pg8 {
#define PG8_LAS __attribute__((address_space(3)))
typedef unsigned short bf16_t;
typedef short bf16x8 __attribute__((ext_vector_type(8)));
typedef float f32x4 __attribute__((ext_vector_type(4)));
typedef unsigned u32x4 __attribute__((ext_vector_type(4)));
constexpr int BM = 256, BK = 64, HALF = 128, HTB = HALF * BK * 2  , STAGE_BYTES = 8 * HTB, NXCD = 8, WGM = 8;

__host__ __device__ __forceinline__ int lds_byte(int r, int c) { const int st = (r >> 4) * 2 + (c >> 5), rr = r & 15, cc = c & 31, ob = rr * 64 + cc * 2; return st * 1024 + (ob ^ (((ob >> 9) & 1) << 5)); }
__host__ __device__ __forceinline__ void stage_rc(int b, int& R, int& C) { const int st = b / 1024, sb = b % 1024, swz = sb ^ (((sb >> 9) & 1) << 5); R = (st >> 1) * 16 + swz / 64; C = (st & 1) * 32 + (swz % 64) / 2; }
__host__ __device__ __forceinline__ int perm32(int rho) { const int n = rho >> 4, i = rho & 15; return 8 * (i >> 2) + 4 * n + (i & 3); }

struct Unit { int pm, pn; };
struct Gemm { const bf16_t* A; const bf16_t* Bt; int M, N, K; };

struct StaticOrder {
    int nM, nN, nwg, G, c, wgm;
    __host__ __device__ void init(int M, int N, int G_, int c_, int wgm_ = WGM) { nM = M / BM; nN = N / BM; nwg = nM * nN; G = G_; c = c_; wgm = wgm_; }
    __host__ __device__ bool next(int i, Unit& u) const {
        const long L = (long)i * G + c; if (L >= nwg) return false;
        int wgid = (int)L; { const int q = nwg / NXCD, r = nwg % NXCD, xcd = wgid % NXCD, off = wgid / NXCD; wgid = (xcd < r ? xcd * (q + 1) : r * (q + 1) + (xcd - r) * q) + off; }
        const int nig = wgm * nN, gid = wgid / nig, fm = gid * wgm, gsz = (nM - fm) < wgm ? (nM - fm) : wgm;
        u.pm = fm + ((wgid % nig) % gsz); u.pn = (wgid % nig) / gsz; return true;
    }
    __device__ __forceinline__ void a_ready(const Unit&) const {}
    __device__ __forceinline__ void done(const Unit&) const {}
};

__device__ __forceinline__ unsigned cvt_pk_bf16(float lo, float hi) { unsigned r; asm volatile("v_cvt_pk_bf16_f32 %0, %1, %2" : "=v"(r) : "v"(lo), "v"(hi)); return r; }
typedef float f32x2 __attribute__((ext_vector_type(2)));
__device__ __forceinline__ f32x2 gelu_pk(f32x2 v) {
    const f32x2 av = __builtin_elementwise_abs(v), d = av * 0.2316418882f + 1.0f;
    f32x2 t; t.x = __builtin_amdgcn_rcpf(d.x); t.y = __builtin_amdgcn_rcpf(d.y);
    f32x2 q = t * 0.5307027145f + (-0.7265760135f); q = q * t + 0.7107068705f; q = q * t + (-0.142248368f); q = q * t + 0.127414796f; q = q * t;
    const f32x2 s = (v * v) * (-0.72134752044f);
    f32x2 e; e.x = __builtin_amdgcn_exp2f(s.x); e.y = __builtin_amdgcn_exp2f(s.y);
    const f32x2 m = v * (q * e), r = v - m;
    f32x2 o; o.x = v.x < 0.f ? m.x : r.x; o.y = v.y < 0.f ? m.y : r.y; return o;
}

template <int ACT  > struct EpiBf16 {
    static constexpr bool PERM = true, AFTER_DRAIN = false; static_assert(ACT == 0 || ACT == 1, "EpiBf16: ACT is 0 (none) or 1 (gelu_pk)");
    bf16_t* O; int ldc; const float* bias; int split_cols; size_t split_stride; float scale0;
    __device__ __forceinline__ void operator()(const f32x4 (&acc)[2][2][4][2], const Unit& u, int wr, int wc, int fr, int fq) const {
        const int row0 = u.pm * BM + wr * 64 + fr; int colt = u.pn * BM; bf16_t* base = O;
        float sc = 1.f; if (split_cols) { const int t = colt / split_cols; base += (size_t)t * split_stride; colt -= t * split_cols; if (t == 0) sc = scale0; }
        const int col0 = colt + wc * 32 + 8 * fq, bcol0 = u.pn * BM + wc * 32 + 8 * fq;
        f32x4 bv[2][2];
#pragma unroll
        for (int bj = 0; bj < 2; ++bj)
#pragma unroll
            for (int n = 0; n < 2; ++n) bv[bj][n] = bias ? *(const f32x4*)(bias + bcol0 + bj * HALF + 4 * n) : (f32x4){0.f, 0.f, 0.f, 0.f};
#pragma unroll
        for (int ai = 0; ai < 2; ++ai)
#pragma unroll
            for (int m = 0; m < 4; ++m) { bf16_t* rowp = base + (size_t)(row0 + ai * HALF + m * 16) * ldc + col0;
#pragma unroll
                for (int bj = 0; bj < 2; ++bj) { f32x4 v0 = acc[ai][bj][m][0] + bv[bj][0], v1 = acc[ai][bj][m][1] + bv[bj][1];
                    if (ACT == 1) { f32x2 a = gelu_pk((f32x2){v0[0], v0[1]}), b = gelu_pk((f32x2){v0[2], v0[3]}), c = gelu_pk((f32x2){v1[0], v1[1]}), d = gelu_pk((f32x2){v1[2], v1[3]});
                        v0 = (f32x4){a.x, a.y, b.x, b.y}; v1 = (f32x4){c.x, c.y, d.x, d.y}; }
                    v0 = v0 * sc; v1 = v1 * sc; u32x4 w; w.x = cvt_pk_bf16(v0[0], v0[1]); w.y = cvt_pk_bf16(v0[2], v0[3]); w.z = cvt_pk_bf16(v1[0], v1[1]); w.w = cvt_pk_bf16(v1[2], v1[3]);
                    *(u32x4*)(rowp + bj * HALF) = w; } }
    }
};

constexpr int XROWS = 32768, SPAD = 8256;
constexpr float QSCALE = 0.125f * 1.4426950408889634f;
__device__ __forceinline__ f32x4 shfl_xor4(f32x4 v, int m) { f32x4 r; r[0] = __shfl_xor(v[0], m); r[1] = __shfl_xor(v[1], m); r[2] = __shfl_xor(v[2], m); r[3] = __shfl_xor(v[3], m); return r; }
__device__ __forceinline__ u32x4 pack8(f32x4 a, f32x4 b) { u32x4 w; w.x = cvt_pk_bf16(a[0], a[1]); w.y = cvt_pk_bf16(a[2], a[3]); w.z = cvt_pk_bf16(b[0], b[1]); w.w = cvt_pk_bf16(b[2], b[3]); return w; }
struct EpiInProj {
    static constexpr bool PERM = true, AFTER_DRAIN = false;
    bf16_t *Q, *K, *V, *G; const float *qg, *kg, *rope;
    __device__ __forceinline__ void operator()(const f32x4 (&acc)[2][2][4][2], const Unit& u, int wr, int wc, int fr, int fq) const {
        const int pn = u.pn; constexpr bool meta = false;
        if (meta && (wr != 0 || pn < 2)) return;
        const int rbase = u.pm * BM + wr * 64 + fr;
        if (pn < 4) {
            const bool isq = pn < 2; const float* gp = isq ? qg : kg; const float osc = isq ? QSCALE : 1.f;
            f32x4 gv[2][2];
#pragma unroll
            for (int bj = 0; bj < 2; ++bj)
#pragma unroll
                for (int n = 0; n < 2; ++n) gv[bj][n] = *(const f32x4*)(gp + 32 * bj + 8 * fq + 4 * n);
            const int colb = (pn & 1) * 256 + wc * 64 + 8 * fq;
            bf16_t* dst = isq ? Q : K;
#pragma unroll
            for (int ai = 0; ai < 2; ++ai) {
                if (meta && ai) continue;
#pragma unroll
              for (int mh = 0; mh < 2; ++mh) {
                if (meta && mh) continue;
                f32x4 rv[2][4];
                if (fq < 2) {
#pragma unroll
                    for (int m2 = 0; m2 < 2; ++m2) { const int row = rbase + ai * HALF + (2 * mh + m2) * 16; const int pos = meta ? (row - XROWS) : ((row & 8191) + 16); const f32x4* rp = (const f32x4*)(rope + (size_t)pos * 16);
#pragma unroll
                        for (int k = 0; k < 4; ++k) rv[m2][k] = rp[k]; }
                }
                asm volatile("" ::: "memory");
#pragma unroll
                for (int m = 2 * mh; m < 2 * mh + 2; ++m) {
                    if (meta && m) continue;
                    const int row = rbase + ai * HALF + m * 16;
                    float ss = 0.f;
#pragma unroll
                    for (int bj = 0; bj < 2; ++bj)
#pragma unroll
                        for (int n = 0; n < 2; ++n) { const f32x4 x = acc[ai][bj][m][n]; ss += (x[0] * x[0] + x[1] * x[1]) + (x[2] * x[2] + x[3] * x[3]); }
                    ss += __shfl_xor(ss, 16); ss += __shfl_xor(ss, 32);
                    const float rs = __builtin_amdgcn_rsqf(ss * (1.0f / 64.0f) + 1e-6f);
                    f32x4 y00 = acc[ai][0][m][0] * rs * gv[0][0], y01 = acc[ai][0][m][1] * rs * gv[0][1], y10 = acc[ai][1][m][0] * rs * gv[1][0], y11 = acc[ai][1][m][1] * rs * gv[1][1];
                    const f32x4 p0 = shfl_xor4(y00, 16), p1 = shfl_xor4(y01, 16);
                    if (fq < 2) {
                        const f32x4 c0 = rv[m & 1][0], c1 = rv[m & 1][1], s0 = rv[m & 1][2], s1 = rv[m & 1][3];
                        const float sg = fq ? 1.f : -1.f;
                        y00 = y00 * c0 + (p0 * s0) * sg; y01 = y01 * c1 + (p1 * s1) * sg;
                    }
                    const u32x4 w0 = pack8(y00 * osc, y01 * osc), w1 = pack8(y10 * osc, y11 * osc);
                    if (!meta) {
                        const size_t orow = isq ? (size_t)row : (size_t)((row >> 13) * SPAD + 64 + (row & 8191));
                        *(u32x4*)(dst + orow * 512 + colb) = w0; *(u32x4*)(dst + orow * 512 + colb + 32) = w1;
                    } else {
#pragma unroll 1
                        for (int b = 0; b < 4; ++b) { const size_t orow = (size_t)(b * SPAD + fr); *(u32x4*)(dst + orow * 512 + colb) = w0; *(u32x4*)(dst + orow * 512 + colb + 32) = w1; }
                    }
                }
              }
            }
        } else if (pn < 6) {
            const int colb = (pn - 4) * 256 + wc * 32 + 8 * fq;
#pragma unroll
            for (int ai = 0; ai < 2; ++ai)
#pragma unroll
                for (int m = 0; m < 4; ++m) {
                    if (meta && (ai || m)) continue;
                    const int row = rbase + ai * HALF + m * 16;
                    const u32x4 w0 = pack8(acc[ai][0][m][0], acc[ai][0][m][1]), w1 = pack8(acc[ai][1][m][0], acc[ai][1][m][1]);
                    if (!meta) {
                        const size_t orow = (size_t)((row >> 13) * SPAD + 64 + (row & 8191));
                        *(u32x4*)(V + orow * 512 + colb) = w0; *(u32x4*)(V + orow * 512 + colb + HALF) = w1;
                    } else {
#pragma unroll 1
                        for (int b = 0; b < 4; ++b) { const size_t orow = (size_t)(b * SPAD + fr); *(u32x4*)(V + orow * 512 + colb) = w0; *(u32x4*)(V + orow * 512 + colb + HALF) = w1; }
                    }
                }
        } else {
            const int colb = (pn - 6) * 128 + wc * 32 + 8 * fq;
#pragma unroll
            for (int ai = 0; ai < 2; ++ai)
#pragma unroll
                for (int m = 0; m < 4; ++m) {
                    if (meta && (ai || m)) continue;
                    const int row = rbase + ai * HALF + m * 16;
                    f32x4 h[2];
#pragma unroll
                    for (int n = 0; n < 2; ++n) { const f32x4 a = acc[ai][0][m][n], g = acc[ai][1][m][n];
#pragma unroll
                        for (int e = 0; e < 4; ++e) h[n][e] = a[e] * __builtin_amdgcn_rcpf(1.0f + __builtin_amdgcn_exp2f(-1.4426950408889634f * g[e])); }
                    const u32x4 w0 = pack8(h[0], h[1]);
                    if (!meta) {
                        const size_t orow = (size_t)((row >> 13) * SPAD + 64 + (row & 8191));
                        *(u32x4*)(G + orow * 512 + colb) = w0;
                    } else {
#pragma unroll 1
                        for (int b = 0; b < 4; ++b) { const size_t orow = (size_t)(b * SPAD + 48 + fr); *(u32x4*)(G + orow * 512 + colb) = w0; }
                    }
                }
        }
    }
};
struct EpiOut {
    static constexpr bool PERM = true, AFTER_DRAIN = false;
    const bf16_t* xn; const float* rn; const float* g1; bf16_t* hb; float* ssq;
    __device__ __forceinline__ void operator()(const f32x4 (&acc)[2][2][4][2], const Unit& u, int wr, int wc, int fr, int fq) const {
        const int rbase = u.pm * BM + wr * 64 + fr, colb = u.pn * BM + wc * 32 + 8 * fq;
        f32x4 ig[2][2];
#pragma unroll
        for (int bj = 0; bj < 2; ++bj)
#pragma unroll
            for (int n = 0; n < 2; ++n) { const f32x4 g = *(const f32x4*)(g1 + colb + bj * HALF + 4 * n);
#pragma unroll
                for (int e = 0; e < 4; ++e) ig[bj][n][e] = __builtin_amdgcn_rcpf(g[e]); }
#pragma unroll
        for (int ai = 0; ai < 2; ++ai) {
            u32x4 xv[4][2]; float rv[4];
#pragma unroll
            for (int m = 0; m < 4; ++m) { const int row = rbase + ai * HALF + m * 16; rv[m] = rn[row];
#pragma unroll
                for (int bj = 0; bj < 2; ++bj) xv[m][bj] = *(const u32x4*)(xn + (size_t)row * 1024 + colb + bj * HALF); }
            asm volatile("" ::: "memory");
#pragma unroll
            for (int m = 0; m < 4; ++m) {
                const int row = rbase + ai * HALF + m * 16; float ss = 0.f;
#pragma unroll
                for (int bj = 0; bj < 2; ++bj) { const size_t off = (size_t)row * 1024 + colb + bj * HALF; const u32x4 w = xv[m][bj];
                    f32x4 x0, x1;
                    x0[0] = __uint_as_float(w.x << 16); x0[1] = __uint_as_float(w.x & 0xffff0000u); x0[2] = __uint_as_float(w.y << 16); x0[3] = __uint_as_float(w.y & 0xffff0000u);
                    x1[0] = __uint_as_float(w.z << 16); x1[1] = __uint_as_float(w.z & 0xffff0000u); x1[2] = __uint_as_float(w.w << 16); x1[3] = __uint_as_float(w.w & 0xffff0000u);
                    const f32x4 h0 = x0 * rv[m] * ig[bj][0] + acc[ai][bj][m][0], h1 = x1 * rv[m] * ig[bj][1] + acc[ai][bj][m][1];
                    *(u32x4*)(hb + off) = pack8(h0, h1);
                    ss += (h0[0] * h0[0] + h0[1] * h0[1]) + (h0[2] * h0[2] + h0[3] * h0[3]) + (h1[0] * h1[0] + h1[1] * h1[1]) + (h1[2] * h1[2] + h1[3] * h1[3]); }
                ss += __shfl_xor(ss, 16); ss += __shfl_xor(ss, 32);
                if (fq == 0) ssq[(size_t)row * 16 + u.pn * 4 + wc] = ss;
            }
        }
    }
};
struct EpiUp {
    static constexpr bool PERM = true, AFTER_DRAIN = false;
    bf16_t* hb; const float* ssq;
    __device__ __forceinline__ void operator()(const f32x4 (&acc)[2][2][4][2], const Unit& u, int wr, int wc, int fr, int fq) const {
        const int rbase = u.pm * BM + wr * 64 + fr, colb = u.pn * BM + wc * 32 + 8 * fq;
#pragma unroll
        for (int ai = 0; ai < 2; ++ai) {
            f32x4 sv[4][4];
#pragma unroll
            for (int m = 0; m < 4; ++m) { const f32x4* sp = (const f32x4*)(ssq + (size_t)(rbase + ai * HALF + m * 16) * 16);
#pragma unroll
                for (int k = 0; k < 4; ++k) sv[m][k] = sp[k]; }
            asm volatile("" ::: "memory");
#pragma unroll
            for (int m = 0; m < 4; ++m) {
                const int row = rbase + ai * HALF + m * 16;
                const f32x4 s0 = sv[m][0], s1 = sv[m][1], s2 = sv[m][2], s3 = sv[m][3];
                const float tot = ((s0[0] + s0[1]) + (s0[2] + s0[3])) + ((s1[0] + s1[1]) + (s1[2] + s1[3])) + ((s2[0] + s2[1]) + (s2[2] + s2[3])) + ((s3[0] + s3[1]) + (s3[2] + s3[3]));
                const float rs = __builtin_amdgcn_rsqf(tot * (1.0f / 1024.0f) + 1e-6f);
#pragma unroll
                for (int bj = 0; bj < 2; ++bj) { f32x4 a0 = acc[ai][bj][m][0] * rs, a1 = acc[ai][bj][m][1] * rs;
#pragma unroll
                    for (int e = 0; e < 4; ++e) { const float p = fmaxf(a0[e], 0.f), q = fmaxf(a1[e], 0.f); a0[e] = p * p; a1[e] = q * q; }
                    *(u32x4*)(hb + (size_t)row * 4096 + colb + bj * HALF) = pack8(a0, a1); }
            }
        }
    }
};
struct EpiDown {
    static constexpr bool PERM = true, AFTER_DRAIN = false;
    const bf16_t* h1; float* out;
    __device__ __forceinline__ void operator()(const f32x4 (&acc)[2][2][4][2], const Unit& u, int wr, int wc, int fr, int fq) const {
        const int rbase = u.pm * BM + wr * 64 + fr, colb = u.pn * BM + wc * 32 + 8 * fq;
        u32x4 hv[2][4][2];
#pragma unroll
        for (int ai = 0; ai < 2; ++ai)
#pragma unroll
            for (int m = 0; m < 4; ++m)
#pragma unroll
                for (int bj = 0; bj < 2; ++bj) hv[ai][m][bj] = *(const u32x4*)(h1 + (size_t)(rbase + ai * HALF + m * 16) * 1024 + colb + bj * HALF);
        asm volatile("" ::: "memory");
#pragma unroll
        for (int ai = 0; ai < 2; ++ai)
#pragma unroll
            for (int m = 0; m < 4; ++m) {
                const int row = rbase + ai * HALF + m * 16;
#pragma unroll
                for (int bj = 0; bj < 2; ++bj) { const size_t off = (size_t)row * 1024 + colb + bj * HALF; const u32x4 w = hv[ai][m][bj];
                    f32x4 r0, r1;
                    r0[0] = __uint_as_float(w.x << 16); r0[1] = __uint_as_float(w.x & 0xffff0000u); r0[2] = __uint_as_float(w.y << 16); r0[3] = __uint_as_float(w.y & 0xffff0000u);
                    r1[0] = __uint_as_float(w.z << 16); r1[1] = __uint_as_float(w.z & 0xffff0000u); r1[2] = __uint_as_float(w.w << 16); r1[3] = __uint_as_float(w.w & 0xffff0000u);
                    *(f32x4*)(out + off) = r0 + acc[ai][bj][m][0]; *(f32x4*)(out + off + 4) = r1 + acc[ai][bj][m][1]; }
            }
    }
};


template <class Epi, class Sched, bool ALIGN_EPI = false, bool SP2 = false>
__device__ __forceinline__ void gemm_phase(PG8_LAS unsigned char* lds, const Gemm g, const Sched& S, const Epi& E) {
    int tid_ = threadIdx.x; asm volatile("" : "+v"(tid_));
    const int tid = tid_, wid = __builtin_amdgcn_readfirstlane(tid >> 6), lane = tid & 63, wr = wid >> 2, wc = wid & 3, fr = lane & 15, fq = lane >> 4;
    const int K = g.K, nt = K / BK;
    unsigned voffA[2], voffB[2];
#pragma unroll
    for (int i = 0; i < 2; ++i) { int R, C; stage_rc(tid * 16 + i * 8192, R, C); const int Rb = Epi::PERM ? ((R & ~31) + perm32(R & 31)) : R;
        voffA[i] = (unsigned)(R * K + C) * 2u; voffB[i] = (unsigned)(Rb * K + C) * 2u; }
    const size_t kstep = (size_t)(BK * 2);
    const size_t hstep = (size_t)HALF * K * 2;
    const size_t tstep = 2 * hstep;
    const unsigned ldsw = (unsigned)wid * 1024u;
    const int aoff = lds_byte(wr * 64 + fr, fq * 8), boff = lds_byte(wc * 32 + fr, fq * 8);
#define PG8_SA(b, h) (((b) * 2 + (h)) * HTB)
#define PG8_SB(b, h) ((4 + (b) * 2 + (h)) * HTB)
#define PG8_STAGE(bufoff, gbase, voff) do { _Pragma("unroll") for (int _i = 0; _i < 2; ++_i) \
        __builtin_amdgcn_global_load_lds((const unsigned*)((const char*)(gbase) + (voff)[_i]), (PG8_LAS unsigned*)(lds + (bufoff) + ldsw + _i * 8192), 16, 0, 0); } while (0)
#define PG8_LDA(dst, b, h) do { _Pragma("unroll") for (int m = 0; m < 4; ++m) _Pragma("unroll") for (int k = 0; k < 2; ++k) dst[m][k] = *(const PG8_LAS bf16x8*)(lds + PG8_SA(b, h) + aoff + m * 2048 + k * 1024); } while (0)
#define PG8_LDB(dst, b, h) do { _Pragma("unroll") for (int n = 0; n < 2; ++n) _Pragma("unroll") for (int k = 0; k < 2; ++k) dst[n][k] = *(const PG8_LAS bf16x8*)(lds + PG8_SB(b, h) + boff + n * 2048 + k * 1024); } while (0)
#define PG8_MMA(ai, bj, At, Bt) do { __builtin_amdgcn_s_setprio(1); _Pragma("unroll") for (int m = 0; m < 4; ++m) _Pragma("unroll") for (int n = 0; n < 2; ++n) _Pragma("unroll") for (int k = 0; k < 2; ++k) \
        acc[ai][bj][m][n] = __builtin_amdgcn_mfma_f32_16x16x32_bf16(Bt[n][k], At[m][k], acc[ai][bj][m][n], 0, 0, 0); __builtin_amdgcn_s_setprio(0); } while (0)
#define PG8_WAIT_V(n) asm volatile("s_waitcnt vmcnt(" #n ")" ::: "memory")
#define PG8_WAIT_L(n) asm volatile("s_waitcnt lgkmcnt(" #n ")" ::: "memory")
#define PG8_BAR __builtin_amdgcn_s_barrier()
#define PG8_SCHED __builtin_amdgcn_sched_barrier(0)
    Unit cur, nxt; int ui = 0;
    if (!S.next(0, cur)) return;
    f32x4 acc[2][2][4][2];
#pragma unroll
    for (int a = 0; a < 2; ++a)
#pragma unroll
        for (int b = 0; b < 2; ++b)
#pragma unroll
            for (int m = 0; m < 4; ++m)
#pragma unroll
                for (int n = 0; n < 2; ++n) acc[a][b][m][n] = (f32x4){0.f, 0.f, 0.f, 0.f};
    bf16x8 At[4][2], B0[2][2], B1[2][2];
    const char* cA = (const char*)g.A + (size_t)cur.pm * tstep; const char* cB = (const char*)g.Bt + (size_t)cur.pn * tstep;
    S.a_ready(cur);
    if constexpr (SP2) {
        PG8_STAGE(PG8_SB(0, 0), cB, voffB); PG8_STAGE(PG8_SB(0, 1), cB + hstep, voffB); PG8_STAGE(PG8_SA(0, 0), cA, voffA); PG8_STAGE(PG8_SA(0, 1), cA + hstep, voffA);
        if (wr == 1) PG8_BAR;
        PG8_WAIT_V(2); PG8_BAR;
        PG8_STAGE(PG8_SB(1, 0), cB + kstep, voffB); PG8_STAGE(PG8_SA(1, 0), cA + kstep, voffA); PG8_STAGE(PG8_SB(1, 1), cB + hstep + kstep, voffB);
        PG8_WAIT_V(6); PG8_BAR;
    } else {
        PG8_STAGE(PG8_SB(0, 0), cB, voffB); PG8_STAGE(PG8_SA(0, 0), cA, voffA); PG8_STAGE(PG8_SB(0, 1), cB + hstep, voffB); PG8_STAGE(PG8_SA(0, 1), cA + hstep, voffA);
        if (wr == 1) PG8_BAR;
        PG8_WAIT_V(4); PG8_BAR;
        PG8_STAGE(PG8_SB(1, 0), cB + kstep, voffB); PG8_STAGE(PG8_SA(1, 0), cA + kstep, voffA); PG8_STAGE(PG8_SB(1, 1), cB + hstep + kstep, voffB);
        PG8_WAIT_V(6); PG8_BAR;
    }
    for (;;) {
        const bool has_next = S.next(ui + 1, nxt);
        const char* nA = has_next ? (const char*)g.A + (size_t)nxt.pm * tstep : cA; const char* nB = has_next ? (const char*)g.Bt + (size_t)nxt.pn * tstep : cB;
        for (int t = 0; t < nt; t += 2) {
            const bool last = (t == nt - 2);
            const char* a1 = cA + (size_t)(t + 1) * kstep;
            const char* a2 = last ? nA : cA + (size_t)(t + 2) * kstep; const char* b2 = last ? nB : cB + (size_t)(t + 2) * kstep;
            const char* a3 = a2 + kstep; const char* b3 = b2 + kstep;
            if (last && has_next) S.a_ready(nxt);
            if constexpr (SP2) {
            PG8_LDB(B0, 0, 0); PG8_LDB(B1, 0, 1); PG8_SCHED; PG8_LDA(At, 0, 0); PG8_STAGE(PG8_SA(1, 1), a1 + hstep, voffA);
            PG8_WAIT_V(8); PG8_WAIT_L(0); PG8_BAR; PG8_MMA(0, 0, At, B0); PG8_MMA(0, 1, At, B1); PG8_BAR; PG8_SCHED;
            PG8_LDA(At, 0, 1); PG8_STAGE(PG8_SB(0, 0), b2, voffB); PG8_STAGE(PG8_SB(0, 1), b2 + hstep, voffB); PG8_STAGE(PG8_SA(0, 0), a2, voffA);
            PG8_WAIT_V(8); PG8_WAIT_L(0); PG8_BAR; PG8_MMA(1, 0, At, B0); PG8_MMA(1, 1, At, B1); PG8_BAR; PG8_SCHED;
            PG8_LDB(B0, 1, 0); PG8_LDB(B1, 1, 1); PG8_SCHED; PG8_LDA(At, 1, 0); PG8_STAGE(PG8_SA(0, 1), a2 + hstep, voffA);
            PG8_WAIT_V(8); PG8_WAIT_L(0); PG8_BAR; PG8_MMA(0, 0, At, B0); PG8_MMA(0, 1, At, B1); PG8_BAR; PG8_SCHED;
            PG8_LDA(At, 1, 1); PG8_STAGE(PG8_SB(1, 0), b3, voffB); PG8_STAGE(PG8_SB(1, 1), b3 + hstep, voffB); PG8_STAGE(PG8_SA(1, 0), a3, voffA);
            PG8_WAIT_V(8); PG8_WAIT_L(0); PG8_BAR; PG8_MMA(1, 0, At, B0); PG8_MMA(1, 1, At, B1); PG8_BAR; PG8_SCHED;
            } else {
            PG8_LDB(B0, 0, 0); PG8_SCHED; PG8_LDA(At, 0, 0); PG8_STAGE(PG8_SA(1, 1), a1 + hstep, voffA);
            PG8_WAIT_L(8); PG8_BAR; PG8_WAIT_L(0); PG8_MMA(0, 0, At, B0); PG8_BAR; PG8_SCHED;
            PG8_LDB(B1, 0, 1); PG8_STAGE(PG8_SB(0, 0), b2, voffB);
            PG8_BAR; PG8_WAIT_L(0); PG8_MMA(0, 1, At, B1); PG8_BAR;
            PG8_LDA(At, 0, 1); PG8_STAGE(PG8_SA(0, 0), a2, voffA);
            PG8_BAR; PG8_WAIT_L(0); PG8_MMA(1, 0, At, B0); PG8_BAR; PG8_SCHED;
            PG8_STAGE(PG8_SB(0, 1), b2 + hstep, voffB);
            PG8_WAIT_V(6); PG8_BAR; PG8_MMA(1, 1, At, B1); PG8_BAR;
            PG8_LDB(B0, 1, 0); PG8_SCHED; PG8_LDA(At, 1, 0); PG8_STAGE(PG8_SA(0, 1), a2 + hstep, voffA);
            PG8_WAIT_L(8); PG8_BAR; PG8_WAIT_L(0); PG8_MMA(0, 0, At, B0); PG8_BAR; PG8_SCHED;
            PG8_LDB(B1, 1, 1); PG8_STAGE(PG8_SB(1, 0), b3, voffB);
            PG8_BAR; PG8_WAIT_L(0); PG8_MMA(0, 1, At, B1); PG8_BAR;
            PG8_LDA(At, 1, 1); PG8_STAGE(PG8_SA(1, 0), a3, voffA);
            PG8_BAR; PG8_WAIT_L(0); PG8_MMA(1, 0, At, B0); PG8_BAR; PG8_SCHED;
            PG8_STAGE(PG8_SB(1, 1), b3 + hstep, voffB);
            PG8_WAIT_V(6); PG8_BAR; PG8_MMA(1, 1, At, B1); PG8_BAR;
            }
        }
        if constexpr (ALIGN_EPI) { if (wr == 0) PG8_BAR; }
        if constexpr (!Epi::AFTER_DRAIN) { E(acc, cur, wr, wc, fr, fq); S.done(cur); }
        if (!has_next) break;
#pragma unroll
        for (int a = 0; a < 2; ++a)
#pragma unroll
            for (int b = 0; b < 2; ++b)
#pragma unroll
                for (int m = 0; m < 4; ++m)
#pragma unroll
                    for (int n = 0; n < 2; ++n) acc[a][b][m][n] = (f32x4){0.f, 0.f, 0.f, 0.f};
        cur = nxt; cA = nA; cB = nB; ++ui;
        if constexpr (ALIGN_EPI) { if (wr == 1) PG8_BAR; }
    }
    PG8_WAIT_V(0);
    if constexpr (!ALIGN_EPI) { if (wr == 0) PG8_BAR; }
    PG8_BAR;
    if constexpr (Epi::AFTER_DRAIN) { E.fused(acc, cur, wr, wc, fr, fq, lds, wid, lane); S.done(cur); }
#undef PG8_SA
#undef PG8_SB
#undef PG8_STAGE
#undef PG8_LDA
#undef PG8_LDB
#undef PG8_MMA
#undef PG8_WAIT_V
#undef PG8_WAIT_L
#undef PG8_BAR
#undef PG8_SCHED
}
}

#ifndef PG8_SP2
#define PG8_SP2 true
#endif
#ifndef PG8_ALIGN
#define PG8_ALIGN true
#endif
#include <hip/hip_bf16.h>
#include <cmath>
namespace attn_body {
using bf16=__hip_bfloat16;
using bf16x8=__attribute__((ext_vector_type(8)))short;
using s16x4=__attribute__((ext_vector_type(4)))short;
using f32x16=__attribute__((ext_vector_type(16)))float;
using u32x4=__attribute__((ext_vector_type(4)))unsigned;
constexpr int SEQ=8192,D=64,PQ=512,PO=1024;
constexpr int NW=8,QBLK=32,QB=QBLK*NW,KVBLK=64,NQB=SEQ/QB;
constexpr int ATTN_UNIT_ROWS=QB;
__device__ __forceinline__ int crow(int r,int hi){return (r&3)+8*(r>>2)+4*hi;}
#define SBAR() __builtin_amdgcn_sched_barrier(0)
__device__ __forceinline__ void cmask(f32x16&p0,f32x16&p1,int jb,int qrel,int hi){
  const float NEG=-INFINITY; int kb=64*jb+4*hi;
  #pragma unroll
  for(int r=0;r<16;++r){int kv=kb+(r&3)+8*(r>>2); if(kv>qrel)p0[r]=NEG; if(kv+32>qrel)p1[r]=NEG;}
}

constexpr int NSLOT=3, SLOTB=8192;
constexpr int LDS_K=0, LDS_V=NSLOT*SLOTB, LDS_WS=2*NSLOT*SLOTB, LDS_OST=LDS_WS+NW*64*4, LDS_BYTES=LDS_OST+NW*4096;
constexpr float C2=0.125f*1.4426950408889634f;
__device__ __forceinline__ void glds16(const void*gsrc,unsigned lds_dst){unsigned keep;
  asm volatile("s_mov_b32 %0, m0\n\ts_mov_b32 m0, %2\n\ts_nop 0\n\tglobal_load_lds_dwordx4 %1, off\n\ts_mov_b32 m0, %0":"=&s"(keep):"v"(gsrc),"s"(lds_dst):"memory");}
__device__ __forceinline__ float max3f(float a,float b,float c){float r;asm("v_max3_f32 %0, %1, %2, %3":"=v"(r):"v"(a),"v"(b),"v"(c));return r;}
__device__ __forceinline__ float max2f(float a,float b){float r;asm("v_max_f32_e32 %0, %1, %2":"=v"(r):"v"(a),"v"(b));return r;}
__device__ __forceinline__ float fadd_s(float a,float b){float r;asm("v_add_f32_e32 %0, %1, %2":"=v"(r):"v"(a),"v"(b));return r;}
__device__ __forceinline__ float fsub_s(float a,float b){float r;asm("v_sub_f32_e32 %0, %1, %2":"=v"(r):"v"(a),"v"(b));return r;}
typedef float f32x2_t __attribute__((ext_vector_type(2))); typedef __bf16 bf16x2_t __attribute__((ext_vector_type(2)));
__device__ __forceinline__ unsigned cvtpk_s(float lo,float hi){f32x2_t v={lo,hi};bf16x2_t b=__builtin_convertvector(v,bf16x2_t);return __builtin_bit_cast(unsigned,b);}
#define WAIT_BAR(N) asm volatile("s_waitcnt vmcnt(" #N ") lgkmcnt(0)\n\ts_barrier":::"memory")

__device__ __forceinline__ void qkt(f32x16&p0,f32x16&p1,const char*Kslot,const bf16x8*qr,const f32x16&negm,int r32,int hi){
  const char*kb=Kslot+hi*1024+r32*16;
  #pragma unroll
  for(int d0=0;d0<4;++d0){
    const bf16x8 b0=*reinterpret_cast<const bf16x8*>(kb+d0*2048);
    const bf16x8 b1=*reinterpret_cast<const bf16x8*>(kb+d0*2048+512);
    if(d0==0){p0=__builtin_amdgcn_mfma_f32_32x32x16_bf16(b0,qr[0],negm,0,0,0);p1=__builtin_amdgcn_mfma_f32_32x32x16_bf16(b1,qr[0],negm,0,0,0);}
    else{p0=__builtin_amdgcn_mfma_f32_32x32x16_bf16(b0,qr[d0],p0,0,0,0);p1=__builtin_amdgcn_mfma_f32_32x32x16_bf16(b1,qr[d0],p1,0,0,0);}}
}
typedef __attribute__((address_space(3))) const char* lds_cptr;
typedef short v4i16_t __attribute__((ext_vector_type(4)));
__device__ __forceinline__ void kload8(bf16x8*kf,lds_cptr kp){
  kf[0]=*(const __attribute__((address_space(3))) bf16x8*)(kp);      kf[1]=*(const __attribute__((address_space(3))) bf16x8*)(kp+512);
  kf[2]=*(const __attribute__((address_space(3))) bf16x8*)(kp+2048); kf[3]=*(const __attribute__((address_space(3))) bf16x8*)(kp+2560);
  kf[4]=*(const __attribute__((address_space(3))) bf16x8*)(kp+4096); kf[5]=*(const __attribute__((address_space(3))) bf16x8*)(kp+4608);
  kf[6]=*(const __attribute__((address_space(3))) bf16x8*)(kp+6144); kf[7]=*(const __attribute__((address_space(3))) bf16x8*)(kp+6656);
}
__device__ __forceinline__ void kload2(bf16x8*kf,lds_cptr kp,int j){ kf[2*j]=*(const __attribute__((address_space(3))) bf16x8*)(kp+j*2048); kf[2*j+1]=*(const __attribute__((address_space(3))) bf16x8*)(kp+j*2048+512); }
__device__ __forceinline__ s16x4 vtr(lds_cptr p){ return __builtin_bit_cast(s16x4,__builtin_amdgcn_ds_read_tr16_b64_v4i16((__attribute__((address_space(3))) v4i16_t*)p)); }
__device__ __forceinline__ float rowmax(const f32x16&p0,const f32x16&p1){
  float a=max3f(p0[0],p0[1],p1[0]),b=max3f(p0[2],p0[3],p1[1]);a=max3f(a,p1[2],p1[3]);
  #pragma unroll
  for(int r=4;r<16;r+=4){a=max3f(a,p0[r],p0[r+1]);b=max3f(b,p0[r+2],p0[r+3]);a=max3f(a,p1[r],p1[r+1]);b=max3f(b,p1[r+2],p1[r+3]);}
  const float m=max2f(a,b);
  auto rr=__builtin_amdgcn_permlane32_swap(__float_as_uint(m),__float_as_uint(m),false,false);
  return max2f(__uint_as_float(rr[0]),__uint_as_float(rr[1]));
}
__device__ __forceinline__ void pv(f32x16*o,int vb,bf16x8 pa0,bf16x8 pa1,bf16x8 pa2,bf16x8 pa3){
  #pragma unroll
  for(int d0=0;d0<2;++d0){s16x4 lo[4],hi[4];
    #pragma unroll
    for(int ks=0;ks<4;++ks){
      asm volatile("ds_read_b64_tr_b16 %0,%1 offset:%c2":"=&v"(lo[ks]):"v"(vb),"i"(d0*4096+ks*1024):"memory");
      asm volatile("ds_read_b64_tr_b16 %0,%1 offset:%c2":"=&v"(hi[ks]):"v"(vb),"i"(d0*4096+ks*1024+512):"memory");}
    asm volatile("s_waitcnt lgkmcnt(0)":::"memory");SBAR();
    #define PK(k) (bf16x8){lo[k][0],lo[k][1],lo[k][2],lo[k][3],hi[k][0],hi[k][1],hi[k][2],hi[k][3]}
    o[d0]=__builtin_amdgcn_mfma_f32_32x32x16_bf16(pa0,PK(0),o[d0],0,0,0);
    o[d0]=__builtin_amdgcn_mfma_f32_32x32x16_bf16(pa1,PK(1),o[d0],0,0,0);
    o[d0]=__builtin_amdgcn_mfma_f32_32x32x16_bf16(pa2,PK(2),o[d0],0,0,0);
    o[d0]=__builtin_amdgcn_mfma_f32_32x32x16_bf16(pa3,PK(3),o[d0],0,0,0);
    #undef PK
  }
}

#ifndef ATTN_STORE16
#define ATTN_STORE16(p,v) (*(u32x4*)(p)=(v))
#endif
template<int THRL> __device__ __forceinline__ void attn_unit(int q0,const bf16*Qu,const bf16*__restrict__ Kh,const bf16*__restrict__ Vh,bf16*Ou,char*shm){
  int tid_=threadIdx.x; asm volatile("":"+v"(tid_)); const int tid=tid_,lane=tid&63,r32=lane&31,hi=lane>>5; const int wid=__builtin_amdgcn_readfirstlane(tid>>6);
  const bf16*Qw=Qu+(long)(wid*QBLK)*PQ;
  const unsigned lds0=(unsigned)(uintptr_t)shm;
  float*wsf=(float*)(shm+LDS_WS)+wid*64;
  const bf16*ksrc=Kh+(long)lane*PQ+wid*8;
  const bf16*vsrc=Vh+(long)(16*(wid&3)+(lane>>2))*PQ+(wid>>2)*32+(lane&3)*8;
  const unsigned kdst=lds0+LDS_K+wid*1024, vdst=lds0+LDS_V+wid*1024;
  #define DMA_K(t,slot) glds16(ksrc+(long)(t)*KVBLK*PQ,(unsigned)__builtin_amdgcn_readfirstlane(kdst+(slot)))
  #define DMA_V(t,slot) glds16(vsrc+(long)(t)*KVBLK*PQ,(unsigned)__builtin_amdgcn_readfirstlane(vdst+(slot)))
  const int vb0=(int)(lds0+LDS_V)+((lane>>4)&1)*32+(lane&3)*8+(4*hi+((lane&15)>>2))*64;
  const char*Kbase=shm+LDS_K; bf16x8 kf[8];
  const lds_cptr shm3=(lds_cptr)shm; const lds_cptr kp0=shm3+LDS_K+hi*1024+r32*16; const lds_cptr vp0=shm3+LDS_V+((lane>>4)&1)*32+(lane&3)*8+(4*hi+((lane&15)>>2))*64;
  const int NT=(q0+QB)/KVBLK+1;
  DMA_K(0,0);DMA_V(0,0);DMA_K(1,SLOTB);
  bf16x8 qr[4];
  #pragma unroll
  for(int d0=0;d0<4;++d0)qr[d0]=*reinterpret_cast<const bf16x8*>(&Qw[(long)r32*PQ+d0*16+hi*8]);
  float mhat=0.f,l_reg=0.f;f32x16 o[2];o[0]=f32x16{};o[1]=f32x16{};f32x16 negm=f32x16{};asm volatile("":"+v"(negm));
  const int qrel=wid*QBLK+r32;
  #define CMASK(P0,P1,t) do{int jb_=(t)-(NT-4); if(jb_>=0)cmask(P0,P1,jb_,qrel,hi);}while(0)
  bool resc=false;
  #define START(P0,P1) do{ const float rm=rowmax(P0,P1); resc=false; \
    { const float dl=rm; mhat=fadd_s(mhat,dl); \
      _Pragma("unroll") for(int r=0;r<16;++r){P0[r]=fsub_s(P0[r],dl);P1[r]=fsub_s(P1[r],dl);} \
      _Pragma("unroll") for(int r=0;r<16;++r)negm[r]=-mhat; asm volatile("":"+v"(negm)); } \
    _Pragma("unroll") for(int r=0;r<16;++r)P0[r]=__builtin_amdgcn_exp2f(P0[r]); }while(0)
  #define RESC() do{ if(resc){ asm volatile("s_waitcnt lgkmcnt(0)":::"memory"); \
      _Pragma("unroll") for(int d_=0;d_<2;++d_) _Pragma("unroll") for(int r=0;r<16;++r)o[d_][r]*=wsf[crow(r,hi)]; } }while(0)
  f32x16 pA0,pA1,pB0,pB1;
  int sl_prev=0,sl_cur=0,sl_next=SLOTB;
  #define ROT() do{sl_prev=sl_cur;sl_cur=sl_next;sl_next=(sl_next==(NSLOT-1)*SLOTB)?0:sl_next+SLOTB;}while(0)
  DMA_K(2,2*SLOTB);
  WAIT_BAR(3);
  qkt(pA0,pA1,Kbase,qr,negm,r32,hi);asm volatile("s_nop 15\n\ts_nop 7":"+v"(pA0),"+v"(pA1));
  { const float NEGI=-INFINITY; _Pragma("unroll") for(int r=8;r<16;++r)pA0[r]=NEGI; _Pragma("unroll") for(int r=0;r<16;++r)pA1[r]=NEGI; }
  START(pA0,pA1);
  _Pragma("unroll") for(int r=0;r<16;++r)pA1[r]=__builtin_amdgcn_exp2f(pA1[r]);
  WAIT_BAR(0);
  DMA_K(3,0);DMA_V(1,SLOTB);
  ROT();
  kload8(kf,kp0+sl_cur);
  WAIT_BAR(2);
  s16x4 vlo[8],vhi[8]; u32x4 pw0,pw1,pw2,pw3;
  #define PKW(P,B) cvtpk_s(P[B],P[B+1])
  #define PAF(k) __builtin_bit_cast(bf16x8,pw##k)
  #define VFR(i) (bf16x8){vlo[i][0],vlo[i][1],vlo[i][2],vlo[i][3],vhi[i][0],vhi[i][1],vhi[i][2],vhi[i][3]}
  #define PIN(x) asm volatile("":"+v"(x))
  #define MX3(a,b,c) __builtin_fmaxf(__builtin_fmaxf((a),(b)),(c))
  #define GAPA(MF,A0,A1,A2,A3,W0,W1,PW) do{ MF; sacc+=A0; sacc+=A1; sacc+=A2; sacc+=A3; PIN(sacc); W0; W1; PIN(PW); SBAR(); }while(0)
  #define EX(v) __builtin_amdgcn_exp2f(v)
  #define GAPB(MF,X,B) do{ MF; X[B]=EX(X[B]); X[B+1]=EX(X[B+1]); X[B+2]=EX(X[B+2]); X[B+3]=EX(X[B+3]); PIN(X); SBAR(); }while(0)
  #define VRD(i) do{ vlo[i]=vtr(vp_+(((i)>>2)*4096+((i)&3)*1024)); vhi[i]=vtr(vp_+(((i)>>2)*4096+((i)&3)*1024+512)); }while(0)
  #define KRD(G,j) do{ if(G){ kload2(kf,kp0+sl_next,j); SBAR(); } }while(0)
  #define STEP(C0,C1,P0,P1,t,GK,GV,GL) do{ SBAR(); \
    const lds_cptr vp_=vp0+sl_prev; \
    VRD(0); SBAR(); float sacc=(P0[0]+P0[1]); \
    GAPA(C0=__builtin_amdgcn_mfma_f32_32x32x16_bf16(kf[0],qr[0],negm,0,0,0), P0[2],P0[3],P0[4],P0[5],     pw0[0]=PKW(P0,0), pw0[1]=PKW(P0,2), pw0); \
    VRD(4); SBAR(); GAPA(C1=__builtin_amdgcn_mfma_f32_32x32x16_bf16(kf[1],qr[0],negm,0,0,0), P0[6],P0[7],P0[8],P0[9],     pw0[2]=PKW(P0,4), pw0[3]=PKW(P0,6), pw0); \
    VRD(1); SBAR(); GAPA(C0=__builtin_amdgcn_mfma_f32_32x32x16_bf16(kf[2],qr[1],C0,0,0,0),   P0[10],P0[11],P0[12],P0[13], pw1[0]=PKW(P0,8), pw1[1]=PKW(P0,10), pw1); \
    VRD(5); SBAR(); GAPA(C1=__builtin_amdgcn_mfma_f32_32x32x16_bf16(kf[3],qr[1],C1,0,0,0),   P0[14],P0[15],P1[0],P1[1],   pw1[2]=PKW(P0,12),pw1[3]=PKW(P0,14), pw1); \
    VRD(2); SBAR(); GAPA(C0=__builtin_amdgcn_mfma_f32_32x32x16_bf16(kf[4],qr[2],C0,0,0,0),   P1[2],P1[3],P1[4],P1[5],     pw2[0]=PKW(P1,0), pw2[1]=PKW(P1,2), pw2); \
    VRD(6); SBAR(); GAPA(C1=__builtin_amdgcn_mfma_f32_32x32x16_bf16(kf[5],qr[2],C1,0,0,0),   P1[6],P1[7],P1[8],P1[9],     pw2[2]=PKW(P1,4), pw2[3]=PKW(P1,6), pw2); \
    VRD(3); SBAR(); GAPA(C0=__builtin_amdgcn_mfma_f32_32x32x16_bf16(kf[6],qr[3],C0,0,0,0),   P1[10],P1[11],P1[12],P1[13], pw3[0]=PKW(P1,8), pw3[1]=PKW(P1,10), pw3); \
    VRD(7); SBAR(); GAPA(C1=__builtin_amdgcn_mfma_f32_32x32x16_bf16(kf[7],qr[3],C1,0,0,0),   P1[14],P1[15],0.f,0.f,       pw3[2]=PKW(P1,12),pw3[3]=PKW(P1,14), pw3); \
    l_reg+=sacc; \
    if(GK){DMA_K((t)+3,sl_cur);} if(GV){DMA_V((t)+1,sl_next);} \
    CMASK(C0,C1,t); \
    { float a=MX3(C0[0],C0[1],C1[0]),b=MX3(C0[2],C0[3],C1[1]); a=MX3(a,C1[2],C1[3]); \
      _Pragma("unroll") for(int r=4;r<16;r+=4){a=MX3(a,C0[r],C0[r+1]);b=MX3(b,C0[r+2],C0[r+3]);a=MX3(a,C1[r],C1[r+1]);b=MX3(b,C1[r+2],C1[r+3]);} \
      float rm=__builtin_fmaxf(a,b); { auto rr=__builtin_amdgcn_permlane32_swap(__float_as_uint(rm),__float_as_uint(rm),false,false); rm=__builtin_fmaxf(__uint_as_float(rr[0]),__uint_as_float(rr[1])); } \
      resc=false; \
      if(__builtin_expect(__any(rm>(float)THRL),0)){ const float dl=__builtin_fmaxf(rm,0.f); mhat+=dl; \
        _Pragma("unroll") for(int r=0;r<16;++r){C0[r]-=dl;C1[r]-=dl;} \
        _Pragma("unroll") for(int r=0;r<16;++r)negm[r]=-mhat; asm volatile("":"+v"(negm)); \
        const float f=__builtin_amdgcn_exp2f(-dl); l_reg*=f; if(hi==0)wsf[r32]=f; resc=true; } } \
    SBAR(); \
    GAPB(o[0]=__builtin_amdgcn_mfma_f32_32x32x16_bf16(PAF(0),VFR(0),o[0],0,0,0), C0,0); \
    GAPB(o[1]=__builtin_amdgcn_mfma_f32_32x32x16_bf16(PAF(0),VFR(4),o[1],0,0,0), C0,4); \
    KRD(GL,0); GAPB(o[0]=__builtin_amdgcn_mfma_f32_32x32x16_bf16(PAF(1),VFR(1),o[0],0,0,0), C0,8); \
    KRD(GL,1); GAPB(o[1]=__builtin_amdgcn_mfma_f32_32x32x16_bf16(PAF(1),VFR(5),o[1],0,0,0), C0,12); \
    KRD(GL,2); GAPB(o[0]=__builtin_amdgcn_mfma_f32_32x32x16_bf16(PAF(2),VFR(2),o[0],0,0,0), C1,0); \
    KRD(GL,3); GAPB(o[1]=__builtin_amdgcn_mfma_f32_32x32x16_bf16(PAF(2),VFR(6),o[1],0,0,0), C1,4); \
    GAPB(o[0]=__builtin_amdgcn_mfma_f32_32x32x16_bf16(PAF(3),VFR(3),o[0],0,0,0), C1,8); \
    GAPB(o[1]=__builtin_amdgcn_mfma_f32_32x32x16_bf16(PAF(3),VFR(7),o[1],0,0,0), C1,12); \
    }while(0)
  int t=1;
  #undef CMASK
  #define CMASK(P0,P1,t) do{}while(0)
  for(;t+5<NT;t+=2){
    STEP(pB0,pB1,pA0,pA1,t,true,true,true);     WAIT_BAR(2); RESC(); ROT();
    STEP(pA0,pA1,pB0,pB1,t+1,true,true,true);   WAIT_BAR(2); RESC(); ROT();
  }
  #undef CMASK
  #define CMASK(P0,P1,t) do{int jb_=(t)-(NT-4); if(jb_>=0)cmask(P0,P1,jb_,qrel,hi);}while(0)
  #define ENDW(tt) do{ if((tt)+3<NT){WAIT_BAR(2);} else if((tt)+2<NT){WAIT_BAR(1);} else {WAIT_BAR(0);} }while(0)
  for(;t+1<NT;t+=2){
    STEP(pB0,pB1,pA0,pA1,t,(t+3<NT),(t+1<NT),(t+1<NT));       ENDW(t);   RESC(); ROT();
    STEP(pA0,pA1,pB0,pB1,t+1,(t+4<NT),(t+2<NT),(t+2<NT));     ENDW(t+1); RESC(); ROT();
  }
  { float sacc=pA0[0]+pA0[1]; _Pragma("unroll") for(int r=2;r<16;++r)sacc+=pA0[r]; _Pragma("unroll") for(int r=0;r<16;++r)sacc+=pA1[r]; l_reg+=sacc;
    pw0=(u32x4){PKW(pA0,0),PKW(pA0,2),PKW(pA0,4),PKW(pA0,6)};pw1=(u32x4){PKW(pA0,8),PKW(pA0,10),PKW(pA0,12),PKW(pA0,14)};pw2=(u32x4){PKW(pA1,0),PKW(pA1,2),PKW(pA1,4),PKW(pA1,6)};pw3=(u32x4){PKW(pA1,8),PKW(pA1,10),PKW(pA1,12),PKW(pA1,14)};
    SBAR(); pv(o,vb0+sl_prev,PAF(0),PAF(1),PAF(2),PAF(3)); }
  #undef PKW
  #undef PAF
  #undef VFR
  #undef PIN
  #undef MX3
  #undef GAPA
  #undef GAPB
  #undef EX
  #undef VRD
  #undef KRD
  #undef STEP
  #undef ENDW
  {auto rr=__builtin_amdgcn_permlane32_swap(__float_as_uint(l_reg),__float_as_uint(l_reg),false,false);l_reg=__uint_as_float(rr[0])+__uint_as_float(rr[1]);}
  if(hi==0)wsf[32+r32]=l_reg;asm volatile("s_waitcnt lgkmcnt(0)":::"memory");
  float rli[16];
  #pragma unroll
  for(int r=0;r<16;++r)rli[r]=__builtin_amdgcn_rcpf(wsf[32+crow(r,hi)]);
  bf16*Ow=Ou+(long)(wid*QBLK)*PO;
  { bf16*stg=(bf16*)(shm+LDS_OST)+wid*2048;
    #pragma unroll
    for(int r=0;r<16;++r){const int orow=crow(r,hi);
      #pragma unroll
      for(int d0=0;d0<2;++d0)stg[orow*64+d0*32+r32]=__float2bfloat16(o[d0][r]*rli[r]);}
    asm volatile("s_waitcnt lgkmcnt(0)":::"memory");
    #pragma unroll
    for(int i=0;i<4;++i){const int row=i*8+(lane>>3),ch=lane&7; const u32x4 v=*(const u32x4*)(stg+row*64+ch*8); ATTN_STORE16(Ow+(long)row*PO+ch*8,v);} }
  asm volatile("s_waitcnt lgkmcnt(0)\n\ts_barrier":::"memory");
  #undef DMA_K
  #undef DMA_V
  #undef CMASK
  #undef START
  #undef RESC
  #undef ROT
}
constexpr int ATTN_LDS_BYTES=LDS_BYTES;
#undef SBAR
#undef WAIT_BAR
typedef float f32x4v __attribute__((ext_vector_type(4)));
constexpr int V2_SLOTV=16384, V2_LDS_K=0, V2_LDS_V=NSLOT*SLOTB, V2_LDS_WS=V2_LDS_V+NSLOT*V2_SLOTV, V2_LDS_OST=V2_LDS_WS+NW*64*4, V2_LDS_BYTES=V2_LDS_OST+NW*8192;
#define SBAR() __builtin_amdgcn_sched_barrier(0)
#define WAIT_BAR(N) asm volatile("s_waitcnt vmcnt(" #N ") lgkmcnt(0)\n\ts_barrier":::"memory")
__device__ __forceinline__ void pv4(f32x16*o,int vb,bf16x8 pa0,bf16x8 pa1,bf16x8 pa2,bf16x8 pa3){
  #pragma unroll
  for(int d0=0;d0<4;++d0){s16x4 lo[4],hi[4];
    #pragma unroll
    for(int ks=0;ks<4;++ks){
      asm volatile("ds_read_b64_tr_b16 %0,%1 offset:%c2":"=&v"(lo[ks]):"v"(vb),"i"(d0*4096+ks*1024):"memory");
      asm volatile("ds_read_b64_tr_b16 %0,%1 offset:%c2":"=&v"(hi[ks]):"v"(vb),"i"(d0*4096+ks*1024+512):"memory");}
    asm volatile("s_waitcnt lgkmcnt(0)":::"memory");SBAR();
    #define PK(k) (bf16x8){lo[k][0],lo[k][1],lo[k][2],lo[k][3],hi[k][0],hi[k][1],hi[k][2],hi[k][3]}
    o[d0]=__builtin_amdgcn_mfma_f32_32x32x16_bf16(pa0,PK(0),o[d0],0,0,0);
    o[d0]=__builtin_amdgcn_mfma_f32_32x32x16_bf16(pa1,PK(1),o[d0],0,0,0);
    o[d0]=__builtin_amdgcn_mfma_f32_32x32x16_bf16(pa2,PK(2),o[d0],0,0,0);
    o[d0]=__builtin_amdgcn_mfma_f32_32x32x16_bf16(pa3,PK(3),o[d0],0,0,0);
    #undef PK
  }
}
template<int MODE> __device__ __forceinline__ void attn_unit128(int q0,const bf16*Qu,const bf16*__restrict__ Kh,const bf16*__restrict__ Vh,bf16*Ou,char*shm,float lam,float oscale,const float*subg){
  int tid_=threadIdx.x; asm volatile("":"+v"(tid_)); const int tid=tid_,lane=tid&63,r32=lane&31,hi=lane>>5; const int wid=__builtin_amdgcn_readfirstlane(tid>>6);
  const bf16*Qw=Qu+(long)(wid*QBLK)*PQ;
  const unsigned lds0=(unsigned)(uintptr_t)shm;
  float*wsf=(float*)(shm+V2_LDS_WS)+wid*64;
  const bf16*ksrc=Kh+(long)lane*PQ+wid*8;
  const bf16*vsrc=Vh+(long)(16*(wid&3)+(lane>>2))*PQ+(wid>>2)*32+(lane&3)*8;
  const unsigned kdst=lds0+V2_LDS_K+wid*1024, vdst=lds0+V2_LDS_V+wid*1024;
  #define DMA_K(t,slot) glds16(ksrc+(long)(t)*KVBLK*PQ,(unsigned)__builtin_amdgcn_readfirstlane(kdst+(slot)))
  #define DMA_V(t,slot) do{ glds16(vsrc+(long)(t)*KVBLK*PQ,(unsigned)__builtin_amdgcn_readfirstlane(vdst+2*(slot))); glds16(vsrc+(long)(t)*KVBLK*PQ+64,(unsigned)__builtin_amdgcn_readfirstlane(vdst+2*(slot)+8192)); }while(0)
  const int vb0=(int)(lds0+V2_LDS_V)+((lane>>4)&1)*32+(lane&3)*8+(4*hi+((lane&15)>>2))*64;
  const char*Kbase=shm+V2_LDS_K; bf16x8 kf[8];
  const lds_cptr shm3=(lds_cptr)shm; const lds_cptr kp0=shm3+V2_LDS_K+hi*1024+r32*16; const lds_cptr vp0=shm3+V2_LDS_V+((lane>>4)&1)*32+(lane&3)*8+(4*hi+((lane&15)>>2))*64;
  const int NT=(q0+QB)/KVBLK+1;
  DMA_K(0,0);DMA_V(0,0);DMA_K(1,SLOTB);
  bf16x8 qr[4];
  #pragma unroll
  for(int d0=0;d0<4;++d0)qr[d0]=*reinterpret_cast<const bf16x8*>(&Qw[(long)r32*PQ+d0*16+hi*8]);
  float l_reg=0.f;f32x16 o[4];o[0]=f32x16{};o[1]=f32x16{};o[2]=f32x16{};o[3]=f32x16{};
  const f32x16 zero16=f32x16{};
  const int qrel=wid*QBLK+r32;
  #define CMASK(P0,P1,t) do{int jb_=(t)-(NT-4); if(jb_>=0)cmask(P0,P1,jb_,qrel,hi);}while(0)
  f32x16 pA0,pA1,pB0,pB1;
  int sl_prev=0,sl_cur=0,sl_next=SLOTB;
  #define ROT() do{sl_prev=sl_cur;sl_cur=sl_next;sl_next=(sl_next==(NSLOT-1)*SLOTB)?0:sl_next+SLOTB;}while(0)
  DMA_K(2,2*SLOTB);
  WAIT_BAR(3);
  qkt(pA0,pA1,Kbase,qr,zero16,r32,hi);asm volatile("s_nop 15\n\ts_nop 7":"+v"(pA0),"+v"(pA1));
  { const float NEGI=-INFINITY; _Pragma("unroll") for(int r=8;r<16;++r)pA0[r]=NEGI; _Pragma("unroll") for(int r=0;r<16;++r)pA1[r]=NEGI; }
  _Pragma("unroll") for(int r=0;r<16;++r){pA0[r]=__builtin_amdgcn_exp2f(pA0[r]);pA1[r]=__builtin_amdgcn_exp2f(pA1[r]);}
  WAIT_BAR(0);
  DMA_K(3,0);DMA_V(1,SLOTB);
  ROT();
  kload8(kf,kp0+sl_cur);
  WAIT_BAR(3);
  s16x4 vlo[8],vhi[8]; u32x4 pw0,pw1,pw2,pw3;
  #define PKW(P,B) cvtpk_s(P[B],P[B+1])
  #define PAF(k) __builtin_bit_cast(bf16x8,pw##k)
  #define VFR(i) (bf16x8){vlo[i][0],vlo[i][1],vlo[i][2],vlo[i][3],vhi[i][0],vhi[i][1],vhi[i][2],vhi[i][3]}
  #define PIN(x) asm volatile("":"+v"(x))
  #define GAPA(MF,A0,A1,A2,A3,W0,W1,PW) do{ MF; sacc+=A0; sacc+=A1; sacc+=A2; sacc+=A3; PIN(sacc); W0; W1; PIN(PW); SBAR(); }while(0)
  #define EX(v) __builtin_amdgcn_exp2f(v)
  #define GAPB(MF,X,B) do{ MF; X[B]=EX(X[B]); X[B+1]=EX(X[B+1]); PIN(X); SBAR(); }while(0)
  #define VRD(i) do{ vlo[i]=vtr(vp_+(((i)>>2)*4096+((i)&3)*1024)); vhi[i]=vtr(vp_+(((i)>>2)*4096+((i)&3)*1024+512)); }while(0)
  #define VRD2(i) do{ vlo[i]=vtr(vp_+(8192+((i)>>2)*4096+((i)&3)*1024)); vhi[i]=vtr(vp_+(8192+((i)>>2)*4096+((i)&3)*1024+512)); SBAR(); }while(0)
  #define KRD(G,j) do{ if(G){ kload2(kf,kp0+sl_next,j); SBAR(); } }while(0)
  #define MF32(a,b,c) __builtin_amdgcn_mfma_f32_32x32x16_bf16(a,b,c,0,0,0)
  #define STEP(C0,C1,P0,P1,t,GK,GV,GL) do{ SBAR(); \
    const lds_cptr vp_=vp0+2*sl_prev; \
    VRD(0); SBAR(); float sacc=(P0[0]+P0[1]); \
    GAPA(C0=MF32(kf[0],qr[0],zero16), P0[2],P0[3],P0[4],P0[5],     pw0[0]=PKW(P0,0), pw0[1]=PKW(P0,2), pw0); \
    VRD(4); SBAR(); GAPA(C1=MF32(kf[1],qr[0],zero16), P0[6],P0[7],P0[8],P0[9],     pw0[2]=PKW(P0,4), pw0[3]=PKW(P0,6), pw0); \
    VRD(1); SBAR(); GAPA(C0=MF32(kf[2],qr[1],C0),   P0[10],P0[11],P0[12],P0[13], pw1[0]=PKW(P0,8), pw1[1]=PKW(P0,10), pw1); \
    VRD(5); SBAR(); GAPA(C1=MF32(kf[3],qr[1],C1),   P0[14],P0[15],P1[0],P1[1],   pw1[2]=PKW(P0,12),pw1[3]=PKW(P0,14), pw1); \
    VRD(2); SBAR(); GAPA(C0=MF32(kf[4],qr[2],C0),   P1[2],P1[3],P1[4],P1[5],     pw2[0]=PKW(P1,0), pw2[1]=PKW(P1,2), pw2); \
    VRD(6); SBAR(); GAPA(C1=MF32(kf[5],qr[2],C1),   P1[6],P1[7],P1[8],P1[9],     pw2[2]=PKW(P1,4), pw2[3]=PKW(P1,6), pw2); \
    VRD(3); SBAR(); GAPA(C0=MF32(kf[6],qr[3],C0),   P1[10],P1[11],P1[12],P1[13], pw3[0]=PKW(P1,8), pw3[1]=PKW(P1,10), pw3); \
    VRD(7); SBAR(); GAPA(C1=MF32(kf[7],qr[3],C1),   P1[14],P1[15],0.f,0.f,       pw3[2]=PKW(P1,12),pw3[3]=PKW(P1,14), pw3); \
    l_reg+=sacc; \
    if(GK){DMA_K((t)+3,sl_cur);} if(GV){DMA_V((t)+1,sl_next);} \
    CMASK(C0,C1,t); \
    SBAR(); \
    GAPB(o[0]=MF32(PAF(0),VFR(0),o[0]), C0,0);  VRD2(0); \
    GAPB(o[1]=MF32(PAF(0),VFR(4),o[1]), C0,2);  VRD2(4); \
    KRD(GL,0); GAPB(o[0]=MF32(PAF(1),VFR(1),o[0]), C0,4);  VRD2(1); \
    KRD(GL,1); GAPB(o[1]=MF32(PAF(1),VFR(5),o[1]), C0,6);  VRD2(5); \
    KRD(GL,2); GAPB(o[0]=MF32(PAF(2),VFR(2),o[0]), C0,8);  VRD2(2); \
    KRD(GL,3); GAPB(o[1]=MF32(PAF(2),VFR(6),o[1]), C0,10); VRD2(6); \
    GAPB(o[0]=MF32(PAF(3),VFR(3),o[0]), C0,12); VRD2(3); \
    GAPB(o[1]=MF32(PAF(3),VFR(7),o[1]), C0,14); VRD2(7); \
    GAPB(o[2]=MF32(PAF(0),VFR(0),o[2]), C1,0); \
    GAPB(o[3]=MF32(PAF(0),VFR(4),o[3]), C1,2); \
    GAPB(o[2]=MF32(PAF(1),VFR(1),o[2]), C1,4); \
    GAPB(o[3]=MF32(PAF(1),VFR(5),o[3]), C1,6); \
    GAPB(o[2]=MF32(PAF(2),VFR(2),o[2]), C1,8); \
    GAPB(o[3]=MF32(PAF(2),VFR(6),o[3]), C1,10); \
    GAPB(o[2]=MF32(PAF(3),VFR(3),o[2]), C1,12); \
    GAPB(o[3]=MF32(PAF(3),VFR(7),o[3]), C1,14); \
    }while(0)
  int t=1;
  #undef CMASK
  #define CMASK(P0,P1,t) do{}while(0)
  for(;t+5<NT;t+=2){
    STEP(pB0,pB1,pA0,pA1,t,true,true,true);     WAIT_BAR(3); ROT();
    STEP(pA0,pA1,pB0,pB1,t+1,true,true,true);   WAIT_BAR(3); ROT();
  }
  #undef CMASK
  #define CMASK(P0,P1,t) do{int jb_=(t)-(NT-4); if(jb_>=0)cmask(P0,P1,jb_,qrel,hi);}while(0)
  #define ENDW(tt) do{ if((tt)+3<NT){WAIT_BAR(3);} else if((tt)+2<NT){WAIT_BAR(2);} else {WAIT_BAR(0);} }while(0)
  for(;t+1<NT;t+=2){
    STEP(pB0,pB1,pA0,pA1,t,(t+3<NT),(t+1<NT),(t+1<NT));       ENDW(t);   ROT();
    STEP(pA0,pA1,pB0,pB1,t+1,(t+4<NT),(t+2<NT),(t+2<NT));     ENDW(t+1); ROT();
  }
  { float sacc=pA0[0]+pA0[1]; _Pragma("unroll") for(int r=2;r<16;++r)sacc+=pA0[r]; _Pragma("unroll") for(int r=0;r<16;++r)sacc+=pA1[r]; l_reg+=sacc;
    pw0=(u32x4){PKW(pA0,0),PKW(pA0,2),PKW(pA0,4),PKW(pA0,6)};pw1=(u32x4){PKW(pA0,8),PKW(pA0,10),PKW(pA0,12),PKW(pA0,14)};pw2=(u32x4){PKW(pA1,0),PKW(pA1,2),PKW(pA1,4),PKW(pA1,6)};pw3=(u32x4){PKW(pA1,8),PKW(pA1,10),PKW(pA1,12),PKW(pA1,14)};
    SBAR(); pv4(o,vb0+2*sl_prev,PAF(0),PAF(1),PAF(2),PAF(3)); }
  #undef PKW
  #undef PAF
  #undef VFR
  #undef PIN
  #undef GAPA
  #undef GAPB
  #undef EX
  #undef VRD
  #undef VRD2
  #undef KRD
  #undef MF32
  #undef STEP
  #undef ENDW
  {auto rr=__builtin_amdgcn_permlane32_swap(__float_as_uint(l_reg),__float_as_uint(l_reg),false,false);l_reg=__uint_as_float(rr[0])+__uint_as_float(rr[1]);}
  if(hi==0)wsf[32+r32]=l_reg;asm volatile("s_waitcnt lgkmcnt(0)":::"memory");
  float rli[16];
  #pragma unroll
  for(int r=0;r<16;++r)rli[r]=__builtin_amdgcn_rcpf(wsf[32+crow(r,hi)]);
  { bf16*park=(bf16*)(shm+V2_LDS_OST)+wid*4096;
    if(MODE==0){
      #pragma unroll
      for(int r=0;r<16;++r){const int orow=crow(r,hi);
        #pragma unroll
        for(int d0=0;d0<4;++d0)park[orow*128+d0*32+r32]=__float2bfloat16(o[d0][r]*rli[r]);}
      asm volatile("s_waitcnt lgkmcnt(0)":::"memory");
    } else {
      #pragma unroll
      for(int r=0;r<16;++r){const int orow=crow(r,hi);
        #pragma unroll
        for(int d0=0;d0<4;++d0){const float o1=__bfloat162float(park[orow*128+d0*32+r32]); park[orow*128+d0*32+r32]=__float2bfloat16(o1-lam*(o[d0][r]*rli[r]));}}
      asm volatile("s_waitcnt lgkmcnt(0)":::"memory");
      bf16*Ow=Ou+(long)(wid*QBLK)*PO;
      const int ch=lane&15; const f32x4v g0=*(const f32x4v*)(subg+8*ch), g1=*(const f32x4v*)(subg+8*ch+4);
      #pragma unroll
      for(int i=0;i<8;++i){const int row=i*4+(lane>>4); const u32x4 v=*(const u32x4*)(park+row*128+ch*8);
        float d[8]; d[0]=__uint_as_float(v.x<<16);d[1]=__uint_as_float(v.x&0xffff0000u);d[2]=__uint_as_float(v.y<<16);d[3]=__uint_as_float(v.y&0xffff0000u);d[4]=__uint_as_float(v.z<<16);d[5]=__uint_as_float(v.z&0xffff0000u);d[6]=__uint_as_float(v.w<<16);d[7]=__uint_as_float(v.w&0xffff0000u);
        float ss=(d[0]*d[0]+d[1]*d[1])+(d[2]*d[2]+d[3]*d[3])+(d[4]*d[4]+d[5]*d[5])+(d[6]*d[6]+d[7]*d[7]);
        ss+=__shfl_xor(ss,1);ss+=__shfl_xor(ss,2);ss+=__shfl_xor(ss,4);ss+=__shfl_xor(ss,8);
        const float rs=__builtin_amdgcn_rsqf(ss*(1.0f/128.0f)+1e-6f)*oscale;
        u32x4 w; w.x=cvtpk_s(d[0]*rs*g0[0],d[1]*rs*g0[1]); w.y=cvtpk_s(d[2]*rs*g0[2],d[3]*rs*g0[3]); w.z=cvtpk_s(d[4]*rs*g1[0],d[5]*rs*g1[1]); w.w=cvtpk_s(d[6]*rs*g1[2],d[7]*rs*g1[3]);
        ATTN_STORE16(Ow+(long)row*PO+ch*8,w);}
      asm volatile("s_waitcnt lgkmcnt(0)":::"memory");
    } }
  asm volatile("s_waitcnt lgkmcnt(0)\n\ts_barrier":::"memory");
  #undef DMA_K
  #undef DMA_V
  #undef CMASK
  #undef ROT
}
#undef SBAR
#undef WAIT_BAR

}
namespace cg = cooperative_groups;
constexpr int NWAVES = 8;
constexpr int NB = 4, SEQ = 8192, DM = 1024, NMETA = 16, DIN = 2560, DFF = 4096, DCONV = 512, CONVW = 31;
constexpr int MX = NB * SEQ;
constexpr int MP = MX + 256;
constexpr int SPAD = pg8::SPAD;
constexpr float EPS = 1e-6f;
constexpr size_t MiB = 1u << 20;
constexpr size_t WS_CTL = 0, WS_WIN = 1 * MiB, WS_WOUT = 6 * MiB, WS_WUP = 8 * MiB, WS_WDN = 16 * MiB, WS_ROPE = 24 * MiB, WS_SSQ = 25 * MiB, WS_RN = 27 * MiB,
                 WS_H1B = 28 * MiB, WS_MIX = 92 * MiB, WS_HB = 156 * MiB, WS_XN = 156 * MiB, WS_O = 156 * MiB, WS_Q = 222 * MiB, WS_K = 254 * MiB, WS_V = 287 * MiB, WS_G = 320 * MiB,
                 WS_END = 412 * MiB;
static_assert(WS_XN + (size_t)MP * DM * 2 <= WS_Q && WS_K + (size_t)NB * SPAD * 512 * 2 <= WS_V && WS_G + (size_t)NB * SPAD * 512 * 2 <= WS_HB + (size_t)MX * DFF * 2 && WS_HB + (size_t)MX * DFF * 2 <= WS_END, "d_ws map");
constexpr int RING_BYTES = 131072, LDS_BYTES = 147456;
#ifndef WGM_P1
#define WGM_P1 4
#endif
#ifndef WGM_P4
#define WGM_P4 4
#endif
#ifndef WGM_P35
#define WGM_P35 4
#endif

#define LAS __attribute__((address_space(3)))
typedef unsigned short bf16;
typedef unsigned v4u __attribute__((ext_vector_type(4)));
typedef float f32x4 __attribute__((ext_vector_type(4)));
typedef float f32x2 __attribute__((ext_vector_type(2)));
#define LDS_WAIT() asm volatile("s_waitcnt lgkmcnt(0)" ::: "memory")
__device__ __forceinline__ unsigned pk2(float lo, float hi) { return pg8::cvt_pk_bf16(lo, hi); }
__device__ __forceinline__ float bf_lo(unsigned u) { return __uint_as_float(u << 16); }
__device__ __forceinline__ float bf_hi(unsigned u) { return __uint_as_float(u & 0xffff0000u); }
__device__ __forceinline__ float wave_sum(float v) {
#pragma unroll
    for (int o = 1; o < 64; o <<= 1) v += __shfl_xor(v, o);
    return v;
}

#define XB_TMO      128
#define XB_XCNT(j)  (256  + 64 * (j))
#define XB_XSUB(j)  (1280 + 64 * (j))
#define XB_XGEN(j)  (2304 + 64 * (j))
#define XB_TOP      3328
#define XB_TOPGEN   3392
#define XCD_BAR_WORDS 3456
#define XB_SPIN_CAP (1u << 18)

__device__ __forceinline__ unsigned xb_ld(unsigned* p)              { return __hip_atomic_load(p, __ATOMIC_RELAXED, __HIP_MEMORY_SCOPE_AGENT); }
__device__ __forceinline__ unsigned xb_add(unsigned* p, unsigned v) { return __hip_atomic_fetch_add(p, v, __ATOMIC_RELAXED, __HIP_MEMORY_SCOPE_AGENT); }
__device__ __forceinline__ unsigned xb_xcc_id() { return (unsigned)__builtin_amdgcn_s_getreg((3 << 11) | 20) & 0xFu; }
#define XB_SPIN(cond, bar) do { unsigned _sp = 0; while (cond) { __builtin_amdgcn_s_sleep(1); \
    if ((++_sp & 255u) == 0u) { if (xb_ld(&(bar)[XB_TMO])) break; if (_sp > XB_SPIN_CAP) { atomicAdd(&(bar)[XB_TMO], 1u); break; } } } } while (0)

struct XcdBarrier {
    unsigned* bar; unsigned x;
    volatile LAS unsigned* st;
};

__device__ __forceinline__ XcdBarrier xcd_barrier_post(unsigned* bar, volatile LAS unsigned* st) {
    XcdBarrier b; b.bar = bar; b.x = xb_xcc_id(); b.st = st;
    if (threadIdx.x == 0) (void)xb_add(&bar[XB_XCNT(b.x)], 1u);
    return b;
}
__device__ __forceinline__ void xcd_barrier_complete(unsigned* bar, unsigned x, unsigned& nloc, unsigned& nx) {
    const unsigned G = gridDim.x * gridDim.y * gridDim.z;
    unsigned sum, cnt, mine, sp = 0u;
    for (;;) {
        sum = 0u; cnt = 0u; mine = 0u;
#pragma unroll
        for (unsigned j = 0; j < 16; ++j) { const unsigned c = xb_ld(&bar[XB_XCNT(j)]); sum += c; cnt += (c > 0u) ? 1u : 0u; mine = (j == x) ? c : mine; }
        if (sum == G) break;
        __builtin_amdgcn_s_sleep(1);
        if ((++sp & 255u) == 0u) { if (xb_ld(&bar[XB_TMO])) break; if (sp > XB_SPIN_CAP) { atomicAdd(&bar[XB_TMO], 1u); break; } }
    }
    nloc = mine > 0u ? mine : 1u; nx = cnt > 0u ? cnt : 1u;
}

__device__ __forceinline__ void xcd_barrier(const XcdBarrier& b) {
    asm volatile("s_waitcnt vmcnt(0)" ::: "memory");
    __syncthreads();
    if (threadIdx.x == 0) {
        unsigned* bar = b.bar;
        __builtin_amdgcn_s_waitcnt(0);
        unsigned nloc = b.st[0], nx = b.st[1];
        if (nloc == 0u) { xcd_barrier_complete(bar, b.x, nloc, nx); b.st[0] = nloc; b.st[1] = nx; }
        const unsigned old = xb_add(&bar[XB_XSUB(b.x)], 1u);
        const unsigned gen = old / nloc;
        if (old + 1u == (gen + 1u) * nloc) {
            __builtin_amdgcn_fence(__ATOMIC_RELEASE, "agent");
            asm volatile("s_waitcnt vmcnt(0)" ::: "memory");
            const unsigned og = xb_add(&bar[XB_TOP], 1u);
            const unsigned tg = og / nx;
            if (og + 1u == (tg + 1u) * nx) xb_add(&bar[XB_TOPGEN], 1u);
            else XB_SPIN(xb_ld(&bar[XB_TOPGEN]) == tg, bar);
            __builtin_amdgcn_fence(__ATOMIC_ACQUIRE, "agent");
            xb_add(&bar[XB_XGEN(b.x)], 1u);
            asm volatile("s_waitcnt vmcnt(0)" ::: "memory");
        } else {
            XB_SPIN(xb_ld(&bar[XB_XGEN(b.x)]) == gen, bar);
            __builtin_amdgcn_fence(__ATOMIC_ACQUIRE, "agent");
            asm volatile("s_waitcnt vmcnt(0)" ::: "memory");
        }
    }
    __syncthreads();
}

__device__ __forceinline__ float dpp_add(float v, const int ctrl_sel) {
    int t;
    if (ctrl_sel == 0) t = __builtin_amdgcn_update_dpp(0, __float_as_int(v), 0xB1, 0xF, 0xF, true);
    else if (ctrl_sel == 1) t = __builtin_amdgcn_update_dpp(0, __float_as_int(v), 0x4E, 0xF, 0xF, true);
    else if (ctrl_sel == 2) t = __builtin_amdgcn_update_dpp(0, __float_as_int(v), 0x141, 0xF, 0xF, true);
    else t = __builtin_amdgcn_update_dpp(0, __float_as_int(v), 0x140, 0xF, 0xF, true);
    return v + __int_as_float(t);
}
__device__ __forceinline__ float wave_sum_fast(float v) {
    v = dpp_add(v, 0); v = dpp_add(v, 1); v = dpp_add(v, 2); v = dpp_add(v, 3);
    { auto rr = __builtin_amdgcn_permlane16_swap(__float_as_uint(v), __float_as_uint(v), false, false); v = __uint_as_float(rr[0]) + __uint_as_float(rr[1]); }
    { auto rr = __builtin_amdgcn_permlane32_swap(__float_as_uint(v), __float_as_uint(v), false, false); v = __uint_as_float(rr[0]) + __uint_as_float(rr[1]); }
    return v;
}

struct Args { const float* in[19]; float* out; unsigned char* ws; float inv_freq[8]; };
enum { I_X = 0, I_META, I_G1, I_WIN, I_QG, I_KG, I_LQ1, I_LK1, I_LQ2, I_LK2, I_SUBLN, I_CW, I_CB, I_CLG, I_CLB, I_WOUT, I_G2, I_WUP, I_WDN };

__device__ __forceinline__ void p0_transpose_item(const float* W, int K, int N, bf16* WT, int out_row0, int n0, int k0, const float* kscale, LAS float* scr, int lane) {
    float tv[32], ts[32];
#pragma unroll
    for (int i = 0; i < 32; ++i) { const int kk = 2 * i + (lane >> 5); tv[i] = W[(size_t)(k0 + kk) * N + n0 + (lane & 31)]; ts[i] = kscale ? kscale[k0 + kk] : 1.0f; }
#pragma unroll
    for (int i = 0; i < 32; ++i) { const int kk = 2 * i + (lane >> 5); scr[kk * 33 + (lane & 31)] = tv[i] * ts[i]; }
    LDS_WAIT(); asm volatile("" ::: "memory");
    const int c = lane & 7;
#pragma unroll
    for (int j = 0; j < 4; ++j) { const int n = (lane >> 3) + 8 * j; const LAS float* s = scr + (8 * c) * 33 + n;
        v4u o; o.x = pk2(s[0 * 33], s[1 * 33]); o.y = pk2(s[2 * 33], s[3 * 33]); o.z = pk2(s[4 * 33], s[5 * 33]); o.w = pk2(s[6 * 33], s[7 * 33]);
        *(v4u*)(WT + (size_t)(out_row0 + n) * K + k0 + 8 * c) = o; }
    LDS_WAIT(); asm volatile("" ::: "memory");
}
__device__ __forceinline__ int win_pcol(int lc) {
    if (lc < 1024) { const int l = lc & 255; return (lc & ~255) + 128 * ((l >> 5) & 1) + 32 * (l >> 6) + (l & 31); }
    if (lc < 1536) return lc;
    if (lc < 2048) { const int ch = lc - 1536; return 1536 + 256 * (ch >> 7) + (ch & 127); }
    const int ch = lc - 2048; return 1536 + 256 * (ch >> 7) + 128 + (ch & 127);
}

__device__ __forceinline__ void p0_prologue(const Args& A, unsigned char* ws, LAS unsigned char* lds, int vcu, int G, int wave, int lane) {
    LAS float* scr = (LAS float*)(lds + wave * 16384);
    const int gw = vcu * NWAVES + wave, NGW = G * NWAVES;
    bf16* Win_t = (bf16*)(ws + WS_WIN); bf16* Wout_t = (bf16*)(ws + WS_WOUT); bf16* Wup_t = (bf16*)(ws + WS_WUP); bf16* Wdn_t = (bf16*)(ws + WS_WDN);
    constexpr int I_IN = (DM / 64) * (DIN / 32);
    for (int it = gw; it < I_IN; it += NGW) { const int nblk = DIN / 32, kb = it / nblk, nb = it % nblk; p0_transpose_item(A.in[I_WIN], DM, DIN, Win_t, win_pcol(32 * nb), 32 * nb, 64 * kb, nullptr, scr, lane); }
    {
        bf16* XN = (bf16*)(ws + WS_XN);
        f32x4 g[4];
#pragma unroll
        for (int j = 0; j < 4; ++j) g[j] = ((const f32x4*)A.in[I_G1])[lane + 64 * j];
        for (int m0 = gw; m0 < MX + NMETA; m0 += 4 * NGW) {
            f32x4 v[4][4];
#pragma unroll
            for (int q = 0; q < 4; ++q) { const int m = m0 + q * NGW; const bool ok = m < MX + NMETA;
                const float* src = !ok ? A.in[I_X] : (m < MX) ? A.in[I_X] + (size_t)m * DM : A.in[I_META] + (size_t)(m - MX) * DM;
                const f32x4* xr = (const f32x4*)src + lane;
#pragma unroll
                for (int j = 0; j < 4; ++j) v[q][j] = xr[64 * j]; }
#pragma unroll
            for (int q = 0; q < 4; ++q) { const int m = m0 + q * NGW; if (m >= MX + NMETA) continue;
                float s = 0.f;
#pragma unroll
                for (int j = 0; j < 4; ++j) s += (v[q][j].x * v[q][j].x + v[q][j].y * v[q][j].y) + (v[q][j].z * v[q][j].z + v[q][j].w * v[q][j].w);
                const float ms = wave_sum_fast(s) * (1.f / DM) + EPS; const float rs = __builtin_amdgcn_rsqf(ms);
                if (lane == 0 && m < MX) ((float*)(ws + WS_RN))[m] = ms * rs;
                unsigned long long* o8 = (unsigned long long*)(XN + (size_t)m * DM) + lane;
#pragma unroll
                for (int j = 0; j < 4; ++j) { const f32x4 y = v[q][j] * rs * g[j]; o8[64 * j] = (unsigned long long)pk2(y.x, y.y) | ((unsigned long long)pk2(y.z, y.w) << 32); } }
        }
    }
    {
        float* rope = (float*)(ws + WS_ROPE);
        const int pos = gw * 64 + lane;
        if (pos < SEQ + NMETA) {
#pragma unroll
            for (int i = 0; i < 8; ++i) {
                const float angf = (float)pos * A.inv_freq[i];
                const double rev = (double)angf * 0.15915494309189533577; const double fr = rev - __builtin_rint(rev);
                const float f = (float)fr;
                rope[pos * 16 + i] = __builtin_amdgcn_cosf(f); rope[pos * 16 + 8 + i] = __builtin_amdgcn_sinf(f); } }
    }
    {
        bf16* KB = (bf16*)(ws + WS_K); bf16* VB = (bf16*)(ws + WS_V); bf16* GB = (bf16*)(ws + WS_G);
        for (int it = gw; it < NB * 48 * 3; it += NGW) { const int which = it / (NB * 48), r = it % (NB * 48), b = r / 48, rr = r % 48;
            bf16* p = which == 0 ? KB + (size_t)(b * SPAD + 16 + rr) * 512 : which == 1 ? VB + (size_t)(b * SPAD + 16 + rr) * 512 : GB + (size_t)(b * SPAD + rr) * 512;
            ((v4u*)p)[lane] = (v4u){0u, 0u, 0u, 0u}; }
    }
}

__device__ __forceinline__ void meta_proj(const Args& A, unsigned char* ws, LAS unsigned char* lds, int vcu, int wave, int lane) {
    typedef short bf16x8 __attribute__((ext_vector_type(8)));
    const int fr = lane & 15, fq = lane >> 4;
    const int item = vcu * 2 + (wave >> 2), kc = wave & 3;
    const int kind = item < 8 ? 0 : item < 16 ? 1 : 2, g = kind == 2 ? item - 16 : (item & 7);
    const bf16* XNm = (const bf16*)(ws + WS_XN) + (size_t)(MX + fr) * DM + 8 * fq + 256 * kc;
    const bf16* Wt = (const bf16*)(ws + WS_WIN);
    const bf16* brow[4];
#pragma unroll
    for (int nb = 0; nb < 4; ++nb) { const int lc = kind == 0 ? 512 + 64 * g + 16 * nb + fr : kind == 1 ? 1024 + 64 * g + 16 * nb + fr : (nb < 2 ? 1536 + 32 * g + 16 * nb + fr : 2048 + 32 * g + 16 * (nb - 2) + fr);
        brow[nb] = Wt + (size_t)(win_pcol(lc & ~31) + (lc & 31)) * DM + 8 * fq + 256 * kc; }
    bf16x8 af[8], bf[8][4];
#pragma unroll
    for (int ks = 0; ks < 8; ++ks) { af[ks] = *(const bf16x8*)(XNm + 32 * ks);
#pragma unroll
        for (int nb = 0; nb < 4; ++nb) bf[ks][nb] = *(const bf16x8*)(brow[nb] + 32 * ks); }
    asm volatile("" ::: "memory");
    f32x4 acc[4];
#pragma unroll
    for (int nb = 0; nb < 4; ++nb) acc[nb] = (f32x4){0.f, 0.f, 0.f, 0.f};
#pragma unroll
    for (int ks = 0; ks < 8; ++ks)
#pragma unroll
        for (int nb = 0; nb < 4; ++nb) acc[nb] = __builtin_amdgcn_mfma_f32_16x16x32_bf16(bf[ks][nb], af[ks], acc[nb], 0, 0, 0);
    LAS f32x4* red = (LAS f32x4*)lds;
#pragma unroll
    for (int nb = 0; nb < 4; ++nb) red[(wave * 4 + nb) * 64 + lane] = acc[nb];
    __syncthreads();
    if (kc == 0) {
#pragma unroll
        for (int nb = 0; nb < 4; ++nb) acc[nb] = (red[((wave + 0) * 4 + nb) * 64 + lane] + red[((wave + 1) * 4 + nb) * 64 + lane]) + (red[((wave + 2) * 4 + nb) * 64 + lane] + red[((wave + 3) * 4 + nb) * 64 + lane]);
        if (kind == 0) {
            float ss = 0.f;
#pragma unroll
            for (int nb = 0; nb < 4; ++nb) ss += (acc[nb][0] * acc[nb][0] + acc[nb][1] * acc[nb][1]) + (acc[nb][2] * acc[nb][2] + acc[nb][3] * acc[nb][3]);
            ss += __shfl_xor(ss, 16); ss += __shfl_xor(ss, 32);
            const float rs = __builtin_amdgcn_rsqf(ss * (1.0f / 64.0f) + EPS);
#pragma unroll
            for (int nb = 0; nb < 4; ++nb) acc[nb] = acc[nb] * rs * *(const f32x4*)(A.in[I_KG] + 16 * nb + 4 * fq);
            f32x4 p; p[0] = __shfl_xor(acc[0][0], 32); p[1] = __shfl_xor(acc[0][1], 32); p[2] = __shfl_xor(acc[0][2], 32); p[3] = __shfl_xor(acc[0][3], 32);
            const float* rp = (const float*)(ws + WS_ROPE) + fr * 16 + 4 * (fq & 1);
            const f32x4 c = *(const f32x4*)rp, s = *(const f32x4*)(rp + 8);
            const float sg = (fq & 2) ? 1.f : -1.f;
            acc[0] = acc[0] * c + (p * s) * sg;
        }
        if (kind == 2) {
#pragma unroll
            for (int nb = 0; nb < 2; ++nb)
#pragma unroll
                for (int e = 0; e < 4; ++e) acc[nb][e] = acc[nb][e] * __builtin_amdgcn_rcpf(1.0f + __builtin_amdgcn_exp2f(-1.4426950408889634f * acc[nb + 2][e]));
        }
        bf16* dst = kind == 0 ? (bf16*)(ws + WS_K) : kind == 1 ? (bf16*)(ws + WS_V) : (bf16*)(ws + WS_G);
        const int r0 = kind == 2 ? 48 + fr : fr, c0 = (kind == 2 ? 32 * g : 64 * g) + 4 * fq, nnb = kind == 2 ? 2 : 4;
#pragma unroll 1
        for (int b = 0; b < NB; ++b) { bf16* o = dst + (size_t)(b * SPAD + r0) * 512 + c0;
#pragma unroll
            for (int nb = 0; nb < 4; ++nb) if (nb < nnb) *(unsigned long long*)(o + 16 * nb) = (unsigned long long)pk2(acc[nb][0], acc[nb][1]) | ((unsigned long long)pk2(acc[nb][2], acc[nb][3]) << 32); }
    }
    __syncthreads();
}

__device__ __forceinline__ void wconv_phase(const Args& A, unsigned char* ws, LAS unsigned char* lds, int wave, int lane) {
    LAS float* scr = (LAS float*)(lds + wave * 16384);
    bf16* Wout_t = (bf16*)(ws + WS_WOUT); bf16* Wup_t = (bf16*)(ws + WS_WUP); bf16* Wdn_t = (bf16*)(ws + WS_WDN);
    constexpr int I_OUT = (DM / 64) * (DM / 32), I_UP = (DM / 64) * (DFF / 32), I_DN = (DFF / 64) * (DM / 32), NIT = I_OUT + I_UP + I_DN;
    unsigned* wq = (unsigned*)(ws + WS_CTL) + 96;
    volatile LAS unsigned* TK = (volatile LAS unsigned*)(lds + LDS_BYTES - 256 + 64);
    for (;;) {
        if (wave == 0 && lane == 0) TK[0] = __hip_atomic_fetch_add(wq, 1u, __ATOMIC_RELAXED, __HIP_MEMORY_SCOPE_AGENT);
        __syncthreads();
        const int t = (int)TK[0];
        __syncthreads();
        if (t * NWAVES >= NIT) break;
        int r = t * NWAVES + wave;
        if (r >= NIT) continue;
        if (r < I_OUT) { const int nblk = DM / 32, kb = r / nblk, nb = r % nblk; p0_transpose_item(A.in[I_WOUT], DM, DM, Wout_t, 32 * nb, 32 * nb, 64 * kb, nullptr, scr, lane); continue; } r -= I_OUT;
        if (r < I_UP) { const int nblk = DFF / 32, kb = r / nblk, nb = r % nblk; p0_transpose_item(A.in[I_WUP], DM, DFF, Wup_t, 32 * nb, 32 * nb, 64 * kb, A.in[I_G2], scr, lane); continue; } r -= I_UP;
        { const int nblk = DM / 32, kb = r / nblk, nb = r % nblk; p0_transpose_item(A.in[I_WDN], DFF, DM, Wdn_t, 32 * nb, 32 * nb, 64 * kb, nullptr, scr, lane); }
    }
}

constexpr int CONV_R = 32;
__device__ __forceinline__ void conv_phase(const Args& A, unsigned char* ws, LAS unsigned char* lds, int vcu, int G, int wave, int lane) {
    LAS float* cbuf = (LAS float*)lds;
    const bf16* GB = (const bf16*)(ws + WS_G); bf16* MIX = (bf16*)(ws + WS_MIX);
    const int cp = (wave & 3) * 64 + lane, half = wave >> 2;
    f32x2 w[CONVW];
#pragma unroll
    for (int j = 0; j < CONVW; ++j) w[j] = *(const f32x2*)(A.in[I_CW] + j * DCONV + 2 * cp);
    const f32x2 bias = *(const f32x2*)(A.in[I_CB] + 2 * cp);
    const f32x4 lg0 = *(const f32x4*)(A.in[I_CLG] + lane * 8), lg1 = *(const f32x4*)(A.in[I_CLG] + lane * 8 + 4), lb0 = *(const f32x4*)(A.in[I_CLB] + lane * 8), lb1 = *(const f32x4*)(A.in[I_CLB] + lane * 8 + 4);
    constexpr int NITEMS = MX / (2 * CONV_R);
    unsigned* cq = (unsigned*)(ws + WS_CTL) + 32;
    volatile LAS unsigned* TK = (volatile LAS unsigned*)(lds + LDS_BYTES - 256 + 64);
    if (wave == 0 && lane == 0) { TK[0] = __hip_atomic_fetch_add(cq, 1u, __ATOMIC_RELAXED, __HIP_MEMORY_SCOPE_AGENT); TK[1] = __hip_atomic_fetch_add(cq, 1u, __ATOMIC_RELAXED, __HIP_MEMORY_SCOPE_AGENT); }
    __syncthreads();
    int it = (int)TK[0], nxt = (int)TK[1];
    __syncthreads();
#define CONV_SRC(item, sub) (GB + (size_t)(((((item) * 2 * CONV_R + half * CONV_R + (sub) * 16) >> 13) * SPAD) + 34 + (((item) * 2 * CONV_R + half * CONV_R + (sub) * 16) & 8191)) * 512 + 2 * cp)
#define CONV_LOAD(buf, item, sub) do { const bf16* gs_ = CONV_SRC(item, sub); _Pragma("unroll") for (int i = 0; i < 46; ++i) buf[i] = *(const unsigned*)(gs_ + (size_t)i * 512); } while (0)
#define CONV_FMA(buf, sub) do { f32x2 acc[16]; _Pragma("unroll") for (int o = 0; o < 16; ++o) acc[o] = bias; \
        _Pragma("unroll") for (int i = 0; i < 46; ++i) { const f32x2 x = {bf_lo(buf[i]), bf_hi(buf[i])}; _Pragma("unroll") for (int o = 0; o < 16; ++o) { const int j = i - o; if (j >= 0 && j < CONVW) acc[o] += w[j] * x; } } \
        _Pragma("unroll") for (int o = 0; o < 16; ++o) *(LAS f32x2*)(cbuf + (half * CONV_R + (sub) * 16 + o) * DCONV + 2 * cp) = acc[o]; } while (0)
    unsigned bufA[46], bufB[46];
    if (it < NITEMS) CONV_LOAD(bufA, it, 0);
#pragma unroll 1
    while (it < NITEMS) {
        if (wave == 0 && lane == 0) TK[0] = __hip_atomic_fetch_add(cq, 1u, __ATOMIC_RELAXED, __HIP_MEMORY_SCOPE_AGENT);
        CONV_LOAD(bufB, it, 1);
        CONV_FMA(bufA, 0);
        if (nxt < NITEMS) CONV_LOAD(bufA, nxt, 0);
        CONV_FMA(bufB, 1);
        __syncthreads();
        const int nn = (int)TK[0];
#pragma unroll
        for (int rr = 0; rr < 8; ++rr) { const int lr = wave * 8 + rr;
            f32x4 x0 = *(const LAS f32x4*)(cbuf + lr * DCONV + lane * 8), x1 = *(const LAS f32x4*)(cbuf + lr * DCONV + lane * 8 + 4);
            const float mu = wave_sum_fast((x0[0] + x0[1]) + (x0[2] + x0[3]) + (x1[0] + x1[1]) + (x1[2] + x1[3])) * (1.f / DCONV);
            x0 = x0 - mu; x1 = x1 - mu;
            const float var = wave_sum_fast((x0[0] * x0[0] + x0[1] * x0[1]) + (x0[2] * x0[2] + x0[3] * x0[3]) + (x1[0] * x1[0] + x1[1] * x1[1]) + (x1[2] * x1[2] + x1[3] * x1[3])) * (1.f / DCONV);
            const float rs = __builtin_amdgcn_rsqf(var + EPS);
            x0 = x0 * rs * lg0 + lb0; x1 = x1 * rs * lg1 + lb1;
#pragma unroll
            for (int e = 0; e < 4; ++e) { x0[e] = x0[e] * __builtin_amdgcn_rcpf(1.0f + __builtin_amdgcn_exp2f(-1.4426950408889634f * x0[e])); x1[e] = x1[e] * __builtin_amdgcn_rcpf(1.0f + __builtin_amdgcn_exp2f(-1.4426950408889634f * x1[e])); }
            *(v4u*)(MIX + (size_t)(it * 2 * CONV_R + lr) * DM + 512 + lane * 8) = pg8::pack8(x0, x1); }
        __syncthreads();
        it = nxt; nxt = nn;
    }
#undef CONV_SRC
#undef CONV_LOAD
#undef CONV_FMA
}

__device__ __forceinline__ void combine_phase(const Args& A, unsigned char* ws, int vcu, int G, int wave, int lane) {
    const bf16* OB = (const bf16*)(ws + WS_O); bf16* MIX = (bf16*)(ws + WS_MIX);
    const float d1 = wave_sum(A.in[I_LQ1][lane] * A.in[I_LK1][lane]), d2 = wave_sum(A.in[I_LQ2][lane] * A.in[I_LK2][lane]);
    const float lam_init = 0.2f;
    const float lam = __builtin_amdgcn_exp2f(d1 * 1.4426950408889634f) - __builtin_amdgcn_exp2f(d2 * 1.4426950408889634f) + lam_init;
    const int h = lane >> 4, q = lane & 15;
    const f32x4 sg0 = *(const f32x4*)(A.in[I_SUBLN] + 8 * q), sg1 = *(const f32x4*)(A.in[I_SUBLN] + 8 * q + 4);
    const int gw = vcu * NWAVES + wave, NGW = G * NWAVES;
    for (int row = gw; row < MX; row += NGW) {
        const bf16* o1 = OB + (size_t)row * 1024 + h * 256 + 8 * q;
        const v4u a = *(const v4u*)o1, bq = *(const v4u*)(o1 + 128);
        f32x4 d0, d1v;
        d0[0] = bf_lo(a.x) - lam * bf_lo(bq.x); d0[1] = bf_hi(a.x) - lam * bf_hi(bq.x); d0[2] = bf_lo(a.y) - lam * bf_lo(bq.y); d0[3] = bf_hi(a.y) - lam * bf_hi(bq.y);
        d1v[0] = bf_lo(a.z) - lam * bf_lo(bq.z); d1v[1] = bf_hi(a.z) - lam * bf_hi(bq.z); d1v[2] = bf_lo(a.w) - lam * bf_lo(bq.w); d1v[3] = bf_hi(a.w) - lam * bf_hi(bq.w);
        float ss = (d0[0] * d0[0] + d0[1] * d0[1]) + (d0[2] * d0[2] + d0[3] * d0[3]) + (d1v[0] * d1v[0] + d1v[1] * d1v[1]) + (d1v[2] * d1v[2] + d1v[3] * d1v[3]);
        ss += __shfl_xor(ss, 1); ss += __shfl_xor(ss, 2); ss += __shfl_xor(ss, 4); ss += __shfl_xor(ss, 8);
        const float rs = __builtin_amdgcn_rsqf(ss * (1.f / 128.f) + EPS) * (1.0f - lam_init);
        *(v4u*)(MIX + (size_t)row * DM + h * 128 + 8 * q) = pg8::pack8(d0 * rs * sg0, d1v * rs * sg1);
    }
}

__global__ void __launch_bounds__(NWAVES * 64, 2) hymba_fwd(Args args) {
    extern __shared__ __attribute__((aligned(16))) unsigned char lds[];
    cg::grid_group grid = cg::this_grid();
    LAS unsigned char* ldsl = (LAS unsigned char*)lds;
    volatile LAS unsigned* MISC = (volatile LAS unsigned*)(ldsl + LDS_BYTES - 256);
    if (threadIdx.x < 32) MISC[threadIdx.x] = 0u;
    __syncthreads();
    const XcdBarrier bar = xcd_barrier_post((unsigned*)(args.ws + WS_CTL) + 4096, MISC + 8);
    const int G = gridDim.x; const int bx = blockIdx.x; const int vcu = (G % 8 == 0) ? (bx % 8) * (G / 8) + bx / 8 : bx;
#ifndef PROBE_DUP
#define PROBE_DUP 0
#endif
#define REP(mask) for (int rep_ = 0; rep_ < (((PROBE_DUP) & (mask)) ? 2 : 1); ++rep_)
#define PHASE_VARS() unsigned char* ws = args.ws; int tid_ = threadIdx.x; asm volatile("" : "+v"(tid_)); const int lane = tid_ & 63, wave = __builtin_amdgcn_readfirstlane(tid_ >> 6); (void)lane; (void)wave

    REP(1) { PHASE_VARS(); p0_prologue(args, ws, ldsl, vcu, G, wave, lane); }
    if (args.ws == nullptr) grid.sync();
    xcd_barrier(bar);

    REP(2) {
        PHASE_VARS();
        if (vcu < 16 && G >= 16) meta_proj(args, ws, ldsl, vcu, wave, lane);
        pg8::Gemm g{(bf16*)(ws + WS_XN), (bf16*)(ws + WS_WIN), MX, DIN, DM}; pg8::StaticOrder S; S.init(MX, DIN, G, bx, WGM_P1);
        pg8::EpiInProj E{(bf16*)(ws + WS_Q), (bf16*)(ws + WS_K), (bf16*)(ws + WS_V), (bf16*)(ws + WS_G), args.in[I_QG], args.in[I_KG], (const float*)(ws + WS_ROPE)};
        pg8::gemm_phase<pg8::EpiInProj, pg8::StaticOrder, PG8_ALIGN, PG8_SP2>(ldsl, g, S, E);
    }
    xcd_barrier(bar);

    REP(8) {
        PHASE_VARS();
        static_assert(attn_body::V2_LDS_BYTES <= LDS_BYTES - 256, "attention LDS");
        const float dq1 = wave_sum(args.in[I_LQ1][lane] * args.in[I_LK1][lane]), dq2 = wave_sum(args.in[I_LQ2][lane] * args.in[I_LK2][lane]);
        const float lam_init = 0.2f;
        const float lam = __builtin_amdgcn_exp2f(dq1 * 1.4426950408889634f) - __builtin_amdgcn_exp2f(dq2 * 1.4426950408889634f) + lam_init;
        for (int vv = vcu; vv < 256; vv += G) {
            const int bh = vv >> 4, s = vv & 15;
            const int b = bh >> 2, head = bh & 3;
            const attn_body::bf16* Kh = (const attn_body::bf16*)(ws + WS_K) + (size_t)(b * SPAD) * 512 + head * 128;
            const attn_body::bf16* Vh = (const attn_body::bf16*)(ws + WS_V) + (size_t)(b * SPAD) * 512 + head * 128;
            for (int i = 0; i < 2; ++i) {
                const int qb = i ? 31 - s : s;
                const int q0 = qb * 256;
                const attn_body::bf16* Qu = (const attn_body::bf16*)(ws + WS_Q) + (size_t)(b * SEQ + q0) * 512 + head * 128;
                attn_body::bf16* Mu = (attn_body::bf16*)(ws + WS_MIX) + (size_t)(b * SEQ + q0) * 1024 + head * 128;
                attn_body::attn_unit128<0>(q0, Qu, Kh, Vh, Mu, (char*)lds, lam, 1.0f - lam_init, args.in[I_SUBLN]);
                attn_body::attn_unit128<1>(q0, Qu + 64, Kh + 64, Vh, Mu, (char*)lds, lam, 1.0f - lam_init, args.in[I_SUBLN]);
            }
        }
    }
    REP(4) { PHASE_VARS(); conv_phase(args, ws, ldsl, vcu, G, wave, lane); }
    { PHASE_VARS(); wconv_phase(args, ws, ldsl, wave, lane); }
    xcd_barrier(bar);

    REP(32) {
        PHASE_VARS();
        pg8::Gemm g{(bf16*)(ws + WS_MIX), (bf16*)(ws + WS_WOUT), MX, DM, DM}; pg8::StaticOrder S; S.init(MX, DM, G, bx, WGM_P35);
        pg8::EpiOut E{(const bf16*)(ws + WS_XN), (const float*)(ws + WS_RN), args.in[I_G1], (bf16*)(ws + WS_H1B), (float*)(ws + WS_SSQ)};
        pg8::gemm_phase<pg8::EpiOut, pg8::StaticOrder, PG8_ALIGN, PG8_SP2>(ldsl, g, S, E);
    }
    xcd_barrier(bar);

    REP(64) {
        PHASE_VARS();
        pg8::Gemm g{(bf16*)(ws + WS_H1B), (bf16*)(ws + WS_WUP), MX, DFF, DM}; pg8::StaticOrder S; S.init(MX, DFF, G, bx, WGM_P4);
        pg8::EpiUp E{(bf16*)(ws + WS_HB), (const float*)(ws + WS_SSQ)};
        pg8::gemm_phase<pg8::EpiUp, pg8::StaticOrder, PG8_ALIGN, PG8_SP2>(ldsl, g, S, E);
    }
    xcd_barrier(bar);

    {
        PHASE_VARS();
        pg8::Gemm g{(bf16*)(ws + WS_HB), (bf16*)(ws + WS_WDN), MX, DM, DFF}; pg8::StaticOrder S; S.init(MX, DM, G, bx, WGM_P35);
        pg8::EpiDown E{(const bf16*)(ws + WS_H1B), args.out};
        pg8::gemm_phase<pg8::EpiDown, pg8::StaticOrder, PG8_ALIGN, PG8_SP2>(ldsl, g, S, E);
    }
#undef PHASE_VARS
#undef REP
}

extern "C" void kernel_launch(void* const* d_in, const int* in_sizes, int n_in, void* d_out, int out_size, void* d_ws, size_t ws_size, hipStream_t stream) {
    static int grid = 0;
    if (grid == 0) {
        if (n_in != 19 || in_sizes[0] != MX * DM || out_size != MX * DM || ws_size < WS_END) { fprintf(stderr, "kernel_launch: unexpected shapes: n_in %d, in0 %d, out %d, ws %zu (need %zu); nothing launched\n", n_in, n_in > 0 ? in_sizes[0] : -1, out_size, ws_size, (size_t)WS_END); grid = -1; return; }
        int dev = 0, cus = 0, per_cu = 0;
        if (hipGetDevice(&dev) != hipSuccess || hipDeviceGetAttribute(&cus, hipDeviceAttributeMultiprocessorCount, dev) != hipSuccess) { fprintf(stderr, "kernel_launch: device query failed\n"); grid = -1; return; }
        if (hipFuncSetAttribute((const void*)hymba_fwd, hipFuncAttributeMaxDynamicSharedMemorySize, LDS_BYTES) != hipSuccess) { fprintf(stderr, "kernel_launch: hipFuncSetAttribute failed\n"); grid = -1; return; }
        if (hipOccupancyMaxActiveBlocksPerMultiprocessor(&per_cu, (const void*)hymba_fwd, NWAVES * 64, LDS_BYTES) != hipSuccess || per_cu < 1) { fprintf(stderr, "kernel_launch: occupancy query says %d\n", per_cu); per_cu = 1; }
        (void)hipGetLastError();
        grid = cus * 1;
        fprintf(stderr, "kernel_launch: grid %d (occupancy query %d per CU)\n", grid, per_cu);
    }
    if (grid < 0) return;
    Args a{};
    for (int i = 0; i < 19; ++i) a.in[i] = (const float*)d_in[i];
    a.out = (float*)d_out; a.ws = (unsigned char*)d_ws;
    for (int i = 0; i < 8; ++i) a.inv_freq[i] = (float)pow(500000.0, -(double)i / 8.0);
    if (hipMemsetAsync((char*)d_ws + WS_CTL, 0, 65536, stream) != hipSuccess) { fprintf(stderr, "kernel_launch: hipMemsetAsync failed\n"); return; }
    void* kargs[] = {&a};
    const hipError_t le = hipLaunchCooperativeKernel((const void*)hymba_fwd, dim3(grid), dim3(NWAVES * 64), kargs, LDS_BYTES, stream);
    if (le != hipSuccess) fprintf(stderr, "kernel_launch: cooperative launch failed: %s (grid %d)\n", hipGetErrorName(le), grid);
}
```

```cpp
#include <hip/hip_cooperative_groups.h>
#include <cmath>
#include <hip/hip_runtime.h>
#include <cstdio>
#include <cstdint>
namespace pg8 {
#define PG8_LAS __attribute__((address_space(3)))
typedef unsigned short bf16_t;
typedef short bf16x8 __attribute__((ext_vector_type(8)));
typedef float f32x4 __attribute__((ext_vector_type(4)));
typedef unsigned u32x4 __attribute__((ext_vector_type(4)));
constexpr int BM = 256, BK = 64, HALF = 128, HTB = HALF * BK * 2  , STAGE_BYTES = 8 * HTB, NXCD = 8, WGM = 8;

__host__ __device__ __forceinline__ int lds_byte(int r, int c) { const int st = (r >> 4) * 2 + (c >> 5), rr = r & 15, cc = c & 31, ob = rr * 64 + cc * 2; return st * 1024 + (ob ^ (((ob >> 9) & 1) << 5)); }
__host__ __device__ __forceinline__ void stage_rc(int b, int& R, int& C) { const int st = b / 1024, sb = b % 1024, swz = sb ^ (((sb >> 9) & 1) << 5); R = (st >> 1) * 16 + swz / 64; C = (st & 1) * 32 + (swz % 64) / 2; }
__host__ __device__ __forceinline__ int perm32(int rho) { const int n = rho >> 4, i = rho & 15; return 8 * (i >> 2) + 4 * n + (i & 3); }

struct Unit { int pm, pn; };
struct Gemm { const bf16_t* A; const bf16_t* Bt; int M, N, K; };

struct StaticOrder {
    int nM, nN, nwg, G, c, wgm;
    __host__ __device__ void init(int M, int N, int G_, int c_, int wgm_ = WGM) { nM = M / BM; nN = N / BM; nwg = nM * nN; G = G_; c = c_; wgm = wgm_; }
    __host__ __device__ bool next(int i, Unit& u) const {
        const long L = (long)i * G + c; if (L >= nwg) return false;
        int wgid = (int)L; { const int q = nwg / NXCD, r = nwg % NXCD, xcd = wgid % NXCD, off = wgid / NXCD; wgid = (xcd < r ? xcd * (q + 1) : r * (q + 1) + (xcd - r) * q) + off; }
        const int nig = wgm * nN, gid = wgid / nig, fm = gid * wgm, gsz = (nM - fm) < wgm ? (nM - fm) : wgm;
        u.pm = fm + ((wgid % nig) % gsz); u.pn = (wgid % nig) / gsz; return true;
    }
    __device__ __forceinline__ void a_ready(const Unit&) const {}
    __device__ __forceinline__ void done(const Unit&) const {}
};

__device__ __forceinline__ unsigned cvt_pk_bf16(float lo, float hi) { unsigned r; asm volatile("v_cvt_pk_bf16_f32 %0, %1, %2" : "=v"(r) : "v"(lo), "v"(hi)); return r; }
typedef float f32x2 __attribute__((ext_vector_type(2)));
__device__ __forceinline__ f32x2 gelu_pk(f32x2 v) {
    const f32x2 av = __builtin_elementwise_abs(v), d = av * 0.2316418882f + 1.0f;
    f32x2 t; t.x = __builtin_amdgcn_rcpf(d.x); t.y = __builtin_amdgcn_rcpf(d.y);
    f32x2 q = t * 0.5307027145f + (-0.7265760135f); q = q * t + 0.7107068705f; q = q * t + (-0.142248368f); q = q * t + 0.127414796f; q = q * t;
    const f32x2 s = (v * v) * (-0.72134752044f);
    f32x2 e; e.x = __builtin_amdgcn_exp2f(s.x); e.y = __builtin_amdgcn_exp2f(s.y);
    const f32x2 m = v * (q * e), r = v - m;
    f32x2 o; o.x = v.x < 0.f ? m.x : r.x; o.y = v.y < 0.f ? m.y : r.y; return o;
}

template <int ACT  > struct EpiBf16 {
    static constexpr bool PERM = true, AFTER_DRAIN = false; static_assert(ACT == 0 || ACT == 1, "EpiBf16: ACT is 0 (none) or 1 (gelu_pk)");
    bf16_t* O; int ldc; const float* bias; int split_cols; size_t split_stride; float scale0;
    __device__ __forceinline__ void operator()(const f32x4 (&acc)[2][2][4][2], const Unit& u, int wr, int wc, int fr, int fq) const {
        const int row0 = u.pm * BM + wr * 64 + fr; int colt = u.pn * BM; bf16_t* base = O;
        float sc = 1.f; if (split_cols) { const int t = colt / split_cols; base += (size_t)t * split_stride; colt -= t * split_cols; if (t == 0) sc = scale0; }
        const int col0 = colt + wc * 32 + 8 * fq, bcol0 = u.pn * BM + wc * 32 + 8 * fq;
        f32x4 bv[2][2];
#pragma unroll
        for (int bj = 0; bj < 2; ++bj)
#pragma unroll
            for (int n = 0; n < 2; ++n) bv[bj][n] = bias ? *(const f32x4*)(bias + bcol0 + bj * HALF + 4 * n) : (f32x4){0.f, 0.f, 0.f, 0.f};
#pragma unroll
        for (int ai = 0; ai < 2; ++ai)
#pragma unroll
            for (int m = 0; m < 4; ++m) { bf16_t* rowp = base + (size_t)(row0 + ai * HALF + m * 16) * ldc + col0;
#pragma unroll
                for (int bj = 0; bj < 2; ++bj) { f32x4 v0 = acc[ai][bj][m][0] + bv[bj][0], v1 = acc[ai][bj][m][1] + bv[bj][1];
                    if (ACT == 1) { f32x2 a = gelu_pk((f32x2){v0[0], v0[1]}), b = gelu_pk((f32x2){v0[2], v0[3]}), c = gelu_pk((f32x2){v1[0], v1[1]}), d = gelu_pk((f32x2){v1[2], v1[3]});
                        v0 = (f32x4){a.x, a.y, b.x, b.y}; v1 = (f32x4){c.x, c.y, d.x, d.y}; }
                    v0 = v0 * sc; v1 = v1 * sc; u32x4 w; w.x = cvt_pk_bf16(v0[0], v0[1]); w.y = cvt_pk_bf16(v0[2], v0[3]); w.z = cvt_pk_bf16(v1[0], v1[1]); w.w = cvt_pk_bf16(v1[2], v1[3]);
                    *(u32x4*)(rowp + bj * HALF) = w; } }
    }
};

constexpr int XROWS = 32768, SPAD = 8256;
constexpr float QSCALE = 0.125f * 1.4426950408889634f;
__device__ __forceinline__ f32x4 shfl_xor4(f32x4 v, int m) { f32x4 r; r[0] = __shfl_xor(v[0], m); r[1] = __shfl_xor(v[1], m); r[2] = __shfl_xor(v[2], m); r[3] = __shfl_xor(v[3], m); return r; }
__device__ __forceinline__ u32x4 pack8(f32x4 a, f32x4 b) { u32x4 w; w.x = cvt_pk_bf16(a[0], a[1]); w.y = cvt_pk_bf16(a[2], a[3]); w.z = cvt_pk_bf16(b[0], b[1]); w.w = cvt_pk_bf16(b[2], b[3]); return w; }
struct EpiInProj {
    static constexpr bool PERM = true, AFTER_DRAIN = false;
    bf16_t *Q, *K, *V, *G; const float *qg, *kg, *rope;
    __device__ __forceinline__ void operator()(const f32x4 (&acc)[2][2][4][2], const Unit& u, int wr, int wc, int fr, int fq) const {
        const int pn = u.pn; constexpr bool meta = false;
        if (meta && (wr != 0 || pn < 2)) return;
        const int rbase = u.pm * BM + wr * 64 + fr;
        if (pn < 4) {
            const bool isq = pn < 2; const float* gp = isq ? qg : kg; const float osc = isq ? QSCALE : 1.f;
            f32x4 gv[2][2];
#pragma unroll
            for (int bj = 0; bj < 2; ++bj)
#pragma unroll
                for (int n = 0; n < 2; ++n) gv[bj][n] = *(const f32x4*)(gp + 32 * bj + 8 * fq + 4 * n);
            const int colb = (pn & 1) * 256 + wc * 64 + 8 * fq;
            bf16_t* dst = isq ? Q : K;
#pragma unroll
            for (int ai = 0; ai < 2; ++ai) {
                if (meta && ai) continue;
#pragma unroll
              for (int mh = 0; mh < 2; ++mh) {
                if (meta && mh) continue;
                f32x4 rv[2][4];
                if (fq < 2) {
#pragma unroll
                    for (int m2 = 0; m2 < 2; ++m2) { const int row = rbase + ai * HALF + (2 * mh + m2) * 16; const int pos = meta ? (row - XROWS) : ((row & 8191) + 16); const f32x4* rp = (const f32x4*)(rope + (size_t)pos * 16);
#pragma unroll
                        for (int k = 0; k < 4; ++k) rv[m2][k] = rp[k]; }
                }
                asm volatile("" ::: "memory");
#pragma unroll
                for (int m = 2 * mh; m < 2 * mh + 2; ++m) {
                    if (meta && m) continue;
                    const int row = rbase + ai * HALF + m * 16;
                    float ss = 0.f;
#pragma unroll
                    for (int bj = 0; bj < 2; ++bj)
#pragma unroll
                        for (int n = 0; n < 2; ++n) { const f32x4 x = acc[ai][bj][m][n]; ss += (x[0] * x[0] + x[1] * x[1]) + (x[2] * x[2] + x[3] * x[3]); }
                    ss += __shfl_xor(ss, 16); ss += __shfl_xor(ss, 32);
                    const float rs = __builtin_amdgcn_rsqf(ss * (1.0f / 64.0f) + 1e-6f);
                    f32x4 y00 = acc[ai][0][m][0] * rs * gv[0][0], y01 = acc[ai][0][m][1] * rs * gv[0][1], y10 = acc[ai][1][m][0] * rs * gv[1][0], y11 = acc[ai][1][m][1] * rs * gv[1][1];
                    const f32x4 p0 = shfl_xor4(y00, 16), p1 = shfl_xor4(y01, 16);
                    if (fq < 2) {
                        const f32x4 c0 = rv[m & 1][0], c1 = rv[m & 1][1], s0 = rv[m & 1][2], s1 = rv[m & 1][3];
                        const float sg = fq ? 1.f : -1.f;
                        y00 = y00 * c0 + (p0 * s0) * sg; y01 = y01 * c1 + (p1 * s1) * sg;
                    }
                    const u32x4 w0 = pack8(y00 * osc, y01 * osc), w1 = pack8(y10 * osc, y11 * osc);
                    if (!meta) {
                        const size_t orow = isq ? (size_t)row : (size_t)((row >> 13) * SPAD + 64 + (row & 8191));
                        *(u32x4*)(dst + orow * 512 + colb) = w0; *(u32x4*)(dst + orow * 512 + colb + 32) = w1;
                    } else {
#pragma unroll 1
                        for (int b = 0; b < 4; ++b) { const size_t orow = (size_t)(b * SPAD + fr); *(u32x4*)(dst + orow * 512 + colb) = w0; *(u32x4*)(dst + orow * 512 + colb + 32) = w1; }
                    }
                }
              }
            }
        } else if (pn < 6) {
            const int colb = (pn - 4) * 256 + wc * 32 + 8 * fq;
#pragma unroll
            for (int ai = 0; ai < 2; ++ai)
#pragma unroll
                for (int m = 0; m < 4; ++m) {
                    if (meta && (ai || m)) continue;
                    const int row = rbase + ai * HALF + m * 16;
                    const u32x4 w0 = pack8(acc[ai][0][m][0], acc[ai][0][m][1]), w1 = pack8(acc[ai][1][m][0], acc[ai][1][m][1]);
                    if (!meta) {
                        const size_t orow = (size_t)((row >> 13) * SPAD + 64 + (row & 8191));
                        *(u32x4*)(V + orow * 512 + colb) = w0; *(u32x4*)(V + orow * 512 + colb + HALF) = w1;
                    } else {
#pragma unroll 1
                        for (int b = 0; b < 4; ++b) { const size_t orow = (size_t)(b * SPAD + fr); *(u32x4*)(V + orow * 512 + colb) = w0; *(u32x4*)(V + orow * 512 + colb + HALF) = w1; }
                    }
                }
        } else {
            const int colb = (pn - 6) * 128 + wc * 32 + 8 * fq;
#pragma unroll
            for (int ai = 0; ai < 2; ++ai)
#pragma unroll
                for (int m = 0; m < 4; ++m) {
                    if (meta && (ai || m)) continue;
                    const int row = rbase + ai * HALF + m * 16;
                    f32x4 h[2];
#pragma unroll
                    for (int n = 0; n < 2; ++n) { const f32x4 a = acc[ai][0][m][n], g = acc[ai][1][m][n];
#pragma unroll
                        for (int e = 0; e < 4; ++e) h[n][e] = a[e] * __builtin_amdgcn_rcpf(1.0f + __builtin_amdgcn_exp2f(-1.4426950408889634f * g[e])); }
                    const u32x4 w0 = pack8(h[0], h[1]);
                    if (!meta) {
                        const size_t orow = (size_t)((row >> 13) * SPAD + 64 + (row & 8191));
                        *(u32x4*)(G + orow * 512 + colb) = w0;
                    } else {
#pragma unroll 1
                        for (int b = 0; b < 4; ++b) { const size_t orow = (size_t)(b * SPAD + 48 + fr); *(u32x4*)(G + orow * 512 + colb) = w0; }
                    }
                }
        }
    }
};
struct EpiOut {
    static constexpr bool PERM = true, AFTER_DRAIN = false;
    const bf16_t* xn; const float* rn; const float* g1; bf16_t* hb; float* ssq;
    __device__ __forceinline__ void operator()(const f32x4 (&acc)[2][2][4][2], const Unit& u, int wr, int wc, int fr, int fq) const {
        const int rbase = u.pm * BM + wr * 64 + fr, colb = u.pn * BM + wc * 32 + 8 * fq;
        f32x4 ig[2][2];
#pragma unroll
        for (int bj = 0; bj < 2; ++bj)
#pragma unroll
            for (int n = 0; n < 2; ++n) { const f32x4 g = *(const f32x4*)(g1 + colb + bj * HALF + 4 * n);
#pragma unroll
                for (int e = 0; e < 4; ++e) ig[bj][n][e] = __builtin_amdgcn_rcpf(g[e]); }
#pragma unroll
        for (int ai = 0; ai < 2; ++ai) {
            u32x4 xv[4][2]; float rv[4];
#pragma unroll
            for (int m = 0; m < 4; ++m) { const int row = rbase + ai * HALF + m * 16; rv[m] = rn[row];
#pragma unroll
                for (int bj = 0; bj < 2; ++bj) xv[m][bj] = *(const u32x4*)(xn + (size_t)row * 1024 + colb + bj * HALF); }
            asm volatile("" ::: "memory");
#pragma unroll
            for (int m = 0; m < 4; ++m) {
                const int row = rbase + ai * HALF + m * 16; float ss = 0.f;
#pragma unroll
                for (int bj = 0; bj < 2; ++bj) { const size_t off = (size_t)row * 1024 + colb + bj * HALF; const u32x4 w = xv[m][bj];
                    f32x4 x0, x1;
                    x0[0] = __uint_as_float(w.x << 16); x0[1] = __uint_as_float(w.x & 0xffff0000u); x0[2] = __uint_as_float(w.y << 16); x0[3] = __uint_as_float(w.y & 0xffff0000u);
                    x1[0] = __uint_as_float(w.z << 16); x1[1] = __uint_as_float(w.z & 0xffff0000u); x1[2] = __uint_as_float(w.w << 16); x1[3] = __uint_as_float(w.w & 0xffff0000u);
                    const f32x4 h0 = x0 * rv[m] * ig[bj][0] + acc[ai][bj][m][0], h1 = x1 * rv[m] * ig[bj][1] + acc[ai][bj][m][1];
                    *(u32x4*)(hb + off) = pack8(h0, h1);
                    ss += (h0[0] * h0[0] + h0[1] * h0[1]) + (h0[2] * h0[2] + h0[3] * h0[3]) + (h1[0] * h1[0] + h1[1] * h1[1]) + (h1[2] * h1[2] + h1[3] * h1[3]); }
                ss += __shfl_xor(ss, 16); ss += __shfl_xor(ss, 32);
                if (fq == 0) ssq[(size_t)row * 16 + u.pn * 4 + wc] = ss;
            }
        }
    }
};
struct EpiUp {
    static constexpr bool PERM = true, AFTER_DRAIN = false;
    bf16_t* hb; const float* ssq;
    __device__ __forceinline__ void operator()(const f32x4 (&acc)[2][2][4][2], const Unit& u, int wr, int wc, int fr, int fq) const {
        const int rbase = u.pm * BM + wr * 64 + fr, colb = u.pn * BM + wc * 32 + 8 * fq;
#pragma unroll
        for (int ai = 0; ai < 2; ++ai) {
            f32x4 sv[4][4];
#pragma unroll
            for (int m = 0; m < 4; ++m) { const f32x4* sp = (const f32x4*)(ssq + (size_t)(rbase + ai * HALF + m * 16) * 16);
#pragma unroll
                for (int k = 0; k < 4; ++k) sv[m][k] = sp[k]; }
            asm volatile("" ::: "memory");
#pragma unroll
            for (int m = 0; m < 4; ++m) {
                const int row = rbase + ai * HALF + m * 16;
                const f32x4 s0 = sv[m][0], s1 = sv[m][1], s2 = sv[m][2], s3 = sv[m][3];
                const float tot = ((s0[0] + s0[1]) + (s0[2] + s0[3])) + ((s1[0] + s1[1]) + (s1[2] + s1[3])) + ((s2[0] + s2[1]) + (s2[2] + s2[3])) + ((s3[0] + s3[1]) + (s3[2] + s3[3]));
                const float rs = __builtin_amdgcn_rsqf(tot * (1.0f / 1024.0f) + 1e-6f);
#pragma unroll
                for (int bj = 0; bj < 2; ++bj) { f32x4 a0 = acc[ai][bj][m][0] * rs, a1 = acc[ai][bj][m][1] * rs;
#pragma unroll
                    for (int e = 0; e < 4; ++e) { const float p = fmaxf(a0[e], 0.f), q = fmaxf(a1[e], 0.f); a0[e] = p * p; a1[e] = q * q; }
                    *(u32x4*)(hb + (size_t)row * 4096 + colb + bj * HALF) = pack8(a0, a1); }
            }
        }
    }
};
struct EpiDown {
    static constexpr bool PERM = true, AFTER_DRAIN = false;
    const bf16_t* h1; float* out;
    __device__ __forceinline__ void operator()(const f32x4 (&acc)[2][2][4][2], const Unit& u, int wr, int wc, int fr, int fq) const {
        const int rbase = u.pm * BM + wr * 64 + fr, colb = u.pn * BM + wc * 32 + 8 * fq;
        u32x4 hv[2][4][2];
#pragma unroll
        for (int ai = 0; ai < 2; ++ai)
#pragma unroll
            for (int m = 0; m < 4; ++m)
#pragma unroll
                for (int bj = 0; bj < 2; ++bj) hv[ai][m][bj] = *(const u32x4*)(h1 + (size_t)(rbase + ai * HALF + m * 16) * 1024 + colb + bj * HALF);
        asm volatile("" ::: "memory");
#pragma unroll
        for (int ai = 0; ai < 2; ++ai)
#pragma unroll
            for (int m = 0; m < 4; ++m) {
                const int row = rbase + ai * HALF + m * 16;
#pragma unroll
                for (int bj = 0; bj < 2; ++bj) { const size_t off = (size_t)row * 1024 + colb + bj * HALF; const u32x4 w = hv[ai][m][bj];
                    f32x4 r0, r1;
                    r0[0] = __uint_as_float(w.x << 16); r0[1] = __uint_as_float(w.x & 0xffff0000u); r0[2] = __uint_as_float(w.y << 16); r0[3] = __uint_as_float(w.y & 0xffff0000u);
                    r1[0] = __uint_as_float(w.z << 16); r1[1] = __uint_as_float(w.z & 0xffff0000u); r1[2] = __uint_as_float(w.w << 16); r1[3] = __uint_as_float(w.w & 0xffff0000u);
                    *(f32x4*)(out + off) = r0 + acc[ai][bj][m][0]; *(f32x4*)(out + off + 4) = r1 + acc[ai][bj][m][1]; }
            }
    }
};


template <class Epi, class Sched, bool ALIGN_EPI = false, bool SP2 = false>
__device__ __forceinline__ void gemm_phase(PG8_LAS unsigned char* lds, const Gemm g, const Sched& S, const Epi& E) {
    int tid_ = threadIdx.x; asm volatile("" : "+v"(tid_));
    const int tid = tid_, wid = __builtin_amdgcn_readfirstlane(tid >> 6), lane = tid & 63, wr = wid >> 2, wc = wid & 3, fr = lane & 15, fq = lane >> 4;
    const int K = g.K, nt = K / BK;
    unsigned voffA[2], voffB[2];
#pragma unroll
    for (int i = 0; i < 2; ++i) { int R, C; stage_rc(tid * 16 + i * 8192, R, C); const int Rb = Epi::PERM ? ((R & ~31) + perm32(R & 31)) : R;
        voffA[i] = (unsigned)(R * K + C) * 2u; voffB[i] = (unsigned)(Rb * K + C) * 2u; }
    const size_t kstep = (size_t)(BK * 2);
    const size_t hstep = (size_t)HALF * K * 2;
    const size_t tstep = 2 * hstep;
    const unsigned ldsw = (unsigned)wid * 1024u;
    const int aoff = lds_byte(wr * 64 + fr, fq * 8), boff = lds_byte(wc * 32 + fr, fq * 8);
#define PG8_SA(b, h) (((b) * 2 + (h)) * HTB)
#define PG8_SB(b, h) ((4 + (b) * 2 + (h)) * HTB)
#define PG8_STAGE(bufoff, gbase, voff) do { _Pragma("unroll") for (int _i = 0; _i < 2; ++_i) \
        __builtin_amdgcn_global_load_lds((const unsigned*)((const char*)(gbase) + (voff)[_i]), (PG8_LAS unsigned*)(lds + (bufoff) + ldsw + _i * 8192), 16, 0, 0); } while (0)
#define PG8_LDA(dst, b, h) do { _Pragma("unroll") for (int m = 0; m < 4; ++m) _Pragma("unroll") for (int k = 0; k < 2; ++k) dst[m][k] = *(const PG8_LAS bf16x8*)(lds + PG8_SA(b, h) + aoff + m * 2048 + k * 1024); } while (0)
#define PG8_LDB(dst, b, h) do { _Pragma("unroll") for (int n = 0; n < 2; ++n) _Pragma("unroll") for (int k = 0; k < 2; ++k) dst[n][k] = *(const PG8_LAS bf16x8*)(lds + PG8_SB(b, h) + boff + n * 2048 + k * 1024); } while (0)
#define PG8_MMA(ai, bj, At, Bt) do { __builtin_amdgcn_s_setprio(1); _Pragma("unroll") for (int m = 0; m < 4; ++m) _Pragma("unroll") for (int n = 0; n < 2; ++n) _Pragma("unroll") for (int k = 0; k < 2; ++k) \
        acc[ai][bj][m][n] = __builtin_amdgcn_mfma_f32_16x16x32_bf16(Bt[n][k], At[m][k], acc[ai][bj][m][n], 0, 0, 0); __builtin_amdgcn_s_setprio(0); } while (0)
#define PG8_WAIT_V(n) asm volatile("s_waitcnt vmcnt(" #n ")" ::: "memory")
#define PG8_WAIT_L(n) asm volatile("s_waitcnt lgkmcnt(" #n ")" ::: "memory")
#define PG8_BAR __builtin_amdgcn_s_barrier()
#define PG8_SCHED __builtin_amdgcn_sched_barrier(0)
    Unit cur, nxt; int ui = 0;
    if (!S.next(0, cur)) return;
    f32x4 acc[2][2][4][2];
#pragma unroll
    for (int a = 0; a < 2; ++a)
#pragma unroll
        for (int b = 0; b < 2; ++b)
#pragma unroll
            for (int m = 0; m < 4; ++m)
#pragma unroll
                for (int n = 0; n < 2; ++n) acc[a][b][m][n] = (f32x4){0.f, 0.f, 0.f, 0.f};
    bf16x8 At[4][2], B0[2][2], B1[2][2];
    const char* cA = (const char*)g.A + (size_t)cur.pm * tstep; const char* cB = (const char*)g.Bt + (size_t)cur.pn * tstep;
    S.a_ready(cur);
    if constexpr (SP2) {
        PG8_STAGE(PG8_SB(0, 0), cB, voffB); PG8_STAGE(PG8_SB(0, 1), cB + hstep, voffB); PG8_STAGE(PG8_SA(0, 0), cA, voffA); PG8_STAGE(PG8_SA(0, 1), cA + hstep, voffA);
        if (wr == 1) PG8_BAR;
        PG8_WAIT_V(2); PG8_BAR;
        PG8_STAGE(PG8_SB(1, 0), cB + kstep, voffB); PG8_STAGE(PG8_SA(1, 0), cA + kstep, voffA); PG8_STAGE(PG8_SB(1, 1), cB + hstep + kstep, voffB);
        PG8_WAIT_V(6); PG8_BAR;
    } else {
        PG8_STAGE(PG8_SB(0, 0), cB, voffB); PG8_STAGE(PG8_SA(0, 0), cA, voffA); PG8_STAGE(PG8_SB(0, 1), cB + hstep, voffB); PG8_STAGE(PG8_SA(0, 1), cA + hstep, voffA);
        if (wr == 1) PG8_BAR;
        PG8_WAIT_V(4); PG8_BAR;
        PG8_STAGE(PG8_SB(1, 0), cB + kstep, voffB); PG8_STAGE(PG8_SA(1, 0), cA + kstep, voffA); PG8_STAGE(PG8_SB(1, 1), cB + hstep + kstep, voffB);
        PG8_WAIT_V(6); PG8_BAR;
    }
    for (;;) {
        const bool has_next = S.next(ui + 1, nxt);
        const char* nA = has_next ? (const char*)g.A + (size_t)nxt.pm * tstep : cA; const char* nB = has_next ? (const char*)g.Bt + (size_t)nxt.pn * tstep : cB;
        for (int t = 0; t < nt; t += 2) {
            const bool last = (t == nt - 2);
            const char* a1 = cA + (size_t)(t + 1) * kstep;
            const char* a2 = last ? nA : cA + (size_t)(t + 2) * kstep; const char* b2 = last ? nB : cB + (size_t)(t + 2) * kstep;
            const char* a3 = a2 + kstep; const char* b3 = b2 + kstep;
            if (last && has_next) S.a_ready(nxt);
            if constexpr (SP2) {
            PG8_LDB(B0, 0, 0); PG8_LDB(B1, 0, 1); PG8_SCHED; PG8_LDA(At, 0, 0); PG8_STAGE(PG8_SA(1, 1), a1 + hstep, voffA);
            PG8_WAIT_V(8); PG8_WAIT_L(0); PG8_BAR; PG8_MMA(0, 0, At, B0); PG8_MMA(0, 1, At, B1); PG8_BAR; PG8_SCHED;
            PG8_LDA(At, 0, 1); PG8_STAGE(PG8_SB(0, 0), b2, voffB); PG8_STAGE(PG8_SB(0, 1), b2 + hstep, voffB); PG8_STAGE(PG8_SA(0, 0), a2, voffA);
            PG8_WAIT_V(8); PG8_WAIT_L(0); PG8_BAR; PG8_MMA(1, 0, At, B0); PG8_MMA(1, 1, At, B1); PG8_BAR; PG8_SCHED;
            PG8_LDB(B0, 1, 0); PG8_LDB(B1, 1, 1); PG8_SCHED; PG8_LDA(At, 1, 0); PG8_STAGE(PG8_SA(0, 1), a2 + hstep, voffA);
            PG8_WAIT_V(8); PG8_WAIT_L(0); PG8_BAR; PG8_MMA(0, 0, At, B0); PG8_MMA(0, 1, At, B1); PG8_BAR; PG8_SCHED;
            PG8_LDA(At, 1, 1); PG8_STAGE(PG8_SB(1, 0), b3, voffB); PG8_STAGE(PG8_SB(1, 1), b3 + hstep, voffB); PG8_STAGE(PG8_SA(1, 0), a3, voffA);
            PG8_WAIT_V(8); PG8_WAIT_L(0); PG8_BAR; PG8_MMA(1, 0, At, B0); PG8_MMA(1, 1, At, B1); PG8_BAR; PG8_SCHED;
            } else {
            PG8_LDB(B0, 0, 0); PG8_SCHED; PG8_LDA(At, 0, 0); PG8_STAGE(PG8_SA(1, 1), a1 + hstep, voffA);
            PG8_WAIT_L(8); PG8_BAR; PG8_WAIT_L(0); PG8_MMA(0, 0, At, B0); PG8_BAR; PG8_SCHED;
            PG8_LDB(B1, 0, 1); PG8_STAGE(PG8_SB(0, 0), b2, voffB);
            PG8_BAR; PG8_WAIT_L(0); PG8_MMA(0, 1, At, B1); PG8_BAR;
            PG8_LDA(At, 0, 1); PG8_STAGE(PG8_SA(0, 0), a2, voffA);
            PG8_BAR; PG8_WAIT_L(0); PG8_MMA(1, 0, At, B0); PG8_BAR; PG8_SCHED;
            PG8_STAGE(PG8_SB(0, 1), b2 + hstep, voffB);
            PG8_WAIT_V(6); PG8_BAR; PG8_MMA(1, 1, At, B1); PG8_BAR;
            PG8_LDB(B0, 1, 0); PG8_SCHED; PG8_LDA(At, 1, 0); PG8_STAGE(PG8_SA(0, 1), a2 + hstep, voffA);
            PG8_WAIT_L(8); PG8_BAR; PG8_WAIT_L(0); PG8_MMA(0, 0, At, B0); PG8_BAR; PG8_SCHED;
            PG8_LDB(B1, 1, 1); PG8_STAGE(PG8_SB(1, 0), b3, voffB);
            PG8_BAR; PG8_WAIT_L(0); PG8_MMA(0, 1, At, B1); PG8_BAR;
            PG8_LDA(At, 1, 1); PG8_STAGE(PG8_SA(1, 0), a3, voffA);
            PG8_BAR; PG8_WAIT_L(0); PG8_MMA(1, 0, At, B0); PG8_BAR; PG8_SCHED;
            PG8_STAGE(PG8_SB(1, 1), b3 + hstep, voffB);
            PG8_WAIT_V(6); PG8_BAR; PG8_MMA(1, 1, At, B1); PG8_BAR;
            }
        }
        if constexpr (ALIGN_EPI) { if (wr == 0) PG8_BAR; }
        if constexpr (!Epi::AFTER_DRAIN) { E(acc, cur, wr, wc, fr, fq); S.done(cur); }
        if (!has_next) break;
#pragma unroll
        for (int a = 0; a < 2; ++a)
#pragma unroll
            for (int b = 0; b < 2; ++b)
#pragma unroll
                for (int m = 0; m < 4; ++m)
#pragma unroll
                    for (int n = 0; n < 2; ++n) acc[a][b][m][n] = (f32x4){0.f, 0.f, 0.f, 0.f};
        cur = nxt; cA = nA; cB = nB; ++ui;
        if constexpr (ALIGN_EPI) { if (wr == 1) PG8_BAR; }
    }
    PG8_WAIT_V(0);
    if constexpr (!ALIGN_EPI) { if (wr == 0) PG8_BAR; }
    PG8_BAR;
    if constexpr (Epi::AFTER_DRAIN) { E.fused(acc, cur, wr, wc, fr, fq, lds, wid, lane); S.done(cur); }
#undef PG8_SA
#undef PG8_SB
#undef PG8_STAGE
#undef PG8_LDA
#undef PG8_LDB
#undef PG8_MMA
#undef PG8_WAIT_V
#undef PG8_WAIT_L
#undef PG8_BAR
#undef PG8_SCHED
}
}

#ifndef PG8_SP2
#define PG8_SP2 true
#endif
#ifndef PG8_ALIGN
#define PG8_ALIGN true
#endif
#include <hip/hip_bf16.h>
#include <cmath>
namespace attn_body {
using bf16=__hip_bfloat16;
using bf16x8=__attribute__((ext_vector_type(8)))short;
using s16x4=__attribute__((ext_vector_type(4)))short;
using f32x16=__attribute__((ext_vector_type(16)))float;
using u32x4=__attribute__((ext_vector_type(4)))unsigned;
constexpr int SEQ=8192,D=64,PQ=512,PO=1024;
constexpr int NW=8,QBLK=32,QB=QBLK*NW,KVBLK=64,NQB=SEQ/QB;
constexpr int ATTN_UNIT_ROWS=QB;
__device__ __forceinline__ int crow(int r,int hi){return (r&3)+8*(r>>2)+4*hi;}
#define SBAR() __builtin_amdgcn_sched_barrier(0)
__device__ __forceinline__ void cmask(f32x16&p0,f32x16&p1,int jb,int qrel,int hi){
  const float NEG=-INFINITY; int kb=64*jb+4*hi;
  #pragma unroll
  for(int r=0;r<16;++r){int kv=kb+(r&3)+8*(r>>2); if(kv>qrel)p0[r]=NEG; if(kv+32>qrel)p1[r]=NEG;}
}

constexpr int NSLOT=3, SLOTB=8192;
constexpr int LDS_K=0, LDS_V=NSLOT*SLOTB, LDS_WS=2*NSLOT*SLOTB, LDS_OST=LDS_WS+NW*64*4, LDS_BYTES=LDS_OST+NW*4096;
constexpr float C2=0.125f*1.4426950408889634f;
__device__ __forceinline__ void glds16(const void*gsrc,unsigned lds_dst){unsigned keep;
  asm volatile("s_mov_b32 %0, m0\n\ts_mov_b32 m0, %2\n\ts_nop 0\n\tglobal_load_lds_dwordx4 %1, off\n\ts_mov_b32 m0, %0":"=&s"(keep):"v"(gsrc),"s"(lds_dst):"memory");}
__device__ __forceinline__ float max3f(float a,float b,float c){float r;asm("v_max3_f32 %0, %1, %2, %3":"=v"(r):"v"(a),"v"(b),"v"(c));return r;}
__device__ __forceinline__ float max2f(float a,float b){float r;asm("v_max_f32_e32 %0, %1, %2":"=v"(r):"v"(a),"v"(b));return r;}
__device__ __forceinline__ float fadd_s(float a,float b){float r;asm("v_add_f32_e32 %0, %1, %2":"=v"(r):"v"(a),"v"(b));return r;}
__device__ __forceinline__ float fsub_s(float a,float b){float r;asm("v_sub_f32_e32 %0, %1, %2":"=v"(r):"v"(a),"v"(b));return r;}
typedef float f32x2_t __attribute__((ext_vector_type(2))); typedef __bf16 bf16x2_t __attribute__((ext_vector_type(2)));
__device__ __forceinline__ unsigned cvtpk_s(float lo,float hi){f32x2_t v={lo,hi};bf16x2_t b=__builtin_convertvector(v,bf16x2_t);return __builtin_bit_cast(unsigned,b);}
#define WAIT_BAR(N) asm volatile("s_waitcnt vmcnt(" #N ") lgkmcnt(0)\n\ts_barrier":::"memory")

__device__ __forceinline__ void qkt(f32x16&p0,f32x16&p1,const char*Kslot,const bf16x8*qr,const f32x16&negm,int r32,int hi){
  const char*kb=Kslot+hi*1024+r32*16;
  #pragma unroll
  for(int d0=0;d0<4;++d0){
    const bf16x8 b0=*reinterpret_cast<const bf16x8*>(kb+d0*2048);
    const bf16x8 b1=*reinterpret_cast<const bf16x8*>(kb+d0*2048+512);
    if(d0==0){p0=__builtin_amdgcn_mfma_f32_32x32x16_bf16(b0,qr[0],negm,0,0,0);p1=__builtin_amdgcn_mfma_f32_32x32x16_bf16(b1,qr[0],negm,0,0,0);}
    else{p0=__builtin_amdgcn_mfma_f32_32x32x16_bf16(b0,qr[d0],p0,0,0,0);p1=__builtin_amdgcn_mfma_f32_32x32x16_bf16(b1,qr[d0],p1,0,0,0);}}
}
typedef __attribute__((address_space(3))) const char* lds_cptr;
typedef short v4i16_t __attribute__((ext_vector_type(4)));
__device__ __forceinline__ void kload8(bf16x8*kf,lds_cptr kp){
  kf[0]=*(const __attribute__((address_space(3))) bf16x8*)(kp);      kf[1]=*(const __attribute__((address_space(3))) bf16x8*)(kp+512);
  kf[2]=*(const __attribute__((address_space(3))) bf16x8*)(kp+2048); kf[3]=*(const __attribute__((address_space(3))) bf16x8*)(kp+2560);
  kf[4]=*(const __attribute__((address_space(3))) bf16x8*)(kp+4096); kf[5]=*(const __attribute__((address_space(3))) bf16x8*)(kp+4608);
  kf[6]=*(const __attribute__((address_space(3))) bf16x8*)(kp+6144); kf[7]=*(const __attribute__((address_space(3))) bf16x8*)(kp+6656);
}
__device__ __forceinline__ void kload2(bf16x8*kf,lds_cptr kp,int j){ kf[2*j]=*(const __attribute__((address_space(3))) bf16x8*)(kp+j*2048); kf[2*j+1]=*(const __attribute__((address_space(3))) bf16x8*)(kp+j*2048+512); }
__device__ __forceinline__ s16x4 vtr(lds_cptr p){ return __builtin_bit_cast(s16x4,__builtin_amdgcn_ds_read_tr16_b64_v4i16((__attribute__((address_space(3))) v4i16_t*)p)); }
__device__ __forceinline__ float rowmax(const f32x16&p0,const f32x16&p1){
  float a=max3f(p0[0],p0[1],p1[0]),b=max3f(p0[2],p0[3],p1[1]);a=max3f(a,p1[2],p1[3]);
  #pragma unroll
  for(int r=4;r<16;r+=4){a=max3f(a,p0[r],p0[r+1]);b=max3f(b,p0[r+2],p0[r+3]);a=max3f(a,p1[r],p1[r+1]);b=max3f(b,p1[r+2],p1[r+3]);}
  const float m=max2f(a,b);
  auto rr=__builtin_amdgcn_permlane32_swap(__float_as_uint(m),__float_as_uint(m),false,false);
  return max2f(__uint_as_float(rr[0]),__uint_as_float(rr[1]));
}
__device__ __forceinline__ void pv(f32x16*o,int vb,bf16x8 pa0,bf16x8 pa1,bf16x8 pa2,bf16x8 pa3){
  #pragma unroll
  for(int d0=0;d0<2;++d0){s16x4 lo[4],hi[4];
    #pragma unroll
    for(int ks=0;ks<4;++ks){
      asm volatile("ds_read_b64_tr_b16 %0,%1 offset:%c2":"=&v"(lo[ks]):"v"(vb),"i"(d0*4096+ks*1024):"memory");
      asm volatile("ds_read_b64_tr_b16 %0,%1 offset:%c2":"=&v"(hi[ks]):"v"(vb),"i"(d0*4096+ks*1024+512):"memory");}
    asm volatile("s_waitcnt lgkmcnt(0)":::"memory");SBAR();
    #define PK(k) (bf16x8){lo[k][0],lo[k][1],lo[k][2],lo[k][3],hi[k][0],hi[k][1],hi[k][2],hi[k][3]}
    o[d0]=__builtin_amdgcn_mfma_f32_32x32x16_bf16(pa0,PK(0),o[d0],0,0,0);
    o[d0]=__builtin_amdgcn_mfma_f32_32x32x16_bf16(pa1,PK(1),o[d0],0,0,0);
    o[d0]=__builtin_amdgcn_mfma_f32_32x32x16_bf16(pa2,PK(2),o[d0],0,0,0);
    o[d0]=__builtin_amdgcn_mfma_f32_32x32x16_bf16(pa3,PK(3),o[d0],0,0,0);
    #undef PK
  }
}

#ifndef ATTN_STORE16
#define ATTN_STORE16(p,v) (*(u32x4*)(p)=(v))
#endif
template<int THRL> __device__ __forceinline__ void attn_unit(int q0,const bf16*Qu,const bf16*__restrict__ Kh,const bf16*__restrict__ Vh,bf16*Ou,char*shm){
  int tid_=threadIdx.x; asm volatile("":"+v"(tid_)); const int tid=tid_,lane=tid&63,r32=lane&31,hi=lane>>5; const int wid=__builtin_amdgcn_readfirstlane(tid>>6);
  const bf16*Qw=Qu+(long)(wid*QBLK)*PQ;
  const unsigned lds0=(unsigned)(uintptr_t)shm;
  float*wsf=(float*)(shm+LDS_WS)+wid*64;
  const bf16*ksrc=Kh+(long)lane*PQ+wid*8;
  const bf16*vsrc=Vh+(long)(16*(wid&3)+(lane>>2))*PQ+(wid>>2)*32+(lane&3)*8;
  const unsigned kdst=lds0+LDS_K+wid*1024, vdst=lds0+LDS_V+wid*1024;
  #define DMA_K(t,slot) glds16(ksrc+(long)(t)*KVBLK*PQ,(unsigned)__builtin_amdgcn_readfirstlane(kdst+(slot)))
  #define DMA_V(t,slot) glds16(vsrc+(long)(t)*KVBLK*PQ,(unsigned)__builtin_amdgcn_readfirstlane(vdst+(slot)))
  const int vb0=(int)(lds0+LDS_V)+((lane>>4)&1)*32+(lane&3)*8+(4*hi+((lane&15)>>2))*64;
  const char*Kbase=shm+LDS_K; bf16x8 kf[8];
  const lds_cptr shm3=(lds_cptr)shm; const lds_cptr kp0=shm3+LDS_K+hi*1024+r32*16; const lds_cptr vp0=shm3+LDS_V+((lane>>4)&1)*32+(lane&3)*8+(4*hi+((lane&15)>>2))*64;
  const int NT=(q0+QB)/KVBLK+1;
  DMA_K(0,0);DMA_V(0,0);DMA_K(1,SLOTB);
  bf16x8 qr[4];
  #pragma unroll
  for(int d0=0;d0<4;++d0)qr[d0]=*reinterpret_cast<const bf16x8*>(&Qw[(long)r32*PQ+d0*16+hi*8]);
  float mhat=0.f,l_reg=0.f;f32x16 o[2];o[0]=f32x16{};o[1]=f32x16{};f32x16 negm=f32x16{};asm volatile("":"+v"(negm));
  const int qrel=wid*QBLK+r32;
  #define CMASK(P0,P1,t) do{int jb_=(t)-(NT-4); if(jb_>=0)cmask(P0,P1,jb_,qrel,hi);}while(0)
  bool resc=false;
  #define START(P0,P1) do{ const float rm=rowmax(P0,P1); resc=false; \
    { const float dl=rm; mhat=fadd_s(mhat,dl); \
      _Pragma("unroll") for(int r=0;r<16;++r){P0[r]=fsub_s(P0[r],dl);P1[r]=fsub_s(P1[r],dl);} \
      _Pragma("unroll") for(int r=0;r<16;++r)negm[r]=-mhat; asm volatile("":"+v"(negm)); } \
    _Pragma("unroll") for(int r=0;r<16;++r)P0[r]=__builtin_amdgcn_exp2f(P0[r]); }while(0)
  #define RESC() do{ if(resc){ asm volatile("s_waitcnt lgkmcnt(0)":::"memory"); \
      _Pragma("unroll") for(int d_=0;d_<2;++d_) _Pragma("unroll") for(int r=0;r<16;++r)o[d_][r]*=wsf[crow(r,hi)]; } }while(0)
  f32x16 pA0,pA1,pB0,pB1;
  int sl_prev=0,sl_cur=0,sl_next=SLOTB;
  #define ROT() do{sl_prev=sl_cur;sl_cur=sl_next;sl_next=(sl_next==(NSLOT-1)*SLOTB)?0:sl_next+SLOTB;}while(0)
  DMA_K(2,2*SLOTB);
  WAIT_BAR(3);
  qkt(pA0,pA1,Kbase,qr,negm,r32,hi);asm volatile("s_nop 15\n\ts_nop 7":"+v"(pA0),"+v"(pA1));
  { const float NEGI=-INFINITY; _Pragma("unroll") for(int r=8;r<16;++r)pA0[r]=NEGI; _Pragma("unroll") for(int r=0;r<16;++r)pA1[r]=NEGI; }
  START(pA0,pA1);
  _Pragma("unroll") for(int r=0;r<16;++r)pA1[r]=__builtin_amdgcn_exp2f(pA1[r]);
  WAIT_BAR(0);
  DMA_K(3,0);DMA_V(1,SLOTB);
  ROT();
  kload8(kf,kp0+sl_cur);
  WAIT_BAR(2);
  s16x4 vlo[8],vhi[8]; u32x4 pw0,pw1,pw2,pw3;
  #define PKW(P,B) cvtpk_s(P[B],P[B+1])
  #define PAF(k) __builtin_bit_cast(bf16x8,pw##k)
  #define VFR(i) (bf16x8){vlo[i][0],vlo[i][1],vlo[i][2],vlo[i][3],vhi[i][0],vhi[i][1],vhi[i][2],vhi[i][3]}
  #define PIN(x) asm volatile("":"+v"(x))
  #define MX3(a,b,c) __builtin_fmaxf(__builtin_fmaxf((a),(b)),(c))
  #define GAPA(MF,A0,A1,A2,A3,W0,W1,PW) do{ MF; sacc+=A0; sacc+=A1; sacc+=A2; sacc+=A3; PIN(sacc); W0; W1; PIN(PW); SBAR(); }while(0)
  #define EX(v) __builtin_amdgcn_exp2f(v)
  #define GAPB(MF,X,B) do{ MF; X[B]=EX(X[B]); X[B+1]=EX(X[B+1]); X[B+2]=EX(X[B+2]); X[B+3]=EX(X[B+3]); PIN(X); SBAR(); }while(0)
  #define VRD(i) do{ vlo[i]=vtr(vp_+(((i)>>2)*4096+((i)&3)*1024)); vhi[i]=vtr(vp_+(((i)>>2)*4096+((i)&3)*1024+512)); }while(0)
  #define KRD(G,j) do{ if(G){ kload2(kf,kp0+sl_next,j); SBAR(); } }while(0)
  #define STEP(C0,C1,P0,P1,t,GK,GV,GL) do{ SBAR(); \
    const lds_cptr vp_=vp0+sl_prev; \
    VRD(0); SBAR(); float sacc=(P0[0]+P0[1]); \
    GAPA(C0=__builtin_amdgcn_mfma_f32_32x32x16_bf16(kf[0],qr[0],negm,0,0,0), P0[2],P0[3],P0[4],P0[5],     pw0[0]=PKW(P0,0), pw0[1]=PKW(P0,2), pw0); \
    VRD(4); SBAR(); GAPA(C1=__builtin_amdgcn_mfma_f32_32x32x16_bf16(kf[1],qr[0],negm,0,0,0), P0[6],P0[7],P0[8],P0[9],     pw0[2]=PKW(P0,4), pw0[3]=PKW(P0,6), pw0); \
    VRD(1); SBAR(); GAPA(C0=__builtin_amdgcn_mfma_f32_32x32x16_bf16(kf[2],qr[1],C0,0,0,0),   P0[10],P0[11],P0[12],P0[13], pw1[0]=PKW(P0,8), pw1[1]=PKW(P0,10), pw1); \
    VRD(5); SBAR(); GAPA(C1=__builtin_amdgcn_mfma_f32_32x32x16_bf16(kf[3],qr[1],C1,0,0,0),   P0[14],P0[15],P1[0],P1[1],   pw1[2]=PKW(P0,12),pw1[3]=PKW(P0,14), pw1); \
    VRD(2); SBAR(); GAPA(C0=__builtin_amdgcn_mfma_f32_32x32x16_bf16(kf[4],qr[2],C0,0,0,0),   P1[2],P1[3],P1[4],P1[5],     pw2[0]=PKW(P1,0), pw2[1]=PKW(P1,2), pw2); \
    VRD(6); SBAR(); GAPA(C1=__builtin_amdgcn_mfma_f32_32x32x16_bf16(kf[5],qr[2],C1,0,0,0),   P1[6],P1[7],P1[8],P1[9],     pw2[2]=PKW(P1,4), pw2[3]=PKW(P1,6), pw2); \
    VRD(3); SBAR(); GAPA(C0=__builtin_amdgcn_mfma_f32_32x32x16_bf16(kf[6],qr[3],C0,0,0,0),   P1[10],P1[11],P1[12],P1[13], pw3[0]=PKW(P1,8), pw3[1]=PKW(P1,10), pw3); \
    VRD(7); SBAR(); GAPA(C1=__builtin_amdgcn_mfma_f32_32x32x16_bf16(kf[7],qr[3],C1,0,0,0),   P1[14],P1[15],0.f,0.f,       pw3[2]=PKW(P1,12),pw3[3]=PKW(P1,14), pw3); \
    l_reg+=sacc; \
    if(GK){DMA_K((t)+3,sl_cur);} if(GV){DMA_V((t)+1,sl_next);} \
    CMASK(C0,C1,t); \
    { float a=MX3(C0[0],C0[1],C1[0]),b=MX3(C0[2],C0[3],C1[1]); a=MX3(a,C1[2],C1[3]); \
      _Pragma("unroll") for(int r=4;r<16;r+=4){a=MX3(a,C0[r],C0[r+1]);b=MX3(b,C0[r+2],C0[r+3]);a=MX3(a,C1[r],C1[r+1]);b=MX3(b,C1[r+2],C1[r+3]);} \
      float rm=__builtin_fmaxf(a,b); { auto rr=__builtin_amdgcn_permlane32_swap(__float_as_uint(rm),__float_as_uint(rm),false,false); rm=__builtin_fmaxf(__uint_as_float(rr[0]),__uint_as_float(rr[1])); } \
      resc=false; \
      if(__builtin_expect(__any(rm>(float)THRL),0)){ const float dl=__builtin_fmaxf(rm,0.f); mhat+=dl; \
        _Pragma("unroll") for(int r=0;r<16;++r){C0[r]-=dl;C1[r]-=dl;} \
        _Pragma("unroll") for(int r=0;r<16;++r)negm[r]=-mhat; asm volatile("":"+v"(negm)); \
        const float f=__builtin_amdgcn_exp2f(-dl); l_reg*=f; if(hi==0)wsf[r32]=f; resc=true; } } \
    SBAR(); \
    GAPB(o[0]=__builtin_amdgcn_mfma_f32_32x32x16_bf16(PAF(0),VFR(0),o[0],0,0,0), C0,0); \
    GAPB(o[1]=__builtin_amdgcn_mfma_f32_32x32x16_bf16(PAF(0),VFR(4),o[1],0,0,0), C0,4); \
    KRD(GL,0); GAPB(o[0]=__builtin_amdgcn_mfma_f32_32x32x16_bf16(PAF(1),VFR(1),o[0],0,0,0), C0,8); \
    KRD(GL,1); GAPB(o[1]=__builtin_amdgcn_mfma_f32_32x32x16_bf16(PAF(1),VFR(5),o[1],0,0,0), C0,12); \
    KRD(GL,2); GAPB(o[0]=__builtin_amdgcn_mfma_f32_32x32x16_bf16(PAF(2),VFR(2),o[0],0,0,0), C1,0); \
    KRD(GL,3); GAPB(o[1]=__builtin_amdgcn_mfma_f32_32x32x16_bf16(PAF(2),VFR(6),o[1],0,0,0), C1,4); \
    GAPB(o[0]=__builtin_amdgcn_mfma_f32_32x32x16_bf16(PAF(3),VFR(3),o[0],0,0,0), C1,8); \
    GAPB(o[1]=__builtin_amdgcn_mfma_f32_32x32x16_bf16(PAF(3),VFR(7),o[1],0,0,0), C1,12); \
    }while(0)
  int t=1;
  #undef CMASK
  #define CMASK(P0,P1,t) do{}while(0)
  for(;t+5<NT;t+=2){
    STEP(pB0,pB1,pA0,pA1,t,true,true,true);     WAIT_BAR(2); RESC(); ROT();
    STEP(pA0,pA1,pB0,pB1,t+1,true,true,true);   WAIT_BAR(2); RESC(); ROT();
  }
  #undef CMASK
  #define CMASK(P0,P1,t) do{int jb_=(t)-(NT-4); if(jb_>=0)cmask(P0,P1,jb_,qrel,hi);}while(0)
  #define ENDW(tt) do{ if((tt)+3<NT){WAIT_BAR(2);} else if((tt)+2<NT){WAIT_BAR(1);} else {WAIT_BAR(0);} }while(0)
  for(;t+1<NT;t+=2){
    STEP(pB0,pB1,pA0,pA1,t,(t+3<NT),(t+1<NT),(t+1<NT));       ENDW(t);   RESC(); ROT();
    STEP(pA0,pA1,pB0,pB1,t+1,(t+4<NT),(t+2<NT),(t+2<NT));     ENDW(t+1); RESC(); ROT();
  }
  { float sacc=pA0[0]+pA0[1]; _Pragma("unroll") for(int r=2;r<16;++r)sacc+=pA0[r]; _Pragma("unroll") for(int r=0;r<16;++r)sacc+=pA1[r]; l_reg+=sacc;
    pw0=(u32x4){PKW(pA0,0),PKW(pA0,2),PKW(pA0,4),PKW(pA0,6)};pw1=(u32x4){PKW(pA0,8),PKW(pA0,10),PKW(pA0,12),PKW(pA0,14)};pw2=(u32x4){PKW(pA1,0),PKW(pA1,2),PKW(pA1,4),PKW(pA1,6)};pw3=(u32x4){PKW(pA1,8),PKW(pA1,10),PKW(pA1,12),PKW(pA1,14)};
    SBAR(); pv(o,vb0+sl_prev,PAF(0),PAF(1),PAF(2),PAF(3)); }
  #undef PKW
  #undef PAF
  #undef VFR
  #undef PIN
  #undef MX3
  #undef GAPA
  #undef GAPB
  #undef EX
  #undef VRD
  #undef KRD
  #undef STEP
  #undef ENDW
  {auto rr=__builtin_amdgcn_permlane32_swap(__float_as_uint(l_reg),__float_as_uint(l_reg),false,false);l_reg=__uint_as_float(rr[0])+__uint_as_float(rr[1]);}
  if(hi==0)wsf[32+r32]=l_reg;asm volatile("s_waitcnt lgkmcnt(0)":::"memory");
  float rli[16];
  #pragma unroll
  for(int r=0;r<16;++r)rli[r]=__builtin_amdgcn_rcpf(wsf[32+crow(r,hi)]);
  bf16*Ow=Ou+(long)(wid*QBLK)*PO;
  { bf16*stg=(bf16*)(shm+LDS_OST)+wid*2048;
    #pragma unroll
    for(int r=0;r<16;++r){const int orow=crow(r,hi);
      #pragma unroll
      for(int d0=0;d0<2;++d0)stg[orow*64+d0*32+r32]=__float2bfloat16(o[d0][r]*rli[r]);}
    asm volatile("s_waitcnt lgkmcnt(0)":::"memory");
    #pragma unroll
    for(int i=0;i<4;++i){const int row=i*8+(lane>>3),ch=lane&7; const u32x4 v=*(const u32x4*)(stg+row*64+ch*8); ATTN_STORE16(Ow+(long)row*PO+ch*8,v);} }
  asm volatile("s_waitcnt lgkmcnt(0)\n\ts_barrier":::"memory");
  #undef DMA_K
  #undef DMA_V
  #undef CMASK
  #undef START
  #undef RESC
  #undef ROT
}
constexpr int ATTN_LDS_BYTES=LDS_BYTES;
#undef SBAR
#undef WAIT_BAR
typedef float f32x4v __attribute__((ext_vector_type(4)));
constexpr int V2_SLOTV=16384, V2_LDS_K=0, V2_LDS_V=NSLOT*SLOTB, V2_LDS_WS=V2_LDS_V+NSLOT*V2_SLOTV, V2_LDS_OST=V2_LDS_WS+NW*64*4, V2_LDS_BYTES=V2_LDS_OST+NW*8192;
#define SBAR() __builtin_amdgcn_sched_barrier(0)
#define WAIT_BAR(N) asm volatile("s_waitcnt vmcnt(" #N ") lgkmcnt(0)\n\ts_barrier":::"memory")
__device__ __forceinline__ void pv4(f32x16*o,int vb,bf16x8 pa0,bf16x8 pa1,bf16x8 pa2,bf16x8 pa3){
  #pragma unroll
  for(int d0=0;d0<4;++d0){s16x4 lo[4],hi[4];
    #pragma unroll
    for(int ks=0;ks<4;++ks){
      asm volatile("ds_read_b64_tr_b16 %0,%1 offset:%c2":"=&v"(lo[ks]):"v"(vb),"i"(d0*4096+ks*1024):"memory");
      asm volatile("ds_read_b64_tr_b16 %0,%1 offset:%c2":"=&v"(hi[ks]):"v"(vb),"i"(d0*4096+ks*1024+512):"memory");}
    asm volatile("s_waitcnt lgkmcnt(0)":::"memory");SBAR();
    #define PK(k) (bf16x8){lo[k][0],lo[k][1],lo[k][2],lo[k][3],hi[k][0],hi[k][1],hi[k][2],hi[k][3]}
    o[d0]=__builtin_amdgcn_mfma_f32_32x32x16_bf16(pa0,PK(0),o[d0],0,0,0);
    o[d0]=__builtin_amdgcn_mfma_f32_32x32x16_bf16(pa1,PK(1),o[d0],0,0,0);
    o[d0]=__builtin_amdgcn_mfma_f32_32x32x16_bf16(pa2,PK(2),o[d0],0,0,0);
    o[d0]=__builtin_amdgcn_mfma_f32_32x32x16_bf16(pa3,PK(3),o[d0],0,0,0);
    #undef PK
  }
}
template<int MODE> __device__ __forceinline__ void attn_unit128(int q0,const bf16*Qu,const bf16*__restrict__ Kh,const bf16*__restrict__ Vh,bf16*Ou,char*shm,float lam,float oscale,const float*subg){
  int tid_=threadIdx.x; asm volatile("":"+v"(tid_)); const int tid=tid_,lane=tid&63,r32=lane&31,hi=lane>>5; const int wid=__builtin_amdgcn_readfirstlane(tid>>6);
  const bf16*Qw=Qu+(long)(wid*QBLK)*PQ;
  const unsigned lds0=(unsigned)(uintptr_t)shm;
  float*wsf=(float*)(shm+V2_LDS_WS)+wid*64;
  const bf16*ksrc=Kh+(long)lane*PQ+wid*8;
  const bf16*vsrc=Vh+(long)(16*(wid&3)+(lane>>2))*PQ+(wid>>2)*32+(lane&3)*8;
  const unsigned kdst=lds0+V2_LDS_K+wid*1024, vdst=lds0+V2_LDS_V+wid*1024;
  #define DMA_K(t,slot) glds16(ksrc+(long)(t)*KVBLK*PQ,(unsigned)__builtin_amdgcn_readfirstlane(kdst+(slot)))
  #define DMA_V(t,slot) do{ glds16(vsrc+(long)(t)*KVBLK*PQ,(unsigned)__builtin_amdgcn_readfirstlane(vdst+2*(slot))); glds16(vsrc+(long)(t)*KVBLK*PQ+64,(unsigned)__builtin_amdgcn_readfirstlane(vdst+2*(slot)+8192)); }while(0)
  const int vb0=(int)(lds0+V2_LDS_V)+((lane>>4)&1)*32+(lane&3)*8+(4*hi+((lane&15)>>2))*64;
  const char*Kbase=shm+V2_LDS_K; bf16x8 kf[8];
  const lds_cptr shm3=(lds_cptr)shm; const lds_cptr kp0=shm3+V2_LDS_K+hi*1024+r32*16; const lds_cptr vp0=shm3+V2_LDS_V+((lane>>4)&1)*32+(lane&3)*8+(4*hi+((lane&15)>>2))*64;
  const int NT=(q0+QB)/KVBLK+1;
  DMA_K(0,0);DMA_V(0,0);DMA_K(1,SLOTB);
  bf16x8 qr[4];
  #pragma unroll
  for(int d0=0;d0<4;++d0)qr[d0]=*reinterpret_cast<const bf16x8*>(&Qw[(long)r32*PQ+d0*16+hi*8]);
  float l_reg=0.f;f32x16 o[4];o[0]=f32x16{};o[1]=f32x16{};o[2]=f32x16{};o[3]=f32x16{};
  const f32x16 zero16=f32x16{};
  const int qrel=wid*QBLK+r32;
  #define CMASK(P0,P1,t) do{int jb_=(t)-(NT-4); if(jb_>=0)cmask(P0,P1,jb_,qrel,hi);}while(0)
  f32x16 pA0,pA1,pB0,pB1;
  int sl_prev=0,sl_cur=0,sl_next=SLOTB;
  #define ROT() do{sl_prev=sl_cur;sl_cur=sl_next;sl_next=(sl_next==(NSLOT-1)*SLOTB)?0:sl_next+SLOTB;}while(0)
  DMA_K(2,2*SLOTB);
  WAIT_BAR(3);
  qkt(pA0,pA1,Kbase,qr,zero16,r32,hi);asm volatile("s_nop 15\n\ts_nop 7":"+v"(pA0),"+v"(pA1));
  { const float NEGI=-INFINITY; _Pragma("unroll") for(int r=8;r<16;++r)pA0[r]=NEGI; _Pragma("unroll") for(int r=0;r<16;++r)pA1[r]=NEGI; }
  _Pragma("unroll") for(int r=0;r<16;++r){pA0[r]=__builtin_amdgcn_exp2f(pA0[r]);pA1[r]=__builtin_amdgcn_exp2f(pA1[r]);}
  WAIT_BAR(0);
  DMA_K(3,0);DMA_V(1,SLOTB);
  ROT();
  kload8(kf,kp0+sl_cur);
  WAIT_BAR(3);
  s16x4 vlo[8],vhi[8]; u32x4 pw0,pw1,pw2,pw3;
  #define PKW(P,B) cvtpk_s(P[B],P[B+1])
  #define PAF(k) __builtin_bit_cast(bf16x8,pw##k)
  #define VFR(i) (bf16x8){vlo[i][0],vlo[i][1],vlo[i][2],vlo[i][3],vhi[i][0],vhi[i][1],vhi[i][2],vhi[i][3]}
  #define PIN(x) asm volatile("":"+v"(x))
  #define GAPA(MF,A0,A1,A2,A3,W0,W1,PW) do{ MF; sacc+=A0; sacc+=A1; sacc+=A2; sacc+=A3; PIN(sacc); W0; W1; PIN(PW); SBAR(); }while(0)
  #define EX(v) __builtin_amdgcn_exp2f(v)
  #define GAPB(MF,X,B) do{ MF; X[B]=EX(X[B]); X[B+1]=EX(X[B+1]); PIN(X); SBAR(); }while(0)
  #define VRD(i) do{ vlo[i]=vtr(vp_+(((i)>>2)*4096+((i)&3)*1024)); vhi[i]=vtr(vp_+(((i)>>2)*4096+((i)&3)*1024+512)); }while(0)
  #define VRD2(i) do{ vlo[i]=vtr(vp_+(8192+((i)>>2)*4096+((i)&3)*1024)); vhi[i]=vtr(vp_+(8192+((i)>>2)*4096+((i)&3)*1024+512)); SBAR(); }while(0)
  #define KRD(G,j) do{ if(G){ kload2(kf,kp0+sl_next,j); SBAR(); } }while(0)
  #define MF32(a,b,c) __builtin_amdgcn_mfma_f32_32x32x16_bf16(a,b,c,0,0,0)
  #define STEP(C0,C1,P0,P1,t,GK,GV,GL) do{ SBAR(); \
    const lds_cptr vp_=vp0+2*sl_prev; \
    VRD(0); SBAR(); float sacc=(P0[0]+P0[1]); \
    GAPA(C0=MF32(kf[0],qr[0],zero16), P0[2],P0[3],P0[4],P0[5],     pw0[0]=PKW(P0,0), pw0[1]=PKW(P0,2), pw0); \
    VRD(4); SBAR(); GAPA(C1=MF32(kf[1],qr[0],zero16), P0[6],P0[7],P0[8],P0[9],     pw0[2]=PKW(P0,4), pw0[3]=PKW(P0,6), pw0); \
    VRD(1); SBAR(); GAPA(C0=MF32(kf[2],qr[1],C0),   P0[10],P0[11],P0[12],P0[13], pw1[0]=PKW(P0,8), pw1[1]=PKW(P0,10), pw1); \
    VRD(5); SBAR(); GAPA(C1=MF32(kf[3],qr[1],C1),   P0[14],P0[15],P1[0],P1[1],   pw1[2]=PKW(P0,12),pw1[3]=PKW(P0,14), pw1); \
    VRD(2); SBAR(); GAPA(C0=MF32(kf[4],qr[2],C0),   P1[2],P1[3],P1[4],P1[5],     pw2[0]=PKW(P1,0), pw2[1]=PKW(P1,2), pw2); \
    VRD(6); SBAR(); GAPA(C1=MF32(kf[5],qr[2],C1),   P1[6],P1[7],P1[8],P1[9],     pw2[2]=PKW(P1,4), pw2[3]=PKW(P1,6), pw2); \
    VRD(3); SBAR(); GAPA(C0=MF32(kf[6],qr[3],C0),   P1[10],P1[11],P1[12],P1[13], pw3[0]=PKW(P1,8), pw3[1]=PKW(P1,10), pw3); \
    VRD(7); SBAR(); GAPA(C1=MF32(kf[7],qr[3],C1),   P1[14],P1[15],0.f,0.f,       pw3[2]=PKW(P1,12),pw3[3]=PKW(P1,14), pw3); \
    l_reg+=sacc; \
    if(GK){DMA_K((t)+3,sl_cur);} if(GV){DMA_V((t)+1,sl_next);} \
    CMASK(C0,C1,t); \
    SBAR(); \
    GAPB(o[0]=MF32(PAF(0),VFR(0),o[0]), C0,0);  VRD2(0); \
    GAPB(o[1]=MF32(PAF(0),VFR(4),o[1]), C0,2);  VRD2(4); \
    KRD(GL,0); GAPB(o[0]=MF32(PAF(1),VFR(1),o[0]), C0,4);  VRD2(1); \
    KRD(GL,1); GAPB(o[1]=MF32(PAF(1),VFR(5),o[1]), C0,6);  VRD2(5); \
    KRD(GL,2); GAPB(o[0]=MF32(PAF(2),VFR(2),o[0]), C0,8);  VRD2(2); \
    KRD(GL,3); GAPB(o[1]=MF32(PAF(2),VFR(6),o[1]), C0,10); VRD2(6); \
    GAPB(o[0]=MF32(PAF(3),VFR(3),o[0]), C0,12); VRD2(3); \
    GAPB(o[1]=MF32(PAF(3),VFR(7),o[1]), C0,14); VRD2(7); \
    GAPB(o[2]=MF32(PAF(0),VFR(0),o[2]), C1,0); \
    GAPB(o[3]=MF32(PAF(0),VFR(4),o[3]), C1,2); \
    GAPB(o[2]=MF32(PAF(1),VFR(1),o[2]), C1,4); \
    GAPB(o[3]=MF32(PAF(1),VFR(5),o[3]), C1,6); \
    GAPB(o[2]=MF32(PAF(2),VFR(2),o[2]), C1,8); \
    GAPB(o[3]=MF32(PAF(2),VFR(6),o[3]), C1,10); \
    GAPB(o[2]=MF32(PAF(3),VFR(3),o[2]), C1,12); \
    GAPB(o[3]=MF32(PAF(3),VFR(7),o[3]), C1,14); \
    }while(0)
  int t=1;
  #undef CMASK
  #define CMASK(P0,P1,t) do{}while(0)
  for(;t+5<NT;t+=2){
    STEP(pB0,pB1,pA0,pA1,t,true,true,true);     WAIT_BAR(3); ROT();
    STEP(pA0,pA1,pB0,pB1,t+1,true,true,true);   WAIT_BAR(3); ROT();
  }
  #undef CMASK
  #define CMASK(P0,P1,t) do{int jb_=(t)-(NT-4); if(jb_>=0)cmask(P0,P1,jb_,qrel,hi);}while(0)
  #define ENDW(tt) do{ if((tt)+3<NT){WAIT_BAR(3);} else if((tt)+2<NT){WAIT_BAR(2);} else {WAIT_BAR(0);} }while(0)
  for(;t+1<NT;t+=2){
    STEP(pB0,pB1,pA0,pA1,t,(t+3<NT),(t+1<NT),(t+1<NT));       ENDW(t);   ROT();
    STEP(pA0,pA1,pB0,pB1,t+1,(t+4<NT),(t+2<NT),(t+2<NT));     ENDW(t+1); ROT();
  }
  { float sacc=pA0[0]+pA0[1]; _Pragma("unroll") for(int r=2;r<16;++r)sacc+=pA0[r]; _Pragma("unroll") for(int r=0;r<16;++r)sacc+=pA1[r]; l_reg+=sacc;
    pw0=(u32x4){PKW(pA0,0),PKW(pA0,2),PKW(pA0,4),PKW(pA0,6)};pw1=(u32x4){PKW(pA0,8),PKW(pA0,10),PKW(pA0,12),PKW(pA0,14)};pw2=(u32x4){PKW(pA1,0),PKW(pA1,2),PKW(pA1,4),PKW(pA1,6)};pw3=(u32x4){PKW(pA1,8),PKW(pA1,10),PKW(pA1,12),PKW(pA1,14)};
    SBAR(); pv4(o,vb0+2*sl_prev,PAF(0),PAF(1),PAF(2),PAF(3)); }
  #undef PKW
  #undef PAF
  #undef VFR
  #undef PIN
  #undef GAPA
  #undef GAPB
  #undef EX
  #undef VRD
  #undef VRD2
  #undef KRD
  #undef MF32
  #undef STEP
  #undef ENDW
  {auto rr=__builtin_amdgcn_permlane32_swap(__float_as_uint(l_reg),__float_as_uint(l_reg),false,false);l_reg=__uint_as_float(rr[0])+__uint_as_float(rr[1]);}
  if(hi==0)wsf[32+r32]=l_reg;asm volatile("s_waitcnt lgkmcnt(0)":::"memory");
  float rli[16];
  #pragma unroll
  for(int r=0;r<16;++r)rli[r]=__builtin_amdgcn_rcpf(wsf[32+crow(r,hi)]);
  { bf16*park=(bf16*)(shm+V2_LDS_OST)+wid*4096;
    if(MODE==0){
      #pragma unroll
      for(int r=0;r<16;++r){const int orow=crow(r,hi);
        #pragma unroll
        for(int d0=0;d0<4;++d0)park[orow*128+d0*32+r32]=__float2bfloat16(o[d0][r]*rli[r]);}
      asm volatile("s_waitcnt lgkmcnt(0)":::"memory");
    } else {
      #pragma unroll
      for(int r=0;r<16;++r){const int orow=crow(r,hi);
        #pragma unroll
        for(int d0=0;d0<4;++d0){const float o1=__bfloat162float(park[orow*128+d0*32+r32]); park[orow*128+d0*32+r32]=__float2bfloat16(o1-lam*(o[d0][r]*rli[r]));}}
      asm volatile("s_waitcnt lgkmcnt(0)":::"memory");
      bf16*Ow=Ou+(long)(wid*QBLK)*PO;
      const int ch=lane&15; const f32x4v g0=*(const f32x4v*)(subg+8*ch), g1=*(const f32x4v*)(subg+8*ch+4);
      #pragma unroll
      for(int i=0;i<8;++i){const int row=i*4+(lane>>4); const u32x4 v=*(const u32x4*)(park+row*128+ch*8);
        float d[8]; d[0]=__uint_as_float(v.x<<16);d[1]=__uint_as_float(v.x&0xffff0000u);d[2]=__uint_as_float(v.y<<16);d[3]=__uint_as_float(v.y&0xffff0000u);d[4]=__uint_as_float(v.z<<16);d[5]=__uint_as_float(v.z&0xffff0000u);d[6]=__uint_as_float(v.w<<16);d[7]=__uint_as_float(v.w&0xffff0000u);
        float ss=(d[0]*d[0]+d[1]*d[1])+(d[2]*d[2]+d[3]*d[3])+(d[4]*d[4]+d[5]*d[5])+(d[6]*d[6]+d[7]*d[7]);
        ss+=__shfl_xor(ss,1);ss+=__shfl_xor(ss,2);ss+=__shfl_xor(ss,4);ss+=__shfl_xor(ss,8);
        const float rs=__builtin_amdgcn_rsqf(ss*(1.0f/128.0f)+1e-6f)*oscale;
        u32x4 w; w.x=cvtpk_s(d[0]*rs*g0[0],d[1]*rs*g0[1]); w.y=cvtpk_s(d[2]*rs*g0[2],d[3]*rs*g0[3]); w.z=cvtpk_s(d[4]*rs*g1[0],d[5]*rs*g1[1]); w.w=cvtpk_s(d[6]*rs*g1[2],d[7]*rs*g1[3]);
        ATTN_STORE16(Ow+(long)row*PO+ch*8,w);}
      asm volatile("s_waitcnt lgkmcnt(0)":::"memory");
    } }
  asm volatile("s_waitcnt lgkmcnt(0)\n\ts_barrier":::"memory");
  #undef DMA_K
  #undef DMA_V
  #undef CMASK
  #undef ROT
}
#undef SBAR
#undef WAIT_BAR

}
namespace cg = cooperative_groups;
constexpr int NWAVES = 8;
constexpr int NB = 4, SEQ = 8192, DM = 1024, NMETA = 16, DIN = 2560, DFF = 4096, DCONV = 512, CONVW = 31;
constexpr int MX = NB * SEQ;
constexpr int MP = MX + 256;
constexpr int SPAD = pg8::SPAD;
constexpr float EPS = 1e-6f;
constexpr size_t MiB = 1u << 20;
constexpr size_t WS_CTL = 0, WS_WIN = 1 * MiB, WS_WOUT = 6 * MiB, WS_WUP = 8 * MiB, WS_WDN = 16 * MiB, WS_ROPE = 24 * MiB, WS_SSQ = 25 * MiB, WS_RN = 27 * MiB,
                 WS_H1B = 28 * MiB, WS_MIX = 92 * MiB, WS_HB = 156 * MiB, WS_XN = 156 * MiB, WS_O = 156 * MiB, WS_Q = 222 * MiB, WS_K = 254 * MiB, WS_V = 287 * MiB, WS_G = 320 * MiB,
                 WS_END = 412 * MiB;
static_assert(WS_XN + (size_t)MP * DM * 2 <= WS_Q && WS_K + (size_t)NB * SPAD * 512 * 2 <= WS_V && WS_G + (size_t)NB * SPAD * 512 * 2 <= WS_HB + (size_t)MX * DFF * 2 && WS_HB + (size_t)MX * DFF * 2 <= WS_END, "d_ws map");
constexpr int RING_BYTES = 131072, LDS_BYTES = 147456;
#ifndef WGM_P1
#define WGM_P1 4
#endif
#ifndef WGM_P4
#define WGM_P4 4
#endif
#ifndef WGM_P35
#define WGM_P35 4
#endif

#define LAS __attribute__((address_space(3)))
typedef unsigned short bf16;
typedef unsigned v4u __attribute__((ext_vector_type(4)));
typedef float f32x4 __attribute__((ext_vector_type(4)));
typedef float f32x2 __attribute__((ext_vector_type(2)));
#define LDS_WAIT() asm volatile("s_waitcnt lgkmcnt(0)" ::: "memory")
__device__ __forceinline__ unsigned pk2(float lo, float hi) { return pg8::cvt_pk_bf16(lo, hi); }
__device__ __forceinline__ float bf_lo(unsigned u) { return __uint_as_float(u << 16); }
__device__ __forceinline__ float bf_hi(unsigned u) { return __uint_as_float(u & 0xffff0000u); }
__device__ __forceinline__ float wave_sum(float v) {
#pragma unroll
    for (int o = 1; o < 64; o <<= 1) v += __shfl_xor(v, o);
    return v;
}

#define XB_TMO      128
#define XB_XCNT(j)  (256  + 64 * (j))
#define XB_XSUB(j)  (1280 + 64 * (j))
#define XB_XGEN(j)  (2304 + 64 * (j))
#define XB_TOP      3328
#define XB_TOPGEN   3392
#define XCD_BAR_WORDS 3456
#define XB_SPIN_CAP (1u << 18)

__device__ __forceinline__ unsigned xb_ld(unsigned* p)              { return __hip_atomic_load(p, __ATOMIC_RELAXED, __HIP_MEMORY_SCOPE_AGENT); }
__device__ __forceinline__ unsigned xb_add(unsigned* p, unsigned v) { return __hip_atomic_fetch_add(p, v, __ATOMIC_RELAXED, __HIP_MEMORY_SCOPE_AGENT); }
__device__ __forceinline__ unsigned xb_xcc_id() { return (unsigned)__builtin_amdgcn_s_getreg((3 << 11) | 20) & 0xFu; }
#define XB_SPIN(cond, bar) do { unsigned _sp = 0; while (cond) { __builtin_amdgcn_s_sleep(1); \
    if ((++_sp & 255u) == 0u) { if (xb_ld(&(bar)[XB_TMO])) break; if (_sp > XB_SPIN_CAP) { atomicAdd(&(bar)[XB_TMO], 1u); break; } } } } while (0)

struct XcdBarrier {
    unsigned* bar; unsigned x;
    volatile LAS unsigned* st;
};

__device__ __forceinline__ XcdBarrier xcd_barrier_post(unsigned* bar, volatile LAS unsigned* st) {
    XcdBarrier b; b.bar = bar; b.x = xb_xcc_id(); b.st = st;
    if (threadIdx.x == 0) (void)xb_add(&bar[XB_XCNT(b.x)], 1u);
    return b;
}
__device__ __forceinline__ void xcd_barrier_complete(unsigned* bar, unsigned x, unsigned& nloc, unsigned& nx) {
    const unsigned G = gridDim.x * gridDim.y * gridDim.z;
    unsigned sum, cnt, mine, sp = 0u;
    for (;;) {
        sum = 0u; cnt = 0u; mine = 0u;
#pragma unroll
        for (unsigned j = 0; j < 16; ++j) { const unsigned c = xb_ld(&bar[XB_XCNT(j)]); sum += c; cnt += (c > 0u) ? 1u : 0u; mine = (j == x) ? c : mine; }
        if (sum == G) break;
        __builtin_amdgcn_s_sleep(1);
        if ((++sp & 255u) == 0u) { if (xb_ld(&bar[XB_TMO])) break; if (sp > XB_SPIN_CAP) { atomicAdd(&bar[XB_TMO], 1u); break; } }
    }
    nloc = mine > 0u ? mine : 1u; nx = cnt > 0u ? cnt : 1u;
}

__device__ __forceinline__ void xcd_barrier(const XcdBarrier& b) {
    asm volatile("s_waitcnt vmcnt(0)" ::: "memory");
    __syncthreads();
    if (threadIdx.x == 0) {
        unsigned* bar = b.bar;
        __builtin_amdgcn_s_waitcnt(0);
        unsigned nloc = b.st[0], nx = b.st[1];
        if (nloc == 0u) { xcd_barrier_complete(bar, b.x, nloc, nx); b.st[0] = nloc; b.st[1] = nx; }
        const unsigned old = xb_add(&bar[XB_XSUB(b.x)], 1u);
        const unsigned gen = old / nloc;
        if (old + 1u == (gen + 1u) * nloc) {
            __builtin_amdgcn_fence(__ATOMIC_RELEASE, "agent");
            asm volatile("s_waitcnt vmcnt(0)" ::: "memory");
            const unsigned og = xb_add(&bar[XB_TOP], 1u);
            const unsigned tg = og / nx;
            if (og + 1u == (tg + 1u) * nx) xb_add(&bar[XB_TOPGEN], 1u);
            else XB_SPIN(xb_ld(&bar[XB_TOPGEN]) == tg, bar);
            __builtin_amdgcn_fence(__ATOMIC_ACQUIRE, "agent");
            xb_add(&bar[XB_XGEN(b.x)], 1u);
            asm volatile("s_waitcnt vmcnt(0)" ::: "memory");
        } else {
            XB_SPIN(xb_ld(&bar[XB_XGEN(b.x)]) == gen, bar);
            __builtin_amdgcn_fence(__ATOMIC_ACQUIRE, "agent");
            asm volatile("s_waitcnt vmcnt(0)" ::: "memory");
        }
    }
    __syncthreads();
}

__device__ __forceinline__ float dpp_add(float v, const int ctrl_sel) {
    int t;
    if (ctrl_sel == 0) t = __builtin_amdgcn_update_dpp(0, __float_as_int(v), 0xB1, 0xF, 0xF, true);
    else if (ctrl_sel == 1) t = __builtin_amdgcn_update_dpp(0, __float_as_int(v), 0x4E, 0xF, 0xF, true);
    else if (ctrl_sel == 2) t = __builtin_amdgcn_update_dpp(0, __float_as_int(v), 0x141, 0xF, 0xF, true);
    else t = __builtin_amdgcn_update_dpp(0, __float_as_int(v), 0x140, 0xF, 0xF, true);
    return v + __int_as_float(t);
}
__device__ __forceinline__ float wave_sum_fast(float v) {
    v = dpp_add(v, 0); v = dpp_add(v, 1); v = dpp_add(v, 2); v = dpp_add(v, 3);
    { auto rr = __builtin_amdgcn_permlane16_swap(__float_as_uint(v), __float_as_uint(v), false, false); v = __uint_as_float(rr[0]) + __uint_as_float(rr[1]); }
    { auto rr = __builtin_amdgcn_permlane32_swap(__float_as_uint(v), __float_as_uint(v), false, false); v = __uint_as_float(rr[0]) + __uint_as_float(rr[1]); }
    return v;
}

struct Args { const float* in[19]; float* out; unsigned char* ws; float inv_freq[8]; };
enum { I_X = 0, I_META, I_G1, I_WIN, I_QG, I_KG, I_LQ1, I_LK1, I_LQ2, I_LK2, I_SUBLN, I_CW, I_CB, I_CLG, I_CLB, I_WOUT, I_G2, I_WUP, I_WDN };

__device__ __forceinline__ void p0_transpose_item(const float* W, int K, int N, bf16* WT, int out_row0, int n0, int k0, const float* kscale, LAS float* scr, int lane) {
    float tv[32], ts[32];
#pragma unroll
    for (int i = 0; i < 32; ++i) { const int kk = 2 * i + (lane >> 5); tv[i] = W[(size_t)(k0 + kk) * N + n0 + (lane & 31)]; ts[i] = kscale ? kscale[k0 + kk] : 1.0f; }
#pragma unroll
    for (int i = 0; i < 32; ++i) { const int kk = 2 * i + (lane >> 5); scr[kk * 33 + (lane & 31)] = tv[i] * ts[i]; }
    LDS_WAIT(); asm volatile("" ::: "memory");
    const int c = lane & 7;
#pragma unroll
    for (int j = 0; j < 4; ++j) { const int n = (lane >> 3) + 8 * j; const LAS float* s = scr + (8 * c) * 33 + n;
        v4u o; o.x = pk2(s[0 * 33], s[1 * 33]); o.y = pk2(s[2 * 33], s[3 * 33]); o.z = pk2(s[4 * 33], s[5 * 33]); o.w = pk2(s[6 * 33], s[7 * 33]);
        *(v4u*)(WT + (size_t)(out_row0 + n) * K + k0 + 8 * c) = o; }
    LDS_WAIT(); asm volatile("" ::: "memory");
}
__device__ __forceinline__ int win_pcol(int lc) {
    if (lc < 1024) { const int l = lc & 255; return (lc & ~255) + 128 * ((l >> 5) & 1) + 32 * (l >> 6) + (l & 31); }
    if (lc < 1536) return lc;
    if (lc < 2048) { const int ch = lc - 1536; return 1536 + 256 * (ch >> 7) + (ch & 127); }
    const int ch = lc - 2048; return 1536 + 256 * (ch >> 7) + 128 + (ch & 127);
}

__device__ __forceinline__ void p0_prologue(const Args& A, unsigned char* ws, LAS unsigned char* lds, int vcu, int G, int wave, int lane) {
    LAS float* scr = (LAS float*)(lds + wave * 16384);
    const int gw = vcu * NWAVES + wave, NGW = G * NWAVES;
    bf16* Win_t = (bf16*)(ws + WS_WIN); bf16* Wout_t = (bf16*)(ws + WS_WOUT); bf16* Wup_t = (bf16*)(ws + WS_WUP); bf16* Wdn_t = (bf16*)(ws + WS_WDN);
    constexpr int I_IN = (DM / 64) * (DIN / 32);
    for (int it = gw; it < I_IN; it += NGW) { const int nblk = DIN / 32, kb = it / nblk, nb = it % nblk; p0_transpose_item(A.in[I_WIN], DM, DIN, Win_t, win_pcol(32 * nb), 32 * nb, 64 * kb, nullptr, scr, lane); }
    {
        bf16* XN = (bf16*)(ws + WS_XN);
        f32x4 g[4];
#pragma unroll
        for (int j = 0; j < 4; ++j) g[j] = ((const f32x4*)A.in[I_G1])[lane + 64 * j];
        for (int m0 = gw; m0 < MX + NMETA; m0 += 4 * NGW) {
            f32x4 v[4][4];
#pragma unroll
            for (int q = 0; q < 4; ++q) { const int m = m0 + q * NGW; const bool ok = m < MX + NMETA;
                const float* src = !ok ? A.in[I_X] : (m < MX) ? A.in[I_X] + (size_t)m * DM : A.in[I_META] + (size_t)(m - MX) * DM;
                const f32x4* xr = (const f32x4*)src + lane;
#pragma unroll
                for (int j = 0; j < 4; ++j) v[q][j] = xr[64 * j]; }
#pragma unroll
            for (int q = 0; q < 4; ++q) { const int m = m0 + q * NGW; if (m >= MX + NMETA) continue;
                float s = 0.f;
#pragma unroll
                for (int j = 0; j < 4; ++j) s += (v[q][j].x * v[q][j].x + v[q][j].y * v[q][j].y) + (v[q][j].z * v[q][j].z + v[q][j].w * v[q][j].w);
                const float ms = wave_sum_fast(s) * (1.f / DM) + EPS; const float rs = __builtin_amdgcn_rsqf(ms);
                if (lane == 0 && m < MX) ((float*)(ws + WS_RN))[m] = ms * rs;
                unsigned long long* o8 = (unsigned long long*)(XN + (size_t)m * DM) + lane;
#pragma unroll
                for (int j = 0; j < 4; ++j) { const f32x4 y = v[q][j] * rs * g[j]; o8[64 * j] = (unsigned long long)pk2(y.x, y.y) | ((unsigned long long)pk2(y.z, y.w) << 32); } }
        }
    }
    {
        float* rope = (float*)(ws + WS_ROPE);
        const int pos = gw * 64 + lane;
        if (pos < SEQ + NMETA) {
#pragma unroll
            for (int i = 0; i < 8; ++i) {
                const float angf = (float)pos * A.inv_freq[i];
                const double rev = (double)angf * 0.15915494309189533577; const double fr = rev - __builtin_rint(rev);
                const float f = (float)fr;
                rope[pos * 16 + i] = __builtin_amdgcn_cosf(f); rope[pos * 16 + 8 + i] = __builtin_amdgcn_sinf(f); } }
    }
    {
        bf16* KB = (bf16*)(ws + WS_K); bf16* VB = (bf16*)(ws + WS_V); bf16* GB = (bf16*)(ws + WS_G);
        for (int it = gw; it < NB * 48 * 3; it += NGW) { const int which = it / (NB * 48), r = it % (NB * 48), b = r / 48, rr = r % 48;
            bf16* p = which == 0 ? KB + (size_t)(b * SPAD + 16 + rr) * 512 : which == 1 ? VB + (size_t)(b * SPAD + 16 + rr) * 512 : GB + (size_t)(b * SPAD + rr) * 512;
            ((v4u*)p)[lane] = (v4u){0u, 0u, 0u, 0u}; }
    }
}

__device__ __forceinline__ void meta_proj(const Args& A, unsigned char* ws, LAS unsigned char* lds, int vcu, int wave, int lane) {
    typedef short bf16x8 __attribute__((ext_vector_type(8)));
    const int fr = lane & 15, fq = lane >> 4;
    const int item = vcu * 2 + (wave >> 2), kc = wave & 3;
    const int kind = item < 8 ? 0 : item < 16 ? 1 : 2, g = kind == 2 ? item - 16 : (item & 7);
    const bf16* XNm = (const bf16*)(ws + WS_XN) + (size_t)(MX + fr) * DM + 8 * fq + 256 * kc;
    const bf16* Wt = (const bf16*)(ws + WS_WIN);
    const bf16* brow[4];
#pragma unroll
    for (int nb = 0; nb < 4; ++nb) { const int lc = kind == 0 ? 512 + 64 * g + 16 * nb + fr : kind == 1 ? 1024 + 64 * g + 16 * nb + fr : (nb < 2 ? 1536 + 32 * g + 16 * nb + fr : 2048 + 32 * g + 16 * (nb - 2) + fr);
        brow[nb] = Wt + (size_t)(win_pcol(lc & ~31) + (lc & 31)) * DM + 8 * fq + 256 * kc; }
    bf16x8 af[8], bf[8][4];
#pragma unroll
    for (int ks = 0; ks < 8; ++ks) { af[ks] = *(const bf16x8*)(XNm + 32 * ks);
#pragma unroll
        for (int nb = 0; nb < 4; ++nb) bf[ks][nb] = *(const bf16x8*)(brow[nb] + 32 * ks); }
    asm volatile("" ::: "memory");
    f32x4 acc[4];
#pragma unroll
    for (int nb = 0; nb < 4; ++nb) acc[nb] = (f32x4){0.f, 0.f, 0.f, 0.f};
#pragma unroll
    for (int ks = 0; ks < 8; ++ks)
#pragma unroll
        for (int nb = 0; nb < 4; ++nb) acc[nb] = __builtin_amdgcn_mfma_f32_16x16x32_bf16(bf[ks][nb], af[ks], acc[nb], 0, 0, 0);
    LAS f32x4* red = (LAS f32x4*)lds;
#pragma unroll
    for (int nb = 0; nb < 4; ++nb) red[(wave * 4 + nb) * 64 + lane] = acc[nb];
    __syncthreads();
    if (kc == 0) {
#pragma unroll
        for (int nb = 0; nb < 4; ++nb) acc[nb] = (red[((wave + 0) * 4 + nb) * 64 + lane] + red[((wave + 1) * 4 + nb) * 64 + lane]) + (red[((wave + 2) * 4 + nb) * 64 + lane] + red[((wave + 3) * 4 + nb) * 64 + lane]);
        if (kind == 0) {
            float ss = 0.f;
#pragma unroll
            for (int nb = 0; nb < 4; ++nb) ss += (acc[nb][0] * acc[nb][0] + acc[nb][1] * acc[nb][1]) + (acc[nb][2] * acc[nb][2] + acc[nb][3] * acc[nb][3]);
            ss += __shfl_xor(ss, 16); ss += __shfl_xor(ss, 32);
            const float rs = __builtin_amdgcn_rsqf(ss * (1.0f / 64.0f) + EPS);
#pragma unroll
            for (int nb = 0; nb < 4; ++nb) acc[nb] = acc[nb] * rs * *(const f32x4*)(A.in[I_KG] + 16 * nb + 4 * fq);
            f32x4 p; p[0] = __shfl_xor(acc[0][0], 32); p[1] = __shfl_xor(acc[0][1], 32); p[2] = __shfl_xor(acc[0][2], 32); p[3] = __shfl_xor(acc[0][3], 32);
            const float* rp = (const float*)(ws + WS_ROPE) + fr * 16 + 4 * (fq & 1);
            const f32x4 c = *(const f32x4*)rp, s = *(const f32x4*)(rp + 8);
            const float sg = (fq & 2) ? 1.f : -1.f;
            acc[0] = acc[0] * c + (p * s) * sg;
        }
        if (kind == 2) {
#pragma unroll
            for (int nb = 0; nb < 2; ++nb)
#pragma unroll
                for (int e = 0; e < 4; ++e) acc[nb][e] = acc[nb][e] * __builtin_amdgcn_rcpf(1.0f + __builtin_amdgcn_exp2f(-1.4426950408889634f * acc[nb + 2][e]));
        }
        bf16* dst = kind == 0 ? (bf16*)(ws + WS_K) : kind == 1 ? (bf16*)(ws + WS_V) : (bf16*)(ws + WS_G);
        const int r0 = kind == 2 ? 48 + fr : fr, c0 = (kind == 2 ? 32 * g : 64 * g) + 4 * fq, nnb = kind == 2 ? 2 : 4;
#pragma unroll 1
        for (int b = 0; b < NB; ++b) { bf16* o = dst + (size_t)(b * SPAD + r0) * 512 + c0;
#pragma unroll
            for (int nb = 0; nb < 4; ++nb) if (nb < nnb) *(unsigned long long*)(o + 16 * nb) = (unsigned long long)pk2(acc[nb][0], acc[nb][1]) | ((unsigned long long)pk2(acc[nb][2], acc[nb][3]) << 32); }
    }
    __syncthreads();
}

__device__ __forceinline__ void wconv_phase(const Args& A, unsigned char* ws, LAS unsigned char* lds, int wave, int lane) {
    LAS float* scr = (LAS float*)(lds + wave * 16384);
    bf16* Wout_t = (bf16*)(ws + WS_WOUT); bf16* Wup_t = (bf16*)(ws + WS_WUP); bf16* Wdn_t = (bf16*)(ws + WS_WDN);
    constexpr int I_OUT = (DM / 64) * (DM / 32), I_UP = (DM / 64) * (DFF / 32), I_DN = (DFF / 64) * (DM / 32), NIT = I_OUT + I_UP + I_DN;
    unsigned* wq = (unsigned*)(ws + WS_CTL) + 96;
    volatile LAS unsigned* TK = (volatile LAS unsigned*)(lds + LDS_BYTES - 256 + 64);
    for (;;) {
        if (wave == 0 && lane == 0) TK[0] = __hip_atomic_fetch_add(wq, 1u, __ATOMIC_RELAXED, __HIP_MEMORY_SCOPE_AGENT);
        __syncthreads();
        const int t = (int)TK[0];
        __syncthreads();
        if (t * NWAVES >= NIT) break;
        int r = t * NWAVES + wave;
        if (r >= NIT) continue;
        if (r < I_OUT) { const int nblk = DM / 32, kb = r / nblk, nb = r % nblk; p0_transpose_item(A.in[I_WOUT], DM, DM, Wout_t, 32 * nb, 32 * nb, 64 * kb, nullptr, scr, lane); continue; } r -= I_OUT;
        if (r < I_UP) { const int nblk = DFF / 32, kb = r / nblk, nb = r % nblk; p0_transpose_item(A.in[I_WUP], DM, DFF, Wup_t, 32 * nb, 32 * nb, 64 * kb, A.in[I_G2], scr, lane); continue; } r -= I_UP;
        { const int nblk = DM / 32, kb = r / nblk, nb = r % nblk; p0_transpose_item(A.in[I_WDN], DFF, DM, Wdn_t, 32 * nb, 32 * nb, 64 * kb, nullptr, scr, lane); }
    }
}

constexpr int CONV_R = 32;
__device__ __forceinline__ void conv_phase(const Args& A, unsigned char* ws, LAS unsigned char* lds, int vcu, int G, int wave, int lane) {
    LAS float* cbuf = (LAS float*)lds;
    const bf16* GB = (const bf16*)(ws + WS_G); bf16* MIX = (bf16*)(ws + WS_MIX);
    const int cp = (wave & 3) * 64 + lane, half = wave >> 2;
    f32x2 w[CONVW];
#pragma unroll
    for (int j = 0; j < CONVW; ++j) w[j] = *(const f32x2*)(A.in[I_CW] + j * DCONV + 2 * cp);
    const f32x2 bias = *(const f32x2*)(A.in[I_CB] + 2 * cp);
    const f32x4 lg0 = *(const f32x4*)(A.in[I_CLG] + lane * 8), lg1 = *(const f32x4*)(A.in[I_CLG] + lane * 8 + 4), lb0 = *(const f32x4*)(A.in[I_CLB] + lane * 8), lb1 = *(const f32x4*)(A.in[I_CLB] + lane * 8 + 4);
    constexpr int NITEMS = MX / (2 * CONV_R);
    unsigned* cq = (unsigned*)(ws + WS_CTL) + 32;
    volatile LAS unsigned* TK = (volatile LAS unsigned*)(lds + LDS_BYTES - 256 + 64);
    if (wave == 0 && lane == 0) { TK[0] = __hip_atomic_fetch_add(cq, 1u, __ATOMIC_RELAXED, __HIP_MEMORY_SCOPE_AGENT); TK[1] = __hip_atomic_fetch_add(cq, 1u, __ATOMIC_RELAXED, __HIP_MEMORY_SCOPE_AGENT); }
    __syncthreads();
    int it = (int)TK[0], nxt = (int)TK[1];
    __syncthreads();
#define CONV_SRC(item, sub) (GB + (size_t)(((((item) * 2 * CONV_R + half * CONV_R + (sub) * 16) >> 13) * SPAD) + 34 + (((item) * 2 * CONV_R + half * CONV_R + (sub) * 16) & 8191)) * 512 + 2 * cp)
#define CONV_LOAD(buf, item, sub) do { const bf16* gs_ = CONV_SRC(item, sub); _Pragma("unroll") for (int i = 0; i < 46; ++i) buf[i] = *(const unsigned*)(gs_ + (size_t)i * 512); } while (0)
#define CONV_FMA(buf, sub) do { f32x2 acc[16]; _Pragma("unroll") for (int o = 0; o < 16; ++o) acc[o] = bias; \
        _Pragma("unroll") for (int i = 0; i < 46; ++i) { const f32x2 x = {bf_lo(buf[i]), bf_hi(buf[i])}; _Pragma("unroll") for (int o = 0; o < 16; ++o) { const int j = i - o; if (j >= 0 && j < CONVW) acc[o] += w[j] * x; } } \
        _Pragma("unroll") for (int o = 0; o < 16; ++o) *(LAS f32x2*)(cbuf + (half * CONV_R + (sub) * 16 + o) * DCONV + 2 * cp) = acc[o]; } while (0)
    unsigned bufA[46], bufB[46];
    if (it < NITEMS) CONV_LOAD(bufA, it, 0);
#pragma unroll 1
    while (it < NITEMS) {
        if (wave == 0 && lane == 0) TK[0] = __hip_atomic_fetch_add(cq, 1u, __ATOMIC_RELAXED, __HIP_MEMORY_SCOPE_AGENT);
        CONV_LOAD(bufB, it, 1);
        CONV_FMA(bufA, 0);
        if (nxt < NITEMS) CONV_LOAD(bufA, nxt, 0);
        CONV_FMA(bufB, 1);
        __syncthreads();
        const int nn = (int)TK[0];
#pragma unroll
        for (int rr = 0; rr < 8; ++rr) { const int lr = wave * 8 + rr;
            f32x4 x0 = *(const LAS f32x4*)(cbuf + lr * DCONV + lane * 8), x1 = *(const LAS f32x4*)(cbuf + lr * DCONV + lane * 8 + 4);
            const float mu = wave_sum_fast((x0[0] + x0[1]) + (x0[2] + x0[3]) + (x1[0] + x1[1]) + (x1[2] + x1[3])) * (1.f / DCONV);
            x0 = x0 - mu; x1 = x1 - mu;
            const float var = wave_sum_fast((x0[0] * x0[0] + x0[1] * x0[1]) + (x0[2] * x0[2] + x0[3] * x0[3]) + (x1[0] * x1[0] + x1[1] * x1[1]) + (x1[2] * x1[2] + x1[3] * x1[3])) * (1.f / DCONV);
            const float rs = __builtin_amdgcn_rsqf(var + EPS);
            x0 = x0 * rs * lg0 + lb0; x1 = x1 * rs * lg1 + lb1;
#pragma unroll
            for (int e = 0; e < 4; ++e) { x0[e] = x0[e] * __builtin_amdgcn_rcpf(1.0f + __builtin_amdgcn_exp2f(-1.4426950408889634f * x0[e])); x1[e] = x1[e] * __builtin_amdgcn_rcpf(1.0f + __builtin_amdgcn_exp2f(-1.4426950408889634f * x1[e])); }
            *(v4u*)(MIX + (size_t)(it * 2 * CONV_R + lr) * DM + 512 + lane * 8) = pg8::pack8(x0, x1); }
        __syncthreads();
        it = nxt; nxt = nn;
    }
#undef CONV_SRC
#undef CONV_LOAD
#undef CONV_FMA
}

__device__ __forceinline__ void combine_phase(const Args& A, unsigned char* ws, int vcu, int G, int wave, int lane) {
    const bf16* OB = (const bf16*)(ws + WS_O); bf16* MIX = (bf16*)(ws + WS_MIX);
    const float d1 = wave_sum(A.in[I_LQ1][lane] * A.in[I_LK1][lane]), d2 = wave_sum(A.in[I_LQ2][lane] * A.in[I_LK2][lane]);
    const float lam_init = 0.2f;
    const float lam = __builtin_amdgcn_exp2f(d1 * 1.4426950408889634f) - __builtin_amdgcn_exp2f(d2 * 1.4426950408889634f) + lam_init;
    const int h = lane >> 4, q = lane & 15;
    const f32x4 sg0 = *(const f32x4*)(A.in[I_SUBLN] + 8 * q), sg1 = *(const f32x4*)(A.in[I_SUBLN] + 8 * q + 4);
    const int gw = vcu * NWAVES + wave, NGW = G * NWAVES;
    for (int row = gw; row < MX; row += NGW) {
        const bf16* o1 = OB + (size_t)row * 1024 + h * 256 + 8 * q;
        const v4u a = *(const v4u*)o1, bq = *(const v4u*)(o1 + 128);
        f32x4 d0, d1v;
        d0[0] = bf_lo(a.x) - lam * bf_lo(bq.x); d0[1] = bf_hi(a.x) - lam * bf_hi(bq.x); d0[2] = bf_lo(a.y) - lam * bf_lo(bq.y); d0[3] = bf_hi(a.y) - lam * bf_hi(bq.y);
        d1v[0] = bf_lo(a.z) - lam * bf_lo(bq.z); d1v[1] = bf_hi(a.z) - lam * bf_hi(bq.z); d1v[2] = bf_lo(a.w) - lam * bf_lo(bq.w); d1v[3] = bf_hi(a.w) - lam * bf_hi(bq.w);
        float ss = (d0[0] * d0[0] + d0[1] * d0[1]) + (d0[2] * d0[2] + d0[3] * d0[3]) + (d1v[0] * d1v[0] + d1v[1] * d1v[1]) + (d1v[2] * d1v[2] + d1v[3] * d1v[3]);
        ss += __shfl_xor(ss, 1); ss += __shfl_xor(ss, 2); ss += __shfl_xor(ss, 4); ss += __shfl_xor(ss, 8);
        const float rs = __builtin_amdgcn_rsqf(ss * (1.f / 128.f) + EPS) * (1.0f - lam_init);
        *(v4u*)(MIX + (size_t)row * DM + h * 128 + 8 * q) = pg8::pack8(d0 * rs * sg0, d1v * rs * sg1);
    }
}

__global__ void __launch_bounds__(NWAVES * 64, 2) hymba_fwd(Args args) {
    extern __shared__ __attribute__((aligned(16))) unsigned char lds[];
    cg::grid_group grid = cg::this_grid();
    LAS unsigned char* ldsl = (LAS unsigned char*)lds;
    volatile LAS unsigned* MISC = (volatile LAS unsigned*)(ldsl + LDS_BYTES - 256);
    if (threadIdx.x < 32) MISC[threadIdx.x] = 0u;
    __syncthreads();
    const XcdBarrier bar = xcd_barrier_post((unsigned*)(args.ws + WS_CTL) + 4096, MISC + 8);
    const int G = gridDim.x; const int bx = blockIdx.x; const int vcu = (G % 8 == 0) ? (bx % 8) * (G / 8) + bx / 8 : bx;
#ifndef PROBE_DUP
#define PROBE_DUP 0
#endif
#define REP(mask) for (int rep_ = 0; rep_ < (((PROBE_DUP) & (mask)) ? 2 : 1); ++rep_)
#define PHASE_VARS() unsigned char* ws = args.ws; int tid_ = threadIdx.x; asm volatile("" : "+v"(tid_)); const int lane = tid_ & 63, wave = __builtin_amdgcn_readfirstlane(tid_ >> 6); (void)lane; (void)wave

    REP(1) { PHASE_VARS(); p0_prologue(args, ws, ldsl, vcu, G, wave, lane); }
    if (args.ws == nullptr) grid.sync();
    xcd_barrier(bar);

    REP(2) {
        PHASE_VARS();
        pg8::Gemm g{(bf16*)(ws + WS_XN), (bf16*)(ws + WS_WIN), MX, DIN, DM}; pg8::StaticOrder S; S.init(MX, DIN, G, bx, WGM_P1);
        pg8::EpiInProj E{(bf16*)(ws + WS_Q), (bf16*)(ws + WS_K), (bf16*)(ws + WS_V), (bf16*)(ws + WS_G), args.in[I_QG], args.in[I_KG], (const float*)(ws + WS_ROPE)};
        pg8::gemm_phase<pg8::EpiInProj, pg8::StaticOrder, PG8_ALIGN, PG8_SP2>(ldsl, g, S, E);
    }
    {
        PHASE_VARS();
        unsigned* mq = (unsigned*)(ws + WS_CTL) + 160;
        volatile LAS unsigned* TK = (volatile LAS unsigned*)(ldsl + LDS_BYTES - 256 + 64);
        for (;;) {
            if (tid_ == 0) TK[0] = __hip_atomic_fetch_add(mq, 1u, __ATOMIC_RELAXED, __HIP_MEMORY_SCOPE_AGENT);
            __syncthreads();
            const int t = (int)TK[0];
            __syncthreads();
            if (t >= 16) break;
            meta_proj(args, ws, ldsl, t, wave, lane);
        }
    }
    xcd_barrier(bar);

    REP(8) {
        PHASE_VARS();
        static_assert(attn_body::V2_LDS_BYTES <= LDS_BYTES - 256, "attention LDS");
        const float dq1 = wave_sum(args.in[I_LQ1][lane] * args.in[I_LK1][lane]), dq2 = wave_sum(args.in[I_LQ2][lane] * args.in[I_LK2][lane]);
        const float lam_init = 0.2f;
        const float lam = __builtin_amdgcn_exp2f(dq1 * 1.4426950408889634f) - __builtin_amdgcn_exp2f(dq2 * 1.4426950408889634f) + lam_init;
        for (int vv = vcu; vv < 256; vv += G) {
            const int bh = vv >> 4, s = vv & 15;
            const int b = bh >> 2, head = bh & 3;
            const attn_body::bf16* Kh = (const attn_body::bf16*)(ws + WS_K) + (size_t)(b * SPAD) * 512 + head * 128;
            const attn_body::bf16* Vh = (const attn_body::bf16*)(ws + WS_V) + (size_t)(b * SPAD) * 512 + head * 128;
            for (int i = 0; i < 2; ++i) {
                const int qb = i ? 31 - s : s;
                const int q0 = qb * 256;
                const attn_body::bf16* Qu = (const attn_body::bf16*)(ws + WS_Q) + (size_t)(b * SEQ + q0) * 512 + head * 128;
                attn_body::bf16* Mu = (attn_body::bf16*)(ws + WS_MIX) + (size_t)(b * SEQ + q0) * 1024 + head * 128;
                attn_body::attn_unit128<0>(q0, Qu, Kh, Vh, Mu, (char*)lds, lam, 1.0f - lam_init, args.in[I_SUBLN]);
                attn_body::attn_unit128<1>(q0, Qu + 64, Kh + 64, Vh, Mu, (char*)lds, lam, 1.0f - lam_init, args.in[I_SUBLN]);
            }
        }
    }
    REP(4) { PHASE_VARS(); conv_phase(args, ws, ldsl, vcu, G, wave, lane); }
    { PHASE_VARS(); wconv_phase(args, ws, ldsl, wave, lane); }
    xcd_barrier(bar);

    REP(32) {
        PHASE_VARS();
        pg8::Gemm g{(bf16*)(ws + WS_MIX), (bf16*)(ws + WS_WOUT), MX, DM, DM}; pg8::StaticOrder S; S.init(MX, DM, G, bx, WGM_P35);
        pg8::EpiOut E{(const bf16*)(ws + WS_XN), (const float*)(ws + WS_RN), args.in[I_G1], (bf16*)(ws + WS_H1B), (float*)(ws + WS_SSQ)};
        pg8::gemm_phase<pg8::EpiOut, pg8::StaticOrder, PG8_ALIGN, PG8_SP2>(ldsl, g, S, E);
    }
    xcd_barrier(bar);

    REP(64) {
        PHASE_VARS();
        pg8::Gemm g{(bf16*)(ws + WS_H1B), (bf16*)(ws + WS_WUP), MX, DFF, DM}; pg8::StaticOrder S; S.init(MX, DFF, G, bx, WGM_P4);
        pg8::EpiUp E{(bf16*)(ws + WS_HB), (const float*)(ws + WS_SSQ)};
        pg8::gemm_phase<pg8::EpiUp, pg8::StaticOrder, PG8_ALIGN, PG8_SP2>(ldsl, g, S, E);
    }
    xcd_barrier(bar);

    {
        PHASE_VARS();
        pg8::Gemm g{(bf16*)(ws + WS_HB), (bf16*)(ws + WS_WDN), MX, DM, DFF}; pg8::StaticOrder S; S.init(MX, DM, G, bx, WGM_P35);
        pg8::EpiDown E{(const bf16*)(ws + WS_H1B), args.out};
        pg8::gemm_phase<pg8::EpiDown, pg8::StaticOrder, PG8_ALIGN, PG8_SP2>(ldsl, g, S, E);
    }
#undef PHASE_VARS
#undef REP
}

extern "C" void kernel_launch(void* const* d_in, const int* in_sizes, int n_in, void* d_out, int out_size, void* d_ws, size_t ws_size, hipStream_t stream) {
    static int grid = 0;
    if (grid == 0) {
        if (n_in != 19 || in_sizes[0] != MX * DM || out_size != MX * DM || ws_size < WS_END) { fprintf(stderr, "kernel_launch: unexpected shapes: n_in %d, in0 %d, out %d, ws %zu (need %zu); nothing launched\n", n_in, n_in > 0 ? in_sizes[0] : -1, out_size, ws_size, (size_t)WS_END); grid = -1; return; }
        int dev = 0, cus = 0, per_cu = 0;
        if (hipGetDevice(&dev) != hipSuccess || hipDeviceGetAttribute(&cus, hipDeviceAttributeMultiprocessorCount, dev) != hipSuccess) { fprintf(stderr, "kernel_launch: device query failed\n"); grid = -1; return; }
        if (hipFuncSetAttribute((const void*)hymba_fwd, hipFuncAttributeMaxDynamicSharedMemorySize, LDS_BYTES) != hipSuccess) { fprintf(stderr, "kernel_launch: hipFuncSetAttribute failed\n"); grid = -1; return; }
        if (hipOccupancyMaxActiveBlocksPerMultiprocessor(&per_cu, (const void*)hymba_fwd, NWAVES * 64, LDS_BYTES) != hipSuccess || per_cu < 1) { fprintf(stderr, "kernel_launch: occupancy query says %d\n", per_cu); per_cu = 1; }
        (void)hipGetLastError();
        grid = cus * 1;
        fprintf(stderr, "kernel_launch: grid %d (occupancy query %d per CU)\n", grid, per_cu);
    }
    if (grid < 0) return;
    Args a{};
    for (int i = 0; i < 19; ++i) a.in[i] = (const float*)d_in[i];
    a.out = (float*)d_out; a.ws = (unsigned char*)d_ws;
    for (int i = 0; i < 8; ++i) a.inv_freq[i] = (float)pow(500000.0, -(double)i / 8.0);
    if (hipMemsetAsync((char*)d_ws + WS_CTL, 0, 65536, stream) != hipSuccess) { fprintf(stderr, "kernel_launch: hipMemsetAsync failed\n"); return; }
    void* kargs[] = {&a};
    const hipError_t le = hipLaunchCooperativeKernel((const void*)hymba_fwd, dim3(grid), dim3(NWAVES * 64), kargs, LDS_BYTES, stream);
    if (le != hipSuccess) fprintf(stderr, "kernel_launch: cooperative launch failed: %s (grid %d)\n", hipGetErrorName(le), grid);
}
```

```cpp
#include <hip/hip_cooperative_groups.h>
#include <cmath>
#include <hip/hip_runtime.h>
#include <cstdio>
#include <cstdint>
namespace pg8 {
#define PG8_LAS __attribute__((address_space(3)))
typedef unsigned short bf16_t;
typedef short bf16x8 __attribute__((ext_vector_type(8)));
typedef float f32x4 __attribute__((ext_vector_type(4)));
typedef unsigned u32x4 __attribute__((ext_vector_type(4)));
constexpr int BM = 256, BK = 64, HALF = 128, HTB = HALF * BK * 2  , STAGE_BYTES = 8 * HTB, NXCD = 8, WGM = 8;

__host__ __device__ __forceinline__ int lds_byte(int r, int c) { const int st = (r >> 4) * 2 + (c >> 5), rr = r & 15, cc = c & 31, ob = rr * 64 + cc * 2; return st * 1024 + (ob ^ (((ob >> 9) & 1) << 5)); }
__host__ __device__ __forceinline__ void stage_rc(int b, int& R, int& C) { const int st = b / 1024, sb = b % 1024, swz = sb ^ (((sb >> 9) & 1) << 5); R = (st >> 1) * 16 + swz / 64; C = (st & 1) * 32 + (swz % 64) / 2; }
__host__ __device__ __forceinline__ int perm32(int rho) { const int n = rho >> 4, i = rho & 15; return 8 * (i >> 2) + 4 * n + (i & 3); }

struct Unit { int pm, pn; };
struct Gemm { const bf16_t* A; const bf16_t* Bt; int M, N, K; };

struct StaticOrder {
    int nM, nN, nwg, G, c, wgm;
    __host__ __device__ void init(int M, int N, int G_, int c_, int wgm_ = WGM) { nM = M / BM; nN = N / BM; nwg = nM * nN; G = G_; c = c_; wgm = wgm_; }
    __host__ __device__ bool next(int i, Unit& u) const {
        const long L = (long)i * G + c; if (L >= nwg) return false;
        int wgid = (int)L; { const int q = nwg / NXCD, r = nwg % NXCD, xcd = wgid % NXCD, off = wgid / NXCD; wgid = (xcd < r ? xcd * (q + 1) : r * (q + 1) + (xcd - r) * q) + off; }
        const int nig = wgm * nN, gid = wgid / nig, fm = gid * wgm, gsz = (nM - fm) < wgm ? (nM - fm) : wgm;
        u.pm = fm + ((wgid % nig) % gsz); u.pn = (wgid % nig) / gsz; return true;
    }
    __device__ __forceinline__ void a_ready(const Unit&) const {}
    __device__ __forceinline__ void done(const Unit&) const {}
};

__device__ __forceinline__ unsigned cvt_pk_bf16(float lo, float hi) { unsigned r; asm volatile("v_cvt_pk_bf16_f32 %0, %1, %2" : "=v"(r) : "v"(lo), "v"(hi)); return r; }
typedef float f32x2 __attribute__((ext_vector_type(2)));
__device__ __forceinline__ f32x2 gelu_pk(f32x2 v) {
    const f32x2 av = __builtin_elementwise_abs(v), d = av * 0.2316418882f + 1.0f;
    f32x2 t; t.x = __builtin_amdgcn_rcpf(d.x); t.y = __builtin_amdgcn_rcpf(d.y);
    f32x2 q = t * 0.5307027145f + (-0.7265760135f); q = q * t + 0.7107068705f; q = q * t + (-0.142248368f); q = q * t + 0.127414796f; q = q * t;
    const f32x2 s = (v * v) * (-0.72134752044f);
    f32x2 e; e.x = __builtin_amdgcn_exp2f(s.x); e.y = __builtin_amdgcn_exp2f(s.y);
    const f32x2 m = v * (q * e), r = v - m;
    f32x2 o; o.x = v.x < 0.f ? m.x : r.x; o.y = v.y < 0.f ? m.y : r.y; return o;
}

template <int ACT  > struct EpiBf16 {
    static constexpr bool PERM = true, AFTER_DRAIN = false; static_assert(ACT == 0 || ACT == 1, "EpiBf16: ACT is 0 (none) or 1 (gelu_pk)");
    bf16_t* O; int ldc; const float* bias; int split_cols; size_t split_stride; float scale0;
    __device__ __forceinline__ void operator()(const f32x4 (&acc)[2][2][4][2], const Unit& u, int wr, int wc, int fr, int fq) const {
        const int row0 = u.pm * BM + wr * 64 + fr; int colt = u.pn * BM; bf16_t* base = O;
        float sc = 1.f; if (split_cols) { const int t = colt / split_cols; base += (size_t)t * split_stride; colt -= t * split_cols; if (t == 0) sc = scale0; }
        const int col0 = colt + wc * 32 + 8 * fq, bcol0 = u.pn * BM + wc * 32 + 8 * fq;
        f32x4 bv[2][2];
#pragma unroll
        for (int bj = 0; bj < 2; ++bj)
#pragma unroll
            for (int n = 0; n < 2; ++n) bv[bj][n] = bias ? *(const f32x4*)(bias + bcol0 + bj * HALF + 4 * n) : (f32x4){0.f, 0.f, 0.f, 0.f};
#pragma unroll
        for (int ai = 0; ai < 2; ++ai)
#pragma unroll
            for (int m = 0; m < 4; ++m) { bf16_t* rowp = base + (size_t)(row0 + ai * HALF + m * 16) * ldc + col0;
#pragma unroll
                for (int bj = 0; bj < 2; ++bj) { f32x4 v0 = acc[ai][bj][m][0] + bv[bj][0], v1 = acc[ai][bj][m][1] + bv[bj][1];
                    if (ACT == 1) { f32x2 a = gelu_pk((f32x2){v0[0], v0[1]}), b = gelu_pk((f32x2){v0[2], v0[3]}), c = gelu_pk((f32x2){v1[0], v1[1]}), d = gelu_pk((f32x2){v1[2], v1[3]});
                        v0 = (f32x4){a.x, a.y, b.x, b.y}; v1 = (f32x4){c.x, c.y, d.x, d.y}; }
                    v0 = v0 * sc; v1 = v1 * sc; u32x4 w; w.x = cvt_pk_bf16(v0[0], v0[1]); w.y = cvt_pk_bf16(v0[2], v0[3]); w.z = cvt_pk_bf16(v1[0], v1[1]); w.w = cvt_pk_bf16(v1[2], v1[3]);
                    *(u32x4*)(rowp + bj * HALF) = w; } }
    }
};

constexpr int XROWS = 32768, SPAD = 8256;
constexpr float QSCALE = 0.125f * 1.4426950408889634f;
__device__ __forceinline__ f32x4 shfl_xor4(f32x4 v, int m) { f32x4 r; r[0] = __shfl_xor(v[0], m); r[1] = __shfl_xor(v[1], m); r[2] = __shfl_xor(v[2], m); r[3] = __shfl_xor(v[3], m); return r; }
__device__ __forceinline__ u32x4 pack8(f32x4 a, f32x4 b) { u32x4 w; w.x = cvt_pk_bf16(a[0], a[1]); w.y = cvt_pk_bf16(a[2], a[3]); w.z = cvt_pk_bf16(b[0], b[1]); w.w = cvt_pk_bf16(b[2], b[3]); return w; }
struct EpiInProj {
    static constexpr bool PERM = true, AFTER_DRAIN = false;
    bf16_t *Q, *K, *V, *G; const float *qg, *kg, *rope;
    __device__ __forceinline__ void operator()(const f32x4 (&acc)[2][2][4][2], const Unit& u, int wr, int wc, int fr, int fq) const {
        const int pn = u.pn; constexpr bool meta = false;
        if (meta && (wr != 0 || pn < 2)) return;
        const int rbase = u.pm * BM + wr * 64 + fr;
        if (pn < 4) {
            const bool isq = pn < 2; const float* gp = isq ? qg : kg; const float osc = isq ? QSCALE : 1.f;
            f32x4 gv[2][2];
#pragma unroll
            for (int bj = 0; bj < 2; ++bj)
#pragma unroll
                for (int n = 0; n < 2; ++n) gv[bj][n] = *(const f32x4*)(gp + 32 * bj + 8 * fq + 4 * n);
            const int colb = (pn & 1) * 256 + wc * 64 + 8 * fq;
            bf16_t* dst = isq ? Q : K;
#pragma unroll
            for (int ai = 0; ai < 2; ++ai) {
                if (meta && ai) continue;
#pragma unroll
              for (int mh = 0; mh < 2; ++mh) {
                if (meta && mh) continue;
                f32x4 rv[2][4];
                if (fq < 2) {
#pragma unroll
                    for (int m2 = 0; m2 < 2; ++m2) { const int row = rbase + ai * HALF + (2 * mh + m2) * 16; const int pos = meta ? (row - XROWS) : ((row & 8191) + 16); const f32x4* rp = (const f32x4*)(rope + (size_t)pos * 16);
#pragma unroll
                        for (int k = 0; k < 4; ++k) rv[m2][k] = rp[k]; }
                }
                asm volatile("" ::: "memory");
#pragma unroll
                for (int m = 2 * mh; m < 2 * mh + 2; ++m) {
                    if (meta && m) continue;
                    const int row = rbase + ai * HALF + m * 16;
                    float ss = 0.f;
#pragma unroll
                    for (int bj = 0; bj < 2; ++bj)
#pragma unroll
                        for (int n = 0; n < 2; ++n) { const f32x4 x = acc[ai][bj][m][n]; ss += (x[0] * x[0] + x[1] * x[1]) + (x[2] * x[2] + x[3] * x[3]); }
                    ss += __shfl_xor(ss, 16); ss += __shfl_xor(ss, 32);
                    const float rs = __builtin_amdgcn_rsqf(ss * (1.0f / 64.0f) + 1e-6f);
                    f32x4 y00 = acc[ai][0][m][0] * rs * gv[0][0], y01 = acc[ai][0][m][1] * rs * gv[0][1], y10 = acc[ai][1][m][0] * rs * gv[1][0], y11 = acc[ai][1][m][1] * rs * gv[1][1];
                    const f32x4 p0 = shfl_xor4(y00, 16), p1 = shfl_xor4(y01, 16);
                    if (fq < 2) {
                        const f32x4 c0 = rv[m & 1][0], c1 = rv[m & 1][1], s0 = rv[m & 1][2], s1 = rv[m & 1][3];
                        const float sg = fq ? 1.f : -1.f;
                        y00 = y00 * c0 + (p0 * s0) * sg; y01 = y01 * c1 + (p1 * s1) * sg;
                    }
                    const u32x4 w0 = pack8(y00 * osc, y01 * osc), w1 = pack8(y10 * osc, y11 * osc);
                    if (!meta) {
                        const size_t orow = isq ? (size_t)row : (size_t)((row >> 13) * SPAD + 64 + (row & 8191));
                        *(u32x4*)(dst + orow * 512 + colb) = w0; *(u32x4*)(dst + orow * 512 + colb + 32) = w1;
                    } else {
#pragma unroll 1
                        for (int b = 0; b < 4; ++b) { const size_t orow = (size_t)(b * SPAD + fr); *(u32x4*)(dst + orow * 512 + colb) = w0; *(u32x4*)(dst + orow * 512 + colb + 32) = w1; }
                    }
                }
              }
            }
        } else if (pn < 6) {
            const int colb = (pn - 4) * 256 + wc * 32 + 8 * fq;
#pragma unroll
            for (int ai = 0; ai < 2; ++ai)
#pragma unroll
                for (int m = 0; m < 4; ++m) {
                    if (meta && (ai || m)) continue;
                    const int row = rbase + ai * HALF + m * 16;
                    const u32x4 w0 = pack8(acc[ai][0][m][0], acc[ai][0][m][1]), w1 = pack8(acc[ai][1][m][0], acc[ai][1][m][1]);
                    if (!meta) {
                        const size_t orow = (size_t)((row >> 13) * SPAD + 64 + (row & 8191));
                        *(u32x4*)(V + orow * 512 + colb) = w0; *(u32x4*)(V + orow * 512 + colb + HALF) = w1;
                    } else {
#pragma unroll 1
                        for (int b = 0; b < 4; ++b) { const size_t orow = (size_t)(b * SPAD + fr); *(u32x4*)(V + orow * 512 + colb) = w0; *(u32x4*)(V + orow * 512 + colb + HALF) = w1; }
                    }
                }
        } else {
            const int colb = (pn - 6) * 128 + wc * 32 + 8 * fq;
#pragma unroll
            for (int ai = 0; ai < 2; ++ai)
#pragma unroll
                for (int m = 0; m < 4; ++m) {
                    if (meta && (ai || m)) continue;
                    const int row = rbase + ai * HALF + m * 16;
                    f32x4 h[2];
#pragma unroll
                    for (int n = 0; n < 2; ++n) { const f32x4 a = acc[ai][0][m][n], g = acc[ai][1][m][n];
#pragma unroll
                        for (int e = 0; e < 4; ++e) h[n][e] = a[e] * __builtin_amdgcn_rcpf(1.0f + __builtin_amdgcn_exp2f(-1.4426950408889634f * g[e])); }
                    const u32x4 w0 = pack8(h[0], h[1]);
                    if (!meta) {
                        const size_t orow = (size_t)((row >> 13) * SPAD + 64 + (row & 8191));
                        *(u32x4*)(G + orow * 512 + colb) = w0;
                    } else {
#pragma unroll 1
                        for (int b = 0; b < 4; ++b) { const size_t orow = (size_t)(b * SPAD + 48 + fr); *(u32x4*)(G + orow * 512 + colb) = w0; }
                    }
                }
        }
    }
};
struct EpiOut {
    static constexpr bool PERM = true, AFTER_DRAIN = false;
    const bf16_t* xn; const float* rn; const float* g1; bf16_t* hb; float* ssq;
    __device__ __forceinline__ void operator()(const f32x4 (&acc)[2][2][4][2], const Unit& u, int wr, int wc, int fr, int fq) const {
        const int rbase = u.pm * BM + wr * 64 + fr, colb = u.pn * BM + wc * 32 + 8 * fq;
        f32x4 ig[2][2];
#pragma unroll
        for (int bj = 0; bj < 2; ++bj)
#pragma unroll
            for (int n = 0; n < 2; ++n) { const f32x4 g = *(const f32x4*)(g1 + colb + bj * HALF + 4 * n);
#pragma unroll
                for (int e = 0; e < 4; ++e) ig[bj][n][e] = __builtin_amdgcn_rcpf(g[e]); }
#pragma unroll
        for (int ai = 0; ai < 2; ++ai) {
            u32x4 xv[4][2]; float rv[4];
#pragma unroll
            for (int m = 0; m < 4; ++m) { const int row = rbase + ai * HALF + m * 16; rv[m] = rn[row];
#pragma unroll
                for (int bj = 0; bj < 2; ++bj) xv[m][bj] = *(const u32x4*)(xn + (size_t)row * 1024 + colb + bj * HALF); }
            asm volatile("" ::: "memory");
#pragma unroll
            for (int m = 0; m < 4; ++m) {
                const int row = rbase + ai * HALF + m * 16; float ss = 0.f;
#pragma unroll
                for (int bj = 0; bj < 2; ++bj) { const size_t off = (size_t)row * 1024 + colb + bj * HALF; const u32x4 w = xv[m][bj];
                    f32x4 x0, x1;
                    x0[0] = __uint_as_float(w.x << 16); x0[1] = __uint_as_float(w.x & 0xffff0000u); x0[2] = __uint_as_float(w.y << 16); x0[3] = __uint_as_float(w.y & 0xffff0000u);
                    x1[0] = __uint_as_float(w.z << 16); x1[1] = __uint_as_float(w.z & 0xffff0000u); x1[2] = __uint_as_float(w.w << 16); x1[3] = __uint_as_float(w.w & 0xffff0000u);
                    const f32x4 h0 = x0 * rv[m] * ig[bj][0] + acc[ai][bj][m][0], h1 = x1 * rv[m] * ig[bj][1] + acc[ai][bj][m][1];
                    *(u32x4*)(hb + off) = pack8(h0, h1);
                    ss += (h0[0] * h0[0] + h0[1] * h0[1]) + (h0[2] * h0[2] + h0[3] * h0[3]) + (h1[0] * h1[0] + h1[1] * h1[1]) + (h1[2] * h1[2] + h1[3] * h1[3]); }
                ss += __shfl_xor(ss, 16); ss += __shfl_xor(ss, 32);
                if (fq == 0) ssq[(size_t)row * 16 + u.pn * 4 + wc] = ss;
            }
        }
    }
};
struct EpiUp {
    static constexpr bool PERM = true, AFTER_DRAIN = false;
    bf16_t* hb; const float* ssq;
    __device__ __forceinline__ void operator()(const f32x4 (&acc)[2][2][4][2], const Unit& u, int wr, int wc, int fr, int fq) const {
        const int rbase = u.pm * BM + wr * 64 + fr, colb = u.pn * BM + wc * 32 + 8 * fq;
#pragma unroll
        for (int ai = 0; ai < 2; ++ai) {
            f32x4 sv[4][4];
#pragma unroll
            for (int m = 0; m < 4; ++m) { const f32x4* sp = (const f32x4*)(ssq + (size_t)(rbase + ai * HALF + m * 16) * 16);
#pragma unroll
                for (int k = 0; k < 4; ++k) sv[m][k] = sp[k]; }
            asm volatile("" ::: "memory");
#pragma unroll
            for (int m = 0; m < 4; ++m) {
                const int row = rbase + ai * HALF + m * 16;
                const f32x4 s0 = sv[m][0], s1 = sv[m][1], s2 = sv[m][2], s3 = sv[m][3];
                const float tot = ((s0[0] + s0[1]) + (s0[2] + s0[3])) + ((s1[0] + s1[1]) + (s1[2] + s1[3])) + ((s2[0] + s2[1]) + (s2[2] + s2[3])) + ((s3[0] + s3[1]) + (s3[2] + s3[3]));
                const float rs = __builtin_amdgcn_rsqf(tot * (1.0f / 1024.0f) + 1e-6f);
#pragma unroll
                for (int bj = 0; bj < 2; ++bj) { f32x4 a0 = acc[ai][bj][m][0] * rs, a1 = acc[ai][bj][m][1] * rs;
#pragma unroll
                    for (int e = 0; e < 4; ++e) { const float p = fmaxf(a0[e], 0.f), q = fmaxf(a1[e], 0.f); a0[e] = p * p; a1[e] = q * q; }
                    *(u32x4*)(hb + (size_t)row * 4096 + colb + bj * HALF) = pack8(a0, a1); }
            }
        }
    }
};
struct EpiDown {
    static constexpr bool PERM = true, AFTER_DRAIN = false;
    const bf16_t* h1; float* out;
    __device__ __forceinline__ void operator()(const f32x4 (&acc)[2][2][4][2], const Unit& u, int wr, int wc, int fr, int fq) const {
        const int rbase = u.pm * BM + wr * 64 + fr, colb = u.pn * BM + wc * 32 + 8 * fq;
        u32x4 hv[2][4][2];
#pragma unroll
        for (int ai = 0; ai < 2; ++ai)
#pragma unroll
            for (int m = 0; m < 4; ++m)
#pragma unroll
                for (int bj = 0; bj < 2; ++bj) hv[ai][m][bj] = *(const u32x4*)(h1 + (size_t)(rbase + ai * HALF + m * 16) * 1024 + colb + bj * HALF);
        asm volatile("" ::: "memory");
#pragma unroll
        for (int ai = 0; ai < 2; ++ai)
#pragma unroll
            for (int m = 0; m < 4; ++m) {
                const int row = rbase + ai * HALF + m * 16;
#pragma unroll
                for (int bj = 0; bj < 2; ++bj) { const size_t off = (size_t)row * 1024 + colb + bj * HALF; const u32x4 w = hv[ai][m][bj];
                    f32x4 r0, r1;
                    r0[0] = __uint_as_float(w.x << 16); r0[1] = __uint_as_float(w.x & 0xffff0000u); r0[2] = __uint_as_float(w.y << 16); r0[3] = __uint_as_float(w.y & 0xffff0000u);
                    r1[0] = __uint_as_float(w.z << 16); r1[1] = __uint_as_float(w.z & 0xffff0000u); r1[2] = __uint_as_float(w.w << 16); r1[3] = __uint_as_float(w.w & 0xffff0000u);
                    *(f32x4*)(out + off) = r0 + acc[ai][bj][m][0]; *(f32x4*)(out + off + 4) = r1 + acc[ai][bj][m][1]; }
            }
    }
};


template <class Epi, class Sched, bool ALIGN_EPI = false, bool SP2 = false>
__device__ __forceinline__ void gemm_phase(PG8_LAS unsigned char* lds, const Gemm g, const Sched& S, const Epi& E) {
    int tid_ = threadIdx.x; asm volatile("" : "+v"(tid_));
    const int tid = tid_, wid = __builtin_amdgcn_readfirstlane(tid >> 6), lane = tid & 63, wr = wid >> 2, wc = wid & 3, fr = lane & 15, fq = lane >> 4;
    const int K = g.K, nt = K / BK;
    unsigned voffA[2], voffB[2];
#pragma unroll
    for (int i = 0; i < 2; ++i) { int R, C; stage_rc(tid * 16 + i * 8192, R, C); const int Rb = Epi::PERM ? ((R & ~31) + perm32(R & 31)) : R;
        voffA[i] = (unsigned)(R * K + C) * 2u; voffB[i] = (unsigned)(Rb * K + C) * 2u; }
    const size_t kstep = (size_t)(BK * 2);
    const size_t hstep = (size_t)HALF * K * 2;
    const size_t tstep = 2 * hstep;
    const unsigned ldsw = (unsigned)wid * 1024u;
    const int aoff = lds_byte(wr * 64 + fr, fq * 8), boff = lds_byte(wc * 32 + fr, fq * 8);
#define PG8_SA(b, h) (((b) * 2 + (h)) * HTB)
#define PG8_SB(b, h) ((4 + (b) * 2 + (h)) * HTB)
#define PG8_STAGE(bufoff, gbase, voff) do { _Pragma("unroll") for (int _i = 0; _i < 2; ++_i) \
        __builtin_amdgcn_global_load_lds((const unsigned*)((const char*)(gbase) + (voff)[_i]), (PG8_LAS unsigned*)(lds + (bufoff) + ldsw + _i * 8192), 16, 0, 0); } while (0)
#define PG8_LDA(dst, b, h) do { _Pragma("unroll") for (int m = 0; m < 4; ++m) _Pragma("unroll") for (int k = 0; k < 2; ++k) dst[m][k] = *(const PG8_LAS bf16x8*)(lds + PG8_SA(b, h) + aoff + m * 2048 + k * 1024); } while (0)
#define PG8_LDB(dst, b, h) do { _Pragma("unroll") for (int n = 0; n < 2; ++n) _Pragma("unroll") for (int k = 0; k < 2; ++k) dst[n][k] = *(const PG8_LAS bf16x8*)(lds + PG8_SB(b, h) + boff + n * 2048 + k * 1024); } while (0)
#define PG8_MMA(ai, bj, At, Bt) do { __builtin_amdgcn_s_setprio(1); _Pragma("unroll") for (int m = 0; m < 4; ++m) _Pragma("unroll") for (int n = 0; n < 2; ++n) _Pragma("unroll") for (int k = 0; k < 2; ++k) \
        acc[ai][bj][m][n] = __builtin_amdgcn_mfma_f32_16x16x32_bf16(Bt[n][k], At[m][k], acc[ai][bj][m][n], 0, 0, 0); __builtin_amdgcn_s_setprio(0); } while (0)
#define PG8_WAIT_V(n) asm volatile("s_waitcnt vmcnt(" #n ")" ::: "memory")
#define PG8_WAIT_L(n) asm volatile("s_waitcnt lgkmcnt(" #n ")" ::: "memory")
#define PG8_BAR __builtin_amdgcn_s_barrier()
#define PG8_SCHED __builtin_amdgcn_sched_barrier(0)
    Unit cur, nxt; int ui = 0;
    if (!S.next(0, cur)) return;
    f32x4 acc[2][2][4][2];
#pragma unroll
    for (int a = 0; a < 2; ++a)
#pragma unroll
        for (int b = 0; b < 2; ++b)
#pragma unroll
            for (int m = 0; m < 4; ++m)
#pragma unroll
                for (int n = 0; n < 2; ++n) acc[a][b][m][n] = (f32x4){0.f, 0.f, 0.f, 0.f};
    bf16x8 At[4][2], B0[2][2], B1[2][2];
    const char* cA = (const char*)g.A + (size_t)cur.pm * tstep; const char* cB = (const char*)g.Bt + (size_t)cur.pn * tstep;
    S.a_ready(cur);
    if constexpr (SP2) {
        PG8_STAGE(PG8_SB(0, 0), cB, voffB); PG8_STAGE(PG8_SB(0, 1), cB + hstep, voffB); PG8_STAGE(PG8_SA(0, 0), cA, voffA); PG8_STAGE(PG8_SA(0, 1), cA + hstep, voffA);
        if (wr == 1) PG8_BAR;
        PG8_WAIT_V(2); PG8_BAR;
        PG8_STAGE(PG8_SB(1, 0), cB + kstep, voffB); PG8_STAGE(PG8_SA(1, 0), cA + kstep, voffA); PG8_STAGE(PG8_SB(1, 1), cB + hstep + kstep, voffB);
        PG8_WAIT_V(6); PG8_BAR;
    } else {
        PG8_STAGE(PG8_SB(0, 0), cB, voffB); PG8_STAGE(PG8_SA(0, 0), cA, voffA); PG8_STAGE(PG8_SB(0, 1), cB + hstep, voffB); PG8_STAGE(PG8_SA(0, 1), cA + hstep, voffA);
        if (wr == 1) PG8_BAR;
        PG8_WAIT_V(4); PG8_BAR;
        PG8_STAGE(PG8_SB(1, 0), cB + kstep, voffB); PG8_STAGE(PG8_SA(1, 0), cA + kstep, voffA); PG8_STAGE(PG8_SB(1, 1), cB + hstep + kstep, voffB);
        PG8_WAIT_V(6); PG8_BAR;
    }
    for (;;) {
        const bool has_next = S.next(ui + 1, nxt);
        const char* nA = has_next ? (const char*)g.A + (size_t)nxt.pm * tstep : cA; const char* nB = has_next ? (const char*)g.Bt + (size_t)nxt.pn * tstep : cB;
        for (int t = 0; t < nt; t += 2) {
            const bool last = (t == nt - 2);
            const char* a1 = cA + (size_t)(t + 1) * kstep;
            const char* a2 = last ? nA : cA + (size_t)(t + 2) * kstep; const char* b2 = last ? nB : cB + (size_t)(t + 2) * kstep;
            const char* a3 = a2 + kstep; const char* b3 = b2 + kstep;
            if (last && has_next) S.a_ready(nxt);
            if constexpr (SP2) {
            PG8_LDB(B0, 0, 0); PG8_LDB(B1, 0, 1); PG8_SCHED; PG8_LDA(At, 0, 0); PG8_STAGE(PG8_SA(1, 1), a1 + hstep, voffA);
            PG8_WAIT_V(8); PG8_WAIT_L(0); PG8_BAR; PG8_MMA(0, 0, At, B0); PG8_MMA(0, 1, At, B1); PG8_BAR; PG8_SCHED;
            PG8_LDA(At, 0, 1); PG8_STAGE(PG8_SB(0, 0), b2, voffB); PG8_STAGE(PG8_SB(0, 1), b2 + hstep, voffB); PG8_STAGE(PG8_SA(0, 0), a2, voffA);
            PG8_WAIT_V(8); PG8_WAIT_L(0); PG8_BAR; PG8_MMA(1, 0, At, B0); PG8_MMA(1, 1, At, B1); PG8_BAR; PG8_SCHED;
            PG8_LDB(B0, 1, 0); PG8_LDB(B1, 1, 1); PG8_SCHED; PG8_LDA(At, 1, 0); PG8_STAGE(PG8_SA(0, 1), a2 + hstep, voffA);
            PG8_WAIT_V(8); PG8_WAIT_L(0); PG8_BAR; PG8_MMA(0, 0, At, B0); PG8_MMA(0, 1, At, B1); PG8_BAR; PG8_SCHED;
            PG8_LDA(At, 1, 1); PG8_STAGE(PG8_SB(1, 0), b3, voffB); PG8_STAGE(PG8_SB(1, 1), b3 + hstep, voffB); PG8_STAGE(PG8_SA(1, 0), a3, voffA);
            PG8_WAIT_V(8); PG8_WAIT_L(0); PG8_BAR; PG8_MMA(1, 0, At, B0); PG8_MMA(1, 1, At, B1); PG8_BAR; PG8_SCHED;
            } else {
            PG8_LDB(B0, 0, 0); PG8_SCHED; PG8_LDA(At, 0, 0); PG8_STAGE(PG8_SA(1, 1), a1 + hstep, voffA);
            PG8_WAIT_L(8); PG8_BAR; PG8_WAIT_L(0); PG8_MMA(0, 0, At, B0); PG8_BAR; PG8_SCHED;
            PG8_LDB(B1, 0, 1); PG8_STAGE(PG8_SB(0, 0), b2, voffB);
            PG8_BAR; PG8_WAIT_L(0); PG8_MMA(0, 1, At, B1); PG8_BAR;
            PG8_LDA(At, 0, 1); PG8_STAGE(PG8_SA(0, 0), a2, voffA);
            PG8_BAR; PG8_WAIT_L(0); PG8_MMA(1, 0, At, B0); PG8_BAR; PG8_SCHED;
            PG8_STAGE(PG8_SB(0, 1), b2 + hstep, voffB);
            PG8_WAIT_V(6); PG8_BAR; PG8_MMA(1, 1, At, B1); PG8_BAR;
            PG8_LDB(B0, 1, 0); PG8_SCHED; PG8_LDA(At, 1, 0); PG8_STAGE(PG8_SA(0, 1), a2 + hstep, voffA);
            PG8_WAIT_L(8); PG8_BAR; PG8_WAIT_L(0); PG8_MMA(0, 0, At, B0); PG8_BAR; PG8_SCHED;
            PG8_LDB(B1, 1, 1); PG8_STAGE(PG8_SB(1, 0), b3, voffB);
            PG8_BAR; PG8_WAIT_L(0); PG8_MMA(0, 1, At, B1); PG8_BAR;
            PG8_LDA(At, 1, 1); PG8_STAGE(PG8_SA(1, 0), a3, voffA);
            PG8_BAR; PG8_WAIT_L(0); PG8_MMA(1, 0, At, B0); PG8_BAR; PG8_SCHED;
            PG8_STAGE(PG8_SB(1, 1), b3 + hstep, voffB);
            PG8_WAIT_V(6); PG8_BAR; PG8_MMA(1, 1, At, B1); PG8_BAR;
            }
        }
        if constexpr (ALIGN_EPI) { if (wr == 0) PG8_BAR; }
        if constexpr (!Epi::AFTER_DRAIN) { E(acc, cur, wr, wc, fr, fq); S.done(cur); }
        if (!has_next) break;
#pragma unroll
        for (int a = 0; a < 2; ++a)
#pragma unroll
            for (int b = 0; b < 2; ++b)
#pragma unroll
                for (int m = 0; m < 4; ++m)
#pragma unroll
                    for (int n = 0; n < 2; ++n) acc[a][b][m][n] = (f32x4){0.f, 0.f, 0.f, 0.f};
        cur = nxt; cA = nA; cB = nB; ++ui;
        if constexpr (ALIGN_EPI) { if (wr == 1) PG8_BAR; }
    }
    PG8_WAIT_V(0);
    if constexpr (!ALIGN_EPI) { if (wr == 0) PG8_BAR; }
    PG8_BAR;
    if constexpr (Epi::AFTER_DRAIN) { E.fused(acc, cur, wr, wc, fr, fq, lds, wid, lane); S.done(cur); }
#undef PG8_SA
#undef PG8_SB
#undef PG8_STAGE
#undef PG8_LDA
#undef PG8_LDB
#undef PG8_MMA
#undef PG8_WAIT_V
#undef PG8_WAIT_L
#undef PG8_BAR
#undef PG8_SCHED
}
}

#ifndef PG8_SP2
#define PG8_SP2 true
#endif
#ifndef PG8_ALIGN
#define PG8_ALIGN true
#endif
#include <hip/hip_bf16.h>
#include <cmath>
namespace attn_body {
using bf16=__hip_bfloat16;
using bf16x8=__attribute__((ext_vector_type(8)))short;
using s16x4=__attribute__((ext_vector_type(4)))short;
using f32x16=__attribute__((ext_vector_type(16)))float;
using u32x4=__attribute__((ext_vector_type(4)))unsigned;
constexpr int SEQ=8192,D=64,PQ=512,PO=1024;
constexpr int NW=8,QBLK=32,QB=QBLK*NW,KVBLK=64,NQB=SEQ/QB;
constexpr int ATTN_UNIT_ROWS=QB;
__device__ __forceinline__ int crow(int r,int hi){return (r&3)+8*(r>>2)+4*hi;}
#define SBAR() __builtin_amdgcn_sched_barrier(0)
__device__ __forceinline__ void cmask(f32x16&p0,f32x16&p1,int jb,int qrel,int hi){
  const float NEG=-INFINITY; int kb=64*jb+4*hi;
  #pragma unroll
  for(int r=0;r<16;++r){int kv=kb+(r&3)+8*(r>>2); if(kv>qrel)p0[r]=NEG; if(kv+32>qrel)p1[r]=NEG;}
}

constexpr int NSLOT=3, SLOTB=8192;
constexpr int LDS_K=0, LDS_V=NSLOT*SLOTB, LDS_WS=2*NSLOT*SLOTB, LDS_OST=LDS_WS+NW*64*4, LDS_BYTES=LDS_OST+NW*4096;
constexpr float C2=0.125f*1.4426950408889634f;
__device__ __forceinline__ void glds16(const void*gsrc,unsigned lds_dst){unsigned keep;
  asm volatile("s_mov_b32 %0, m0\n\ts_mov_b32 m0, %2\n\ts_nop 0\n\tglobal_load_lds_dwordx4 %1, off\n\ts_mov_b32 m0, %0":"=&s"(keep):"v"(gsrc),"s"(lds_dst):"memory");}
__device__ __forceinline__ float max3f(float a,float b,float c){float r;asm("v_max3_f32 %0, %1, %2, %3":"=v"(r):"v"(a),"v"(b),"v"(c));return r;}
__device__ __forceinline__ float max2f(float a,float b){float r;asm("v_max_f32_e32 %0, %1, %2":"=v"(r):"v"(a),"v"(b));return r;}
__device__ __forceinline__ float fadd_s(float a,float b){float r;asm("v_add_f32_e32 %0, %1, %2":"=v"(r):"v"(a),"v"(b));return r;}
__device__ __forceinline__ float fsub_s(float a,float b){float r;asm("v_sub_f32_e32 %0, %1, %2":"=v"(r):"v"(a),"v"(b));return r;}
typedef float f32x2_t __attribute__((ext_vector_type(2))); typedef __bf16 bf16x2_t __attribute__((ext_vector_type(2)));
__device__ __forceinline__ unsigned cvtpk_s(float lo,float hi){f32x2_t v={lo,hi};bf16x2_t b=__builtin_convertvector(v,bf16x2_t);return __builtin_bit_cast(unsigned,b);}
#define WAIT_BAR(N) asm volatile("s_waitcnt vmcnt(" #N ") lgkmcnt(0)\n\ts_barrier":::"memory")

__device__ __forceinline__ void qkt(f32x16&p0,f32x16&p1,const char*Kslot,const bf16x8*qr,const f32x16&negm,int r32,int hi){
  const char*kb=Kslot+hi*1024+r32*16;
  #pragma unroll
  for(int d0=0;d0<4;++d0){
    const bf16x8 b0=*reinterpret_cast<const bf16x8*>(kb+d0*2048);
    const bf16x8 b1=*reinterpret_cast<const bf16x8*>(kb+d0*2048+512);
    if(d0==0){p0=__builtin_amdgcn_mfma_f32_32x32x16_bf16(b0,qr[0],negm,0,0,0);p1=__builtin_amdgcn_mfma_f32_32x32x16_bf16(b1,qr[0],negm,0,0,0);}
    else{p0=__builtin_amdgcn_mfma_f32_32x32x16_bf16(b0,qr[d0],p0,0,0,0);p1=__builtin_amdgcn_mfma_f32_32x32x16_bf16(b1,qr[d0],p1,0,0,0);}}
}
typedef __attribute__((address_space(3))) const char* lds_cptr;
typedef short v4i16_t __attribute__((ext_vector_type(4)));
__device__ __forceinline__ void kload8(bf16x8*kf,lds_cptr kp){
  kf[0]=*(const __attribute__((address_space(3))) bf16x8*)(kp);      kf[1]=*(const __attribute__((address_space(3))) bf16x8*)(kp+512);
  kf[2]=*(const __attribute__((address_space(3))) bf16x8*)(kp+2048); kf[3]=*(const __attribute__((address_space(3))) bf16x8*)(kp+2560);
  kf[4]=*(const __attribute__((address_space(3))) bf16x8*)(kp+4096); kf[5]=*(const __attribute__((address_space(3))) bf16x8*)(kp+4608);
  kf[6]=*(const __attribute__((address_space(3))) bf16x8*)(kp+6144); kf[7]=*(const __attribute__((address_space(3))) bf16x8*)(kp+6656);
}
__device__ __forceinline__ void kload2(bf16x8*kf,lds_cptr kp,int j){ kf[2*j]=*(const __attribute__((address_space(3))) bf16x8*)(kp+j*2048); kf[2*j+1]=*(const __attribute__((address_space(3))) bf16x8*)(kp+j*2048+512); }
__device__ __forceinline__ s16x4 vtr(lds_cptr p){ return __builtin_bit_cast(s16x4,__builtin_amdgcn_ds_read_tr16_b64_v4i16((__attribute__((address_space(3))) v4i16_t*)p)); }
__device__ __forceinline__ float rowmax(const f32x16&p0,const f32x16&p1){
  float a=max3f(p0[0],p0[1],p1[0]),b=max3f(p0[2],p0[3],p1[1]);a=max3f(a,p1[2],p1[3]);
  #pragma unroll
  for(int r=4;r<16;r+=4){a=max3f(a,p0[r],p0[r+1]);b=max3f(b,p0[r+2],p0[r+3]);a=max3f(a,p1[r],p1[r+1]);b=max3f(b,p1[r+2],p1[r+3]);}
  const float m=max2f(a,b);
  auto rr=__builtin_amdgcn_permlane32_swap(__float_as_uint(m),__float_as_uint(m),false,false);
  return max2f(__uint_as_float(rr[0]),__uint_as_float(rr[1]));
}
__device__ __forceinline__ void pv(f32x16*o,int vb,bf16x8 pa0,bf16x8 pa1,bf16x8 pa2,bf16x8 pa3){
  #pragma unroll
  for(int d0=0;d0<2;++d0){s16x4 lo[4],hi[4];
    #pragma unroll
    for(int ks=0;ks<4;++ks){
      asm volatile("ds_read_b64_tr_b16 %0,%1 offset:%c2":"=&v"(lo[ks]):"v"(vb),"i"(d0*4096+ks*1024):"memory");
      asm volatile("ds_read_b64_tr_b16 %0,%1 offset:%c2":"=&v"(hi[ks]):"v"(vb),"i"(d0*4096+ks*1024+512):"memory");}
    asm volatile("s_waitcnt lgkmcnt(0)":::"memory");SBAR();
    #define PK(k) (bf16x8){lo[k][0],lo[k][1],lo[k][2],lo[k][3],hi[k][0],hi[k][1],hi[k][2],hi[k][3]}
    o[d0]=__builtin_amdgcn_mfma_f32_32x32x16_bf16(pa0,PK(0),o[d0],0,0,0);
    o[d0]=__builtin_amdgcn_mfma_f32_32x32x16_bf16(pa1,PK(1),o[d0],0,0,0);
    o[d0]=__builtin_amdgcn_mfma_f32_32x32x16_bf16(pa2,PK(2),o[d0],0,0,0);
    o[d0]=__builtin_amdgcn_mfma_f32_32x32x16_bf16(pa3,PK(3),o[d0],0,0,0);
    #undef PK
  }
}

#ifndef ATTN_STORE16
#define ATTN_STORE16(p,v) (*(u32x4*)(p)=(v))
#endif
template<int THRL> __device__ __forceinline__ void attn_unit(int q0,const bf16*Qu,const bf16*__restrict__ Kh,const bf16*__restrict__ Vh,bf16*Ou,char*shm){
  int tid_=threadIdx.x; asm volatile("":"+v"(tid_)); const int tid=tid_,lane=tid&63,r32=lane&31,hi=lane>>5; const int wid=__builtin_amdgcn_readfirstlane(tid>>6);
  const bf16*Qw=Qu+(long)(wid*QBLK)*PQ;
  const unsigned lds0=(unsigned)(uintptr_t)shm;
  float*wsf=(float*)(shm+LDS_WS)+wid*64;
  const bf16*ksrc=Kh+(long)lane*PQ+wid*8;
  const bf16*vsrc=Vh+(long)(16*(wid&3)+(lane>>2))*PQ+(wid>>2)*32+(lane&3)*8;
  const unsigned kdst=lds0+LDS_K+wid*1024, vdst=lds0+LDS_V+wid*1024;
  #define DMA_K(t,slot) glds16(ksrc+(long)(t)*KVBLK*PQ,(unsigned)__builtin_amdgcn_readfirstlane(kdst+(slot)))
  #define DMA_V(t,slot) glds16(vsrc+(long)(t)*KVBLK*PQ,(unsigned)__builtin_amdgcn_readfirstlane(vdst+(slot)))
  const int vb0=(int)(lds0+LDS_V)+((lane>>4)&1)*32+(lane&3)*8+(4*hi+((lane&15)>>2))*64;
  const char*Kbase=shm+LDS_K; bf16x8 kf[8];
  const lds_cptr shm3=(lds_cptr)shm; const lds_cptr kp0=shm3+LDS_K+hi*1024+r32*16; const lds_cptr vp0=shm3+LDS_V+((lane>>4)&1)*32+(lane&3)*8+(4*hi+((lane&15)>>2))*64;
  const int NT=(q0+QB)/KVBLK+1;
  DMA_K(0,0);DMA_V(0,0);DMA_K(1,SLOTB);
  bf16x8 qr[4];
  #pragma unroll
  for(int d0=0;d0<4;++d0)qr[d0]=*reinterpret_cast<const bf16x8*>(&Qw[(long)r32*PQ+d0*16+hi*8]);
  float mhat=0.f,l_reg=0.f;f32x16 o[2];o[0]=f32x16{};o[1]=f32x16{};f32x16 negm=f32x16{};asm volatile("":"+v"(negm));
  const int qrel=wid*QBLK+r32;
  #define CMASK(P0,P1,t) do{int jb_=(t)-(NT-4); if(jb_>=0)cmask(P0,P1,jb_,qrel,hi);}while(0)
  bool resc=false;
  #define START(P0,P1) do{ const float rm=rowmax(P0,P1); resc=false; \
    { const float dl=rm; mhat=fadd_s(mhat,dl); \
      _Pragma("unroll") for(int r=0;r<16;++r){P0[r]=fsub_s(P0[r],dl);P1[r]=fsub_s(P1[r],dl);} \
      _Pragma("unroll") for(int r=0;r<16;++r)negm[r]=-mhat; asm volatile("":"+v"(negm)); } \
    _Pragma("unroll") for(int r=0;r<16;++r)P0[r]=__builtin_amdgcn_exp2f(P0[r]); }while(0)
  #define RESC() do{ if(resc){ asm volatile("s_waitcnt lgkmcnt(0)":::"memory"); \
      _Pragma("unroll") for(int d_=0;d_<2;++d_) _Pragma("unroll") for(int r=0;r<16;++r)o[d_][r]*=wsf[crow(r,hi)]; } }while(0)
  f32x16 pA0,pA1,pB0,pB1;
  int sl_prev=0,sl_cur=0,sl_next=SLOTB;
  #define ROT() do{sl_prev=sl_cur;sl_cur=sl_next;sl_next=(sl_next==(NSLOT-1)*SLOTB)?0:sl_next+SLOTB;}while(0)
  DMA_K(2,2*SLOTB);
  WAIT_BAR(3);
  qkt(pA0,pA1,Kbase,qr,negm,r32,hi);asm volatile("s_nop 15\n\ts_nop 7":"+v"(pA0),"+v"(pA1));
  { const float NEGI=-INFINITY; _Pragma("unroll") for(int r=8;r<16;++r)pA0[r]=NEGI; _Pragma("unroll") for(int r=0;r<16;++r)pA1[r]=NEGI; }
  START(pA0,pA1);
  _Pragma("unroll") for(int r=0;r<16;++r)pA1[r]=__builtin_amdgcn_exp2f(pA1[r]);
  WAIT_BAR(0);
  DMA_K(3,0);DMA_V(1,SLOTB);
  ROT();
  kload8(kf,kp0+sl_cur);
  WAIT_BAR(2);
  s16x4 vlo[8],vhi[8]; u32x4 pw0,pw1,pw2,pw3;
  #define PKW(P,B) cvtpk_s(P[B],P[B+1])
  #define PAF(k) __builtin_bit_cast(bf16x8,pw##k)
  #define VFR(i) (bf16x8){vlo[i][0],vlo[i][1],vlo[i][2],vlo[i][3],vhi[i][0],vhi[i][1],vhi[i][2],vhi[i][3]}
  #define PIN(x) asm volatile("":"+v"(x))
  #define MX3(a,b,c) __builtin_fmaxf(__builtin_fmaxf((a),(b)),(c))
  #define GAPA(MF,A0,A1,A2,A3,W0,W1,PW) do{ MF; sacc+=A0; sacc+=A1; sacc+=A2; sacc+=A3; PIN(sacc); W0; W1; PIN(PW); SBAR(); }while(0)
  #define EX(v) __builtin_amdgcn_exp2f(v)
  #define GAPB(MF,X,B) do{ MF; X[B]=EX(X[B]); X[B+1]=EX(X[B+1]); X[B+2]=EX(X[B+2]); X[B+3]=EX(X[B+3]); PIN(X); SBAR(); }while(0)
  #define VRD(i) do{ vlo[i]=vtr(vp_+(((i)>>2)*4096+((i)&3)*1024)); vhi[i]=vtr(vp_+(((i)>>2)*4096+((i)&3)*1024+512)); }while(0)
  #define KRD(G,j) do{ if(G){ kload2(kf,kp0+sl_next,j); SBAR(); } }while(0)
  #define STEP(C0,C1,P0,P1,t,GK,GV,GL) do{ SBAR(); \
    const lds_cptr vp_=vp0+sl_prev; \
    VRD(0); SBAR(); float sacc=(P0[0]+P0[1]); \
    GAPA(C0=__builtin_amdgcn_mfma_f32_32x32x16_bf16(kf[0],qr[0],negm,0,0,0), P0[2],P0[3],P0[4],P0[5],     pw0[0]=PKW(P0,0), pw0[1]=PKW(P0,2), pw0); \
    VRD(4); SBAR(); GAPA(C1=__builtin_amdgcn_mfma_f32_32x32x16_bf16(kf[1],qr[0],negm,0,0,0), P0[6],P0[7],P0[8],P0[9],     pw0[2]=PKW(P0,4), pw0[3]=PKW(P0,6), pw0); \
    VRD(1); SBAR(); GAPA(C0=__builtin_amdgcn_mfma_f32_32x32x16_bf16(kf[2],qr[1],C0,0,0,0),   P0[10],P0[11],P0[12],P0[13], pw1[0]=PKW(P0,8), pw1[1]=PKW(P0,10), pw1); \
    VRD(5); SBAR(); GAPA(C1=__builtin_amdgcn_mfma_f32_32x32x16_bf16(kf[3],qr[1],C1,0,0,0),   P0[14],P0[15],P1[0],P1[1],   pw1[2]=PKW(P0,12),pw1[3]=PKW(P0,14), pw1); \
    VRD(2); SBAR(); GAPA(C0=__builtin_amdgcn_mfma_f32_32x32x16_bf16(kf[4],qr[2],C0,0,0,0),   P1[2],P1[3],P1[4],P1[5],     pw2[0]=PKW(P1,0), pw2[1]=PKW(P1,2), pw2); \
    VRD(6); SBAR(); GAPA(C1=__builtin_amdgcn_mfma_f32_32x32x16_bf16(kf[5],qr[2],C1,0,0,0),   P1[6],P1[7],P1[8],P1[9],     pw2[2]=PKW(P1,4), pw2[3]=PKW(P1,6), pw2); \
    VRD(3); SBAR(); GAPA(C0=__builtin_amdgcn_mfma_f32_32x32x16_bf16(kf[6],qr[3],C0,0,0,0),   P1[10],P1[11],P1[12],P1[13], pw3[0]=PKW(P1,8), pw3[1]=PKW(P1,10), pw3); \
    VRD(7); SBAR(); GAPA(C1=__builtin_amdgcn_mfma_f32_32x32x16_bf16(kf[7],qr[3],C1,0,0,0),   P1[14],P1[15],0.f,0.f,       pw3[2]=PKW(P1,12),pw3[3]=PKW(P1,14), pw3); \
    l_reg+=sacc; \
    if(GK){DMA_K((t)+3,sl_cur);} if(GV){DMA_V((t)+1,sl_next);} \
    CMASK(C0,C1,t); \
    { float a=MX3(C0[0],C0[1],C1[0]),b=MX3(C0[2],C0[3],C1[1]); a=MX3(a,C1[2],C1[3]); \
      _Pragma("unroll") for(int r=4;r<16;r+=4){a=MX3(a,C0[r],C0[r+1]);b=MX3(b,C0[r+2],C0[r+3]);a=MX3(a,C1[r],C1[r+1]);b=MX3(b,C1[r+2],C1[r+3]);} \
      float rm=__builtin_fmaxf(a,b); { auto rr=__builtin_amdgcn_permlane32_swap(__float_as_uint(rm),__float_as_uint(rm),false,false); rm=__builtin_fmaxf(__uint_as_float(rr[0]),__uint_as_float(rr[1])); } \
      resc=false; \
      if(__builtin_expect(__any(rm>(float)THRL),0)){ const float dl=__builtin_fmaxf(rm,0.f); mhat+=dl; \
        _Pragma("unroll") for(int r=0;r<16;++r){C0[r]-=dl;C1[r]-=dl;} \
        _Pragma("unroll") for(int r=0;r<16;++r)negm[r]=-mhat; asm volatile("":"+v"(negm)); \
        const float f=__builtin_amdgcn_exp2f(-dl); l_reg*=f; if(hi==0)wsf[r32]=f; resc=true; } } \
    SBAR(); \
    GAPB(o[0]=__builtin_amdgcn_mfma_f32_32x32x16_bf16(PAF(0),VFR(0),o[0],0,0,0), C0,0); \
    GAPB(o[1]=__builtin_amdgcn_mfma_f32_32x32x16_bf16(PAF(0),VFR(4),o[1],0,0,0), C0,4); \
    KRD(GL,0); GAPB(o[0]=__builtin_amdgcn_mfma_f32_32x32x16_bf16(PAF(1),VFR(1),o[0],0,0,0), C0,8); \
    KRD(GL,1); GAPB(o[1]=__builtin_amdgcn_mfma_f32_32x32x16_bf16(PAF(1),VFR(5),o[1],0,0,0), C0,12); \
    KRD(GL,2); GAPB(o[0]=__builtin_amdgcn_mfma_f32_32x32x16_bf16(PAF(2),VFR(2),o[0],0,0,0), C1,0); \
    KRD(GL,3); GAPB(o[1]=__builtin_amdgcn_mfma_f32_32x32x16_bf16(PAF(2),VFR(6),o[1],0,0,0), C1,4); \
    GAPB(o[0]=__builtin_amdgcn_mfma_f32_32x32x16_bf16(PAF(3),VFR(3),o[0],0,0,0), C1,8); \
    GAPB(o[1]=__builtin_amdgcn_mfma_f32_32x32x16_bf16(PAF(3),VFR(7),o[1],0,0,0), C1,12); \
    }while(0)
  int t=1;
  #undef CMASK
  #define CMASK(P0,P1,t) do{}while(0)
  for(;t+5<NT;t+=2){
    STEP(pB0,pB1,pA0,pA1,t,true,true,true);     WAIT_BAR(2); RESC(); ROT();
    STEP(pA0,pA1,pB0,pB1,t+1,true,true,true);   WAIT_BAR(2); RESC(); ROT();
  }
  #undef CMASK
  #define CMASK(P0,P1,t) do{int jb_=(t)-(NT-4); if(jb_>=0)cmask(P0,P1,jb_,qrel,hi);}while(0)
  #define ENDW(tt) do{ if((tt)+3<NT){WAIT_BAR(2);} else if((tt)+2<NT){WAIT_BAR(1);} else {WAIT_BAR(0);} }while(0)
  for(;t+1<NT;t+=2){
    STEP(pB0,pB1,pA0,pA1,t,(t+3<NT),(t+1<NT),(t+1<NT));       ENDW(t);   RESC(); ROT();
    STEP(pA0,pA1,pB0,pB1,t+1,(t+4<NT),(t+2<NT),(t+2<NT));     ENDW(t+1); RESC(); ROT();
  }
  { float sacc=pA0[0]+pA0[1]; _Pragma("unroll") for(int r=2;r<16;++r)sacc+=pA0[r]; _Pragma("unroll") for(int r=0;r<16;++r)sacc+=pA1[r]; l_reg+=sacc;
    pw0=(u32x4){PKW(pA0,0),PKW(pA0,2),PKW(pA0,4),PKW(pA0,6)};pw1=(u32x4){PKW(pA0,8),PKW(pA0,10),PKW(pA0,12),PKW(pA0,14)};pw2=(u32x4){PKW(pA1,0),PKW(pA1,2),PKW(pA1,4),PKW(pA1,6)};pw3=(u32x4){PKW(pA1,8),PKW(pA1,10),PKW(pA1,12),PKW(pA1,14)};
    SBAR(); pv(o,vb0+sl_prev,PAF(0),PAF(1),PAF(2),PAF(3)); }
  #undef PKW
  #undef PAF
  #undef VFR
  #undef PIN
  #undef MX3
  #undef GAPA
  #undef GAPB
  #undef EX
  #undef VRD
  #undef KRD
  #undef STEP
  #undef ENDW
  {auto rr=__builtin_amdgcn_permlane32_swap(__float_as_uint(l_reg),__float_as_uint(l_reg),false,false);l_reg=__uint_as_float(rr[0])+__uint_as_float(rr[1]);}
  if(hi==0)wsf[32+r32]=l_reg;asm volatile("s_waitcnt lgkmcnt(0)":::"memory");
  float rli[16];
  #pragma unroll
  for(int r=0;r<16;++r)rli[r]=__builtin_amdgcn_rcpf(wsf[32+crow(r,hi)]);
  bf16*Ow=Ou+(long)(wid*QBLK)*PO;
  { bf16*stg=(bf16*)(shm+LDS_OST)+wid*2048;
    #pragma unroll
    for(int r=0;r<16;++r){const int orow=crow(r,hi);
      #pragma unroll
      for(int d0=0;d0<2;++d0)stg[orow*64+d0*32+r32]=__float2bfloat16(o[d0][r]*rli[r]);}
    asm volatile("s_waitcnt lgkmcnt(0)":::"memory");
    #pragma unroll
    for(int i=0;i<4;++i){const int row=i*8+(lane>>3),ch=lane&7; const u32x4 v=*(const u32x4*)(stg+row*64+ch*8); ATTN_STORE16(Ow+(long)row*PO+ch*8,v);} }
  asm volatile("s_waitcnt lgkmcnt(0)\n\ts_barrier":::"memory");
  #undef DMA_K
  #undef DMA_V
  #undef CMASK
  #undef START
  #undef RESC
  #undef ROT
}
constexpr int ATTN_LDS_BYTES=LDS_BYTES;
#undef SBAR
#undef WAIT_BAR
typedef float f32x4v __attribute__((ext_vector_type(4)));
constexpr int V2_SLOTV=16384, V2_LDS_K=0, V2_LDS_V=NSLOT*SLOTB, V2_LDS_WS=V2_LDS_V+NSLOT*V2_SLOTV, V2_LDS_OST=V2_LDS_WS+NW*64*4, V2_LDS_BYTES=V2_LDS_OST+NW*8192;
#define SBAR() __builtin_amdgcn_sched_barrier(0)
#define WAIT_BAR(N) asm volatile("s_waitcnt vmcnt(" #N ") lgkmcnt(0)\n\ts_barrier":::"memory")
__device__ __forceinline__ void pv4(f32x16*o,int vb,bf16x8 pa0,bf16x8 pa1,bf16x8 pa2,bf16x8 pa3){
  #pragma unroll
  for(int d0=0;d0<4;++d0){s16x4 lo[4],hi[4];
    #pragma unroll
    for(int ks=0;ks<4;++ks){
      asm volatile("ds_read_b64_tr_b16 %0,%1 offset:%c2":"=&v"(lo[ks]):"v"(vb),"i"(d0*4096+ks*1024):"memory");
      asm volatile("ds_read_b64_tr_b16 %0,%1 offset:%c2":"=&v"(hi[ks]):"v"(vb),"i"(d0*4096+ks*1024+512):"memory");}
    asm volatile("s_waitcnt lgkmcnt(0)":::"memory");SBAR();
    #define PK(k) (bf16x8){lo[k][0],lo[k][1],lo[k][2],lo[k][3],hi[k][0],hi[k][1],hi[k][2],hi[k][3]}
    o[d0]=__builtin_amdgcn_mfma_f32_32x32x16_bf16(pa0,PK(0),o[d0],0,0,0);
    o[d0]=__builtin_amdgcn_mfma_f32_32x32x16_bf16(pa1,PK(1),o[d0],0,0,0);
    o[d0]=__builtin_amdgcn_mfma_f32_32x32x16_bf16(pa2,PK(2),o[d0],0,0,0);
    o[d0]=__builtin_amdgcn_mfma_f32_32x32x16_bf16(pa3,PK(3),o[d0],0,0,0);
    #undef PK
  }
}
template<int MODE> __device__ __forceinline__ void attn_unit128(int q0,const bf16*Qu,const bf16*__restrict__ Kh,const bf16*__restrict__ Vh,bf16*Ou,char*shm,float lam,float oscale,const float*subg){
  int tid_=threadIdx.x; asm volatile("":"+v"(tid_)); const int tid=tid_,lane=tid&63,r32=lane&31,hi=lane>>5; const int wid=__builtin_amdgcn_readfirstlane(tid>>6);
  const bf16*Qw=Qu+(long)(wid*QBLK)*PQ;
  const unsigned lds0=(unsigned)(uintptr_t)shm;
  float*wsf=(float*)(shm+V2_LDS_WS)+wid*64;
  const bf16*ksrc=Kh+(long)lane*PQ+wid*8;
  const bf16*vsrc=Vh+(long)(16*(wid&3)+(lane>>2))*PQ+(wid>>2)*32+(lane&3)*8;
  const unsigned kdst=lds0+V2_LDS_K+wid*1024, vdst=lds0+V2_LDS_V+wid*1024;
  #define DMA_K(t,slot) glds16(ksrc+(long)(t)*KVBLK*PQ,(unsigned)__builtin_amdgcn_readfirstlane(kdst+(slot)))
  #define DMA_V(t,slot) do{ glds16(vsrc+(long)(t)*KVBLK*PQ,(unsigned)__builtin_amdgcn_readfirstlane(vdst+2*(slot))); glds16(vsrc+(long)(t)*KVBLK*PQ+64,(unsigned)__builtin_amdgcn_readfirstlane(vdst+2*(slot)+8192)); }while(0)
  const int vb0=(int)(lds0+V2_LDS_V)+((lane>>4)&1)*32+(lane&3)*8+(4*hi+((lane&15)>>2))*64;
  const char*Kbase=shm+V2_LDS_K; bf16x8 kf[8];
  const lds_cptr shm3=(lds_cptr)shm; const lds_cptr kp0=shm3+V2_LDS_K+hi*1024+r32*16; const lds_cptr vp0=shm3+V2_LDS_V+((lane>>4)&1)*32+(lane&3)*8+(4*hi+((lane&15)>>2))*64;
  const int NT=(q0+QB)/KVBLK+1;
  DMA_K(0,0);DMA_V(0,0);DMA_K(1,SLOTB);
  bf16x8 qr[4];
  #pragma unroll
  for(int d0=0;d0<4;++d0)qr[d0]=*reinterpret_cast<const bf16x8*>(&Qw[(long)r32*PQ+d0*16+hi*8]);
  float l_reg=0.f;f32x16 o[4];o[0]=f32x16{};o[1]=f32x16{};o[2]=f32x16{};o[3]=f32x16{};
  const f32x16 zero16=f32x16{};
  const int qrel=wid*QBLK+r32;
  #define CMASK(P0,P1,t) do{int jb_=(t)-(NT-4); if(jb_>=0)cmask(P0,P1,jb_,qrel,hi);}while(0)
  f32x16 pA0,pA1,pB0,pB1;
  int sl_prev=0,sl_cur=0,sl_next=SLOTB;
  #define ROT() do{sl_prev=sl_cur;sl_cur=sl_next;sl_next=(sl_next==(NSLOT-1)*SLOTB)?0:sl_next+SLOTB;}while(0)
  DMA_K(2,2*SLOTB);
  WAIT_BAR(3);
  qkt(pA0,pA1,Kbase,qr,zero16,r32,hi);asm volatile("s_nop 15\n\ts_nop 7":"+v"(pA0),"+v"(pA1));
  { const float NEGI=-INFINITY; _Pragma("unroll") for(int r=8;r<16;++r)pA0[r]=NEGI; _Pragma("unroll") for(int r=0;r<16;++r)pA1[r]=NEGI; }
  _Pragma("unroll") for(int r=0;r<16;++r){pA0[r]=__builtin_amdgcn_exp2f(pA0[r]);pA1[r]=__builtin_amdgcn_exp2f(pA1[r]);}
  WAIT_BAR(0);
  DMA_K(3,0);DMA_V(1,SLOTB);
  ROT();
  kload8(kf,kp0+sl_cur);
  WAIT_BAR(3);
  s16x4 vlo[8],vhi[8]; u32x4 pw0,pw1,pw2,pw3;
  #define PKW(P,B) cvtpk_s(P[B],P[B+1])
  #define PAF(k) __builtin_bit_cast(bf16x8,pw##k)
  #define VFR(i) (bf16x8){vlo[i][0],vlo[i][1],vlo[i][2],vlo[i][3],vhi[i][0],vhi[i][1],vhi[i][2],vhi[i][3]}
  #define PIN(x) asm volatile("":"+v"(x))
  #define GAPA(MF,A0,A1,A2,A3,W0,W1,PW) do{ MF; sacc+=A0; sacc+=A1; sacc+=A2; sacc+=A3; PIN(sacc); W0; W1; PIN(PW); SBAR(); }while(0)
  #define EX(v) __builtin_amdgcn_exp2f(v)
  #define GAPB(MF,X,B) do{ MF; X[B]=EX(X[B]); X[B+1]=EX(X[B+1]); PIN(X); SBAR(); }while(0)
  #define VRD(i) do{ vlo[i]=vtr(vp_+(((i)>>2)*4096+((i)&3)*1024)); vhi[i]=vtr(vp_+(((i)>>2)*4096+((i)&3)*1024+512)); }while(0)
  #define VRD2(i) do{ vlo[i]=vtr(vp_+(8192+((i)>>2)*4096+((i)&3)*1024)); vhi[i]=vtr(vp_+(8192+((i)>>2)*4096+((i)&3)*1024+512)); SBAR(); }while(0)
  #define KRD(G,j) do{ if(G){ kload2(kf,kp0+sl_next,j); SBAR(); } }while(0)
  #define MF32(a,b,c) __builtin_amdgcn_mfma_f32_32x32x16_bf16(a,b,c,0,0,0)
  #define STEP(C0,C1,P0,P1,t,GK,GV,GL) do{ SBAR(); \
    const lds_cptr vp_=vp0+2*sl_prev; \
    VRD(0); SBAR(); float sacc=(P0[0]+P0[1]); \
    GAPA(C0=MF32(kf[0],qr[0],zero16), P0[2],P0[3],P0[4],P0[5],     pw0[0]=PKW(P0,0), pw0[1]=PKW(P0,2), pw0); \
    VRD(4); SBAR(); GAPA(C1=MF32(kf[1],qr[0],zero16), P0[6],P0[7],P0[8],P0[9],     pw0[2]=PKW(P0,4), pw0[3]=PKW(P0,6), pw0); \
    VRD(1); SBAR(); GAPA(C0=MF32(kf[2],qr[1],C0),   P0[10],P0[11],P0[12],P0[13], pw1[0]=PKW(P0,8), pw1[1]=PKW(P0,10), pw1); \
    VRD(5); SBAR(); GAPA(C1=MF32(kf[3],qr[1],C1),   P0[14],P0[15],P1[0],P1[1],   pw1[2]=PKW(P0,12),pw1[3]=PKW(P0,14), pw1); \
    VRD(2); SBAR(); GAPA(C0=MF32(kf[4],qr[2],C0),   P1[2],P1[3],P1[4],P1[5],     pw2[0]=PKW(P1,0), pw2[1]=PKW(P1,2), pw2); \
    VRD(6); SBAR(); GAPA(C1=MF32(kf[5],qr[2],C1),   P1[6],P1[7],P1[8],P1[9],     pw2[2]=PKW(P1,4), pw2[3]=PKW(P1,6), pw2); \
    VRD(3); SBAR(); GAPA(C0=MF32(kf[6],qr[3],C0),   P1[10],P1[11],P1[12],P1[13], pw3[0]=PKW(P1,8), pw3[1]=PKW(P1,10), pw3); \
    VRD(7); SBAR(); GAPA(C1=MF32(kf[7],qr[3],C1),   P1[14],P1[15],0.f,0.f,       pw3[2]=PKW(P1,12),pw3[3]=PKW(P1,14), pw3); \
    l_reg+=sacc; \
    if(GK){DMA_K((t)+3,sl_cur);} if(GV){DMA_V((t)+1,sl_next);} \
    CMASK(C0,C1,t); \
    SBAR(); \
    GAPB(o[0]=MF32(PAF(0),VFR(0),o[0]), C0,0);  VRD2(0); \
    GAPB(o[1]=MF32(PAF(0),VFR(4),o[1]), C0,2);  VRD2(4); \
    KRD(GL,0); GAPB(o[0]=MF32(PAF(1),VFR(1),o[0]), C0,4);  VRD2(1); \
    KRD(GL,1); GAPB(o[1]=MF32(PAF(1),VFR(5),o[1]), C0,6);  VRD2(5); \
    KRD(GL,2); GAPB(o[0]=MF32(PAF(2),VFR(2),o[0]), C0,8);  VRD2(2); \
    KRD(GL,3); GAPB(o[1]=MF32(PAF(2),VFR(6),o[1]), C0,10); VRD2(6); \
    GAPB(o[0]=MF32(PAF(3),VFR(3),o[0]), C0,12); VRD2(3); \
    GAPB(o[1]=MF32(PAF(3),VFR(7),o[1]), C0,14); VRD2(7); \
    GAPB(o[2]=MF32(PAF(0),VFR(0),o[2]), C1,0); \
    GAPB(o[3]=MF32(PAF(0),VFR(4),o[3]), C1,2); \
    GAPB(o[2]=MF32(PAF(1),VFR(1),o[2]), C1,4); \
    GAPB(o[3]=MF32(PAF(1),VFR(5),o[3]), C1,6); \
    GAPB(o[2]=MF32(PAF(2),VFR(2),o[2]), C1,8); \
    GAPB(o[3]=MF32(PAF(2),VFR(6),o[3]), C1,10); \
    GAPB(o[2]=MF32(PAF(3),VFR(3),o[2]), C1,12); \
    GAPB(o[3]=MF32(PAF(3),VFR(7),o[3]), C1,14); \
    }while(0)
  int t=1;
  #undef CMASK
  #define CMASK(P0,P1,t) do{}while(0)
  for(;t+5<NT;t+=2){
    STEP(pB0,pB1,pA0,pA1,t,true,true,true);     WAIT_BAR(3); ROT();
    STEP(pA0,pA1,pB0,pB1,t+1,true,true,true);   WAIT_BAR(3); ROT();
  }
  #undef CMASK
  #define CMASK(P0,P1,t) do{int jb_=(t)-(NT-4); if(jb_>=0)cmask(P0,P1,jb_,qrel,hi);}while(0)
  #define ENDW(tt) do{ if((tt)+3<NT){WAIT_BAR(3);} else if((tt)+2<NT){WAIT_BAR(2);} else {WAIT_BAR(0);} }while(0)
  for(;t+1<NT;t+=2){
    STEP(pB0,pB1,pA0,pA1,t,(t+3<NT),(t+1<NT),(t+1<NT));       ENDW(t);   ROT();
    STEP(pA0,pA1,pB0,pB1,t+1,(t+4<NT),(t+2<NT),(t+2<NT));     ENDW(t+1); ROT();
  }
  { float sacc=pA0[0]+pA0[1]; _Pragma("unroll") for(int r=2;r<16;++r)sacc+=pA0[r]; _Pragma("unroll") for(int r=0;r<16;++r)sacc+=pA1[r]; l_reg+=sacc;
    pw0=(u32x4){PKW(pA0,0),PKW(pA0,2),PKW(pA0,4),PKW(pA0,6)};pw1=(u32x4){PKW(pA0,8),PKW(pA0,10),PKW(pA0,12),PKW(pA0,14)};pw2=(u32x4){PKW(pA1,0),PKW(pA1,2),PKW(pA1,4),PKW(pA1,6)};pw3=(u32x4){PKW(pA1,8),PKW(pA1,10),PKW(pA1,12),PKW(pA1,14)};
    SBAR(); pv4(o,vb0+2*sl_prev,PAF(0),PAF(1),PAF(2),PAF(3)); }
  #undef PKW
  #undef PAF
  #undef VFR
  #undef PIN
  #undef GAPA
  #undef GAPB
  #undef EX
  #undef VRD
  #undef VRD2
  #undef KRD
  #undef MF32
  #undef STEP
  #undef ENDW
  {auto rr=__builtin_amdgcn_permlane32_swap(__float_as_uint(l_reg),__float_as_uint(l_reg),false,false);l_reg=__uint_as_float(rr[0])+__uint_as_float(rr[1]);}
  if(hi==0)wsf[32+r32]=l_reg;asm volatile("s_waitcnt lgkmcnt(0)":::"memory");
  float rli[16];
  #pragma unroll
  for(int r=0;r<16;++r)rli[r]=__builtin_amdgcn_rcpf(wsf[32+crow(r,hi)]);
  { bf16*park=(bf16*)(shm+V2_LDS_OST)+wid*4096;
    if(MODE==0){
      #pragma unroll
      for(int r=0;r<16;++r){const int orow=crow(r,hi);
        #pragma unroll
        for(int d0=0;d0<4;++d0)park[orow*128+d0*32+r32]=__float2bfloat16(o[d0][r]*rli[r]);}
      asm volatile("s_waitcnt lgkmcnt(0)":::"memory");
    } else {
      #pragma unroll
      for(int r=0;r<16;++r){const int orow=crow(r,hi);
        #pragma unroll
        for(int d0=0;d0<4;++d0){const float o1=__bfloat162float(park[orow*128+d0*32+r32]); park[orow*128+d0*32+r32]=__float2bfloat16(o1-lam*(o[d0][r]*rli[r]));}}
      asm volatile("s_waitcnt lgkmcnt(0)":::"memory");
      bf16*Ow=Ou+(long)(wid*QBLK)*PO;
      const int ch=lane&15; const f32x4v g0=*(const f32x4v*)(subg+8*ch), g1=*(const f32x4v*)(subg+8*ch+4);
      #pragma unroll
      for(int i=0;i<8;++i){const int row=i*4+(lane>>4); const u32x4 v=*(const u32x4*)(park+row*128+ch*8);
        float d[8]; d[0]=__uint_as_float(v.x<<16);d[1]=__uint_as_float(v.x&0xffff0000u);d[2]=__uint_as_float(v.y<<16);d[3]=__uint_as_float(v.y&0xffff0000u);d[4]=__uint_as_float(v.z<<16);d[5]=__uint_as_float(v.z&0xffff0000u);d[6]=__uint_as_float(v.w<<16);d[7]=__uint_as_float(v.w&0xffff0000u);
        float ss=(d[0]*d[0]+d[1]*d[1])+(d[2]*d[2]+d[3]*d[3])+(d[4]*d[4]+d[5]*d[5])+(d[6]*d[6]+d[7]*d[7]);
        ss+=__shfl_xor(ss,1);ss+=__shfl_xor(ss,2);ss+=__shfl_xor(ss,4);ss+=__shfl_xor(ss,8);
        const float rs=__builtin_amdgcn_rsqf(ss*(1.0f/128.0f)+1e-6f)*oscale;
        u32x4 w; w.x=cvtpk_s(d[0]*rs*g0[0],d[1]*rs*g0[1]); w.y=cvtpk_s(d[2]*rs*g0[2],d[3]*rs*g0[3]); w.z=cvtpk_s(d[4]*rs*g1[0],d[5]*rs*g1[1]); w.w=cvtpk_s(d[6]*rs*g1[2],d[7]*rs*g1[3]);
        ATTN_STORE16(Ow+(long)row*PO+ch*8,w);}
      asm volatile("s_waitcnt lgkmcnt(0)":::"memory");
    } }
  asm volatile("s_waitcnt lgkmcnt(0)\n\ts_barrier":::"memory");
  #undef DMA_K
  #undef DMA_V
  #undef CMASK
  #undef ROT
}
#undef SBAR
#undef WAIT_BAR

}
namespace cg = cooperative_groups;
constexpr int NWAVES = 8;
constexpr int NB = 4, SEQ = 8192, DM = 1024, NMETA = 16, DIN = 2560, DFF = 4096, DCONV = 512, CONVW = 31;
constexpr int MX = NB * SEQ;
constexpr int MP = MX + 256;
constexpr int SPAD = pg8::SPAD;
constexpr float EPS = 1e-6f;
constexpr size_t MiB = 1u << 20;
constexpr size_t WS_CTL = 0, WS_WIN = 1 * MiB, WS_WOUT = 6 * MiB, WS_WUP = 8 * MiB, WS_WDN = 16 * MiB, WS_ROPE = 24 * MiB, WS_SSQ = 25 * MiB, WS_RN = 27 * MiB,
                 WS_H1B = 28 * MiB, WS_MIX = 92 * MiB, WS_HB = 156 * MiB, WS_XN = 156 * MiB, WS_O = 156 * MiB, WS_Q = 222 * MiB, WS_K = 254 * MiB, WS_V = 287 * MiB, WS_G = 320 * MiB,
                 WS_END = 412 * MiB;
static_assert(WS_XN + (size_t)MP * DM * 2 <= WS_Q && WS_K + (size_t)NB * SPAD * 512 * 2 <= WS_V && WS_G + (size_t)NB * SPAD * 512 * 2 <= WS_HB + (size_t)MX * DFF * 2 && WS_HB + (size_t)MX * DFF * 2 <= WS_END, "d_ws map");
constexpr int RING_BYTES = 131072, LDS_BYTES = 147456;
#ifndef WGM_P1
#define WGM_P1 4
#endif
#ifndef WGM_P4
#define WGM_P4 4
#endif
#ifndef WGM_P35
#define WGM_P35 4
#endif

#define LAS __attribute__((address_space(3)))
typedef unsigned short bf16;
typedef unsigned v4u __attribute__((ext_vector_type(4)));
typedef float f32x4 __attribute__((ext_vector_type(4)));
typedef float f32x2 __attribute__((ext_vector_type(2)));
#define LDS_WAIT() asm volatile("s_waitcnt lgkmcnt(0)" ::: "memory")
__device__ __forceinline__ unsigned pk2(float lo, float hi) { return pg8::cvt_pk_bf16(lo, hi); }
__device__ __forceinline__ float bf_lo(unsigned u) { return __uint_as_float(u << 16); }
__device__ __forceinline__ float bf_hi(unsigned u) { return __uint_as_float(u & 0xffff0000u); }
__device__ __forceinline__ float wave_sum(float v) {
#pragma unroll
    for (int o = 1; o < 64; o <<= 1) v += __shfl_xor(v, o);
    return v;
}

#define XB_TMO      128
#define XB_XCNT(j)  (256  + 64 * (j))
#define XB_XSUB(j)  (1280 + 64 * (j))
#define XB_XGEN(j)  (2304 + 64 * (j))
#define XB_TOP      3328
#define XB_TOPGEN   3392
#define XCD_BAR_WORDS 3456
#define XB_SPIN_CAP (1u << 18)

__device__ __forceinline__ unsigned xb_ld(unsigned* p)              { return __hip_atomic_load(p, __ATOMIC_RELAXED, __HIP_MEMORY_SCOPE_AGENT); }
__device__ __forceinline__ unsigned xb_add(unsigned* p, unsigned v) { return __hip_atomic_fetch_add(p, v, __ATOMIC_RELAXED, __HIP_MEMORY_SCOPE_AGENT); }
__device__ __forceinline__ unsigned xb_xcc_id() { return (unsigned)__builtin_amdgcn_s_getreg((3 << 11) | 20) & 0xFu; }
#define XB_SPIN(cond, bar) do { unsigned _sp = 0; while (cond) { __builtin_amdgcn_s_sleep(1); \
    if ((++_sp & 255u) == 0u) { if (xb_ld(&(bar)[XB_TMO])) break; if (_sp > XB_SPIN_CAP) { atomicAdd(&(bar)[XB_TMO], 1u); break; } } } } while (0)

struct XcdBarrier {
    unsigned* bar; unsigned x;
    volatile LAS unsigned* st;
};

__device__ __forceinline__ XcdBarrier xcd_barrier_post(unsigned* bar, volatile LAS unsigned* st) {
    XcdBarrier b; b.bar = bar; b.x = xb_xcc_id(); b.st = st;
    if (threadIdx.x == 0) (void)xb_add(&bar[XB_XCNT(b.x)], 1u);
    return b;
}
__device__ __forceinline__ void xcd_barrier_complete(unsigned* bar, unsigned x, unsigned& nloc, unsigned& nx) {
    const unsigned G = gridDim.x * gridDim.y * gridDim.z;
    unsigned sum, cnt, mine, sp = 0u;
    for (;;) {
        sum = 0u; cnt = 0u; mine = 0u;
#pragma unroll
        for (unsigned j = 0; j < 16; ++j) { const unsigned c = xb_ld(&bar[XB_XCNT(j)]); sum += c; cnt += (c > 0u) ? 1u : 0u; mine = (j == x) ? c : mine; }
        if (sum == G) break;
        __builtin_amdgcn_s_sleep(1);
        if ((++sp & 255u) == 0u) { if (xb_ld(&bar[XB_TMO])) break; if (sp > XB_SPIN_CAP) { atomicAdd(&bar[XB_TMO], 1u); break; } }
    }
    nloc = mine > 0u ? mine : 1u; nx = cnt > 0u ? cnt : 1u;
}

__device__ __forceinline__ void xcd_barrier(const XcdBarrier& b) {
    asm volatile("s_waitcnt vmcnt(0)" ::: "memory");
    __syncthreads();
    if (threadIdx.x == 0) {
        unsigned* bar = b.bar;
        __builtin_amdgcn_s_waitcnt(0);
        unsigned nloc = b.st[0], nx = b.st[1];
        if (nloc == 0u) { xcd_barrier_complete(bar, b.x, nloc, nx); b.st[0] = nloc; b.st[1] = nx; }
        const unsigned old = xb_add(&bar[XB_XSUB(b.x)], 1u);
        const unsigned gen = old / nloc;
        if (old + 1u == (gen + 1u) * nloc) {
            __builtin_amdgcn_fence(__ATOMIC_RELEASE, "agent");
            asm volatile("s_waitcnt vmcnt(0)" ::: "memory");
            const unsigned og = xb_add(&bar[XB_TOP], 1u);
            const unsigned tg = og / nx;
            if (og + 1u == (tg + 1u) * nx) xb_add(&bar[XB_TOPGEN], 1u);
            else XB_SPIN(xb_ld(&bar[XB_TOPGEN]) == tg, bar);
            __builtin_amdgcn_fence(__ATOMIC_ACQUIRE, "agent");
            xb_add(&bar[XB_XGEN(b.x)], 1u);
            asm volatile("s_waitcnt vmcnt(0)" ::: "memory");
        } else {
            XB_SPIN(xb_ld(&bar[XB_XGEN(b.x)]) == gen, bar);
            __builtin_amdgcn_fence(__ATOMIC_ACQUIRE, "agent");
            asm volatile("s_waitcnt vmcnt(0)" ::: "memory");
        }
    }
    __syncthreads();
}

__device__ __forceinline__ float dpp_add(float v, const int ctrl_sel) {
    int t;
    if (ctrl_sel == 0) t = __builtin_amdgcn_update_dpp(0, __float_as_int(v), 0xB1, 0xF, 0xF, true);
    else if (ctrl_sel == 1) t = __builtin_amdgcn_update_dpp(0, __float_as_int(v), 0x4E, 0xF, 0xF, true);
    else if (ctrl_sel == 2) t = __builtin_amdgcn_update_dpp(0, __float_as_int(v), 0x141, 0xF, 0xF, true);
    else t = __builtin_amdgcn_update_dpp(0, __float_as_int(v), 0x140, 0xF, 0xF, true);
    return v + __int_as_float(t);
}
__device__ __forceinline__ float wave_sum_fast(float v) {
    v = dpp_add(v, 0); v = dpp_add(v, 1); v = dpp_add(v, 2); v = dpp_add(v, 3);
    { auto rr = __builtin_amdgcn_permlane16_swap(__float_as_uint(v), __float_as_uint(v), false, false); v = __uint_as_float(rr[0]) + __uint_as_float(rr[1]); }
    { auto rr = __builtin_amdgcn_permlane32_swap(__float_as_uint(v), __float_as_uint(v), false, false); v = __uint_as_float(rr[0]) + __uint_as_float(rr[1]); }
    return v;
}

struct Args { const float* in[19]; float* out; unsigned char* ws; float inv_freq[8]; };
enum { I_X = 0, I_META, I_G1, I_WIN, I_QG, I_KG, I_LQ1, I_LK1, I_LQ2, I_LK2, I_SUBLN, I_CW, I_CB, I_CLG, I_CLB, I_WOUT, I_G2, I_WUP, I_WDN };

__device__ __forceinline__ void p0_transpose_item(const float* W, int K, int N, bf16* WT, int out_row0, int n0, int k0, const float* kscale, LAS float* scr, int lane) {
    float tv[32], ts[32];
#pragma unroll
    for (int i = 0; i < 32; ++i) { const int kk = 2 * i + (lane >> 5); tv[i] = W[(size_t)(k0 + kk) * N + n0 + (lane & 31)]; ts[i] = kscale ? kscale[k0 + kk] : 1.0f; }
#pragma unroll
    for (int i = 0; i < 32; ++i) { const int kk = 2 * i + (lane >> 5); scr[kk * 33 + (lane & 31)] = tv[i] * ts[i]; }
    LDS_WAIT(); asm volatile("" ::: "memory");
    const int c = lane & 7;
#pragma unroll
    for (int j = 0; j < 4; ++j) { const int n = (lane >> 3) + 8 * j; const LAS float* s = scr + (8 * c) * 33 + n;
        v4u o; o.x = pk2(s[0 * 33], s[1 * 33]); o.y = pk2(s[2 * 33], s[3 * 33]); o.z = pk2(s[4 * 33], s[5 * 33]); o.w = pk2(s[6 * 33], s[7 * 33]);
        *(v4u*)(WT + (size_t)(out_row0 + n) * K + k0 + 8 * c) = o; }
    LDS_WAIT(); asm volatile("" ::: "memory");
}
__device__ __forceinline__ int win_pcol(int lc) {
    if (lc < 1024) { const int l = lc & 255; return (lc & ~255) + 128 * ((l >> 5) & 1) + 32 * (l >> 6) + (l & 31); }
    if (lc < 1536) return lc;
    if (lc < 2048) { const int ch = lc - 1536; return 1536 + 256 * (ch >> 7) + (ch & 127); }
    const int ch = lc - 2048; return 1536 + 256 * (ch >> 7) + 128 + (ch & 127);
}

__device__ __forceinline__ void p0_prologue(const Args& A, unsigned char* ws, LAS unsigned char* lds, int vcu, int G, int wave, int lane) {
    LAS float* scr = (LAS float*)(lds + wave * 16384);
    const int gw = vcu * NWAVES + wave, NGW = G * NWAVES;
    bf16* Win_t = (bf16*)(ws + WS_WIN); bf16* Wout_t = (bf16*)(ws + WS_WOUT); bf16* Wup_t = (bf16*)(ws + WS_WUP); bf16* Wdn_t = (bf16*)(ws + WS_WDN);
    constexpr int I_IN = (DM / 64) * (DIN / 32);
    for (int it = gw; it < I_IN; it += NGW) { const int nblk = DIN / 32, kb = it / nblk, nb = it % nblk; p0_transpose_item(A.in[I_WIN], DM, DIN, Win_t, win_pcol(32 * nb), 32 * nb, 64 * kb, nullptr, scr, lane); }
    {
        bf16* XN = (bf16*)(ws + WS_XN);
        f32x4 g[4];
#pragma unroll
        for (int j = 0; j < 4; ++j) g[j] = ((const f32x4*)A.in[I_G1])[lane + 64 * j];
        for (int m0 = gw; m0 < MX + NMETA; m0 += 4 * NGW) {
            f32x4 v[4][4];
#pragma unroll
            for (int q = 0; q < 4; ++q) { const int m = m0 + q * NGW; const bool ok = m < MX + NMETA;
                const float* src = !ok ? A.in[I_X] : (m < MX) ? A.in[I_X] + (size_t)m * DM : A.in[I_META] + (size_t)(m - MX) * DM;
                const f32x4* xr = (const f32x4*)src + lane;
#pragma unroll
                for (int j = 0; j < 4; ++j) v[q][j] = __builtin_nontemporal_load(xr + 64 * j); }
#pragma unroll
            for (int q = 0; q < 4; ++q) { const int m = m0 + q * NGW; if (m >= MX + NMETA) continue;
                float s = 0.f;
#pragma unroll
                for (int j = 0; j < 4; ++j) s += (v[q][j].x * v[q][j].x + v[q][j].y * v[q][j].y) + (v[q][j].z * v[q][j].z + v[q][j].w * v[q][j].w);
                const float ms = wave_sum_fast(s) * (1.f / DM) + EPS; const float rs = __builtin_amdgcn_rsqf(ms);
                if (lane == 0 && m < MX) ((float*)(ws + WS_RN))[m] = ms * rs;
                unsigned long long* o8 = (unsigned long long*)(XN + (size_t)m * DM) + lane;
#pragma unroll
                for (int j = 0; j < 4; ++j) { const f32x4 y = v[q][j] * rs * g[j]; o8[64 * j] = (unsigned long long)pk2(y.x, y.y) | ((unsigned long long)pk2(y.z, y.w) << 32); } }
        }
    }
    {
        float* rope = (float*)(ws + WS_ROPE);
        const int pos = gw * 64 + lane;
        if (pos < SEQ + NMETA) {
#pragma unroll
            for (int i = 0; i < 8; ++i) {
                const float angf = (float)pos * A.inv_freq[i];
                const double rev = (double)angf * 0.15915494309189533577; const double fr = rev - __builtin_rint(rev);
                const float f = (float)fr;
                rope[pos * 16 + i] = __builtin_amdgcn_cosf(f); rope[pos * 16 + 8 + i] = __builtin_amdgcn_sinf(f); } }
    }
    {
        bf16* KB = (bf16*)(ws + WS_K); bf16* VB = (bf16*)(ws + WS_V); bf16* GB = (bf16*)(ws + WS_G);
        for (int it = gw; it < NB * 48 * 3; it += NGW) { const int which = it / (NB * 48), r = it % (NB * 48), b = r / 48, rr = r % 48;
            bf16* p = which == 0 ? KB + (size_t)(b * SPAD + 16 + rr) * 512 : which == 1 ? VB + (size_t)(b * SPAD + 16 + rr) * 512 : GB + (size_t)(b * SPAD + rr) * 512;
            ((v4u*)p)[lane] = (v4u){0u, 0u, 0u, 0u}; }
    }
}

__device__ __forceinline__ void meta_proj(const Args& A, unsigned char* ws, LAS unsigned char* lds, int vcu, int wave, int lane) {
    typedef short bf16x8 __attribute__((ext_vector_type(8)));
    const int fr = lane & 15, fq = lane >> 4;
    const int item = vcu * 2 + (wave >> 2), kc = wave & 3;
    const int kind = item < 8 ? 0 : item < 16 ? 1 : 2, g = kind == 2 ? item - 16 : (item & 7);
    const bf16* XNm = (const bf16*)(ws + WS_XN) + (size_t)(MX + fr) * DM + 8 * fq + 256 * kc;
    const bf16* Wt = (const bf16*)(ws + WS_WIN);
    const bf16* brow[4];
#pragma unroll
    for (int nb = 0; nb < 4; ++nb) { const int lc = kind == 0 ? 512 + 64 * g + 16 * nb + fr : kind == 1 ? 1024 + 64 * g + 16 * nb + fr : (nb < 2 ? 1536 + 32 * g + 16 * nb + fr : 2048 + 32 * g + 16 * (nb - 2) + fr);
        brow[nb] = Wt + (size_t)(win_pcol(lc & ~31) + (lc & 31)) * DM + 8 * fq + 256 * kc; }
    bf16x8 af[8], bf[8][4];
#pragma unroll
    for (int ks = 0; ks < 8; ++ks) { af[ks] = *(const bf16x8*)(XNm + 32 * ks);
#pragma unroll
        for (int nb = 0; nb < 4; ++nb) bf[ks][nb] = *(const bf16x8*)(brow[nb] + 32 * ks); }
    asm volatile("" ::: "memory");
    f32x4 acc[4];
#pragma unroll
    for (int nb = 0; nb < 4; ++nb) acc[nb] = (f32x4){0.f, 0.f, 0.f, 0.f};
#pragma unroll
    for (int ks = 0; ks < 8; ++ks)
#pragma unroll
        for (int nb = 0; nb < 4; ++nb) acc[nb] = __builtin_amdgcn_mfma_f32_16x16x32_bf16(bf[ks][nb], af[ks], acc[nb], 0, 0, 0);
    LAS f32x4* red = (LAS f32x4*)lds;
#pragma unroll
    for (int nb = 0; nb < 4; ++nb) red[(wave * 4 + nb) * 64 + lane] = acc[nb];
    __syncthreads();
    if (kc == 0) {
#pragma unroll
        for (int nb = 0; nb < 4; ++nb) acc[nb] = (red[((wave + 0) * 4 + nb) * 64 + lane] + red[((wave + 1) * 4 + nb) * 64 + lane]) + (red[((wave + 2) * 4 + nb) * 64 + lane] + red[((wave + 3) * 4 + nb) * 64 + lane]);
        if (kind == 0) {
            float ss = 0.f;
#pragma unroll
            for (int nb = 0; nb < 4; ++nb) ss += (acc[nb][0] * acc[nb][0] + acc[nb][1] * acc[nb][1]) + (acc[nb][2] * acc[nb][2] + acc[nb][3] * acc[nb][3]);
            ss += __shfl_xor(ss, 16); ss += __shfl_xor(ss, 32);
            const float rs = __builtin_amdgcn_rsqf(ss * (1.0f / 64.0f) + EPS);
#pragma unroll
            for (int nb = 0; nb < 4; ++nb) acc[nb] = acc[nb] * rs * *(const f32x4*)(A.in[I_KG] + 16 * nb + 4 * fq);
            f32x4 p; p[0] = __shfl_xor(acc[0][0], 32); p[1] = __shfl_xor(acc[0][1], 32); p[2] = __shfl_xor(acc[0][2], 32); p[3] = __shfl_xor(acc[0][3], 32);
            const float* rp = (const float*)(ws + WS_ROPE) + fr * 16 + 4 * (fq & 1);
            const f32x4 c = *(const f32x4*)rp, s = *(const f32x4*)(rp + 8);
            const float sg = (fq & 2) ? 1.f : -1.f;
            acc[0] = acc[0] * c + (p * s) * sg;
        }
        if (kind == 2) {
#pragma unroll
            for (int nb = 0; nb < 2; ++nb)
#pragma unroll
                for (int e = 0; e < 4; ++e) acc[nb][e] = acc[nb][e] * __builtin_amdgcn_rcpf(1.0f + __builtin_amdgcn_exp2f(-1.4426950408889634f * acc[nb + 2][e]));
        }
        bf16* dst = kind == 0 ? (bf16*)(ws + WS_K) : kind == 1 ? (bf16*)(ws + WS_V) : (bf16*)(ws + WS_G);
        const int r0 = kind == 2 ? 48 + fr : fr, c0 = (kind == 2 ? 32 * g : 64 * g) + 4 * fq, nnb = kind == 2 ? 2 : 4;
#pragma unroll 1
        for (int b = 0; b < NB; ++b) { bf16* o = dst + (size_t)(b * SPAD + r0) * 512 + c0;
#pragma unroll
            for (int nb = 0; nb < 4; ++nb) if (nb < nnb) *(unsigned long long*)(o + 16 * nb) = (unsigned long long)pk2(acc[nb][0], acc[nb][1]) | ((unsigned long long)pk2(acc[nb][2], acc[nb][3]) << 32); }
    }
    __syncthreads();
}

__device__ __forceinline__ void wconv_phase(const Args& A, unsigned char* ws, LAS unsigned char* lds, int wave, int lane) {
    LAS float* scr = (LAS float*)(lds + wave * 16384);
    bf16* Wout_t = (bf16*)(ws + WS_WOUT); bf16* Wup_t = (bf16*)(ws + WS_WUP); bf16* Wdn_t = (bf16*)(ws + WS_WDN);
    constexpr int I_OUT = (DM / 64) * (DM / 32), I_UP = (DM / 64) * (DFF / 32), I_DN = (DFF / 64) * (DM / 32), NIT = I_OUT + I_UP + I_DN;
    unsigned* wq = (unsigned*)(ws + WS_CTL) + 96;
    volatile LAS unsigned* TK = (volatile LAS unsigned*)(lds + LDS_BYTES - 256 + 64);
    for (;;) {
        if (wave == 0 && lane == 0) TK[0] = __hip_atomic_fetch_add(wq, 1u, __ATOMIC_RELAXED, __HIP_MEMORY_SCOPE_AGENT);
        __syncthreads();
        const int t = (int)TK[0];
        __syncthreads();
        if (t * NWAVES >= NIT) break;
        int r = t * NWAVES + wave;
        if (r >= NIT) continue;
        if (r < I_OUT) { const int nblk = DM / 32, kb = r / nblk, nb = r % nblk; p0_transpose_item(A.in[I_WOUT], DM, DM, Wout_t, 32 * nb, 32 * nb, 64 * kb, nullptr, scr, lane); continue; } r -= I_OUT;
        if (r < I_UP) { const int nblk = DFF / 32, kb = r / nblk, nb = r % nblk; p0_transpose_item(A.in[I_WUP], DM, DFF, Wup_t, 32 * nb, 32 * nb, 64 * kb, A.in[I_G2], scr, lane); continue; } r -= I_UP;
        { const int nblk = DM / 32, kb = r / nblk, nb = r % nblk; p0_transpose_item(A.in[I_WDN], DFF, DM, Wdn_t, 32 * nb, 32 * nb, 64 * kb, nullptr, scr, lane); }
    }
}

constexpr int CONV_R = 32;
__device__ __forceinline__ void conv_phase(const Args& A, unsigned char* ws, LAS unsigned char* lds, int vcu, int G, int wave, int lane) {
    LAS float* cbuf = (LAS float*)lds;
    const bf16* GB = (const bf16*)(ws + WS_G); bf16* MIX = (bf16*)(ws + WS_MIX);
    const int cp = (wave & 3) * 64 + lane, half = wave >> 2;
    f32x2 w[CONVW];
#pragma unroll
    for (int j = 0; j < CONVW; ++j) w[j] = *(const f32x2*)(A.in[I_CW] + j * DCONV + 2 * cp);
    const f32x2 bias = *(const f32x2*)(A.in[I_CB] + 2 * cp);
    const f32x4 lg0 = *(const f32x4*)(A.in[I_CLG] + lane * 8), lg1 = *(const f32x4*)(A.in[I_CLG] + lane * 8 + 4), lb0 = *(const f32x4*)(A.in[I_CLB] + lane * 8), lb1 = *(const f32x4*)(A.in[I_CLB] + lane * 8 + 4);
    constexpr int NITEMS = MX / (2 * CONV_R);
    unsigned* cq = (unsigned*)(ws + WS_CTL) + 32;
    volatile LAS unsigned* TK = (volatile LAS unsigned*)(lds + LDS_BYTES - 256 + 64);
    if (wave == 0 && lane == 0) { TK[0] = __hip_atomic_fetch_add(cq, 1u, __ATOMIC_RELAXED, __HIP_MEMORY_SCOPE_AGENT); TK[1] = __hip_atomic_fetch_add(cq, 1u, __ATOMIC_RELAXED, __HIP_MEMORY_SCOPE_AGENT); }
    __syncthreads();
    int it = (int)TK[0], nxt = (int)TK[1];
    __syncthreads();
#define CONV_SRC(item, sub) (GB + (size_t)(((((item) * 2 * CONV_R + half * CONV_R + (sub) * 16) >> 13) * SPAD) + 34 + (((item) * 2 * CONV_R + half * CONV_R + (sub) * 16) & 8191)) * 512 + 2 * cp)
#define CONV_LOAD(buf, item, sub) do { const bf16* gs_ = CONV_SRC(item, sub); _Pragma("unroll") for (int i = 0; i < 46; ++i) buf[i] = *(const unsigned*)(gs_ + (size_t)i * 512); } while (0)
#define CONV_FMA(buf, sub) do { f32x2 acc[16]; _Pragma("unroll") for (int o = 0; o < 16; ++o) acc[o] = bias; \
        _Pragma("unroll") for (int i = 0; i < 46; ++i) { const f32x2 x = {bf_lo(buf[i]), bf_hi(buf[i])}; _Pragma("unroll") for (int o = 0; o < 16; ++o) { const int j = i - o; if (j >= 0 && j < CONVW) acc[o] += w[j] * x; } } \
        _Pragma("unroll") for (int o = 0; o < 16; ++o) *(LAS f32x2*)(cbuf + (half * CONV_R + (sub) * 16 + o) * DCONV + 2 * cp) = acc[o]; } while (0)
    unsigned bufA[46], bufB[46];
    if (it < NITEMS) CONV_LOAD(bufA, it, 0);
#pragma unroll 1
    while (it < NITEMS) {
        if (wave == 0 && lane == 0) TK[0] = __hip_atomic_fetch_add(cq, 1u, __ATOMIC_RELAXED, __HIP_MEMORY_SCOPE_AGENT);
        CONV_LOAD(bufB, it, 1);
        CONV_FMA(bufA, 0);
        if (nxt < NITEMS) CONV_LOAD(bufA, nxt, 0);
        CONV_FMA(bufB, 1);
        __syncthreads();
        const int nn = (int)TK[0];
#pragma unroll
        for (int rr = 0; rr < 8; ++rr) { const int lr = wave * 8 + rr;
            f32x4 x0 = *(const LAS f32x4*)(cbuf + lr * DCONV + lane * 8), x1 = *(const LAS f32x4*)(cbuf + lr * DCONV + lane * 8 + 4);
            const float mu = wave_sum_fast((x0[0] + x0[1]) + (x0[2] + x0[3]) + (x1[0] + x1[1]) + (x1[2] + x1[3])) * (1.f / DCONV);
            x0 = x0 - mu; x1 = x1 - mu;
            const float var = wave_sum_fast((x0[0] * x0[0] + x0[1] * x0[1]) + (x0[2] * x0[2] + x0[3] * x0[3]) + (x1[0] * x1[0] + x1[1] * x1[1]) + (x1[2] * x1[2] + x1[3] * x1[3])) * (1.f / DCONV);
            const float rs = __builtin_amdgcn_rsqf(var + EPS);
            x0 = x0 * rs * lg0 + lb0; x1 = x1 * rs * lg1 + lb1;
#pragma unroll
            for (int e = 0; e < 4; ++e) { x0[e] = x0[e] * __builtin_amdgcn_rcpf(1.0f + __builtin_amdgcn_exp2f(-1.4426950408889634f * x0[e])); x1[e] = x1[e] * __builtin_amdgcn_rcpf(1.0f + __builtin_amdgcn_exp2f(-1.4426950408889634f * x1[e])); }
            *(v4u*)(MIX + (size_t)(it * 2 * CONV_R + lr) * DM + 512 + lane * 8) = pg8::pack8(x0, x1); }
        __syncthreads();
        it = nxt; nxt = nn;
    }
#undef CONV_SRC
#undef CONV_LOAD
#undef CONV_FMA
}

__device__ __forceinline__ void combine_phase(const Args& A, unsigned char* ws, int vcu, int G, int wave, int lane) {
    const bf16* OB = (const bf16*)(ws + WS_O); bf16* MIX = (bf16*)(ws + WS_MIX);
    const float d1 = wave_sum(A.in[I_LQ1][lane] * A.in[I_LK1][lane]), d2 = wave_sum(A.in[I_LQ2][lane] * A.in[I_LK2][lane]);
    const float lam_init = 0.2f;
    const float lam = __builtin_amdgcn_exp2f(d1 * 1.4426950408889634f) - __builtin_amdgcn_exp2f(d2 * 1.4426950408889634f) + lam_init;
    const int h = lane >> 4, q = lane & 15;
    const f32x4 sg0 = *(const f32x4*)(A.in[I_SUBLN] + 8 * q), sg1 = *(const f32x4*)(A.in[I_SUBLN] + 8 * q + 4);
    const int gw = vcu * NWAVES + wave, NGW = G * NWAVES;
    for (int row = gw; row < MX; row += NGW) {
        const bf16* o1 = OB + (size_t)row * 1024 + h * 256 + 8 * q;
        const v4u a = *(const v4u*)o1, bq = *(const v4u*)(o1 + 128);
        f32x4 d0, d1v;
        d0[0] = bf_lo(a.x) - lam * bf_lo(bq.x); d0[1] = bf_hi(a.x) - lam * bf_hi(bq.x); d0[2] = bf_lo(a.y) - lam * bf_lo(bq.y); d0[3] = bf_hi(a.y) - lam * bf_hi(bq.y);
        d1v[0] = bf_lo(a.z) - lam * bf_lo(bq.z); d1v[1] = bf_hi(a.z) - lam * bf_hi(bq.z); d1v[2] = bf_lo(a.w) - lam * bf_lo(bq.w); d1v[3] = bf_hi(a.w) - lam * bf_hi(bq.w);
        float ss = (d0[0] * d0[0] + d0[1] * d0[1]) + (d0[2] * d0[2] + d0[3] * d0[3]) + (d1v[0] * d1v[0] + d1v[1] * d1v[1]) + (d1v[2] * d1v[2] + d1v[3] * d1v[3]);
        ss += __shfl_xor(ss, 1); ss += __shfl_xor(ss, 2); ss += __shfl_xor(ss, 4); ss += __shfl_xor(ss, 8);
        const float rs = __builtin_amdgcn_rsqf(ss * (1.f / 128.f) + EPS) * (1.0f - lam_init);
        *(v4u*)(MIX + (size_t)row * DM + h * 128 + 8 * q) = pg8::pack8(d0 * rs * sg0, d1v * rs * sg1);
    }
}

__global__ void __launch_bounds__(NWAVES * 64, 2) hymba_fwd(Args args) {
    extern __shared__ __attribute__((aligned(16))) unsigned char lds[];
    cg::grid_group grid = cg::this_grid();
    LAS unsigned char* ldsl = (LAS unsigned char*)lds;
    volatile LAS unsigned* MISC = (volatile LAS unsigned*)(ldsl + LDS_BYTES - 256);
    if (threadIdx.x < 32) MISC[threadIdx.x] = 0u;
    __syncthreads();
    const XcdBarrier bar = xcd_barrier_post((unsigned*)(args.ws + WS_CTL) + 4096, MISC + 8);
    const int G = gridDim.x; const int bx = blockIdx.x; const int vcu = (G % 8 == 0) ? (bx % 8) * (G / 8) + bx / 8 : bx;
#ifndef PROBE_DUP
#define PROBE_DUP 0
#endif
#define REP(mask) for (int rep_ = 0; rep_ < (((PROBE_DUP) & (mask)) ? 2 : 1); ++rep_)
#define PHASE_VARS() unsigned char* ws = args.ws; int tid_ = threadIdx.x; asm volatile("" : "+v"(tid_)); const int lane = tid_ & 63, wave = __builtin_amdgcn_readfirstlane(tid_ >> 6); (void)lane; (void)wave

    REP(1) { PHASE_VARS(); p0_prologue(args, ws, ldsl, vcu, G, wave, lane); }
    if (args.ws == nullptr) grid.sync();
    xcd_barrier(bar);

    REP(2) {
        PHASE_VARS();
        pg8::Gemm g{(bf16*)(ws + WS_XN), (bf16*)(ws + WS_WIN), MX, DIN, DM}; pg8::StaticOrder S; S.init(MX, DIN, G, bx, WGM_P1);
        pg8::EpiInProj E{(bf16*)(ws + WS_Q), (bf16*)(ws + WS_K), (bf16*)(ws + WS_V), (bf16*)(ws + WS_G), args.in[I_QG], args.in[I_KG], (const float*)(ws + WS_ROPE)};
        pg8::gemm_phase<pg8::EpiInProj, pg8::StaticOrder, PG8_ALIGN, PG8_SP2>(ldsl, g, S, E);
    }
    {
        PHASE_VARS();
        unsigned* mq = (unsigned*)(ws + WS_CTL) + 160;
        volatile LAS unsigned* TK = (volatile LAS unsigned*)(ldsl + LDS_BYTES - 256 + 64);
        for (;;) {
            if (tid_ == 0) TK[0] = __hip_atomic_fetch_add(mq, 1u, __ATOMIC_RELAXED, __HIP_MEMORY_SCOPE_AGENT);
            __syncthreads();
            const int t = (int)TK[0];
            __syncthreads();
            if (t >= 16) break;
            meta_proj(args, ws, ldsl, t, wave, lane);
        }
    }
    xcd_barrier(bar);

    REP(8) {
        PHASE_VARS();
        static_assert(attn_body::V2_LDS_BYTES <= LDS_BYTES - 256, "attention LDS");
        const float dq1 = wave_sum(args.in[I_LQ1][lane] * args.in[I_LK1][lane]), dq2 = wave_sum(args.in[I_LQ2][lane] * args.in[I_LK2][lane]);
        const float lam_init = 0.2f;
        const float lam = __builtin_amdgcn_exp2f(dq1 * 1.4426950408889634f) - __builtin_amdgcn_exp2f(dq2 * 1.4426950408889634f) + lam_init;
        for (int vv = vcu; vv < 256; vv += G) {
            const int bh = vv >> 4, s = vv & 15;
            const int b = bh >> 2, head = bh & 3;
            const attn_body::bf16* Kh = (const attn_body::bf16*)(ws + WS_K) + (size_t)(b * SPAD) * 512 + head * 128;
            const attn_body::bf16* Vh = (const attn_body::bf16*)(ws + WS_V) + (size_t)(b * SPAD) * 512 + head * 128;
            for (int i = 0; i < 2; ++i) {
                const int qb = i ? 31 - s : s;
                const int q0 = qb * 256;
                const attn_body::bf16* Qu = (const attn_body::bf16*)(ws + WS_Q) + (size_t)(b * SEQ + q0) * 512 + head * 128;
                attn_body::bf16* Mu = (attn_body::bf16*)(ws + WS_MIX) + (size_t)(b * SEQ + q0) * 1024 + head * 128;
                attn_body::attn_unit128<0>(q0, Qu, Kh, Vh, Mu, (char*)lds, lam, 1.0f - lam_init, args.in[I_SUBLN]);
                attn_body::attn_unit128<1>(q0, Qu + 64, Kh + 64, Vh, Mu, (char*)lds, lam, 1.0f - lam_init, args.in[I_SUBLN]);
            }
        }
    }
    REP(4) { PHASE_VARS(); conv_phase(args, ws, ldsl, vcu, G, wave, lane); }
    { PHASE_VARS(); wconv_phase(args, ws, ldsl, wave, lane); }
    xcd_barrier(bar);

    REP(32) {
        PHASE_VARS();
        pg8::Gemm g{(bf16*)(ws + WS_MIX), (bf16*)(ws + WS_WOUT), MX, DM, DM}; pg8::StaticOrder S; S.init(MX, DM, G, bx, WGM_P35);
        pg8::EpiOut E{(const bf16*)(ws + WS_XN), (const float*)(ws + WS_RN), args.in[I_G1], (bf16*)(ws + WS_H1B), (float*)(ws + WS_SSQ)};
        pg8::gemm_phase<pg8::EpiOut, pg8::StaticOrder, PG8_ALIGN, PG8_SP2>(ldsl, g, S, E);
    }
    xcd_barrier(bar);

    REP(64) {
        PHASE_VARS();
        pg8::Gemm g{(bf16*)(ws + WS_H1B), (bf16*)(ws + WS_WUP), MX, DFF, DM}; pg8::StaticOrder S; S.init(MX, DFF, G, bx, WGM_P4);
        pg8::EpiUp E{(bf16*)(ws + WS_HB), (const float*)(ws + WS_SSQ)};
        pg8::gemm_phase<pg8::EpiUp, pg8::StaticOrder, PG8_ALIGN, PG8_SP2>(ldsl, g, S, E);
    }
    xcd_barrier(bar);

    {
        PHASE_VARS();
        pg8::Gemm g{(bf16*)(ws + WS_HB), (bf16*)(ws + WS_WDN), MX, DM, DFF}; pg8::StaticOrder S; S.init(MX, DM, G, bx, WGM_P35);
        pg8::EpiDown E{(const bf16*)(ws + WS_H1B), args.out};
        pg8::gemm_phase<pg8::EpiDown, pg8::StaticOrder, PG8_ALIGN, PG8_SP2>(ldsl, g, S, E);
    }
#undef PHASE_VARS
#undef REP
}

extern "C" void kernel_launch(void* const* d_in, const int* in_sizes, int n_in, void* d_out, int out_size, void* d_ws, size_t ws_size, hipStream_t stream) {
    static int grid = 0;
    if (grid == 0) {
        if (n_in != 19 || in_sizes[0] != MX * DM || out_size != MX * DM || ws_size < WS_END) { fprintf(stderr, "kernel_launch: unexpected shapes: n_in %d, in0 %d, out %d, ws %zu (need %zu); nothing launched\n", n_in, n_in > 0 ? in_sizes[0] : -1, out_size, ws_size, (size_t)WS_END); grid = -1; return; }
        int dev = 0, cus = 0, per_cu = 0;
        if (hipGetDevice(&dev) != hipSuccess || hipDeviceGetAttribute(&cus, hipDeviceAttributeMultiprocessorCount, dev) != hipSuccess) { fprintf(stderr, "kernel_launch: device query failed\n"); grid = -1; return; }
        if (hipFuncSetAttribute((const void*)hymba_fwd, hipFuncAttributeMaxDynamicSharedMemorySize, LDS_BYTES) != hipSuccess) { fprintf(stderr, "kernel_launch: hipFuncSetAttribute failed\n"); grid = -1; return; }
        if (hipOccupancyMaxActiveBlocksPerMultiprocessor(&per_cu, (const void*)hymba_fwd, NWAVES * 64, LDS_BYTES) != hipSuccess || per_cu < 1) { fprintf(stderr, "kernel_launch: occupancy query says %d\n", per_cu); per_cu = 1; }
        (void)hipGetLastError();
        grid = cus * 1;
        fprintf(stderr, "kernel_launch: grid %d (occupancy query %d per CU)\n", grid, per_cu);
    }
    if (grid < 0) return;
    Args a{};
    for (int i = 0; i < 19; ++i) a.in[i] = (const float*)d_in[i];
    a.out = (float*)d_out; a.ws = (unsigned char*)d_ws;
    for (int i = 0; i < 8; ++i) a.inv_freq[i] = (float)pow(500000.0, -(double)i / 8.0);
    if (hipMemsetAsync((char*)d_ws + WS_CTL, 0, 65536, stream) != hipSuccess) { fprintf(stderr, "kernel_launch: hipMemsetAsync failed\n"); return; }
    void* kargs[] = {&a};
    const hipError_t le = hipLaunchCooperativeKernel((const void*)hymba_fwd, dim3(grid), dim3(NWAVES * 64), kargs, LDS_BYTES, stream);
    if (le != hipSuccess) fprintf(stderr, "kernel_launch: cooperative launch failed: %s (grid %d)\n", hipGetErrorName(le), grid);
}
```

```cpp
#include <hip/hip_cooperative_groups.h>
#include <cmath>
#include <hip/hip_runtime.h>
#include <cstdio>
#include <cstdint>
namespace pg8 {
#define PG8_LAS __attribute__((address_space(3)))
typedef unsigned short bf16_t;
typedef short bf16x8 __attribute__((ext_vector_type(8)));
typedef float f32x4 __attribute__((ext_vector_type(4)));
typedef unsigned u32x4 __attribute__((ext_vector_type(4)));
constexpr int BM = 256, BK = 64, HALF = 128, HTB = HALF * BK * 2  , STAGE_BYTES = 8 * HTB, NXCD = 8, WGM = 8;

__host__ __device__ __forceinline__ int lds_byte(int r, int c) { const int st = (r >> 4) * 2 + (c >> 5), rr = r & 15, cc = c & 31, ob = rr * 64 + cc * 2; return st * 1024 + (ob ^ (((ob >> 9) & 1) << 5)); }
__host__ __device__ __forceinline__ void stage_rc(int b, int& R, int& C) { const int st = b / 1024, sb = b % 1024, swz = sb ^ (((sb >> 9) & 1) << 5); R = (st >> 1) * 16 + swz / 64; C = (st & 1) * 32 + (swz % 64) / 2; }
__host__ __device__ __forceinline__ int perm32(int rho) { const int n = rho >> 4, i = rho & 15; return 8 * (i >> 2) + 4 * n + (i & 3); }

struct Unit { int pm, pn; };
struct Gemm { const bf16_t* A; const bf16_t* Bt; int M, N, K; };

struct StaticOrder {
    int nM, nN, nwg, G, c, wgm;
    __host__ __device__ void init(int M, int N, int G_, int c_, int wgm_ = WGM) { nM = M / BM; nN = N / BM; nwg = nM * nN; G = G_; c = c_; wgm = wgm_; }
    __host__ __device__ bool next(int i, Unit& u) const {
        const long L = (long)i * G + c; if (L >= nwg) return false;
        int wgid = (int)L; { const int q = nwg / NXCD, r = nwg % NXCD, xcd = wgid % NXCD, off = wgid / NXCD; wgid = (xcd < r ? xcd * (q + 1) : r * (q + 1) + (xcd - r) * q) + off; }
        const int nig = wgm * nN, gid = wgid / nig, fm = gid * wgm, gsz = (nM - fm) < wgm ? (nM - fm) : wgm;
        u.pm = fm + ((wgid % nig) % gsz); u.pn = (wgid % nig) / gsz; return true;
    }
    __device__ __forceinline__ void a_ready(const Unit&) const {}
    __device__ __forceinline__ void done(const Unit&) const {}
};

__device__ __forceinline__ unsigned cvt_pk_bf16(float lo, float hi) { unsigned r; asm volatile("v_cvt_pk_bf16_f32 %0, %1, %2" : "=v"(r) : "v"(lo), "v"(hi)); return r; }
typedef float f32x2 __attribute__((ext_vector_type(2)));
__device__ __forceinline__ f32x2 gelu_pk(f32x2 v) {
    const f32x2 av = __builtin_elementwise_abs(v), d = av * 0.2316418882f + 1.0f;
    f32x2 t; t.x = __builtin_amdgcn_rcpf(d.x); t.y = __builtin_amdgcn_rcpf(d.y);
    f32x2 q = t * 0.5307027145f + (-0.7265760135f); q = q * t + 0.7107068705f; q = q * t + (-0.142248368f); q = q * t + 0.127414796f; q = q * t;
    const f32x2 s = (v * v) * (-0.72134752044f);
    f32x2 e; e.x = __builtin_amdgcn_exp2f(s.x); e.y = __builtin_amdgcn_exp2f(s.y);
    const f32x2 m = v * (q * e), r = v - m;
    f32x2 o; o.x = v.x < 0.f ? m.x : r.x; o.y = v.y < 0.f ? m.y : r.y; return o;
}

template <int ACT  > struct EpiBf16 {
    static constexpr bool PERM = true, AFTER_DRAIN = false; static_assert(ACT == 0 || ACT == 1, "EpiBf16: ACT is 0 (none) or 1 (gelu_pk)");
    bf16_t* O; int ldc; const float* bias; int split_cols; size_t split_stride; float scale0;
    __device__ __forceinline__ void operator()(const f32x4 (&acc)[2][2][4][2], const Unit& u, int wr, int wc, int fr, int fq) const {
        const int row0 = u.pm * BM + wr * 64 + fr; int colt = u.pn * BM; bf16_t* base = O;
        float sc = 1.f; if (split_cols) { const int t = colt / split_cols; base += (size_t)t * split_stride; colt -= t * split_cols; if (t == 0) sc = scale0; }
        const int col0 = colt + wc * 32 + 8 * fq, bcol0 = u.pn * BM + wc * 32 + 8 * fq;
        f32x4 bv[2][2];
#pragma unroll
        for (int bj = 0; bj < 2; ++bj)
#pragma unroll
            for (int n = 0; n < 2; ++n) bv[bj][n] = bias ? *(const f32x4*)(bias + bcol0 + bj * HALF + 4 * n) : (f32x4){0.f, 0.f, 0.f, 0.f};
#pragma unroll
        for (int ai = 0; ai < 2; ++ai)
#pragma unroll
            for (int m = 0; m < 4; ++m) { bf16_t* rowp = base + (size_t)(row0 + ai * HALF + m * 16) * ldc + col0;
#pragma unroll
                for (int bj = 0; bj < 2; ++bj) { f32x4 v0 = acc[ai][bj][m][0] + bv[bj][0], v1 = acc[ai][bj][m][1] + bv[bj][1];
                    if (ACT == 1) { f32x2 a = gelu_pk((f32x2){v0[0], v0[1]}), b = gelu_pk((f32x2){v0[2], v0[3]}), c = gelu_pk((f32x2){v1[0], v1[1]}), d = gelu_pk((f32x2){v1[2], v1[3]});
                        v0 = (f32x4){a.x, a.y, b.x, b.y}; v1 = (f32x4){c.x, c.y, d.x, d.y}; }
                    v0 = v0 * sc; v1 = v1 * sc; u32x4 w; w.x = cvt_pk_bf16(v0[0], v0[1]); w.y = cvt_pk_bf16(v0[2], v0[3]); w.z = cvt_pk_bf16(v1[0], v1[1]); w.w = cvt_pk_bf16(v1[2], v1[3]);
                    *(u32x4*)(rowp + bj * HALF) = w; } }
    }
};

constexpr int XROWS = 32768, SPAD = 8256;
constexpr float QSCALE = 0.125f * 1.4426950408889634f;
__device__ __forceinline__ f32x4 shfl_xor4(f32x4 v, int m) { f32x4 r; r[0] = __shfl_xor(v[0], m); r[1] = __shfl_xor(v[1], m); r[2] = __shfl_xor(v[2], m); r[3] = __shfl_xor(v[3], m); return r; }
__device__ __forceinline__ u32x4 pack8(f32x4 a, f32x4 b) { u32x4 w; w.x = cvt_pk_bf16(a[0], a[1]); w.y = cvt_pk_bf16(a[2], a[3]); w.z = cvt_pk_bf16(b[0], b[1]); w.w = cvt_pk_bf16(b[2], b[3]); return w; }
struct EpiInProj {
    static constexpr bool PERM = true, AFTER_DRAIN = false;
    bf16_t *Q, *K, *V, *G; const float *qg, *kg, *rope;
    __device__ __forceinline__ void operator()(const f32x4 (&acc)[2][2][4][2], const Unit& u, int wr, int wc, int fr, int fq) const {
        const int pn = u.pn; constexpr bool meta = false;
        if (meta && (wr != 0 || pn < 2)) return;
        const int rbase = u.pm * BM + wr * 64 + fr;
        if (pn < 4) {
            const bool isq = pn < 2; const float* gp = isq ? qg : kg; const float osc = isq ? QSCALE : 1.f;
            f32x4 gv[2][2];
#pragma unroll
            for (int bj = 0; bj < 2; ++bj)
#pragma unroll
                for (int n = 0; n < 2; ++n) gv[bj][n] = *(const f32x4*)(gp + 32 * bj + 8 * fq + 4 * n);
            const int colb = (pn & 1) * 256 + wc * 64 + 8 * fq;
            bf16_t* dst = isq ? Q : K;
#pragma unroll
            for (int ai = 0; ai < 2; ++ai) {
                if (meta && ai) continue;
#pragma unroll
              for (int mh = 0; mh < 2; ++mh) {
                if (meta && mh) continue;
                f32x4 rv[2][4];
                if (fq < 2) {
#pragma unroll
                    for (int m2 = 0; m2 < 2; ++m2) { const int row = rbase + ai * HALF + (2 * mh + m2) * 16; const int pos = meta ? (row - XROWS) : ((row & 8191) + 16); const f32x4* rp = (const f32x4*)(rope + (size_t)pos * 16);
#pragma unroll
                        for (int k = 0; k < 4; ++k) rv[m2][k] = rp[k]; }
                }
                asm volatile("" ::: "memory");
#pragma unroll
                for (int m = 2 * mh; m < 2 * mh + 2; ++m) {
                    if (meta && m) continue;
                    const int row = rbase + ai * HALF + m * 16;
                    float ss = 0.f;
#pragma unroll
                    for (int bj = 0; bj < 2; ++bj)
#pragma unroll
                        for (int n = 0; n < 2; ++n) { const f32x4 x = acc[ai][bj][m][n]; ss += (x[0] * x[0] + x[1] * x[1]) + (x[2] * x[2] + x[3] * x[3]); }
                    ss += __shfl_xor(ss, 16); ss += __shfl_xor(ss, 32);
                    const float rs = __builtin_amdgcn_rsqf(ss * (1.0f / 64.0f) + 1e-6f);
                    f32x4 y00 = acc[ai][0][m][0] * rs * gv[0][0], y01 = acc[ai][0][m][1] * rs * gv[0][1], y10 = acc[ai][1][m][0] * rs * gv[1][0], y11 = acc[ai][1][m][1] * rs * gv[1][1];
                    const f32x4 p0 = shfl_xor4(y00, 16), p1 = shfl_xor4(y01, 16);
                    if (fq < 2) {
                        const f32x4 c0 = rv[m & 1][0], c1 = rv[m & 1][1], s0 = rv[m & 1][2], s1 = rv[m & 1][3];
                        const float sg = fq ? 1.f : -1.f;
                        y00 = y00 * c0 + (p0 * s0) * sg; y01 = y01 * c1 + (p1 * s1) * sg;
                    }
                    const u32x4 w0 = pack8(y00 * osc, y01 * osc), w1 = pack8(y10 * osc, y11 * osc);
                    if (!meta) {
                        const size_t orow = isq ? (size_t)row : (size_t)((row >> 13) * SPAD + 64 + (row & 8191));
                        *(u32x4*)(dst + orow * 512 + colb) = w0; *(u32x4*)(dst + orow * 512 + colb + 32) = w1;
                    } else {
#pragma unroll 1
                        for (int b = 0; b < 4; ++b) { const size_t orow = (size_t)(b * SPAD + fr); *(u32x4*)(dst + orow * 512 + colb) = w0; *(u32x4*)(dst + orow * 512 + colb + 32) = w1; }
                    }
                }
              }
            }
        } else if (pn < 6) {
            const int colb = (pn - 4) * 256 + wc * 32 + 8 * fq;
#pragma unroll
            for (int ai = 0; ai < 2; ++ai)
#pragma unroll
                for (int m = 0; m < 4; ++m) {
                    if (meta && (ai || m)) continue;
                    const int row = rbase + ai * HALF + m * 16;
                    const u32x4 w0 = pack8(acc[ai][0][m][0], acc[ai][0][m][1]), w1 = pack8(acc[ai][1][m][0], acc[ai][1][m][1]);
                    if (!meta) {
                        const size_t orow = (size_t)((row >> 13) * SPAD + 64 + (row & 8191));
                        *(u32x4*)(V + orow * 512 + colb) = w0; *(u32x4*)(V + orow * 512 + colb + HALF) = w1;
                    } else {
#pragma unroll 1
                        for (int b = 0; b < 4; ++b) { const size_t orow = (size_t)(b * SPAD + fr); *(u32x4*)(V + orow * 512 + colb) = w0; *(u32x4*)(V + orow * 512 + colb + HALF) = w1; }
                    }
                }
        } else {
            const int colb = (pn - 6) * 128 + wc * 32 + 8 * fq;
#pragma unroll
            for (int ai = 0; ai < 2; ++ai)
#pragma unroll
                for (int m = 0; m < 4; ++m) {
                    if (meta && (ai || m)) continue;
                    const int row = rbase + ai * HALF + m * 16;
                    f32x4 h[2];
#pragma unroll
                    for (int n = 0; n < 2; ++n) { const f32x4 a = acc[ai][0][m][n], g = acc[ai][1][m][n];
#pragma unroll
                        for (int e = 0; e < 4; ++e) h[n][e] = a[e] * __builtin_amdgcn_rcpf(1.0f + __builtin_amdgcn_exp2f(-1.4426950408889634f * g[e])); }
                    const u32x4 w0 = pack8(h[0], h[1]);
                    if (!meta) {
                        const size_t orow = (size_t)((row >> 13) * SPAD + 64 + (row & 8191));
                        *(u32x4*)(G + orow * 512 + colb) = w0;
                    } else {
#pragma unroll 1
                        for (int b = 0; b < 4; ++b) { const size_t orow = (size_t)(b * SPAD + 48 + fr); *(u32x4*)(G + orow * 512 + colb) = w0; }
                    }
                }
        }
    }
};
struct EpiOut {
    static constexpr bool PERM = true, AFTER_DRAIN = false;
    const bf16_t* xn; const float* rn; const float* g1; bf16_t* hb; float* ssq;
    __device__ __forceinline__ void operator()(const f32x4 (&acc)[2][2][4][2], const Unit& u, int wr, int wc, int fr, int fq) const {
        const int rbase = u.pm * BM + wr * 64 + fr, colb = u.pn * BM + wc * 32 + 8 * fq;
        f32x4 ig[2][2];
#pragma unroll
        for (int bj = 0; bj < 2; ++bj)
#pragma unroll
            for (int n = 0; n < 2; ++n) { const f32x4 g = *(const f32x4*)(g1 + colb + bj * HALF + 4 * n);
#pragma unroll
                for (int e = 0; e < 4; ++e) ig[bj][n][e] = __builtin_amdgcn_rcpf(g[e]); }
#pragma unroll
        for (int ai = 0; ai < 2; ++ai) {
            u32x4 xv[4][2]; float rv[4];
#pragma unroll
            for (int m = 0; m < 4; ++m) { const int row = rbase + ai * HALF + m * 16; rv[m] = rn[row];
#pragma unroll
                for (int bj = 0; bj < 2; ++bj) xv[m][bj] = *(const u32x4*)(xn + (size_t)row * 1024 + colb + bj * HALF); }
            asm volatile("" ::: "memory");
#pragma unroll
            for (int m = 0; m < 4; ++m) {
                const int row = rbase + ai * HALF + m * 16; float ss = 0.f;
#pragma unroll
                for (int bj = 0; bj < 2; ++bj) { const size_t off = (size_t)row * 1024 + colb + bj * HALF; const u32x4 w = xv[m][bj];
                    f32x4 x0, x1;
                    x0[0] = __uint_as_float(w.x << 16); x0[1] = __uint_as_float(w.x & 0xffff0000u); x0[2] = __uint_as_float(w.y << 16); x0[3] = __uint_as_float(w.y & 0xffff0000u);
                    x1[0] = __uint_as_float(w.z << 16); x1[1] = __uint_as_float(w.z & 0xffff0000u); x1[2] = __uint_as_float(w.w << 16); x1[3] = __uint_as_float(w.w & 0xffff0000u);
                    const f32x4 h0 = x0 * rv[m] * ig[bj][0] + acc[ai][bj][m][0], h1 = x1 * rv[m] * ig[bj][1] + acc[ai][bj][m][1];
                    *(u32x4*)(hb + off) = pack8(h0, h1);
                    ss += (h0[0] * h0[0] + h0[1] * h0[1]) + (h0[2] * h0[2] + h0[3] * h0[3]) + (h1[0] * h1[0] + h1[1] * h1[1]) + (h1[2] * h1[2] + h1[3] * h1[3]); }
                ss += __shfl_xor(ss, 16); ss += __shfl_xor(ss, 32);
                if (fq == 0) ssq[(size_t)row * 16 + u.pn * 4 + wc] = ss;
            }
        }
    }
};
struct EpiUp {
    static constexpr bool PERM = true, AFTER_DRAIN = false;
    bf16_t* hb; const float* ssq;
    __device__ __forceinline__ void operator()(const f32x4 (&acc)[2][2][4][2], const Unit& u, int wr, int wc, int fr, int fq) const {
        const int rbase = u.pm * BM + wr * 64 + fr, colb = u.pn * BM + wc * 32 + 8 * fq;
#pragma unroll
        for (int ai = 0; ai < 2; ++ai) {
            f32x4 sv[4][4];
#pragma unroll
            for (int m = 0; m < 4; ++m) { const f32x4* sp = (const f32x4*)(ssq + (size_t)(rbase + ai * HALF + m * 16) * 16);
#pragma unroll
                for (int k = 0; k < 4; ++k) sv[m][k] = sp[k]; }
            asm volatile("" ::: "memory");
#pragma unroll
            for (int m = 0; m < 4; ++m) {
                const int row = rbase + ai * HALF + m * 16;
                const f32x4 s0 = sv[m][0], s1 = sv[m][1], s2 = sv[m][2], s3 = sv[m][3];
                const float tot = ((s0[0] + s0[1]) + (s0[2] + s0[3])) + ((s1[0] + s1[1]) + (s1[2] + s1[3])) + ((s2[0] + s2[1]) + (s2[2] + s2[3])) + ((s3[0] + s3[1]) + (s3[2] + s3[3]));
                const float rs = __builtin_amdgcn_rsqf(tot * (1.0f / 1024.0f) + 1e-6f);
#pragma unroll
                for (int bj = 0; bj < 2; ++bj) { f32x4 a0 = acc[ai][bj][m][0] * rs, a1 = acc[ai][bj][m][1] * rs;
#pragma unroll
                    for (int e = 0; e < 4; ++e) { const float p = fmaxf(a0[e], 0.f), q = fmaxf(a1[e], 0.f); a0[e] = p * p; a1[e] = q * q; }
                    __builtin_nontemporal_store(pack8(a0, a1), (u32x4*)(hb + (size_t)row * 4096 + colb + bj * HALF)); }
            }
        }
    }
};
struct EpiDown {
    static constexpr bool PERM = true, AFTER_DRAIN = false;
    const bf16_t* h1; float* out;
    __device__ __forceinline__ void operator()(const f32x4 (&acc)[2][2][4][2], const Unit& u, int wr, int wc, int fr, int fq) const {
        const int rbase = u.pm * BM + wr * 64 + fr, colb = u.pn * BM + wc * 32 + 8 * fq;
        u32x4 hv[2][4][2];
#pragma unroll
        for (int ai = 0; ai < 2; ++ai)
#pragma unroll
            for (int m = 0; m < 4; ++m)
#pragma unroll
                for (int bj = 0; bj < 2; ++bj) hv[ai][m][bj] = *(const u32x4*)(h1 + (size_t)(rbase + ai * HALF + m * 16) * 1024 + colb + bj * HALF);
        asm volatile("" ::: "memory");
#pragma unroll
        for (int ai = 0; ai < 2; ++ai)
#pragma unroll
            for (int m = 0; m < 4; ++m) {
                const int row = rbase + ai * HALF + m * 16;
#pragma unroll
                for (int bj = 0; bj < 2; ++bj) { const size_t off = (size_t)row * 1024 + colb + bj * HALF; const u32x4 w = hv[ai][m][bj];
                    f32x4 r0, r1;
                    r0[0] = __uint_as_float(w.x << 16); r0[1] = __uint_as_float(w.x & 0xffff0000u); r0[2] = __uint_as_float(w.y << 16); r0[3] = __uint_as_float(w.y & 0xffff0000u);
                    r1[0] = __uint_as_float(w.z << 16); r1[1] = __uint_as_float(w.z & 0xffff0000u); r1[2] = __uint_as_float(w.w << 16); r1[3] = __uint_as_float(w.w & 0xffff0000u);
                    *(f32x4*)(out + off) = r0 + acc[ai][bj][m][0]; *(f32x4*)(out + off + 4) = r1 + acc[ai][bj][m][1]; }
            }
    }
};


template <class Epi, class Sched, bool ALIGN_EPI = false, bool SP2 = false>
__device__ __forceinline__ void gemm_phase(PG8_LAS unsigned char* lds, const Gemm g, const Sched& S, const Epi& E) {
    int tid_ = threadIdx.x; asm volatile("" : "+v"(tid_));
    const int tid = tid_, wid = __builtin_amdgcn_readfirstlane(tid >> 6), lane = tid & 63, wr = wid >> 2, wc = wid & 3, fr = lane & 15, fq = lane >> 4;
    const int K = g.K, nt = K / BK;
    unsigned voffA[2], voffB[2];
#pragma unroll
    for (int i = 0; i < 2; ++i) { int R, C; stage_rc(tid * 16 + i * 8192, R, C); const int Rb = Epi::PERM ? ((R & ~31) + perm32(R & 31)) : R;
        voffA[i] = (unsigned)(R * K + C) * 2u; voffB[i] = (unsigned)(Rb * K + C) * 2u; }
    const size_t kstep = (size_t)(BK * 2);
    const size_t hstep = (size_t)HALF * K * 2;
    const size_t tstep = 2 * hstep;
    const unsigned ldsw = (unsigned)wid * 1024u;
    const int aoff = lds_byte(wr * 64 + fr, fq * 8), boff = lds_byte(wc * 32 + fr, fq * 8);
#define PG8_SA(b, h) (((b) * 2 + (h)) * HTB)
#define PG8_SB(b, h) ((4 + (b) * 2 + (h)) * HTB)
#define PG8_STAGE(bufoff, gbase, voff) do { _Pragma("unroll") for (int _i = 0; _i < 2; ++_i) \
        __builtin_amdgcn_global_load_lds((const unsigned*)((const char*)(gbase) + (voff)[_i]), (PG8_LAS unsigned*)(lds + (bufoff) + ldsw + _i * 8192), 16, 0, 0); } while (0)
#define PG8_LDA(dst, b, h) do { _Pragma("unroll") for (int m = 0; m < 4; ++m) _Pragma("unroll") for (int k = 0; k < 2; ++k) dst[m][k] = *(const PG8_LAS bf16x8*)(lds + PG8_SA(b, h) + aoff + m * 2048 + k * 1024); } while (0)
#define PG8_LDB(dst, b, h) do { _Pragma("unroll") for (int n = 0; n < 2; ++n) _Pragma("unroll") for (int k = 0; k < 2; ++k) dst[n][k] = *(const PG8_LAS bf16x8*)(lds + PG8_SB(b, h) + boff + n * 2048 + k * 1024); } while (0)
#define PG8_MMA(ai, bj, At, Bt) do { __builtin_amdgcn_s_setprio(1); _Pragma("unroll") for (int m = 0; m < 4; ++m) _Pragma("unroll") for (int n = 0; n < 2; ++n) _Pragma("unroll") for (int k = 0; k < 2; ++k) \
        acc[ai][bj][m][n] = __builtin_amdgcn_mfma_f32_16x16x32_bf16(Bt[n][k], At[m][k], acc[ai][bj][m][n], 0, 0, 0); __builtin_amdgcn_s_setprio(0); } while (0)
#define PG8_WAIT_V(n) asm volatile("s_waitcnt vmcnt(" #n ")" ::: "memory")
#define PG8_WAIT_L(n) asm volatile("s_waitcnt lgkmcnt(" #n ")" ::: "memory")
#define PG8_BAR __builtin_amdgcn_s_barrier()
#define PG8_SCHED __builtin_amdgcn_sched_barrier(0)
    Unit cur, nxt; int ui = 0;
    if (!S.next(0, cur)) return;
    f32x4 acc[2][2][4][2];
#pragma unroll
    for (int a = 0; a < 2; ++a)
#pragma unroll
        for (int b = 0; b < 2; ++b)
#pragma unroll
            for (int m = 0; m < 4; ++m)
#pragma unroll
                for (int n = 0; n < 2; ++n) acc[a][b][m][n] = (f32x4){0.f, 0.f, 0.f, 0.f};
    bf16x8 At[4][2], B0[2][2], B1[2][2];
    const char* cA = (const char*)g.A + (size_t)cur.pm * tstep; const char* cB = (const char*)g.Bt + (size_t)cur.pn * tstep;
    S.a_ready(cur);
    if constexpr (SP2) {
        PG8_STAGE(PG8_SB(0, 0), cB, voffB); PG8_STAGE(PG8_SB(0, 1), cB + hstep, voffB); PG8_STAGE(PG8_SA(0, 0), cA, voffA); PG8_STAGE(PG8_SA(0, 1), cA + hstep, voffA);
        if (wr == 1) PG8_BAR;
        PG8_WAIT_V(2); PG8_BAR;
        PG8_STAGE(PG8_SB(1, 0), cB + kstep, voffB); PG8_STAGE(PG8_SA(1, 0), cA + kstep, voffA); PG8_STAGE(PG8_SB(1, 1), cB + hstep + kstep, voffB);
        PG8_WAIT_V(6); PG8_BAR;
    } else {
        PG8_STAGE(PG8_SB(0, 0), cB, voffB); PG8_STAGE(PG8_SA(0, 0), cA, voffA); PG8_STAGE(PG8_SB(0, 1), cB + hstep, voffB); PG8_STAGE(PG8_SA(0, 1), cA + hstep, voffA);
        if (wr == 1) PG8_BAR;
        PG8_WAIT_V(4); PG8_BAR;
        PG8_STAGE(PG8_SB(1, 0), cB + kstep, voffB); PG8_STAGE(PG8_SA(1, 0), cA + kstep, voffA); PG8_STAGE(PG8_SB(1, 1), cB + hstep + kstep, voffB);
        PG8_WAIT_V(6); PG8_BAR;
    }
    for (;;) {
        const bool has_next = S.next(ui + 1, nxt);
        const char* nA = has_next ? (const char*)g.A + (size_t)nxt.pm * tstep : cA; const char* nB = has_next ? (const char*)g.Bt + (size_t)nxt.pn * tstep : cB;
        for (int t = 0; t < nt; t += 2) {
            const bool last = (t == nt - 2);
            const char* a1 = cA + (size_t)(t + 1) * kstep;
            const char* a2 = last ? nA : cA + (size_t)(t + 2) * kstep; const char* b2 = last ? nB : cB + (size_t)(t + 2) * kstep;
            const char* a3 = a2 + kstep; const char* b3 = b2 + kstep;
            if (last && has_next) S.a_ready(nxt);
            if constexpr (SP2) {
            PG8_LDB(B0, 0, 0); PG8_LDB(B1, 0, 1); PG8_SCHED; PG8_LDA(At, 0, 0); PG8_STAGE(PG8_SA(1, 1), a1 + hstep, voffA);
            PG8_WAIT_V(8); PG8_WAIT_L(0); PG8_BAR; PG8_MMA(0, 0, At, B0); PG8_MMA(0, 1, At, B1); PG8_BAR; PG8_SCHED;
            PG8_LDA(At, 0, 1); PG8_STAGE(PG8_SB(0, 0), b2, voffB); PG8_STAGE(PG8_SB(0, 1), b2 + hstep, voffB); PG8_STAGE(PG8_SA(0, 0), a2, voffA);
            PG8_WAIT_V(8); PG8_WAIT_L(0); PG8_BAR; PG8_MMA(1, 0, At, B0); PG8_MMA(1, 1, At, B1); PG8_BAR; PG8_SCHED;
            PG8_LDB(B0, 1, 0); PG8_LDB(B1, 1, 1); PG8_SCHED; PG8_LDA(At, 1, 0); PG8_STAGE(PG8_SA(0, 1), a2 + hstep, voffA);
            PG8_WAIT_V(8); PG8_WAIT_L(0); PG8_BAR; PG8_MMA(0, 0, At, B0); PG8_MMA(0, 1, At, B1); PG8_BAR; PG8_SCHED;
            PG8_LDA(At, 1, 1); PG8_STAGE(PG8_SB(1, 0), b3, voffB); PG8_STAGE(PG8_SB(1, 1), b3 + hstep, voffB); PG8_STAGE(PG8_SA(1, 0), a3, voffA);
            PG8_WAIT_V(8); PG8_WAIT_L(0); PG8_BAR; PG8_MMA(1, 0, At, B0); PG8_MMA(1, 1, At, B1); PG8_BAR; PG8_SCHED;
            } else {
            PG8_LDB(B0, 0, 0); PG8_SCHED; PG8_LDA(At, 0, 0); PG8_STAGE(PG8_SA(1, 1), a1 + hstep, voffA);
            PG8_WAIT_L(8); PG8_BAR; PG8_WAIT_L(0); PG8_MMA(0, 0, At, B0); PG8_BAR; PG8_SCHED;
            PG8_LDB(B1, 0, 1); PG8_STAGE(PG8_SB(0, 0), b2, voffB);
            PG8_BAR; PG8_WAIT_L(0); PG8_MMA(0, 1, At, B1); PG8_BAR;
            PG8_LDA(At, 0, 1); PG8_STAGE(PG8_SA(0, 0), a2, voffA);
            PG8_BAR; PG8_WAIT_L(0); PG8_MMA(1, 0, At, B0); PG8_BAR; PG8_SCHED;
            PG8_STAGE(PG8_SB(0, 1), b2 + hstep, voffB);
            PG8_WAIT_V(6); PG8_BAR; PG8_MMA(1, 1, At, B1); PG8_BAR;
            PG8_LDB(B0, 1, 0); PG8_SCHED; PG8_LDA(At, 1, 0); PG8_STAGE(PG8_SA(0, 1), a2 + hstep, voffA);
            PG8_WAIT_L(8); PG8_BAR; PG8_WAIT_L(0); PG8_MMA(0, 0, At, B0); PG8_BAR; PG8_SCHED;
            PG8_LDB(B1, 1, 1); PG8_STAGE(PG8_SB(1, 0), b3, voffB);
            PG8_BAR; PG8_WAIT_L(0); PG8_MMA(0, 1, At, B1); PG8_BAR;
            PG8_LDA(At, 1, 1); PG8_STAGE(PG8_SA(1, 0), a3, voffA);
            PG8_BAR; PG8_WAIT_L(0); PG8_MMA(1, 0, At, B0); PG8_BAR; PG8_SCHED;
            PG8_STAGE(PG8_SB(1, 1), b3 + hstep, voffB);
            PG8_WAIT_V(6); PG8_BAR; PG8_MMA(1, 1, At, B1); PG8_BAR;
            }
        }
        if constexpr (ALIGN_EPI) { if (wr == 0) PG8_BAR; }
        if constexpr (!Epi::AFTER_DRAIN) { E(acc, cur, wr, wc, fr, fq); S.done(cur); }
        if (!has_next) break;
#pragma unroll
        for (int a = 0; a < 2; ++a)
#pragma unroll
            for (int b = 0; b < 2; ++b)
#pragma unroll
                for (int m = 0; m < 4; ++m)
#pragma unroll
                    for (int n = 0; n < 2; ++n) acc[a][b][m][n] = (f32x4){0.f, 0.f, 0.f, 0.f};
        cur = nxt; cA = nA; cB = nB; ++ui;
        if constexpr (ALIGN_EPI) { if (wr == 1) PG8_BAR; }
    }
    PG8_WAIT_V(0);
    if constexpr (!ALIGN_EPI) { if (wr == 0) PG8_BAR; }
    PG8_BAR;
    if constexpr (Epi::AFTER_DRAIN) { E.fused(acc, cur, wr, wc, fr, fq, lds, wid, lane); S.done(cur); }
#undef PG8_SA
#undef PG8_SB
#undef PG8_STAGE
#undef PG8_LDA
#undef PG8_LDB
#undef PG8_MMA
#undef PG8_WAIT_V
#undef PG8_WAIT_L
#undef PG8_BAR
#undef PG8_SCHED
}
}

#ifndef PG8_SP2
#define PG8_SP2 true
#endif
#ifndef PG8_ALIGN
#define PG8_ALIGN true
#endif
#include <hip/hip_bf16.h>
#include <cmath>
namespace attn_body {
using bf16=__hip_bfloat16;
using bf16x8=__attribute__((ext_vector_type(8)))short;
using s16x4=__attribute__((ext_vector_type(4)))short;
using f32x16=__attribute__((ext_vector_type(16)))float;
using u32x4=__attribute__((ext_vector_type(4)))unsigned;
constexpr int SEQ=8192,D=64,PQ=512,PO=1024;
constexpr int NW=8,QBLK=32,QB=QBLK*NW,KVBLK=64,NQB=SEQ/QB;
constexpr int ATTN_UNIT_ROWS=QB;
__device__ __forceinline__ int crow(int r,int hi){return (r&3)+8*(r>>2)+4*hi;}
#define SBAR() __builtin_amdgcn_sched_barrier(0)
__device__ __forceinline__ void cmask(f32x16&p0,f32x16&p1,int jb,int qrel,int hi){
  const float NEG=-INFINITY; int kb=64*jb+4*hi;
  #pragma unroll
  for(int r=0;r<16;++r){int kv=kb+(r&3)+8*(r>>2); if(kv>qrel)p0[r]=NEG; if(kv+32>qrel)p1[r]=NEG;}
}

constexpr int NSLOT=3, SLOTB=8192;
constexpr int LDS_K=0, LDS_V=NSLOT*SLOTB, LDS_WS=2*NSLOT*SLOTB, LDS_OST=LDS_WS+NW*64*4, LDS_BYTES=LDS_OST+NW*4096;
constexpr float C2=0.125f*1.4426950408889634f;
__device__ __forceinline__ void glds16(const void*gsrc,unsigned lds_dst){unsigned keep;
  asm volatile("s_mov_b32 %0, m0\n\ts_mov_b32 m0, %2\n\ts_nop 0\n\tglobal_load_lds_dwordx4 %1, off\n\ts_mov_b32 m0, %0":"=&s"(keep):"v"(gsrc),"s"(lds_dst):"memory");}
__device__ __forceinline__ float max3f(float a,float b,float c){float r;asm("v_max3_f32 %0, %1, %2, %3":"=v"(r):"v"(a),"v"(b),"v"(c));return r;}
__device__ __forceinline__ float max2f(float a,float b){float r;asm("v_max_f32_e32 %0, %1, %2":"=v"(r):"v"(a),"v"(b));return r;}
__device__ __forceinline__ float fadd_s(float a,float b){float r;asm("v_add_f32_e32 %0, %1, %2":"=v"(r):"v"(a),"v"(b));return r;}
__device__ __forceinline__ float fsub_s(float a,float b){float r;asm("v_sub_f32_e32 %0, %1, %2":"=v"(r):"v"(a),"v"(b));return r;}
typedef float f32x2_t __attribute__((ext_vector_type(2))); typedef __bf16 bf16x2_t __attribute__((ext_vector_type(2)));
__device__ __forceinline__ unsigned cvtpk_s(float lo,float hi){f32x2_t v={lo,hi};bf16x2_t b=__builtin_convertvector(v,bf16x2_t);return __builtin_bit_cast(unsigned,b);}
#define WAIT_BAR(N) asm volatile("s_waitcnt vmcnt(" #N ") lgkmcnt(0)\n\ts_barrier":::"memory")

__device__ __forceinline__ void qkt(f32x16&p0,f32x16&p1,const char*Kslot,const bf16x8*qr,const f32x16&negm,int r32,int hi){
  const char*kb=Kslot+hi*1024+r32*16;
  #pragma unroll
  for(int d0=0;d0<4;++d0){
    const bf16x8 b0=*reinterpret_cast<const bf16x8*>(kb+d0*2048);
    const bf16x8 b1=*reinterpret_cast<const bf16x8*>(kb+d0*2048+512);
    if(d0==0){p0=__builtin_amdgcn_mfma_f32_32x32x16_bf16(b0,qr[0],negm,0,0,0);p1=__builtin_amdgcn_mfma_f32_32x32x16_bf16(b1,qr[0],negm,0,0,0);}
    else{p0=__builtin_amdgcn_mfma_f32_32x32x16_bf16(b0,qr[d0],p0,0,0,0);p1=__builtin_amdgcn_mfma_f32_32x32x16_bf16(b1,qr[d0],p1,0,0,0);}}
}
typedef __attribute__((address_space(3))) const char* lds_cptr;
typedef short v4i16_t __attribute__((ext_vector_type(4)));
__device__ __forceinline__ void kload8(bf16x8*kf,lds_cptr kp){
  kf[0]=*(const __attribute__((address_space(3))) bf16x8*)(kp);      kf[1]=*(const __attribute__((address_space(3))) bf16x8*)(kp+512);
  kf[2]=*(const __attribute__((address_space(3))) bf16x8*)(kp+2048); kf[3]=*(const __attribute__((address_space(3))) bf16x8*)(kp+2560);
  kf[4]=*(const __attribute__((address_space(3))) bf16x8*)(kp+4096); kf[5]=*(const __attribute__((address_space(3))) bf16x8*)(kp+4608);
  kf[6]=*(const __attribute__((address_space(3))) bf16x8*)(kp+6144); kf[7]=*(const __attribute__((address_space(3))) bf16x8*)(kp+6656);
}
__device__ __forceinline__ void kload2(bf16x8*kf,lds_cptr kp,int j){ kf[2*j]=*(const __attribute__((address_space(3))) bf16x8*)(kp+j*2048); kf[2*j+1]=*(const __attribute__((address_space(3))) bf16x8*)(kp+j*2048+512); }
__device__ __forceinline__ s16x4 vtr(lds_cptr p){ return __builtin_bit_cast(s16x4,__builtin_amdgcn_ds_read_tr16_b64_v4i16((__attribute__((address_space(3))) v4i16_t*)p)); }
__device__ __forceinline__ float rowmax(const f32x16&p0,const f32x16&p1){
  float a=max3f(p0[0],p0[1],p1[0]),b=max3f(p0[2],p0[3],p1[1]);a=max3f(a,p1[2],p1[3]);
  #pragma unroll
  for(int r=4;r<16;r+=4){a=max3f(a,p0[r],p0[r+1]);b=max3f(b,p0[r+2],p0[r+3]);a=max3f(a,p1[r],p1[r+1]);b=max3f(b,p1[r+2],p1[r+3]);}
  const float m=max2f(a,b);
  auto rr=__builtin_amdgcn_permlane32_swap(__float_as_uint(m),__float_as_uint(m),false,false);
  return max2f(__uint_as_float(rr[0]),__uint_as_float(rr[1]));
}
__device__ __forceinline__ void pv(f32x16*o,int vb,bf16x8 pa0,bf16x8 pa1,bf16x8 pa2,bf16x8 pa3){
  #pragma unroll
  for(int d0=0;d0<2;++d0){s16x4 lo[4],hi[4];
    #pragma unroll
    for(int ks=0;ks<4;++ks){
      asm volatile("ds_read_b64_tr_b16 %0,%1 offset:%c2":"=&v"(lo[ks]):"v"(vb),"i"(d0*4096+ks*1024):"memory");
      asm volatile("ds_read_b64_tr_b16 %0,%1 offset:%c2":"=&v"(hi[ks]):"v"(vb),"i"(d0*4096+ks*1024+512):"memory");}
    asm volatile("s_waitcnt lgkmcnt(0)":::"memory");SBAR();
    #define PK(k) (bf16x8){lo[k][0],lo[k][1],lo[k][2],lo[k][3],hi[k][0],hi[k][1],hi[k][2],hi[k][3]}
    o[d0]=__builtin_amdgcn_mfma_f32_32x32x16_bf16(pa0,PK(0),o[d0],0,0,0);
    o[d0]=__builtin_amdgcn_mfma_f32_32x32x16_bf16(pa1,PK(1),o[d0],0,0,0);
    o[d0]=__builtin_amdgcn_mfma_f32_32x32x16_bf16(pa2,PK(2),o[d0],0,0,0);
    o[d0]=__builtin_amdgcn_mfma_f32_32x32x16_bf16(pa3,PK(3),o[d0],0,0,0);
    #undef PK
  }
}

#ifndef ATTN_STORE16
#define ATTN_STORE16(p,v) (*(u32x4*)(p)=(v))
#endif
template<int THRL> __device__ __forceinline__ void attn_unit(int q0,const bf16*Qu,const bf16*__restrict__ Kh,const bf16*__restrict__ Vh,bf16*Ou,char*shm){
  int tid_=threadIdx.x; asm volatile("":"+v"(tid_)); const int tid=tid_,lane=tid&63,r32=lane&31,hi=lane>>5; const int wid=__builtin_amdgcn_readfirstlane(tid>>6);
  const bf16*Qw=Qu+(long)(wid*QBLK)*PQ;
  const unsigned lds0=(unsigned)(uintptr_t)shm;
  float*wsf=(float*)(shm+LDS_WS)+wid*64;
  const bf16*ksrc=Kh+(long)lane*PQ+wid*8;
  const bf16*vsrc=Vh+(long)(16*(wid&3)+(lane>>2))*PQ+(wid>>2)*32+(lane&3)*8;
  const unsigned kdst=lds0+LDS_K+wid*1024, vdst=lds0+LDS_V+wid*1024;
  #define DMA_K(t,slot) glds16(ksrc+(long)(t)*KVBLK*PQ,(unsigned)__builtin_amdgcn_readfirstlane(kdst+(slot)))
  #define DMA_V(t,slot) glds16(vsrc+(long)(t)*KVBLK*PQ,(unsigned)__builtin_amdgcn_readfirstlane(vdst+(slot)))
  const int vb0=(int)(lds0+LDS_V)+((lane>>4)&1)*32+(lane&3)*8+(4*hi+((lane&15)>>2))*64;
  const char*Kbase=shm+LDS_K; bf16x8 kf[8];
  const lds_cptr shm3=(lds_cptr)shm; const lds_cptr kp0=shm3+LDS_K+hi*1024+r32*16; const lds_cptr vp0=shm3+LDS_V+((lane>>4)&1)*32+(lane&3)*8+(4*hi+((lane&15)>>2))*64;
  const int NT=(q0+QB)/KVBLK+1;
  DMA_K(0,0);DMA_V(0,0);DMA_K(1,SLOTB);
  bf16x8 qr[4];
  #pragma unroll
  for(int d0=0;d0<4;++d0)qr[d0]=*reinterpret_cast<const bf16x8*>(&Qw[(long)r32*PQ+d0*16+hi*8]);
  float mhat=0.f,l_reg=0.f;f32x16 o[2];o[0]=f32x16{};o[1]=f32x16{};f32x16 negm=f32x16{};asm volatile("":"+v"(negm));
  const int qrel=wid*QBLK+r32;
  #define CMASK(P0,P1,t) do{int jb_=(t)-(NT-4); if(jb_>=0)cmask(P0,P1,jb_,qrel,hi);}while(0)
  bool resc=false;
  #define START(P0,P1) do{ const float rm=rowmax(P0,P1); resc=false; \
    { const float dl=rm; mhat=fadd_s(mhat,dl); \
      _Pragma("unroll") for(int r=0;r<16;++r){P0[r]=fsub_s(P0[r],dl);P1[r]=fsub_s(P1[r],dl);} \
      _Pragma("unroll") for(int r=0;r<16;++r)negm[r]=-mhat; asm volatile("":"+v"(negm)); } \
    _Pragma("unroll") for(int r=0;r<16;++r)P0[r]=__builtin_amdgcn_exp2f(P0[r]); }while(0)
  #define RESC() do{ if(resc){ asm volatile("s_waitcnt lgkmcnt(0)":::"memory"); \
      _Pragma("unroll") for(int d_=0;d_<2;++d_) _Pragma("unroll") for(int r=0;r<16;++r)o[d_][r]*=wsf[crow(r,hi)]; } }while(0)
  f32x16 pA0,pA1,pB0,pB1;
  int sl_prev=0,sl_cur=0,sl_next=SLOTB;
  #define ROT() do{sl_prev=sl_cur;sl_cur=sl_next;sl_next=(sl_next==(NSLOT-1)*SLOTB)?0:sl_next+SLOTB;}while(0)
  DMA_K(2,2*SLOTB);
  WAIT_BAR(3);
  qkt(pA0,pA1,Kbase,qr,negm,r32,hi);asm volatile("s_nop 15\n\ts_nop 7":"+v"(pA0),"+v"(pA1));
  { const float NEGI=-INFINITY; _Pragma("unroll") for(int r=8;r<16;++r)pA0[r]=NEGI; _Pragma("unroll") for(int r=0;r<16;++r)pA1[r]=NEGI; }
  START(pA0,pA1);
  _Pragma("unroll") for(int r=0;r<16;++r)pA1[r]=__builtin_amdgcn_exp2f(pA1[r]);
  WAIT_BAR(0);
  DMA_K(3,0);DMA_V(1,SLOTB);
  ROT();
  kload8(kf,kp0+sl_cur);
  WAIT_BAR(2);
  s16x4 vlo[8],vhi[8]; u32x4 pw0,pw1,pw2,pw3;
  #define PKW(P,B) cvtpk_s(P[B],P[B+1])
  #define PAF(k) __builtin_bit_cast(bf16x8,pw##k)
  #define VFR(i) (bf16x8){vlo[i][0],vlo[i][1],vlo[i][2],vlo[i][3],vhi[i][0],vhi[i][1],vhi[i][2],vhi[i][3]}
  #define PIN(x) asm volatile("":"+v"(x))
  #define MX3(a,b,c) __builtin_fmaxf(__builtin_fmaxf((a),(b)),(c))
  #define GAPA(MF,A0,A1,A2,A3,W0,W1,PW) do{ MF; sacc+=A0; sacc+=A1; sacc+=A2; sacc+=A3; PIN(sacc); W0; W1; PIN(PW); SBAR(); }while(0)
  #define EX(v) __builtin_amdgcn_exp2f(v)
  #define GAPB(MF,X,B) do{ MF; X[B]=EX(X[B]); X[B+1]=EX(X[B+1]); X[B+2]=EX(X[B+2]); X[B+3]=EX(X[B+3]); PIN(X); SBAR(); }while(0)
  #define VRD(i) do{ vlo[i]=vtr(vp_+(((i)>>2)*4096+((i)&3)*1024)); vhi[i]=vtr(vp_+(((i)>>2)*4096+((i)&3)*1024+512)); }while(0)
  #define KRD(G,j) do{ if(G){ kload2(kf,kp0+sl_next,j); SBAR(); } }while(0)
  #define STEP(C0,C1,P0,P1,t,GK,GV,GL) do{ SBAR(); \
    const lds_cptr vp_=vp0+sl_prev; \
    VRD(0); SBAR(); float sacc=(P0[0]+P0[1]); \
    GAPA(C0=__builtin_amdgcn_mfma_f32_32x32x16_bf16(kf[0],qr[0],negm,0,0,0), P0[2],P0[3],P0[4],P0[5],     pw0[0]=PKW(P0,0), pw0[1]=PKW(P0,2), pw0); \
    VRD(4); SBAR(); GAPA(C1=__builtin_amdgcn_mfma_f32_32x32x16_bf16(kf[1],qr[0],negm,0,0,0), P0[6],P0[7],P0[8],P0[9],     pw0[2]=PKW(P0,4), pw0[3]=PKW(P0,6), pw0); \
    VRD(1); SBAR(); GAPA(C0=__builtin_amdgcn_mfma_f32_32x32x16_bf16(kf[2],qr[1],C0,0,0,0),   P0[10],P0[11],P0[12],P0[13], pw1[0]=PKW(P0,8), pw1[1]=PKW(P0,10), pw1); \
    VRD(5); SBAR(); GAPA(C1=__builtin_amdgcn_mfma_f32_32x32x16_bf16(kf[3],qr[1],C1,0,0,0),   P0[14],P0[15],P1[0],P1[1],   pw1[2]=PKW(P0,12),pw1[3]=PKW(P0,14), pw1); \
    VRD(2); SBAR(); GAPA(C0=__builtin_amdgcn_mfma_f32_32x32x16_bf16(kf[4],qr[2],C0,0,0,0),   P1[2],P1[3],P1[4],P1[5],     pw2[0]=PKW(P1,0), pw2[1]=PKW(P1,2), pw2); \
    VRD(6); SBAR(); GAPA(C1=__builtin_amdgcn_mfma_f32_32x32x16_bf16(kf[5],qr[2],C1,0,0,0),   P1[6],P1[7],P1[8],P1[9],     pw2[2]=PKW(P1,4), pw2[3]=PKW(P1,6), pw2); \
    VRD(3); SBAR(); GAPA(C0=__builtin_amdgcn_mfma_f32_32x32x16_bf16(kf[6],qr[3],C0,0,0,0),   P1[10],P1[11],P1[12],P1[13], pw3[0]=PKW(P1,8), pw3[1]=PKW(P1,10), pw3); \
    VRD(7); SBAR(); GAPA(C1=__builtin_amdgcn_mfma_f32_32x32x16_bf16(kf[7],qr[3],C1,0,0,0),   P1[14],P1[15],0.f,0.f,       pw3[2]=PKW(P1,12),pw3[3]=PKW(P1,14), pw3); \
    l_reg+=sacc; \
    if(GK){DMA_K((t)+3,sl_cur);} if(GV){DMA_V((t)+1,sl_next);} \
    CMASK(C0,C1,t); \
    { float a=MX3(C0[0],C0[1],C1[0]),b=MX3(C0[2],C0[3],C1[1]); a=MX3(a,C1[2],C1[3]); \
      _Pragma("unroll") for(int r=4;r<16;r+=4){a=MX3(a,C0[r],C0[r+1]);b=MX3(b,C0[r+2],C0[r+3]);a=MX3(a,C1[r],C1[r+1]);b=MX3(b,C1[r+2],C1[r+3]);} \
      float rm=__builtin_fmaxf(a,b); { auto rr=__builtin_amdgcn_permlane32_swap(__float_as_uint(rm),__float_as_uint(rm),false,false); rm=__builtin_fmaxf(__uint_as_float(rr[0]),__uint_as_float(rr[1])); } \
      resc=false; \
      if(__builtin_expect(__any(rm>(float)THRL),0)){ const float dl=__builtin_fmaxf(rm,0.f); mhat+=dl; \
        _Pragma("unroll") for(int r=0;r<16;++r){C0[r]-=dl;C1[r]-=dl;} \
        _Pragma("unroll") for(int r=0;r<16;++r)negm[r]=-mhat; asm volatile("":"+v"(negm)); \
        const float f=__builtin_amdgcn_exp2f(-dl); l_reg*=f; if(hi==0)wsf[r32]=f; resc=true; } } \
    SBAR(); \
    GAPB(o[0]=__builtin_amdgcn_mfma_f32_32x32x16_bf16(PAF(0),VFR(0),o[0],0,0,0), C0,0); \
    GAPB(o[1]=__builtin_amdgcn_mfma_f32_32x32x16_bf16(PAF(0),VFR(4),o[1],0,0,0), C0,4); \
    KRD(GL,0); GAPB(o[0]=__builtin_amdgcn_mfma_f32_32x32x16_bf16(PAF(1),VFR(1),o[0],0,0,0), C0,8); \
    KRD(GL,1); GAPB(o[1]=__builtin_amdgcn_mfma_f32_32x32x16_bf16(PAF(1),VFR(5),o[1],0,0,0), C0,12); \
    KRD(GL,2); GAPB(o[0]=__builtin_amdgcn_mfma_f32_32x32x16_bf16(PAF(2),VFR(2),o[0],0,0,0), C1,0); \
    KRD(GL,3); GAPB(o[1]=__builtin_amdgcn_mfma_f32_32x32x16_bf16(PAF(2),VFR(6),o[1],0,0,0), C1,4); \
    GAPB(o[0]=__builtin_amdgcn_mfma_f32_32x32x16_bf16(PAF(3),VFR(3),o[0],0,0,0), C1,8); \
    GAPB(o[1]=__builtin_amdgcn_mfma_f32_32x32x16_bf16(PAF(3),VFR(7),o[1],0,0,0), C1,12); \
    }while(0)
  int t=1;
  #undef CMASK
  #define CMASK(P0,P1,t) do{}while(0)
  for(;t+5<NT;t+=2){
    STEP(pB0,pB1,pA0,pA1,t,true,true,true);     WAIT_BAR(2); RESC(); ROT();
    STEP(pA0,pA1,pB0,pB1,t+1,true,true,true);   WAIT_BAR(2); RESC(); ROT();
  }
  #undef CMASK
  #define CMASK(P0,P1,t) do{int jb_=(t)-(NT-4); if(jb_>=0)cmask(P0,P1,jb_,qrel,hi);}while(0)
  #define ENDW(tt) do{ if((tt)+3<NT){WAIT_BAR(2);} else if((tt)+2<NT){WAIT_BAR(1);} else {WAIT_BAR(0);} }while(0)
  for(;t+1<NT;t+=2){
    STEP(pB0,pB1,pA0,pA1,t,(t+3<NT),(t+1<NT),(t+1<NT));       ENDW(t);   RESC(); ROT();
    STEP(pA0,pA1,pB0,pB1,t+1,(t+4<NT),(t+2<NT),(t+2<NT));     ENDW(t+1); RESC(); ROT();
  }
  { float sacc=pA0[0]+pA0[1]; _Pragma("unroll") for(int r=2;r<16;++r)sacc+=pA0[r]; _Pragma("unroll") for(int r=0;r<16;++r)sacc+=pA1[r]; l_reg+=sacc;
    pw0=(u32x4){PKW(pA0,0),PKW(pA0,2),PKW(pA0,4),PKW(pA0,6)};pw1=(u32x4){PKW(pA0,8),PKW(pA0,10),PKW(pA0,12),PKW(pA0,14)};pw2=(u32x4){PKW(pA1,0),PKW(pA1,2),PKW(pA1,4),PKW(pA1,6)};pw3=(u32x4){PKW(pA1,8),PKW(pA1,10),PKW(pA1,12),PKW(pA1,14)};
    SBAR(); pv(o,vb0+sl_prev,PAF(0),PAF(1),PAF(2),PAF(3)); }
  #undef PKW
  #undef PAF
  #undef VFR
  #undef PIN
  #undef MX3
  #undef GAPA
  #undef GAPB
  #undef EX
  #undef VRD
  #undef KRD
  #undef STEP
  #undef ENDW
  {auto rr=__builtin_amdgcn_permlane32_swap(__float_as_uint(l_reg),__float_as_uint(l_reg),false,false);l_reg=__uint_as_float(rr[0])+__uint_as_float(rr[1]);}
  if(hi==0)wsf[32+r32]=l_reg;asm volatile("s_waitcnt lgkmcnt(0)":::"memory");
  float rli[16];
  #pragma unroll
  for(int r=0;r<16;++r)rli[r]=__builtin_amdgcn_rcpf(wsf[32+crow(r,hi)]);
  bf16*Ow=Ou+(long)(wid*QBLK)*PO;
  { bf16*stg=(bf16*)(shm+LDS_OST)+wid*2048;
    #pragma unroll
    for(int r=0;r<16;++r){const int orow=crow(r,hi);
      #pragma unroll
      for(int d0=0;d0<2;++d0)stg[orow*64+d0*32+r32]=__float2bfloat16(o[d0][r]*rli[r]);}
    asm volatile("s_waitcnt lgkmcnt(0)":::"memory");
    #pragma unroll
    for(int i=0;i<4;++i){const int row=i*8+(lane>>3),ch=lane&7; const u32x4 v=*(const u32x4*)(stg+row*64+ch*8); ATTN_STORE16(Ow+(long)row*PO+ch*8,v);} }
  asm volatile("s_waitcnt lgkmcnt(0)\n\ts_barrier":::"memory");
  #undef DMA_K
  #undef DMA_V
  #undef CMASK
  #undef START
  #undef RESC
  #undef ROT
}
constexpr int ATTN_LDS_BYTES=LDS_BYTES;
#undef SBAR
#undef WAIT_BAR
typedef float f32x4v __attribute__((ext_vector_type(4)));
constexpr int V2_SLOTV=16384, V2_LDS_K=0, V2_LDS_V=NSLOT*SLOTB, V2_LDS_WS=V2_LDS_V+NSLOT*V2_SLOTV, V2_LDS_OST=V2_LDS_WS+NW*64*4, V2_LDS_BYTES=V2_LDS_OST+NW*8192;
#define SBAR() __builtin_amdgcn_sched_barrier(0)
#define WAIT_BAR(N) asm volatile("s_waitcnt vmcnt(" #N ") lgkmcnt(0)\n\ts_barrier":::"memory")
__device__ __forceinline__ void pv4(f32x16*o,int vb,bf16x8 pa0,bf16x8 pa1,bf16x8 pa2,bf16x8 pa3){
  #pragma unroll
  for(int d0=0;d0<4;++d0){s16x4 lo[4],hi[4];
    #pragma unroll
    for(int ks=0;ks<4;++ks){
      asm volatile("ds_read_b64_tr_b16 %0,%1 offset:%c2":"=&v"(lo[ks]):"v"(vb),"i"(d0*4096+ks*1024):"memory");
      asm volatile("ds_read_b64_tr_b16 %0,%1 offset:%c2":"=&v"(hi[ks]):"v"(vb),"i"(d0*4096+ks*1024+512):"memory");}
    asm volatile("s_waitcnt lgkmcnt(0)":::"memory");SBAR();
    #define PK(k) (bf16x8){lo[k][0],lo[k][1],lo[k][2],lo[k][3],hi[k][0],hi[k][1],hi[k][2],hi[k][3]}
    o[d0]=__builtin_amdgcn_mfma_f32_32x32x16_bf16(pa0,PK(0),o[d0],0,0,0);
    o[d0]=__builtin_amdgcn_mfma_f32_32x32x16_bf16(pa1,PK(1),o[d0],0,0,0);
    o[d0]=__builtin_amdgcn_mfma_f32_32x32x16_bf16(pa2,PK(2),o[d0],0,0,0);
    o[d0]=__builtin_amdgcn_mfma_f32_32x32x16_bf16(pa3,PK(3),o[d0],0,0,0);
    #undef PK
  }
}
template<int MODE> __device__ __forceinline__ void attn_unit128(int q0,const bf16*Qu,const bf16*__restrict__ Kh,const bf16*__restrict__ Vh,bf16*Ou,char*shm,float lam,float oscale,const float*subg){
  int tid_=threadIdx.x; asm volatile("":"+v"(tid_)); const int tid=tid_,lane=tid&63,r32=lane&31,hi=lane>>5; const int wid=__builtin_amdgcn_readfirstlane(tid>>6);
  const bf16*Qw=Qu+(long)(wid*QBLK)*PQ;
  const unsigned lds0=(unsigned)(uintptr_t)shm;
  float*wsf=(float*)(shm+V2_LDS_WS)+wid*64;
  const bf16*ksrc=Kh+(long)lane*PQ+wid*8;
  const bf16*vsrc=Vh+(long)(16*(wid&3)+(lane>>2))*PQ+(wid>>2)*32+(lane&3)*8;
  const unsigned kdst=lds0+V2_LDS_K+wid*1024, vdst=lds0+V2_LDS_V+wid*1024;
  #define DMA_K(t,slot) glds16(ksrc+(long)(t)*KVBLK*PQ,(unsigned)__builtin_amdgcn_readfirstlane(kdst+(slot)))
  #define DMA_V(t,slot) do{ glds16(vsrc+(long)(t)*KVBLK*PQ,(unsigned)__builtin_amdgcn_readfirstlane(vdst+2*(slot))); glds16(vsrc+(long)(t)*KVBLK*PQ+64,(unsigned)__builtin_amdgcn_readfirstlane(vdst+2*(slot)+8192)); }while(0)
  const int vb0=(int)(lds0+V2_LDS_V)+((lane>>4)&1)*32+(lane&3)*8+(4*hi+((lane&15)>>2))*64;
  const char*Kbase=shm+V2_LDS_K; bf16x8 kf[8];
  const lds_cptr shm3=(lds_cptr)shm; const lds_cptr kp0=shm3+V2_LDS_K+hi*1024+r32*16; const lds_cptr vp0=shm3+V2_LDS_V+((lane>>4)&1)*32+(lane&3)*8+(4*hi+((lane&15)>>2))*64;
  const int NT=(q0+QB)/KVBLK+1;
  DMA_K(0,0);DMA_V(0,0);DMA_K(1,SLOTB);
  bf16x8 qr[4];
  #pragma unroll
  for(int d0=0;d0<4;++d0)qr[d0]=*reinterpret_cast<const bf16x8*>(&Qw[(long)r32*PQ+d0*16+hi*8]);
  float l_reg=0.f;f32x16 o[4];o[0]=f32x16{};o[1]=f32x16{};o[2]=f32x16{};o[3]=f32x16{};
  const f32x16 zero16=f32x16{};
  const int qrel=wid*QBLK+r32;
  #define CMASK(P0,P1,t) do{int jb_=(t)-(NT-4); if(jb_>=0)cmask(P0,P1,jb_,qrel,hi);}while(0)
  f32x16 pA0,pA1,pB0,pB1;
  int sl_prev=0,sl_cur=0,sl_next=SLOTB;
  #define ROT() do{sl_prev=sl_cur;sl_cur=sl_next;sl_next=(sl_next==(NSLOT-1)*SLOTB)?0:sl_next+SLOTB;}while(0)
  DMA_K(2,2*SLOTB);
  WAIT_BAR(3);
  qkt(pA0,pA1,Kbase,qr,zero16,r32,hi);asm volatile("s_nop 15\n\ts_nop 7":"+v"(pA0),"+v"(pA1));
  { const float NEGI=-INFINITY; _Pragma("unroll") for(int r=8;r<16;++r)pA0[r]=NEGI; _Pragma("unroll") for(int r=0;r<16;++r)pA1[r]=NEGI; }
  _Pragma("unroll") for(int r=0;r<16;++r){pA0[r]=__builtin_amdgcn_exp2f(pA0[r]);pA1[r]=__builtin_amdgcn_exp2f(pA1[r]);}
  WAIT_BAR(0);
  DMA_K(3,0);DMA_V(1,SLOTB);
  ROT();
  kload8(kf,kp0+sl_cur);
  WAIT_BAR(3);
  s16x4 vlo[8],vhi[8]; u32x4 pw0,pw1,pw2,pw3;
  #define PKW(P,B) cvtpk_s(P[B],P[B+1])
  #define PAF(k) __builtin_bit_cast(bf16x8,pw##k)
  #define VFR(i) (bf16x8){vlo[i][0],vlo[i][1],vlo[i][2],vlo[i][3],vhi[i][0],vhi[i][1],vhi[i][2],vhi[i][3]}
  #define PIN(x) asm volatile("":"+v"(x))
  #define GAPA(MF,A0,A1,A2,A3,W0,W1,PW) do{ MF; sacc+=A0; sacc+=A1; sacc+=A2; sacc+=A3; PIN(sacc); W0; W1; PIN(PW); SBAR(); }while(0)
  #define EX(v) __builtin_amdgcn_exp2f(v)
  #define GAPB(MF,X,B) do{ MF; X[B]=EX(X[B]); X[B+1]=EX(X[B+1]); PIN(X); SBAR(); }while(0)
  #define VRD(i) do{ vlo[i]=vtr(vp_+(((i)>>2)*4096+((i)&3)*1024)); vhi[i]=vtr(vp_+(((i)>>2)*4096+((i)&3)*1024+512)); }while(0)
  #define VRD2(i) do{ vlo[i]=vtr(vp_+(8192+((i)>>2)*4096+((i)&3)*1024)); vhi[i]=vtr(vp_+(8192+((i)>>2)*4096+((i)&3)*1024+512)); SBAR(); }while(0)
  #define KRD(G,j) do{ if(G){ kload2(kf,kp0+sl_next,j); SBAR(); } }while(0)
  #define MF32(a,b,c) __builtin_amdgcn_mfma_f32_32x32x16_bf16(a,b,c,0,0,0)
  #define STEP(C0,C1,P0,P1,t,GK,GV,GL) do{ SBAR(); \
    const lds_cptr vp_=vp0+2*sl_prev; \
    VRD(0); SBAR(); float sacc=(P0[0]+P0[1]); \
    GAPA(C0=MF32(kf[0],qr[0],zero16), P0[2],P0[3],P0[4],P0[5],     pw0[0]=PKW(P0,0), pw0[1]=PKW(P0,2), pw0); \
    VRD(4); SBAR(); GAPA(C1=MF32(kf[1],qr[0],zero16), P0[6],P0[7],P0[8],P0[9],     pw0[2]=PKW(P0,4), pw0[3]=PKW(P0,6), pw0); \
    VRD(1); SBAR(); GAPA(C0=MF32(kf[2],qr[1],C0),   P0[10],P0[11],P0[12],P0[13], pw1[0]=PKW(P0,8), pw1[1]=PKW(P0,10), pw1); \
    VRD(5); SBAR(); GAPA(C1=MF32(kf[3],qr[1],C1),   P0[14],P0[15],P1[0],P1[1],   pw1[2]=PKW(P0,12),pw1[3]=PKW(P0,14), pw1); \
    VRD(2); SBAR(); GAPA(C0=MF32(kf[4],qr[2],C0),   P1[2],P1[3],P1[4],P1[5],     pw2[0]=PKW(P1,0), pw2[1]=PKW(P1,2), pw2); \
    VRD(6); SBAR(); GAPA(C1=MF32(kf[5],qr[2],C1),   P1[6],P1[7],P1[8],P1[9],     pw2[2]=PKW(P1,4), pw2[3]=PKW(P1,6), pw2); \
    VRD(3); SBAR(); GAPA(C0=MF32(kf[6],qr[3],C0),   P1[10],P1[11],P1[12],P1[13], pw3[0]=PKW(P1,8), pw3[1]=PKW(P1,10), pw3); \
    VRD(7); SBAR(); GAPA(C1=MF32(kf[7],qr[3],C1),   P1[14],P1[15],0.f,0.f,       pw3[2]=PKW(P1,12),pw3[3]=PKW(P1,14), pw3); \
    l_reg+=sacc; \
    if(GK){DMA_K((t)+3,sl_cur);} if(GV){DMA_V((t)+1,sl_next);} \
    CMASK(C0,C1,t); \
    SBAR(); \
    GAPB(o[0]=MF32(PAF(0),VFR(0),o[0]), C0,0);  VRD2(0); \
    GAPB(o[1]=MF32(PAF(0),VFR(4),o[1]), C0,2);  VRD2(4); \
    KRD(GL,0); GAPB(o[0]=MF32(PAF(1),VFR(1),o[0]), C0,4);  VRD2(1); \
    KRD(GL,1); GAPB(o[1]=MF32(PAF(1),VFR(5),o[1]), C0,6);  VRD2(5); \
    KRD(GL,2); GAPB(o[0]=MF32(PAF(2),VFR(2),o[0]), C0,8);  VRD2(2); \
    KRD(GL,3); GAPB(o[1]=MF32(PAF(2),VFR(6),o[1]), C0,10); VRD2(6); \
    GAPB(o[0]=MF32(PAF(3),VFR(3),o[0]), C0,12); VRD2(3); \
    GAPB(o[1]=MF32(PAF(3),VFR(7),o[1]), C0,14); VRD2(7); \
    GAPB(o[2]=MF32(PAF(0),VFR(0),o[2]), C1,0); \
    GAPB(o[3]=MF32(PAF(0),VFR(4),o[3]), C1,2); \
    GAPB(o[2]=MF32(PAF(1),VFR(1),o[2]), C1,4); \
    GAPB(o[3]=MF32(PAF(1),VFR(5),o[3]), C1,6); \
    GAPB(o[2]=MF32(PAF(2),VFR(2),o[2]), C1,8); \
    GAPB(o[3]=MF32(PAF(2),VFR(6),o[3]), C1,10); \
    GAPB(o[2]=MF32(PAF(3),VFR(3),o[2]), C1,12); \
    GAPB(o[3]=MF32(PAF(3),VFR(7),o[3]), C1,14); \
    }while(0)
  int t=1;
  #undef CMASK
  #define CMASK(P0,P1,t) do{}while(0)
  for(;t+5<NT;t+=2){
    STEP(pB0,pB1,pA0,pA1,t,true,true,true);     WAIT_BAR(3); ROT();
    STEP(pA0,pA1,pB0,pB1,t+1,true,true,true);   WAIT_BAR(3); ROT();
  }
  #undef CMASK
  #define CMASK(P0,P1,t) do{int jb_=(t)-(NT-4); if(jb_>=0)cmask(P0,P1,jb_,qrel,hi);}while(0)
  #define ENDW(tt) do{ if((tt)+3<NT){WAIT_BAR(3);} else if((tt)+2<NT){WAIT_BAR(2);} else {WAIT_BAR(0);} }while(0)
  for(;t+1<NT;t+=2){
    STEP(pB0,pB1,pA0,pA1,t,(t+3<NT),(t+1<NT),(t+1<NT));       ENDW(t);   ROT();
    STEP(pA0,pA1,pB0,pB1,t+1,(t+4<NT),(t+2<NT),(t+2<NT));     ENDW(t+1); ROT();
  }
  { float sacc=pA0[0]+pA0[1]; _Pragma("unroll") for(int r=2;r<16;++r)sacc+=pA0[r]; _Pragma("unroll") for(int r=0;r<16;++r)sacc+=pA1[r]; l_reg+=sacc;
    pw0=(u32x4){PKW(pA0,0),PKW(pA0,2),PKW(pA0,4),PKW(pA0,6)};pw1=(u32x4){PKW(pA0,8),PKW(pA0,10),PKW(pA0,12),PKW(pA0,14)};pw2=(u32x4){PKW(pA1,0),PKW(pA1,2),PKW(pA1,4),PKW(pA1,6)};pw3=(u32x4){PKW(pA1,8),PKW(pA1,10),PKW(pA1,12),PKW(pA1,14)};
    SBAR(); pv4(o,vb0+2*sl_prev,PAF(0),PAF(1),PAF(2),PAF(3)); }
  #undef PKW
  #undef PAF
  #undef VFR
  #undef PIN
  #undef GAPA
  #undef GAPB
  #undef EX
  #undef VRD
  #undef VRD2
  #undef KRD
  #undef MF32
  #undef STEP
  #undef ENDW
  {auto rr=__builtin_amdgcn_permlane32_swap(__float_as_uint(l_reg),__float_as_uint(l_reg),false,false);l_reg=__uint_as_float(rr[0])+__uint_as_float(rr[1]);}
  if(hi==0)wsf[32+r32]=l_reg;asm volatile("s_waitcnt lgkmcnt(0)":::"memory");
  float rli[16];
  #pragma unroll
  for(int r=0;r<16;++r)rli[r]=__builtin_amdgcn_rcpf(wsf[32+crow(r,hi)]);
  { bf16*park=(bf16*)(shm+V2_LDS_OST)+wid*4096;
    if(MODE==0){
      #pragma unroll
      for(int r=0;r<16;++r){const int orow=crow(r,hi);
        #pragma unroll
        for(int d0=0;d0<4;++d0)park[orow*128+d0*32+r32]=__float2bfloat16(o[d0][r]*rli[r]);}
      asm volatile("s_waitcnt lgkmcnt(0)":::"memory");
    } else {
      #pragma unroll
      for(int r=0;r<16;++r){const int orow=crow(r,hi);
        #pragma unroll
        for(int d0=0;d0<4;++d0){const float o1=__bfloat162float(park[orow*128+d0*32+r32]); park[orow*128+d0*32+r32]=__float2bfloat16(o1-lam*(o[d0][r]*rli[r]));}}
      asm volatile("s_waitcnt lgkmcnt(0)":::"memory");
      bf16*Ow=Ou+(long)(wid*QBLK)*PO;
      const int ch=lane&15; const f32x4v g0=*(const f32x4v*)(subg+8*ch), g1=*(const f32x4v*)(subg+8*ch+4);
      #pragma unroll
      for(int i=0;i<8;++i){const int row=i*4+(lane>>4); const u32x4 v=*(const u32x4*)(park+row*128+ch*8);
        float d[8]; d[0]=__uint_as_float(v.x<<16);d[1]=__uint_as_float(v.x&0xffff0000u);d[2]=__uint_as_float(v.y<<16);d[3]=__uint_as_float(v.y&0xffff0000u);d[4]=__uint_as_float(v.z<<16);d[5]=__uint_as_float(v.z&0xffff0000u);d[6]=__uint_as_float(v.w<<16);d[7]=__uint_as_float(v.w&0xffff0000u);
        float ss=(d[0]*d[0]+d[1]*d[1])+(d[2]*d[2]+d[3]*d[3])+(d[4]*d[4]+d[5]*d[5])+(d[6]*d[6]+d[7]*d[7]);
        ss+=__shfl_xor(ss,1);ss+=__shfl_xor(ss,2);ss+=__shfl_xor(ss,4);ss+=__shfl_xor(ss,8);
        const float rs=__builtin_amdgcn_rsqf(ss*(1.0f/128.0f)+1e-6f)*oscale;
        u32x4 w; w.x=cvtpk_s(d[0]*rs*g0[0],d[1]*rs*g0[1]); w.y=cvtpk_s(d[2]*rs*g0[2],d[3]*rs*g0[3]); w.z=cvtpk_s(d[4]*rs*g1[0],d[5]*rs*g1[1]); w.w=cvtpk_s(d[6]*rs*g1[2],d[7]*rs*g1[3]);
        ATTN_STORE16(Ow+(long)row*PO+ch*8,w);}
      asm volatile("s_waitcnt lgkmcnt(0)":::"memory");
    } }
  asm volatile("s_waitcnt lgkmcnt(0)\n\ts_barrier":::"memory");
  #undef DMA_K
  #undef DMA_V
  #undef CMASK
  #undef ROT
}
#undef SBAR
#undef WAIT_BAR

}
namespace cg = cooperative_groups;
constexpr int NWAVES = 8;
constexpr int NB = 4, SEQ = 8192, DM = 1024, NMETA = 16, DIN = 2560, DFF = 4096, DCONV = 512, CONVW = 31;
constexpr int MX = NB * SEQ;
constexpr int MP = MX + 256;
constexpr int SPAD = pg8::SPAD;
constexpr float EPS = 1e-6f;
constexpr size_t MiB = 1u << 20;
constexpr size_t WS_CTL = 0, WS_WIN = 1 * MiB, WS_WOUT = 6 * MiB, WS_WUP = 8 * MiB, WS_WDN = 16 * MiB, WS_ROPE = 24 * MiB, WS_SSQ = 25 * MiB, WS_RN = 27 * MiB,
                 WS_H1B = 28 * MiB, WS_MIX = 92 * MiB, WS_HB = 156 * MiB, WS_XN = 156 * MiB, WS_O = 156 * MiB, WS_Q = 222 * MiB, WS_K = 254 * MiB, WS_V = 287 * MiB, WS_G = 320 * MiB,
                 WS_END = 412 * MiB;
static_assert(WS_XN + (size_t)MP * DM * 2 <= WS_Q && WS_K + (size_t)NB * SPAD * 512 * 2 <= WS_V && WS_G + (size_t)NB * SPAD * 512 * 2 <= WS_HB + (size_t)MX * DFF * 2 && WS_HB + (size_t)MX * DFF * 2 <= WS_END, "d_ws map");
constexpr int RING_BYTES = 131072, LDS_BYTES = 147456;
#ifndef WGM_P1
#define WGM_P1 4
#endif
#ifndef WGM_P4
#define WGM_P4 4
#endif
#ifndef WGM_P35
#define WGM_P35 4
#endif

#define LAS __attribute__((address_space(3)))
typedef unsigned short bf16;
typedef unsigned v4u __attribute__((ext_vector_type(4)));
typedef float f32x4 __attribute__((ext_vector_type(4)));
typedef float f32x2 __attribute__((ext_vector_type(2)));
#define LDS_WAIT() asm volatile("s_waitcnt lgkmcnt(0)" ::: "memory")
__device__ __forceinline__ unsigned pk2(float lo, float hi) { return pg8::cvt_pk_bf16(lo, hi); }
__device__ __forceinline__ float bf_lo(unsigned u) { return __uint_as_float(u << 16); }
__device__ __forceinline__ float bf_hi(unsigned u) { return __uint_as_float(u & 0xffff0000u); }
__device__ __forceinline__ float wave_sum(float v) {
#pragma unroll
    for (int o = 1; o < 64; o <<= 1) v += __shfl_xor(v, o);
    return v;
}

#define XB_TMO      128
#define XB_XCNT(j)  (256  + 64 * (j))
#define XB_XSUB(j)  (1280 + 64 * (j))
#define XB_XGEN(j)  (2304 + 64 * (j))
#define XB_TOP      3328
#define XB_TOPGEN   3392
#define XCD_BAR_WORDS 3456
#define XB_SPIN_CAP (1u << 18)

__device__ __forceinline__ unsigned xb_ld(unsigned* p)              { return __hip_atomic_load(p, __ATOMIC_RELAXED, __HIP_MEMORY_SCOPE_AGENT); }
__device__ __forceinline__ unsigned xb_add(unsigned* p, unsigned v) { return __hip_atomic_fetch_add(p, v, __ATOMIC_RELAXED, __HIP_MEMORY_SCOPE_AGENT); }
__device__ __forceinline__ unsigned xb_xcc_id() { return (unsigned)__builtin_amdgcn_s_getreg((3 << 11) | 20) & 0xFu; }
#define XB_SPIN(cond, bar) do { unsigned _sp = 0; while (cond) { __builtin_amdgcn_s_sleep(1); \
    if ((++_sp & 255u) == 0u) { if (xb_ld(&(bar)[XB_TMO])) break; if (_sp > XB_SPIN_CAP) { atomicAdd(&(bar)[XB_TMO], 1u); break; } } } } while (0)

struct XcdBarrier {
    unsigned* bar; unsigned x;
    volatile LAS unsigned* st;
};

__device__ __forceinline__ XcdBarrier xcd_barrier_post(unsigned* bar, volatile LAS unsigned* st) {
    XcdBarrier b; b.bar = bar; b.x = xb_xcc_id(); b.st = st;
    if (threadIdx.x == 0) (void)xb_add(&bar[XB_XCNT(b.x)], 1u);
    return b;
}
__device__ __forceinline__ void xcd_barrier_complete(unsigned* bar, unsigned x, unsigned& nloc, unsigned& nx) {
    const unsigned G = gridDim.x * gridDim.y * gridDim.z;
    unsigned sum, cnt, mine, sp = 0u;
    for (;;) {
        sum = 0u; cnt = 0u; mine = 0u;
#pragma unroll
        for (unsigned j = 0; j < 16; ++j) { const unsigned c = xb_ld(&bar[XB_XCNT(j)]); sum += c; cnt += (c > 0u) ? 1u : 0u; mine = (j == x) ? c : mine; }
        if (sum == G) break;
        __builtin_amdgcn_s_sleep(1);
        if ((++sp & 255u) == 0u) { if (xb_ld(&bar[XB_TMO])) break; if (sp > XB_SPIN_CAP) { atomicAdd(&bar[XB_TMO], 1u); break; } }
    }
    nloc = mine > 0u ? mine : 1u; nx = cnt > 0u ? cnt : 1u;
}

__device__ __forceinline__ void xcd_barrier(const XcdBarrier& b) {
    asm volatile("s_waitcnt vmcnt(0)" ::: "memory");
    __syncthreads();
    if (threadIdx.x == 0) {
        unsigned* bar = b.bar;
        __builtin_amdgcn_s_waitcnt(0);
        unsigned nloc = b.st[0], nx = b.st[1];
        if (nloc == 0u) { xcd_barrier_complete(bar, b.x, nloc, nx); b.st[0] = nloc; b.st[1] = nx; }
        const unsigned old = xb_add(&bar[XB_XSUB(b.x)], 1u);
        const unsigned gen = old / nloc;
        if (old + 1u == (gen + 1u) * nloc) {
            __builtin_amdgcn_fence(__ATOMIC_RELEASE, "agent");
            asm volatile("s_waitcnt vmcnt(0)" ::: "memory");
            const unsigned og = xb_add(&bar[XB_TOP], 1u);
            const unsigned tg = og / nx;
            if (og + 1u == (tg + 1u) * nx) xb_add(&bar[XB_TOPGEN], 1u);
            else XB_SPIN(xb_ld(&bar[XB_TOPGEN]) == tg, bar);
            __builtin_amdgcn_fence(__ATOMIC_ACQUIRE, "agent");
            xb_add(&bar[XB_XGEN(b.x)], 1u);
            asm volatile("s_waitcnt vmcnt(0)" ::: "memory");
        } else {
            XB_SPIN(xb_ld(&bar[XB_XGEN(b.x)]) == gen, bar);
            __builtin_amdgcn_fence(__ATOMIC_ACQUIRE, "agent");
            asm volatile("s_waitcnt vmcnt(0)" ::: "memory");
        }
    }
    __syncthreads();
}

__device__ __forceinline__ float dpp_add(float v, const int ctrl_sel) {
    int t;
    if (ctrl_sel == 0) t = __builtin_amdgcn_update_dpp(0, __float_as_int(v), 0xB1, 0xF, 0xF, true);
    else if (ctrl_sel == 1) t = __builtin_amdgcn_update_dpp(0, __float_as_int(v), 0x4E, 0xF, 0xF, true);
    else if (ctrl_sel == 2) t = __builtin_amdgcn_update_dpp(0, __float_as_int(v), 0x141, 0xF, 0xF, true);
    else t = __builtin_amdgcn_update_dpp(0, __float_as_int(v), 0x140, 0xF, 0xF, true);
    return v + __int_as_float(t);
}
__device__ __forceinline__ float wave_sum_fast(float v) {
    v = dpp_add(v, 0); v = dpp_add(v, 1); v = dpp_add(v, 2); v = dpp_add(v, 3);
    { auto rr = __builtin_amdgcn_permlane16_swap(__float_as_uint(v), __float_as_uint(v), false, false); v = __uint_as_float(rr[0]) + __uint_as_float(rr[1]); }
    { auto rr = __builtin_amdgcn_permlane32_swap(__float_as_uint(v), __float_as_uint(v), false, false); v = __uint_as_float(rr[0]) + __uint_as_float(rr[1]); }
    return v;
}

struct Args { const float* in[19]; float* out; unsigned char* ws; float inv_freq[8]; };
enum { I_X = 0, I_META, I_G1, I_WIN, I_QG, I_KG, I_LQ1, I_LK1, I_LQ2, I_LK2, I_SUBLN, I_CW, I_CB, I_CLG, I_CLB, I_WOUT, I_G2, I_WUP, I_WDN };

__device__ __forceinline__ void p0_transpose_item(const float* W, int K, int N, bf16* WT, int out_row0, int n0, int k0, const float* kscale, LAS float* scr, int lane) {
    float tv[32], ts[32];
#pragma unroll
    for (int i = 0; i < 32; ++i) { const int kk = 2 * i + (lane >> 5); tv[i] = W[(size_t)(k0 + kk) * N + n0 + (lane & 31)]; ts[i] = kscale ? kscale[k0 + kk] : 1.0f; }
#pragma unroll
    for (int i = 0; i < 32; ++i) { const int kk = 2 * i + (lane >> 5); scr[kk * 33 + (lane & 31)] = tv[i] * ts[i]; }
    LDS_WAIT(); asm volatile("" ::: "memory");
    const int c = lane & 7;
#pragma unroll
    for (int j = 0; j < 4; ++j) { const int n = (lane >> 3) + 8 * j; const LAS float* s = scr + (8 * c) * 33 + n;
        v4u o; o.x = pk2(s[0 * 33], s[1 * 33]); o.y = pk2(s[2 * 33], s[3 * 33]); o.z = pk2(s[4 * 33], s[5 * 33]); o.w = pk2(s[6 * 33], s[7 * 33]);
        *(v4u*)(WT + (size_t)(out_row0 + n) * K + k0 + 8 * c) = o; }
    LDS_WAIT(); asm volatile("" ::: "memory");
}
__device__ __forceinline__ int win_pcol(int lc) {
    if (lc < 1024) { const int l = lc & 255; return (lc & ~255) + 128 * ((l >> 5) & 1) + 32 * (l >> 6) + (l & 31); }
    if (lc < 1536) return lc;
    if (lc < 2048) { const int ch = lc - 1536; return 1536 + 256 * (ch >> 7) + (ch & 127); }
    const int ch = lc - 2048; return 1536 + 256 * (ch >> 7) + 128 + (ch & 127);
}

__device__ __forceinline__ void p0_prologue(const Args& A, unsigned char* ws, LAS unsigned char* lds, int vcu, int G, int wave, int lane) {
    LAS float* scr = (LAS float*)(lds + wave * 16384);
    const int gw = vcu * NWAVES + wave, NGW = G * NWAVES;
    bf16* Win_t = (bf16*)(ws + WS_WIN); bf16* Wout_t = (bf16*)(ws + WS_WOUT); bf16* Wup_t = (bf16*)(ws + WS_WUP); bf16* Wdn_t = (bf16*)(ws + WS_WDN);
    constexpr int I_IN = (DM / 64) * (DIN / 32);
    for (int it = gw; it < I_IN; it += NGW) { const int nblk = DIN / 32, kb = it / nblk, nb = it % nblk; p0_transpose_item(A.in[I_WIN], DM, DIN, Win_t, win_pcol(32 * nb), 32 * nb, 64 * kb, nullptr, scr, lane); }
    {
        bf16* XN = (bf16*)(ws + WS_XN);
        f32x4 g[4];
#pragma unroll
        for (int j = 0; j < 4; ++j) g[j] = ((const f32x4*)A.in[I_G1])[lane + 64 * j];
        for (int m0 = gw; m0 < MX + NMETA; m0 += 4 * NGW) {
            f32x4 v[4][4];
#pragma unroll
            for (int q = 0; q < 4; ++q) { const int m = m0 + q * NGW; const bool ok = m < MX + NMETA;
                const float* src = !ok ? A.in[I_X] : (m < MX) ? A.in[I_X] + (size_t)m * DM : A.in[I_META] + (size_t)(m - MX) * DM;
                const f32x4* xr = (const f32x4*)src + lane;
#pragma unroll
                for (int j = 0; j < 4; ++j) v[q][j] = __builtin_nontemporal_load(xr + 64 * j); }
#pragma unroll
            for (int q = 0; q < 4; ++q) { const int m = m0 + q * NGW; if (m >= MX + NMETA) continue;
                float s = 0.f;
#pragma unroll
                for (int j = 0; j < 4; ++j) s += (v[q][j].x * v[q][j].x + v[q][j].y * v[q][j].y) + (v[q][j].z * v[q][j].z + v[q][j].w * v[q][j].w);
                const float ms = wave_sum_fast(s) * (1.f / DM) + EPS; const float rs = __builtin_amdgcn_rsqf(ms);
                if (lane == 0 && m < MX) ((float*)(ws + WS_RN))[m] = ms * rs;
                unsigned long long* o8 = (unsigned long long*)(XN + (size_t)m * DM) + lane;
#pragma unroll
                for (int j = 0; j < 4; ++j) { const f32x4 y = v[q][j] * rs * g[j]; o8[64 * j] = (unsigned long long)pk2(y.x, y.y) | ((unsigned long long)pk2(y.z, y.w) << 32); } }
        }
    }
    {
        float* rope = (float*)(ws + WS_ROPE);
        const int pos = gw * 64 + lane;
        if (pos < SEQ + NMETA) {
#pragma unroll
            for (int i = 0; i < 8; ++i) {
                const float angf = (float)pos * A.inv_freq[i];
                const double rev = (double)angf * 0.15915494309189533577; const double fr = rev - __builtin_rint(rev);
                const float f = (float)fr;
                rope[pos * 16 + i] = __builtin_amdgcn_cosf(f); rope[pos * 16 + 8 + i] = __builtin_amdgcn_sinf(f); } }
    }
    {
        bf16* KB = (bf16*)(ws + WS_K); bf16* VB = (bf16*)(ws + WS_V); bf16* GB = (bf16*)(ws + WS_G);
        for (int it = gw; it < NB * 48 * 3; it += NGW) { const int which = it / (NB * 48), r = it % (NB * 48), b = r / 48, rr = r % 48;
            bf16* p = which == 0 ? KB + (size_t)(b * SPAD + 16 + rr) * 512 : which == 1 ? VB + (size_t)(b * SPAD + 16 + rr) * 512 : GB + (size_t)(b * SPAD + rr) * 512;
            ((v4u*)p)[lane] = (v4u){0u, 0u, 0u, 0u}; }
    }
}

__device__ __forceinline__ void meta_proj(const Args& A, unsigned char* ws, LAS unsigned char* lds, int vcu, int wave, int lane) {
    typedef short bf16x8 __attribute__((ext_vector_type(8)));
    const int fr = lane & 15, fq = lane >> 4;
    const int item = vcu * 2 + (wave >> 2), kc = wave & 3;
    const int kind = item < 8 ? 0 : item < 16 ? 1 : 2, g = kind == 2 ? item - 16 : (item & 7);
    const bf16* XNm = (const bf16*)(ws + WS_XN) + (size_t)(MX + fr) * DM + 8 * fq + 256 * kc;
    const bf16* Wt = (const bf16*)(ws + WS_WIN);
    const bf16* brow[4];
#pragma unroll
    for (int nb = 0; nb < 4; ++nb) { const int lc = kind == 0 ? 512 + 64 * g + 16 * nb + fr : kind == 1 ? 1024 + 64 * g + 16 * nb + fr : (nb < 2 ? 1536 + 32 * g + 16 * nb + fr : 2048 + 32 * g + 16 * (nb - 2) + fr);
        brow[nb] = Wt + (size_t)(win_pcol(lc & ~31) + (lc & 31)) * DM + 8 * fq + 256 * kc; }
    bf16x8 af[8], bf[8][4];
#pragma unroll
    for (int ks = 0; ks < 8; ++ks) { af[ks] = *(const bf16x8*)(XNm + 32 * ks);
#pragma unroll
        for (int nb = 0; nb < 4; ++nb) bf[ks][nb] = *(const bf16x8*)(brow[nb] + 32 * ks); }
    asm volatile("" ::: "memory");
    f32x4 acc[4];
#pragma unroll
    for (int nb = 0; nb < 4; ++nb) acc[nb] = (f32x4){0.f, 0.f, 0.f, 0.f};
#pragma unroll
    for (int ks = 0; ks < 8; ++ks)
#pragma unroll
        for (int nb = 0; nb < 4; ++nb) acc[nb] = __builtin_amdgcn_mfma_f32_16x16x32_bf16(bf[ks][nb], af[ks], acc[nb], 0, 0, 0);
    LAS f32x4* red = (LAS f32x4*)lds;
#pragma unroll
    for (int nb = 0; nb < 4; ++nb) red[(wave * 4 + nb) * 64 + lane] = acc[nb];
    __syncthreads();
    if (kc == 0) {
#pragma unroll
        for (int nb = 0; nb < 4; ++nb) acc[nb] = (red[((wave + 0) * 4 + nb) * 64 + lane] + red[((wave + 1) * 4 + nb) * 64 + lane]) + (red[((wave + 2) * 4 + nb) * 64 + lane] + red[((wave + 3) * 4 + nb) * 64 + lane]);
        if (kind == 0) {
            float ss = 0.f;
#pragma unroll
            for (int nb = 0; nb < 4; ++nb) ss += (acc[nb][0] * acc[nb][0] + acc[nb][1] * acc[nb][1]) + (acc[nb][2] * acc[nb][2] + acc[nb][3] * acc[nb][3]);
            ss += __shfl_xor(ss, 16); ss += __shfl_xor(ss, 32);
            const float rs = __builtin_amdgcn_rsqf(ss * (1.0f / 64.0f) + EPS);
#pragma unroll
            for (int nb = 0; nb < 4; ++nb) acc[nb] = acc[nb] * rs * *(const f32x4*)(A.in[I_KG] + 16 * nb + 4 * fq);
            f32x4 p; p[0] = __shfl_xor(acc[0][0], 32); p[1] = __shfl_xor(acc[0][1], 32); p[2] = __shfl_xor(acc[0][2], 32); p[3] = __shfl_xor(acc[0][3], 32);
            const float* rp = (const float*)(ws + WS_ROPE) + fr * 16 + 4 * (fq & 1);
            const f32x4 c = *(const f32x4*)rp, s = *(const f32x4*)(rp + 8);
            const float sg = (fq & 2) ? 1.f : -1.f;
            acc[0] = acc[0] * c + (p * s) * sg;
        }
        if (kind == 2) {
#pragma unroll
            for (int nb = 0; nb < 2; ++nb)
#pragma unroll
                for (int e = 0; e < 4; ++e) acc[nb][e] = acc[nb][e] * __builtin_amdgcn_rcpf(1.0f + __builtin_amdgcn_exp2f(-1.4426950408889634f * acc[nb + 2][e]));
        }
        bf16* dst = kind == 0 ? (bf16*)(ws + WS_K) : kind == 1 ? (bf16*)(ws + WS_V) : (bf16*)(ws + WS_G);
        const int r0 = kind == 2 ? 48 + fr : fr, c0 = (kind == 2 ? 32 * g : 64 * g) + 4 * fq, nnb = kind == 2 ? 2 : 4;
#pragma unroll 1
        for (int b = 0; b < NB; ++b) { bf16* o = dst + (size_t)(b * SPAD + r0) * 512 + c0;
#pragma unroll
            for (int nb = 0; nb < 4; ++nb) if (nb < nnb) *(unsigned long long*)(o + 16 * nb) = (unsigned long long)pk2(acc[nb][0], acc[nb][1]) | ((unsigned long long)pk2(acc[nb][2], acc[nb][3]) << 32); }
    }
    __syncthreads();
}

__device__ __forceinline__ void wconv_phase(const Args& A, unsigned char* ws, LAS unsigned char* lds, int wave, int lane) {
    LAS float* scr = (LAS float*)(lds + wave * 16384);
    bf16* Wout_t = (bf16*)(ws + WS_WOUT); bf16* Wup_t = (bf16*)(ws + WS_WUP); bf16* Wdn_t = (bf16*)(ws + WS_WDN);
    constexpr int I_OUT = (DM / 64) * (DM / 32), I_UP = (DM / 64) * (DFF / 32), I_DN = (DFF / 64) * (DM / 32), NIT = I_OUT + I_UP + I_DN;
    unsigned* wq = (unsigned*)(ws + WS_CTL) + 96;
    volatile LAS unsigned* TK = (volatile LAS unsigned*)(lds + LDS_BYTES - 256 + 64);
    for (;;) {
        if (wave == 0 && lane == 0) TK[0] = __hip_atomic_fetch_add(wq, 1u, __ATOMIC_RELAXED, __HIP_MEMORY_SCOPE_AGENT);
        __syncthreads();
        const int t = (int)TK[0];
        __syncthreads();
        if (t * NWAVES >= NIT) break;
        int r = t * NWAVES + wave;
        if (r >= NIT) continue;
        if (r < I_OUT) { const int nblk = DM / 32, kb = r / nblk, nb = r % nblk; p0_transpose_item(A.in[I_WOUT], DM, DM, Wout_t, 32 * nb, 32 * nb, 64 * kb, nullptr, scr, lane); continue; } r -= I_OUT;
        if (r < I_UP) { const int nblk = DFF / 32, kb = r / nblk, nb = r % nblk; p0_transpose_item(A.in[I_WUP], DM, DFF, Wup_t, 32 * nb, 32 * nb, 64 * kb, A.in[I_G2], scr, lane); continue; } r -= I_UP;
        { const int nblk = DM / 32, kb = r / nblk, nb = r % nblk; p0_transpose_item(A.in[I_WDN], DFF, DM, Wdn_t, 32 * nb, 32 * nb, 64 * kb, nullptr, scr, lane); }
    }
}

constexpr int CONV_R = 32;
__device__ __forceinline__ void conv_phase(const Args& A, unsigned char* ws, LAS unsigned char* lds, int vcu, int G, int wave, int lane) {
    LAS float* cbuf = (LAS float*)lds;
    const bf16* GB = (const bf16*)(ws + WS_G); bf16* MIX = (bf16*)(ws + WS_MIX);
    const int cp = (wave & 3) * 64 + lane, half = wave >> 2;
    f32x2 w[CONVW];
#pragma unroll
    for (int j = 0; j < CONVW; ++j) w[j] = *(const f32x2*)(A.in[I_CW] + j * DCONV + 2 * cp);
    const f32x2 bias = *(const f32x2*)(A.in[I_CB] + 2 * cp);
    const f32x4 lg0 = *(const f32x4*)(A.in[I_CLG] + lane * 8), lg1 = *(const f32x4*)(A.in[I_CLG] + lane * 8 + 4), lb0 = *(const f32x4*)(A.in[I_CLB] + lane * 8), lb1 = *(const f32x4*)(A.in[I_CLB] + lane * 8 + 4);
    constexpr int NITEMS = MX / (2 * CONV_R);
    unsigned* cq = (unsigned*)(ws + WS_CTL) + 32;
    volatile LAS unsigned* TK = (volatile LAS unsigned*)(lds + LDS_BYTES - 256 + 64);
    if (wave == 0 && lane == 0) { TK[0] = __hip_atomic_fetch_add(cq, 1u, __ATOMIC_RELAXED, __HIP_MEMORY_SCOPE_AGENT); TK[1] = __hip_atomic_fetch_add(cq, 1u, __ATOMIC_RELAXED, __HIP_MEMORY_SCOPE_AGENT); }
    __syncthreads();
    int it = (int)TK[0], nxt = (int)TK[1];
    __syncthreads();
#define CONV_SRC(item, sub) (GB + (size_t)(((((item) * 2 * CONV_R + half * CONV_R + (sub) * 16) >> 13) * SPAD) + 34 + (((item) * 2 * CONV_R + half * CONV_R + (sub) * 16) & 8191)) * 512 + 2 * cp)
#define CONV_LOAD(buf, item, sub) do { const bf16* gs_ = CONV_SRC(item, sub); _Pragma("unroll") for (int i = 0; i < 46; ++i) buf[i] = *(const unsigned*)(gs_ + (size_t)i * 512); } while (0)
#define CONV_FMA(buf, sub) do { f32x2 acc[16]; _Pragma("unroll") for (int o = 0; o < 16; ++o) acc[o] = bias; \
        _Pragma("unroll") for (int i = 0; i < 46; ++i) { const f32x2 x = {bf_lo(buf[i]), bf_hi(buf[i])}; _Pragma("unroll") for (int o = 0; o < 16; ++o) { const int j = i - o; if (j >= 0 && j < CONVW) acc[o] += w[j] * x; } } \
        _Pragma("unroll") for (int o = 0; o < 16; ++o) *(LAS f32x2*)(cbuf + (half * CONV_R + (sub) * 16 + o) * DCONV + 2 * cp) = acc[o]; } while (0)
    unsigned bufA[46], bufB[46];
    if (it < NITEMS) CONV_LOAD(bufA, it, 0);
#pragma unroll 1
    while (it < NITEMS) {
        if (wave == 0 && lane == 0) TK[0] = __hip_atomic_fetch_add(cq, 1u, __ATOMIC_RELAXED, __HIP_MEMORY_SCOPE_AGENT);
        CONV_LOAD(bufB, it, 1);
        CONV_FMA(bufA, 0);
        if (nxt < NITEMS) CONV_LOAD(bufA, nxt, 0);
        CONV_FMA(bufB, 1);
        __syncthreads();
        const int nn = (int)TK[0];
#pragma unroll
        for (int rr = 0; rr < 8; ++rr) { const int lr = wave * 8 + rr;
            f32x4 x0 = *(const LAS f32x4*)(cbuf + lr * DCONV + lane * 8), x1 = *(const LAS f32x4*)(cbuf + lr * DCONV + lane * 8 + 4);
            const float mu = wave_sum_fast((x0[0] + x0[1]) + (x0[2] + x0[3]) + (x1[0] + x1[1]) + (x1[2] + x1[3])) * (1.f / DCONV);
            x0 = x0 - mu; x1 = x1 - mu;
            const float var = wave_sum_fast((x0[0] * x0[0] + x0[1] * x0[1]) + (x0[2] * x0[2] + x0[3] * x0[3]) + (x1[0] * x1[0] + x1[1] * x1[1]) + (x1[2] * x1[2] + x1[3] * x1[3])) * (1.f / DCONV);
            const float rs = __builtin_amdgcn_rsqf(var + EPS);
            x0 = x0 * rs * lg0 + lb0; x1 = x1 * rs * lg1 + lb1;
#pragma unroll
            for (int e = 0; e < 4; ++e) { x0[e] = x0[e] * __builtin_amdgcn_rcpf(1.0f + __builtin_amdgcn_exp2f(-1.4426950408889634f * x0[e])); x1[e] = x1[e] * __builtin_amdgcn_rcpf(1.0f + __builtin_amdgcn_exp2f(-1.4426950408889634f * x1[e])); }
            *(v4u*)(MIX + (size_t)(it * 2 * CONV_R + lr) * DM + 512 + lane * 8) = pg8::pack8(x0, x1); }
        __syncthreads();
        it = nxt; nxt = nn;
    }
#undef CONV_SRC
#undef CONV_LOAD
#undef CONV_FMA
}

__device__ __forceinline__ void combine_phase(const Args& A, unsigned char* ws, int vcu, int G, int wave, int lane) {
    const bf16* OB = (const bf16*)(ws + WS_O); bf16* MIX = (bf16*)(ws + WS_MIX);
    const float d1 = wave_sum(A.in[I_LQ1][lane] * A.in[I_LK1][lane]), d2 = wave_sum(A.in[I_LQ2][lane] * A.in[I_LK2][lane]);
    const float lam_init = 0.2f;
    const float lam = __builtin_amdgcn_exp2f(d1 * 1.4426950408889634f) - __builtin_amdgcn_exp2f(d2 * 1.4426950408889634f) + lam_init;
    const int h = lane >> 4, q = lane & 15;
    const f32x4 sg0 = *(const f32x4*)(A.in[I_SUBLN] + 8 * q), sg1 = *(const f32x4*)(A.in[I_SUBLN] + 8 * q + 4);
    const int gw = vcu * NWAVES + wave, NGW = G * NWAVES;
    for (int row = gw; row < MX; row += NGW) {
        const bf16* o1 = OB + (size_t)row * 1024 + h * 256 + 8 * q;
        const v4u a = *(const v4u*)o1, bq = *(const v4u*)(o1 + 128);
        f32x4 d0, d1v;
        d0[0] = bf_lo(a.x) - lam * bf_lo(bq.x); d0[1] = bf_hi(a.x) - lam * bf_hi(bq.x); d0[2] = bf_lo(a.y) - lam * bf_lo(bq.y); d0[3] = bf_hi(a.y) - lam * bf_hi(bq.y);
        d1v[0] = bf_lo(a.z) - lam * bf_lo(bq.z); d1v[1] = bf_hi(a.z) - lam * bf_hi(bq.z); d1v[2] = bf_lo(a.w) - lam * bf_lo(bq.w); d1v[3] = bf_hi(a.w) - lam * bf_hi(bq.w);
        float ss = (d0[0] * d0[0] + d0[1] * d0[1]) + (d0[2] * d0[2] + d0[3] * d0[3]) + (d1v[0] * d1v[0] + d1v[1] * d1v[1]) + (d1v[2] * d1v[2] + d1v[3] * d1v[3]);
        ss += __shfl_xor(ss, 1); ss += __shfl_xor(ss, 2); ss += __shfl_xor(ss, 4); ss += __shfl_xor(ss, 8);
        const float rs = __builtin_amdgcn_rsqf(ss * (1.f / 128.f) + EPS) * (1.0f - lam_init);
        *(v4u*)(MIX + (size_t)row * DM + h * 128 + 8 * q) = pg8::pack8(d0 * rs * sg0, d1v * rs * sg1);
    }
}

__global__ void __launch_bounds__(NWAVES * 64, 2) hymba_fwd(Args args) {
    extern __shared__ __attribute__((aligned(16))) unsigned char lds[];
    cg::grid_group grid = cg::this_grid();
    LAS unsigned char* ldsl = (LAS unsigned char*)lds;
    volatile LAS unsigned* MISC = (volatile LAS unsigned*)(ldsl + LDS_BYTES - 256);
    if (threadIdx.x < 32) MISC[threadIdx.x] = 0u;
    __syncthreads();
    const XcdBarrier bar = xcd_barrier_post((unsigned*)(args.ws + WS_CTL) + 4096, MISC + 8);
    const int G = gridDim.x; const int bx = blockIdx.x; const int vcu = (G % 8 == 0) ? (bx % 8) * (G / 8) + bx / 8 : bx;
#ifndef PROBE_DUP
#define PROBE_DUP 0
#endif
#define REP(mask) for (int rep_ = 0; rep_ < (((PROBE_DUP) & (mask)) ? 2 : 1); ++rep_)
#define PHASE_VARS() unsigned char* ws = args.ws; int tid_ = threadIdx.x; asm volatile("" : "+v"(tid_)); const int lane = tid_ & 63, wave = __builtin_amdgcn_readfirstlane(tid_ >> 6); (void)lane; (void)wave

    REP(1) { PHASE_VARS(); p0_prologue(args, ws, ldsl, vcu, G, wave, lane); }
    if (args.ws == nullptr) grid.sync();
    xcd_barrier(bar);

    REP(2) {
        PHASE_VARS();
        pg8::Gemm g{(bf16*)(ws + WS_XN), (bf16*)(ws + WS_WIN), MX, DIN, DM}; pg8::StaticOrder S; S.init(MX, DIN, G, bx, WGM_P1);
        pg8::EpiInProj E{(bf16*)(ws + WS_Q), (bf16*)(ws + WS_K), (bf16*)(ws + WS_V), (bf16*)(ws + WS_G), args.in[I_QG], args.in[I_KG], (const float*)(ws + WS_ROPE)};
        pg8::gemm_phase<pg8::EpiInProj, pg8::StaticOrder, PG8_ALIGN, PG8_SP2>(ldsl, g, S, E);
    }
    {
        PHASE_VARS();
        unsigned* mq = (unsigned*)(ws + WS_CTL) + 160;
        volatile LAS unsigned* TK = (volatile LAS unsigned*)(ldsl + LDS_BYTES - 256 + 64);
        for (;;) {
            if (tid_ == 0) TK[0] = __hip_atomic_fetch_add(mq, 1u, __ATOMIC_RELAXED, __HIP_MEMORY_SCOPE_AGENT);
            __syncthreads();
            const int t = (int)TK[0];
            __syncthreads();
            if (t >= 16) break;
            meta_proj(args, ws, ldsl, t, wave, lane);
        }
    }
    xcd_barrier(bar);

    REP(8) {
        PHASE_VARS();
        static_assert(attn_body::V2_LDS_BYTES <= LDS_BYTES - 256, "attention LDS");
        const float dq1 = wave_sum(args.in[I_LQ1][lane] * args.in[I_LK1][lane]), dq2 = wave_sum(args.in[I_LQ2][lane] * args.in[I_LK2][lane]);
        const float lam_init = 0.2f;
        const float lam = __builtin_amdgcn_exp2f(dq1 * 1.4426950408889634f) - __builtin_amdgcn_exp2f(dq2 * 1.4426950408889634f) + lam_init;
        for (int vv = vcu; vv < 256; vv += G) {
            const int bh = vv >> 4, s = vv & 15;
            const int b = bh >> 2, head = bh & 3;
            const attn_body::bf16* Kh = (const attn_body::bf16*)(ws + WS_K) + (size_t)(b * SPAD) * 512 + head * 128;
            const attn_body::bf16* Vh = (const attn_body::bf16*)(ws + WS_V) + (size_t)(b * SPAD) * 512 + head * 128;
            for (int i = 0; i < 2; ++i) {
                const int qb = i ? 31 - s : s;
                const int q0 = qb * 256;
                const attn_body::bf16* Qu = (const attn_body::bf16*)(ws + WS_Q) + (size_t)(b * SEQ + q0) * 512 + head * 128;
                attn_body::bf16* Mu = (attn_body::bf16*)(ws + WS_MIX) + (size_t)(b * SEQ + q0) * 1024 + head * 128;
                attn_body::attn_unit128<0>(q0, Qu, Kh, Vh, Mu, (char*)lds, lam, 1.0f - lam_init, args.in[I_SUBLN]);
                attn_body::attn_unit128<1>(q0, Qu + 64, Kh + 64, Vh, Mu, (char*)lds, lam, 1.0f - lam_init, args.in[I_SUBLN]);
            }
        }
    }
    REP(4) { PHASE_VARS(); conv_phase(args, ws, ldsl, vcu, G, wave, lane); }
    { PHASE_VARS(); wconv_phase(args, ws, ldsl, wave, lane); }
    xcd_barrier(bar);

    REP(32) {
        PHASE_VARS();
        pg8::Gemm g{(bf16*)(ws + WS_MIX), (bf16*)(ws + WS_WOUT), MX, DM, DM}; pg8::StaticOrder S; S.init(MX, DM, G, bx, WGM_P35);
        pg8::EpiOut E{(const bf16*)(ws + WS_XN), (const float*)(ws + WS_RN), args.in[I_G1], (bf16*)(ws + WS_H1B), (float*)(ws + WS_SSQ)};
        pg8::gemm_phase<pg8::EpiOut, pg8::StaticOrder, PG8_ALIGN, PG8_SP2>(ldsl, g, S, E);
    }
    xcd_barrier(bar);

    REP(64) {
        PHASE_VARS();
        pg8::Gemm g{(bf16*)(ws + WS_H1B), (bf16*)(ws + WS_WUP), MX, DFF, DM}; pg8::StaticOrder S; S.init(MX, DFF, G, bx, WGM_P4);
        pg8::EpiUp E{(bf16*)(ws + WS_HB), (const float*)(ws + WS_SSQ)};
        pg8::gemm_phase<pg8::EpiUp, pg8::StaticOrder, PG8_ALIGN, PG8_SP2>(ldsl, g, S, E);
    }
    xcd_barrier(bar);

    {
        PHASE_VARS();
        pg8::Gemm g{(bf16*)(ws + WS_HB), (bf16*)(ws + WS_WDN), MX, DM, DFF}; pg8::StaticOrder S; S.init(MX, DM, G, bx, WGM_P35);
        pg8::EpiDown E{(const bf16*)(ws + WS_H1B), args.out};
        pg8::gemm_phase<pg8::EpiDown, pg8::StaticOrder, PG8_ALIGN, PG8_SP2>(ldsl, g, S, E);
    }
#undef PHASE_VARS
#undef REP
}

extern "C" void kernel_launch(void* const* d_in, const int* in_sizes, int n_in, void* d_out, int out_size, void* d_ws, size_t ws_size, hipStream_t stream) {
    static int grid = 0;
    if (grid == 0) {
        if (n_in != 19 || in_sizes[0] != MX * DM || out_size != MX * DM || ws_size < WS_END) { fprintf(stderr, "kernel_launch: unexpected shapes: n_in %d, in0 %d, out %d, ws %zu (need %zu); nothing launched\n", n_in, n_in > 0 ? in_sizes[0] : -1, out_size, ws_size, (size_t)WS_END); grid = -1; return; }
        int dev = 0, cus = 0, per_cu = 0;
        if (hipGetDevice(&dev) != hipSuccess || hipDeviceGetAttribute(&cus, hipDeviceAttributeMultiprocessorCount, dev) != hipSuccess) { fprintf(stderr, "kernel_launch: device query failed\n"); grid = -1; return; }
        if (hipFuncSetAttribute((const void*)hymba_fwd, hipFuncAttributeMaxDynamicSharedMemorySize, LDS_BYTES) != hipSuccess) { fprintf(stderr, "kernel_launch: hipFuncSetAttribute failed\n"); grid = -1; return; }
        if (hipOccupancyMaxActiveBlocksPerMultiprocessor(&per_cu, (const void*)hymba_fwd, NWAVES * 64, LDS_BYTES) != hipSuccess || per_cu < 1) { fprintf(stderr, "kernel_launch: occupancy query says %d\n", per_cu); per_cu = 1; }
        (void)hipGetLastError();
        grid = cus * 1;
        fprintf(stderr, "kernel_launch: grid %d (occupancy query %d per CU)\n", grid, per_cu);
    }
    if (grid < 0) return;
    Args a{};
    for (int i = 0; i < 19; ++i) a.in[i] = (const float*)d_in[i];
    a.out = (float*)d_out; a.ws = (unsigned char*)d_ws;
    for (int i = 0; i < 8; ++i) a.inv_freq[i] = (float)pow(500000.0, -(double)i / 8.0);
    if (hipMemsetAsync((char*)d_ws + WS_CTL, 0, 65536, stream) != hipSuccess) { fprintf(stderr, "kernel_launch: hipMemsetAsync failed\n"); return; }
    void* kargs[] = {&a};
    const hipError_t le = hipLaunchCooperativeKernel((const void*)hymba_fwd, dim3(grid), dim3(NWAVES * 64), kargs, LDS_BYTES, stream);
    if (le != hipSuccess) fprintf(stderr, "kernel_launch: cooperative launch failed: %s (grid %d)\n", hipGetErrorName(le), grid);
}
```

```cpp
#include <hip/hip_cooperative_groups.h>
#include <cmath>
#include <hip/hip_runtime.h>
#include <cstdio>
#include <cstdint>
namespace pg8 {
#define PG8_LAS __attribute__((address_space(3)))
typedef unsigned short bf16_t;
typedef short bf16x8 __attribute__((ext_vector_type(8)));
typedef float f32x4 __attribute__((ext_vector_type(4)));
typedef unsigned u32x4 __attribute__((ext_vector_type(4)));
constexpr int BM = 256, BK = 64, HALF = 128, HTB = HALF * BK * 2  , STAGE_BYTES = 8 * HTB, NXCD = 8, WGM = 8;

__host__ __device__ __forceinline__ int lds_byte(int r, int c) { const int st = (r >> 4) * 2 + (c >> 5), rr = r & 15, cc = c & 31, ob = rr * 64 + cc * 2; return st * 1024 + (ob ^ (((ob >> 9) & 1) << 5)); }
__host__ __device__ __forceinline__ void stage_rc(int b, int& R, int& C) { const int st = b / 1024, sb = b % 1024, swz = sb ^ (((sb >> 9) & 1) << 5); R = (st >> 1) * 16 + swz / 64; C = (st & 1) * 32 + (swz % 64) / 2; }
__host__ __device__ __forceinline__ int perm32(int rho) { const int n = rho >> 4, i = rho & 15; return 8 * (i >> 2) + 4 * n + (i & 3); }

struct Unit { int pm, pn; };
struct Gemm { const bf16_t* A; const bf16_t* Bt; int M, N, K; };

struct StaticOrder {
    int nM, nN, nwg, G, c, wgm;
    __host__ __device__ void init(int M, int N, int G_, int c_, int wgm_ = WGM) { nM = M / BM; nN = N / BM; nwg = nM * nN; G = G_; c = c_; wgm = wgm_; }
    __host__ __device__ bool next(int i, Unit& u) const {
        const long L = (long)i * G + c; if (L >= nwg) return false;
        int wgid = (int)L; { const int q = nwg / NXCD, r = nwg % NXCD, xcd = wgid % NXCD, off = wgid / NXCD; wgid = (xcd < r ? xcd * (q + 1) : r * (q + 1) + (xcd - r) * q) + off; }
        const int nig = wgm * nN, gid = wgid / nig, fm = gid * wgm, gsz = (nM - fm) < wgm ? (nM - fm) : wgm;
        u.pm = fm + ((wgid % nig) % gsz); u.pn = (wgid % nig) / gsz; return true;
    }
    __device__ __forceinline__ void a_ready(const Unit&) const {}
    __device__ __forceinline__ void done(const Unit&) const {}
};

__device__ __forceinline__ unsigned cvt_pk_bf16(float lo, float hi) { unsigned r; asm volatile("v_cvt_pk_bf16_f32 %0, %1, %2" : "=v"(r) : "v"(lo), "v"(hi)); return r; }
typedef float f32x2 __attribute__((ext_vector_type(2)));
__device__ __forceinline__ f32x2 gelu_pk(f32x2 v) {
    const f32x2 av = __builtin_elementwise_abs(v), d = av * 0.2316418882f + 1.0f;
    f32x2 t; t.x = __builtin_amdgcn_rcpf(d.x); t.y = __builtin_amdgcn_rcpf(d.y);
    f32x2 q = t * 0.5307027145f + (-0.7265760135f); q = q * t + 0.7107068705f; q = q * t + (-0.142248368f); q = q * t + 0.127414796f; q = q * t;
    const f32x2 s = (v * v) * (-0.72134752044f);
    f32x2 e; e.x = __builtin_amdgcn_exp2f(s.x); e.y = __builtin_amdgcn_exp2f(s.y);
    const f32x2 m = v * (q * e), r = v - m;
    f32x2 o; o.x = v.x < 0.f ? m.x : r.x; o.y = v.y < 0.f ? m.y : r.y; return o;
}

template <int ACT  > struct EpiBf16 {
    static constexpr bool PERM = true, AFTER_DRAIN = false; static_assert(ACT == 0 || ACT == 1, "EpiBf16: ACT is 0 (none) or 1 (gelu_pk)");
    bf16_t* O; int ldc; const float* bias; int split_cols; size_t split_stride; float scale0;
    __device__ __forceinline__ void operator()(const f32x4 (&acc)[2][2][4][2], const Unit& u, int wr, int wc, int fr, int fq) const {
        const int row0 = u.pm * BM + wr * 64 + fr; int colt = u.pn * BM; bf16_t* base = O;
        float sc = 1.f; if (split_cols) { const int t = colt / split_cols; base += (size_t)t * split_stride; colt -= t * split_cols; if (t == 0) sc = scale0; }
        const int col0 = colt + wc * 32 + 8 * fq, bcol0 = u.pn * BM + wc * 32 + 8 * fq;
        f32x4 bv[2][2];
#pragma unroll
        for (int bj = 0; bj < 2; ++bj)
#pragma unroll
            for (int n = 0; n < 2; ++n) bv[bj][n] = bias ? *(const f32x4*)(bias + bcol0 + bj * HALF + 4 * n) : (f32x4){0.f, 0.f, 0.f, 0.f};
#pragma unroll
        for (int ai = 0; ai < 2; ++ai)
#pragma unroll
            for (int m = 0; m < 4; ++m) { bf16_t* rowp = base + (size_t)(row0 + ai * HALF + m * 16) * ldc + col0;
#pragma unroll
                for (int bj = 0; bj < 2; ++bj) { f32x4 v0 = acc[ai][bj][m][0] + bv[bj][0], v1 = acc[ai][bj][m][1] + bv[bj][1];
                    if (ACT == 1) { f32x2 a = gelu_pk((f32x2){v0[0], v0[1]}), b = gelu_pk((f32x2){v0[2], v0[3]}), c = gelu_pk((f32x2){v1[0], v1[1]}), d = gelu_pk((f32x2){v1[2], v1[3]});
                        v0 = (f32x4){a.x, a.y, b.x, b.y}; v1 = (f32x4){c.x, c.y, d.x, d.y}; }
                    v0 = v0 * sc; v1 = v1 * sc; u32x4 w; w.x = cvt_pk_bf16(v0[0], v0[1]); w.y = cvt_pk_bf16(v0[2], v0[3]); w.z = cvt_pk_bf16(v1[0], v1[1]); w.w = cvt_pk_bf16(v1[2], v1[3]);
                    *(u32x4*)(rowp + bj * HALF) = w; } }
    }
};

constexpr int XROWS = 32768, SPAD = 8256;
constexpr float QSCALE = 0.125f * 1.4426950408889634f;
__device__ __forceinline__ f32x4 shfl_xor4(f32x4 v, int m) { f32x4 r; r[0] = __shfl_xor(v[0], m); r[1] = __shfl_xor(v[1], m); r[2] = __shfl_xor(v[2], m); r[3] = __shfl_xor(v[3], m); return r; }
__device__ __forceinline__ u32x4 pack8(f32x4 a, f32x4 b) { u32x4 w; w.x = cvt_pk_bf16(a[0], a[1]); w.y = cvt_pk_bf16(a[2], a[3]); w.z = cvt_pk_bf16(b[0], b[1]); w.w = cvt_pk_bf16(b[2], b[3]); return w; }
struct EpiInProj {
    static constexpr bool PERM = true, AFTER_DRAIN = false;
    bf16_t *Q, *K, *V, *G; const float *qg, *kg, *rope;
    __device__ __forceinline__ void operator()(const f32x4 (&acc)[2][2][4][2], const Unit& u, int wr, int wc, int fr, int fq) const {
        const int pn = u.pn; constexpr bool meta = false;
        if (meta && (wr != 0 || pn < 2)) return;
        const int rbase = u.pm * BM + wr * 64 + fr;
        if (pn < 4) {
            const bool isq = pn < 2; const float* gp = isq ? qg : kg; const float osc = isq ? QSCALE : 1.f;
            f32x4 gv[2][2];
#pragma unroll
            for (int bj = 0; bj < 2; ++bj)
#pragma unroll
                for (int n = 0; n < 2; ++n) gv[bj][n] = *(const f32x4*)(gp + 32 * bj + 8 * fq + 4 * n);
            const int colb = (pn & 1) * 256 + wc * 64 + 8 * fq;
            bf16_t* dst = isq ? Q : K;
#pragma unroll
            for (int ai = 0; ai < 2; ++ai) {
                if (meta && ai) continue;
#pragma unroll
              for (int mh = 0; mh < 2; ++mh) {
                if (meta && mh) continue;
                f32x4 rv[2][4];
                if (fq < 2) {
#pragma unroll
                    for (int m2 = 0; m2 < 2; ++m2) { const int row = rbase + ai * HALF + (2 * mh + m2) * 16; const int pos = meta ? (row - XROWS) : ((row & 8191) + 16); const f32x4* rp = (const f32x4*)(rope + (size_t)pos * 16);
#pragma unroll
                        for (int k = 0; k < 4; ++k) rv[m2][k] = rp[k]; }
                }
                asm volatile("" ::: "memory");
#pragma unroll
                for (int m = 2 * mh; m < 2 * mh + 2; ++m) {
                    if (meta && m) continue;
                    const int row = rbase + ai * HALF + m * 16;
                    float ss = 0.f;
#pragma unroll
                    for (int bj = 0; bj < 2; ++bj)
#pragma unroll
                        for (int n = 0; n < 2; ++n) { const f32x4 x = acc[ai][bj][m][n]; ss += (x[0] * x[0] + x[1] * x[1]) + (x[2] * x[2] + x[3] * x[3]); }
                    ss += __shfl_xor(ss, 16); ss += __shfl_xor(ss, 32);
                    const float rs = __builtin_amdgcn_rsqf(ss * (1.0f / 64.0f) + 1e-6f);
                    f32x4 y00 = acc[ai][0][m][0] * rs * gv[0][0], y01 = acc[ai][0][m][1] * rs * gv[0][1], y10 = acc[ai][1][m][0] * rs * gv[1][0], y11 = acc[ai][1][m][1] * rs * gv[1][1];
                    const f32x4 p0 = shfl_xor4(y00, 16), p1 = shfl_xor4(y01, 16);
                    if (fq < 2) {
                        const f32x4 c0 = rv[m & 1][0], c1 = rv[m & 1][1], s0 = rv[m & 1][2], s1 = rv[m & 1][3];
                        const float sg = fq ? 1.f : -1.f;
                        y00 = y00 * c0 + (p0 * s0) * sg; y01 = y01 * c1 + (p1 * s1) * sg;
                    }
                    const u32x4 w0 = pack8(y00 * osc, y01 * osc), w1 = pack8(y10 * osc, y11 * osc);
                    if (!meta) {
                        const size_t orow = isq ? (size_t)row : (size_t)((row >> 13) * SPAD + 64 + (row & 8191));
                        *(u32x4*)(dst + orow * 512 + colb) = w0; *(u32x4*)(dst + orow * 512 + colb + 32) = w1;
                    } else {
#pragma unroll 1
                        for (int b = 0; b < 4; ++b) { const size_t orow = (size_t)(b * SPAD + fr); *(u32x4*)(dst + orow * 512 + colb) = w0; *(u32x4*)(dst + orow * 512 + colb + 32) = w1; }
                    }
                }
              }
            }
        } else if (pn < 6) {
            const int colb = (pn - 4) * 256 + wc * 32 + 8 * fq;
#pragma unroll
            for (int ai = 0; ai < 2; ++ai)
#pragma unroll
                for (int m = 0; m < 4; ++m) {
                    if (meta && (ai || m)) continue;
                    const int row = rbase + ai * HALF + m * 16;
                    const u32x4 w0 = pack8(acc[ai][0][m][0], acc[ai][0][m][1]), w1 = pack8(acc[ai][1][m][0], acc[ai][1][m][1]);
                    if (!meta) {
                        const size_t orow = (size_t)((row >> 13) * SPAD + 64 + (row & 8191));
                        *(u32x4*)(V + orow * 512 + colb) = w0; *(u32x4*)(V + orow * 512 + colb + HALF) = w1;
                    } else {
#pragma unroll 1
                        for (int b = 0; b < 4; ++b) { const size_t orow = (size_t)(b * SPAD + fr); *(u32x4*)(V + orow * 512 + colb) = w0; *(u32x4*)(V + orow * 512 + colb + HALF) = w1; }
                    }
                }
        } else {
            const int colb = (pn - 6) * 128 + wc * 32 + 8 * fq;
#pragma unroll
            for (int ai = 0; ai < 2; ++ai)
#pragma unroll
                for (int m = 0; m < 4; ++m) {
                    if (meta && (ai || m)) continue;
                    const int row = rbase + ai * HALF + m * 16;
                    f32x4 h[2];
#pragma unroll
                    for (int n = 0; n < 2; ++n) { const f32x4 a = acc[ai][0][m][n], g = acc[ai][1][m][n];
#pragma unroll
                        for (int e = 0; e < 4; ++e) h[n][e] = a[e] * __builtin_amdgcn_rcpf(1.0f + __builtin_amdgcn_exp2f(-1.4426950408889634f * g[e])); }
                    const u32x4 w0 = pack8(h[0], h[1]);
                    if (!meta) {
                        const size_t orow = (size_t)((row >> 13) * SPAD + 64 + (row & 8191));
                        *(u32x4*)(G + orow * 512 + colb) = w0;
                    } else {
#pragma unroll 1
                        for (int b = 0; b < 4; ++b) { const size_t orow = (size_t)(b * SPAD + 48 + fr); *(u32x4*)(G + orow * 512 + colb) = w0; }
                    }
                }
        }
    }
};
struct EpiOut {
    static constexpr bool PERM = true, AFTER_DRAIN = false;
    const bf16_t* xn; const float* rn; const float* g1; bf16_t* hb; float* ssq;
    __device__ __forceinline__ void operator()(const f32x4 (&acc)[2][2][4][2], const Unit& u, int wr, int wc, int fr, int fq) const {
        const int rbase = u.pm * BM + wr * 64 + fr, colb = u.pn * BM + wc * 32 + 8 * fq;
        f32x4 ig[2][2];
#pragma unroll
        for (int bj = 0; bj < 2; ++bj)
#pragma unroll
            for (int n = 0; n < 2; ++n) { const f32x4 g = *(const f32x4*)(g1 + colb + bj * HALF + 4 * n);
#pragma unroll
                for (int e = 0; e < 4; ++e) ig[bj][n][e] = __builtin_amdgcn_rcpf(g[e]); }
#pragma unroll
        for (int ai = 0; ai < 2; ++ai) {
            u32x4 xv[4][2]; float rv[4];
#pragma unroll
            for (int m = 0; m < 4; ++m) { const int row = rbase + ai * HALF + m * 16; rv[m] = rn[row];
#pragma unroll
                for (int bj = 0; bj < 2; ++bj) xv[m][bj] = *(const u32x4*)(xn + (size_t)row * 1024 + colb + bj * HALF); }
            asm volatile("" ::: "memory");
#pragma unroll
            for (int m = 0; m < 4; ++m) {
                const int row = rbase + ai * HALF + m * 16; float ss = 0.f;
#pragma unroll
                for (int bj = 0; bj < 2; ++bj) { const size_t off = (size_t)row * 1024 + colb + bj * HALF; const u32x4 w = xv[m][bj];
                    f32x4 x0, x1;
                    x0[0] = __uint_as_float(w.x << 16); x0[1] = __uint_as_float(w.x & 0xffff0000u); x0[2] = __uint_as_float(w.y << 16); x0[3] = __uint_as_float(w.y & 0xffff0000u);
                    x1[0] = __uint_as_float(w.z << 16); x1[1] = __uint_as_float(w.z & 0xffff0000u); x1[2] = __uint_as_float(w.w << 16); x1[3] = __uint_as_float(w.w & 0xffff0000u);
                    const f32x4 h0 = x0 * rv[m] * ig[bj][0] + acc[ai][bj][m][0], h1 = x1 * rv[m] * ig[bj][1] + acc[ai][bj][m][1];
                    *(u32x4*)(hb + off) = pack8(h0, h1);
                    ss += (h0[0] * h0[0] + h0[1] * h0[1]) + (h0[2] * h0[2] + h0[3] * h0[3]) + (h1[0] * h1[0] + h1[1] * h1[1]) + (h1[2] * h1[2] + h1[3] * h1[3]); }
                ss += __shfl_xor(ss, 16); ss += __shfl_xor(ss, 32);
                if (fq == 0) ssq[(size_t)row * 16 + u.pn * 4 + wc] = ss;
            }
        }
    }
};
struct EpiUp {
    static constexpr bool PERM = true, AFTER_DRAIN = false;
    bf16_t* hb; const float* ssq;
    __device__ __forceinline__ void operator()(const f32x4 (&acc)[2][2][4][2], const Unit& u, int wr, int wc, int fr, int fq) const {
        const int rbase = u.pm * BM + wr * 64 + fr, colb = u.pn * BM + wc * 32 + 8 * fq;
#pragma unroll
        for (int ai = 0; ai < 2; ++ai) {
            f32x4 sv[4][4];
#pragma unroll
            for (int m = 0; m < 4; ++m) { const f32x4* sp = (const f32x4*)(ssq + (size_t)(rbase + ai * HALF + m * 16) * 16);
#pragma unroll
                for (int k = 0; k < 4; ++k) sv[m][k] = sp[k]; }
            asm volatile("" ::: "memory");
#pragma unroll
            for (int m = 0; m < 4; ++m) {
                const int row = rbase + ai * HALF + m * 16;
                const f32x4 s0 = sv[m][0], s1 = sv[m][1], s2 = sv[m][2], s3 = sv[m][3];
                const float tot = ((s0[0] + s0[1]) + (s0[2] + s0[3])) + ((s1[0] + s1[1]) + (s1[2] + s1[3])) + ((s2[0] + s2[1]) + (s2[2] + s2[3])) + ((s3[0] + s3[1]) + (s3[2] + s3[3]));
                const float rs = __builtin_amdgcn_rsqf(tot * (1.0f / 1024.0f) + 1e-6f);
#pragma unroll
                for (int bj = 0; bj < 2; ++bj) { f32x4 a0 = acc[ai][bj][m][0] * rs, a1 = acc[ai][bj][m][1] * rs;
#pragma unroll
                    for (int e = 0; e < 4; ++e) { const float p = fmaxf(a0[e], 0.f), q = fmaxf(a1[e], 0.f); a0[e] = p * p; a1[e] = q * q; }
                    __builtin_nontemporal_store(pack8(a0, a1), (u32x4*)(hb + (size_t)row * 4096 + colb + bj * HALF)); }
            }
        }
    }
};
struct EpiDown {
    static constexpr bool PERM = false, AFTER_DRAIN = false;
    const bf16_t* h1; float* out;
    __device__ __forceinline__ void operator()(const f32x4 (&acc)[2][2][4][2], const Unit& u, int wr, int wc, int fr, int fq) const {
        typedef unsigned u32x2 __attribute__((ext_vector_type(2)));
        const int rbase = u.pm * BM + wr * 64 + fr, colb = u.pn * BM + wc * 32 + 4 * fq;
        const bool odd = (fr & 1) != 0;
#pragma unroll
        for (int ai = 0; ai < 2; ++ai) {
            u32x2 hv[4][2][2];
#pragma unroll
            for (int m = 0; m < 4; ++m)
#pragma unroll
                for (int bj = 0; bj < 2; ++bj)
#pragma unroll
                    for (int n = 0; n < 2; ++n) hv[m][bj][n] = *(const u32x2*)(h1 + (size_t)(rbase + ai * HALF + m * 16) * 1024 + colb + bj * HALF + 16 * n);
            asm volatile("" ::: "memory");
#pragma unroll
            for (int m = 0; m < 4; ++m) {
                const int row = rbase + ai * HALF + m * 16, row_e = row - (odd ? 1 : 0);
#pragma unroll
                for (int bj = 0; bj < 2; ++bj) {
                    f32x4 a[2];
#pragma unroll
                    for (int n = 0; n < 2; ++n) { const u32x2 w = hv[m][bj][n];
                        f32x4 r; r[0] = __uint_as_float(w.x << 16); r[1] = __uint_as_float(w.x & 0xffff0000u); r[2] = __uint_as_float(w.y << 16); r[3] = __uint_as_float(w.y & 0xffff0000u);
                        a[n] = r + acc[ai][bj][m][n]; }
                    const f32x4 snd = odd ? a[0] : a[1]; f32x4 rcv;
#pragma unroll
                    for (int e = 0; e < 4; ++e) rcv[e] = __int_as_float(__builtin_amdgcn_update_dpp(0, __float_as_int(snd[e]), 0xB1, 0xF, 0xF, true));
                    const size_t off = (size_t)row_e * 1024 + colb + bj * HALF + (odd ? 16 : 0);
                    __builtin_nontemporal_store(odd ? rcv : a[0], (f32x4*)(out + off));
                    __builtin_nontemporal_store(odd ? a[1] : rcv, (f32x4*)(out + off + 1024)); }
            }
        }
    }
};


template <class Epi, class Sched, bool ALIGN_EPI = false, bool SP2 = false>
__device__ __forceinline__ void gemm_phase(PG8_LAS unsigned char* lds, const Gemm g, const Sched& S, const Epi& E) {
    int tid_ = threadIdx.x; asm volatile("" : "+v"(tid_));
    const int tid = tid_, wid = __builtin_amdgcn_readfirstlane(tid >> 6), lane = tid & 63, wr = wid >> 2, wc = wid & 3, fr = lane & 15, fq = lane >> 4;
    const int K = g.K, nt = K / BK;
    unsigned voffA[2], voffB[2];
#pragma unroll
    for (int i = 0; i < 2; ++i) { int R, C; stage_rc(tid * 16 + i * 8192, R, C); const int Rb = Epi::PERM ? ((R & ~31) + perm32(R & 31)) : R;
        voffA[i] = (unsigned)(R * K + C) * 2u; voffB[i] = (unsigned)(Rb * K + C) * 2u; }
    const size_t kstep = (size_t)(BK * 2);
    const size_t hstep = (size_t)HALF * K * 2;
    const size_t tstep = 2 * hstep;
    const unsigned ldsw = (unsigned)wid * 1024u;
    const int aoff = lds_byte(wr * 64 + fr, fq * 8), boff = lds_byte(wc * 32 + fr, fq * 8);
#define PG8_SA(b, h) (((b) * 2 + (h)) * HTB)
#define PG8_SB(b, h) ((4 + (b) * 2 + (h)) * HTB)
#define PG8_STAGE(bufoff, gbase, voff) do { _Pragma("unroll") for (int _i = 0; _i < 2; ++_i) \
        __builtin_amdgcn_global_load_lds((const unsigned*)((const char*)(gbase) + (voff)[_i]), (PG8_LAS unsigned*)(lds + (bufoff) + ldsw + _i * 8192), 16, 0, 0); } while (0)
#define PG8_LDA(dst, b, h) do { _Pragma("unroll") for (int m = 0; m < 4; ++m) _Pragma("unroll") for (int k = 0; k < 2; ++k) dst[m][k] = *(const PG8_LAS bf16x8*)(lds + PG8_SA(b, h) + aoff + m * 2048 + k * 1024); } while (0)
#define PG8_LDB(dst, b, h) do { _Pragma("unroll") for (int n = 0; n < 2; ++n) _Pragma("unroll") for (int k = 0; k < 2; ++k) dst[n][k] = *(const PG8_LAS bf16x8*)(lds + PG8_SB(b, h) + boff + n * 2048 + k * 1024); } while (0)
#define PG8_MMA(ai, bj, At, Bt) do { __builtin_amdgcn_s_setprio(1); _Pragma("unroll") for (int m = 0; m < 4; ++m) _Pragma("unroll") for (int n = 0; n < 2; ++n) _Pragma("unroll") for (int k = 0; k < 2; ++k) \
        acc[ai][bj][m][n] = __builtin_amdgcn_mfma_f32_16x16x32_bf16(Bt[n][k], At[m][k], acc[ai][bj][m][n], 0, 0, 0); __builtin_amdgcn_s_setprio(0); } while (0)
#define PG8_WAIT_V(n) asm volatile("s_waitcnt vmcnt(" #n ")" ::: "memory")
#define PG8_WAIT_L(n) asm volatile("s_waitcnt lgkmcnt(" #n ")" ::: "memory")
#define PG8_BAR __builtin_amdgcn_s_barrier()
#define PG8_SCHED __builtin_amdgcn_sched_barrier(0)
    Unit cur, nxt; int ui = 0;
    if (!S.next(0, cur)) return;
    f32x4 acc[2][2][4][2];
#pragma unroll
    for (int a = 0; a < 2; ++a)
#pragma unroll
        for (int b = 0; b < 2; ++b)
#pragma unroll
            for (int m = 0; m < 4; ++m)
#pragma unroll
                for (int n = 0; n < 2; ++n) acc[a][b][m][n] = (f32x4){0.f, 0.f, 0.f, 0.f};
    bf16x8 At[4][2], B0[2][2], B1[2][2];
    const char* cA = (const char*)g.A + (size_t)cur.pm * tstep; const char* cB = (const char*)g.Bt + (size_t)cur.pn * tstep;
    S.a_ready(cur);
    if constexpr (SP2) {
        PG8_STAGE(PG8_SB(0, 0), cB, voffB); PG8_STAGE(PG8_SB(0, 1), cB + hstep, voffB); PG8_STAGE(PG8_SA(0, 0), cA, voffA); PG8_STAGE(PG8_SA(0, 1), cA + hstep, voffA);
        if (wr == 1) PG8_BAR;
        PG8_WAIT_V(2); PG8_BAR;
        PG8_STAGE(PG8_SB(1, 0), cB + kstep, voffB); PG8_STAGE(PG8_SA(1, 0), cA + kstep, voffA); PG8_STAGE(PG8_SB(1, 1), cB + hstep + kstep, voffB);
        PG8_WAIT_V(6); PG8_BAR;
    } else {
        PG8_STAGE(PG8_SB(0, 0), cB, voffB); PG8_STAGE(PG8_SA(0, 0), cA, voffA); PG8_STAGE(PG8_SB(0, 1), cB + hstep, voffB); PG8_STAGE(PG8_SA(0, 1), cA + hstep, voffA);
        if (wr == 1) PG8_BAR;
        PG8_WAIT_V(4); PG8_BAR;
        PG8_STAGE(PG8_SB(1, 0), cB + kstep, voffB); PG8_STAGE(PG8_SA(1, 0), cA + kstep, voffA); PG8_STAGE(PG8_SB(1, 1), cB + hstep + kstep, voffB);
        PG8_WAIT_V(6); PG8_BAR;
    }
    for (;;) {
        const bool has_next = S.next(ui + 1, nxt);
        const char* nA = has_next ? (const char*)g.A + (size_t)nxt.pm * tstep : cA; const char* nB = has_next ? (const char*)g.Bt + (size_t)nxt.pn * tstep : cB;
        for (int t = 0; t < nt; t += 2) {
            const bool last = (t == nt - 2);
            const char* a1 = cA + (size_t)(t + 1) * kstep;
            const char* a2 = last ? nA : cA + (size_t)(t + 2) * kstep; const char* b2 = last ? nB : cB + (size_t)(t + 2) * kstep;
            const char* a3 = a2 + kstep; const char* b3 = b2 + kstep;
            if (last && has_next) S.a_ready(nxt);
            if constexpr (SP2) {
            PG8_LDB(B0, 0, 0); PG8_LDB(B1, 0, 1); PG8_SCHED; PG8_LDA(At, 0, 0); PG8_STAGE(PG8_SA(1, 1), a1 + hstep, voffA);
            PG8_WAIT_V(8); PG8_WAIT_L(0); PG8_BAR; PG8_MMA(0, 0, At, B0); PG8_MMA(0, 1, At, B1); PG8_BAR; PG8_SCHED;
            PG8_LDA(At, 0, 1); PG8_STAGE(PG8_SB(0, 0), b2, voffB); PG8_STAGE(PG8_SB(0, 1), b2 + hstep, voffB); PG8_STAGE(PG8_SA(0, 0), a2, voffA);
            PG8_WAIT_V(8); PG8_WAIT_L(0); PG8_BAR; PG8_MMA(1, 0, At, B0); PG8_MMA(1, 1, At, B1); PG8_BAR; PG8_SCHED;
            PG8_LDB(B0, 1, 0); PG8_LDB(B1, 1, 1); PG8_SCHED; PG8_LDA(At, 1, 0); PG8_STAGE(PG8_SA(0, 1), a2 + hstep, voffA);
            PG8_WAIT_V(8); PG8_WAIT_L(0); PG8_BAR; PG8_MMA(0, 0, At, B0); PG8_MMA(0, 1, At, B1); PG8_BAR; PG8_SCHED;
            PG8_LDA(At, 1, 1); PG8_STAGE(PG8_SB(1, 0), b3, voffB); PG8_STAGE(PG8_SB(1, 1), b3 + hstep, voffB); PG8_STAGE(PG8_SA(1, 0), a3, voffA);
            PG8_WAIT_V(8); PG8_WAIT_L(0); PG8_BAR; PG8_MMA(1, 0, At, B0); PG8_MMA(1, 1, At, B1); PG8_BAR; PG8_SCHED;
            } else {
            PG8_LDB(B0, 0, 0); PG8_SCHED; PG8_LDA(At, 0, 0); PG8_STAGE(PG8_SA(1, 1), a1 + hstep, voffA);
            PG8_WAIT_L(8); PG8_BAR; PG8_WAIT_L(0); PG8_MMA(0, 0, At, B0); PG8_BAR; PG8_SCHED;
            PG8_LDB(B1, 0, 1); PG8_STAGE(PG8_SB(0, 0), b2, voffB);
            PG8_BAR; PG8_WAIT_L(0); PG8_MMA(0, 1, At, B1); PG8_BAR;
            PG8_LDA(At, 0, 1); PG8_STAGE(PG8_SA(0, 0), a2, voffA);
            PG8_BAR; PG8_WAIT_L(0); PG8_MMA(1, 0, At, B0); PG8_BAR; PG8_SCHED;
            PG8_STAGE(PG8_SB(0, 1), b2 + hstep, voffB);
            PG8_WAIT_V(6); PG8_BAR; PG8_MMA(1, 1, At, B1); PG8_BAR;
            PG8_LDB(B0, 1, 0); PG8_SCHED; PG8_LDA(At, 1, 0); PG8_STAGE(PG8_SA(0, 1), a2 + hstep, voffA);
            PG8_WAIT_L(8); PG8_BAR; PG8_WAIT_L(0); PG8_MMA(0, 0, At, B0); PG8_BAR; PG8_SCHED;
            PG8_LDB(B1, 1, 1); PG8_STAGE(PG8_SB(1, 0), b3, voffB);
            PG8_BAR; PG8_WAIT_L(0); PG8_MMA(0, 1, At, B1); PG8_BAR;
            PG8_LDA(At, 1, 1); PG8_STAGE(PG8_SA(1, 0), a3, voffA);
            PG8_BAR; PG8_WAIT_L(0); PG8_MMA(1, 0, At, B0); PG8_BAR; PG8_SCHED;
            PG8_STAGE(PG8_SB(1, 1), b3 + hstep, voffB);
            PG8_WAIT_V(6); PG8_BAR; PG8_MMA(1, 1, At, B1); PG8_BAR;
            }
        }
        if constexpr (ALIGN_EPI) { if (wr == 0) PG8_BAR; }
        if constexpr (!Epi::AFTER_DRAIN) { E(acc, cur, wr, wc, fr, fq); S.done(cur); }
        if (!has_next) break;
#pragma unroll
        for (int a = 0; a < 2; ++a)
#pragma unroll
            for (int b = 0; b < 2; ++b)
#pragma unroll
                for (int m = 0; m < 4; ++m)
#pragma unroll
                    for (int n = 0; n < 2; ++n) acc[a][b][m][n] = (f32x4){0.f, 0.f, 0.f, 0.f};
        cur = nxt; cA = nA; cB = nB; ++ui;
        if constexpr (ALIGN_EPI) { if (wr == 1) PG8_BAR; }
    }
    PG8_WAIT_V(0);
    if constexpr (!ALIGN_EPI) { if (wr == 0) PG8_BAR; }
    PG8_BAR;
    if constexpr (Epi::AFTER_DRAIN) { E.fused(acc, cur, wr, wc, fr, fq, lds, wid, lane); S.done(cur); }
#undef PG8_SA
#undef PG8_SB
#undef PG8_STAGE
#undef PG8_LDA
#undef PG8_LDB
#undef PG8_MMA
#undef PG8_WAIT_V
#undef PG8_WAIT_L
#undef PG8_BAR
#undef PG8_SCHED
}
}

#ifndef PG8_SP2
#define PG8_SP2 true
#endif
#ifndef PG8_ALIGN
#define PG8_ALIGN true
#endif
#include <hip/hip_bf16.h>
#include <cmath>
namespace attn_body {
using bf16=__hip_bfloat16;
using bf16x8=__attribute__((ext_vector_type(8)))short;
using s16x4=__attribute__((ext_vector_type(4)))short;
using f32x16=__attribute__((ext_vector_type(16)))float;
using u32x4=__attribute__((ext_vector_type(4)))unsigned;
constexpr int SEQ=8192,D=64,PQ=512,PO=1024;
constexpr int NW=8,QBLK=32,QB=QBLK*NW,KVBLK=64,NQB=SEQ/QB;
constexpr int ATTN_UNIT_ROWS=QB;
__device__ __forceinline__ int crow(int r,int hi){return (r&3)+8*(r>>2)+4*hi;}
#define SBAR() __builtin_amdgcn_sched_barrier(0)
__device__ __forceinline__ void cmask(f32x16&p0,f32x16&p1,int jb,int qrel,int hi){
  const float NEG=-INFINITY; int kb=64*jb+4*hi;
  #pragma unroll
  for(int r=0;r<16;++r){int kv=kb+(r&3)+8*(r>>2); if(kv>qrel)p0[r]=NEG; if(kv+32>qrel)p1[r]=NEG;}
}

constexpr int NSLOT=3, SLOTB=8192;
constexpr int LDS_K=0, LDS_V=NSLOT*SLOTB, LDS_WS=2*NSLOT*SLOTB, LDS_OST=LDS_WS+NW*64*4, LDS_BYTES=LDS_OST+NW*4096;
constexpr float C2=0.125f*1.4426950408889634f;
__device__ __forceinline__ void glds16(const void*gsrc,unsigned lds_dst){unsigned keep;
  asm volatile("s_mov_b32 %0, m0\n\ts_mov_b32 m0, %2\n\ts_nop 0\n\tglobal_load_lds_dwordx4 %1, off\n\ts_mov_b32 m0, %0":"=&s"(keep):"v"(gsrc),"s"(lds_dst):"memory");}
__device__ __forceinline__ float max3f(float a,float b,float c){float r;asm("v_max3_f32 %0, %1, %2, %3":"=v"(r):"v"(a),"v"(b),"v"(c));return r;}
__device__ __forceinline__ float max2f(float a,float b){float r;asm("v_max_f32_e32 %0, %1, %2":"=v"(r):"v"(a),"v"(b));return r;}
__device__ __forceinline__ float fadd_s(float a,float b){float r;asm("v_add_f32_e32 %0, %1, %2":"=v"(r):"v"(a),"v"(b));return r;}
__device__ __forceinline__ float fsub_s(float a,float b){float r;asm("v_sub_f32_e32 %0, %1, %2":"=v"(r):"v"(a),"v"(b));return r;}
typedef float f32x2_t __attribute__((ext_vector_type(2))); typedef __bf16 bf16x2_t __attribute__((ext_vector_type(2)));
__device__ __forceinline__ unsigned cvtpk_s(float lo,float hi){f32x2_t v={lo,hi};bf16x2_t b=__builtin_convertvector(v,bf16x2_t);return __builtin_bit_cast(unsigned,b);}
#define WAIT_BAR(N) asm volatile("s_waitcnt vmcnt(" #N ") lgkmcnt(0)\n\ts_barrier":::"memory")

__device__ __forceinline__ void qkt(f32x16&p0,f32x16&p1,const char*Kslot,const bf16x8*qr,const f32x16&negm,int r32,int hi){
  const char*kb=Kslot+hi*1024+r32*16;
  #pragma unroll
  for(int d0=0;d0<4;++d0){
    const bf16x8 b0=*reinterpret_cast<const bf16x8*>(kb+d0*2048);
    const bf16x8 b1=*reinterpret_cast<const bf16x8*>(kb+d0*2048+512);
    if(d0==0){p0=__builtin_amdgcn_mfma_f32_32x32x16_bf16(b0,qr[0],negm,0,0,0);p1=__builtin_amdgcn_mfma_f32_32x32x16_bf16(b1,qr[0],negm,0,0,0);}
    else{p0=__builtin_amdgcn_mfma_f32_32x32x16_bf16(b0,qr[d0],p0,0,0,0);p1=__builtin_amdgcn_mfma_f32_32x32x16_bf16(b1,qr[d0],p1,0,0,0);}}
}
typedef __attribute__((address_space(3))) const char* lds_cptr;
typedef short v4i16_t __attribute__((ext_vector_type(4)));
__device__ __forceinline__ void kload8(bf16x8*kf,lds_cptr kp){
  kf[0]=*(const __attribute__((address_space(3))) bf16x8*)(kp);      kf[1]=*(const __attribute__((address_space(3))) bf16x8*)(kp+512);
  kf[2]=*(const __attribute__((address_space(3))) bf16x8*)(kp+2048); kf[3]=*(const __attribute__((address_space(3))) bf16x8*)(kp+2560);
  kf[4]=*(const __attribute__((address_space(3))) bf16x8*)(kp+4096); kf[5]=*(const __attribute__((address_space(3))) bf16x8*)(kp+4608);
  kf[6]=*(const __attribute__((address_space(3))) bf16x8*)(kp+6144); kf[7]=*(const __attribute__((address_space(3))) bf16x8*)(kp+6656);
}
__device__ __forceinline__ void kload2(bf16x8*kf,lds_cptr kp,int j){ kf[2*j]=*(const __attribute__((address_space(3))) bf16x8*)(kp+j*2048); kf[2*j+1]=*(const __attribute__((address_space(3))) bf16x8*)(kp+j*2048+512); }
__device__ __forceinline__ s16x4 vtr(lds_cptr p){ return __builtin_bit_cast(s16x4,__builtin_amdgcn_ds_read_tr16_b64_v4i16((__attribute__((address_space(3))) v4i16_t*)p)); }
__device__ __forceinline__ float rowmax(const f32x16&p0,const f32x16&p1){
  float a=max3f(p0[0],p0[1],p1[0]),b=max3f(p0[2],p0[3],p1[1]);a=max3f(a,p1[2],p1[3]);
  #pragma unroll
  for(int r=4;r<16;r+=4){a=max3f(a,p0[r],p0[r+1]);b=max3f(b,p0[r+2],p0[r+3]);a=max3f(a,p1[r],p1[r+1]);b=max3f(b,p1[r+2],p1[r+3]);}
  const float m=max2f(a,b);
  auto rr=__builtin_amdgcn_permlane32_swap(__float_as_uint(m),__float_as_uint(m),false,false);
  return max2f(__uint_as_float(rr[0]),__uint_as_float(rr[1]));
}
__device__ __forceinline__ void pv(f32x16*o,int vb,bf16x8 pa0,bf16x8 pa1,bf16x8 pa2,bf16x8 pa3){
  #pragma unroll
  for(int d0=0;d0<2;++d0){s16x4 lo[4],hi[4];
    #pragma unroll
    for(int ks=0;ks<4;++ks){
      asm volatile("ds_read_b64_tr_b16 %0,%1 offset:%c2":"=&v"(lo[ks]):"v"(vb),"i"(d0*4096+ks*1024):"memory");
      asm volatile("ds_read_b64_tr_b16 %0,%1 offset:%c2":"=&v"(hi[ks]):"v"(vb),"i"(d0*4096+ks*1024+512):"memory");}
    asm volatile("s_waitcnt lgkmcnt(0)":::"memory");SBAR();
    #define PK(k) (bf16x8){lo[k][0],lo[k][1],lo[k][2],lo[k][3],hi[k][0],hi[k][1],hi[k][2],hi[k][3]}
    o[d0]=__builtin_amdgcn_mfma_f32_32x32x16_bf16(pa0,PK(0),o[d0],0,0,0);
    o[d0]=__builtin_amdgcn_mfma_f32_32x32x16_bf16(pa1,PK(1),o[d0],0,0,0);
    o[d0]=__builtin_amdgcn_mfma_f32_32x32x16_bf16(pa2,PK(2),o[d0],0,0,0);
    o[d0]=__builtin_amdgcn_mfma_f32_32x32x16_bf16(pa3,PK(3),o[d0],0,0,0);
    #undef PK
  }
}

#ifndef ATTN_STORE16
#define ATTN_STORE16(p,v) (*(u32x4*)(p)=(v))
#endif
template<int THRL> __device__ __forceinline__ void attn_unit(int q0,const bf16*Qu,const bf16*__restrict__ Kh,const bf16*__restrict__ Vh,bf16*Ou,char*shm){
  int tid_=threadIdx.x; asm volatile("":"+v"(tid_)); const int tid=tid_,lane=tid&63,r32=lane&31,hi=lane>>5; const int wid=__builtin_amdgcn_readfirstlane(tid>>6);
  const bf16*Qw=Qu+(long)(wid*QBLK)*PQ;
  const unsigned lds0=(unsigned)(uintptr_t)shm;
  float*wsf=(float*)(shm+LDS_WS)+wid*64;
  const bf16*ksrc=Kh+(long)lane*PQ+wid*8;
  const bf16*vsrc=Vh+(long)(16*(wid&3)+(lane>>2))*PQ+(wid>>2)*32+(lane&3)*8;
  const unsigned kdst=lds0+LDS_K+wid*1024, vdst=lds0+LDS_V+wid*1024;
  #define DMA_K(t,slot) glds16(ksrc+(long)(t)*KVBLK*PQ,(unsigned)__builtin_amdgcn_readfirstlane(kdst+(slot)))
  #define DMA_V(t,slot) glds16(vsrc+(long)(t)*KVBLK*PQ,(unsigned)__builtin_amdgcn_readfirstlane(vdst+(slot)))
  const int vb0=(int)(lds0+LDS_V)+((lane>>4)&1)*32+(lane&3)*8+(4*hi+((lane&15)>>2))*64;
  const char*Kbase=shm+LDS_K; bf16x8 kf[8];
  const lds_cptr shm3=(lds_cptr)shm; const lds_cptr kp0=shm3+LDS_K+hi*1024+r32*16; const lds_cptr vp0=shm3+LDS_V+((lane>>4)&1)*32+(lane&3)*8+(4*hi+((lane&15)>>2))*64;
  const int NT=(q0+QB)/KVBLK+1;
  DMA_K(0,0);DMA_V(0,0);DMA_K(1,SLOTB);
  bf16x8 qr[4];
  #pragma unroll
  for(int d0=0;d0<4;++d0)qr[d0]=*reinterpret_cast<const bf16x8*>(&Qw[(long)r32*PQ+d0*16+hi*8]);
  float mhat=0.f,l_reg=0.f;f32x16 o[2];o[0]=f32x16{};o[1]=f32x16{};f32x16 negm=f32x16{};asm volatile("":"+v"(negm));
  const int qrel=wid*QBLK+r32;
  #define CMASK(P0,P1,t) do{int jb_=(t)-(NT-4); if(jb_>=0)cmask(P0,P1,jb_,qrel,hi);}while(0)
  bool resc=false;
  #define START(P0,P1) do{ const float rm=rowmax(P0,P1); resc=false; \
    { const float dl=rm; mhat=fadd_s(mhat,dl); \
      _Pragma("unroll") for(int r=0;r<16;++r){P0[r]=fsub_s(P0[r],dl);P1[r]=fsub_s(P1[r],dl);} \
      _Pragma("unroll") for(int r=0;r<16;++r)negm[r]=-mhat; asm volatile("":"+v"(negm)); } \
    _Pragma("unroll") for(int r=0;r<16;++r)P0[r]=__builtin_amdgcn_exp2f(P0[r]); }while(0)
  #define RESC() do{ if(resc){ asm volatile("s_waitcnt lgkmcnt(0)":::"memory"); \
      _Pragma("unroll") for(int d_=0;d_<2;++d_) _Pragma("unroll") for(int r=0;r<16;++r)o[d_][r]*=wsf[crow(r,hi)]; } }while(0)
  f32x16 pA0,pA1,pB0,pB1;
  int sl_prev=0,sl_cur=0,sl_next=SLOTB;
  #define ROT() do{sl_prev=sl_cur;sl_cur=sl_next;sl_next=(sl_next==(NSLOT-1)*SLOTB)?0:sl_next+SLOTB;}while(0)
  DMA_K(2,2*SLOTB);
  WAIT_BAR(3);
  qkt(pA0,pA1,Kbase,qr,negm,r32,hi);asm volatile("s_nop 15\n\ts_nop 7":"+v"(pA0),"+v"(pA1));
  { const float NEGI=-INFINITY; _Pragma("unroll") for(int r=8;r<16;++r)pA0[r]=NEGI; _Pragma("unroll") for(int r=0;r<16;++r)pA1[r]=NEGI; }
  START(pA0,pA1);
  _Pragma("unroll") for(int r=0;r<16;++r)pA1[r]=__builtin_amdgcn_exp2f(pA1[r]);
  WAIT_BAR(0);
  DMA_K(3,0);DMA_V(1,SLOTB);
  ROT();
  kload8(kf,kp0+sl_cur);
  WAIT_BAR(2);
  s16x4 vlo[8],vhi[8]; u32x4 pw0,pw1,pw2,pw3;
  #define PKW(P,B) cvtpk_s(P[B],P[B+1])
  #define PAF(k) __builtin_bit_cast(bf16x8,pw##k)
  #define VFR(i) (bf16x8){vlo[i][0],vlo[i][1],vlo[i][2],vlo[i][3],vhi[i][0],vhi[i][1],vhi[i][2],vhi[i][3]}
  #define PIN(x) asm volatile("":"+v"(x))
  #define MX3(a,b,c) __builtin_fmaxf(__builtin_fmaxf((a),(b)),(c))
  #define GAPA(MF,A0,A1,A2,A3,W0,W1,PW) do{ MF; sacc+=A0; sacc+=A1; sacc+=A2; sacc+=A3; PIN(sacc); W0; W1; PIN(PW); SBAR(); }while(0)
  #define EX(v) __builtin_amdgcn_exp2f(v)
  #define GAPB(MF,X,B) do{ MF; X[B]=EX(X[B]); X[B+1]=EX(X[B+1]); X[B+2]=EX(X[B+2]); X[B+3]=EX(X[B+3]); PIN(X); SBAR(); }while(0)
  #define VRD(i) do{ vlo[i]=vtr(vp_+(((i)>>2)*4096+((i)&3)*1024)); vhi[i]=vtr(vp_+(((i)>>2)*4096+((i)&3)*1024+512)); }while(0)
  #define KRD(G,j) do{ if(G){ kload2(kf,kp0+sl_next,j); SBAR(); } }while(0)
  #define STEP(C0,C1,P0,P1,t,GK,GV,GL) do{ SBAR(); \
    const lds_cptr vp_=vp0+sl_prev; \
    VRD(0); SBAR(); float sacc=(P0[0]+P0[1]); \
    GAPA(C0=__builtin_amdgcn_mfma_f32_32x32x16_bf16(kf[0],qr[0],negm,0,0,0), P0[2],P0[3],P0[4],P0[5],     pw0[0]=PKW(P0,0), pw0[1]=PKW(P0,2), pw0); \
    VRD(4); SBAR(); GAPA(C1=__builtin_amdgcn_mfma_f32_32x32x16_bf16(kf[1],qr[0],negm,0,0,0), P0[6],P0[7],P0[8],P0[9],     pw0[2]=PKW(P0,4), pw0[3]=PKW(P0,6), pw0); \
    VRD(1); SBAR(); GAPA(C0=__builtin_amdgcn_mfma_f32_32x32x16_bf16(kf[2],qr[1],C0,0,0,0),   P0[10],P0[11],P0[12],P0[13], pw1[0]=PKW(P0,8), pw1[1]=PKW(P0,10), pw1); \
    VRD(5); SBAR(); GAPA(C1=__builtin_amdgcn_mfma_f32_32x32x16_bf16(kf[3],qr[1],C1,0,0,0),   P0[14],P0[15],P1[0],P1[1],   pw1[2]=PKW(P0,12),pw1[3]=PKW(P0,14), pw1); \
    VRD(2); SBAR(); GAPA(C0=__builtin_amdgcn_mfma_f32_32x32x16_bf16(kf[4],qr[2],C0,0,0,0),   P1[2],P1[3],P1[4],P1[5],     pw2[0]=PKW(P1,0), pw2[1]=PKW(P1,2), pw2); \
    VRD(6); SBAR(); GAPA(C1=__builtin_amdgcn_mfma_f32_32x32x16_bf16(kf[5],qr[2],C1,0,0,0),   P1[6],P1[7],P1[8],P1[9],     pw2[2]=PKW(P1,4), pw2[3]=PKW(P1,6), pw2); \
    VRD(3); SBAR(); GAPA(C0=__builtin_amdgcn_mfma_f32_32x32x16_bf16(kf[6],qr[3],C0,0,0,0),   P1[10],P1[11],P1[12],P1[13], pw3[0]=PKW(P1,8), pw3[1]=PKW(P1,10), pw3); \
    VRD(7); SBAR(); GAPA(C1=__builtin_amdgcn_mfma_f32_32x32x16_bf16(kf[7],qr[3],C1,0,0,0),   P1[14],P1[15],0.f,0.f,       pw3[2]=PKW(P1,12),pw3[3]=PKW(P1,14), pw3); \
    l_reg+=sacc; \
    if(GK){DMA_K((t)+3,sl_cur);} if(GV){DMA_V((t)+1,sl_next);} \
    CMASK(C0,C1,t); \
    { float a=MX3(C0[0],C0[1],C1[0]),b=MX3(C0[2],C0[3],C1[1]); a=MX3(a,C1[2],C1[3]); \
      _Pragma("unroll") for(int r=4;r<16;r+=4){a=MX3(a,C0[r],C0[r+1]);b=MX3(b,C0[r+2],C0[r+3]);a=MX3(a,C1[r],C1[r+1]);b=MX3(b,C1[r+2],C1[r+3]);} \
      float rm=__builtin_fmaxf(a,b); { auto rr=__builtin_amdgcn_permlane32_swap(__float_as_uint(rm),__float_as_uint(rm),false,false); rm=__builtin_fmaxf(__uint_as_float(rr[0]),__uint_as_float(rr[1])); } \
      resc=false; \
      if(__builtin_expect(__any(rm>(float)THRL),0)){ const float dl=__builtin_fmaxf(rm,0.f); mhat+=dl; \
        _Pragma("unroll") for(int r=0;r<16;++r){C0[r]-=dl;C1[r]-=dl;} \
        _Pragma("unroll") for(int r=0;r<16;++r)negm[r]=-mhat; asm volatile("":"+v"(negm)); \
        const float f=__builtin_amdgcn_exp2f(-dl); l_reg*=f; if(hi==0)wsf[r32]=f; resc=true; } } \
    SBAR(); \
    GAPB(o[0]=__builtin_amdgcn_mfma_f32_32x32x16_bf16(PAF(0),VFR(0),o[0],0,0,0), C0,0); \
    GAPB(o[1]=__builtin_amdgcn_mfma_f32_32x32x16_bf16(PAF(0),VFR(4),o[1],0,0,0), C0,4); \
    KRD(GL,0); GAPB(o[0]=__builtin_amdgcn_mfma_f32_32x32x16_bf16(PAF(1),VFR(1),o[0],0,0,0), C0,8); \
    KRD(GL,1); GAPB(o[1]=__builtin_amdgcn_mfma_f32_32x32x16_bf16(PAF(1),VFR(5),o[1],0,0,0), C0,12); \
    KRD(GL,2); GAPB(o[0]=__builtin_amdgcn_mfma_f32_32x32x16_bf16(PAF(2),VFR(2),o[0],0,0,0), C1,0); \
    KRD(GL,3); GAPB(o[1]=__builtin_amdgcn_mfma_f32_32x32x16_bf16(PAF(2),VFR(6),o[1],0,0,0), C1,4); \
    GAPB(o[0]=__builtin_amdgcn_mfma_f32_32x32x16_bf16(PAF(3),VFR(3),o[0],0,0,0), C1,8); \
    GAPB(o[1]=__builtin_amdgcn_mfma_f32_32x32x16_bf16(PAF(3),VFR(7),o[1],0,0,0), C1,12); \
    }while(0)
  int t=1;
  #undef CMASK
  #define CMASK(P0,P1,t) do{}while(0)
  for(;t+5<NT;t+=2){
    STEP(pB0,pB1,pA0,pA1,t,true,true,true);     WAIT_BAR(2); RESC(); ROT();
    STEP(pA0,pA1,pB0,pB1,t+1,true,true,true);   WAIT_BAR(2); RESC(); ROT();
  }
  #undef CMASK
  #define CMASK(P0,P1,t) do{int jb_=(t)-(NT-4); if(jb_>=0)cmask(P0,P1,jb_,qrel,hi);}while(0)
  #define ENDW(tt) do{ if((tt)+3<NT){WAIT_BAR(2);} else if((tt)+2<NT){WAIT_BAR(1);} else {WAIT_BAR(0);} }while(0)
  for(;t+1<NT;t+=2){
    STEP(pB0,pB1,pA0,pA1,t,(t+3<NT),(t+1<NT),(t+1<NT));       ENDW(t);   RESC(); ROT();
    STEP(pA0,pA1,pB0,pB1,t+1,(t+4<NT),(t+2<NT),(t+2<NT));     ENDW(t+1); RESC(); ROT();
  }
  { float sacc=pA0[0]+pA0[1]; _Pragma("unroll") for(int r=2;r<16;++r)sacc+=pA0[r]; _Pragma("unroll") for(int r=0;r<16;++r)sacc+=pA1[r]; l_reg+=sacc;
    pw0=(u32x4){PKW(pA0,0),PKW(pA0,2),PKW(pA0,4),PKW(pA0,6)};pw1=(u32x4){PKW(pA0,8),PKW(pA0,10),PKW(pA0,12),PKW(pA0,14)};pw2=(u32x4){PKW(pA1,0),PKW(pA1,2),PKW(pA1,4),PKW(pA1,6)};pw3=(u32x4){PKW(pA1,8),PKW(pA1,10),PKW(pA1,12),PKW(pA1,14)};
    SBAR(); pv(o,vb0+sl_prev,PAF(0),PAF(1),PAF(2),PAF(3)); }
  #undef PKW
  #undef PAF
  #undef VFR
  #undef PIN
  #undef MX3
  #undef GAPA
  #undef GAPB
  #undef EX
  #undef VRD
  #undef KRD
  #undef STEP
  #undef ENDW
  {auto rr=__builtin_amdgcn_permlane32_swap(__float_as_uint(l_reg),__float_as_uint(l_reg),false,false);l_reg=__uint_as_float(rr[0])+__uint_as_float(rr[1]);}
  if(hi==0)wsf[32+r32]=l_reg;asm volatile("s_waitcnt lgkmcnt(0)":::"memory");
  float rli[16];
  #pragma unroll
  for(int r=0;r<16;++r)rli[r]=__builtin_amdgcn_rcpf(wsf[32+crow(r,hi)]);
  bf16*Ow=Ou+(long)(wid*QBLK)*PO;
  { bf16*stg=(bf16*)(shm+LDS_OST)+wid*2048;
    #pragma unroll
    for(int r=0;r<16;++r){const int orow=crow(r,hi);
      #pragma unroll
      for(int d0=0;d0<2;++d0)stg[orow*64+d0*32+r32]=__float2bfloat16(o[d0][r]*rli[r]);}
    asm volatile("s_waitcnt lgkmcnt(0)":::"memory");
    #pragma unroll
    for(int i=0;i<4;++i){const int row=i*8+(lane>>3),ch=lane&7; const u32x4 v=*(const u32x4*)(stg+row*64+ch*8); ATTN_STORE16(Ow+(long)row*PO+ch*8,v);} }
  asm volatile("s_waitcnt lgkmcnt(0)\n\ts_barrier":::"memory");
  #undef DMA_K
  #undef DMA_V
  #undef CMASK
  #undef START
  #undef RESC
  #undef ROT
}
constexpr int ATTN_LDS_BYTES=LDS_BYTES;
#undef SBAR
#undef WAIT_BAR
typedef float f32x4v __attribute__((ext_vector_type(4)));
constexpr int V2_SLOTV=16384, V2_LDS_K=0, V2_LDS_V=NSLOT*SLOTB, V2_LDS_WS=V2_LDS_V+NSLOT*V2_SLOTV, V2_LDS_OST=V2_LDS_WS+NW*64*4, V2_LDS_BYTES=V2_LDS_OST+NW*8192;
#define SBAR() __builtin_amdgcn_sched_barrier(0)
#define WAIT_BAR(N) asm volatile("s_waitcnt vmcnt(" #N ") lgkmcnt(0)\n\ts_barrier":::"memory")
__device__ __forceinline__ void pv4(f32x16*o,int vb,bf16x8 pa0,bf16x8 pa1,bf16x8 pa2,bf16x8 pa3){
  #pragma unroll
  for(int d0=0;d0<4;++d0){s16x4 lo[4],hi[4];
    #pragma unroll
    for(int ks=0;ks<4;++ks){
      asm volatile("ds_read_b64_tr_b16 %0,%1 offset:%c2":"=&v"(lo[ks]):"v"(vb),"i"(d0*4096+ks*1024):"memory");
      asm volatile("ds_read_b64_tr_b16 %0,%1 offset:%c2":"=&v"(hi[ks]):"v"(vb),"i"(d0*4096+ks*1024+512):"memory");}
    asm volatile("s_waitcnt lgkmcnt(0)":::"memory");SBAR();
    #define PK(k) (bf16x8){lo[k][0],lo[k][1],lo[k][2],lo[k][3],hi[k][0],hi[k][1],hi[k][2],hi[k][3]}
    o[d0]=__builtin_amdgcn_mfma_f32_32x32x16_bf16(pa0,PK(0),o[d0],0,0,0);
    o[d0]=__builtin_amdgcn_mfma_f32_32x32x16_bf16(pa1,PK(1),o[d0],0,0,0);
    o[d0]=__builtin_amdgcn_mfma_f32_32x32x16_bf16(pa2,PK(2),o[d0],0,0,0);
    o[d0]=__builtin_amdgcn_mfma_f32_32x32x16_bf16(pa3,PK(3),o[d0],0,0,0);
    #undef PK
  }
}
template<int MODE> __device__ __forceinline__ void attn_unit128(int q0,const bf16*Qu,const bf16*__restrict__ Kh,const bf16*__restrict__ Vh,bf16*Ou,char*shm,float lam,float oscale,const float*subg){
  int tid_=threadIdx.x; asm volatile("":"+v"(tid_)); const int tid=tid_,lane=tid&63,r32=lane&31,hi=lane>>5; const int wid=__builtin_amdgcn_readfirstlane(tid>>6);
  const bf16*Qw=Qu+(long)(wid*QBLK)*PQ;
  const unsigned lds0=(unsigned)(uintptr_t)shm;
  float*wsf=(float*)(shm+V2_LDS_WS)+wid*64;
  const bf16*ksrc=Kh+(long)lane*PQ+wid*8;
  const bf16*vsrc=Vh+(long)(16*(wid&3)+(lane>>2))*PQ+(wid>>2)*32+(lane&3)*8;
  const unsigned kdst=lds0+V2_LDS_K+wid*1024, vdst=lds0+V2_LDS_V+wid*1024;
  #define DMA_K(t,slot) glds16(ksrc+(long)(t)*KVBLK*PQ,(unsigned)__builtin_amdgcn_readfirstlane(kdst+(slot)))
  #define DMA_V(t,slot) do{ glds16(vsrc+(long)(t)*KVBLK*PQ,(unsigned)__builtin_amdgcn_readfirstlane(vdst+2*(slot))); glds16(vsrc+(long)(t)*KVBLK*PQ+64,(unsigned)__builtin_amdgcn_readfirstlane(vdst+2*(slot)+8192)); }while(0)
  const int vb0=(int)(lds0+V2_LDS_V)+((lane>>4)&1)*32+(lane&3)*8+(4*hi+((lane&15)>>2))*64;
  const char*Kbase=shm+V2_LDS_K; bf16x8 kf[8];
  const lds_cptr shm3=(lds_cptr)shm; const lds_cptr kp0=shm3+V2_LDS_K+hi*1024+r32*16; const lds_cptr vp0=shm3+V2_LDS_V+((lane>>4)&1)*32+(lane&3)*8+(4*hi+((lane&15)>>2))*64;
  const int NT=(q0+QB)/KVBLK+1;
  DMA_K(0,0);DMA_V(0,0);DMA_K(1,SLOTB);
  bf16x8 qr[4];
  #pragma unroll
  for(int d0=0;d0<4;++d0)qr[d0]=*reinterpret_cast<const bf16x8*>(&Qw[(long)r32*PQ+d0*16+hi*8]);
  float l_reg=0.f;f32x16 o[4];o[0]=f32x16{};o[1]=f32x16{};o[2]=f32x16{};o[3]=f32x16{};
  const f32x16 zero16=f32x16{};
  const int qrel=wid*QBLK+r32;
  #define CMASK(P0,P1,t) do{int jb_=(t)-(NT-4); if(jb_>=0)cmask(P0,P1,jb_,qrel,hi);}while(0)
  f32x16 pA0,pA1,pB0,pB1;
  int sl_prev=0,sl_cur=0,sl_next=SLOTB;
  #define ROT() do{sl_prev=sl_cur;sl_cur=sl_next;sl_next=(sl_next==(NSLOT-1)*SLOTB)?0:sl_next+SLOTB;}while(0)
  DMA_K(2,2*SLOTB);
  WAIT_BAR(3);
  qkt(pA0,pA1,Kbase,qr,zero16,r32,hi);asm volatile("s_nop 15\n\ts_nop 7":"+v"(pA0),"+v"(pA1));
  { const float NEGI=-INFINITY; _Pragma("unroll") for(int r=8;r<16;++r)pA0[r]=NEGI; _Pragma("unroll") for(int r=0;r<16;++r)pA1[r]=NEGI; }
  _Pragma("unroll") for(int r=0;r<16;++r){pA0[r]=__builtin_amdgcn_exp2f(pA0[r]);pA1[r]=__builtin_amdgcn_exp2f(pA1[r]);}
  WAIT_BAR(0);
  DMA_K(3,0);DMA_V(1,SLOTB);
  ROT();
  kload8(kf,kp0+sl_cur);
  WAIT_BAR(3);
  s16x4 vlo[8],vhi[8]; u32x4 pw0,pw1,pw2,pw3;
  #define PKW(P,B) cvtpk_s(P[B],P[B+1])
  #define PAF(k) __builtin_bit_cast(bf16x8,pw##k)
  #define VFR(i) (bf16x8){vlo[i][0],vlo[i][1],vlo[i][2],vlo[i][3],vhi[i][0],vhi[i][1],vhi[i][2],vhi[i][3]}
  #define PIN(x) asm volatile("":"+v"(x))
  #define GAPA(MF,A0,A1,A2,A3,W0,W1,PW) do{ MF; sacc+=A0; sacc+=A1; sacc+=A2; sacc+=A3; PIN(sacc); W0; W1; PIN(PW); SBAR(); }while(0)
  #define EX(v) __builtin_amdgcn_exp2f(v)
  #define GAPB(MF,X,B) do{ MF; X[B]=EX(X[B]); X[B+1]=EX(X[B+1]); PIN(X); SBAR(); }while(0)
  #define VRD(i) do{ vlo[i]=vtr(vp_+(((i)>>2)*4096+((i)&3)*1024)); vhi[i]=vtr(vp_+(((i)>>2)*4096+((i)&3)*1024+512)); }while(0)
  #define VRD2(i) do{ vlo[i]=vtr(vp_+(8192+((i)>>2)*4096+((i)&3)*1024)); vhi[i]=vtr(vp_+(8192+((i)>>2)*4096+((i)&3)*1024+512)); SBAR(); }while(0)
  #define KRD(G,j) do{ if(G){ kload2(kf,kp0+sl_next,j); SBAR(); } }while(0)
  #define MF32(a,b,c) __builtin_amdgcn_mfma_f32_32x32x16_bf16(a,b,c,0,0,0)
  #define STEP(C0,C1,P0,P1,t,GK,GV,GL) do{ SBAR(); \
    const lds_cptr vp_=vp0+2*sl_prev; \
    VRD(0); SBAR(); float sacc=(P0[0]+P0[1]); \
    GAPA(C0=MF32(kf[0],qr[0],zero16), P0[2],P0[3],P0[4],P0[5],     pw0[0]=PKW(P0,0), pw0[1]=PKW(P0,2), pw0); \
    VRD(4); SBAR(); GAPA(C1=MF32(kf[1],qr[0],zero16), P0[6],P0[7],P0[8],P0[9],     pw0[2]=PKW(P0,4), pw0[3]=PKW(P0,6), pw0); \
    VRD(1); SBAR(); GAPA(C0=MF32(kf[2],qr[1],C0),   P0[10],P0[11],P0[12],P0[13], pw1[0]=PKW(P0,8), pw1[1]=PKW(P0,10), pw1); \
    VRD(5); SBAR(); GAPA(C1=MF32(kf[3],qr[1],C1),   P0[14],P0[15],P1[0],P1[1],   pw1[2]=PKW(P0,12),pw1[3]=PKW(P0,14), pw1); \
    VRD(2); SBAR(); GAPA(C0=MF32(kf[4],qr[2],C0),   P1[2],P1[3],P1[4],P1[5],     pw2[0]=PKW(P1,0), pw2[1]=PKW(P1,2), pw2); \
    VRD(6); SBAR(); GAPA(C1=MF32(kf[5],qr[2],C1),   P1[6],P1[7],P1[8],P1[9],     pw2[2]=PKW(P1,4), pw2[3]=PKW(P1,6), pw2); \
    VRD(3); SBAR(); GAPA(C0=MF32(kf[6],qr[3],C0),   P1[10],P1[11],P1[12],P1[13], pw3[0]=PKW(P1,8), pw3[1]=PKW(P1,10), pw3); \
    VRD(7); SBAR(); GAPA(C1=MF32(kf[7],qr[3],C1),   P1[14],P1[15],0.f,0.f,       pw3[2]=PKW(P1,12),pw3[3]=PKW(P1,14), pw3); \
    l_reg+=sacc; \
    if(GK){DMA_K((t)+3,sl_cur);} if(GV){DMA_V((t)+1,sl_next);} \
    CMASK(C0,C1,t); \
    SBAR(); \
    GAPB(o[0]=MF32(PAF(0),VFR(0),o[0]), C0,0);  VRD2(0); \
    GAPB(o[1]=MF32(PAF(0),VFR(4),o[1]), C0,2);  VRD2(4); \
    KRD(GL,0); GAPB(o[0]=MF32(PAF(1),VFR(1),o[0]), C0,4);  VRD2(1); \
    KRD(GL,1); GAPB(o[1]=MF32(PAF(1),VFR(5),o[1]), C0,6);  VRD2(5); \
    KRD(GL,2); GAPB(o[0]=MF32(PAF(2),VFR(2),o[0]), C0,8);  VRD2(2); \
    KRD(GL,3); GAPB(o[1]=MF32(PAF(2),VFR(6),o[1]), C0,10); VRD2(6); \
    GAPB(o[0]=MF32(PAF(3),VFR(3),o[0]), C0,12); VRD2(3); \
    GAPB(o[1]=MF32(PAF(3),VFR(7),o[1]), C0,14); VRD2(7); \
    GAPB(o[2]=MF32(PAF(0),VFR(0),o[2]), C1,0); \
    GAPB(o[3]=MF32(PAF(0),VFR(4),o[3]), C1,2); \
    GAPB(o[2]=MF32(PAF(1),VFR(1),o[2]), C1,4); \
    GAPB(o[3]=MF32(PAF(1),VFR(5),o[3]), C1,6); \
    GAPB(o[2]=MF32(PAF(2),VFR(2),o[2]), C1,8); \
    GAPB(o[3]=MF32(PAF(2),VFR(6),o[3]), C1,10); \
    GAPB(o[2]=MF32(PAF(3),VFR(3),o[2]), C1,12); \
    GAPB(o[3]=MF32(PAF(3),VFR(7),o[3]), C1,14); \
    }while(0)
  int t=1;
  #undef CMASK
  #define CMASK(P0,P1,t) do{}while(0)
  for(;t+5<NT;t+=2){
    STEP(pB0,pB1,pA0,pA1,t,true,true,true);     WAIT_BAR(3); ROT();
    STEP(pA0,pA1,pB0,pB1,t+1,true,true,true);   WAIT_BAR(3); ROT();
  }
  #undef CMASK
  #define CMASK(P0,P1,t) do{int jb_=(t)-(NT-4); if(jb_>=0)cmask(P0,P1,jb_,qrel,hi);}while(0)
  #define ENDW(tt) do{ if((tt)+3<NT){WAIT_BAR(3);} else if((tt)+2<NT){WAIT_BAR(2);} else {WAIT_BAR(0);} }while(0)
  for(;t+1<NT;t+=2){
    STEP(pB0,pB1,pA0,pA1,t,(t+3<NT),(t+1<NT),(t+1<NT));       ENDW(t);   ROT();
    STEP(pA0,pA1,pB0,pB1,t+1,(t+4<NT),(t+2<NT),(t+2<NT));     ENDW(t+1); ROT();
  }
  { float sacc=pA0[0]+pA0[1]; _Pragma("unroll") for(int r=2;r<16;++r)sacc+=pA0[r]; _Pragma("unroll") for(int r=0;r<16;++r)sacc+=pA1[r]; l_reg+=sacc;
    pw0=(u32x4){PKW(pA0,0),PKW(pA0,2),PKW(pA0,4),PKW(pA0,6)};pw1=(u32x4){PKW(pA0,8),PKW(pA0,10),PKW(pA0,12),PKW(pA0,14)};pw2=(u32x4){PKW(pA1,0),PKW(pA1,2),PKW(pA1,4),PKW(pA1,6)};pw3=(u32x4){PKW(pA1,8),PKW(pA1,10),PKW(pA1,12),PKW(pA1,14)};
    SBAR(); pv4(o,vb0+2*sl_prev,PAF(0),PAF(1),PAF(2),PAF(3)); }
  #undef PKW
  #undef PAF
  #undef VFR
  #undef PIN
  #undef GAPA
  #undef GAPB
  #undef EX
  #undef VRD
  #undef VRD2
  #undef KRD
  #undef MF32
  #undef STEP
  #undef ENDW
  {auto rr=__builtin_amdgcn_permlane32_swap(__float_as_uint(l_reg),__float_as_uint(l_reg),false,false);l_reg=__uint_as_float(rr[0])+__uint_as_float(rr[1]);}
  if(hi==0)wsf[32+r32]=l_reg;asm volatile("s_waitcnt lgkmcnt(0)":::"memory");
  float rli[16];
  #pragma unroll
  for(int r=0;r<16;++r)rli[r]=__builtin_amdgcn_rcpf(wsf[32+crow(r,hi)]);
  { bf16*park=(bf16*)(shm+V2_LDS_OST)+wid*4096;
    if(MODE==0){
      #pragma unroll
      for(int r=0;r<16;++r){const int orow=crow(r,hi);
        #pragma unroll
        for(int d0=0;d0<4;++d0)park[orow*128+d0*32+r32]=__float2bfloat16(o[d0][r]*rli[r]);}
      asm volatile("s_waitcnt lgkmcnt(0)":::"memory");
    } else {
      #pragma unroll
      for(int r=0;r<16;++r){const int orow=crow(r,hi);
        #pragma unroll
        for(int d0=0;d0<4;++d0){const float o1=__bfloat162float(park[orow*128+d0*32+r32]); park[orow*128+d0*32+r32]=__float2bfloat16(o1-lam*(o[d0][r]*rli[r]));}}
      asm volatile("s_waitcnt lgkmcnt(0)":::"memory");
      bf16*Ow=Ou+(long)(wid*QBLK)*PO;
      const int ch=lane&15; const f32x4v g0=*(const f32x4v*)(subg+8*ch), g1=*(const f32x4v*)(subg+8*ch+4);
      #pragma unroll
      for(int i=0;i<8;++i){const int row=i*4+(lane>>4); const u32x4 v=*(const u32x4*)(park+row*128+ch*8);
        float d[8]; d[0]=__uint_as_float(v.x<<16);d[1]=__uint_as_float(v.x&0xffff0000u);d[2]=__uint_as_float(v.y<<16);d[3]=__uint_as_float(v.y&0xffff0000u);d[4]=__uint_as_float(v.z<<16);d[5]=__uint_as_float(v.z&0xffff0000u);d[6]=__uint_as_float(v.w<<16);d[7]=__uint_as_float(v.w&0xffff0000u);
        float ss=(d[0]*d[0]+d[1]*d[1])+(d[2]*d[2]+d[3]*d[3])+(d[4]*d[4]+d[5]*d[5])+(d[6]*d[6]+d[7]*d[7]);
        ss+=__shfl_xor(ss,1);ss+=__shfl_xor(ss,2);ss+=__shfl_xor(ss,4);ss+=__shfl_xor(ss,8);
        const float rs=__builtin_amdgcn_rsqf(ss*(1.0f/128.0f)+1e-6f)*oscale;
        u32x4 w; w.x=cvtpk_s(d[0]*rs*g0[0],d[1]*rs*g0[1]); w.y=cvtpk_s(d[2]*rs*g0[2],d[3]*rs*g0[3]); w.z=cvtpk_s(d[4]*rs*g1[0],d[5]*rs*g1[1]); w.w=cvtpk_s(d[6]*rs*g1[2],d[7]*rs*g1[3]);
        ATTN_STORE16(Ow+(long)row*PO+ch*8,w);}
      asm volatile("s_waitcnt lgkmcnt(0)":::"memory");
    } }
  asm volatile("s_waitcnt lgkmcnt(0)\n\ts_barrier":::"memory");
  #undef DMA_K
  #undef DMA_V
  #undef CMASK
  #undef ROT
}
#undef SBAR
#undef WAIT_BAR

}
namespace cg = cooperative_groups;
constexpr int NWAVES = 8;
constexpr int NB = 4, SEQ = 8192, DM = 1024, NMETA = 16, DIN = 2560, DFF = 4096, DCONV = 512, CONVW = 31;
constexpr int MX = NB * SEQ;
constexpr int MP = MX + 256;
constexpr int SPAD = pg8::SPAD;
constexpr float EPS = 1e-6f;
constexpr size_t MiB = 1u << 20;
constexpr size_t WS_CTL = 0, WS_WIN = 1 * MiB, WS_WOUT = 6 * MiB, WS_WUP = 8 * MiB, WS_WDN = 16 * MiB, WS_ROPE = 24 * MiB, WS_SSQ = 25 * MiB, WS_RN = 27 * MiB,
                 WS_H1B = 28 * MiB, WS_MIX = 92 * MiB, WS_HB = 156 * MiB, WS_XN = 156 * MiB, WS_O = 156 * MiB, WS_Q = 222 * MiB, WS_K = 254 * MiB, WS_V = 287 * MiB, WS_G = 320 * MiB,
                 WS_END = 412 * MiB;
static_assert(WS_XN + (size_t)MP * DM * 2 <= WS_Q && WS_K + (size_t)NB * SPAD * 512 * 2 <= WS_V && WS_G + (size_t)NB * SPAD * 512 * 2 <= WS_HB + (size_t)MX * DFF * 2 && WS_HB + (size_t)MX * DFF * 2 <= WS_END, "d_ws map");
constexpr int RING_BYTES = 131072, LDS_BYTES = 147456;
#ifndef WGM_P1
#define WGM_P1 4
#endif
#ifndef WGM_P4
#define WGM_P4 4
#endif
#ifndef WGM_P35
#define WGM_P35 4
#endif

#define LAS __attribute__((address_space(3)))
typedef unsigned short bf16;
typedef unsigned v4u __attribute__((ext_vector_type(4)));
typedef float f32x4 __attribute__((ext_vector_type(4)));
typedef float f32x2 __attribute__((ext_vector_type(2)));
#define LDS_WAIT() asm volatile("s_waitcnt lgkmcnt(0)" ::: "memory")
__device__ __forceinline__ unsigned pk2(float lo, float hi) { return pg8::cvt_pk_bf16(lo, hi); }
__device__ __forceinline__ float bf_lo(unsigned u) { return __uint_as_float(u << 16); }
__device__ __forceinline__ float bf_hi(unsigned u) { return __uint_as_float(u & 0xffff0000u); }
__device__ __forceinline__ float wave_sum(float v) {
#pragma unroll
    for (int o = 1; o < 64; o <<= 1) v += __shfl_xor(v, o);
    return v;
}

#define XB_TMO      128
#define XB_XCNT(j)  (256  + 64 * (j))
#define XB_XSUB(j)  (1280 + 64 * (j))
#define XB_XGEN(j)  (2304 + 64 * (j))
#define XB_TOP      3328
#define XB_TOPGEN   3392
#define XCD_BAR_WORDS 3456
#define XB_SPIN_CAP (1u << 18)

__device__ __forceinline__ unsigned xb_ld(unsigned* p)              { return __hip_atomic_load(p, __ATOMIC_RELAXED, __HIP_MEMORY_SCOPE_AGENT); }
__device__ __forceinline__ unsigned xb_add(unsigned* p, unsigned v) { return __hip_atomic_fetch_add(p, v, __ATOMIC_RELAXED, __HIP_MEMORY_SCOPE_AGENT); }
__device__ __forceinline__ unsigned xb_xcc_id() { return (unsigned)__builtin_amdgcn_s_getreg((3 << 11) | 20) & 0xFu; }
#define XB_SPIN(cond, bar) do { unsigned _sp = 0; while (cond) { __builtin_amdgcn_s_sleep(1); \
    if ((++_sp & 255u) == 0u) { if (xb_ld(&(bar)[XB_TMO])) break; if (_sp > XB_SPIN_CAP) { atomicAdd(&(bar)[XB_TMO], 1u); break; } } } } while (0)

struct XcdBarrier {
    unsigned* bar; unsigned x;
    volatile LAS unsigned* st;
};

__device__ __forceinline__ XcdBarrier xcd_barrier_post(unsigned* bar, volatile LAS unsigned* st) {
    XcdBarrier b; b.bar = bar; b.x = xb_xcc_id(); b.st = st;
    if (threadIdx.x == 0) (void)xb_add(&bar[XB_XCNT(b.x)], 1u);
    return b;
}
__device__ __forceinline__ void xcd_barrier_complete(unsigned* bar, unsigned x, unsigned& nloc, unsigned& nx) {
    const unsigned G = gridDim.x * gridDim.y * gridDim.z;
    unsigned sum, cnt, mine, sp = 0u;
    for (;;) {
        sum = 0u; cnt = 0u; mine = 0u;
#pragma unroll
        for (unsigned j = 0; j < 16; ++j) { const unsigned c = xb_ld(&bar[XB_XCNT(j)]); sum += c; cnt += (c > 0u) ? 1u : 0u; mine = (j == x) ? c : mine; }
        if (sum == G) break;
        __builtin_amdgcn_s_sleep(1);
        if ((++sp & 255u) == 0u) { if (xb_ld(&bar[XB_TMO])) break; if (sp > XB_SPIN_CAP) { atomicAdd(&bar[XB_TMO], 1u); break; } }
    }
    nloc = mine > 0u ? mine : 1u; nx = cnt > 0u ? cnt : 1u;
}

__device__ __forceinline__ void xcd_barrier(const XcdBarrier& b) {
    asm volatile("s_waitcnt vmcnt(0)" ::: "memory");
    __syncthreads();
    if (threadIdx.x == 0) {
        unsigned* bar = b.bar;
        __builtin_amdgcn_s_waitcnt(0);
        unsigned nloc = b.st[0], nx = b.st[1];
        if (nloc == 0u) { xcd_barrier_complete(bar, b.x, nloc, nx); b.st[0] = nloc; b.st[1] = nx; }
        const unsigned old = xb_add(&bar[XB_XSUB(b.x)], 1u);
        const unsigned gen = old / nloc;
        if (old + 1u == (gen + 1u) * nloc) {
            __builtin_amdgcn_fence(__ATOMIC_RELEASE, "agent");
            asm volatile("s_waitcnt vmcnt(0)" ::: "memory");
            const unsigned og = xb_add(&bar[XB_TOP], 1u);
            const unsigned tg = og / nx;
            if (og + 1u == (tg + 1u) * nx) xb_add(&bar[XB_TOPGEN], 1u);
            else XB_SPIN(xb_ld(&bar[XB_TOPGEN]) == tg, bar);
            __builtin_amdgcn_fence(__ATOMIC_ACQUIRE, "agent");
            xb_add(&bar[XB_XGEN(b.x)], 1u);
            asm volatile("s_waitcnt vmcnt(0)" ::: "memory");
        } else {
            XB_SPIN(xb_ld(&bar[XB_XGEN(b.x)]) == gen, bar);
            __builtin_amdgcn_fence(__ATOMIC_ACQUIRE, "agent");
            asm volatile("s_waitcnt vmcnt(0)" ::: "memory");
        }
    }
    __syncthreads();
}

__device__ __forceinline__ float dpp_add(float v, const int ctrl_sel) {
    int t;
    if (ctrl_sel == 0) t = __builtin_amdgcn_update_dpp(0, __float_as_int(v), 0xB1, 0xF, 0xF, true);
    else if (ctrl_sel == 1) t = __builtin_amdgcn_update_dpp(0, __float_as_int(v), 0x4E, 0xF, 0xF, true);
    else if (ctrl_sel == 2) t = __builtin_amdgcn_update_dpp(0, __float_as_int(v), 0x141, 0xF, 0xF, true);
    else t = __builtin_amdgcn_update_dpp(0, __float_as_int(v), 0x140, 0xF, 0xF, true);
    return v + __int_as_float(t);
}
__device__ __forceinline__ float wave_sum_fast(float v) {
    v = dpp_add(v, 0); v = dpp_add(v, 1); v = dpp_add(v, 2); v = dpp_add(v, 3);
    { auto rr = __builtin_amdgcn_permlane16_swap(__float_as_uint(v), __float_as_uint(v), false, false); v = __uint_as_float(rr[0]) + __uint_as_float(rr[1]); }
    { auto rr = __builtin_amdgcn_permlane32_swap(__float_as_uint(v), __float_as_uint(v), false, false); v = __uint_as_float(rr[0]) + __uint_as_float(rr[1]); }
    return v;
}

struct Args { const float* in[19]; float* out; unsigned char* ws; float inv_freq[8]; };
enum { I_X = 0, I_META, I_G1, I_WIN, I_QG, I_KG, I_LQ1, I_LK1, I_LQ2, I_LK2, I_SUBLN, I_CW, I_CB, I_CLG, I_CLB, I_WOUT, I_G2, I_WUP, I_WDN };

__device__ __forceinline__ void p0_transpose_item(const float* W, int K, int N, bf16* WT, int out_row0, int n0, int k0, const float* kscale, LAS float* scr, int lane) {
    float tv[32], ts[32];
#pragma unroll
    for (int i = 0; i < 32; ++i) { const int kk = 2 * i + (lane >> 5); tv[i] = W[(size_t)(k0 + kk) * N + n0 + (lane & 31)]; ts[i] = kscale ? kscale[k0 + kk] : 1.0f; }
#pragma unroll
    for (int i = 0; i < 32; ++i) { const int kk = 2 * i + (lane >> 5); scr[kk * 33 + (lane & 31)] = tv[i] * ts[i]; }
    LDS_WAIT(); asm volatile("" ::: "memory");
    const int c = lane & 7;
#pragma unroll
    for (int j = 0; j < 4; ++j) { const int n = (lane >> 3) + 8 * j; const LAS float* s = scr + (8 * c) * 33 + n;
        v4u o; o.x = pk2(s[0 * 33], s[1 * 33]); o.y = pk2(s[2 * 33], s[3 * 33]); o.z = pk2(s[4 * 33], s[5 * 33]); o.w = pk2(s[6 * 33], s[7 * 33]);
        *(v4u*)(WT + (size_t)(out_row0 + n) * K + k0 + 8 * c) = o; }
    LDS_WAIT(); asm volatile("" ::: "memory");
}
__device__ __forceinline__ int win_pcol(int lc) {
    if (lc < 1024) { const int l = lc & 255; return (lc & ~255) + 128 * ((l >> 5) & 1) + 32 * (l >> 6) + (l & 31); }
    if (lc < 1536) return lc;
    if (lc < 2048) { const int ch = lc - 1536; return 1536 + 256 * (ch >> 7) + (ch & 127); }
    const int ch = lc - 2048; return 1536 + 256 * (ch >> 7) + 128 + (ch & 127);
}

__device__ __forceinline__ void p0_prologue(const Args& A, unsigned char* ws, LAS unsigned char* lds, int vcu, int G, int wave, int lane) {
    LAS float* scr = (LAS float*)(lds + wave * 16384);
    const int gw = vcu * NWAVES + wave, NGW = G * NWAVES;
    bf16* Win_t = (bf16*)(ws + WS_WIN); bf16* Wout_t = (bf16*)(ws + WS_WOUT); bf16* Wup_t = (bf16*)(ws + WS_WUP); bf16* Wdn_t = (bf16*)(ws + WS_WDN);
    constexpr int I_IN = (DM / 64) * (DIN / 32);
    for (int it = gw; it < I_IN; it += NGW) { const int nblk = DIN / 32, kb = it / nblk, nb = it % nblk; p0_transpose_item(A.in[I_WIN], DM, DIN, Win_t, win_pcol(32 * nb), 32 * nb, 64 * kb, nullptr, scr, lane); }
    {
        bf16* XN = (bf16*)(ws + WS_XN);
        f32x4 g[4];
#pragma unroll
        for (int j = 0; j < 4; ++j) g[j] = ((const f32x4*)A.in[I_G1])[lane + 64 * j];
        for (int m0 = gw; m0 < MX + NMETA; m0 += 4 * NGW) {
            f32x4 v[4][4];
#pragma unroll
            for (int q = 0; q < 4; ++q) { const int m = m0 + q * NGW; const bool ok = m < MX + NMETA;
                const float* src = !ok ? A.in[I_X] : (m < MX) ? A.in[I_X] + (size_t)m * DM : A.in[I_META] + (size_t)(m - MX) * DM;
                const f32x4* xr = (const f32x4*)src + lane;
#pragma unroll
                for (int j = 0; j < 4; ++j) v[q][j] = __builtin_nontemporal_load(xr + 64 * j); }
#pragma unroll
            for (int q = 0; q < 4; ++q) { const int m = m0 + q * NGW; if (m >= MX + NMETA) continue;
                float s = 0.f;
#pragma unroll
                for (int j = 0; j < 4; ++j) s += (v[q][j].x * v[q][j].x + v[q][j].y * v[q][j].y) + (v[q][j].z * v[q][j].z + v[q][j].w * v[q][j].w);
                const float ms = wave_sum_fast(s) * (1.f / DM) + EPS; const float rs = __builtin_amdgcn_rsqf(ms);
                if (lane == 0 && m < MX) ((float*)(ws + WS_RN))[m] = ms * rs;
                unsigned long long* o8 = (unsigned long long*)(XN + (size_t)m * DM) + lane;
#pragma unroll
                for (int j = 0; j < 4; ++j) { const f32x4 y = v[q][j] * rs * g[j]; o8[64 * j] = (unsigned long long)pk2(y.x, y.y) | ((unsigned long long)pk2(y.z, y.w) << 32); } }
        }
    }
    {
        float* rope = (float*)(ws + WS_ROPE);
        const int pos = gw * 64 + lane;
        if (pos < SEQ + NMETA) {
#pragma unroll
            for (int i = 0; i < 8; ++i) {
                const float angf = (float)pos * A.inv_freq[i];
                const double rev = (double)angf * 0.15915494309189533577; const double fr = rev - __builtin_rint(rev);
                const float f = (float)fr;
                rope[pos * 16 + i] = __builtin_amdgcn_cosf(f); rope[pos * 16 + 8 + i] = __builtin_amdgcn_sinf(f); } }
    }
    {
        bf16* KB = (bf16*)(ws + WS_K); bf16* VB = (bf16*)(ws + WS_V); bf16* GB = (bf16*)(ws + WS_G);
        for (int it = gw; it < NB * 48 * 3; it += NGW) { const int which = it / (NB * 48), r = it % (NB * 48), b = r / 48, rr = r % 48;
            bf16* p = which == 0 ? KB + (size_t)(b * SPAD + 16 + rr) * 512 : which == 1 ? VB + (size_t)(b * SPAD + 16 + rr) * 512 : GB + (size_t)(b * SPAD + rr) * 512;
            ((v4u*)p)[lane] = (v4u){0u, 0u, 0u, 0u}; }
    }
}

__device__ __forceinline__ void meta_proj(const Args& A, unsigned char* ws, LAS unsigned char* lds, int vcu, int wave, int lane) {
    typedef short bf16x8 __attribute__((ext_vector_type(8)));
    const int fr = lane & 15, fq = lane >> 4;
    const int item = vcu * 2 + (wave >> 2), kc = wave & 3;
    const int kind = item < 8 ? 0 : item < 16 ? 1 : 2, g = kind == 2 ? item - 16 : (item & 7);
    const bf16* XNm = (const bf16*)(ws + WS_XN) + (size_t)(MX + fr) * DM + 8 * fq + 256 * kc;
    const bf16* Wt = (const bf16*)(ws + WS_WIN);
    const bf16* brow[4];
#pragma unroll
    for (int nb = 0; nb < 4; ++nb) { const int lc = kind == 0 ? 512 + 64 * g + 16 * nb + fr : kind == 1 ? 1024 + 64 * g + 16 * nb + fr : (nb < 2 ? 1536 + 32 * g + 16 * nb + fr : 2048 + 32 * g + 16 * (nb - 2) + fr);
        brow[nb] = Wt + (size_t)(win_pcol(lc & ~31) + (lc & 31)) * DM + 8 * fq + 256 * kc; }
    bf16x8 af[8], bf[8][4];
#pragma unroll
    for (int ks = 0; ks < 8; ++ks) { af[ks] = *(const bf16x8*)(XNm + 32 * ks);
#pragma unroll
        for (int nb = 0; nb < 4; ++nb) bf[ks][nb] = *(const bf16x8*)(brow[nb] + 32 * ks); }
    asm volatile("" ::: "memory");
    f32x4 acc[4];
#pragma unroll
    for (int nb = 0; nb < 4; ++nb) acc[nb] = (f32x4){0.f, 0.f, 0.f, 0.f};
#pragma unroll
    for (int ks = 0; ks < 8; ++ks)
#pragma unroll
        for (int nb = 0; nb < 4; ++nb) acc[nb] = __builtin_amdgcn_mfma_f32_16x16x32_bf16(bf[ks][nb], af[ks], acc[nb], 0, 0, 0);
    LAS f32x4* red = (LAS f32x4*)lds;
#pragma unroll
    for (int nb = 0; nb < 4; ++nb) red[(wave * 4 + nb) * 64 + lane] = acc[nb];
    __syncthreads();
    if (kc == 0) {
#pragma unroll
        for (int nb = 0; nb < 4; ++nb) acc[nb] = (red[((wave + 0) * 4 + nb) * 64 + lane] + red[((wave + 1) * 4 + nb) * 64 + lane]) + (red[((wave + 2) * 4 + nb) * 64 + lane] + red[((wave + 3) * 4 + nb) * 64 + lane]);
        if (kind == 0) {
            float ss = 0.f;
#pragma unroll
            for (int nb = 0; nb < 4; ++nb) ss += (acc[nb][0] * acc[nb][0] + acc[nb][1] * acc[nb][1]) + (acc[nb][2] * acc[nb][2] + acc[nb][3] * acc[nb][3]);
            ss += __shfl_xor(ss, 16); ss += __shfl_xor(ss, 32);
            const float rs = __builtin_amdgcn_rsqf(ss * (1.0f / 64.0f) + EPS);
#pragma unroll
            for (int nb = 0; nb < 4; ++nb) acc[nb] = acc[nb] * rs * *(const f32x4*)(A.in[I_KG] + 16 * nb + 4 * fq);
            f32x4 p; p[0] = __shfl_xor(acc[0][0], 32); p[1] = __shfl_xor(acc[0][1], 32); p[2] = __shfl_xor(acc[0][2], 32); p[3] = __shfl_xor(acc[0][3], 32);
            const float* rp = (const float*)(ws + WS_ROPE) + fr * 16 + 4 * (fq & 1);
            const f32x4 c = *(const f32x4*)rp, s = *(const f32x4*)(rp + 8);
            const float sg = (fq & 2) ? 1.f : -1.f;
            acc[0] = acc[0] * c + (p * s) * sg;
        }
        if (kind == 2) {
#pragma unroll
            for (int nb = 0; nb < 2; ++nb)
#pragma unroll
                for (int e = 0; e < 4; ++e) acc[nb][e] = acc[nb][e] * __builtin_amdgcn_rcpf(1.0f + __builtin_amdgcn_exp2f(-1.4426950408889634f * acc[nb + 2][e]));
        }
        bf16* dst = kind == 0 ? (bf16*)(ws + WS_K) : kind == 1 ? (bf16*)(ws + WS_V) : (bf16*)(ws + WS_G);
        const int r0 = kind == 2 ? 48 + fr : fr, c0 = (kind == 2 ? 32 * g : 64 * g) + 4 * fq, nnb = kind == 2 ? 2 : 4;
#pragma unroll 1
        for (int b = 0; b < NB; ++b) { bf16* o = dst + (size_t)(b * SPAD + r0) * 512 + c0;
#pragma unroll
            for (int nb = 0; nb < 4; ++nb) if (nb < nnb) *(unsigned long long*)(o + 16 * nb) = (unsigned long long)pk2(acc[nb][0], acc[nb][1]) | ((unsigned long long)pk2(acc[nb][2], acc[nb][3]) << 32); }
    }
    __syncthreads();
}

__device__ __forceinline__ void wconv_phase(const Args& A, unsigned char* ws, LAS unsigned char* lds, int wave, int lane) {
    LAS float* scr = (LAS float*)(lds + wave * 16384);
    bf16* Wout_t = (bf16*)(ws + WS_WOUT); bf16* Wup_t = (bf16*)(ws + WS_WUP); bf16* Wdn_t = (bf16*)(ws + WS_WDN);
    constexpr int I_OUT = (DM / 64) * (DM / 32), I_UP = (DM / 64) * (DFF / 32), I_DN = (DFF / 64) * (DM / 32), NIT = I_OUT + I_UP + I_DN;
    unsigned* wq = (unsigned*)(ws + WS_CTL) + 96;
    volatile LAS unsigned* TK = (volatile LAS unsigned*)(lds + LDS_BYTES - 256 + 64);
    for (;;) {
        if (wave == 0 && lane == 0) TK[0] = __hip_atomic_fetch_add(wq, 1u, __ATOMIC_RELAXED, __HIP_MEMORY_SCOPE_AGENT);
        __syncthreads();
        const int t = (int)TK[0];
        __syncthreads();
        if (t * NWAVES >= NIT) break;
        int r = t * NWAVES + wave;
        if (r >= NIT) continue;
        if (r < I_OUT) { const int nblk = DM / 32, kb = r / nblk, nb = r % nblk; p0_transpose_item(A.in[I_WOUT], DM, DM, Wout_t, 32 * nb, 32 * nb, 64 * kb, nullptr, scr, lane); continue; } r -= I_OUT;
        if (r < I_UP) { const int nblk = DFF / 32, kb = r / nblk, nb = r % nblk; p0_transpose_item(A.in[I_WUP], DM, DFF, Wup_t, 32 * nb, 32 * nb, 64 * kb, A.in[I_G2], scr, lane); continue; } r -= I_UP;
        { const int nblk = DM / 32, kb = r / nblk, nb = r % nblk; p0_transpose_item(A.in[I_WDN], DFF, DM, Wdn_t, 32 * nb, 32 * nb, 64 * kb, nullptr, scr, lane); }
    }
}

constexpr int CONV_R = 32;
__device__ __forceinline__ void conv_phase(const Args& A, unsigned char* ws, LAS unsigned char* lds, int vcu, int G, int wave, int lane) {
    LAS float* cbuf = (LAS float*)lds;
    const bf16* GB = (const bf16*)(ws + WS_G); bf16* MIX = (bf16*)(ws + WS_MIX);
    const int cp = (wave & 3) * 64 + lane, half = wave >> 2;
    f32x2 w[CONVW];
#pragma unroll
    for (int j = 0; j < CONVW; ++j) w[j] = *(const f32x2*)(A.in[I_CW] + j * DCONV + 2 * cp);
    const f32x2 bias = *(const f32x2*)(A.in[I_CB] + 2 * cp);
    const f32x4 lg0 = *(const f32x4*)(A.in[I_CLG] + lane * 8), lg1 = *(const f32x4*)(A.in[I_CLG] + lane * 8 + 4), lb0 = *(const f32x4*)(A.in[I_CLB] + lane * 8), lb1 = *(const f32x4*)(A.in[I_CLB] + lane * 8 + 4);
    constexpr int NITEMS = MX / (2 * CONV_R);
    unsigned* cq = (unsigned*)(ws + WS_CTL) + 32;
    volatile LAS unsigned* TK = (volatile LAS unsigned*)(lds + LDS_BYTES - 256 + 64);
    if (wave == 0 && lane == 0) { TK[0] = __hip_atomic_fetch_add(cq, 1u, __ATOMIC_RELAXED, __HIP_MEMORY_SCOPE_AGENT); TK[1] = __hip_atomic_fetch_add(cq, 1u, __ATOMIC_RELAXED, __HIP_MEMORY_SCOPE_AGENT); }
    __syncthreads();
    int it = (int)TK[0], nxt = (int)TK[1];
    __syncthreads();
#define CONV_SRC(item, sub) (GB + (size_t)(((((item) * 2 * CONV_R + half * CONV_R + (sub) * 16) >> 13) * SPAD) + 34 + (((item) * 2 * CONV_R + half * CONV_R + (sub) * 16) & 8191)) * 512 + 2 * cp)
#define CONV_LOAD(buf, item, sub) do { const bf16* gs_ = CONV_SRC(item, sub); _Pragma("unroll") for (int i = 0; i < 46; ++i) buf[i] = *(const unsigned*)(gs_ + (size_t)i * 512); } while (0)
#define CONV_FMA(buf, sub) do { f32x2 acc[16]; _Pragma("unroll") for (int o = 0; o < 16; ++o) acc[o] = bias; \
        _Pragma("unroll") for (int i = 0; i < 46; ++i) { const f32x2 x = {bf_lo(buf[i]), bf_hi(buf[i])}; _Pragma("unroll") for (int o = 0; o < 16; ++o) { const int j = i - o; if (j >= 0 && j < CONVW) acc[o] += w[j] * x; } } \
        _Pragma("unroll") for (int o = 0; o < 16; ++o) *(LAS f32x2*)(cbuf + (half * CONV_R + (sub) * 16 + o) * DCONV + 2 * cp) = acc[o]; } while (0)
    unsigned bufA[46], bufB[46];
    if (it < NITEMS) CONV_LOAD(bufA, it, 0);
#pragma unroll 1
    while (it < NITEMS) {
        if (wave == 0 && lane == 0) TK[0] = __hip_atomic_fetch_add(cq, 1u, __ATOMIC_RELAXED, __HIP_MEMORY_SCOPE_AGENT);
        CONV_LOAD(bufB, it, 1);
        CONV_FMA(bufA, 0);
        if (nxt < NITEMS) CONV_LOAD(bufA, nxt, 0);
        CONV_FMA(bufB, 1);
        __syncthreads();
        const int nn = (int)TK[0];
#pragma unroll
        for (int rr = 0; rr < 8; ++rr) { const int lr = wave * 8 + rr;
            f32x4 x0 = *(const LAS f32x4*)(cbuf + lr * DCONV + lane * 8), x1 = *(const LAS f32x4*)(cbuf + lr * DCONV + lane * 8 + 4);
            const float mu = wave_sum_fast((x0[0] + x0[1]) + (x0[2] + x0[3]) + (x1[0] + x1[1]) + (x1[2] + x1[3])) * (1.f / DCONV);
            x0 = x0 - mu; x1 = x1 - mu;
            const float var = wave_sum_fast((x0[0] * x0[0] + x0[1] * x0[1]) + (x0[2] * x0[2] + x0[3] * x0[3]) + (x1[0] * x1[0] + x1[1] * x1[1]) + (x1[2] * x1[2] + x1[3] * x1[3])) * (1.f / DCONV);
            const float rs = __builtin_amdgcn_rsqf(var + EPS);
            x0 = x0 * rs * lg0 + lb0; x1 = x1 * rs * lg1 + lb1;
#pragma unroll
            for (int e = 0; e < 4; ++e) { x0[e] = x0[e] * __builtin_amdgcn_rcpf(1.0f + __builtin_amdgcn_exp2f(-1.4426950408889634f * x0[e])); x1[e] = x1[e] * __builtin_amdgcn_rcpf(1.0f + __builtin_amdgcn_exp2f(-1.4426950408889634f * x1[e])); }
            *(v4u*)(MIX + (size_t)(it * 2 * CONV_R + lr) * DM + 512 + lane * 8) = pg8::pack8(x0, x1); }
        __syncthreads();
        it = nxt; nxt = nn;
    }
#undef CONV_SRC
#undef CONV_LOAD
#undef CONV_FMA
}

__device__ __forceinline__ void combine_phase(const Args& A, unsigned char* ws, int vcu, int G, int wave, int lane) {
    const bf16* OB = (const bf16*)(ws + WS_O); bf16* MIX = (bf16*)(ws + WS_MIX);
    const float d1 = wave_sum(A.in[I_LQ1][lane] * A.in[I_LK1][lane]), d2 = wave_sum(A.in[I_LQ2][lane] * A.in[I_LK2][lane]);
    const float lam_init = 0.2f;
    const float lam = __builtin_amdgcn_exp2f(d1 * 1.4426950408889634f) - __builtin_amdgcn_exp2f(d2 * 1.4426950408889634f) + lam_init;
    const int h = lane >> 4, q = lane & 15;
    const f32x4 sg0 = *(const f32x4*)(A.in[I_SUBLN] + 8 * q), sg1 = *(const f32x4*)(A.in[I_SUBLN] + 8 * q + 4);
    const int gw = vcu * NWAVES + wave, NGW = G * NWAVES;
    for (int row = gw; row < MX; row += NGW) {
        const bf16* o1 = OB + (size_t)row * 1024 + h * 256 + 8 * q;
        const v4u a = *(const v4u*)o1, bq = *(const v4u*)(o1 + 128);
        f32x4 d0, d1v;
        d0[0] = bf_lo(a.x) - lam * bf_lo(bq.x); d0[1] = bf_hi(a.x) - lam * bf_hi(bq.x); d0[2] = bf_lo(a.y) - lam * bf_lo(bq.y); d0[3] = bf_hi(a.y) - lam * bf_hi(bq.y);
        d1v[0] = bf_lo(a.z) - lam * bf_lo(bq.z); d1v[1] = bf_hi(a.z) - lam * bf_hi(bq.z); d1v[2] = bf_lo(a.w) - lam * bf_lo(bq.w); d1v[3] = bf_hi(a.w) - lam * bf_hi(bq.w);
        float ss = (d0[0] * d0[0] + d0[1] * d0[1]) + (d0[2] * d0[2] + d0[3] * d0[3]) + (d1v[0] * d1v[0] + d1v[1] * d1v[1]) + (d1v[2] * d1v[2] + d1v[3] * d1v[3]);
        ss += __shfl_xor(ss, 1); ss += __shfl_xor(ss, 2); ss += __shfl_xor(ss, 4); ss += __shfl_xor(ss, 8);
        const float rs = __builtin_amdgcn_rsqf(ss * (1.f / 128.f) + EPS) * (1.0f - lam_init);
        *(v4u*)(MIX + (size_t)row * DM + h * 128 + 8 * q) = pg8::pack8(d0 * rs * sg0, d1v * rs * sg1);
    }
}

__global__ void __launch_bounds__(NWAVES * 64, 2) hymba_fwd(Args args) {
    extern __shared__ __attribute__((aligned(16))) unsigned char lds[];
    cg::grid_group grid = cg::this_grid();
    LAS unsigned char* ldsl = (LAS unsigned char*)lds;
    volatile LAS unsigned* MISC = (volatile LAS unsigned*)(ldsl + LDS_BYTES - 256);
    if (threadIdx.x < 32) MISC[threadIdx.x] = 0u;
    __syncthreads();
    const XcdBarrier bar = xcd_barrier_post((unsigned*)(args.ws + WS_CTL) + 4096, MISC + 8);
    const int G = gridDim.x; const int bx = blockIdx.x; const int vcu = (G % 8 == 0) ? (bx % 8) * (G / 8) + bx / 8 : bx;
#ifndef PROBE_DUP
#define PROBE_DUP 0
#endif
#define REP(mask) for (int rep_ = 0; rep_ < (((PROBE_DUP) & (mask)) ? 2 : 1); ++rep_)
#define PHASE_VARS() unsigned char* ws = args.ws; int tid_ = threadIdx.x; asm volatile("" : "+v"(tid_)); const int lane = tid_ & 63, wave = __builtin_amdgcn_readfirstlane(tid_ >> 6); (void)lane; (void)wave

    REP(1) { PHASE_VARS(); p0_prologue(args, ws, ldsl, vcu, G, wave, lane); }
    if (args.ws == nullptr) grid.sync();
    xcd_barrier(bar);

    REP(2) {
        PHASE_VARS();
        pg8::Gemm g{(bf16*)(ws + WS_XN), (bf16*)(ws + WS_WIN), MX, DIN, DM}; pg8::StaticOrder S; S.init(MX, DIN, G, bx, WGM_P1);
        pg8::EpiInProj E{(bf16*)(ws + WS_Q), (bf16*)(ws + WS_K), (bf16*)(ws + WS_V), (bf16*)(ws + WS_G), args.in[I_QG], args.in[I_KG], (const float*)(ws + WS_ROPE)};
        pg8::gemm_phase<pg8::EpiInProj, pg8::StaticOrder, PG8_ALIGN, PG8_SP2>(ldsl, g, S, E);
    }
    {
        PHASE_VARS();
        unsigned* mq = (unsigned*)(ws + WS_CTL) + 160;
        volatile LAS unsigned* TK = (volatile LAS unsigned*)(ldsl + LDS_BYTES - 256 + 64);
        for (;;) {
            if (tid_ == 0) TK[0] = __hip_atomic_fetch_add(mq, 1u, __ATOMIC_RELAXED, __HIP_MEMORY_SCOPE_AGENT);
            __syncthreads();
            const int t = (int)TK[0];
            __syncthreads();
            if (t >= 16) break;
            meta_proj(args, ws, ldsl, t, wave, lane);
        }
    }
    xcd_barrier(bar);

    REP(8) {
        PHASE_VARS();
        static_assert(attn_body::V2_LDS_BYTES <= LDS_BYTES - 256, "attention LDS");
        const float dq1 = wave_sum(args.in[I_LQ1][lane] * args.in[I_LK1][lane]), dq2 = wave_sum(args.in[I_LQ2][lane] * args.in[I_LK2][lane]);
        const float lam_init = 0.2f;
        const float lam = __builtin_amdgcn_exp2f(dq1 * 1.4426950408889634f) - __builtin_amdgcn_exp2f(dq2 * 1.4426950408889634f) + lam_init;
        for (int vv = vcu; vv < 256; vv += G) {
            const int bh = vv >> 4, s = vv & 15;
            const int b = bh >> 2, head = bh & 3;
            const attn_body::bf16* Kh = (const attn_body::bf16*)(ws + WS_K) + (size_t)(b * SPAD) * 512 + head * 128;
            const attn_body::bf16* Vh = (const attn_body::bf16*)(ws + WS_V) + (size_t)(b * SPAD) * 512 + head * 128;
            for (int i = 0; i < 2; ++i) {
                const int qb = i ? 31 - s : s;
                const int q0 = qb * 256;
                const attn_body::bf16* Qu = (const attn_body::bf16*)(ws + WS_Q) + (size_t)(b * SEQ + q0) * 512 + head * 128;
                attn_body::bf16* Mu = (attn_body::bf16*)(ws + WS_MIX) + (size_t)(b * SEQ + q0) * 1024 + head * 128;
                attn_body::attn_unit128<0>(q0, Qu, Kh, Vh, Mu, (char*)lds, lam, 1.0f - lam_init, args.in[I_SUBLN]);
                attn_body::attn_unit128<1>(q0, Qu + 64, Kh + 64, Vh, Mu, (char*)lds, lam, 1.0f - lam_init, args.in[I_SUBLN]);
            }
        }
    }
    REP(4) { PHASE_VARS(); conv_phase(args, ws, ldsl, vcu, G, wave, lane); }
    { PHASE_VARS(); wconv_phase(args, ws, ldsl, wave, lane); }
    xcd_barrier(bar);

    REP(32) {
        PHASE_VARS();
        pg8::Gemm g{(bf16*)(ws + WS_MIX), (bf16*)(ws + WS_WOUT), MX, DM, DM}; pg8::StaticOrder S; S.init(MX, DM, G, bx, WGM_P35);
        pg8::EpiOut E{(const bf16*)(ws + WS_XN), (const float*)(ws + WS_RN), args.in[I_G1], (bf16*)(ws + WS_H1B), (float*)(ws + WS_SSQ)};
        pg8::gemm_phase<pg8::EpiOut, pg8::StaticOrder, PG8_ALIGN, PG8_SP2>(ldsl, g, S, E);
    }
    xcd_barrier(bar);

    REP(64) {
        PHASE_VARS();
        pg8::Gemm g{(bf16*)(ws + WS_H1B), (bf16*)(ws + WS_WUP), MX, DFF, DM}; pg8::StaticOrder S; S.init(MX, DFF, G, bx, WGM_P4);
        pg8::EpiUp E{(bf16*)(ws + WS_HB), (const float*)(ws + WS_SSQ)};
        pg8::gemm_phase<pg8::EpiUp, pg8::StaticOrder, PG8_ALIGN, PG8_SP2>(ldsl, g, S, E);
    }
    xcd_barrier(bar);

    {
        PHASE_VARS();
        pg8::Gemm g{(bf16*)(ws + WS_HB), (bf16*)(ws + WS_WDN), MX, DM, DFF}; pg8::StaticOrder S; S.init(MX, DM, G, bx, WGM_P35);
        pg8::EpiDown E{(const bf16*)(ws + WS_H1B), args.out};
        pg8::gemm_phase<pg8::EpiDown, pg8::StaticOrder, PG8_ALIGN, PG8_SP2>(ldsl, g, S, E);
    }
#undef PHASE_VARS
#undef REP
}

extern "C" void kernel_launch(void* const* d_in, const int* in_sizes, int n_in, void* d_out, int out_size, void* d_ws, size_t ws_size, hipStream_t stream) {
    static int grid = 0;
    if (grid == 0) {
        if (n_in != 19 || in_sizes[0] != MX * DM || out_size != MX * DM || ws_size < WS_END) { fprintf(stderr, "kernel_launch: unexpected shapes: n_in %d, in0 %d, out %d, ws %zu (need %zu); nothing launched\n", n_in, n_in > 0 ? in_sizes[0] : -1, out_size, ws_size, (size_t)WS_END); grid = -1; return; }
        int dev = 0, cus = 0, per_cu = 0;
        if (hipGetDevice(&dev) != hipSuccess || hipDeviceGetAttribute(&cus, hipDeviceAttributeMultiprocessorCount, dev) != hipSuccess) { fprintf(stderr, "kernel_launch: device query failed\n"); grid = -1; return; }
        if (hipFuncSetAttribute((const void*)hymba_fwd, hipFuncAttributeMaxDynamicSharedMemorySize, LDS_BYTES) != hipSuccess) { fprintf(stderr, "kernel_launch: hipFuncSetAttribute failed\n"); grid = -1; return; }
        if (hipOccupancyMaxActiveBlocksPerMultiprocessor(&per_cu, (const void*)hymba_fwd, NWAVES * 64, LDS_BYTES) != hipSuccess || per_cu < 1) { fprintf(stderr, "kernel_launch: occupancy query says %d\n", per_cu); per_cu = 1; }
        (void)hipGetLastError();
        grid = cus * 1;
        fprintf(stderr, "kernel_launch: grid %d (occupancy query %d per CU)\n", grid, per_cu);
    }
    if (grid < 0) return;
    Args a{};
    for (int i = 0; i < 19; ++i) a.in[i] = (const float*)d_in[i];
    a.out = (float*)d_out; a.ws = (unsigned char*)d_ws;
    for (int i = 0; i < 8; ++i) a.inv_freq[i] = (float)pow(500000.0, -(double)i / 8.0);
    if (hipMemsetAsync((char*)d_ws + WS_CTL, 0, 65536, stream) != hipSuccess) { fprintf(stderr, "kernel_launch: hipMemsetAsync failed\n"); return; }
    void* kargs[] = {&a};
    const hipError_t le = hipLaunchCooperativeKernel((const void*)hymba_fwd, dim3(grid), dim3(NWAVES * 64), kargs, LDS_BYTES, stream);
    if (le != hipSuccess) fprintf(stderr, "kernel_launch: cooperative launch failed: %s (grid %d)\n", hipGetErrorName(le), grid);
}
```

```cpp
#include <hip/hip_cooperative_groups.h>
#include <cmath>
#include <hip/hip_runtime.h>
#include <cstdio>
#include <cstdint>
namespace pg8 {
#define PG8_LAS __attribute__((address_space(3)))
typedef unsigned short bf16_t;
typedef short bf16x8 __attribute__((ext_vector_type(8)));
typedef float f32x4 __attribute__((ext_vector_type(4)));
typedef unsigned u32x4 __attribute__((ext_vector_type(4)));
constexpr int BM = 256, BK = 64, HALF = 128, HTB = HALF * BK * 2  , STAGE_BYTES = 8 * HTB, NXCD = 8, WGM = 8;

__host__ __device__ __forceinline__ int lds_byte(int r, int c) { const int st = (r >> 4) * 2 + (c >> 5), rr = r & 15, cc = c & 31, ob = rr * 64 + cc * 2; return st * 1024 + (ob ^ (((ob >> 9) & 1) << 5)); }
__host__ __device__ __forceinline__ void stage_rc(int b, int& R, int& C) { const int st = b / 1024, sb = b % 1024, swz = sb ^ (((sb >> 9) & 1) << 5); R = (st >> 1) * 16 + swz / 64; C = (st & 1) * 32 + (swz % 64) / 2; }
__host__ __device__ __forceinline__ int perm32(int rho) { const int n = rho >> 4, i = rho & 15; return 8 * (i >> 2) + 4 * n + (i & 3); }

struct Unit { int pm, pn; };
struct Gemm { const bf16_t* A; const bf16_t* Bt; int M, N, K; };

struct StaticOrder {
    int nM, nN, nwg, G, c, wgm;
    __host__ __device__ void init(int M, int N, int G_, int c_, int wgm_ = WGM) { nM = M / BM; nN = N / BM; nwg = nM * nN; G = G_; c = c_; wgm = wgm_; }
    __host__ __device__ bool next(int i, Unit& u) const {
        const long L = (long)i * G + c; if (L >= nwg) return false;
        int wgid = (int)L; { const int q = nwg / NXCD, r = nwg % NXCD, xcd = wgid % NXCD, off = wgid / NXCD; wgid = (xcd < r ? xcd * (q + 1) : r * (q + 1) + (xcd - r) * q) + off; }
        const int nig = wgm * nN, gid = wgid / nig, fm = gid * wgm, gsz = (nM - fm) < wgm ? (nM - fm) : wgm;
        u.pm = fm + ((wgid % nig) % gsz); u.pn = (wgid % nig) / gsz; return true;
    }
    __device__ __forceinline__ void a_ready(const Unit&) const {}
    __device__ __forceinline__ void done(const Unit&) const {}
};

__device__ __forceinline__ unsigned cvt_pk_bf16(float lo, float hi) { unsigned r; asm volatile("v_cvt_pk_bf16_f32 %0, %1, %2" : "=v"(r) : "v"(lo), "v"(hi)); return r; }
typedef float f32x2 __attribute__((ext_vector_type(2)));
__device__ __forceinline__ f32x2 gelu_pk(f32x2 v) {
    const f32x2 av = __builtin_elementwise_abs(v), d = av * 0.2316418882f + 1.0f;
    f32x2 t; t.x = __builtin_amdgcn_rcpf(d.x); t.y = __builtin_amdgcn_rcpf(d.y);
    f32x2 q = t * 0.5307027145f + (-0.7265760135f); q = q * t + 0.7107068705f; q = q * t + (-0.142248368f); q = q * t + 0.127414796f; q = q * t;
    const f32x2 s = (v * v) * (-0.72134752044f);
    f32x2 e; e.x = __builtin_amdgcn_exp2f(s.x); e.y = __builtin_amdgcn_exp2f(s.y);
    const f32x2 m = v * (q * e), r = v - m;
    f32x2 o; o.x = v.x < 0.f ? m.x : r.x; o.y = v.y < 0.f ? m.y : r.y; return o;
}

template <int ACT  > struct EpiBf16 {
    static constexpr bool PERM = true, AFTER_DRAIN = false; static_assert(ACT == 0 || ACT == 1, "EpiBf16: ACT is 0 (none) or 1 (gelu_pk)");
    bf16_t* O; int ldc; const float* bias; int split_cols; size_t split_stride; float scale0;
    __device__ __forceinline__ void operator()(const f32x4 (&acc)[2][2][4][2], const Unit& u, int wr, int wc, int fr, int fq) const {
        const int row0 = u.pm * BM + wr * 64 + fr; int colt = u.pn * BM; bf16_t* base = O;
        float sc = 1.f; if (split_cols) { const int t = colt / split_cols; base += (size_t)t * split_stride; colt -= t * split_cols; if (t == 0) sc = scale0; }
        const int col0 = colt + wc * 32 + 8 * fq, bcol0 = u.pn * BM + wc * 32 + 8 * fq;
        f32x4 bv[2][2];
#pragma unroll
        for (int bj = 0; bj < 2; ++bj)
#pragma unroll
            for (int n = 0; n < 2; ++n) bv[bj][n] = bias ? *(const f32x4*)(bias + bcol0 + bj * HALF + 4 * n) : (f32x4){0.f, 0.f, 0.f, 0.f};
#pragma unroll
        for (int ai = 0; ai < 2; ++ai)
#pragma unroll
            for (int m = 0; m < 4; ++m) { bf16_t* rowp = base + (size_t)(row0 + ai * HALF + m * 16) * ldc + col0;
#pragma unroll
                for (int bj = 0; bj < 2; ++bj) { f32x4 v0 = acc[ai][bj][m][0] + bv[bj][0], v1 = acc[ai][bj][m][1] + bv[bj][1];
                    if (ACT == 1) { f32x2 a = gelu_pk((f32x2){v0[0], v0[1]}), b = gelu_pk((f32x2){v0[2], v0[3]}), c = gelu_pk((f32x2){v1[0], v1[1]}), d = gelu_pk((f32x2){v1[2], v1[3]});
                        v0 = (f32x4){a.x, a.y, b.x, b.y}; v1 = (f32x4){c.x, c.y, d.x, d.y}; }
                    v0 = v0 * sc; v1 = v1 * sc; u32x4 w; w.x = cvt_pk_bf16(v0[0], v0[1]); w.y = cvt_pk_bf16(v0[2], v0[3]); w.z = cvt_pk_bf16(v1[0], v1[1]); w.w = cvt_pk_bf16(v1[2], v1[3]);
                    *(u32x4*)(rowp + bj * HALF) = w; } }
    }
};

constexpr int XROWS = 32768, SPAD = 8256;
constexpr float QSCALE = 0.125f * 1.4426950408889634f;
__device__ __forceinline__ f32x4 shfl_xor4(f32x4 v, int m) { f32x4 r; r[0] = __shfl_xor(v[0], m); r[1] = __shfl_xor(v[1], m); r[2] = __shfl_xor(v[2], m); r[3] = __shfl_xor(v[3], m); return r; }
__device__ __forceinline__ u32x4 pack8(f32x4 a, f32x4 b) { u32x4 w; w.x = cvt_pk_bf16(a[0], a[1]); w.y = cvt_pk_bf16(a[2], a[3]); w.z = cvt_pk_bf16(b[0], b[1]); w.w = cvt_pk_bf16(b[2], b[3]); return w; }
struct EpiInProj {
    static constexpr bool PERM = true, AFTER_DRAIN = false;
    bf16_t *Q, *K, *V, *G; const float *qg, *kg, *rope;
    __device__ __forceinline__ void operator()(const f32x4 (&acc)[2][2][4][2], const Unit& u, int wr, int wc, int fr, int fq) const {
        const int pn = u.pn; constexpr bool meta = false;
        if (meta && (wr != 0 || pn < 2)) return;
        const int rbase = u.pm * BM + wr * 64 + fr;
        if (pn < 4) {
            const bool isq = pn < 2; const float* gp = isq ? qg : kg; const float osc = isq ? QSCALE : 1.f;
            f32x4 gv[2][2];
#pragma unroll
            for (int bj = 0; bj < 2; ++bj)
#pragma unroll
                for (int n = 0; n < 2; ++n) gv[bj][n] = *(const f32x4*)(gp + 32 * bj + 8 * fq + 4 * n);
            const int colb = (pn & 1) * 256 + wc * 64 + 8 * fq;
            bf16_t* dst = isq ? Q : K;
#pragma unroll
            for (int ai = 0; ai < 2; ++ai) {
                if (meta && ai) continue;
#pragma unroll
              for (int mh = 0; mh < 2; ++mh) {
                if (meta && mh) continue;
                f32x4 rv[2][4];
                if (fq < 2) {
#pragma unroll
                    for (int m2 = 0; m2 < 2; ++m2) { const int row = rbase + ai * HALF + (2 * mh + m2) * 16; const int pos = meta ? (row - XROWS) : ((row & 8191) + 16); const f32x4* rp = (const f32x4*)(rope + (size_t)pos * 16);
#pragma unroll
                        for (int k = 0; k < 4; ++k) rv[m2][k] = rp[k]; }
                }
                asm volatile("" ::: "memory");
#pragma unroll
                for (int m = 2 * mh; m < 2 * mh + 2; ++m) {
                    if (meta && m) continue;
                    const int row = rbase + ai * HALF + m * 16;
                    float ss = 0.f;
#pragma unroll
                    for (int bj = 0; bj < 2; ++bj)
#pragma unroll
                        for (int n = 0; n < 2; ++n) { const f32x4 x = acc[ai][bj][m][n]; ss += (x[0] * x[0] + x[1] * x[1]) + (x[2] * x[2] + x[3] * x[3]); }
                    ss += __shfl_xor(ss, 16); ss += __shfl_xor(ss, 32);
                    const float rs = __builtin_amdgcn_rsqf(ss * (1.0f / 64.0f) + 1e-6f);
                    f32x4 y00 = acc[ai][0][m][0] * rs * gv[0][0], y01 = acc[ai][0][m][1] * rs * gv[0][1], y10 = acc[ai][1][m][0] * rs * gv[1][0], y11 = acc[ai][1][m][1] * rs * gv[1][1];
                    const f32x4 p0 = shfl_xor4(y00, 16), p1 = shfl_xor4(y01, 16);
                    if (fq < 2) {
                        const f32x4 c0 = rv[m & 1][0], c1 = rv[m & 1][1], s0 = rv[m & 1][2], s1 = rv[m & 1][3];
                        const float sg = fq ? 1.f : -1.f;
                        y00 = y00 * c0 + (p0 * s0) * sg; y01 = y01 * c1 + (p1 * s1) * sg;
                    }
                    const u32x4 w0 = pack8(y00 * osc, y01 * osc), w1 = pack8(y10 * osc, y11 * osc);
                    if (!meta) {
                        const size_t orow = isq ? (size_t)row : (size_t)((row >> 13) * SPAD + 64 + (row & 8191));
                        *(u32x4*)(dst + orow * 512 + colb) = w0; *(u32x4*)(dst + orow * 512 + colb + 32) = w1;
                    } else {
#pragma unroll 1
                        for (int b = 0; b < 4; ++b) { const size_t orow = (size_t)(b * SPAD + fr); *(u32x4*)(dst + orow * 512 + colb) = w0; *(u32x4*)(dst + orow * 512 + colb + 32) = w1; }
                    }
                }
              }
            }
        } else if (pn < 6) {
            const int colb = (pn - 4) * 256 + wc * 32 + 8 * fq;
#pragma unroll
            for (int ai = 0; ai < 2; ++ai)
#pragma unroll
                for (int m = 0; m < 4; ++m) {
                    if (meta && (ai || m)) continue;
                    const int row = rbase + ai * HALF + m * 16;
                    const u32x4 w0 = pack8(acc[ai][0][m][0], acc[ai][0][m][1]), w1 = pack8(acc[ai][1][m][0], acc[ai][1][m][1]);
                    if (!meta) {
                        const size_t orow = (size_t)((row >> 13) * SPAD + 64 + (row & 8191));
                        *(u32x4*)(V + orow * 512 + colb) = w0; *(u32x4*)(V + orow * 512 + colb + HALF) = w1;
                    } else {
#pragma unroll 1
                        for (int b = 0; b < 4; ++b) { const size_t orow = (size_t)(b * SPAD + fr); *(u32x4*)(V + orow * 512 + colb) = w0; *(u32x4*)(V + orow * 512 + colb + HALF) = w1; }
                    }
                }
        } else {
            const int colb = (pn - 6) * 128 + wc * 32 + 8 * fq;
#pragma unroll
            for (int ai = 0; ai < 2; ++ai)
#pragma unroll
                for (int m = 0; m < 4; ++m) {
                    if (meta && (ai || m)) continue;
                    const int row = rbase + ai * HALF + m * 16;
                    f32x4 h[2];
#pragma unroll
                    for (int n = 0; n < 2; ++n) { const f32x4 a = acc[ai][0][m][n], g = acc[ai][1][m][n];
#pragma unroll
                        for (int e = 0; e < 4; ++e) h[n][e] = a[e] * __builtin_amdgcn_rcpf(1.0f + __builtin_amdgcn_exp2f(-1.4426950408889634f * g[e])); }
                    const u32x4 w0 = pack8(h[0], h[1]);
                    if (!meta) {
                        const size_t orow = (size_t)((row >> 13) * SPAD + 64 + (row & 8191));
                        *(u32x4*)(G + orow * 512 + colb) = w0;
                    } else {
#pragma unroll 1
                        for (int b = 0; b < 4; ++b) { const size_t orow = (size_t)(b * SPAD + 48 + fr); *(u32x4*)(G + orow * 512 + colb) = w0; }
                    }
                }
        }
    }
};
struct EpiOut {
    static constexpr bool PERM = true, AFTER_DRAIN = false;
    const bf16_t* xn; const float* rn; const float* g1; bf16_t* hb; float* ssq;
    __device__ __forceinline__ void operator()(const f32x4 (&acc)[2][2][4][2], const Unit& u, int wr, int wc, int fr, int fq) const {
        const int rbase = u.pm * BM + wr * 64 + fr, colb = u.pn * BM + wc * 32 + 8 * fq;
        f32x4 ig[2][2];
#pragma unroll
        for (int bj = 0; bj < 2; ++bj)
#pragma unroll
            for (int n = 0; n < 2; ++n) { const f32x4 g = *(const f32x4*)(g1 + colb + bj * HALF + 4 * n);
#pragma unroll
                for (int e = 0; e < 4; ++e) ig[bj][n][e] = __builtin_amdgcn_rcpf(g[e]); }
#pragma unroll
        for (int ai = 0; ai < 2; ++ai) {
            u32x4 xv[4][2]; float rv[4];
#pragma unroll
            for (int m = 0; m < 4; ++m) { const int row = rbase + ai * HALF + m * 16; rv[m] = rn[row];
#pragma unroll
                for (int bj = 0; bj < 2; ++bj) xv[m][bj] = *(const u32x4*)(xn + (size_t)row * 1024 + colb + bj * HALF); }
            asm volatile("" ::: "memory");
#pragma unroll
            for (int m = 0; m < 4; ++m) {
                const int row = rbase + ai * HALF + m * 16; float ss = 0.f;
#pragma unroll
                for (int bj = 0; bj < 2; ++bj) { const size_t off = (size_t)row * 1024 + colb + bj * HALF; const u32x4 w = xv[m][bj];
                    f32x4 x0, x1;
                    x0[0] = __uint_as_float(w.x << 16); x0[1] = __uint_as_float(w.x & 0xffff0000u); x0[2] = __uint_as_float(w.y << 16); x0[3] = __uint_as_float(w.y & 0xffff0000u);
                    x1[0] = __uint_as_float(w.z << 16); x1[1] = __uint_as_float(w.z & 0xffff0000u); x1[2] = __uint_as_float(w.w << 16); x1[3] = __uint_as_float(w.w & 0xffff0000u);
                    const f32x4 h0 = x0 * rv[m] * ig[bj][0] + acc[ai][bj][m][0], h1 = x1 * rv[m] * ig[bj][1] + acc[ai][bj][m][1];
                    *(u32x4*)(hb + off) = pack8(h0, h1);
                    ss += (h0[0] * h0[0] + h0[1] * h0[1]) + (h0[2] * h0[2] + h0[3] * h0[3]) + (h1[0] * h1[0] + h1[1] * h1[1]) + (h1[2] * h1[2] + h1[3] * h1[3]); }
                ss += __shfl_xor(ss, 16); ss += __shfl_xor(ss, 32);
                if (fq == 0) ssq[(size_t)row * 16 + u.pn * 4 + wc] = ss;
            }
        }
    }
};
struct EpiUp {
    static constexpr bool PERM = true, AFTER_DRAIN = false;
    bf16_t* hb; const float* ssq;
    __device__ __forceinline__ void operator()(const f32x4 (&acc)[2][2][4][2], const Unit& u, int wr, int wc, int fr, int fq) const {
        const int rbase = u.pm * BM + wr * 64 + fr, colb = u.pn * BM + wc * 64 + 8 * fq;
        const bool odd = (fr & 1) != 0;
#pragma unroll
        for (int ai = 0; ai < 2; ++ai) {
            f32x4 sv[4][4];
#pragma unroll
            for (int m = 0; m < 4; ++m) { const f32x4* sp = (const f32x4*)(ssq + (size_t)(rbase + ai * HALF + m * 16) * 16);
#pragma unroll
                for (int k = 0; k < 4; ++k) sv[m][k] = sp[k]; }
            asm volatile("" ::: "memory");
#pragma unroll
            for (int m = 0; m < 4; ++m) {
                const int row = rbase + ai * HALF + m * 16, row_e = row - (odd ? 1 : 0);
                const f32x4 s0 = sv[m][0], s1 = sv[m][1], s2 = sv[m][2], s3 = sv[m][3];
                const float tot = ((s0[0] + s0[1]) + (s0[2] + s0[3])) + ((s1[0] + s1[1]) + (s1[2] + s1[3])) + ((s2[0] + s2[1]) + (s2[2] + s2[3])) + ((s3[0] + s3[1]) + (s3[2] + s3[3]));
                const float rs = __builtin_amdgcn_rsqf(tot * (1.0f / 1024.0f) + 1e-6f);
                u32x4 w[2];
#pragma unroll
                for (int bj = 0; bj < 2; ++bj) { f32x4 a0 = acc[ai][bj][m][0] * rs, a1 = acc[ai][bj][m][1] * rs;
#pragma unroll
                    for (int e = 0; e < 4; ++e) { const float p = fmaxf(a0[e], 0.f), q = fmaxf(a1[e], 0.f); a0[e] = p * p; a1[e] = q * q; }
                    w[bj] = pack8(a0, a1); }
                const u32x4 snd = odd ? w[0] : w[1]; u32x4 rcv;
                rcv.x = (unsigned)__builtin_amdgcn_update_dpp(0, (int)snd.x, 0xB1, 0xF, 0xF, true); rcv.y = (unsigned)__builtin_amdgcn_update_dpp(0, (int)snd.y, 0xB1, 0xF, 0xF, true);
                rcv.z = (unsigned)__builtin_amdgcn_update_dpp(0, (int)snd.z, 0xB1, 0xF, 0xF, true); rcv.w = (unsigned)__builtin_amdgcn_update_dpp(0, (int)snd.w, 0xB1, 0xF, 0xF, true);
                bf16_t* p = hb + (size_t)row_e * 4096 + colb + (odd ? 32 : 0);
                __builtin_nontemporal_store(odd ? rcv : w[0], (u32x4*)p);
                __builtin_nontemporal_store(odd ? w[1] : rcv, (u32x4*)(p + 4096));
            }
        }
    }
};
struct EpiDown {
    static constexpr bool PERM = false, AFTER_DRAIN = false;
    const bf16_t* h1; float* out;
    __device__ __forceinline__ void operator()(const f32x4 (&acc)[2][2][4][2], const Unit& u, int wr, int wc, int fr, int fq) const {
        typedef unsigned u32x2 __attribute__((ext_vector_type(2)));
        const int rbase = u.pm * BM + wr * 64 + fr, colb = u.pn * BM + wc * 32 + 4 * fq;
        const bool odd = (fr & 1) != 0;
#pragma unroll
        for (int ai = 0; ai < 2; ++ai) {
            u32x2 hv[4][2][2];
#pragma unroll
            for (int m = 0; m < 4; ++m)
#pragma unroll
                for (int bj = 0; bj < 2; ++bj)
#pragma unroll
                    for (int n = 0; n < 2; ++n) hv[m][bj][n] = *(const u32x2*)(h1 + (size_t)(rbase + ai * HALF + m * 16) * 1024 + colb + bj * HALF + 16 * n);
            asm volatile("" ::: "memory");
#pragma unroll
            for (int m = 0; m < 4; ++m) {
                const int row = rbase + ai * HALF + m * 16, row_e = row - (odd ? 1 : 0);
#pragma unroll
                for (int bj = 0; bj < 2; ++bj) {
                    f32x4 a[2];
#pragma unroll
                    for (int n = 0; n < 2; ++n) { const u32x2 w = hv[m][bj][n];
                        f32x4 r; r[0] = __uint_as_float(w.x << 16); r[1] = __uint_as_float(w.x & 0xffff0000u); r[2] = __uint_as_float(w.y << 16); r[3] = __uint_as_float(w.y & 0xffff0000u);
                        a[n] = r + acc[ai][bj][m][n]; }
                    const f32x4 snd = odd ? a[0] : a[1]; f32x4 rcv;
#pragma unroll
                    for (int e = 0; e < 4; ++e) rcv[e] = __int_as_float(__builtin_amdgcn_update_dpp(0, __float_as_int(snd[e]), 0xB1, 0xF, 0xF, true));
                    const size_t off = (size_t)row_e * 1024 + colb + bj * HALF + (odd ? 16 : 0);
                    __builtin_nontemporal_store(odd ? rcv : a[0], (f32x4*)(out + off));
                    __builtin_nontemporal_store(odd ? a[1] : rcv, (f32x4*)(out + off + 1024)); }
            }
        }
    }
};


template <class Epi, class Sched, bool ALIGN_EPI = false, bool SP2 = false>
__device__ __forceinline__ void gemm_phase(PG8_LAS unsigned char* lds, const Gemm g, const Sched& S, const Epi& E) {
    int tid_ = threadIdx.x; asm volatile("" : "+v"(tid_));
    const int tid = tid_, wid = __builtin_amdgcn_readfirstlane(tid >> 6), lane = tid & 63, wr = wid >> 2, wc = wid & 3, fr = lane & 15, fq = lane >> 4;
    const int K = g.K, nt = K / BK;
    unsigned voffA[2], voffB[2];
#pragma unroll
    for (int i = 0; i < 2; ++i) { int R, C; stage_rc(tid * 16 + i * 8192, R, C); const int Rb = Epi::PERM ? ((R & ~31) + perm32(R & 31)) : R;
        voffA[i] = (unsigned)(R * K + C) * 2u; voffB[i] = (unsigned)(Rb * K + C) * 2u; }
    const size_t kstep = (size_t)(BK * 2);
    const size_t hstep = (size_t)HALF * K * 2;
    const size_t tstep = 2 * hstep;
    const unsigned ldsw = (unsigned)wid * 1024u;
    const int aoff = lds_byte(wr * 64 + fr, fq * 8), boff = lds_byte(wc * 32 + fr, fq * 8);
#define PG8_SA(b, h) (((b) * 2 + (h)) * HTB)
#define PG8_SB(b, h) ((4 + (b) * 2 + (h)) * HTB)
#define PG8_STAGE(bufoff, gbase, voff) do { _Pragma("unroll") for (int _i = 0; _i < 2; ++_i) \
        __builtin_amdgcn_global_load_lds((const unsigned*)((const char*)(gbase) + (voff)[_i]), (PG8_LAS unsigned*)(lds + (bufoff) + ldsw + _i * 8192), 16, 0, 0); } while (0)
#define PG8_LDA(dst, b, h) do { _Pragma("unroll") for (int m = 0; m < 4; ++m) _Pragma("unroll") for (int k = 0; k < 2; ++k) dst[m][k] = *(const PG8_LAS bf16x8*)(lds + PG8_SA(b, h) + aoff + m * 2048 + k * 1024); } while (0)
#define PG8_LDB(dst, b, h) do { _Pragma("unroll") for (int n = 0; n < 2; ++n) _Pragma("unroll") for (int k = 0; k < 2; ++k) dst[n][k] = *(const PG8_LAS bf16x8*)(lds + PG8_SB(b, h) + boff + n * 2048 + k * 1024); } while (0)
#define PG8_MMA(ai, bj, At, Bt) do { __builtin_amdgcn_s_setprio(1); _Pragma("unroll") for (int m = 0; m < 4; ++m) _Pragma("unroll") for (int n = 0; n < 2; ++n) _Pragma("unroll") for (int k = 0; k < 2; ++k) \
        acc[ai][bj][m][n] = __builtin_amdgcn_mfma_f32_16x16x32_bf16(Bt[n][k], At[m][k], acc[ai][bj][m][n], 0, 0, 0); __builtin_amdgcn_s_setprio(0); } while (0)
#define PG8_WAIT_V(n) asm volatile("s_waitcnt vmcnt(" #n ")" ::: "memory")
#define PG8_WAIT_L(n) asm volatile("s_waitcnt lgkmcnt(" #n ")" ::: "memory")
#define PG8_BAR __builtin_amdgcn_s_barrier()
#define PG8_SCHED __builtin_amdgcn_sched_barrier(0)
    Unit cur, nxt; int ui = 0;
    if (!S.next(0, cur)) return;
    f32x4 acc[2][2][4][2];
#pragma unroll
    for (int a = 0; a < 2; ++a)
#pragma unroll
        for (int b = 0; b < 2; ++b)
#pragma unroll
            for (int m = 0; m < 4; ++m)
#pragma unroll
                for (int n = 0; n < 2; ++n) acc[a][b][m][n] = (f32x4){0.f, 0.f, 0.f, 0.f};
    bf16x8 At[4][2], B0[2][2], B1[2][2];
    const char* cA = (const char*)g.A + (size_t)cur.pm * tstep; const char* cB = (const char*)g.Bt + (size_t)cur.pn * tstep;
    S.a_ready(cur);
    if constexpr (SP2) {
        PG8_STAGE(PG8_SB(0, 0), cB, voffB); PG8_STAGE(PG8_SB(0, 1), cB + hstep, voffB); PG8_STAGE(PG8_SA(0, 0), cA, voffA); PG8_STAGE(PG8_SA(0, 1), cA + hstep, voffA);
        if (wr == 1) PG8_BAR;
        PG8_WAIT_V(2); PG8_BAR;
        PG8_STAGE(PG8_SB(1, 0), cB + kstep, voffB); PG8_STAGE(PG8_SA(1, 0), cA + kstep, voffA); PG8_STAGE(PG8_SB(1, 1), cB + hstep + kstep, voffB);
        PG8_WAIT_V(6); PG8_BAR;
    } else {
        PG8_STAGE(PG8_SB(0, 0), cB, voffB); PG8_STAGE(PG8_SA(0, 0), cA, voffA); PG8_STAGE(PG8_SB(0, 1), cB + hstep, voffB); PG8_STAGE(PG8_SA(0, 1), cA + hstep, voffA);
        if (wr == 1) PG8_BAR;
        PG8_WAIT_V(4); PG8_BAR;
        PG8_STAGE(PG8_SB(1, 0), cB + kstep, voffB); PG8_STAGE(PG8_SA(1, 0), cA + kstep, voffA); PG8_STAGE(PG8_SB(1, 1), cB + hstep + kstep, voffB);
        PG8_WAIT_V(6); PG8_BAR;
    }
    for (;;) {
        const bool has_next = S.next(ui + 1, nxt);
        const char* nA = has_next ? (const char*)g.A + (size_t)nxt.pm * tstep : cA; const char* nB = has_next ? (const char*)g.Bt + (size_t)nxt.pn * tstep : cB;
        for (int t = 0; t < nt; t += 2) {
            const bool last = (t == nt - 2);
            const char* a1 = cA + (size_t)(t + 1) * kstep;
            const char* a2 = last ? nA : cA + (size_t)(t + 2) * kstep; const char* b2 = last ? nB : cB + (size_t)(t + 2) * kstep;
            const char* a3 = a2 + kstep; const char* b3 = b2 + kstep;
            if (last && has_next) S.a_ready(nxt);
            if constexpr (SP2) {
            PG8_LDB(B0, 0, 0); PG8_LDB(B1, 0, 1); PG8_SCHED; PG8_LDA(At, 0, 0); PG8_STAGE(PG8_SA(1, 1), a1 + hstep, voffA);
            PG8_WAIT_V(8); PG8_WAIT_L(0); PG8_BAR; PG8_MMA(0, 0, At, B0); PG8_MMA(0, 1, At, B1); PG8_BAR; PG8_SCHED;
            PG8_LDA(At, 0, 1); PG8_STAGE(PG8_SB(0, 0), b2, voffB); PG8_STAGE(PG8_SB(0, 1), b2 + hstep, voffB); PG8_STAGE(PG8_SA(0, 0), a2, voffA);
            PG8_WAIT_V(8); PG8_WAIT_L(0); PG8_BAR; PG8_MMA(1, 0, At, B0); PG8_MMA(1, 1, At, B1); PG8_BAR; PG8_SCHED;
            PG8_LDB(B0, 1, 0); PG8_LDB(B1, 1, 1); PG8_SCHED; PG8_LDA(At, 1, 0); PG8_STAGE(PG8_SA(0, 1), a2 + hstep, voffA);
            PG8_WAIT_V(8); PG8_WAIT_L(0); PG8_BAR; PG8_MMA(0, 0, At, B0); PG8_MMA(0, 1, At, B1); PG8_BAR; PG8_SCHED;
            PG8_LDA(At, 1, 1); PG8_STAGE(PG8_SB(1, 0), b3, voffB); PG8_STAGE(PG8_SB(1, 1), b3 + hstep, voffB); PG8_STAGE(PG8_SA(1, 0), a3, voffA);
            PG8_WAIT_V(8); PG8_WAIT_L(0); PG8_BAR; PG8_MMA(1, 0, At, B0); PG8_MMA(1, 1, At, B1); PG8_BAR; PG8_SCHED;
            } else {
            PG8_LDB(B0, 0, 0); PG8_SCHED; PG8_LDA(At, 0, 0); PG8_STAGE(PG8_SA(1, 1), a1 + hstep, voffA);
            PG8_WAIT_L(8); PG8_BAR; PG8_WAIT_L(0); PG8_MMA(0, 0, At, B0); PG8_BAR; PG8_SCHED;
            PG8_LDB(B1, 0, 1); PG8_STAGE(PG8_SB(0, 0), b2, voffB);
            PG8_BAR; PG8_WAIT_L(0); PG8_MMA(0, 1, At, B1); PG8_BAR;
            PG8_LDA(At, 0, 1); PG8_STAGE(PG8_SA(0, 0), a2, voffA);
            PG8_BAR; PG8_WAIT_L(0); PG8_MMA(1, 0, At, B0); PG8_BAR; PG8_SCHED;
            PG8_STAGE(PG8_SB(0, 1), b2 + hstep, voffB);
            PG8_WAIT_V(6); PG8_BAR; PG8_MMA(1, 1, At, B1); PG8_BAR;
            PG8_LDB(B0, 1, 0); PG8_SCHED; PG8_LDA(At, 1, 0); PG8_STAGE(PG8_SA(0, 1), a2 + hstep, voffA);
            PG8_WAIT_L(8); PG8_BAR; PG8_WAIT_L(0); PG8_MMA(0, 0, At, B0); PG8_BAR; PG8_SCHED;
            PG8_LDB(B1, 1, 1); PG8_STAGE(PG8_SB(1, 0), b3, voffB);
            PG8_BAR; PG8_WAIT_L(0); PG8_MMA(0, 1, At, B1); PG8_BAR;
            PG8_LDA(At, 1, 1); PG8_STAGE(PG8_SA(1, 0), a3, voffA);
            PG8_BAR; PG8_WAIT_L(0); PG8_MMA(1, 0, At, B0); PG8_BAR; PG8_SCHED;
            PG8_STAGE(PG8_SB(1, 1), b3 + hstep, voffB);
            PG8_WAIT_V(6); PG8_BAR; PG8_MMA(1, 1, At, B1); PG8_BAR;
            }
        }
        if constexpr (ALIGN_EPI) { if (wr == 0) PG8_BAR; }
        if constexpr (!Epi::AFTER_DRAIN) { E(acc, cur, wr, wc, fr, fq); S.done(cur); }
        if (!has_next) break;
#pragma unroll
        for (int a = 0; a < 2; ++a)
#pragma unroll
            for (int b = 0; b < 2; ++b)
#pragma unroll
                for (int m = 0; m < 4; ++m)
#pragma unroll
                    for (int n = 0; n < 2; ++n) acc[a][b][m][n] = (f32x4){0.f, 0.f, 0.f, 0.f};
        cur = nxt; cA = nA; cB = nB; ++ui;
        if constexpr (ALIGN_EPI) { if (wr == 1) PG8_BAR; }
    }
    PG8_WAIT_V(0);
    if constexpr (!ALIGN_EPI) { if (wr == 0) PG8_BAR; }
    PG8_BAR;
    if constexpr (Epi::AFTER_DRAIN) { E.fused(acc, cur, wr, wc, fr, fq, lds, wid, lane); S.done(cur); }
#undef PG8_SA
#undef PG8_SB
#undef PG8_STAGE
#undef PG8_LDA
#undef PG8_LDB
#undef PG8_MMA
#undef PG8_WAIT_V
#undef PG8_WAIT_L
#undef PG8_BAR
#undef PG8_SCHED
}
}

#ifndef PG8_SP2
#define PG8_SP2 true
#endif
#ifndef PG8_ALIGN
#define PG8_ALIGN true
#endif
#include <hip/hip_bf16.h>
#include <cmath>
namespace attn_body {
using bf16=__hip_bfloat16;
using bf16x8=__attribute__((ext_vector_type(8)))short;
using s16x4=__attribute__((ext_vector_type(4)))short;
using f32x16=__attribute__((ext_vector_type(16)))float;
using u32x4=__attribute__((ext_vector_type(4)))unsigned;
constexpr int SEQ=8192,D=64,PQ=512,PO=1024;
constexpr int NW=8,QBLK=32,QB=QBLK*NW,KVBLK=64,NQB=SEQ/QB;
constexpr int ATTN_UNIT_ROWS=QB;
__device__ __forceinline__ int crow(int r,int hi){return (r&3)+8*(r>>2)+4*hi;}
#define SBAR() __builtin_amdgcn_sched_barrier(0)
__device__ __forceinline__ void cmask(f32x16&p0,f32x16&p1,int jb,int qrel,int hi){
  const float NEG=-INFINITY; int kb=64*jb+4*hi;
  #pragma unroll
  for(int r=0;r<16;++r){int kv=kb+(r&3)+8*(r>>2); if(kv>qrel)p0[r]=NEG; if(kv+32>qrel)p1[r]=NEG;}
}

constexpr int NSLOT=3, SLOTB=8192;
constexpr int LDS_K=0, LDS_V=NSLOT*SLOTB, LDS_WS=2*NSLOT*SLOTB, LDS_OST=LDS_WS+NW*64*4, LDS_BYTES=LDS_OST+NW*4096;
constexpr float C2=0.125f*1.4426950408889634f;
__device__ __forceinline__ void glds16(const void*gsrc,unsigned lds_dst){unsigned keep;
  asm volatile("s_mov_b32 %0, m0\n\ts_mov_b32 m0, %2\n\ts_nop 0\n\tglobal_load_lds_dwordx4 %1, off\n\ts_mov_b32 m0, %0":"=&s"(keep):"v"(gsrc),"s"(lds_dst):"memory");}
__device__ __forceinline__ float max3f(float a,float b,float c){float r;asm("v_max3_f32 %0, %1, %2, %3":"=v"(r):"v"(a),"v"(b),"v"(c));return r;}
__device__ __forceinline__ float max2f(float a,float b){float r;asm("v_max_f32_e32 %0, %1, %2":"=v"(r):"v"(a),"v"(b));return r;}
__device__ __forceinline__ float fadd_s(float a,float b){float r;asm("v_add_f32_e32 %0, %1, %2":"=v"(r):"v"(a),"v"(b));return r;}
__device__ __forceinline__ float fsub_s(float a,float b){float r;asm("v_sub_f32_e32 %0, %1, %2":"=v"(r):"v"(a),"v"(b));return r;}
typedef float f32x2_t __attribute__((ext_vector_type(2))); typedef __bf16 bf16x2_t __attribute__((ext_vector_type(2)));
__device__ __forceinline__ unsigned cvtpk_s(float lo,float hi){f32x2_t v={lo,hi};bf16x2_t b=__builtin_convertvector(v,bf16x2_t);return __builtin_bit_cast(unsigned,b);}
#define WAIT_BAR(N) asm volatile("s_waitcnt vmcnt(" #N ") lgkmcnt(0)\n\ts_barrier":::"memory")

__device__ __forceinline__ void qkt(f32x16&p0,f32x16&p1,const char*Kslot,const bf16x8*qr,const f32x16&negm,int r32,int hi){
  const char*kb=Kslot+hi*1024+r32*16;
  #pragma unroll
  for(int d0=0;d0<4;++d0){
    const bf16x8 b0=*reinterpret_cast<const bf16x8*>(kb+d0*2048);
    const bf16x8 b1=*reinterpret_cast<const bf16x8*>(kb+d0*2048+512);
    if(d0==0){p0=__builtin_amdgcn_mfma_f32_32x32x16_bf16(b0,qr[0],negm,0,0,0);p1=__builtin_amdgcn_mfma_f32_32x32x16_bf16(b1,qr[0],negm,0,0,0);}
    else{p0=__builtin_amdgcn_mfma_f32_32x32x16_bf16(b0,qr[d0],p0,0,0,0);p1=__builtin_amdgcn_mfma_f32_32x32x16_bf16(b1,qr[d0],p1,0,0,0);}}
}
typedef __attribute__((address_space(3))) const char* lds_cptr;
typedef short v4i16_t __attribute__((ext_vector_type(4)));
__device__ __forceinline__ void kload8(bf16x8*kf,lds_cptr kp){
  kf[0]=*(const __attribute__((address_space(3))) bf16x8*)(kp);      kf[1]=*(const __attribute__((address_space(3))) bf16x8*)(kp+512);
  kf[2]=*(const __attribute__((address_space(3))) bf16x8*)(kp+2048); kf[3]=*(const __attribute__((address_space(3))) bf16x8*)(kp+2560);
  kf[4]=*(const __attribute__((address_space(3))) bf16x8*)(kp+4096); kf[5]=*(const __attribute__((address_space(3))) bf16x8*)(kp+4608);
  kf[6]=*(const __attribute__((address_space(3))) bf16x8*)(kp+6144); kf[7]=*(const __attribute__((address_space(3))) bf16x8*)(kp+6656);
}
__device__ __forceinline__ void kload2(bf16x8*kf,lds_cptr kp,int j){ kf[2*j]=*(const __attribute__((address_space(3))) bf16x8*)(kp+j*2048); kf[2*j+1]=*(const __attribute__((address_space(3))) bf16x8*)(kp+j*2048+512); }
__device__ __forceinline__ s16x4 vtr(lds_cptr p){ return __builtin_bit_cast(s16x4,__builtin_amdgcn_ds_read_tr16_b64_v4i16((__attribute__((address_space(3))) v4i16_t*)p)); }
__device__ __forceinline__ float rowmax(const f32x16&p0,const f32x16&p1){
  float a=max3f(p0[0],p0[1],p1[0]),b=max3f(p0[2],p0[3],p1[1]);a=max3f(a,p1[2],p1[3]);
  #pragma unroll
  for(int r=4;r<16;r+=4){a=max3f(a,p0[r],p0[r+1]);b=max3f(b,p0[r+2],p0[r+3]);a=max3f(a,p1[r],p1[r+1]);b=max3f(b,p1[r+2],p1[r+3]);}
  const float m=max2f(a,b);
  auto rr=__builtin_amdgcn_permlane32_swap(__float_as_uint(m),__float_as_uint(m),false,false);
  return max2f(__uint_as_float(rr[0]),__uint_as_float(rr[1]));
}
__device__ __forceinline__ void pv(f32x16*o,int vb,bf16x8 pa0,bf16x8 pa1,bf16x8 pa2,bf16x8 pa3){
  #pragma unroll
  for(int d0=0;d0<2;++d0){s16x4 lo[4],hi[4];
    #pragma unroll
    for(int ks=0;ks<4;++ks){
      asm volatile("ds_read_b64_tr_b16 %0,%1 offset:%c2":"=&v"(lo[ks]):"v"(vb),"i"(d0*4096+ks*1024):"memory");
      asm volatile("ds_read_b64_tr_b16 %0,%1 offset:%c2":"=&v"(hi[ks]):"v"(vb),"i"(d0*4096+ks*1024+512):"memory");}
    asm volatile("s_waitcnt lgkmcnt(0)":::"memory");SBAR();
    #define PK(k) (bf16x8){lo[k][0],lo[k][1],lo[k][2],lo[k][3],hi[k][0],hi[k][1],hi[k][2],hi[k][3]}
    o[d0]=__builtin_amdgcn_mfma_f32_32x32x16_bf16(pa0,PK(0),o[d0],0,0,0);
    o[d0]=__builtin_amdgcn_mfma_f32_32x32x16_bf16(pa1,PK(1),o[d0],0,0,0);
    o[d0]=__builtin_amdgcn_mfma_f32_32x32x16_bf16(pa2,PK(2),o[d0],0,0,0);
    o[d0]=__builtin_amdgcn_mfma_f32_32x32x16_bf16(pa3,PK(3),o[d0],0,0,0);
    #undef PK
  }
}

#ifndef ATTN_STORE16
#define ATTN_STORE16(p,v) (*(u32x4*)(p)=(v))
#endif
template<int THRL> __device__ __forceinline__ void attn_unit(int q0,const bf16*Qu,const bf16*__restrict__ Kh,const bf16*__restrict__ Vh,bf16*Ou,char*shm){
  int tid_=threadIdx.x; asm volatile("":"+v"(tid_)); const int tid=tid_,lane=tid&63,r32=lane&31,hi=lane>>5; const int wid=__builtin_amdgcn_readfirstlane(tid>>6);
  const bf16*Qw=Qu+(long)(wid*QBLK)*PQ;
  const unsigned lds0=(unsigned)(uintptr_t)shm;
  float*wsf=(float*)(shm+LDS_WS)+wid*64;
  const bf16*ksrc=Kh+(long)lane*PQ+wid*8;
  const bf16*vsrc=Vh+(long)(16*(wid&3)+(lane>>2))*PQ+(wid>>2)*32+(lane&3)*8;
  const unsigned kdst=lds0+LDS_K+wid*1024, vdst=lds0+LDS_V+wid*1024;
  #define DMA_K(t,slot) glds16(ksrc+(long)(t)*KVBLK*PQ,(unsigned)__builtin_amdgcn_readfirstlane(kdst+(slot)))
  #define DMA_V(t,slot) glds16(vsrc+(long)(t)*KVBLK*PQ,(unsigned)__builtin_amdgcn_readfirstlane(vdst+(slot)))
  const int vb0=(int)(lds0+LDS_V)+((lane>>4)&1)*32+(lane&3)*8+(4*hi+((lane&15)>>2))*64;
  const char*Kbase=shm+LDS_K; bf16x8 kf[8];
  const lds_cptr shm3=(lds_cptr)shm; const lds_cptr kp0=shm3+LDS_K+hi*1024+r32*16; const lds_cptr vp0=shm3+LDS_V+((lane>>4)&1)*32+(lane&3)*8+(4*hi+((lane&15)>>2))*64;
  const int NT=(q0+QB)/KVBLK+1;
  DMA_K(0,0);DMA_V(0,0);DMA_K(1,SLOTB);
  bf16x8 qr[4];
  #pragma unroll
  for(int d0=0;d0<4;++d0)qr[d0]=*reinterpret_cast<const bf16x8*>(&Qw[(long)r32*PQ+d0*16+hi*8]);
  float mhat=0.f,l_reg=0.f;f32x16 o[2];o[0]=f32x16{};o[1]=f32x16{};f32x16 negm=f32x16{};asm volatile("":"+v"(negm));
  const int qrel=wid*QBLK+r32;
  #define CMASK(P0,P1,t) do{int jb_=(t)-(NT-4); if(jb_>=0)cmask(P0,P1,jb_,qrel,hi);}while(0)
  bool resc=false;
  #define START(P0,P1) do{ const float rm=rowmax(P0,P1); resc=false; \
    { const float dl=rm; mhat=fadd_s(mhat,dl); \
      _Pragma("unroll") for(int r=0;r<16;++r){P0[r]=fsub_s(P0[r],dl);P1[r]=fsub_s(P1[r],dl);} \
      _Pragma("unroll") for(int r=0;r<16;++r)negm[r]=-mhat; asm volatile("":"+v"(negm)); } \
    _Pragma("unroll") for(int r=0;r<16;++r)P0[r]=__builtin_amdgcn_exp2f(P0[r]); }while(0)
  #define RESC() do{ if(resc){ asm volatile("s_waitcnt lgkmcnt(0)":::"memory"); \
      _Pragma("unroll") for(int d_=0;d_<2;++d_) _Pragma("unroll") for(int r=0;r<16;++r)o[d_][r]*=wsf[crow(r,hi)]; } }while(0)
  f32x16 pA0,pA1,pB0,pB1;
  int sl_prev=0,sl_cur=0,sl_next=SLOTB;
  #define ROT() do{sl_prev=sl_cur;sl_cur=sl_next;sl_next=(sl_next==(NSLOT-1)*SLOTB)?0:sl_next+SLOTB;}while(0)
  DMA_K(2,2*SLOTB);
  WAIT_BAR(3);
  qkt(pA0,pA1,Kbase,qr,negm,r32,hi);asm volatile("s_nop 15\n\ts_nop 7":"+v"(pA0),"+v"(pA1));
  { const float NEGI=-INFINITY; _Pragma("unroll") for(int r=8;r<16;++r)pA0[r]=NEGI; _Pragma("unroll") for(int r=0;r<16;++r)pA1[r]=NEGI; }
  START(pA0,pA1);
  _Pragma("unroll") for(int r=0;r<16;++r)pA1[r]=__builtin_amdgcn_exp2f(pA1[r]);
  WAIT_BAR(0);
  DMA_K(3,0);DMA_V(1,SLOTB);
  ROT();
  kload8(kf,kp0+sl_cur);
  WAIT_BAR(2);
  s16x4 vlo[8],vhi[8]; u32x4 pw0,pw1,pw2,pw3;
  #define PKW(P,B) cvtpk_s(P[B],P[B+1])
  #define PAF(k) __builtin_bit_cast(bf16x8,pw##k)
  #define VFR(i) (bf16x8){vlo[i][0],vlo[i][1],vlo[i][2],vlo[i][3],vhi[i][0],vhi[i][1],vhi[i][2],vhi[i][3]}
  #define PIN(x) asm volatile("":"+v"(x))
  #define MX3(a,b,c) __builtin_fmaxf(__builtin_fmaxf((a),(b)),(c))
  #define GAPA(MF,A0,A1,A2,A3,W0,W1,PW) do{ MF; sacc+=A0; sacc+=A1; sacc+=A2; sacc+=A3; PIN(sacc); W0; W1; PIN(PW); SBAR(); }while(0)
  #define EX(v) __builtin_amdgcn_exp2f(v)
  #define GAPB(MF,X,B) do{ MF; X[B]=EX(X[B]); X[B+1]=EX(X[B+1]); X[B+2]=EX(X[B+2]); X[B+3]=EX(X[B+3]); PIN(X); SBAR(); }while(0)
  #define VRD(i) do{ vlo[i]=vtr(vp_+(((i)>>2)*4096+((i)&3)*1024)); vhi[i]=vtr(vp_+(((i)>>2)*4096+((i)&3)*1024+512)); }while(0)
  #define KRD(G,j) do{ if(G){ kload2(kf,kp0+sl_next,j); SBAR(); } }while(0)
  #define STEP(C0,C1,P0,P1,t,GK,GV,GL) do{ SBAR(); \
    const lds_cptr vp_=vp0+sl_prev; \
    VRD(0); SBAR(); float sacc=(P0[0]+P0[1]); \
    GAPA(C0=__builtin_amdgcn_mfma_f32_32x32x16_bf16(kf[0],qr[0],negm,0,0,0), P0[2],P0[3],P0[4],P0[5],     pw0[0]=PKW(P0,0), pw0[1]=PKW(P0,2), pw0); \
    VRD(4); SBAR(); GAPA(C1=__builtin_amdgcn_mfma_f32_32x32x16_bf16(kf[1],qr[0],negm,0,0,0), P0[6],P0[7],P0[8],P0[9],     pw0[2]=PKW(P0,4), pw0[3]=PKW(P0,6), pw0); \
    VRD(1); SBAR(); GAPA(C0=__builtin_amdgcn_mfma_f32_32x32x16_bf16(kf[2],qr[1],C0,0,0,0),   P0[10],P0[11],P0[12],P0[13], pw1[0]=PKW(P0,8), pw1[1]=PKW(P0,10), pw1); \
    VRD(5); SBAR(); GAPA(C1=__builtin_amdgcn_mfma_f32_32x32x16_bf16(kf[3],qr[1],C1,0,0,0),   P0[14],P0[15],P1[0],P1[1],   pw1[2]=PKW(P0,12),pw1[3]=PKW(P0,14), pw1); \
    VRD(2); SBAR(); GAPA(C0=__builtin_amdgcn_mfma_f32_32x32x16_bf16(kf[4],qr[2],C0,0,0,0),   P1[2],P1[3],P1[4],P1[5],     pw2[0]=PKW(P1,0), pw2[1]=PKW(P1,2), pw2); \
    VRD(6); SBAR(); GAPA(C1=__builtin_amdgcn_mfma_f32_32x32x16_bf16(kf[5],qr[2],C1,0,0,0),   P1[6],P1[7],P1[8],P1[9],     pw2[2]=PKW(P1,4), pw2[3]=PKW(P1,6), pw2); \
    VRD(3); SBAR(); GAPA(C0=__builtin_amdgcn_mfma_f32_32x32x16_bf16(kf[6],qr[3],C0,0,0,0),   P1[10],P1[11],P1[12],P1[13], pw3[0]=PKW(P1,8), pw3[1]=PKW(P1,10), pw3); \
    VRD(7); SBAR(); GAPA(C1=__builtin_amdgcn_mfma_f32_32x32x16_bf16(kf[7],qr[3],C1,0,0,0),   P1[14],P1[15],0.f,0.f,       pw3[2]=PKW(P1,12),pw3[3]=PKW(P1,14), pw3); \
    l_reg+=sacc; \
    if(GK){DMA_K((t)+3,sl_cur);} if(GV){DMA_V((t)+1,sl_next);} \
    CMASK(C0,C1,t); \
    { float a=MX3(C0[0],C0[1],C1[0]),b=MX3(C0[2],C0[3],C1[1]); a=MX3(a,C1[2],C1[3]); \
      _Pragma("unroll") for(int r=4;r<16;r+=4){a=MX3(a,C0[r],C0[r+1]);b=MX3(b,C0[r+2],C0[r+3]);a=MX3(a,C1[r],C1[r+1]);b=MX3(b,C1[r+2],C1[r+3]);} \
      float rm=__builtin_fmaxf(a,b); { auto rr=__builtin_amdgcn_permlane32_swap(__float_as_uint(rm),__float_as_uint(rm),false,false); rm=__builtin_fmaxf(__uint_as_float(rr[0]),__uint_as_float(rr[1])); } \
      resc=false; \
      if(__builtin_expect(__any(rm>(float)THRL),0)){ const float dl=__builtin_fmaxf(rm,0.f); mhat+=dl; \
        _Pragma("unroll") for(int r=0;r<16;++r){C0[r]-=dl;C1[r]-=dl;} \
        _Pragma("unroll") for(int r=0;r<16;++r)negm[r]=-mhat; asm volatile("":"+v"(negm)); \
        const float f=__builtin_amdgcn_exp2f(-dl); l_reg*=f; if(hi==0)wsf[r32]=f; resc=true; } } \
    SBAR(); \
    GAPB(o[0]=__builtin_amdgcn_mfma_f32_32x32x16_bf16(PAF(0),VFR(0),o[0],0,0,0), C0,0); \
    GAPB(o[1]=__builtin_amdgcn_mfma_f32_32x32x16_bf16(PAF(0),VFR(4),o[1],0,0,0), C0,4); \
    KRD(GL,0); GAPB(o[0]=__builtin_amdgcn_mfma_f32_32x32x16_bf16(PAF(1),VFR(1),o[0],0,0,0), C0,8); \
    KRD(GL,1); GAPB(o[1]=__builtin_amdgcn_mfma_f32_32x32x16_bf16(PAF(1),VFR(5),o[1],0,0,0), C0,12); \
    KRD(GL,2); GAPB(o[0]=__builtin_amdgcn_mfma_f32_32x32x16_bf16(PAF(2),VFR(2),o[0],0,0,0), C1,0); \
    KRD(GL,3); GAPB(o[1]=__builtin_amdgcn_mfma_f32_32x32x16_bf16(PAF(2),VFR(6),o[1],0,0,0), C1,4); \
    GAPB(o[0]=__builtin_amdgcn_mfma_f32_32x32x16_bf16(PAF(3),VFR(3),o[0],0,0,0), C1,8); \
    GAPB(o[1]=__builtin_amdgcn_mfma_f32_32x32x16_bf16(PAF(3),VFR(7),o[1],0,0,0), C1,12); \
    }while(0)
  int t=1;
  #undef CMASK
  #define CMASK(P0,P1,t) do{}while(0)
  for(;t+5<NT;t+=2){
    STEP(pB0,pB1,pA0,pA1,t,true,true,true);     WAIT_BAR(2); RESC(); ROT();
    STEP(pA0,pA1,pB0,pB1,t+1,true,true,true);   WAIT_BAR(2); RESC(); ROT();
  }
  #undef CMASK
  #define CMASK(P0,P1,t) do{int jb_=(t)-(NT-4); if(jb_>=0)cmask(P0,P1,jb_,qrel,hi);}while(0)
  #define ENDW(tt) do{ if((tt)+3<NT){WAIT_BAR(2);} else if((tt)+2<NT){WAIT_BAR(1);} else {WAIT_BAR(0);} }while(0)
  for(;t+1<NT;t+=2){
    STEP(pB0,pB1,pA0,pA1,t,(t+3<NT),(t+1<NT),(t+1<NT));       ENDW(t);   RESC(); ROT();
    STEP(pA0,pA1,pB0,pB1,t+1,(t+4<NT),(t+2<NT),(t+2<NT));     ENDW(t+1); RESC(); ROT();
  }
  { float sacc=pA0[0]+pA0[1]; _Pragma("unroll") for(int r=2;r<16;++r)sacc+=pA0[r]; _Pragma("unroll") for(int r=0;r<16;++r)sacc+=pA1[r]; l_reg+=sacc;
    pw0=(u32x4){PKW(pA0,0),PKW(pA0,2),PKW(pA0,4),PKW(pA0,6)};pw1=(u32x4){PKW(pA0,8),PKW(pA0,10),PKW(pA0,12),PKW(pA0,14)};pw2=(u32x4){PKW(pA1,0),PKW(pA1,2),PKW(pA1,4),PKW(pA1,6)};pw3=(u32x4){PKW(pA1,8),PKW(pA1,10),PKW(pA1,12),PKW(pA1,14)};
    SBAR(); pv(o,vb0+sl_prev,PAF(0),PAF(1),PAF(2),PAF(3)); }
  #undef PKW
  #undef PAF
  #undef VFR
  #undef PIN
  #undef MX3
  #undef GAPA
  #undef GAPB
  #undef EX
  #undef VRD
  #undef KRD
  #undef STEP
  #undef ENDW
  {auto rr=__builtin_amdgcn_permlane32_swap(__float_as_uint(l_reg),__float_as_uint(l_reg),false,false);l_reg=__uint_as_float(rr[0])+__uint_as_float(rr[1]);}
  if(hi==0)wsf[32+r32]=l_reg;asm volatile("s_waitcnt lgkmcnt(0)":::"memory");
  float rli[16];
  #pragma unroll
  for(int r=0;r<16;++r)rli[r]=__builtin_amdgcn_rcpf(wsf[32+crow(r,hi)]);
  bf16*Ow=Ou+(long)(wid*QBLK)*PO;
  { bf16*stg=(bf16*)(shm+LDS_OST)+wid*2048;
    #pragma unroll
    for(int r=0;r<16;++r){const int orow=crow(r,hi);
      #pragma unroll
      for(int d0=0;d0<2;++d0)stg[orow*64+d0*32+r32]=__float2bfloat16(o[d0][r]*rli[r]);}
    asm volatile("s_waitcnt lgkmcnt(0)":::"memory");
    #pragma unroll
    for(int i=0;i<4;++i){const int row=i*8+(lane>>3),ch=lane&7; const u32x4 v=*(const u32x4*)(stg+row*64+ch*8); ATTN_STORE16(Ow+(long)row*PO+ch*8,v);} }
  asm volatile("s_waitcnt lgkmcnt(0)\n\ts_barrier":::"memory");
  #undef DMA_K
  #undef DMA_V
  #undef CMASK
  #undef START
  #undef RESC
  #undef ROT
}
constexpr int ATTN_LDS_BYTES=LDS_BYTES;
#undef SBAR
#undef WAIT_BAR
typedef float f32x4v __attribute__((ext_vector_type(4)));
constexpr int V2_SLOTV=16384, V2_LDS_K=0, V2_LDS_V=NSLOT*SLOTB, V2_LDS_WS=V2_LDS_V+NSLOT*V2_SLOTV, V2_LDS_OST=V2_LDS_WS+NW*64*4, V2_LDS_BYTES=V2_LDS_OST+NW*8192;
#define SBAR() __builtin_amdgcn_sched_barrier(0)
#define WAIT_BAR(N) asm volatile("s_waitcnt vmcnt(" #N ") lgkmcnt(0)\n\ts_barrier":::"memory")
__device__ __forceinline__ void pv4(f32x16*o,int vb,bf16x8 pa0,bf16x8 pa1,bf16x8 pa2,bf16x8 pa3){
  #pragma unroll
  for(int d0=0;d0<4;++d0){s16x4 lo[4],hi[4];
    #pragma unroll
    for(int ks=0;ks<4;++ks){
      asm volatile("ds_read_b64_tr_b16 %0,%1 offset:%c2":"=&v"(lo[ks]):"v"(vb),"i"(d0*4096+ks*1024):"memory");
      asm volatile("ds_read_b64_tr_b16 %0,%1 offset:%c2":"=&v"(hi[ks]):"v"(vb),"i"(d0*4096+ks*1024+512):"memory");}
    asm volatile("s_waitcnt lgkmcnt(0)":::"memory");SBAR();
    #define PK(k) (bf16x8){lo[k][0],lo[k][1],lo[k][2],lo[k][3],hi[k][0],hi[k][1],hi[k][2],hi[k][3]}
    o[d0]=__builtin_amdgcn_mfma_f32_32x32x16_bf16(pa0,PK(0),o[d0],0,0,0);
    o[d0]=__builtin_amdgcn_mfma_f32_32x32x16_bf16(pa1,PK(1),o[d0],0,0,0);
    o[d0]=__builtin_amdgcn_mfma_f32_32x32x16_bf16(pa2,PK(2),o[d0],0,0,0);
    o[d0]=__builtin_amdgcn_mfma_f32_32x32x16_bf16(pa3,PK(3),o[d0],0,0,0);
    #undef PK
  }
}
template<int MODE> __device__ __forceinline__ void attn_unit128(int q0,const bf16*Qu,const bf16*__restrict__ Kh,const bf16*__restrict__ Vh,bf16*Ou,char*shm,float lam,float oscale,const float*subg){
  int tid_=threadIdx.x; asm volatile("":"+v"(tid_)); const int tid=tid_,lane=tid&63,r32=lane&31,hi=lane>>5; const int wid=__builtin_amdgcn_readfirstlane(tid>>6);
  const bf16*Qw=Qu+(long)(wid*QBLK)*PQ;
  const unsigned lds0=(unsigned)(uintptr_t)shm;
  float*wsf=(float*)(shm+V2_LDS_WS)+wid*64;
  const bf16*ksrc=Kh+(long)lane*PQ+wid*8;
  const bf16*vsrc=Vh+(long)(16*(wid&3)+(lane>>2))*PQ+(wid>>2)*32+(lane&3)*8;
  const unsigned kdst=lds0+V2_LDS_K+wid*1024, vdst=lds0+V2_LDS_V+wid*1024;
  #define DMA_K(t,slot) glds16(ksrc+(long)(t)*KVBLK*PQ,(unsigned)__builtin_amdgcn_readfirstlane(kdst+(slot)))
  #define DMA_V(t,slot) do{ glds16(vsrc+(long)(t)*KVBLK*PQ,(unsigned)__builtin_amdgcn_readfirstlane(vdst+2*(slot))); glds16(vsrc+(long)(t)*KVBLK*PQ+64,(unsigned)__builtin_amdgcn_readfirstlane(vdst+2*(slot)+8192)); }while(0)
  const int vb0=(int)(lds0+V2_LDS_V)+((lane>>4)&1)*32+(lane&3)*8+(4*hi+((lane&15)>>2))*64;
  const char*Kbase=shm+V2_LDS_K; bf16x8 kf[8];
  const lds_cptr shm3=(lds_cptr)shm; const lds_cptr kp0=shm3+V2_LDS_K+hi*1024+r32*16; const lds_cptr vp0=shm3+V2_LDS_V+((lane>>4)&1)*32+(lane&3)*8+(4*hi+((lane&15)>>2))*64;
  const int NT=(q0+QB)/KVBLK+1;
  DMA_K(0,0);DMA_V(0,0);DMA_K(1,SLOTB);
  bf16x8 qr[4];
  #pragma unroll
  for(int d0=0;d0<4;++d0)qr[d0]=*reinterpret_cast<const bf16x8*>(&Qw[(long)r32*PQ+d0*16+hi*8]);
  float l_reg=0.f;f32x16 o[4];o[0]=f32x16{};o[1]=f32x16{};o[2]=f32x16{};o[3]=f32x16{};
  const f32x16 zero16=f32x16{};
  const int qrel=wid*QBLK+r32;
  #define CMASK(P0,P1,t) do{int jb_=(t)-(NT-4); if(jb_>=0)cmask(P0,P1,jb_,qrel,hi);}while(0)
  f32x16 pA0,pA1,pB0,pB1;
  int sl_prev=0,sl_cur=0,sl_next=SLOTB;
  #define ROT() do{sl_prev=sl_cur;sl_cur=sl_next;sl_next=(sl_next==(NSLOT-1)*SLOTB)?0:sl_next+SLOTB;}while(0)
  DMA_K(2,2*SLOTB);
  WAIT_BAR(3);
  qkt(pA0,pA1,Kbase,qr,zero16,r32,hi);asm volatile("s_nop 15\n\ts_nop 7":"+v"(pA0),"+v"(pA1));
  { const float NEGI=-INFINITY; _Pragma("unroll") for(int r=8;r<16;++r)pA0[r]=NEGI; _Pragma("unroll") for(int r=0;r<16;++r)pA1[r]=NEGI; }
  _Pragma("unroll") for(int r=0;r<16;++r){pA0[r]=__builtin_amdgcn_exp2f(pA0[r]);pA1[r]=__builtin_amdgcn_exp2f(pA1[r]);}
  WAIT_BAR(0);
  DMA_K(3,0);DMA_V(1,SLOTB);
  ROT();
  kload8(kf,kp0+sl_cur);
  WAIT_BAR(3);
  s16x4 vlo[8],vhi[8]; u32x4 pw0,pw1,pw2,pw3;
  #define PKW(P,B) cvtpk_s(P[B],P[B+1])
  #define PAF(k) __builtin_bit_cast(bf16x8,pw##k)
  #define VFR(i) (bf16x8){vlo[i][0],vlo[i][1],vlo[i][2],vlo[i][3],vhi[i][0],vhi[i][1],vhi[i][2],vhi[i][3]}
  #define PIN(x) asm volatile("":"+v"(x))
  #define GAPA(MF,A0,A1,A2,A3,W0,W1,PW) do{ MF; sacc+=A0; sacc+=A1; sacc+=A2; sacc+=A3; PIN(sacc); W0; W1; PIN(PW); SBAR(); }while(0)
  #define EX(v) __builtin_amdgcn_exp2f(v)
  #define GAPB(MF,X,B) do{ MF; X[B]=EX(X[B]); X[B+1]=EX(X[B+1]); PIN(X); SBAR(); }while(0)
  #define VRD(i) do{ vlo[i]=vtr(vp_+(((i)>>2)*4096+((i)&3)*1024)); vhi[i]=vtr(vp_+(((i)>>2)*4096+((i)&3)*1024+512)); }while(0)
  #define VRD2(i) do{ vlo[i]=vtr(vp_+(8192+((i)>>2)*4096+((i)&3)*1024)); vhi[i]=vtr(vp_+(8192+((i)>>2)*4096+((i)&3)*1024+512)); SBAR(); }while(0)
  #define KRD(G,j) do{ if(G){ kload2(kf,kp0+sl_next,j); SBAR(); } }while(0)
  #define MF32(a,b,c) __builtin_amdgcn_mfma_f32_32x32x16_bf16(a,b,c,0,0,0)
  #define STEP(C0,C1,P0,P1,t,GK,GV,GL) do{ SBAR(); \
    const lds_cptr vp_=vp0+2*sl_prev; \
    VRD(0); SBAR(); float sacc=(P0[0]+P0[1]); \
    GAPA(C0=MF32(kf[0],qr[0],zero16), P0[2],P0[3],P0[4],P0[5],     pw0[0]=PKW(P0,0), pw0[1]=PKW(P0,2), pw0); \
    VRD(4); SBAR(); GAPA(C1=MF32(kf[1],qr[0],zero16), P0[6],P0[7],P0[8],P0[9],     pw0[2]=PKW(P0,4), pw0[3]=PKW(P0,6), pw0); \
    VRD(1); SBAR(); GAPA(C0=MF32(kf[2],qr[1],C0),   P0[10],P0[11],P0[12],P0[13], pw1[0]=PKW(P0,8), pw1[1]=PKW(P0,10), pw1); \
    VRD(5); SBAR(); GAPA(C1=MF32(kf[3],qr[1],C1),   P0[14],P0[15],P1[0],P1[1],   pw1[2]=PKW(P0,12),pw1[3]=PKW(P0,14), pw1); \
    VRD(2); SBAR(); GAPA(C0=MF32(kf[4],qr[2],C0),   P1[2],P1[3],P1[4],P1[5],     pw2[0]=PKW(P1,0), pw2[1]=PKW(P1,2), pw2); \
    VRD(6); SBAR(); GAPA(C1=MF32(kf[5],qr[2],C1),   P1[6],P1[7],P1[8],P1[9],     pw2[2]=PKW(P1,4), pw2[3]=PKW(P1,6), pw2); \
    VRD(3); SBAR(); GAPA(C0=MF32(kf[6],qr[3],C0),   P1[10],P1[11],P1[12],P1[13], pw3[0]=PKW(P1,8), pw3[1]=PKW(P1,10), pw3); \
    VRD(7); SBAR(); GAPA(C1=MF32(kf[7],qr[3],C1),   P1[14],P1[15],0.f,0.f,       pw3[2]=PKW(P1,12),pw3[3]=PKW(P1,14), pw3); \
    l_reg+=sacc; \
    if(GK){DMA_K((t)+3,sl_cur);} if(GV){DMA_V((t)+1,sl_next);} \
    CMASK(C0,C1,t); \
    SBAR(); \
    GAPB(o[0]=MF32(PAF(0),VFR(0),o[0]), C0,0);  VRD2(0); \
    GAPB(o[1]=MF32(PAF(0),VFR(4),o[1]), C0,2);  VRD2(4); \
    KRD(GL,0); GAPB(o[0]=MF32(PAF(1),VFR(1),o[0]), C0,4);  VRD2(1); \
    KRD(GL,1); GAPB(o[1]=MF32(PAF(1),VFR(5),o[1]), C0,6);  VRD2(5); \
    KRD(GL,2); GAPB(o[0]=MF32(PAF(2),VFR(2),o[0]), C0,8);  VRD2(2); \
    KRD(GL,3); GAPB(o[1]=MF32(PAF(2),VFR(6),o[1]), C0,10); VRD2(6); \
    GAPB(o[0]=MF32(PAF(3),VFR(3),o[0]), C0,12); VRD2(3); \
    GAPB(o[1]=MF32(PAF(3),VFR(7),o[1]), C0,14); VRD2(7); \
    GAPB(o[2]=MF32(PAF(0),VFR(0),o[2]), C1,0); \
    GAPB(o[3]=MF32(PAF(0),VFR(4),o[3]), C1,2); \
    GAPB(o[2]=MF32(PAF(1),VFR(1),o[2]), C1,4); \
    GAPB(o[3]=MF32(PAF(1),VFR(5),o[3]), C1,6); \
    GAPB(o[2]=MF32(PAF(2),VFR(2),o[2]), C1,8); \
    GAPB(o[3]=MF32(PAF(2),VFR(6),o[3]), C1,10); \
    GAPB(o[2]=MF32(PAF(3),VFR(3),o[2]), C1,12); \
    GAPB(o[3]=MF32(PAF(3),VFR(7),o[3]), C1,14); \
    }while(0)
  int t=1;
  #undef CMASK
  #define CMASK(P0,P1,t) do{}while(0)
  for(;t+5<NT;t+=2){
    STEP(pB0,pB1,pA0,pA1,t,true,true,true);     WAIT_BAR(3); ROT();
    STEP(pA0,pA1,pB0,pB1,t+1,true,true,true);   WAIT_BAR(3); ROT();
  }
  #undef CMASK
  #define CMASK(P0,P1,t) do{int jb_=(t)-(NT-4); if(jb_>=0)cmask(P0,P1,jb_,qrel,hi);}while(0)
  #define ENDW(tt) do{ if((tt)+3<NT){WAIT_BAR(3);} else if((tt)+2<NT){WAIT_BAR(2);} else {WAIT_BAR(0);} }while(0)
  for(;t+1<NT;t+=2){
    STEP(pB0,pB1,pA0,pA1,t,(t+3<NT),(t+1<NT),(t+1<NT));       ENDW(t);   ROT();
    STEP(pA0,pA1,pB0,pB1,t+1,(t+4<NT),(t+2<NT),(t+2<NT));     ENDW(t+1); ROT();
  }
  { float sacc=pA0[0]+pA0[1]; _Pragma("unroll") for(int r=2;r<16;++r)sacc+=pA0[r]; _Pragma("unroll") for(int r=0;r<16;++r)sacc+=pA1[r]; l_reg+=sacc;
    pw0=(u32x4){PKW(pA0,0),PKW(pA0,2),PKW(pA0,4),PKW(pA0,6)};pw1=(u32x4){PKW(pA0,8),PKW(pA0,10),PKW(pA0,12),PKW(pA0,14)};pw2=(u32x4){PKW(pA1,0),PKW(pA1,2),PKW(pA1,4),PKW(pA1,6)};pw3=(u32x4){PKW(pA1,8),PKW(pA1,10),PKW(pA1,12),PKW(pA1,14)};
    SBAR(); pv4(o,vb0+2*sl_prev,PAF(0),PAF(1),PAF(2),PAF(3)); }
  #undef PKW
  #undef PAF
  #undef VFR
  #undef PIN
  #undef GAPA
  #undef GAPB
  #undef EX
  #undef VRD
  #undef VRD2
  #undef KRD
  #undef MF32
  #undef STEP
  #undef ENDW
  {auto rr=__builtin_amdgcn_permlane32_swap(__float_as_uint(l_reg),__float_as_uint(l_reg),false,false);l_reg=__uint_as_float(rr[0])+__uint_as_float(rr[1]);}
  if(hi==0)wsf[32+r32]=l_reg;asm volatile("s_waitcnt lgkmcnt(0)":::"memory");
  float rli[16];
  #pragma unroll
  for(int r=0;r<16;++r)rli[r]=__builtin_amdgcn_rcpf(wsf[32+crow(r,hi)]);
  { bf16*park=(bf16*)(shm+V2_LDS_OST)+wid*4096;
    if(MODE==0){
      #pragma unroll
      for(int r=0;r<16;++r){const int orow=crow(r,hi);
        #pragma unroll
        for(int d0=0;d0<4;++d0)park[orow*128+d0*32+r32]=__float2bfloat16(o[d0][r]*rli[r]);}
      asm volatile("s_waitcnt lgkmcnt(0)":::"memory");
    } else {
      #pragma unroll
      for(int r=0;r<16;++r){const int orow=crow(r,hi);
        #pragma unroll
        for(int d0=0;d0<4;++d0){const float o1=__bfloat162float(park[orow*128+d0*32+r32]); park[orow*128+d0*32+r32]=__float2bfloat16(o1-lam*(o[d0][r]*rli[r]));}}
      asm volatile("s_waitcnt lgkmcnt(0)":::"memory");
      bf16*Ow=Ou+(long)(wid*QBLK)*PO;
      const int ch=lane&15; const f32x4v g0=*(const f32x4v*)(subg+8*ch), g1=*(const f32x4v*)(subg+8*ch+4);
      #pragma unroll
      for(int i=0;i<8;++i){const int row=i*4+(lane>>4); const u32x4 v=*(const u32x4*)(park+row*128+ch*8);
        float d[8]; d[0]=__uint_as_float(v.x<<16);d[1]=__uint_as_float(v.x&0xffff0000u);d[2]=__uint_as_float(v.y<<16);d[3]=__uint_as_float(v.y&0xffff0000u);d[4]=__uint_as_float(v.z<<16);d[5]=__uint_as_float(v.z&0xffff0000u);d[6]=__uint_as_float(v.w<<16);d[7]=__uint_as_float(v.w&0xffff0000u);
        float ss=(d[0]*d[0]+d[1]*d[1])+(d[2]*d[2]+d[3]*d[3])+(d[4]*d[4]+d[5]*d[5])+(d[6]*d[6]+d[7]*d[7]);
        ss+=__shfl_xor(ss,1);ss+=__shfl_xor(ss,2);ss+=__shfl_xor(ss,4);ss+=__shfl_xor(ss,8);
        const float rs=__builtin_amdgcn_rsqf(ss*(1.0f/128.0f)+1e-6f)*oscale;
        u32x4 w; w.x=cvtpk_s(d[0]*rs*g0[0],d[1]*rs*g0[1]); w.y=cvtpk_s(d[2]*rs*g0[2],d[3]*rs*g0[3]); w.z=cvtpk_s(d[4]*rs*g1[0],d[5]*rs*g1[1]); w.w=cvtpk_s(d[6]*rs*g1[2],d[7]*rs*g1[3]);
        ATTN_STORE16(Ow+(long)row*PO+ch*8,w);}
      asm volatile("s_waitcnt lgkmcnt(0)":::"memory");
    } }
  asm volatile("s_waitcnt lgkmcnt(0)\n\ts_barrier":::"memory");
  #undef DMA_K
  #undef DMA_V
  #undef CMASK
  #undef ROT
}
#undef SBAR
#undef WAIT_BAR

}
namespace cg = cooperative_groups;
constexpr int NWAVES = 8;
constexpr int NB = 4, SEQ = 8192, DM = 1024, NMETA = 16, DIN = 2560, DFF = 4096, DCONV = 512, CONVW = 31;
constexpr int MX = NB * SEQ;
constexpr int MP = MX + 256;
constexpr int SPAD = pg8::SPAD;
constexpr float EPS = 1e-6f;
constexpr size_t MiB = 1u << 20;
constexpr size_t WS_CTL = 0, WS_WIN = 1 * MiB, WS_WOUT = 6 * MiB, WS_WUP = 8 * MiB, WS_WDN = 16 * MiB, WS_ROPE = 24 * MiB, WS_SSQ = 25 * MiB, WS_RN = 27 * MiB,
                 WS_H1B = 28 * MiB, WS_MIX = 92 * MiB, WS_HB = 156 * MiB, WS_XN = 156 * MiB, WS_O = 156 * MiB, WS_Q = 222 * MiB, WS_K = 254 * MiB, WS_V = 287 * MiB, WS_G = 320 * MiB,
                 WS_END = 412 * MiB;
static_assert(WS_XN + (size_t)MP * DM * 2 <= WS_Q && WS_K + (size_t)NB * SPAD * 512 * 2 <= WS_V && WS_G + (size_t)NB * SPAD * 512 * 2 <= WS_HB + (size_t)MX * DFF * 2 && WS_HB + (size_t)MX * DFF * 2 <= WS_END, "d_ws map");
constexpr int RING_BYTES = 131072, LDS_BYTES = 147456;
#ifndef WGM_P1
#define WGM_P1 4
#endif
#ifndef WGM_P4
#define WGM_P4 4
#endif
#ifndef WGM_P35
#define WGM_P35 4
#endif

#define LAS __attribute__((address_space(3)))
typedef unsigned short bf16;
typedef unsigned v4u __attribute__((ext_vector_type(4)));
typedef float f32x4 __attribute__((ext_vector_type(4)));
typedef float f32x2 __attribute__((ext_vector_type(2)));
#define LDS_WAIT() asm volatile("s_waitcnt lgkmcnt(0)" ::: "memory")
__device__ __forceinline__ unsigned pk2(float lo, float hi) { return pg8::cvt_pk_bf16(lo, hi); }
__device__ __forceinline__ float bf_lo(unsigned u) { return __uint_as_float(u << 16); }
__device__ __forceinline__ float bf_hi(unsigned u) { return __uint_as_float(u & 0xffff0000u); }
__device__ __forceinline__ float wave_sum(float v) {
#pragma unroll
    for (int o = 1; o < 64; o <<= 1) v += __shfl_xor(v, o);
    return v;
}

#define XB_TMO      128
#define XB_XCNT(j)  (256  + 64 * (j))
#define XB_XSUB(j)  (1280 + 64 * (j))
#define XB_XGEN(j)  (2304 + 64 * (j))
#define XB_TOP      3328
#define XB_TOPGEN   3392
#define XCD_BAR_WORDS 3456
#define XB_SPIN_CAP (1u << 18)

__device__ __forceinline__ unsigned xb_ld(unsigned* p)              { return __hip_atomic_load(p, __ATOMIC_RELAXED, __HIP_MEMORY_SCOPE_AGENT); }
__device__ __forceinline__ unsigned xb_add(unsigned* p, unsigned v) { return __hip_atomic_fetch_add(p, v, __ATOMIC_RELAXED, __HIP_MEMORY_SCOPE_AGENT); }
__device__ __forceinline__ unsigned xb_xcc_id() { return (unsigned)__builtin_amdgcn_s_getreg((3 << 11) | 20) & 0xFu; }
#define XB_SPIN(cond, bar) do { unsigned _sp = 0; while (cond) { __builtin_amdgcn_s_sleep(1); \
    if ((++_sp & 255u) == 0u) { if (xb_ld(&(bar)[XB_TMO])) break; if (_sp > XB_SPIN_CAP) { atomicAdd(&(bar)[XB_TMO], 1u); break; } } } } while (0)

struct XcdBarrier {
    unsigned* bar; unsigned x;
    volatile LAS unsigned* st;
};

__device__ __forceinline__ XcdBarrier xcd_barrier_post(unsigned* bar, volatile LAS unsigned* st) {
    XcdBarrier b; b.bar = bar; b.x = xb_xcc_id(); b.st = st;
    if (threadIdx.x == 0) (void)xb_add(&bar[XB_XCNT(b.x)], 1u);
    return b;
}
__device__ __forceinline__ void xcd_barrier_complete(unsigned* bar, unsigned x, unsigned& nloc, unsigned& nx) {
    const unsigned G = gridDim.x * gridDim.y * gridDim.z;
    unsigned sum, cnt, mine, sp = 0u;
    for (;;) {
        sum = 0u; cnt = 0u; mine = 0u;
#pragma unroll
        for (unsigned j = 0; j < 16; ++j) { const unsigned c = xb_ld(&bar[XB_XCNT(j)]); sum += c; cnt += (c > 0u) ? 1u : 0u; mine = (j == x) ? c : mine; }
        if (sum == G) break;
        __builtin_amdgcn_s_sleep(1);
        if ((++sp & 255u) == 0u) { if (xb_ld(&bar[XB_TMO])) break; if (sp > XB_SPIN_CAP) { atomicAdd(&bar[XB_TMO], 1u); break; } }
    }
    nloc = mine > 0u ? mine : 1u; nx = cnt > 0u ? cnt : 1u;
}

__device__ __forceinline__ void xcd_barrier(const XcdBarrier& b) {
    asm volatile("s_waitcnt vmcnt(0)" ::: "memory");
    __syncthreads();
    if (threadIdx.x == 0) {
        unsigned* bar = b.bar;
        __builtin_amdgcn_s_waitcnt(0);
        unsigned nloc = b.st[0], nx = b.st[1];
        if (nloc == 0u) { xcd_barrier_complete(bar, b.x, nloc, nx); b.st[0] = nloc; b.st[1] = nx; }
        const unsigned old = xb_add(&bar[XB_XSUB(b.x)], 1u);
        const unsigned gen = old / nloc;
        if (old + 1u == (gen + 1u) * nloc) {
            __builtin_amdgcn_fence(__ATOMIC_RELEASE, "agent");
            asm volatile("s_waitcnt vmcnt(0)" ::: "memory");
            const unsigned og = xb_add(&bar[XB_TOP], 1u);
            const unsigned tg = og / nx;
            if (og + 1u == (tg + 1u) * nx) xb_add(&bar[XB_TOPGEN], 1u);
            else XB_SPIN(xb_ld(&bar[XB_TOPGEN]) == tg, bar);
            __builtin_amdgcn_fence(__ATOMIC_ACQUIRE, "agent");
            xb_add(&bar[XB_XGEN(b.x)], 1u);
            asm volatile("s_waitcnt vmcnt(0)" ::: "memory");
        } else {
            XB_SPIN(xb_ld(&bar[XB_XGEN(b.x)]) == gen, bar);
            __builtin_amdgcn_fence(__ATOMIC_ACQUIRE, "agent");
            asm volatile("s_waitcnt vmcnt(0)" ::: "memory");
        }
    }
    __syncthreads();
}

__device__ __forceinline__ float dpp_add(float v, const int ctrl_sel) {
    int t;
    if (ctrl_sel == 0) t = __builtin_amdgcn_update_dpp(0, __float_as_int(v), 0xB1, 0xF, 0xF, true);
    else if (ctrl_sel == 1) t = __builtin_amdgcn_update_dpp(0, __float_as_int(v), 0x4E, 0xF, 0xF, true);
    else if (ctrl_sel == 2) t = __builtin_amdgcn_update_dpp(0, __float_as_int(v), 0x141, 0xF, 0xF, true);
    else t = __builtin_amdgcn_update_dpp(0, __float_as_int(v), 0x140, 0xF, 0xF, true);
    return v + __int_as_float(t);
}
__device__ __forceinline__ float wave_sum_fast(float v) {
    v = dpp_add(v, 0); v = dpp_add(v, 1); v = dpp_add(v, 2); v = dpp_add(v, 3);
    { auto rr = __builtin_amdgcn_permlane16_swap(__float_as_uint(v), __float_as_uint(v), false, false); v = __uint_as_float(rr[0]) + __uint_as_float(rr[1]); }
    { auto rr = __builtin_amdgcn_permlane32_swap(__float_as_uint(v), __float_as_uint(v), false, false); v = __uint_as_float(rr[0]) + __uint_as_float(rr[1]); }
    return v;
}

struct Args { const float* in[19]; float* out; unsigned char* ws; float inv_freq[8]; };
enum { I_X = 0, I_META, I_G1, I_WIN, I_QG, I_KG, I_LQ1, I_LK1, I_LQ2, I_LK2, I_SUBLN, I_CW, I_CB, I_CLG, I_CLB, I_WOUT, I_G2, I_WUP, I_WDN };

__device__ __forceinline__ void p0_transpose_item(const float* W, int K, int N, bf16* WT, int out_row0, int n0, int k0, const float* kscale, LAS float* scr, int lane) {
    float tv[32], ts[32];
#pragma unroll
    for (int i = 0; i < 32; ++i) { const int kk = 2 * i + (lane >> 5); tv[i] = W[(size_t)(k0 + kk) * N + n0 + (lane & 31)]; ts[i] = kscale ? kscale[k0 + kk] : 1.0f; }
#pragma unroll
    for (int i = 0; i < 32; ++i) { const int kk = 2 * i + (lane >> 5); scr[kk * 33 + (lane & 31)] = tv[i] * ts[i]; }
    LDS_WAIT(); asm volatile("" ::: "memory");
    const int c = lane & 7;
#pragma unroll
    for (int j = 0; j < 4; ++j) { const int n = (lane >> 3) + 8 * j; const LAS float* s = scr + (8 * c) * 33 + n;
        v4u o; o.x = pk2(s[0 * 33], s[1 * 33]); o.y = pk2(s[2 * 33], s[3 * 33]); o.z = pk2(s[4 * 33], s[5 * 33]); o.w = pk2(s[6 * 33], s[7 * 33]);
        *(v4u*)(WT + (size_t)(out_row0 + n) * K + k0 + 8 * c) = o; }
    LDS_WAIT(); asm volatile("" ::: "memory");
}
__device__ __forceinline__ int wup_pcol(int lc) { const int l = lc & 255; return (lc & ~255) + 128 * ((l >> 5) & 1) + 32 * (l >> 6); }
__device__ __forceinline__ int win_pcol(int lc) {
    if (lc < 1024) { const int l = lc & 255; return (lc & ~255) + 128 * ((l >> 5) & 1) + 32 * (l >> 6) + (l & 31); }
    if (lc < 1536) return lc;
    if (lc < 2048) { const int ch = lc - 1536; return 1536 + 256 * (ch >> 7) + (ch & 127); }
    const int ch = lc - 2048; return 1536 + 256 * (ch >> 7) + 128 + (ch & 127);
}

__device__ __forceinline__ void p0_prologue(const Args& A, unsigned char* ws, LAS unsigned char* lds, int vcu, int G, int wave, int lane) {
    LAS float* scr = (LAS float*)(lds + wave * 16384);
    const int gw = vcu * NWAVES + wave, NGW = G * NWAVES;
    bf16* Win_t = (bf16*)(ws + WS_WIN); bf16* Wout_t = (bf16*)(ws + WS_WOUT); bf16* Wup_t = (bf16*)(ws + WS_WUP); bf16* Wdn_t = (bf16*)(ws + WS_WDN);
    constexpr int I_IN = (DM / 64) * (DIN / 32);
    for (int it = gw; it < I_IN; it += NGW) { const int nblk = DIN / 32, kb = it / nblk, nb = it % nblk; p0_transpose_item(A.in[I_WIN], DM, DIN, Win_t, win_pcol(32 * nb), 32 * nb, 64 * kb, nullptr, scr, lane); }
    {
        bf16* XN = (bf16*)(ws + WS_XN);
        f32x4 g[4];
#pragma unroll
        for (int j = 0; j < 4; ++j) g[j] = ((const f32x4*)A.in[I_G1])[lane + 64 * j];
        for (int m0 = gw; m0 < MX + NMETA; m0 += 4 * NGW) {
            f32x4 v[4][4];
#pragma unroll
            for (int q = 0; q < 4; ++q) { const int m = m0 + q * NGW; const bool ok = m < MX + NMETA;
                const float* src = !ok ? A.in[I_X] : (m < MX) ? A.in[I_X] + (size_t)m * DM : A.in[I_META] + (size_t)(m - MX) * DM;
                const f32x4* xr = (const f32x4*)src + lane;
#pragma unroll
                for (int j = 0; j < 4; ++j) v[q][j] = __builtin_nontemporal_load(xr + 64 * j); }
#pragma unroll
            for (int q = 0; q < 4; ++q) { const int m = m0 + q * NGW; if (m >= MX + NMETA) continue;
                float s = 0.f;
#pragma unroll
                for (int j = 0; j < 4; ++j) s += (v[q][j].x * v[q][j].x + v[q][j].y * v[q][j].y) + (v[q][j].z * v[q][j].z + v[q][j].w * v[q][j].w);
                const float ms = wave_sum_fast(s) * (1.f / DM) + EPS; const float rs = __builtin_amdgcn_rsqf(ms);
                if (lane == 0 && m < MX) ((float*)(ws + WS_RN))[m] = ms * rs;
                unsigned long long* o8 = (unsigned long long*)(XN + (size_t)m * DM) + lane;
#pragma unroll
                for (int j = 0; j < 4; ++j) { const f32x4 y = v[q][j] * rs * g[j]; o8[64 * j] = (unsigned long long)pk2(y.x, y.y) | ((unsigned long long)pk2(y.z, y.w) << 32); } }
        }
    }
    {
        float* rope = (float*)(ws + WS_ROPE);
        const int pos = gw * 64 + lane;
        if (pos < SEQ + NMETA) {
#pragma unroll
            for (int i = 0; i < 8; ++i) {
                const float angf = (float)pos * A.inv_freq[i];
                const double rev = (double)angf * 0.15915494309189533577; const double fr = rev - __builtin_rint(rev);
                const float f = (float)fr;
                rope[pos * 16 + i] = __builtin_amdgcn_cosf(f); rope[pos * 16 + 8 + i] = __builtin_amdgcn_sinf(f); } }
    }
    {
        bf16* KB = (bf16*)(ws + WS_K); bf16* VB = (bf16*)(ws + WS_V); bf16* GB = (bf16*)(ws + WS_G);
        for (int it = gw; it < NB * 48 * 3; it += NGW) { const int which = it / (NB * 48), r = it % (NB * 48), b = r / 48, rr = r % 48;
            bf16* p = which == 0 ? KB + (size_t)(b * SPAD + 16 + rr) * 512 : which == 1 ? VB + (size_t)(b * SPAD + 16 + rr) * 512 : GB + (size_t)(b * SPAD + rr) * 512;
            ((v4u*)p)[lane] = (v4u){0u, 0u, 0u, 0u}; }
    }
}

__device__ __forceinline__ void meta_proj(const Args& A, unsigned char* ws, LAS unsigned char* lds, int vcu, int wave, int lane) {
    typedef short bf16x8 __attribute__((ext_vector_type(8)));
    const int fr = lane & 15, fq = lane >> 4;
    const int item = vcu * 2 + (wave >> 2), kc = wave & 3;
    const int kind = item < 8 ? 0 : item < 16 ? 1 : 2, g = kind == 2 ? item - 16 : (item & 7);
    const bf16* XNm = (const bf16*)(ws + WS_XN) + (size_t)(MX + fr) * DM + 8 * fq + 256 * kc;
    const bf16* Wt = (const bf16*)(ws + WS_WIN);
    const bf16* brow[4];
#pragma unroll
    for (int nb = 0; nb < 4; ++nb) { const int lc = kind == 0 ? 512 + 64 * g + 16 * nb + fr : kind == 1 ? 1024 + 64 * g + 16 * nb + fr : (nb < 2 ? 1536 + 32 * g + 16 * nb + fr : 2048 + 32 * g + 16 * (nb - 2) + fr);
        brow[nb] = Wt + (size_t)(win_pcol(lc & ~31) + (lc & 31)) * DM + 8 * fq + 256 * kc; }
    bf16x8 af[8], bf[8][4];
#pragma unroll
    for (int ks = 0; ks < 8; ++ks) { af[ks] = *(const bf16x8*)(XNm + 32 * ks);
#pragma unroll
        for (int nb = 0; nb < 4; ++nb) bf[ks][nb] = *(const bf16x8*)(brow[nb] + 32 * ks); }
    asm volatile("" ::: "memory");
    f32x4 acc[4];
#pragma unroll
    for (int nb = 0; nb < 4; ++nb) acc[nb] = (f32x4){0.f, 0.f, 0.f, 0.f};
#pragma unroll
    for (int ks = 0; ks < 8; ++ks)
#pragma unroll
        for (int nb = 0; nb < 4; ++nb) acc[nb] = __builtin_amdgcn_mfma_f32_16x16x32_bf16(bf[ks][nb], af[ks], acc[nb], 0, 0, 0);
    LAS f32x4* red = (LAS f32x4*)lds;
#pragma unroll
    for (int nb = 0; nb < 4; ++nb) red[(wave * 4 + nb) * 64 + lane] = acc[nb];
    __syncthreads();
    if (kc == 0) {
#pragma unroll
        for (int nb = 0; nb < 4; ++nb) acc[nb] = (red[((wave + 0) * 4 + nb) * 64 + lane] + red[((wave + 1) * 4 + nb) * 64 + lane]) + (red[((wave + 2) * 4 + nb) * 64 + lane] + red[((wave + 3) * 4 + nb) * 64 + lane]);
        if (kind == 0) {
            float ss = 0.f;
#pragma unroll
            for (int nb = 0; nb < 4; ++nb) ss += (acc[nb][0] * acc[nb][0] + acc[nb][1] * acc[nb][1]) + (acc[nb][2] * acc[nb][2] + acc[nb][3] * acc[nb][3]);
            ss += __shfl_xor(ss, 16); ss += __shfl_xor(ss, 32);
            const float rs = __builtin_amdgcn_rsqf(ss * (1.0f / 64.0f) + EPS);
#pragma unroll
            for (int nb = 0; nb < 4; ++nb) acc[nb] = acc[nb] * rs * *(const f32x4*)(A.in[I_KG] + 16 * nb + 4 * fq);
            f32x4 p; p[0] = __shfl_xor(acc[0][0], 32); p[1] = __shfl_xor(acc[0][1], 32); p[2] = __shfl_xor(acc[0][2], 32); p[3] = __shfl_xor(acc[0][3], 32);
            const float* rp = (const float*)(ws + WS_ROPE) + fr * 16 + 4 * (fq & 1);
            const f32x4 c = *(const f32x4*)rp, s = *(const f32x4*)(rp + 8);
            const float sg = (fq & 2) ? 1.f : -1.f;
            acc[0] = acc[0] * c + (p * s) * sg;
        }
        if (kind == 2) {
#pragma unroll
            for (int nb = 0; nb < 2; ++nb)
#pragma unroll
                for (int e = 0; e < 4; ++e) acc[nb][e] = acc[nb][e] * __builtin_amdgcn_rcpf(1.0f + __builtin_amdgcn_exp2f(-1.4426950408889634f * acc[nb + 2][e]));
        }
        bf16* dst = kind == 0 ? (bf16*)(ws + WS_K) : kind == 1 ? (bf16*)(ws + WS_V) : (bf16*)(ws + WS_G);
        const int r0 = kind == 2 ? 48 + fr : fr, c0 = (kind == 2 ? 32 * g : 64 * g) + 4 * fq, nnb = kind == 2 ? 2 : 4;
#pragma unroll 1
        for (int b = 0; b < NB; ++b) { bf16* o = dst + (size_t)(b * SPAD + r0) * 512 + c0;
#pragma unroll
            for (int nb = 0; nb < 4; ++nb) if (nb < nnb) *(unsigned long long*)(o + 16 * nb) = (unsigned long long)pk2(acc[nb][0], acc[nb][1]) | ((unsigned long long)pk2(acc[nb][2], acc[nb][3]) << 32); }
    }
    __syncthreads();
}

__device__ __forceinline__ void wconv_phase(const Args& A, unsigned char* ws, LAS unsigned char* lds, int wave, int lane) {
    LAS float* scr = (LAS float*)(lds + wave * 16384);
    bf16* Wout_t = (bf16*)(ws + WS_WOUT); bf16* Wup_t = (bf16*)(ws + WS_WUP); bf16* Wdn_t = (bf16*)(ws + WS_WDN);
    constexpr int I_OUT = (DM / 64) * (DM / 32), I_UP = (DM / 64) * (DFF / 32), I_DN = (DFF / 64) * (DM / 32), NIT = I_OUT + I_UP + I_DN;
    unsigned* wq = (unsigned*)(ws + WS_CTL) + 96;
    volatile LAS unsigned* TK = (volatile LAS unsigned*)(lds + LDS_BYTES - 256 + 64);
    for (;;) {
        if (wave == 0 && lane == 0) TK[0] = __hip_atomic_fetch_add(wq, 1u, __ATOMIC_RELAXED, __HIP_MEMORY_SCOPE_AGENT);
        __syncthreads();
        const int t = (int)TK[0];
        __syncthreads();
        if (t * NWAVES >= NIT) break;
        int r = t * NWAVES + wave;
        if (r >= NIT) continue;
        if (r < I_OUT) { const int nblk = DM / 32, kb = r / nblk, nb = r % nblk; p0_transpose_item(A.in[I_WOUT], DM, DM, Wout_t, 32 * nb, 32 * nb, 64 * kb, nullptr, scr, lane); continue; } r -= I_OUT;
        if (r < I_UP) { const int nblk = DFF / 32, kb = r / nblk, nb = r % nblk; p0_transpose_item(A.in[I_WUP], DM, DFF, Wup_t, wup_pcol(32 * nb), 32 * nb, 64 * kb, A.in[I_G2], scr, lane); continue; } r -= I_UP;
        { const int nblk = DM / 32, kb = r / nblk, nb = r % nblk; p0_transpose_item(A.in[I_WDN], DFF, DM, Wdn_t, 32 * nb, 32 * nb, 64 * kb, nullptr, scr, lane); }
    }
}

constexpr int CONV_R = 32;
__device__ __forceinline__ void conv_phase(const Args& A, unsigned char* ws, LAS unsigned char* lds, int vcu, int G, int wave, int lane) {
    LAS float* cbuf = (LAS float*)lds;
    const bf16* GB = (const bf16*)(ws + WS_G); bf16* MIX = (bf16*)(ws + WS_MIX);
    const int cp = (wave & 3) * 64 + lane, half = wave >> 2;
    f32x2 w[CONVW];
#pragma unroll
    for (int j = 0; j < CONVW; ++j) w[j] = *(const f32x2*)(A.in[I_CW] + j * DCONV + 2 * cp);
    const f32x2 bias = *(const f32x2*)(A.in[I_CB] + 2 * cp);
    const f32x4 lg0 = *(const f32x4*)(A.in[I_CLG] + lane * 8), lg1 = *(const f32x4*)(A.in[I_CLG] + lane * 8 + 4), lb0 = *(const f32x4*)(A.in[I_CLB] + lane * 8), lb1 = *(const f32x4*)(A.in[I_CLB] + lane * 8 + 4);
    constexpr int NITEMS = MX / (2 * CONV_R);
    unsigned* cq = (unsigned*)(ws + WS_CTL) + 32;
    volatile LAS unsigned* TK = (volatile LAS unsigned*)(lds + LDS_BYTES - 256 + 64);
    if (wave == 0 && lane == 0) { TK[0] = __hip_atomic_fetch_add(cq, 1u, __ATOMIC_RELAXED, __HIP_MEMORY_SCOPE_AGENT); TK[1] = __hip_atomic_fetch_add(cq, 1u, __ATOMIC_RELAXED, __HIP_MEMORY_SCOPE_AGENT); }
    __syncthreads();
    int it = (int)TK[0], nxt = (int)TK[1];
    __syncthreads();
#define CONV_SRC(item, sub) (GB + (size_t)(((((item) * 2 * CONV_R + half * CONV_R + (sub) * 16) >> 13) * SPAD) + 34 + (((item) * 2 * CONV_R + half * CONV_R + (sub) * 16) & 8191)) * 512 + 2 * cp)
#define CONV_LOAD(buf, item, sub) do { const bf16* gs_ = CONV_SRC(item, sub); _Pragma("unroll") for (int i = 0; i < 46; ++i) buf[i] = *(const unsigned*)(gs_ + (size_t)i * 512); } while (0)
#define CONV_FMA(buf, sub) do { f32x2 acc[16]; _Pragma("unroll") for (int o = 0; o < 16; ++o) acc[o] = bias; \
        _Pragma("unroll") for (int i = 0; i < 46; ++i) { const f32x2 x = {bf_lo(buf[i]), bf_hi(buf[i])}; _Pragma("unroll") for (int o = 0; o < 16; ++o) { const int j = i - o; if (j >= 0 && j < CONVW) acc[o] += w[j] * x; } } \
        _Pragma("unroll") for (int o = 0; o < 16; ++o) *(LAS f32x2*)(cbuf + (half * CONV_R + (sub) * 16 + o) * DCONV + 2 * cp) = acc[o]; } while (0)
    unsigned bufA[46], bufB[46];
    if (it < NITEMS) CONV_LOAD(bufA, it, 0);
#pragma unroll 1
    while (it < NITEMS) {
        if (wave == 0 && lane == 0) TK[0] = __hip_atomic_fetch_add(cq, 1u, __ATOMIC_RELAXED, __HIP_MEMORY_SCOPE_AGENT);
        CONV_LOAD(bufB, it, 1);
        CONV_FMA(bufA, 0);
        if (nxt < NITEMS) CONV_LOAD(bufA, nxt, 0);
        CONV_FMA(bufB, 1);
        __syncthreads();
        const int nn = (int)TK[0];
#pragma unroll
        for (int rr = 0; rr < 8; ++rr) { const int lr = wave * 8 + rr;
            f32x4 x0 = *(const LAS f32x4*)(cbuf + lr * DCONV + lane * 8), x1 = *(const LAS f32x4*)(cbuf + lr * DCONV + lane * 8 + 4);
            const float mu = wave_sum_fast((x0[0] + x0[1]) + (x0[2] + x0[3]) + (x1[0] + x1[1]) + (x1[2] + x1[3])) * (1.f / DCONV);
            x0 = x0 - mu; x1 = x1 - mu;
            const float var = wave_sum_fast((x0[0] * x0[0] + x0[1] * x0[1]) + (x0[2] * x0[2] + x0[3] * x0[3]) + (x1[0] * x1[0] + x1[1] * x1[1]) + (x1[2] * x1[2] + x1[3] * x1[3])) * (1.f / DCONV);
            const float rs = __builtin_amdgcn_rsqf(var + EPS);
            x0 = x0 * rs * lg0 + lb0; x1 = x1 * rs * lg1 + lb1;
#pragma unroll
            for (int e = 0; e < 4; ++e) { x0[e] = x0[e] * __builtin_amdgcn_rcpf(1.0f + __builtin_amdgcn_exp2f(-1.4426950408889634f * x0[e])); x1[e] = x1[e] * __builtin_amdgcn_rcpf(1.0f + __builtin_amdgcn_exp2f(-1.4426950408889634f * x1[e])); }
            *(v4u*)(MIX + (size_t)(it * 2 * CONV_R + lr) * DM + 512 + lane * 8) = pg8::pack8(x0, x1); }
        __syncthreads();
        it = nxt; nxt = nn;
    }
#undef CONV_SRC
#undef CONV_LOAD
#undef CONV_FMA
}

__device__ __forceinline__ void combine_phase(const Args& A, unsigned char* ws, int vcu, int G, int wave, int lane) {
    const bf16* OB = (const bf16*)(ws + WS_O); bf16* MIX = (bf16*)(ws + WS_MIX);
    const float d1 = wave_sum(A.in[I_LQ1][lane] * A.in[I_LK1][lane]), d2 = wave_sum(A.in[I_LQ2][lane] * A.in[I_LK2][lane]);
    const float lam_init = 0.2f;
    const float lam = __builtin_amdgcn_exp2f(d1 * 1.4426950408889634f) - __builtin_amdgcn_exp2f(d2 * 1.4426950408889634f) + lam_init;
    const int h = lane >> 4, q = lane & 15;
    const f32x4 sg0 = *(const f32x4*)(A.in[I_SUBLN] + 8 * q), sg1 = *(const f32x4*)(A.in[I_SUBLN] + 8 * q + 4);
    const int gw = vcu * NWAVES + wave, NGW = G * NWAVES;
    for (int row = gw; row < MX; row += NGW) {
        const bf16* o1 = OB + (size_t)row * 1024 + h * 256 + 8 * q;
        const v4u a = *(const v4u*)o1, bq = *(const v4u*)(o1 + 128);
        f32x4 d0, d1v;
        d0[0] = bf_lo(a.x) - lam * bf_lo(bq.x); d0[1] = bf_hi(a.x) - lam * bf_hi(bq.x); d0[2] = bf_lo(a.y) - lam * bf_lo(bq.y); d0[3] = bf_hi(a.y) - lam * bf_hi(bq.y);
        d1v[0] = bf_lo(a.z) - lam * bf_lo(bq.z); d1v[1] = bf_hi(a.z) - lam * bf_hi(bq.z); d1v[2] = bf_lo(a.w) - lam * bf_lo(bq.w); d1v[3] = bf_hi(a.w) - lam * bf_hi(bq.w);
        float ss = (d0[0] * d0[0] + d0[1] * d0[1]) + (d0[2] * d0[2] + d0[3] * d0[3]) + (d1v[0] * d1v[0] + d1v[1] * d1v[1]) + (d1v[2] * d1v[2] + d1v[3] * d1v[3]);
        ss += __shfl_xor(ss, 1); ss += __shfl_xor(ss, 2); ss += __shfl_xor(ss, 4); ss += __shfl_xor(ss, 8);
        const float rs = __builtin_amdgcn_rsqf(ss * (1.f / 128.f) + EPS) * (1.0f - lam_init);
        *(v4u*)(MIX + (size_t)row * DM + h * 128 + 8 * q) = pg8::pack8(d0 * rs * sg0, d1v * rs * sg1);
    }
}

__global__ void __launch_bounds__(NWAVES * 64, 2) hymba_fwd(Args args) {
    extern __shared__ __attribute__((aligned(16))) unsigned char lds[];
    cg::grid_group grid = cg::this_grid();
    LAS unsigned char* ldsl = (LAS unsigned char*)lds;
    volatile LAS unsigned* MISC = (volatile LAS unsigned*)(ldsl + LDS_BYTES - 256);
    if (threadIdx.x < 32) MISC[threadIdx.x] = 0u;
    __syncthreads();
    const XcdBarrier bar = xcd_barrier_post((unsigned*)(args.ws + WS_CTL) + 4096, MISC + 8);
    const int G = gridDim.x; const int bx = blockIdx.x; const int vcu = (G % 8 == 0) ? (bx % 8) * (G / 8) + bx / 8 : bx;
#ifndef PROBE_DUP
#define PROBE_DUP 0
#endif
#define REP(mask) for (int rep_ = 0; rep_ < (((PROBE_DUP) & (mask)) ? 2 : 1); ++rep_)
#define PHASE_VARS() unsigned char* ws = args.ws; int tid_ = threadIdx.x; asm volatile("" : "+v"(tid_)); const int lane = tid_ & 63, wave = __builtin_amdgcn_readfirstlane(tid_ >> 6); (void)lane; (void)wave

    REP(1) { PHASE_VARS(); p0_prologue(args, ws, ldsl, vcu, G, wave, lane); }
    if (args.ws == nullptr) grid.sync();
    xcd_barrier(bar);

    REP(2) {
        PHASE_VARS();
        pg8::Gemm g{(bf16*)(ws + WS_XN), (bf16*)(ws + WS_WIN), MX, DIN, DM}; pg8::StaticOrder S; S.init(MX, DIN, G, bx, WGM_P1);
        pg8::EpiInProj E{(bf16*)(ws + WS_Q), (bf16*)(ws + WS_K), (bf16*)(ws + WS_V), (bf16*)(ws + WS_G), args.in[I_QG], args.in[I_KG], (const float*)(ws + WS_ROPE)};
        pg8::gemm_phase<pg8::EpiInProj, pg8::StaticOrder, PG8_ALIGN, PG8_SP2>(ldsl, g, S, E);
    }
    {
        PHASE_VARS();
        unsigned* mq = (unsigned*)(ws + WS_CTL) + 160;
        volatile LAS unsigned* TK = (volatile LAS unsigned*)(ldsl + LDS_BYTES - 256 + 64);
        for (;;) {
            if (tid_ == 0) TK[0] = __hip_atomic_fetch_add(mq, 1u, __ATOMIC_RELAXED, __HIP_MEMORY_SCOPE_AGENT);
            __syncthreads();
            const int t = (int)TK[0];
            __syncthreads();
            if (t >= 16) break;
            meta_proj(args, ws, ldsl, t, wave, lane);
        }
    }
    xcd_barrier(bar);

    REP(8) {
        PHASE_VARS();
        static_assert(attn_body::V2_LDS_BYTES <= LDS_BYTES - 256, "attention LDS");
        const float dq1 = wave_sum(args.in[I_LQ1][lane] * args.in[I_LK1][lane]), dq2 = wave_sum(args.in[I_LQ2][lane] * args.in[I_LK2][lane]);
        const float lam_init = 0.2f;
        const float lam = __builtin_amdgcn_exp2f(dq1 * 1.4426950408889634f) - __builtin_amdgcn_exp2f(dq2 * 1.4426950408889634f) + lam_init;
        for (int vv = vcu; vv < 256; vv += G) {
            const int bh = vv >> 4, s = vv & 15;
            const int b = bh >> 2, head = bh & 3;
            const attn_body::bf16* Kh = (const attn_body::bf16*)(ws + WS_K) + (size_t)(b * SPAD) * 512 + head * 128;
            const attn_body::bf16* Vh = (const attn_body::bf16*)(ws + WS_V) + (size_t)(b * SPAD) * 512 + head * 128;
            for (int i = 0; i < 2; ++i) {
                const int qb = i ? 31 - s : s;
                const int q0 = qb * 256;
                const attn_body::bf16* Qu = (const attn_body::bf16*)(ws + WS_Q) + (size_t)(b * SEQ + q0) * 512 + head * 128;
                attn_body::bf16* Mu = (attn_body::bf16*)(ws + WS_MIX) + (size_t)(b * SEQ + q0) * 1024 + head * 128;
                attn_body::attn_unit128<0>(q0, Qu, Kh, Vh, Mu, (char*)lds, lam, 1.0f - lam_init, args.in[I_SUBLN]);
                attn_body::attn_unit128<1>(q0, Qu + 64, Kh + 64, Vh, Mu, (char*)lds, lam, 1.0f - lam_init, args.in[I_SUBLN]);
            }
        }
    }
    REP(4) { PHASE_VARS(); conv_phase(args, ws, ldsl, vcu, G, wave, lane); }
    { PHASE_VARS(); wconv_phase(args, ws, ldsl, wave, lane); }
    xcd_barrier(bar);

    REP(32) {
        PHASE_VARS();
        pg8::Gemm g{(bf16*)(ws + WS_MIX), (bf16*)(ws + WS_WOUT), MX, DM, DM}; pg8::StaticOrder S; S.init(MX, DM, G, bx, WGM_P35);
        pg8::EpiOut E{(const bf16*)(ws + WS_XN), (const float*)(ws + WS_RN), args.in[I_G1], (bf16*)(ws + WS_H1B), (float*)(ws + WS_SSQ)};
        pg8::gemm_phase<pg8::EpiOut, pg8::StaticOrder, PG8_ALIGN, PG8_SP2>(ldsl, g, S, E);
    }
    xcd_barrier(bar);

    REP(64) {
        PHASE_VARS();
        pg8::Gemm g{(bf16*)(ws + WS_H1B), (bf16*)(ws + WS_WUP), MX, DFF, DM}; pg8::StaticOrder S; S.init(MX, DFF, G, bx, WGM_P4);
        pg8::EpiUp E{(bf16*)(ws + WS_HB), (const float*)(ws + WS_SSQ)};
        pg8::gemm_phase<pg8::EpiUp, pg8::StaticOrder, PG8_ALIGN, PG8_SP2>(ldsl, g, S, E);
    }
    xcd_barrier(bar);

    {
        PHASE_VARS();
        pg8::Gemm g{(bf16*)(ws + WS_HB), (bf16*)(ws + WS_WDN), MX, DM, DFF}; pg8::StaticOrder S; S.init(MX, DM, G, bx, WGM_P35);
        pg8::EpiDown E{(const bf16*)(ws + WS_H1B), args.out};
        pg8::gemm_phase<pg8::EpiDown, pg8::StaticOrder, PG8_ALIGN, PG8_SP2>(ldsl, g, S, E);
    }
#undef PHASE_VARS
#undef REP
}

extern "C" void kernel_launch(void* const* d_in, const int* in_sizes, int n_in, void* d_out, int out_size, void* d_ws, size_t ws_size, hipStream_t stream) {
    static int grid = 0;
    if (grid == 0) {
        if (n_in != 19 || in_sizes[0] != MX * DM || out_size != MX * DM || ws_size < WS_END) { fprintf(stderr, "kernel_launch: unexpected shapes: n_in %d, in0 %d, out %d, ws %zu (need %zu); nothing launched\n", n_in, n_in > 0 ? in_sizes[0] : -1, out_size, ws_size, (size_t)WS_END); grid = -1; return; }
        int dev = 0, cus = 0, per_cu = 0;
        if (hipGetDevice(&dev) != hipSuccess || hipDeviceGetAttribute(&cus, hipDeviceAttributeMultiprocessorCount, dev) != hipSuccess) { fprintf(stderr, "kernel_launch: device query failed\n"); grid = -1; return; }
        if (hipFuncSetAttribute((const void*)hymba_fwd, hipFuncAttributeMaxDynamicSharedMemorySize, LDS_BYTES) != hipSuccess) { fprintf(stderr, "kernel_launch: hipFuncSetAttribute failed\n"); grid = -1; return; }
        if (hipOccupancyMaxActiveBlocksPerMultiprocessor(&per_cu, (const void*)hymba_fwd, NWAVES * 64, LDS_BYTES) != hipSuccess || per_cu < 1) { fprintf(stderr, "kernel_launch: occupancy query says %d\n", per_cu); per_cu = 1; }
        (void)hipGetLastError();
        grid = cus * 1;
        fprintf(stderr, "kernel_launch: grid %d (occupancy query %d per CU)\n", grid, per_cu);
    }
    if (grid < 0) return;
    Args a{};
    for (int i = 0; i < 19; ++i) a.in[i] = (const float*)d_in[i];
    a.out = (float*)d_out; a.ws = (unsigned char*)d_ws;
    for (int i = 0; i < 8; ++i) a.inv_freq[i] = (float)pow(500000.0, -(double)i / 8.0);
    if (hipMemsetAsync((char*)d_ws + WS_CTL, 0, 65536, stream) != hipSuccess) { fprintf(stderr, "kernel_launch: hipMemsetAsync failed\n"); return; }
    void* kargs[] = {&a};
    const hipError_t le = hipLaunchCooperativeKernel((const void*)hymba_fwd, dim3(grid), dim3(NWAVES * 64), kargs, LDS_BYTES, stream);
    if (le != hipSuccess) fprintf(stderr, "kernel_launch: cooperative launch failed: %s (grid %d)\n", hipGetErrorName(le), grid);
}
```

```cpp
#include <hip/hip_cooperative_groups.h>
#include <cmath>
#include <hip/hip_runtime.h>
#include <cstdio>
#include <cstdint>
namespace pg8 {
#define PG8_LAS __attribute__((address_space(3)))
typedef unsigned short bf16_t;
typedef short bf16x8 __attribute__((ext_vector_type(8)));
typedef float f32x4 __attribute__((ext_vector_type(4)));
typedef unsigned u32x4 __attribute__((ext_vector_type(4)));
constexpr int BM = 256, BK = 64, HALF = 128, HTB = HALF * BK * 2  , STAGE_BYTES = 8 * HTB, NXCD = 8, WGM = 8;

__host__ __device__ __forceinline__ int lds_byte(int r, int c) { const int st = (r >> 4) * 2 + (c >> 5), rr = r & 15, cc = c & 31, ob = rr * 64 + cc * 2; return st * 1024 + (ob ^ (((ob >> 9) & 1) << 5)); }
__host__ __device__ __forceinline__ void stage_rc(int b, int& R, int& C) { const int st = b / 1024, sb = b % 1024, swz = sb ^ (((sb >> 9) & 1) << 5); R = (st >> 1) * 16 + swz / 64; C = (st & 1) * 32 + (swz % 64) / 2; }
__host__ __device__ __forceinline__ int perm32(int rho) { const int n = rho >> 4, i = rho & 15; return 8 * (i >> 2) + 4 * n + (i & 3); }

struct Unit { int pm, pn; };
struct Gemm { const bf16_t* A; const bf16_t* Bt; int M, N, K; };

struct StaticOrder {
    int nM, nN, nwg, G, c, wgm;
    __host__ __device__ void init(int M, int N, int G_, int c_, int wgm_ = WGM) { nM = M / BM; nN = N / BM; nwg = nM * nN; G = G_; c = c_; wgm = wgm_; }
    __host__ __device__ bool next(int i, Unit& u) const {
        const long L = (long)i * G + c; if (L >= nwg) return false;
        int wgid = (int)L; { const int q = nwg / NXCD, r = nwg % NXCD, xcd = wgid % NXCD, off = wgid / NXCD; wgid = (xcd < r ? xcd * (q + 1) : r * (q + 1) + (xcd - r) * q) + off; }
        const int nig = wgm * nN, gid = wgid / nig, fm = gid * wgm, gsz = (nM - fm) < wgm ? (nM - fm) : wgm;
        u.pm = fm + ((wgid % nig) % gsz); u.pn = (wgid % nig) / gsz; return true;
    }
    __device__ __forceinline__ void a_ready(const Unit&) const {}
    __device__ __forceinline__ void done(const Unit&) const {}
};

__device__ __forceinline__ unsigned cvt_pk_bf16(float lo, float hi) { unsigned r; asm volatile("v_cvt_pk_bf16_f32 %0, %1, %2" : "=v"(r) : "v"(lo), "v"(hi)); return r; }
typedef float f32x2 __attribute__((ext_vector_type(2)));
__device__ __forceinline__ f32x2 gelu_pk(f32x2 v) {
    const f32x2 av = __builtin_elementwise_abs(v), d = av * 0.2316418882f + 1.0f;
    f32x2 t; t.x = __builtin_amdgcn_rcpf(d.x); t.y = __builtin_amdgcn_rcpf(d.y);
    f32x2 q = t * 0.5307027145f + (-0.7265760135f); q = q * t + 0.7107068705f; q = q * t + (-0.142248368f); q = q * t + 0.127414796f; q = q * t;
    const f32x2 s = (v * v) * (-0.72134752044f);
    f32x2 e; e.x = __builtin_amdgcn_exp2f(s.x); e.y = __builtin_amdgcn_exp2f(s.y);
    const f32x2 m = v * (q * e), r = v - m;
    f32x2 o; o.x = v.x < 0.f ? m.x : r.x; o.y = v.y < 0.f ? m.y : r.y; return o;
}

template <int ACT  > struct EpiBf16 {
    static constexpr bool PERM = true, AFTER_DRAIN = false; static_assert(ACT == 0 || ACT == 1, "EpiBf16: ACT is 0 (none) or 1 (gelu_pk)");
    bf16_t* O; int ldc; const float* bias; int split_cols; size_t split_stride; float scale0;
    __device__ __forceinline__ void operator()(const f32x4 (&acc)[2][2][4][2], const Unit& u, int wr, int wc, int fr, int fq) const {
        const int row0 = u.pm * BM + wr * 64 + fr; int colt = u.pn * BM; bf16_t* base = O;
        float sc = 1.f; if (split_cols) { const int t = colt / split_cols; base += (size_t)t * split_stride; colt -= t * split_cols; if (t == 0) sc = scale0; }
        const int col0 = colt + wc * 32 + 8 * fq, bcol0 = u.pn * BM + wc * 32 + 8 * fq;
        f32x4 bv[2][2];
#pragma unroll
        for (int bj = 0; bj < 2; ++bj)
#pragma unroll
            for (int n = 0; n < 2; ++n) bv[bj][n] = bias ? *(const f32x4*)(bias + bcol0 + bj * HALF + 4 * n) : (f32x4){0.f, 0.f, 0.f, 0.f};
#pragma unroll
        for (int ai = 0; ai < 2; ++ai)
#pragma unroll
            for (int m = 0; m < 4; ++m) { bf16_t* rowp = base + (size_t)(row0 + ai * HALF + m * 16) * ldc + col0;
#pragma unroll
                for (int bj = 0; bj < 2; ++bj) { f32x4 v0 = acc[ai][bj][m][0] + bv[bj][0], v1 = acc[ai][bj][m][1] + bv[bj][1];
                    if (ACT == 1) { f32x2 a = gelu_pk((f32x2){v0[0], v0[1]}), b = gelu_pk((f32x2){v0[2], v0[3]}), c = gelu_pk((f32x2){v1[0], v1[1]}), d = gelu_pk((f32x2){v1[2], v1[3]});
                        v0 = (f32x4){a.x, a.y, b.x, b.y}; v1 = (f32x4){c.x, c.y, d.x, d.y}; }
                    v0 = v0 * sc; v1 = v1 * sc; u32x4 w; w.x = cvt_pk_bf16(v0[0], v0[1]); w.y = cvt_pk_bf16(v0[2], v0[3]); w.z = cvt_pk_bf16(v1[0], v1[1]); w.w = cvt_pk_bf16(v1[2], v1[3]);
                    *(u32x4*)(rowp + bj * HALF) = w; } }
    }
};

constexpr int XROWS = 32768, SPAD = 8256;
constexpr float QSCALE = 0.125f * 1.4426950408889634f;
__device__ __forceinline__ f32x4 shfl_xor4(f32x4 v, int m) { f32x4 r; r[0] = __shfl_xor(v[0], m); r[1] = __shfl_xor(v[1], m); r[2] = __shfl_xor(v[2], m); r[3] = __shfl_xor(v[3], m); return r; }
__device__ __forceinline__ u32x4 pack8(f32x4 a, f32x4 b) { u32x4 w; w.x = cvt_pk_bf16(a[0], a[1]); w.y = cvt_pk_bf16(a[2], a[3]); w.z = cvt_pk_bf16(b[0], b[1]); w.w = cvt_pk_bf16(b[2], b[3]); return w; }
struct EpiInProj {
    static constexpr bool PERM = true, AFTER_DRAIN = false;
    bf16_t *Q, *K, *V, *G; const float *qg, *kg, *rope;
    __device__ __forceinline__ void operator()(const f32x4 (&acc)[2][2][4][2], const Unit& u, int wr, int wc, int fr, int fq) const {
        const int pn = u.pn; constexpr bool meta = false;
        if (meta && (wr != 0 || pn < 2)) return;
        const int rbase = u.pm * BM + wr * 64 + fr;
        if (pn < 4) {
            const bool isq = pn < 2; const float* gp = isq ? qg : kg; const float osc = isq ? QSCALE : 1.f;
            f32x4 gv[2][2];
#pragma unroll
            for (int bj = 0; bj < 2; ++bj)
#pragma unroll
                for (int n = 0; n < 2; ++n) gv[bj][n] = *(const f32x4*)(gp + 32 * bj + 8 * fq + 4 * n);
            const int colb = (pn & 1) * 256 + wc * 64 + 8 * fq;
            bf16_t* dst = isq ? Q : K;
#pragma unroll
            for (int ai = 0; ai < 2; ++ai) {
                if (meta && ai) continue;
#pragma unroll
              for (int mh = 0; mh < 2; ++mh) {
                if (meta && mh) continue;
                f32x4 rv[2][4];
                if (fq < 2) {
#pragma unroll
                    for (int m2 = 0; m2 < 2; ++m2) { const int row = rbase + ai * HALF + (2 * mh + m2) * 16; const int pos = meta ? (row - XROWS) : ((row & 8191) + 16); const f32x4* rp = (const f32x4*)(rope + (size_t)pos * 16);
#pragma unroll
                        for (int k = 0; k < 4; ++k) rv[m2][k] = rp[k]; }
                }
                asm volatile("" ::: "memory");
#pragma unroll
                for (int m = 2 * mh; m < 2 * mh + 2; ++m) {
                    if (meta && m) continue;
                    const int row = rbase + ai * HALF + m * 16;
                    float ss = 0.f;
#pragma unroll
                    for (int bj = 0; bj < 2; ++bj)
#pragma unroll
                        for (int n = 0; n < 2; ++n) { const f32x4 x = acc[ai][bj][m][n]; ss += (x[0] * x[0] + x[1] * x[1]) + (x[2] * x[2] + x[3] * x[3]); }
                    ss += __shfl_xor(ss, 16); ss += __shfl_xor(ss, 32);
                    const float rs = __builtin_amdgcn_rsqf(ss * (1.0f / 64.0f) + 1e-6f);
                    f32x4 y00 = acc[ai][0][m][0] * rs * gv[0][0], y01 = acc[ai][0][m][1] * rs * gv[0][1], y10 = acc[ai][1][m][0] * rs * gv[1][0], y11 = acc[ai][1][m][1] * rs * gv[1][1];
                    const f32x4 p0 = shfl_xor4(y00, 16), p1 = shfl_xor4(y01, 16);
                    if (fq < 2) {
                        const f32x4 c0 = rv[m & 1][0], c1 = rv[m & 1][1], s0 = rv[m & 1][2], s1 = rv[m & 1][3];
                        const float sg = fq ? 1.f : -1.f;
                        y00 = y00 * c0 + (p0 * s0) * sg; y01 = y01 * c1 + (p1 * s1) * sg;
                    }
                    const u32x4 w0 = pack8(y00 * osc, y01 * osc), w1 = pack8(y10 * osc, y11 * osc);
                    if (!meta) {
                        const size_t orow = isq ? (size_t)row : (size_t)((row >> 13) * SPAD + 64 + (row & 8191));
                        *(u32x4*)(dst + orow * 512 + colb) = w0; *(u32x4*)(dst + orow * 512 + colb + 32) = w1;
                    } else {
#pragma unroll 1
                        for (int b = 0; b < 4; ++b) { const size_t orow = (size_t)(b * SPAD + fr); *(u32x4*)(dst + orow * 512 + colb) = w0; *(u32x4*)(dst + orow * 512 + colb + 32) = w1; }
                    }
                }
              }
            }
        } else if (pn < 6) {
            const int colb = (pn - 4) * 256 + wc * 32 + 8 * fq;
#pragma unroll
            for (int ai = 0; ai < 2; ++ai)
#pragma unroll
                for (int m = 0; m < 4; ++m) {
                    if (meta && (ai || m)) continue;
                    const int row = rbase + ai * HALF + m * 16;
                    const u32x4 w0 = pack8(acc[ai][0][m][0], acc[ai][0][m][1]), w1 = pack8(acc[ai][1][m][0], acc[ai][1][m][1]);
                    if (!meta) {
                        const size_t orow = (size_t)((row >> 13) * SPAD + 64 + (row & 8191));
                        *(u32x4*)(V + orow * 512 + colb) = w0; *(u32x4*)(V + orow * 512 + colb + HALF) = w1;
                    } else {
#pragma unroll 1
                        for (int b = 0; b < 4; ++b) { const size_t orow = (size_t)(b * SPAD + fr); *(u32x4*)(V + orow * 512 + colb) = w0; *(u32x4*)(V + orow * 512 + colb + HALF) = w1; }
                    }
                }
        } else {
            const int colb = (pn - 6) * 128 + wc * 32 + 8 * fq;
#pragma unroll
            for (int ai = 0; ai < 2; ++ai)
#pragma unroll
                for (int m = 0; m < 4; ++m) {
                    if (meta && (ai || m)) continue;
                    const int row = rbase + ai * HALF + m * 16;
                    f32x4 h[2];
#pragma unroll
                    for (int n = 0; n < 2; ++n) { const f32x4 a = acc[ai][0][m][n], g = acc[ai][1][m][n];
#pragma unroll
                        for (int e = 0; e < 4; ++e) h[n][e] = a[e] * __builtin_amdgcn_rcpf(1.0f + __builtin_amdgcn_exp2f(-1.4426950408889634f * g[e])); }
                    const u32x4 w0 = pack8(h[0], h[1]);
                    if (!meta) {
                        const size_t orow = (size_t)((row >> 13) * SPAD + 64 + (row & 8191));
                        *(u32x4*)(G + orow * 512 + colb) = w0;
                    } else {
#pragma unroll 1
                        for (int b = 0; b < 4; ++b) { const size_t orow = (size_t)(b * SPAD + 48 + fr); *(u32x4*)(G + orow * 512 + colb) = w0; }
                    }
                }
        }
    }
};
struct EpiOut {
    static constexpr bool PERM = true, AFTER_DRAIN = false;
    const bf16_t* xn; const float* rn; const float* g1; bf16_t* hb; float* ssq;
    __device__ __forceinline__ void operator()(const f32x4 (&acc)[2][2][4][2], const Unit& u, int wr, int wc, int fr, int fq) const {
        const int rbase = u.pm * BM + wr * 64 + fr, colb = u.pn * BM + wc * 64 + 8 * fq;
        const bool odd = (fr & 1) != 0;
        f32x4 ig[2][2];
#pragma unroll
        for (int bj = 0; bj < 2; ++bj)
#pragma unroll
            for (int n = 0; n < 2; ++n) { const f32x4 g = *(const f32x4*)(g1 + colb + bj * 32 + 4 * n);
#pragma unroll
                for (int e = 0; e < 4; ++e) ig[bj][n][e] = __builtin_amdgcn_rcpf(g[e]); }
#pragma unroll
        for (int ai = 0; ai < 2; ++ai) {
            u32x4 xv[4][2]; float rv[4];
#pragma unroll
            for (int m = 0; m < 4; ++m) { const int row = rbase + ai * HALF + m * 16; rv[m] = rn[row];
#pragma unroll
                for (int bj = 0; bj < 2; ++bj) xv[m][bj] = *(const u32x4*)(xn + (size_t)row * 1024 + colb + bj * 32); }
            asm volatile("" ::: "memory");
#pragma unroll
            for (int m = 0; m < 4; ++m) {
                const int row = rbase + ai * HALF + m * 16, row_e = row - (odd ? 1 : 0); float ss = 0.f;
                u32x4 wv[2];
#pragma unroll
                for (int bj = 0; bj < 2; ++bj) { const u32x4 w = xv[m][bj];
                    f32x4 x0, x1;
                    x0[0] = __uint_as_float(w.x << 16); x0[1] = __uint_as_float(w.x & 0xffff0000u); x0[2] = __uint_as_float(w.y << 16); x0[3] = __uint_as_float(w.y & 0xffff0000u);
                    x1[0] = __uint_as_float(w.z << 16); x1[1] = __uint_as_float(w.z & 0xffff0000u); x1[2] = __uint_as_float(w.w << 16); x1[3] = __uint_as_float(w.w & 0xffff0000u);
                    const f32x4 h0 = x0 * rv[m] * ig[bj][0] + acc[ai][bj][m][0], h1 = x1 * rv[m] * ig[bj][1] + acc[ai][bj][m][1];
                    wv[bj] = pack8(h0, h1);
                    ss += (h0[0] * h0[0] + h0[1] * h0[1]) + (h0[2] * h0[2] + h0[3] * h0[3]) + (h1[0] * h1[0] + h1[1] * h1[1]) + (h1[2] * h1[2] + h1[3] * h1[3]); }
                const u32x4 snd = odd ? wv[0] : wv[1]; u32x4 rcv;
                rcv.x = (unsigned)__builtin_amdgcn_update_dpp(0, (int)snd.x, 0xB1, 0xF, 0xF, true); rcv.y = (unsigned)__builtin_amdgcn_update_dpp(0, (int)snd.y, 0xB1, 0xF, 0xF, true);
                rcv.z = (unsigned)__builtin_amdgcn_update_dpp(0, (int)snd.z, 0xB1, 0xF, 0xF, true); rcv.w = (unsigned)__builtin_amdgcn_update_dpp(0, (int)snd.w, 0xB1, 0xF, 0xF, true);
                bf16_t* p = hb + (size_t)row_e * 1024 + colb + (odd ? 32 : 0);
                *(u32x4*)p = odd ? rcv : wv[0];
                *(u32x4*)(p + 1024) = odd ? wv[1] : rcv;
                ss += __shfl_xor(ss, 16); ss += __shfl_xor(ss, 32);
                if (fq == 0) ssq[(size_t)row * 16 + u.pn * 4 + wc] = ss;
            }
        }
    }
};
struct EpiUp {
    static constexpr bool PERM = true, AFTER_DRAIN = false;
    bf16_t* hb; const float* ssq;
    __device__ __forceinline__ void operator()(const f32x4 (&acc)[2][2][4][2], const Unit& u, int wr, int wc, int fr, int fq) const {
        const int rbase = u.pm * BM + wr * 64 + fr, colb = u.pn * BM + wc * 64 + 8 * fq;
        const bool odd = (fr & 1) != 0;
#pragma unroll
        for (int ai = 0; ai < 2; ++ai) {
            f32x4 sv[4][4];
#pragma unroll
            for (int m = 0; m < 4; ++m) { const f32x4* sp = (const f32x4*)(ssq + (size_t)(rbase + ai * HALF + m * 16) * 16);
#pragma unroll
                for (int k = 0; k < 4; ++k) sv[m][k] = sp[k]; }
            asm volatile("" ::: "memory");
#pragma unroll
            for (int m = 0; m < 4; ++m) {
                const int row = rbase + ai * HALF + m * 16, row_e = row - (odd ? 1 : 0);
                const f32x4 s0 = sv[m][0], s1 = sv[m][1], s2 = sv[m][2], s3 = sv[m][3];
                const float tot = ((s0[0] + s0[1]) + (s0[2] + s0[3])) + ((s1[0] + s1[1]) + (s1[2] + s1[3])) + ((s2[0] + s2[1]) + (s2[2] + s2[3])) + ((s3[0] + s3[1]) + (s3[2] + s3[3]));
                const float rs = __builtin_amdgcn_rsqf(tot * (1.0f / 1024.0f) + 1e-6f);
                u32x4 w[2];
#pragma unroll
                for (int bj = 0; bj < 2; ++bj) { f32x4 a0 = acc[ai][bj][m][0] * rs, a1 = acc[ai][bj][m][1] * rs;
#pragma unroll
                    for (int e = 0; e < 4; ++e) { const float p = fmaxf(a0[e], 0.f), q = fmaxf(a1[e], 0.f); a0[e] = p * p; a1[e] = q * q; }
                    w[bj] = pack8(a0, a1); }
                const u32x4 snd = odd ? w[0] : w[1]; u32x4 rcv;
                rcv.x = (unsigned)__builtin_amdgcn_update_dpp(0, (int)snd.x, 0xB1, 0xF, 0xF, true); rcv.y = (unsigned)__builtin_amdgcn_update_dpp(0, (int)snd.y, 0xB1, 0xF, 0xF, true);
                rcv.z = (unsigned)__builtin_amdgcn_update_dpp(0, (int)snd.z, 0xB1, 0xF, 0xF, true); rcv.w = (unsigned)__builtin_amdgcn_update_dpp(0, (int)snd.w, 0xB1, 0xF, 0xF, true);
                bf16_t* p = hb + (size_t)row_e * 4096 + colb + (odd ? 32 : 0);
                __builtin_nontemporal_store(odd ? rcv : w[0], (u32x4*)p);
                __builtin_nontemporal_store(odd ? w[1] : rcv, (u32x4*)(p + 4096));
            }
        }
    }
};
struct EpiDown {
    static constexpr bool PERM = false, AFTER_DRAIN = false;
    const bf16_t* h1; float* out;
    __device__ __forceinline__ void operator()(const f32x4 (&acc)[2][2][4][2], const Unit& u, int wr, int wc, int fr, int fq) const {
        typedef unsigned u32x2 __attribute__((ext_vector_type(2)));
        const int rbase = u.pm * BM + wr * 64 + fr, colb = u.pn * BM + wc * 32 + 4 * fq;
        const bool odd = (fr & 1) != 0;
#pragma unroll
        for (int ai = 0; ai < 2; ++ai) {
            u32x2 hv[4][2][2];
#pragma unroll
            for (int m = 0; m < 4; ++m)
#pragma unroll
                for (int bj = 0; bj < 2; ++bj)
#pragma unroll
                    for (int n = 0; n < 2; ++n) hv[m][bj][n] = *(const u32x2*)(h1 + (size_t)(rbase + ai * HALF + m * 16) * 1024 + colb + bj * HALF + 16 * n);
            asm volatile("" ::: "memory");
#pragma unroll
            for (int m = 0; m < 4; ++m) {
                const int row = rbase + ai * HALF + m * 16, row_e = row - (odd ? 1 : 0);
#pragma unroll
                for (int bj = 0; bj < 2; ++bj) {
                    f32x4 a[2];
#pragma unroll
                    for (int n = 0; n < 2; ++n) { const u32x2 w = hv[m][bj][n];
                        f32x4 r; r[0] = __uint_as_float(w.x << 16); r[1] = __uint_as_float(w.x & 0xffff0000u); r[2] = __uint_as_float(w.y << 16); r[3] = __uint_as_float(w.y & 0xffff0000u);
                        a[n] = r + acc[ai][bj][m][n]; }
                    const f32x4 snd = odd ? a[0] : a[1]; f32x4 rcv;
#pragma unroll
                    for (int e = 0; e < 4; ++e) rcv[e] = __int_as_float(__builtin_amdgcn_update_dpp(0, __float_as_int(snd[e]), 0xB1, 0xF, 0xF, true));
                    const size_t off = (size_t)row_e * 1024 + colb + bj * HALF + (odd ? 16 : 0);
                    __builtin_nontemporal_store(odd ? rcv : a[0], (f32x4*)(out + off));
                    __builtin_nontemporal_store(odd ? a[1] : rcv, (f32x4*)(out + off + 1024)); }
            }
        }
    }
};


template <class Epi, class Sched, bool ALIGN_EPI = false, bool SP2 = false>
__device__ __forceinline__ void gemm_phase(PG8_LAS unsigned char* lds, const Gemm g, const Sched& S, const Epi& E) {
    int tid_ = threadIdx.x; asm volatile("" : "+v"(tid_));
    const int tid = tid_, wid = __builtin_amdgcn_readfirstlane(tid >> 6), lane = tid & 63, wr = wid >> 2, wc = wid & 3, fr = lane & 15, fq = lane >> 4;
    const int K = g.K, nt = K / BK;
    unsigned voffA[2], voffB[2];
#pragma unroll
    for (int i = 0; i < 2; ++i) { int R, C; stage_rc(tid * 16 + i * 8192, R, C); const int Rb = Epi::PERM ? ((R & ~31) + perm32(R & 31)) : R;
        voffA[i] = (unsigned)(R * K + C) * 2u; voffB[i] = (unsigned)(Rb * K + C) * 2u; }
    const size_t kstep = (size_t)(BK * 2);
    const size_t hstep = (size_t)HALF * K * 2;
    const size_t tstep = 2 * hstep;
    const unsigned ldsw = (unsigned)wid * 1024u;
    const int aoff = lds_byte(wr * 64 + fr, fq * 8), boff = lds_byte(wc * 32 + fr, fq * 8);
#define PG8_SA(b, h) (((b) * 2 + (h)) * HTB)
#define PG8_SB(b, h) ((4 + (b) * 2 + (h)) * HTB)
#define PG8_STAGE(bufoff, gbase, voff) do { _Pragma("unroll") for (int _i = 0; _i < 2; ++_i) \
        __builtin_amdgcn_global_load_lds((const unsigned*)((const char*)(gbase) + (voff)[_i]), (PG8_LAS unsigned*)(lds + (bufoff) + ldsw + _i * 8192), 16, 0, 0); } while (0)
#define PG8_LDA(dst, b, h) do { _Pragma("unroll") for (int m = 0; m < 4; ++m) _Pragma("unroll") for (int k = 0; k < 2; ++k) dst[m][k] = *(const PG8_LAS bf16x8*)(lds + PG8_SA(b, h) + aoff + m * 2048 + k * 1024); } while (0)
#define PG8_LDB(dst, b, h) do { _Pragma("unroll") for (int n = 0; n < 2; ++n) _Pragma("unroll") for (int k = 0; k < 2; ++k) dst[n][k] = *(const PG8_LAS bf16x8*)(lds + PG8_SB(b, h) + boff + n * 2048 + k * 1024); } while (0)
#define PG8_MMA(ai, bj, At, Bt) do { __builtin_amdgcn_s_setprio(1); _Pragma("unroll") for (int m = 0; m < 4; ++m) _Pragma("unroll") for (int n = 0; n < 2; ++n) _Pragma("unroll") for (int k = 0; k < 2; ++k) \
        acc[ai][bj][m][n] = __builtin_amdgcn_mfma_f32_16x16x32_bf16(Bt[n][k], At[m][k], acc[ai][bj][m][n], 0, 0, 0); __builtin_amdgcn_s_setprio(0); } while (0)
#define PG8_WAIT_V(n) asm volatile("s_waitcnt vmcnt(" #n ")" ::: "memory")
#define PG8_WAIT_L(n) asm volatile("s_waitcnt lgkmcnt(" #n ")" ::: "memory")
#define PG8_BAR __builtin_amdgcn_s_barrier()
#define PG8_SCHED __builtin_amdgcn_sched_barrier(0)
    Unit cur, nxt; int ui = 0;
    if (!S.next(0, cur)) return;
    f32x4 acc[2][2][4][2];
#pragma unroll
    for (int a = 0; a < 2; ++a)
#pragma unroll
        for (int b = 0; b < 2; ++b)
#pragma unroll
            for (int m = 0; m < 4; ++m)
#pragma unroll
                for (int n = 0; n < 2; ++n) acc[a][b][m][n] = (f32x4){0.f, 0.f, 0.f, 0.f};
    bf16x8 At[4][2], B0[2][2], B1[2][2];
    const char* cA = (const char*)g.A + (size_t)cur.pm * tstep; const char* cB = (const char*)g.Bt + (size_t)cur.pn * tstep;
    S.a_ready(cur);
    if constexpr (SP2) {
        PG8_STAGE(PG8_SB(0, 0), cB, voffB); PG8_STAGE(PG8_SB(0, 1), cB + hstep, voffB); PG8_STAGE(PG8_SA(0, 0), cA, voffA); PG8_STAGE(PG8_SA(0, 1), cA + hstep, voffA);
        if (wr == 1) PG8_BAR;
        PG8_WAIT_V(2); PG8_BAR;
        PG8_STAGE(PG8_SB(1, 0), cB + kstep, voffB); PG8_STAGE(PG8_SA(1, 0), cA + kstep, voffA); PG8_STAGE(PG8_SB(1, 1), cB + hstep + kstep, voffB);
        PG8_WAIT_V(6); PG8_BAR;
    } else {
        PG8_STAGE(PG8_SB(0, 0), cB, voffB); PG8_STAGE(PG8_SA(0, 0), cA, voffA); PG8_STAGE(PG8_SB(0, 1), cB + hstep, voffB); PG8_STAGE(PG8_SA(0, 1), cA + hstep, voffA);
        if (wr == 1) PG8_BAR;
        PG8_WAIT_V(4); PG8_BAR;
        PG8_STAGE(PG8_SB(1, 0), cB + kstep, voffB); PG8_STAGE(PG8_SA(1, 0), cA + kstep, voffA); PG8_STAGE(PG8_SB(1, 1), cB + hstep + kstep, voffB);
        PG8_WAIT_V(6); PG8_BAR;
    }
    for (;;) {
        const bool has_next = S.next(ui + 1, nxt);
        const char* nA = has_next ? (const char*)g.A + (size_t)nxt.pm * tstep : cA; const char* nB = has_next ? (const char*)g.Bt + (size_t)nxt.pn * tstep : cB;
        for (int t = 0; t < nt; t += 2) {
            const bool last = (t == nt - 2);
            const char* a1 = cA + (size_t)(t + 1) * kstep;
            const char* a2 = last ? nA : cA + (size_t)(t + 2) * kstep; const char* b2 = last ? nB : cB + (size_t)(t + 2) * kstep;
            const char* a3 = a2 + kstep; const char* b3 = b2 + kstep;
            if (last && has_next) S.a_ready(nxt);
            if constexpr (SP2) {
            PG8_LDB(B0, 0, 0); PG8_LDB(B1, 0, 1); PG8_SCHED; PG8_LDA(At, 0, 0); PG8_STAGE(PG8_SA(1, 1), a1 + hstep, voffA);
            PG8_WAIT_V(8); PG8_WAIT_L(0); PG8_BAR; PG8_MMA(0, 0, At, B0); PG8_MMA(0, 1, At, B1); PG8_BAR; PG8_SCHED;
            PG8_LDA(At, 0, 1); PG8_STAGE(PG8_SB(0, 0), b2, voffB); PG8_STAGE(PG8_SB(0, 1), b2 + hstep, voffB); PG8_STAGE(PG8_SA(0, 0), a2, voffA);
            PG8_WAIT_V(8); PG8_WAIT_L(0); PG8_BAR; PG8_MMA(1, 0, At, B0); PG8_MMA(1, 1, At, B1); PG8_BAR; PG8_SCHED;
            PG8_LDB(B0, 1, 0); PG8_LDB(B1, 1, 1); PG8_SCHED; PG8_LDA(At, 1, 0); PG8_STAGE(PG8_SA(0, 1), a2 + hstep, voffA);
            PG8_WAIT_V(8); PG8_WAIT_L(0); PG8_BAR; PG8_MMA(0, 0, At, B0); PG8_MMA(0, 1, At, B1); PG8_BAR; PG8_SCHED;
            PG8_LDA(At, 1, 1); PG8_STAGE(PG8_SB(1, 0), b3, voffB); PG8_STAGE(PG8_SB(1, 1), b3 + hstep, voffB); PG8_STAGE(PG8_SA(1, 0), a3, voffA);
            PG8_WAIT_V(8); PG8_WAIT_L(0); PG8_BAR; PG8_MMA(1, 0, At, B0); PG8_MMA(1, 1, At, B1); PG8_BAR; PG8_SCHED;
            } else {
            PG8_LDB(B0, 0, 0); PG8_SCHED; PG8_LDA(At, 0, 0); PG8_STAGE(PG8_SA(1, 1), a1 + hstep, voffA);
            PG8_WAIT_L(8); PG8_BAR; PG8_WAIT_L(0); PG8_MMA(0, 0, At, B0); PG8_BAR; PG8_SCHED;
            PG8_LDB(B1, 0, 1); PG8_STAGE(PG8_SB(0, 0), b2, voffB);
            PG8_BAR; PG8_WAIT_L(0); PG8_MMA(0, 1, At, B1); PG8_BAR;
            PG8_LDA(At, 0, 1); PG8_STAGE(PG8_SA(0, 0), a2, voffA);
            PG8_BAR; PG8_WAIT_L(0); PG8_MMA(1, 0, At, B0); PG8_BAR; PG8_SCHED;
            PG8_STAGE(PG8_SB(0, 1), b2 + hstep, voffB);
            PG8_WAIT_V(6); PG8_BAR; PG8_MMA(1, 1, At, B1); PG8_BAR;
            PG8_LDB(B0, 1, 0); PG8_SCHED; PG8_LDA(At, 1, 0); PG8_STAGE(PG8_SA(0, 1), a2 + hstep, voffA);
            PG8_WAIT_L(8); PG8_BAR; PG8_WAIT_L(0); PG8_MMA(0, 0, At, B0); PG8_BAR; PG8_SCHED;
            PG8_LDB(B1, 1, 1); PG8_STAGE(PG8_SB(1, 0), b3, voffB);
            PG8_BAR; PG8_WAIT_L(0); PG8_MMA(0, 1, At, B1); PG8_BAR;
            PG8_LDA(At, 1, 1); PG8_STAGE(PG8_SA(1, 0), a3, voffA);
            PG8_BAR; PG8_WAIT_L(0); PG8_MMA(1, 0, At, B0); PG8_BAR; PG8_SCHED;
            PG8_STAGE(PG8_SB(1, 1), b3 + hstep, voffB);
            PG8_WAIT_V(6); PG8_BAR; PG8_MMA(1, 1, At, B1); PG8_BAR;
            }
        }
        if constexpr (ALIGN_EPI) { if (wr == 0) PG8_BAR; }
        if constexpr (!Epi::AFTER_DRAIN) { E(acc, cur, wr, wc, fr, fq); S.done(cur); }
        if (!has_next) break;
#pragma unroll
        for (int a = 0; a < 2; ++a)
#pragma unroll
            for (int b = 0; b < 2; ++b)
#pragma unroll
                for (int m = 0; m < 4; ++m)
#pragma unroll
                    for (int n = 0; n < 2; ++n) acc[a][b][m][n] = (f32x4){0.f, 0.f, 0.f, 0.f};
        cur = nxt; cA = nA; cB = nB; ++ui;
        if constexpr (ALIGN_EPI) { if (wr == 1) PG8_BAR; }
    }
    PG8_WAIT_V(0);
    if constexpr (!ALIGN_EPI) { if (wr == 0) PG8_BAR; }
    PG8_BAR;
    if constexpr (Epi::AFTER_DRAIN) { E.fused(acc, cur, wr, wc, fr, fq, lds, wid, lane); S.done(cur); }
#undef PG8_SA
#undef PG8_SB
#undef PG8_STAGE
#undef PG8_LDA
#undef PG8_LDB
#undef PG8_MMA
#undef PG8_WAIT_V
#undef PG8_WAIT_L
#undef PG8_BAR
#undef PG8_SCHED
}
}

#ifndef PG8_SP2
#define PG8_SP2 true
#endif
#ifndef PG8_ALIGN
#define PG8_ALIGN true
#endif
#include <hip/hip_bf16.h>
#include <cmath>
namespace attn_body {
using bf16=__hip_bfloat16;
using bf16x8=__attribute__((ext_vector_type(8)))short;
using s16x4=__attribute__((ext_vector_type(4)))short;
using f32x16=__attribute__((ext_vector_type(16)))float;
using u32x4=__attribute__((ext_vector_type(4)))unsigned;
constexpr int SEQ=8192,D=64,PQ=512,PO=1024;
constexpr int NW=8,QBLK=32,QB=QBLK*NW,KVBLK=64,NQB=SEQ/QB;
constexpr int ATTN_UNIT_ROWS=QB;
__device__ __forceinline__ int crow(int r,int hi){return (r&3)+8*(r>>2)+4*hi;}
#define SBAR() __builtin_amdgcn_sched_barrier(0)
__device__ __forceinline__ void cmask(f32x16&p0,f32x16&p1,int jb,int qrel,int hi){
  const float NEG=-INFINITY; int kb=64*jb+4*hi;
  #pragma unroll
  for(int r=0;r<16;++r){int kv=kb+(r&3)+8*(r>>2); if(kv>qrel)p0[r]=NEG; if(kv+32>qrel)p1[r]=NEG;}
}

constexpr int NSLOT=3, SLOTB=8192;
constexpr int LDS_K=0, LDS_V=NSLOT*SLOTB, LDS_WS=2*NSLOT*SLOTB, LDS_OST=LDS_WS+NW*64*4, LDS_BYTES=LDS_OST+NW*4096;
constexpr float C2=0.125f*1.4426950408889634f;
__device__ __forceinline__ void glds16(const void*gsrc,unsigned lds_dst){unsigned keep;
  asm volatile("s_mov_b32 %0, m0\n\ts_mov_b32 m0, %2\n\ts_nop 0\n\tglobal_load_lds_dwordx4 %1, off\n\ts_mov_b32 m0, %0":"=&s"(keep):"v"(gsrc),"s"(lds_dst):"memory");}
__device__ __forceinline__ float max3f(float a,float b,float c){float r;asm("v_max3_f32 %0, %1, %2, %3":"=v"(r):"v"(a),"v"(b),"v"(c));return r;}
__device__ __forceinline__ float max2f(float a,float b){float r;asm("v_max_f32_e32 %0, %1, %2":"=v"(r):"v"(a),"v"(b));return r;}
__device__ __forceinline__ float fadd_s(float a,float b){float r;asm("v_add_f32_e32 %0, %1, %2":"=v"(r):"v"(a),"v"(b));return r;}
__device__ __forceinline__ float fsub_s(float a,float b){float r;asm("v_sub_f32_e32 %0, %1, %2":"=v"(r):"v"(a),"v"(b));return r;}
typedef float f32x2_t __attribute__((ext_vector_type(2))); typedef __bf16 bf16x2_t __attribute__((ext_vector_type(2)));
__device__ __forceinline__ unsigned cvtpk_s(float lo,float hi){f32x2_t v={lo,hi};bf16x2_t b=__builtin_convertvector(v,bf16x2_t);return __builtin_bit_cast(unsigned,b);}
#define WAIT_BAR(N) asm volatile("s_waitcnt vmcnt(" #N ") lgkmcnt(0)\n\ts_barrier":::"memory")

__device__ __forceinline__ void qkt(f32x16&p0,f32x16&p1,const char*Kslot,const bf16x8*qr,const f32x16&negm,int r32,int hi){
  const char*kb=Kslot+hi*1024+r32*16;
  #pragma unroll
  for(int d0=0;d0<4;++d0){
    const bf16x8 b0=*reinterpret_cast<const bf16x8*>(kb+d0*2048);
    const bf16x8 b1=*reinterpret_cast<const bf16x8*>(kb+d0*2048+512);
    if(d0==0){p0=__builtin_amdgcn_mfma_f32_32x32x16_bf16(b0,qr[0],negm,0,0,0);p1=__builtin_amdgcn_mfma_f32_32x32x16_bf16(b1,qr[0],negm,0,0,0);}
    else{p0=__builtin_amdgcn_mfma_f32_32x32x16_bf16(b0,qr[d0],p0,0,0,0);p1=__builtin_amdgcn_mfma_f32_32x32x16_bf16(b1,qr[d0],p1,0,0,0);}}
}
typedef __attribute__((address_space(3))) const char* lds_cptr;
typedef short v4i16_t __attribute__((ext_vector_type(4)));
__device__ __forceinline__ void kload8(bf16x8*kf,lds_cptr kp){
  kf[0]=*(const __attribute__((address_space(3))) bf16x8*)(kp);      kf[1]=*(const __attribute__((address_space(3))) bf16x8*)(kp+512);
  kf[2]=*(const __attribute__((address_space(3))) bf16x8*)(kp+2048); kf[3]=*(const __attribute__((address_space(3))) bf16x8*)(kp+2560);
  kf[4]=*(const __attribute__((address_space(3))) bf16x8*)(kp+4096); kf[5]=*(const __attribute__((address_space(3))) bf16x8*)(kp+4608);
  kf[6]=*(const __attribute__((address_space(3))) bf16x8*)(kp+6144); kf[7]=*(const __attribute__((address_space(3))) bf16x8*)(kp+6656);
}
__device__ __forceinline__ void kload2(bf16x8*kf,lds_cptr kp,int j){ kf[2*j]=*(const __attribute__((address_space(3))) bf16x8*)(kp+j*2048); kf[2*j+1]=*(const __attribute__((address_space(3))) bf16x8*)(kp+j*2048+512); }
__device__ __forceinline__ s16x4 vtr(lds_cptr p){ return __builtin_bit_cast(s16x4,__builtin_amdgcn_ds_read_tr16_b64_v4i16((__attribute__((address_space(3))) v4i16_t*)p)); }
__device__ __forceinline__ float rowmax(const f32x16&p0,const f32x16&p1){
  float a=max3f(p0[0],p0[1],p1[0]),b=max3f(p0[2],p0[3],p1[1]);a=max3f(a,p1[2],p1[3]);
  #pragma unroll
  for(int r=4;r<16;r+=4){a=max3f(a,p0[r],p0[r+1]);b=max3f(b,p0[r+2],p0[r+3]);a=max3f(a,p1[r],p1[r+1]);b=max3f(b,p1[r+2],p1[r+3]);}
  const float m=max2f(a,b);
  auto rr=__builtin_amdgcn_permlane32_swap(__float_as_uint(m),__float_as_uint(m),false,false);
  return max2f(__uint_as_float(rr[0]),__uint_as_float(rr[1]));
}
__device__ __forceinline__ void pv(f32x16*o,int vb,bf16x8 pa0,bf16x8 pa1,bf16x8 pa2,bf16x8 pa3){
  #pragma unroll
  for(int d0=0;d0<2;++d0){s16x4 lo[4],hi[4];
    #pragma unroll
    for(int ks=0;ks<4;++ks){
      asm volatile("ds_read_b64_tr_b16 %0,%1 offset:%c2":"=&v"(lo[ks]):"v"(vb),"i"(d0*4096+ks*1024):"memory");
      asm volatile("ds_read_b64_tr_b16 %0,%1 offset:%c2":"=&v"(hi[ks]):"v"(vb),"i"(d0*4096+ks*1024+512):"memory");}
    asm volatile("s_waitcnt lgkmcnt(0)":::"memory");SBAR();
    #define PK(k) (bf16x8){lo[k][0],lo[k][1],lo[k][2],lo[k][3],hi[k][0],hi[k][1],hi[k][2],hi[k][3]}
    o[d0]=__builtin_amdgcn_mfma_f32_32x32x16_bf16(pa0,PK(0),o[d0],0,0,0);
    o[d0]=__builtin_amdgcn_mfma_f32_32x32x16_bf16(pa1,PK(1),o[d0],0,0,0);
    o[d0]=__builtin_amdgcn_mfma_f32_32x32x16_bf16(pa2,PK(2),o[d0],0,0,0);
    o[d0]=__builtin_amdgcn_mfma_f32_32x32x16_bf16(pa3,PK(3),o[d0],0,0,0);
    #undef PK
  }
}

#ifndef ATTN_STORE16
#define ATTN_STORE16(p,v) (*(u32x4*)(p)=(v))
#endif
template<int THRL> __device__ __forceinline__ void attn_unit(int q0,const bf16*Qu,const bf16*__restrict__ Kh,const bf16*__restrict__ Vh,bf16*Ou,char*shm){
  int tid_=threadIdx.x; asm volatile("":"+v"(tid_)); const int tid=tid_,lane=tid&63,r32=lane&31,hi=lane>>5; const int wid=__builtin_amdgcn_readfirstlane(tid>>6);
  const bf16*Qw=Qu+(long)(wid*QBLK)*PQ;
  const unsigned lds0=(unsigned)(uintptr_t)shm;
  float*wsf=(float*)(shm+LDS_WS)+wid*64;
  const bf16*ksrc=Kh+(long)lane*PQ+wid*8;
  const bf16*vsrc=Vh+(long)(16*(wid&3)+(lane>>2))*PQ+(wid>>2)*32+(lane&3)*8;
  const unsigned kdst=lds0+LDS_K+wid*1024, vdst=lds0+LDS_V+wid*1024;
  #define DMA_K(t,slot) glds16(ksrc+(long)(t)*KVBLK*PQ,(unsigned)__builtin_amdgcn_readfirstlane(kdst+(slot)))
  #define DMA_V(t,slot) glds16(vsrc+(long)(t)*KVBLK*PQ,(unsigned)__builtin_amdgcn_readfirstlane(vdst+(slot)))
  const int vb0=(int)(lds0+LDS_V)+((lane>>4)&1)*32+(lane&3)*8+(4*hi+((lane&15)>>2))*64;
  const char*Kbase=shm+LDS_K; bf16x8 kf[8];
  const lds_cptr shm3=(lds_cptr)shm; const lds_cptr kp0=shm3+LDS_K+hi*1024+r32*16; const lds_cptr vp0=shm3+LDS_V+((lane>>4)&1)*32+(lane&3)*8+(4*hi+((lane&15)>>2))*64;
  const int NT=(q0+QB)/KVBLK+1;
  DMA_K(0,0);DMA_V(0,0);DMA_K(1,SLOTB);
  bf16x8 qr[4];
  #pragma unroll
  for(int d0=0;d0<4;++d0)qr[d0]=*reinterpret_cast<const bf16x8*>(&Qw[(long)r32*PQ+d0*16+hi*8]);
  float mhat=0.f,l_reg=0.f;f32x16 o[2];o[0]=f32x16{};o[1]=f32x16{};f32x16 negm=f32x16{};asm volatile("":"+v"(negm));
  const int qrel=wid*QBLK+r32;
  #define CMASK(P0,P1,t) do{int jb_=(t)-(NT-4); if(jb_>=0)cmask(P0,P1,jb_,qrel,hi);}while(0)
  bool resc=false;
  #define START(P0,P1) do{ const float rm=rowmax(P0,P1); resc=false; \
    { const float dl=rm; mhat=fadd_s(mhat,dl); \
      _Pragma("unroll") for(int r=0;r<16;++r){P0[r]=fsub_s(P0[r],dl);P1[r]=fsub_s(P1[r],dl);} \
      _Pragma("unroll") for(int r=0;r<16;++r)negm[r]=-mhat; asm volatile("":"+v"(negm)); } \
    _Pragma("unroll") for(int r=0;r<16;++r)P0[r]=__builtin_amdgcn_exp2f(P0[r]); }while(0)
  #define RESC() do{ if(resc){ asm volatile("s_waitcnt lgkmcnt(0)":::"memory"); \
      _Pragma("unroll") for(int d_=0;d_<2;++d_) _Pragma("unroll") for(int r=0;r<16;++r)o[d_][r]*=wsf[crow(r,hi)]; } }while(0)
  f32x16 pA0,pA1,pB0,pB1;
  int sl_prev=0,sl_cur=0,sl_next=SLOTB;
  #define ROT() do{sl_prev=sl_cur;sl_cur=sl_next;sl_next=(sl_next==(NSLOT-1)*SLOTB)?0:sl_next+SLOTB;}while(0)
  DMA_K(2,2*SLOTB);
  WAIT_BAR(3);
  qkt(pA0,pA1,Kbase,qr,negm,r32,hi);asm volatile("s_nop 15\n\ts_nop 7":"+v"(pA0),"+v"(pA1));
  { const float NEGI=-INFINITY; _Pragma("unroll") for(int r=8;r<16;++r)pA0[r]=NEGI; _Pragma("unroll") for(int r=0;r<16;++r)pA1[r]=NEGI; }
  START(pA0,pA1);
  _Pragma("unroll") for(int r=0;r<16;++r)pA1[r]=__builtin_amdgcn_exp2f(pA1[r]);
  WAIT_BAR(0);
  DMA_K(3,0);DMA_V(1,SLOTB);
  ROT();
  kload8(kf,kp0+sl_cur);
  WAIT_BAR(2);
  s16x4 vlo[8],vhi[8]; u32x4 pw0,pw1,pw2,pw3;
  #define PKW(P,B) cvtpk_s(P[B],P[B+1])
  #define PAF(k) __builtin_bit_cast(bf16x8,pw##k)
  #define VFR(i) (bf16x8){vlo[i][0],vlo[i][1],vlo[i][2],vlo[i][3],vhi[i][0],vhi[i][1],vhi[i][2],vhi[i][3]}
  #define PIN(x) asm volatile("":"+v"(x))
  #define MX3(a,b,c) __builtin_fmaxf(__builtin_fmaxf((a),(b)),(c))
  #define GAPA(MF,A0,A1,A2,A3,W0,W1,PW) do{ MF; sacc+=A0; sacc+=A1; sacc+=A2; sacc+=A3; PIN(sacc); W0; W1; PIN(PW); SBAR(); }while(0)
  #define EX(v) __builtin_amdgcn_exp2f(v)
  #define GAPB(MF,X,B) do{ MF; X[B]=EX(X[B]); X[B+1]=EX(X[B+1]); X[B+2]=EX(X[B+2]); X[B+3]=EX(X[B+3]); PIN(X); SBAR(); }while(0)
  #define VRD(i) do{ vlo[i]=vtr(vp_+(((i)>>2)*4096+((i)&3)*1024)); vhi[i]=vtr(vp_+(((i)>>2)*4096+((i)&3)*1024+512)); }while(0)
  #define KRD(G,j) do{ if(G){ kload2(kf,kp0+sl_next,j); SBAR(); } }while(0)
  #define STEP(C0,C1,P0,P1,t,GK,GV,GL) do{ SBAR(); \
    const lds_cptr vp_=vp0+sl_prev; \
    VRD(0); SBAR(); float sacc=(P0[0]+P0[1]); \
    GAPA(C0=__builtin_amdgcn_mfma_f32_32x32x16_bf16(kf[0],qr[0],negm,0,0,0), P0[2],P0[3],P0[4],P0[5],     pw0[0]=PKW(P0,0), pw0[1]=PKW(P0,2), pw0); \
    VRD(4); SBAR(); GAPA(C1=__builtin_amdgcn_mfma_f32_32x32x16_bf16(kf[1],qr[0],negm,0,0,0), P0[6],P0[7],P0[8],P0[9],     pw0[2]=PKW(P0,4), pw0[3]=PKW(P0,6), pw0); \
    VRD(1); SBAR(); GAPA(C0=__builtin_amdgcn_mfma_f32_32x32x16_bf16(kf[2],qr[1],C0,0,0,0),   P0[10],P0[11],P0[12],P0[13], pw1[0]=PKW(P0,8), pw1[1]=PKW(P0,10), pw1); \
    VRD(5); SBAR(); GAPA(C1=__builtin_amdgcn_mfma_f32_32x32x16_bf16(kf[3],qr[1],C1,0,0,0),   P0[14],P0[15],P1[0],P1[1],   pw1[2]=PKW(P0,12),pw1[3]=PKW(P0,14), pw1); \
    VRD(2); SBAR(); GAPA(C0=__builtin_amdgcn_mfma_f32_32x32x16_bf16(kf[4],qr[2],C0,0,0,0),   P1[2],P1[3],P1[4],P1[5],     pw2[0]=PKW(P1,0), pw2[1]=PKW(P1,2), pw2); \
    VRD(6); SBAR(); GAPA(C1=__builtin_amdgcn_mfma_f32_32x32x16_bf16(kf[5],qr[2],C1,0,0,0),   P1[6],P1[7],P1[8],P1[9],     pw2[2]=PKW(P1,4), pw2[3]=PKW(P1,6), pw2); \
    VRD(3); SBAR(); GAPA(C0=__builtin_amdgcn_mfma_f32_32x32x16_bf16(kf[6],qr[3],C0,0,0,0),   P1[10],P1[11],P1[12],P1[13], pw3[0]=PKW(P1,8), pw3[1]=PKW(P1,10), pw3); \
    VRD(7); SBAR(); GAPA(C1=__builtin_amdgcn_mfma_f32_32x32x16_bf16(kf[7],qr[3],C1,0,0,0),   P1[14],P1[15],0.f,0.f,       pw3[2]=PKW(P1,12),pw3[3]=PKW(P1,14), pw3); \
    l_reg+=sacc; \
    if(GK){DMA_K((t)+3,sl_cur);} if(GV){DMA_V((t)+1,sl_next);} \
    CMASK(C0,C1,t); \
    { float a=MX3(C0[0],C0[1],C1[0]),b=MX3(C0[2],C0[3],C1[1]); a=MX3(a,C1[2],C1[3]); \
      _Pragma("unroll") for(int r=4;r<16;r+=4){a=MX3(a,C0[r],C0[r+1]);b=MX3(b,C0[r+2],C0[r+3]);a=MX3(a,C1[r],C1[r+1]);b=MX3(b,C1[r+2],C1[r+3]);} \
      float rm=__builtin_fmaxf(a,b); { auto rr=__builtin_amdgcn_permlane32_swap(__float_as_uint(rm),__float_as_uint(rm),false,false); rm=__builtin_fmaxf(__uint_as_float(rr[0]),__uint_as_float(rr[1])); } \
      resc=false; \
      if(__builtin_expect(__any(rm>(float)THRL),0)){ const float dl=__builtin_fmaxf(rm,0.f); mhat+=dl; \
        _Pragma("unroll") for(int r=0;r<16;++r){C0[r]-=dl;C1[r]-=dl;} \
        _Pragma("unroll") for(int r=0;r<16;++r)negm[r]=-mhat; asm volatile("":"+v"(negm)); \
        const float f=__builtin_amdgcn_exp2f(-dl); l_reg*=f; if(hi==0)wsf[r32]=f; resc=true; } } \
    SBAR(); \
    GAPB(o[0]=__builtin_amdgcn_mfma_f32_32x32x16_bf16(PAF(0),VFR(0),o[0],0,0,0), C0,0); \
    GAPB(o[1]=__builtin_amdgcn_mfma_f32_32x32x16_bf16(PAF(0),VFR(4),o[1],0,0,0), C0,4); \
    KRD(GL,0); GAPB(o[0]=__builtin_amdgcn_mfma_f32_32x32x16_bf16(PAF(1),VFR(1),o[0],0,0,0), C0,8); \
    KRD(GL,1); GAPB(o[1]=__builtin_amdgcn_mfma_f32_32x32x16_bf16(PAF(1),VFR(5),o[1],0,0,0), C0,12); \
    KRD(GL,2); GAPB(o[0]=__builtin_amdgcn_mfma_f32_32x32x16_bf16(PAF(2),VFR(2),o[0],0,0,0), C1,0); \
    KRD(GL,3); GAPB(o[1]=__builtin_amdgcn_mfma_f32_32x32x16_bf16(PAF(2),VFR(6),o[1],0,0,0), C1,4); \
    GAPB(o[0]=__builtin_amdgcn_mfma_f32_32x32x16_bf16(PAF(3),VFR(3),o[0],0,0,0), C1,8); \
    GAPB(o[1]=__builtin_amdgcn_mfma_f32_32x32x16_bf16(PAF(3),VFR(7),o[1],0,0,0), C1,12); \
    }while(0)
  int t=1;
  #undef CMASK
  #define CMASK(P0,P1,t) do{}while(0)
  for(;t+5<NT;t+=2){
    STEP(pB0,pB1,pA0,pA1,t,true,true,true);     WAIT_BAR(2); RESC(); ROT();
    STEP(pA0,pA1,pB0,pB1,t+1,true,true,true);   WAIT_BAR(2); RESC(); ROT();
  }
  #undef CMASK
  #define CMASK(P0,P1,t) do{int jb_=(t)-(NT-4); if(jb_>=0)cmask(P0,P1,jb_,qrel,hi);}while(0)
  #define ENDW(tt) do{ if((tt)+3<NT){WAIT_BAR(2);} else if((tt)+2<NT){WAIT_BAR(1);} else {WAIT_BAR(0);} }while(0)
  for(;t+1<NT;t+=2){
    STEP(pB0,pB1,pA0,pA1,t,(t+3<NT),(t+1<NT),(t+1<NT));       ENDW(t);   RESC(); ROT();
    STEP(pA0,pA1,pB0,pB1,t+1,(t+4<NT),(t+2<NT),(t+2<NT));     ENDW(t+1); RESC(); ROT();
  }
  { float sacc=pA0[0]+pA0[1]; _Pragma("unroll") for(int r=2;r<16;++r)sacc+=pA0[r]; _Pragma("unroll") for(int r=0;r<16;++r)sacc+=pA1[r]; l_reg+=sacc;
    pw0=(u32x4){PKW(pA0,0),PKW(pA0,2),PKW(pA0,4),PKW(pA0,6)};pw1=(u32x4){PKW(pA0,8),PKW(pA0,10),PKW(pA0,12),PKW(pA0,14)};pw2=(u32x4){PKW(pA1,0),PKW(pA1,2),PKW(pA1,4),PKW(pA1,6)};pw3=(u32x4){PKW(pA1,8),PKW(pA1,10),PKW(pA1,12),PKW(pA1,14)};
    SBAR(); pv(o,vb0+sl_prev,PAF(0),PAF(1),PAF(2),PAF(3)); }
  #undef PKW
  #undef PAF
  #undef VFR
  #undef PIN
  #undef MX3
  #undef GAPA
  #undef GAPB
  #undef EX
  #undef VRD
  #undef KRD
  #undef STEP
  #undef ENDW
  {auto rr=__builtin_amdgcn_permlane32_swap(__float_as_uint(l_reg),__float_as_uint(l_reg),false,false);l_reg=__uint_as_float(rr[0])+__uint_as_float(rr[1]);}
  if(hi==0)wsf[32+r32]=l_reg;asm volatile("s_waitcnt lgkmcnt(0)":::"memory");
  float rli[16];
  #pragma unroll
  for(int r=0;r<16;++r)rli[r]=__builtin_amdgcn_rcpf(wsf[32+crow(r,hi)]);
  bf16*Ow=Ou+(long)(wid*QBLK)*PO;
  { bf16*stg=(bf16*)(shm+LDS_OST)+wid*2048;
    #pragma unroll
    for(int r=0;r<16;++r){const int orow=crow(r,hi);
      #pragma unroll
      for(int d0=0;d0<2;++d0)stg[orow*64+d0*32+r32]=__float2bfloat16(o[d0][r]*rli[r]);}
    asm volatile("s_waitcnt lgkmcnt(0)":::"memory");
    #pragma unroll
    for(int i=0;i<4;++i){const int row=i*8+(lane>>3),ch=lane&7; const u32x4 v=*(const u32x4*)(stg+row*64+ch*8); ATTN_STORE16(Ow+(long)row*PO+ch*8,v);} }
  asm volatile("s_waitcnt lgkmcnt(0)\n\ts_barrier":::"memory");
  #undef DMA_K
  #undef DMA_V
  #undef CMASK
  #undef START
  #undef RESC
  #undef ROT
}
constexpr int ATTN_LDS_BYTES=LDS_BYTES;
#undef SBAR
#undef WAIT_BAR
typedef float f32x4v __attribute__((ext_vector_type(4)));
constexpr int V2_SLOTV=16384, V2_LDS_K=0, V2_LDS_V=NSLOT*SLOTB, V2_LDS_WS=V2_LDS_V+NSLOT*V2_SLOTV, V2_LDS_OST=V2_LDS_WS+NW*64*4, V2_LDS_BYTES=V2_LDS_OST+NW*8192;
#define SBAR() __builtin_amdgcn_sched_barrier(0)
#define WAIT_BAR(N) asm volatile("s_waitcnt vmcnt(" #N ") lgkmcnt(0)\n\ts_barrier":::"memory")
__device__ __forceinline__ void pv4(f32x16*o,int vb,bf16x8 pa0,bf16x8 pa1,bf16x8 pa2,bf16x8 pa3){
  #pragma unroll
  for(int d0=0;d0<4;++d0){s16x4 lo[4],hi[4];
    #pragma unroll
    for(int ks=0;ks<4;++ks){
      asm volatile("ds_read_b64_tr_b16 %0,%1 offset:%c2":"=&v"(lo[ks]):"v"(vb),"i"(d0*4096+ks*1024):"memory");
      asm volatile("ds_read_b64_tr_b16 %0,%1 offset:%c2":"=&v"(hi[ks]):"v"(vb),"i"(d0*4096+ks*1024+512):"memory");}
    asm volatile("s_waitcnt lgkmcnt(0)":::"memory");SBAR();
    #define PK(k) (bf16x8){lo[k][0],lo[k][1],lo[k][2],lo[k][3],hi[k][0],hi[k][1],hi[k][2],hi[k][3]}
    o[d0]=__builtin_amdgcn_mfma_f32_32x32x16_bf16(pa0,PK(0),o[d0],0,0,0);
    o[d0]=__builtin_amdgcn_mfma_f32_32x32x16_bf16(pa1,PK(1),o[d0],0,0,0);
    o[d0]=__builtin_amdgcn_mfma_f32_32x32x16_bf16(pa2,PK(2),o[d0],0,0,0);
    o[d0]=__builtin_amdgcn_mfma_f32_32x32x16_bf16(pa3,PK(3),o[d0],0,0,0);
    #undef PK
  }
}
template<int MODE> __device__ __forceinline__ void attn_unit128(int q0,const bf16*Qu,const bf16*__restrict__ Kh,const bf16*__restrict__ Vh,bf16*Ou,char*shm,float lam,float oscale,const float*subg){
  int tid_=threadIdx.x; asm volatile("":"+v"(tid_)); const int tid=tid_,lane=tid&63,r32=lane&31,hi=lane>>5; const int wid=__builtin_amdgcn_readfirstlane(tid>>6);
  const bf16*Qw=Qu+(long)(wid*QBLK)*PQ;
  const unsigned lds0=(unsigned)(uintptr_t)shm;
  float*wsf=(float*)(shm+V2_LDS_WS)+wid*64;
  const bf16*ksrc=Kh+(long)lane*PQ+wid*8;
  const bf16*vsrc=Vh+(long)(16*(wid&3)+(lane>>2))*PQ+(wid>>2)*32+(lane&3)*8;
  const unsigned kdst=lds0+V2_LDS_K+wid*1024, vdst=lds0+V2_LDS_V+wid*1024;
  #define DMA_K(t,slot) glds16(ksrc+(long)(t)*KVBLK*PQ,(unsigned)__builtin_amdgcn_readfirstlane(kdst+(slot)))
  #define DMA_V(t,slot) do{ glds16(vsrc+(long)(t)*KVBLK*PQ,(unsigned)__builtin_amdgcn_readfirstlane(vdst+2*(slot))); glds16(vsrc+(long)(t)*KVBLK*PQ+64,(unsigned)__builtin_amdgcn_readfirstlane(vdst+2*(slot)+8192)); }while(0)
  const int vb0=(int)(lds0+V2_LDS_V)+((lane>>4)&1)*32+(lane&3)*8+(4*hi+((lane&15)>>2))*64;
  const char*Kbase=shm+V2_LDS_K; bf16x8 kf[8];
  const lds_cptr shm3=(lds_cptr)shm; const lds_cptr kp0=shm3+V2_LDS_K+hi*1024+r32*16; const lds_cptr vp0=shm3+V2_LDS_V+((lane>>4)&1)*32+(lane&3)*8+(4*hi+((lane&15)>>2))*64;
  const int NT=(q0+QB)/KVBLK+1;
  DMA_K(0,0);DMA_V(0,0);DMA_K(1,SLOTB);
  bf16x8 qr[4];
  #pragma unroll
  for(int d0=0;d0<4;++d0)qr[d0]=*reinterpret_cast<const bf16x8*>(&Qw[(long)r32*PQ+d0*16+hi*8]);
  float l_reg=0.f;f32x16 o[4];o[0]=f32x16{};o[1]=f32x16{};o[2]=f32x16{};o[3]=f32x16{};
  const f32x16 zero16=f32x16{};
  const int qrel=wid*QBLK+r32;
  #define CMASK(P0,P1,t) do{int jb_=(t)-(NT-4); if(jb_>=0)cmask(P0,P1,jb_,qrel,hi);}while(0)
  f32x16 pA0,pA1,pB0,pB1;
  int sl_prev=0,sl_cur=0,sl_next=SLOTB;
  #define ROT() do{sl_prev=sl_cur;sl_cur=sl_next;sl_next=(sl_next==(NSLOT-1)*SLOTB)?0:sl_next+SLOTB;}while(0)
  DMA_K(2,2*SLOTB);
  WAIT_BAR(3);
  qkt(pA0,pA1,Kbase,qr,zero16,r32,hi);asm volatile("s_nop 15\n\ts_nop 7":"+v"(pA0),"+v"(pA1));
  { const float NEGI=-INFINITY; _Pragma("unroll") for(int r=8;r<16;++r)pA0[r]=NEGI; _Pragma("unroll") for(int r=0;r<16;++r)pA1[r]=NEGI; }
  _Pragma("unroll") for(int r=0;r<16;++r){pA0[r]=__builtin_amdgcn_exp2f(pA0[r]);pA1[r]=__builtin_amdgcn_exp2f(pA1[r]);}
  WAIT_BAR(0);
  DMA_K(3,0);DMA_V(1,SLOTB);
  ROT();
  kload8(kf,kp0+sl_cur);
  WAIT_BAR(3);
  s16x4 vlo[8],vhi[8]; u32x4 pw0,pw1,pw2,pw3;
  #define PKW(P,B) cvtpk_s(P[B],P[B+1])
  #define PAF(k) __builtin_bit_cast(bf16x8,pw##k)
  #define VFR(i) (bf16x8){vlo[i][0],vlo[i][1],vlo[i][2],vlo[i][3],vhi[i][0],vhi[i][1],vhi[i][2],vhi[i][3]}
  #define PIN(x) asm volatile("":"+v"(x))
  #define GAPA(MF,A0,A1,A2,A3,W0,W1,PW) do{ MF; sacc+=A0; sacc+=A1; sacc+=A2; sacc+=A3; PIN(sacc); W0; W1; PIN(PW); SBAR(); }while(0)
  #define EX(v) __builtin_amdgcn_exp2f(v)
  #define GAPB(MF,X,B) do{ MF; X[B]=EX(X[B]); X[B+1]=EX(X[B+1]); PIN(X); SBAR(); }while(0)
  #define VRD(i) do{ vlo[i]=vtr(vp_+(((i)>>2)*4096+((i)&3)*1024)); vhi[i]=vtr(vp_+(((i)>>2)*4096+((i)&3)*1024+512)); }while(0)
  #define VRD2(i) do{ vlo[i]=vtr(vp_+(8192+((i)>>2)*4096+((i)&3)*1024)); vhi[i]=vtr(vp_+(8192+((i)>>2)*4096+((i)&3)*1024+512)); SBAR(); }while(0)
  #define KRD(G,j) do{ if(G){ kload2(kf,kp0+sl_next,j); SBAR(); } }while(0)
  #define MF32(a,b,c) __builtin_amdgcn_mfma_f32_32x32x16_bf16(a,b,c,0,0,0)
  #define STEP(C0,C1,P0,P1,t,GK,GV,GL) do{ SBAR(); \
    const lds_cptr vp_=vp0+2*sl_prev; \
    VRD(0); SBAR(); float sacc=(P0[0]+P0[1]); \
    GAPA(C0=MF32(kf[0],qr[0],zero16), P0[2],P0[3],P0[4],P0[5],     pw0[0]=PKW(P0,0), pw0[1]=PKW(P0,2), pw0); \
    VRD(4); SBAR(); GAPA(C1=MF32(kf[1],qr[0],zero16), P0[6],P0[7],P0[8],P0[9],     pw0[2]=PKW(P0,4), pw0[3]=PKW(P0,6), pw0); \
    VRD(1); SBAR(); GAPA(C0=MF32(kf[2],qr[1],C0),   P0[10],P0[11],P0[12],P0[13], pw1[0]=PKW(P0,8), pw1[1]=PKW(P0,10), pw1); \
    VRD(5); SBAR(); GAPA(C1=MF32(kf[3],qr[1],C1),   P0[14],P0[15],P1[0],P1[1],   pw1[2]=PKW(P0,12),pw1[3]=PKW(P0,14), pw1); \
    VRD(2); SBAR(); GAPA(C0=MF32(kf[4],qr[2],C0),   P1[2],P1[3],P1[4],P1[5],     pw2[0]=PKW(P1,0), pw2[1]=PKW(P1,2), pw2); \
    VRD(6); SBAR(); GAPA(C1=MF32(kf[5],qr[2],C1),   P1[6],P1[7],P1[8],P1[9],     pw2[2]=PKW(P1,4), pw2[3]=PKW(P1,6), pw2); \
    VRD(3); SBAR(); GAPA(C0=MF32(kf[6],qr[3],C0),   P1[10],P1[11],P1[12],P1[13], pw3[0]=PKW(P1,8), pw3[1]=PKW(P1,10), pw3); \
    VRD(7); SBAR(); GAPA(C1=MF32(kf[7],qr[3],C1),   P1[14],P1[15],0.f,0.f,       pw3[2]=PKW(P1,12),pw3[3]=PKW(P1,14), pw3); \
    l_reg+=sacc; \
    if(GK){DMA_K((t)+3,sl_cur);} if(GV){DMA_V((t)+1,sl_next);} \
    CMASK(C0,C1,t); \
    SBAR(); \
    GAPB(o[0]=MF32(PAF(0),VFR(0),o[0]), C0,0);  VRD2(0); \
    GAPB(o[1]=MF32(PAF(0),VFR(4),o[1]), C0,2);  VRD2(4); \
    KRD(GL,0); GAPB(o[0]=MF32(PAF(1),VFR(1),o[0]), C0,4);  VRD2(1); \
    KRD(GL,1); GAPB(o[1]=MF32(PAF(1),VFR(5),o[1]), C0,6);  VRD2(5); \
    KRD(GL,2); GAPB(o[0]=MF32(PAF(2),VFR(2),o[0]), C0,8);  VRD2(2); \
    KRD(GL,3); GAPB(o[1]=MF32(PAF(2),VFR(6),o[1]), C0,10); VRD2(6); \
    GAPB(o[0]=MF32(PAF(3),VFR(3),o[0]), C0,12); VRD2(3); \
    GAPB(o[1]=MF32(PAF(3),VFR(7),o[1]), C0,14); VRD2(7); \
    GAPB(o[2]=MF32(PAF(0),VFR(0),o[2]), C1,0); \
    GAPB(o[3]=MF32(PAF(0),VFR(4),o[3]), C1,2); \
    GAPB(o[2]=MF32(PAF(1),VFR(1),o[2]), C1,4); \
    GAPB(o[3]=MF32(PAF(1),VFR(5),o[3]), C1,6); \
    GAPB(o[2]=MF32(PAF(2),VFR(2),o[2]), C1,8); \
    GAPB(o[3]=MF32(PAF(2),VFR(6),o[3]), C1,10); \
    GAPB(o[2]=MF32(PAF(3),VFR(3),o[2]), C1,12); \
    GAPB(o[3]=MF32(PAF(3),VFR(7),o[3]), C1,14); \
    }while(0)
  int t=1;
  #undef CMASK
  #define CMASK(P0,P1,t) do{}while(0)
  for(;t+5<NT;t+=2){
    STEP(pB0,pB1,pA0,pA1,t,true,true,true);     WAIT_BAR(3); ROT();
    STEP(pA0,pA1,pB0,pB1,t+1,true,true,true);   WAIT_BAR(3); ROT();
  }
  #undef CMASK
  #define CMASK(P0,P1,t) do{int jb_=(t)-(NT-4); if(jb_>=0)cmask(P0,P1,jb_,qrel,hi);}while(0)
  #define ENDW(tt) do{ if((tt)+3<NT){WAIT_BAR(3);} else if((tt)+2<NT){WAIT_BAR(2);} else {WAIT_BAR(0);} }while(0)
  for(;t+1<NT;t+=2){
    STEP(pB0,pB1,pA0,pA1,t,(t+3<NT),(t+1<NT),(t+1<NT));       ENDW(t);   ROT();
    STEP(pA0,pA1,pB0,pB1,t+1,(t+4<NT),(t+2<NT),(t+2<NT));     ENDW(t+1); ROT();
  }
  { float sacc=pA0[0]+pA0[1]; _Pragma("unroll") for(int r=2;r<16;++r)sacc+=pA0[r]; _Pragma("unroll") for(int r=0;r<16;++r)sacc+=pA1[r]; l_reg+=sacc;
    pw0=(u32x4){PKW(pA0,0),PKW(pA0,2),PKW(pA0,4),PKW(pA0,6)};pw1=(u32x4){PKW(pA0,8),PKW(pA0,10),PKW(pA0,12),PKW(pA0,14)};pw2=(u32x4){PKW(pA1,0),PKW(pA1,2),PKW(pA1,4),PKW(pA1,6)};pw3=(u32x4){PKW(pA1,8),PKW(pA1,10),PKW(pA1,12),PKW(pA1,14)};
    SBAR(); pv4(o,vb0+2*sl_prev,PAF(0),PAF(1),PAF(2),PAF(3)); }
  #undef PKW
  #undef PAF
  #undef VFR
  #undef PIN
  #undef GAPA
  #undef GAPB
  #undef EX
  #undef VRD
  #undef VRD2
  #undef KRD
  #undef MF32
  #undef STEP
  #undef ENDW
  {auto rr=__builtin_amdgcn_permlane32_swap(__float_as_uint(l_reg),__float_as_uint(l_reg),false,false);l_reg=__uint_as_float(rr[0])+__uint_as_float(rr[1]);}
  if(hi==0)wsf[32+r32]=l_reg;asm volatile("s_waitcnt lgkmcnt(0)":::"memory");
  float rli[16];
  #pragma unroll
  for(int r=0;r<16;++r)rli[r]=__builtin_amdgcn_rcpf(wsf[32+crow(r,hi)]);
  { bf16*park=(bf16*)(shm+V2_LDS_OST)+wid*4096;
    if(MODE==0){
      #pragma unroll
      for(int r=0;r<16;++r){const int orow=crow(r,hi);
        #pragma unroll
        for(int d0=0;d0<4;++d0)park[orow*128+d0*32+r32]=__float2bfloat16(o[d0][r]*rli[r]);}
      asm volatile("s_waitcnt lgkmcnt(0)":::"memory");
    } else {
      #pragma unroll
      for(int r=0;r<16;++r){const int orow=crow(r,hi);
        #pragma unroll
        for(int d0=0;d0<4;++d0){const float o1=__bfloat162float(park[orow*128+d0*32+r32]); park[orow*128+d0*32+r32]=__float2bfloat16(o1-lam*(o[d0][r]*rli[r]));}}
      asm volatile("s_waitcnt lgkmcnt(0)":::"memory");
      bf16*Ow=Ou+(long)(wid*QBLK)*PO;
      const int ch=lane&15; const f32x4v g0=*(const f32x4v*)(subg+8*ch), g1=*(const f32x4v*)(subg+8*ch+4);
      #pragma unroll
      for(int i=0;i<8;++i){const int row=i*4+(lane>>4); const u32x4 v=*(const u32x4*)(park+row*128+ch*8);
        float d[8]; d[0]=__uint_as_float(v.x<<16);d[1]=__uint_as_float(v.x&0xffff0000u);d[2]=__uint_as_float(v.y<<16);d[3]=__uint_as_float(v.y&0xffff0000u);d[4]=__uint_as_float(v.z<<16);d[5]=__uint_as_float(v.z&0xffff0000u);d[6]=__uint_as_float(v.w<<16);d[7]=__uint_as_float(v.w&0xffff0000u);
        float ss=(d[0]*d[0]+d[1]*d[1])+(d[2]*d[2]+d[3]*d[3])+(d[4]*d[4]+d[5]*d[5])+(d[6]*d[6]+d[7]*d[7]);
        ss+=__shfl_xor(ss,1);ss+=__shfl_xor(ss,2);ss+=__shfl_xor(ss,4);ss+=__shfl_xor(ss,8);
        const float rs=__builtin_amdgcn_rsqf(ss*(1.0f/128.0f)+1e-6f)*oscale;
        u32x4 w; w.x=cvtpk_s(d[0]*rs*g0[0],d[1]*rs*g0[1]); w.y=cvtpk_s(d[2]*rs*g0[2],d[3]*rs*g0[3]); w.z=cvtpk_s(d[4]*rs*g1[0],d[5]*rs*g1[1]); w.w=cvtpk_s(d[6]*rs*g1[2],d[7]*rs*g1[3]);
        ATTN_STORE16(Ow+(long)row*PO+ch*8,w);}
      asm volatile("s_waitcnt lgkmcnt(0)":::"memory");
    } }
  asm volatile("s_waitcnt lgkmcnt(0)\n\ts_barrier":::"memory");
  #undef DMA_K
  #undef DMA_V
  #undef CMASK
  #undef ROT
}
#undef SBAR
#undef WAIT_BAR

}
namespace cg = cooperative_groups;
constexpr int NWAVES = 8;
constexpr int NB = 4, SEQ = 8192, DM = 1024, NMETA = 16, DIN = 2560, DFF = 4096, DCONV = 512, CONVW = 31;
constexpr int MX = NB * SEQ;
constexpr int MP = MX + 256;
constexpr int SPAD = pg8::SPAD;
constexpr float EPS = 1e-6f;
constexpr size_t MiB = 1u << 20;
constexpr size_t WS_CTL = 0, WS_WIN = 1 * MiB, WS_WOUT = 6 * MiB, WS_WUP = 8 * MiB, WS_WDN = 16 * MiB, WS_ROPE = 24 * MiB, WS_SSQ = 25 * MiB, WS_RN = 27 * MiB,
                 WS_H1B = 28 * MiB, WS_MIX = 92 * MiB, WS_HB = 156 * MiB, WS_XN = 156 * MiB, WS_O = 156 * MiB, WS_Q = 222 * MiB, WS_K = 254 * MiB, WS_V = 287 * MiB, WS_G = 320 * MiB,
                 WS_END = 412 * MiB;
static_assert(WS_XN + (size_t)MP * DM * 2 <= WS_Q && WS_K + (size_t)NB * SPAD * 512 * 2 <= WS_V && WS_G + (size_t)NB * SPAD * 512 * 2 <= WS_HB + (size_t)MX * DFF * 2 && WS_HB + (size_t)MX * DFF * 2 <= WS_END, "d_ws map");
constexpr int RING_BYTES = 131072, LDS_BYTES = 147456;
#ifndef WGM_P1
#define WGM_P1 4
#endif
#ifndef WGM_P4
#define WGM_P4 4
#endif
#ifndef WGM_P35
#define WGM_P35 4
#endif

#define LAS __attribute__((address_space(3)))
typedef unsigned short bf16;
typedef unsigned v4u __attribute__((ext_vector_type(4)));
typedef float f32x4 __attribute__((ext_vector_type(4)));
typedef float f32x2 __attribute__((ext_vector_type(2)));
#define LDS_WAIT() asm volatile("s_waitcnt lgkmcnt(0)" ::: "memory")
__device__ __forceinline__ unsigned pk2(float lo, float hi) { return pg8::cvt_pk_bf16(lo, hi); }
__device__ __forceinline__ float bf_lo(unsigned u) { return __uint_as_float(u << 16); }
__device__ __forceinline__ float bf_hi(unsigned u) { return __uint_as_float(u & 0xffff0000u); }
__device__ __forceinline__ float wave_sum(float v) {
#pragma unroll
    for (int o = 1; o < 64; o <<= 1) v += __shfl_xor(v, o);
    return v;
}

#define XB_TMO      128
#define XB_XCNT(j)  (256  + 64 * (j))
#define XB_XSUB(j)  (1280 + 64 * (j))
#define XB_XGEN(j)  (2304 + 64 * (j))
#define XB_TOP      3328
#define XB_TOPGEN   3392
#define XCD_BAR_WORDS 3456
#define XB_SPIN_CAP (1u << 18)

__device__ __forceinline__ unsigned xb_ld(unsigned* p)              { return __hip_atomic_load(p, __ATOMIC_RELAXED, __HIP_MEMORY_SCOPE_AGENT); }
__device__ __forceinline__ unsigned xb_add(unsigned* p, unsigned v) { return __hip_atomic_fetch_add(p, v, __ATOMIC_RELAXED, __HIP_MEMORY_SCOPE_AGENT); }
__device__ __forceinline__ unsigned xb_xcc_id() { return (unsigned)__builtin_amdgcn_s_getreg((3 << 11) | 20) & 0xFu; }
#define XB_SPIN(cond, bar) do { unsigned _sp = 0; while (cond) { __builtin_amdgcn_s_sleep(1); \
    if ((++_sp & 255u) == 0u) { if (xb_ld(&(bar)[XB_TMO])) break; if (_sp > XB_SPIN_CAP) { atomicAdd(&(bar)[XB_TMO], 1u); break; } } } } while (0)

struct XcdBarrier {
    unsigned* bar; unsigned x;
    volatile LAS unsigned* st;
};

__device__ __forceinline__ XcdBarrier xcd_barrier_post(unsigned* bar, volatile LAS unsigned* st) {
    XcdBarrier b; b.bar = bar; b.x = xb_xcc_id(); b.st = st;
    if (threadIdx.x == 0) (void)xb_add(&bar[XB_XCNT(b.x)], 1u);
    return b;
}
__device__ __forceinline__ void xcd_barrier_complete(unsigned* bar, unsigned x, unsigned& nloc, unsigned& nx) {
    const unsigned G = gridDim.x * gridDim.y * gridDim.z;
    unsigned sum, cnt, mine, sp = 0u;
    for (;;) {
        sum = 0u; cnt = 0u; mine = 0u;
#pragma unroll
        for (unsigned j = 0; j < 16; ++j) { const unsigned c = xb_ld(&bar[XB_XCNT(j)]); sum += c; cnt += (c > 0u) ? 1u : 0u; mine = (j == x) ? c : mine; }
        if (sum == G) break;
        __builtin_amdgcn_s_sleep(1);
        if ((++sp & 255u) == 0u) { if (xb_ld(&bar[XB_TMO])) break; if (sp > XB_SPIN_CAP) { atomicAdd(&bar[XB_TMO], 1u); break; } }
    }
    nloc = mine > 0u ? mine : 1u; nx = cnt > 0u ? cnt : 1u;
}

__device__ __forceinline__ void xcd_barrier(const XcdBarrier& b) {
    asm volatile("s_waitcnt vmcnt(0)" ::: "memory");
    __syncthreads();
    if (threadIdx.x == 0) {
        unsigned* bar = b.bar;
        __builtin_amdgcn_s_waitcnt(0);
        unsigned nloc = b.st[0], nx = b.st[1];
        if (nloc == 0u) { xcd_barrier_complete(bar, b.x, nloc, nx); b.st[0] = nloc; b.st[1] = nx; }
        const unsigned old = xb_add(&bar[XB_XSUB(b.x)], 1u);
        const unsigned gen = old / nloc;
        if (old + 1u == (gen + 1u) * nloc) {
            __builtin_amdgcn_fence(__ATOMIC_RELEASE, "agent");
            asm volatile("s_waitcnt vmcnt(0)" ::: "memory");
            const unsigned og = xb_add(&bar[XB_TOP], 1u);
            const unsigned tg = og / nx;
            if (og + 1u == (tg + 1u) * nx) xb_add(&bar[XB_TOPGEN], 1u);
            else XB_SPIN(xb_ld(&bar[XB_TOPGEN]) == tg, bar);
            __builtin_amdgcn_fence(__ATOMIC_ACQUIRE, "agent");
            xb_add(&bar[XB_XGEN(b.x)], 1u);
            asm volatile("s_waitcnt vmcnt(0)" ::: "memory");
        } else {
            XB_SPIN(xb_ld(&bar[XB_XGEN(b.x)]) == gen, bar);
            __builtin_amdgcn_fence(__ATOMIC_ACQUIRE, "agent");
            asm volatile("s_waitcnt vmcnt(0)" ::: "memory");
        }
    }
    __syncthreads();
}

__device__ __forceinline__ float dpp_add(float v, const int ctrl_sel) {
    int t;
    if (ctrl_sel == 0) t = __builtin_amdgcn_update_dpp(0, __float_as_int(v), 0xB1, 0xF, 0xF, true);
    else if (ctrl_sel == 1) t = __builtin_amdgcn_update_dpp(0, __float_as_int(v), 0x4E, 0xF, 0xF, true);
    else if (ctrl_sel == 2) t = __builtin_amdgcn_update_dpp(0, __float_as_int(v), 0x141, 0xF, 0xF, true);
    else t = __builtin_amdgcn_update_dpp(0, __float_as_int(v), 0x140, 0xF, 0xF, true);
    return v + __int_as_float(t);
}
__device__ __forceinline__ float wave_sum_fast(float v) {
    v = dpp_add(v, 0); v = dpp_add(v, 1); v = dpp_add(v, 2); v = dpp_add(v, 3);
    { auto rr = __builtin_amdgcn_permlane16_swap(__float_as_uint(v), __float_as_uint(v), false, false); v = __uint_as_float(rr[0]) + __uint_as_float(rr[1]); }
    { auto rr = __builtin_amdgcn_permlane32_swap(__float_as_uint(v), __float_as_uint(v), false, false); v = __uint_as_float(rr[0]) + __uint_as_float(rr[1]); }
    return v;
}

struct Args { const float* in[19]; float* out; unsigned char* ws; float inv_freq[8]; };
enum { I_X = 0, I_META, I_G1, I_WIN, I_QG, I_KG, I_LQ1, I_LK1, I_LQ2, I_LK2, I_SUBLN, I_CW, I_CB, I_CLG, I_CLB, I_WOUT, I_G2, I_WUP, I_WDN };

__device__ __forceinline__ void p0_transpose_item(const float* W, int K, int N, bf16* WT, int out_row0, int n0, int k0, const float* kscale, LAS float* scr, int lane) {
    float tv[32], ts[32];
#pragma unroll
    for (int i = 0; i < 32; ++i) { const int kk = 2 * i + (lane >> 5); tv[i] = W[(size_t)(k0 + kk) * N + n0 + (lane & 31)]; ts[i] = kscale ? kscale[k0 + kk] : 1.0f; }
#pragma unroll
    for (int i = 0; i < 32; ++i) { const int kk = 2 * i + (lane >> 5); scr[kk * 33 + (lane & 31)] = tv[i] * ts[i]; }
    LDS_WAIT(); asm volatile("" ::: "memory");
    const int c = lane & 7;
#pragma unroll
    for (int j = 0; j < 4; ++j) { const int n = (lane >> 3) + 8 * j; const LAS float* s = scr + (8 * c) * 33 + n;
        v4u o; o.x = pk2(s[0 * 33], s[1 * 33]); o.y = pk2(s[2 * 33], s[3 * 33]); o.z = pk2(s[4 * 33], s[5 * 33]); o.w = pk2(s[6 * 33], s[7 * 33]);
        *(v4u*)(WT + (size_t)(out_row0 + n) * K + k0 + 8 * c) = o; }
    LDS_WAIT(); asm volatile("" ::: "memory");
}
__device__ __forceinline__ int wup_pcol(int lc) { const int l = lc & 255; return (lc & ~255) + 128 * ((l >> 5) & 1) + 32 * (l >> 6); }
__device__ __forceinline__ int win_pcol(int lc) {
    if (lc < 1024) { const int l = lc & 255; return (lc & ~255) + 128 * ((l >> 5) & 1) + 32 * (l >> 6) + (l & 31); }
    if (lc < 1536) return lc;
    if (lc < 2048) { const int ch = lc - 1536; return 1536 + 256 * (ch >> 7) + (ch & 127); }
    const int ch = lc - 2048; return 1536 + 256 * (ch >> 7) + 128 + (ch & 127);
}

__device__ __forceinline__ void p0_prologue(const Args& A, unsigned char* ws, LAS unsigned char* lds, int vcu, int G, int wave, int lane) {
    LAS float* scr = (LAS float*)(lds + wave * 16384);
    const int gw = vcu * NWAVES + wave, NGW = G * NWAVES;
    bf16* Win_t = (bf16*)(ws + WS_WIN); bf16* Wout_t = (bf16*)(ws + WS_WOUT); bf16* Wup_t = (bf16*)(ws + WS_WUP); bf16* Wdn_t = (bf16*)(ws + WS_WDN);
    constexpr int I_IN = (DM / 64) * (DIN / 32);
    for (int it = gw; it < I_IN; it += NGW) { const int nblk = DIN / 32, kb = it / nblk, nb = it % nblk; p0_transpose_item(A.in[I_WIN], DM, DIN, Win_t, win_pcol(32 * nb), 32 * nb, 64 * kb, nullptr, scr, lane); }
    {
        bf16* XN = (bf16*)(ws + WS_XN);
        f32x4 g[4];
#pragma unroll
        for (int j = 0; j < 4; ++j) g[j] = ((const f32x4*)A.in[I_G1])[lane + 64 * j];
        for (int m0 = gw; m0 < MX + NMETA; m0 += 4 * NGW) {
            f32x4 v[4][4];
#pragma unroll
            for (int q = 0; q < 4; ++q) { const int m = m0 + q * NGW; const bool ok = m < MX + NMETA;
                const float* src = !ok ? A.in[I_X] : (m < MX) ? A.in[I_X] + (size_t)m * DM : A.in[I_META] + (size_t)(m - MX) * DM;
                const f32x4* xr = (const f32x4*)src + lane;
#pragma unroll
                for (int j = 0; j < 4; ++j) v[q][j] = __builtin_nontemporal_load(xr + 64 * j); }
#pragma unroll
            for (int q = 0; q < 4; ++q) { const int m = m0 + q * NGW; if (m >= MX + NMETA) continue;
                float s = 0.f;
#pragma unroll
                for (int j = 0; j < 4; ++j) s += (v[q][j].x * v[q][j].x + v[q][j].y * v[q][j].y) + (v[q][j].z * v[q][j].z + v[q][j].w * v[q][j].w);
                const float ms = wave_sum_fast(s) * (1.f / DM) + EPS; const float rs = __builtin_amdgcn_rsqf(ms);
                if (lane == 0 && m < MX) ((float*)(ws + WS_RN))[m] = ms * rs;
                unsigned long long* o8 = (unsigned long long*)(XN + (size_t)m * DM) + lane;
#pragma unroll
                for (int j = 0; j < 4; ++j) { const f32x4 y = v[q][j] * rs * g[j]; o8[64 * j] = (unsigned long long)pk2(y.x, y.y) | ((unsigned long long)pk2(y.z, y.w) << 32); } }
        }
    }
    {
        float* rope = (float*)(ws + WS_ROPE);
        const int pos = gw * 64 + lane;
        if (pos < SEQ + NMETA) {
#pragma unroll
            for (int i = 0; i < 8; ++i) {
                const float angf = (float)pos * A.inv_freq[i];
                const double rev = (double)angf * 0.15915494309189533577; const double fr = rev - __builtin_rint(rev);
                const float f = (float)fr;
                rope[pos * 16 + i] = __builtin_amdgcn_cosf(f); rope[pos * 16 + 8 + i] = __builtin_amdgcn_sinf(f); } }
    }
    {
        bf16* KB = (bf16*)(ws + WS_K); bf16* VB = (bf16*)(ws + WS_V); bf16* GB = (bf16*)(ws + WS_G);
        for (int it = gw; it < NB * 48 * 3; it += NGW) { const int which = it / (NB * 48), r = it % (NB * 48), b = r / 48, rr = r % 48;
            bf16* p = which == 0 ? KB + (size_t)(b * SPAD + 16 + rr) * 512 : which == 1 ? VB + (size_t)(b * SPAD + 16 + rr) * 512 : GB + (size_t)(b * SPAD + rr) * 512;
            ((v4u*)p)[lane] = (v4u){0u, 0u, 0u, 0u}; }
    }
}

__device__ __forceinline__ void meta_proj(const Args& A, unsigned char* ws, LAS unsigned char* lds, int vcu, int wave, int lane) {
    typedef short bf16x8 __attribute__((ext_vector_type(8)));
    const int fr = lane & 15, fq = lane >> 4;
    const int item = vcu * 2 + (wave >> 2), kc = wave & 3;
    const int kind = item < 8 ? 0 : item < 16 ? 1 : 2, g = kind == 2 ? item - 16 : (item & 7);
    const bf16* XNm = (const bf16*)(ws + WS_XN) + (size_t)(MX + fr) * DM + 8 * fq + 256 * kc;
    const bf16* Wt = (const bf16*)(ws + WS_WIN);
    const bf16* brow[4];
#pragma unroll
    for (int nb = 0; nb < 4; ++nb) { const int lc = kind == 0 ? 512 + 64 * g + 16 * nb + fr : kind == 1 ? 1024 + 64 * g + 16 * nb + fr : (nb < 2 ? 1536 + 32 * g + 16 * nb + fr : 2048 + 32 * g + 16 * (nb - 2) + fr);
        brow[nb] = Wt + (size_t)(win_pcol(lc & ~31) + (lc & 31)) * DM + 8 * fq + 256 * kc; }
    bf16x8 af[8], bf[8][4];
#pragma unroll
    for (int ks = 0; ks < 8; ++ks) { af[ks] = *(const bf16x8*)(XNm + 32 * ks);
#pragma unroll
        for (int nb = 0; nb < 4; ++nb) bf[ks][nb] = *(const bf16x8*)(brow[nb] + 32 * ks); }
    asm volatile("" ::: "memory");
    f32x4 acc[4];
#pragma unroll
    for (int nb = 0; nb < 4; ++nb) acc[nb] = (f32x4){0.f, 0.f, 0.f, 0.f};
#pragma unroll
    for (int ks = 0; ks < 8; ++ks)
#pragma unroll
        for (int nb = 0; nb < 4; ++nb) acc[nb] = __builtin_amdgcn_mfma_f32_16x16x32_bf16(bf[ks][nb], af[ks], acc[nb], 0, 0, 0);
    LAS f32x4* red = (LAS f32x4*)lds;
#pragma unroll
    for (int nb = 0; nb < 4; ++nb) red[(wave * 4 + nb) * 64 + lane] = acc[nb];
    __syncthreads();
    if (kc == 0) {
#pragma unroll
        for (int nb = 0; nb < 4; ++nb) acc[nb] = (red[((wave + 0) * 4 + nb) * 64 + lane] + red[((wave + 1) * 4 + nb) * 64 + lane]) + (red[((wave + 2) * 4 + nb) * 64 + lane] + red[((wave + 3) * 4 + nb) * 64 + lane]);
        if (kind == 0) {
            float ss = 0.f;
#pragma unroll
            for (int nb = 0; nb < 4; ++nb) ss += (acc[nb][0] * acc[nb][0] + acc[nb][1] * acc[nb][1]) + (acc[nb][2] * acc[nb][2] + acc[nb][3] * acc[nb][3]);
            ss += __shfl_xor(ss, 16); ss += __shfl_xor(ss, 32);
            const float rs = __builtin_amdgcn_rsqf(ss * (1.0f / 64.0f) + EPS);
#pragma unroll
            for (int nb = 0; nb < 4; ++nb) acc[nb] = acc[nb] * rs * *(const f32x4*)(A.in[I_KG] + 16 * nb + 4 * fq);
            f32x4 p; p[0] = __shfl_xor(acc[0][0], 32); p[1] = __shfl_xor(acc[0][1], 32); p[2] = __shfl_xor(acc[0][2], 32); p[3] = __shfl_xor(acc[0][3], 32);
            const float* rp = (const float*)(ws + WS_ROPE) + fr * 16 + 4 * (fq & 1);
            const f32x4 c = *(const f32x4*)rp, s = *(const f32x4*)(rp + 8);
            const float sg = (fq & 2) ? 1.f : -1.f;
            acc[0] = acc[0] * c + (p * s) * sg;
        }
        if (kind == 2) {
#pragma unroll
            for (int nb = 0; nb < 2; ++nb)
#pragma unroll
                for (int e = 0; e < 4; ++e) acc[nb][e] = acc[nb][e] * __builtin_amdgcn_rcpf(1.0f + __builtin_amdgcn_exp2f(-1.4426950408889634f * acc[nb + 2][e]));
        }
        bf16* dst = kind == 0 ? (bf16*)(ws + WS_K) : kind == 1 ? (bf16*)(ws + WS_V) : (bf16*)(ws + WS_G);
        const int r0 = kind == 2 ? 48 + fr : fr, c0 = (kind == 2 ? 32 * g : 64 * g) + 4 * fq, nnb = kind == 2 ? 2 : 4;
#pragma unroll 1
        for (int b = 0; b < NB; ++b) { bf16* o = dst + (size_t)(b * SPAD + r0) * 512 + c0;
#pragma unroll
            for (int nb = 0; nb < 4; ++nb) if (nb < nnb) *(unsigned long long*)(o + 16 * nb) = (unsigned long long)pk2(acc[nb][0], acc[nb][1]) | ((unsigned long long)pk2(acc[nb][2], acc[nb][3]) << 32); }
    }
    __syncthreads();
}

__device__ __forceinline__ void wconv_phase(const Args& A, unsigned char* ws, LAS unsigned char* lds, int wave, int lane) {
    LAS float* scr = (LAS float*)(lds + wave * 16384);
    bf16* Wout_t = (bf16*)(ws + WS_WOUT); bf16* Wup_t = (bf16*)(ws + WS_WUP); bf16* Wdn_t = (bf16*)(ws + WS_WDN);
    constexpr int I_OUT = (DM / 64) * (DM / 32), I_UP = (DM / 64) * (DFF / 32), I_DN = (DFF / 64) * (DM / 32), NIT = I_OUT + I_UP + I_DN;
    unsigned* wq = (unsigned*)(ws + WS_CTL) + 96;
    volatile LAS unsigned* TK = (volatile LAS unsigned*)(lds + LDS_BYTES - 256 + 64);
    for (;;) {
        if (wave == 0 && lane == 0) TK[0] = __hip_atomic_fetch_add(wq, 1u, __ATOMIC_RELAXED, __HIP_MEMORY_SCOPE_AGENT);
        __syncthreads();
        const int t = (int)TK[0];
        __syncthreads();
        if (t * NWAVES >= NIT) break;
        int r = t * NWAVES + wave;
        if (r >= NIT) continue;
        if (r < I_OUT) { const int nblk = DM / 32, kb = r / nblk, nb = r % nblk; p0_transpose_item(A.in[I_WOUT], DM, DM, Wout_t, wup_pcol(32 * nb), 32 * nb, 64 * kb, nullptr, scr, lane); continue; } r -= I_OUT;
        if (r < I_UP) { const int nblk = DFF / 32, kb = r / nblk, nb = r % nblk; p0_transpose_item(A.in[I_WUP], DM, DFF, Wup_t, wup_pcol(32 * nb), 32 * nb, 64 * kb, A.in[I_G2], scr, lane); continue; } r -= I_UP;
        { const int nblk = DM / 32, kb = r / nblk, nb = r % nblk; p0_transpose_item(A.in[I_WDN], DFF, DM, Wdn_t, 32 * nb, 32 * nb, 64 * kb, nullptr, scr, lane); }
    }
}

constexpr int CONV_R = 32;
__device__ __forceinline__ void conv_phase(const Args& A, unsigned char* ws, LAS unsigned char* lds, int vcu, int G, int wave, int lane) {
    LAS float* cbuf = (LAS float*)lds;
    const bf16* GB = (const bf16*)(ws + WS_G); bf16* MIX = (bf16*)(ws + WS_MIX);
    const int cp = (wave & 3) * 64 + lane, half = wave >> 2;
    f32x2 w[CONVW];
#pragma unroll
    for (int j = 0; j < CONVW; ++j) w[j] = *(const f32x2*)(A.in[I_CW] + j * DCONV + 2 * cp);
    const f32x2 bias = *(const f32x2*)(A.in[I_CB] + 2 * cp);
    const f32x4 lg0 = *(const f32x4*)(A.in[I_CLG] + lane * 8), lg1 = *(const f32x4*)(A.in[I_CLG] + lane * 8 + 4), lb0 = *(const f32x4*)(A.in[I_CLB] + lane * 8), lb1 = *(const f32x4*)(A.in[I_CLB] + lane * 8 + 4);
    constexpr int NITEMS = MX / (2 * CONV_R);
    unsigned* cq = (unsigned*)(ws + WS_CTL) + 32;
    volatile LAS unsigned* TK = (volatile LAS unsigned*)(lds + LDS_BYTES - 256 + 64);
    if (wave == 0 && lane == 0) { TK[0] = __hip_atomic_fetch_add(cq, 1u, __ATOMIC_RELAXED, __HIP_MEMORY_SCOPE_AGENT); TK[1] = __hip_atomic_fetch_add(cq, 1u, __ATOMIC_RELAXED, __HIP_MEMORY_SCOPE_AGENT); }
    __syncthreads();
    int it = (int)TK[0], nxt = (int)TK[1];
    __syncthreads();
#define CONV_SRC(item, sub) (GB + (size_t)(((((item) * 2 * CONV_R + half * CONV_R + (sub) * 16) >> 13) * SPAD) + 34 + (((item) * 2 * CONV_R + half * CONV_R + (sub) * 16) & 8191)) * 512 + 2 * cp)
#define CONV_LOAD(buf, item, sub) do { const bf16* gs_ = CONV_SRC(item, sub); _Pragma("unroll") for (int i = 0; i < 46; ++i) buf[i] = *(const unsigned*)(gs_ + (size_t)i * 512); } while (0)
#define CONV_FMA(buf, sub) do { f32x2 acc[16]; _Pragma("unroll") for (int o = 0; o < 16; ++o) acc[o] = bias; \
        _Pragma("unroll") for (int i = 0; i < 46; ++i) { const f32x2 x = {bf_lo(buf[i]), bf_hi(buf[i])}; _Pragma("unroll") for (int o = 0; o < 16; ++o) { const int j = i - o; if (j >= 0 && j < CONVW) acc[o] += w[j] * x; } } \
        _Pragma("unroll") for (int o = 0; o < 16; ++o) *(LAS f32x2*)(cbuf + (half * CONV_R + (sub) * 16 + o) * DCONV + 2 * cp) = acc[o]; } while (0)
    unsigned bufA[46], bufB[46];
    if (it < NITEMS) CONV_LOAD(bufA, it, 0);
#pragma unroll 1
    while (it < NITEMS) {
        if (wave == 0 && lane == 0) TK[0] = __hip_atomic_fetch_add(cq, 1u, __ATOMIC_RELAXED, __HIP_MEMORY_SCOPE_AGENT);
        CONV_LOAD(bufB, it, 1);
        CONV_FMA(bufA, 0);
        if (nxt < NITEMS) CONV_LOAD(bufA, nxt, 0);
        CONV_FMA(bufB, 1);
        __syncthreads();
        const int nn = (int)TK[0];
#pragma unroll
        for (int rr = 0; rr < 8; ++rr) { const int lr = wave * 8 + rr;
            f32x4 x0 = *(const LAS f32x4*)(cbuf + lr * DCONV + lane * 8), x1 = *(const LAS f32x4*)(cbuf + lr * DCONV + lane * 8 + 4);
            const float mu = wave_sum_fast((x0[0] + x0[1]) + (x0[2] + x0[3]) + (x1[0] + x1[1]) + (x1[2] + x1[3])) * (1.f / DCONV);
            x0 = x0 - mu; x1 = x1 - mu;
            const float var = wave_sum_fast((x0[0] * x0[0] + x0[1] * x0[1]) + (x0[2] * x0[2] + x0[3] * x0[3]) + (x1[0] * x1[0] + x1[1] * x1[1]) + (x1[2] * x1[2] + x1[3] * x1[3])) * (1.f / DCONV);
            const float rs = __builtin_amdgcn_rsqf(var + EPS);
            x0 = x0 * rs * lg0 + lb0; x1 = x1 * rs * lg1 + lb1;
#pragma unroll
            for (int e = 0; e < 4; ++e) { x0[e] = x0[e] * __builtin_amdgcn_rcpf(1.0f + __builtin_amdgcn_exp2f(-1.4426950408889634f * x0[e])); x1[e] = x1[e] * __builtin_amdgcn_rcpf(1.0f + __builtin_amdgcn_exp2f(-1.4426950408889634f * x1[e])); }
            *(v4u*)(MIX + (size_t)(it * 2 * CONV_R + lr) * DM + 512 + lane * 8) = pg8::pack8(x0, x1); }
        __syncthreads();
        it = nxt; nxt = nn;
    }
#undef CONV_SRC
#undef CONV_LOAD
#undef CONV_FMA
}

__device__ __forceinline__ void combine_phase(const Args& A, unsigned char* ws, int vcu, int G, int wave, int lane) {
    const bf16* OB = (const bf16*)(ws + WS_O); bf16* MIX = (bf16*)(ws + WS_MIX);
    const float d1 = wave_sum(A.in[I_LQ1][lane] * A.in[I_LK1][lane]), d2 = wave_sum(A.in[I_LQ2][lane] * A.in[I_LK2][lane]);
    const float lam_init = 0.2f;
    const float lam = __builtin_amdgcn_exp2f(d1 * 1.4426950408889634f) - __builtin_amdgcn_exp2f(d2 * 1.4426950408889634f) + lam_init;
    const int h = lane >> 4, q = lane & 15;
    const f32x4 sg0 = *(const f32x4*)(A.in[I_SUBLN] + 8 * q), sg1 = *(const f32x4*)(A.in[I_SUBLN] + 8 * q + 4);
    const int gw = vcu * NWAVES + wave, NGW = G * NWAVES;
    for (int row = gw; row < MX; row += NGW) {
        const bf16* o1 = OB + (size_t)row * 1024 + h * 256 + 8 * q;
        const v4u a = *(const v4u*)o1, bq = *(const v4u*)(o1 + 128);
        f32x4 d0, d1v;
        d0[0] = bf_lo(a.x) - lam * bf_lo(bq.x); d0[1] = bf_hi(a.x) - lam * bf_hi(bq.x); d0[2] = bf_lo(a.y) - lam * bf_lo(bq.y); d0[3] = bf_hi(a.y) - lam * bf_hi(bq.y);
        d1v[0] = bf_lo(a.z) - lam * bf_lo(bq.z); d1v[1] = bf_hi(a.z) - lam * bf_hi(bq.z); d1v[2] = bf_lo(a.w) - lam * bf_lo(bq.w); d1v[3] = bf_hi(a.w) - lam * bf_hi(bq.w);
        float ss = (d0[0] * d0[0] + d0[1] * d0[1]) + (d0[2] * d0[2] + d0[3] * d0[3]) + (d1v[0] * d1v[0] + d1v[1] * d1v[1]) + (d1v[2] * d1v[2] + d1v[3] * d1v[3]);
        ss += __shfl_xor(ss, 1); ss += __shfl_xor(ss, 2); ss += __shfl_xor(ss, 4); ss += __shfl_xor(ss, 8);
        const float rs = __builtin_amdgcn_rsqf(ss * (1.f / 128.f) + EPS) * (1.0f - lam_init);
        *(v4u*)(MIX + (size_t)row * DM + h * 128 + 8 * q) = pg8::pack8(d0 * rs * sg0, d1v * rs * sg1);
    }
}

__global__ void __launch_bounds__(NWAVES * 64, 2) hymba_fwd(Args args) {
    extern __shared__ __attribute__((aligned(16))) unsigned char lds[];
    cg::grid_group grid = cg::this_grid();
    LAS unsigned char* ldsl = (LAS unsigned char*)lds;
    volatile LAS unsigned* MISC = (volatile LAS unsigned*)(ldsl + LDS_BYTES - 256);
    if (threadIdx.x < 32) MISC[threadIdx.x] = 0u;
    __syncthreads();
    const XcdBarrier bar = xcd_barrier_post((unsigned*)(args.ws + WS_CTL) + 4096, MISC + 8);
    const int G = gridDim.x; const int bx = blockIdx.x; const int vcu = (G % 8 == 0) ? (bx % 8) * (G / 8) + bx / 8 : bx;
#ifndef PROBE_DUP
#define PROBE_DUP 0
#endif
#define REP(mask) for (int rep_ = 0; rep_ < (((PROBE_DUP) & (mask)) ? 2 : 1); ++rep_)
#define PHASE_VARS() unsigned char* ws = args.ws; int tid_ = threadIdx.x; asm volatile("" : "+v"(tid_)); const int lane = tid_ & 63, wave = __builtin_amdgcn_readfirstlane(tid_ >> 6); (void)lane; (void)wave

    REP(1) { PHASE_VARS(); p0_prologue(args, ws, ldsl, vcu, G, wave, lane); }
    if (args.ws == nullptr) grid.sync();
    xcd_barrier(bar);

    REP(2) {
        PHASE_VARS();
        pg8::Gemm g{(bf16*)(ws + WS_XN), (bf16*)(ws + WS_WIN), MX, DIN, DM}; pg8::StaticOrder S; S.init(MX, DIN, G, bx, WGM_P1);
        pg8::EpiInProj E{(bf16*)(ws + WS_Q), (bf16*)(ws + WS_K), (bf16*)(ws + WS_V), (bf16*)(ws + WS_G), args.in[I_QG], args.in[I_KG], (const float*)(ws + WS_ROPE)};
        pg8::gemm_phase<pg8::EpiInProj, pg8::StaticOrder, PG8_ALIGN, PG8_SP2>(ldsl, g, S, E);
    }
    {
        PHASE_VARS();
        unsigned* mq = (unsigned*)(ws + WS_CTL) + 160;
        volatile LAS unsigned* TK = (volatile LAS unsigned*)(ldsl + LDS_BYTES - 256 + 64);
        for (;;) {
            if (tid_ == 0) TK[0] = __hip_atomic_fetch_add(mq, 1u, __ATOMIC_RELAXED, __HIP_MEMORY_SCOPE_AGENT);
            __syncthreads();
            const int t = (int)TK[0];
            __syncthreads();
            if (t >= 16) break;
            meta_proj(args, ws, ldsl, t, wave, lane);
        }
    }
    xcd_barrier(bar);

    REP(8) {
        PHASE_VARS();
        static_assert(attn_body::V2_LDS_BYTES <= LDS_BYTES - 256, "attention LDS");
        const float dq1 = wave_sum(args.in[I_LQ1][lane] * args.in[I_LK1][lane]), dq2 = wave_sum(args.in[I_LQ2][lane] * args.in[I_LK2][lane]);
        const float lam_init = 0.2f;
        const float lam = __builtin_amdgcn_exp2f(dq1 * 1.4426950408889634f) - __builtin_amdgcn_exp2f(dq2 * 1.4426950408889634f) + lam_init;
        for (int vv = vcu; vv < 256; vv += G) {
            const int bh = vv >> 4, s = vv & 15;
            const int b = bh >> 2, head = bh & 3;
            const attn_body::bf16* Kh = (const attn_body::bf16*)(ws + WS_K) + (size_t)(b * SPAD) * 512 + head * 128;
            const attn_body::bf16* Vh = (const attn_body::bf16*)(ws + WS_V) + (size_t)(b * SPAD) * 512 + head * 128;
            for (int i = 0; i < 2; ++i) {
                const int qb = i ? 31 - s : s;
                const int q0 = qb * 256;
                const attn_body::bf16* Qu = (const attn_body::bf16*)(ws + WS_Q) + (size_t)(b * SEQ + q0) * 512 + head * 128;
                attn_body::bf16* Mu = (attn_body::bf16*)(ws + WS_MIX) + (size_t)(b * SEQ + q0) * 1024 + head * 128;
                attn_body::attn_unit128<0>(q0, Qu, Kh, Vh, Mu, (char*)lds, lam, 1.0f - lam_init, args.in[I_SUBLN]);
                attn_body::attn_unit128<1>(q0, Qu + 64, Kh + 64, Vh, Mu, (char*)lds, lam, 1.0f - lam_init, args.in[I_SUBLN]);
            }
        }
    }
    REP(4) { PHASE_VARS(); conv_phase(args, ws, ldsl, vcu, G, wave, lane); }
    { PHASE_VARS(); wconv_phase(args, ws, ldsl, wave, lane); }
    xcd_barrier(bar);

    REP(32) {
        PHASE_VARS();
        pg8::Gemm g{(bf16*)(ws + WS_MIX), (bf16*)(ws + WS_WOUT), MX, DM, DM}; pg8::StaticOrder S; S.init(MX, DM, G, bx, WGM_P35);
        pg8::EpiOut E{(const bf16*)(ws + WS_XN), (const float*)(ws + WS_RN), args.in[I_G1], (bf16*)(ws + WS_H1B), (float*)(ws + WS_SSQ)};
        pg8::gemm_phase<pg8::EpiOut, pg8::StaticOrder, PG8_ALIGN, PG8_SP2>(ldsl, g, S, E);
    }
    xcd_barrier(bar);

    REP(64) {
        PHASE_VARS();
        pg8::Gemm g{(bf16*)(ws + WS_H1B), (bf16*)(ws + WS_WUP), MX, DFF, DM}; pg8::StaticOrder S; S.init(MX, DFF, G, bx, WGM_P4);
        pg8::EpiUp E{(bf16*)(ws + WS_HB), (const float*)(ws + WS_SSQ)};
        pg8::gemm_phase<pg8::EpiUp, pg8::StaticOrder, PG8_ALIGN, PG8_SP2>(ldsl, g, S, E);
    }
    xcd_barrier(bar);

    {
        PHASE_VARS();
        pg8::Gemm g{(bf16*)(ws + WS_HB), (bf16*)(ws + WS_WDN), MX, DM, DFF}; pg8::StaticOrder S; S.init(MX, DM, G, bx, WGM_P35);
        pg8::EpiDown E{(const bf16*)(ws + WS_H1B), args.out};
        pg8::gemm_phase<pg8::EpiDown, pg8::StaticOrder, PG8_ALIGN, PG8_SP2>(ldsl, g, S, E);
    }
#undef PHASE_VARS
#undef REP
}

extern "C" void kernel_launch(void* const* d_in, const int* in_sizes, int n_in, void* d_out, int out_size, void* d_ws, size_t ws_size, hipStream_t stream) {
    static int grid = 0;
    if (grid == 0) {
        if (n_in != 19 || in_sizes[0] != MX * DM || out_size != MX * DM || ws_size < WS_END) { fprintf(stderr, "kernel_launch: unexpected shapes: n_in %d, in0 %d, out %d, ws %zu (need %zu); nothing launched\n", n_in, n_in > 0 ? in_sizes[0] : -1, out_size, ws_size, (size_t)WS_END); grid = -1; return; }
        int dev = 0, cus = 0, per_cu = 0;
        if (hipGetDevice(&dev) != hipSuccess || hipDeviceGetAttribute(&cus, hipDeviceAttributeMultiprocessorCount, dev) != hipSuccess) { fprintf(stderr, "kernel_launch: device query failed\n"); grid = -1; return; }
        if (hipFuncSetAttribute((const void*)hymba_fwd, hipFuncAttributeMaxDynamicSharedMemorySize, LDS_BYTES) != hipSuccess) { fprintf(stderr, "kernel_launch: hipFuncSetAttribute failed\n"); grid = -1; return; }
        if (hipOccupancyMaxActiveBlocksPerMultiprocessor(&per_cu, (const void*)hymba_fwd, NWAVES * 64, LDS_BYTES) != hipSuccess || per_cu < 1) { fprintf(stderr, "kernel_launch: occupancy query says %d\n", per_cu); per_cu = 1; }
        (void)hipGetLastError();
        grid = cus * 1;
        fprintf(stderr, "kernel_launch: grid %d (occupancy query %d per CU)\n", grid, per_cu);
    }
    if (grid < 0) return;
    Args a{};
    for (int i = 0; i < 19; ++i) a.in[i] = (const float*)d_in[i];
    a.out = (float*)d_out; a.ws = (unsigned char*)d_ws;
    for (int i = 0; i < 8; ++i) a.inv_freq[i] = (float)pow(500000.0, -(double)i / 8.0);
    if (hipMemsetAsync((char*)d_ws + WS_CTL, 0, 65536, stream) != hipSuccess) { fprintf(stderr, "kernel_launch: hipMemsetAsync failed\n"); return; }
    void* kargs[] = {&a};
    const hipError_t le = hipLaunchCooperativeKernel((const void*)hymba_fwd, dim3(grid), dim3(NWAVES * 64), kargs, LDS_BYTES, stream);
    if (le != hipSuccess) fprintf(stderr, "kernel_launch: cooperative launch failed: %s (grid %d)\n", hipGetErrorName(le), grid);
}
```

```cpp
#include <hip/hip_cooperative_groups.h>
#include <cmath>
#include <hip/hip_runtime.h>
#include <cstdio>
#include <cstdint>
namespace pg8 {
#define PG8_LAS __attribute__((address_space(3)))
typedef unsigned short bf16_t;
typedef short bf16x8 __attribute__((ext_vector_type(8)));
typedef float f32x4 __attribute__((ext_vector_type(4)));
typedef unsigned u32x4 __attribute__((ext_vector_type(4)));
constexpr int BM = 256, BK = 64, HALF = 128, HTB = HALF * BK * 2  , STAGE_BYTES = 8 * HTB, NXCD = 8, WGM = 8;

__host__ __device__ __forceinline__ int lds_byte(int r, int c) { const int st = (r >> 4) * 2 + (c >> 5), rr = r & 15, cc = c & 31, ob = rr * 64 + cc * 2; return st * 1024 + (ob ^ (((ob >> 9) & 1) << 5)); }
__host__ __device__ __forceinline__ void stage_rc(int b, int& R, int& C) { const int st = b / 1024, sb = b % 1024, swz = sb ^ (((sb >> 9) & 1) << 5); R = (st >> 1) * 16 + swz / 64; C = (st & 1) * 32 + (swz % 64) / 2; }
__host__ __device__ __forceinline__ int perm32(int rho) { const int n = rho >> 4, i = rho & 15; return 8 * (i >> 2) + 4 * n + (i & 3); }

struct Unit { int pm, pn; };
struct Gemm { const bf16_t* A; const bf16_t* Bt; int M, N, K; };

struct StaticOrder {
    int nM, nN, nwg, G, c, wgm;
    __host__ __device__ void init(int M, int N, int G_, int c_, int wgm_ = WGM) { nM = M / BM; nN = N / BM; nwg = nM * nN; G = G_; c = c_; wgm = wgm_; }
    __host__ __device__ bool next(int i, Unit& u) const {
        const long L = (long)i * G + c; if (L >= nwg) return false;
        int wgid = (int)L; { const int q = nwg / NXCD, r = nwg % NXCD, xcd = wgid % NXCD, off = wgid / NXCD; wgid = (xcd < r ? xcd * (q + 1) : r * (q + 1) + (xcd - r) * q) + off; }
        const int nig = wgm * nN, gid = wgid / nig, fm = gid * wgm, gsz = (nM - fm) < wgm ? (nM - fm) : wgm;
        u.pm = fm + ((wgid % nig) % gsz); u.pn = (wgid % nig) / gsz; return true;
    }
    __device__ __forceinline__ void a_ready(const Unit&) const {}
    __device__ __forceinline__ void done(const Unit&) const {}
};

__device__ __forceinline__ unsigned cvt_pk_bf16(float lo, float hi) { unsigned r; asm volatile("v_cvt_pk_bf16_f32 %0, %1, %2" : "=v"(r) : "v"(lo), "v"(hi)); return r; }
typedef float f32x2 __attribute__((ext_vector_type(2)));
__device__ __forceinline__ f32x2 gelu_pk(f32x2 v) {
    const f32x2 av = __builtin_elementwise_abs(v), d = av * 0.2316418882f + 1.0f;
    f32x2 t; t.x = __builtin_amdgcn_rcpf(d.x); t.y = __builtin_amdgcn_rcpf(d.y);
    f32x2 q = t * 0.5307027145f + (-0.7265760135f); q = q * t + 0.7107068705f; q = q * t + (-0.142248368f); q = q * t + 0.127414796f; q = q * t;
    const f32x2 s = (v * v) * (-0.72134752044f);
    f32x2 e; e.x = __builtin_amdgcn_exp2f(s.x); e.y = __builtin_amdgcn_exp2f(s.y);
    const f32x2 m = v * (q * e), r = v - m;
    f32x2 o; o.x = v.x < 0.f ? m.x : r.x; o.y = v.y < 0.f ? m.y : r.y; return o;
}

template <int ACT  > struct EpiBf16 {
    static constexpr bool PERM = true, AFTER_DRAIN = false; static_assert(ACT == 0 || ACT == 1, "EpiBf16: ACT is 0 (none) or 1 (gelu_pk)");
    bf16_t* O; int ldc; const float* bias; int split_cols; size_t split_stride; float scale0;
    __device__ __forceinline__ void operator()(const f32x4 (&acc)[2][2][4][2], const Unit& u, int wr, int wc, int fr, int fq) const {
        const int row0 = u.pm * BM + wr * 64 + fr; int colt = u.pn * BM; bf16_t* base = O;
        float sc = 1.f; if (split_cols) { const int t = colt / split_cols; base += (size_t)t * split_stride; colt -= t * split_cols; if (t == 0) sc = scale0; }
        const int col0 = colt + wc * 32 + 8 * fq, bcol0 = u.pn * BM + wc * 32 + 8 * fq;
        f32x4 bv[2][2];
#pragma unroll
        for (int bj = 0; bj < 2; ++bj)
#pragma unroll
            for (int n = 0; n < 2; ++n) bv[bj][n] = bias ? *(const f32x4*)(bias + bcol0 + bj * HALF + 4 * n) : (f32x4){0.f, 0.f, 0.f, 0.f};
#pragma unroll
        for (int ai = 0; ai < 2; ++ai)
#pragma unroll
            for (int m = 0; m < 4; ++m) { bf16_t* rowp = base + (size_t)(row0 + ai * HALF + m * 16) * ldc + col0;
#pragma unroll
                for (int bj = 0; bj < 2; ++bj) { f32x4 v0 = acc[ai][bj][m][0] + bv[bj][0], v1 = acc[ai][bj][m][1] + bv[bj][1];
                    if (ACT == 1) { f32x2 a = gelu_pk((f32x2){v0[0], v0[1]}), b = gelu_pk((f32x2){v0[2], v0[3]}), c = gelu_pk((f32x2){v1[0], v1[1]}), d = gelu_pk((f32x2){v1[2], v1[3]});
                        v0 = (f32x4){a.x, a.y, b.x, b.y}; v1 = (f32x4){c.x, c.y, d.x, d.y}; }
                    v0 = v0 * sc; v1 = v1 * sc; u32x4 w; w.x = cvt_pk_bf16(v0[0], v0[1]); w.y = cvt_pk_bf16(v0[2], v0[3]); w.z = cvt_pk_bf16(v1[0], v1[1]); w.w = cvt_pk_bf16(v1[2], v1[3]);
                    *(u32x4*)(rowp + bj * HALF) = w; } }
    }
};

constexpr int XROWS = 32768, SPAD = 8256;
constexpr float QSCALE = 0.125f * 1.4426950408889634f;
__device__ __forceinline__ f32x4 shfl_xor4(f32x4 v, int m) { f32x4 r; r[0] = __shfl_xor(v[0], m); r[1] = __shfl_xor(v[1], m); r[2] = __shfl_xor(v[2], m); r[3] = __shfl_xor(v[3], m); return r; }
__device__ __forceinline__ u32x4 pack8(f32x4 a, f32x4 b) { u32x4 w; w.x = cvt_pk_bf16(a[0], a[1]); w.y = cvt_pk_bf16(a[2], a[3]); w.z = cvt_pk_bf16(b[0], b[1]); w.w = cvt_pk_bf16(b[2], b[3]); return w; }
__device__ __forceinline__ u32x4 swap_lane1(u32x4 v) { u32x4 r; r.x = (unsigned)__builtin_amdgcn_update_dpp(0, (int)v.x, 0xB1, 0xF, 0xF, true); r.y = (unsigned)__builtin_amdgcn_update_dpp(0, (int)v.y, 0xB1, 0xF, 0xF, true);
    r.z = (unsigned)__builtin_amdgcn_update_dpp(0, (int)v.z, 0xB1, 0xF, 0xF, true); r.w = (unsigned)__builtin_amdgcn_update_dpp(0, (int)v.w, 0xB1, 0xF, 0xF, true); return r; }
struct EpiInProj {
    static constexpr bool PERM = true, AFTER_DRAIN = false;
    bf16_t *Q, *K, *V, *G; const float *qg, *kg, *rope;
    __device__ __forceinline__ void operator()(const f32x4 (&acc)[2][2][4][2], const Unit& u, int wr, int wc, int fr, int fq) const {
        const int pn = u.pn; constexpr bool meta = false;
        if (meta && (wr != 0 || pn < 2)) return;
        const int rbase = u.pm * BM + wr * 64 + fr;
        if (pn < 4) {
            const bool isq = pn < 2; const float* gp = isq ? qg : kg; const float osc = isq ? QSCALE : 1.f;
            f32x4 gv[2][2];
#pragma unroll
            for (int bj = 0; bj < 2; ++bj)
#pragma unroll
                for (int n = 0; n < 2; ++n) gv[bj][n] = *(const f32x4*)(gp + 32 * bj + 8 * fq + 4 * n);
            const int colb = (pn & 1) * 256 + wc * 64 + 8 * fq;
            bf16_t* dst = isq ? Q : K;
#pragma unroll
            for (int ai = 0; ai < 2; ++ai) {
                if (meta && ai) continue;
#pragma unroll
              for (int mh = 0; mh < 2; ++mh) {
                if (meta && mh) continue;
                f32x4 rv[2][4];
                if (fq < 2) {
#pragma unroll
                    for (int m2 = 0; m2 < 2; ++m2) { const int row = rbase + ai * HALF + (2 * mh + m2) * 16; const int pos = meta ? (row - XROWS) : ((row & 8191) + 16); const f32x4* rp = (const f32x4*)(rope + (size_t)pos * 16);
#pragma unroll
                        for (int k = 0; k < 4; ++k) rv[m2][k] = rp[k]; }
                }
                asm volatile("" ::: "memory");
#pragma unroll
                for (int m = 2 * mh; m < 2 * mh + 2; ++m) {
                    if (meta && m) continue;
                    const int row = rbase + ai * HALF + m * 16;
                    float ss = 0.f;
#pragma unroll
                    for (int bj = 0; bj < 2; ++bj)
#pragma unroll
                        for (int n = 0; n < 2; ++n) { const f32x4 x = acc[ai][bj][m][n]; ss += (x[0] * x[0] + x[1] * x[1]) + (x[2] * x[2] + x[3] * x[3]); }
                    ss += __shfl_xor(ss, 16); ss += __shfl_xor(ss, 32);
                    const float rs = __builtin_amdgcn_rsqf(ss * (1.0f / 64.0f) + 1e-6f);
                    f32x4 y00 = acc[ai][0][m][0] * rs * gv[0][0], y01 = acc[ai][0][m][1] * rs * gv[0][1], y10 = acc[ai][1][m][0] * rs * gv[1][0], y11 = acc[ai][1][m][1] * rs * gv[1][1];
                    const f32x4 p0 = shfl_xor4(y00, 16), p1 = shfl_xor4(y01, 16);
                    if (fq < 2) {
                        const f32x4 c0 = rv[m & 1][0], c1 = rv[m & 1][1], s0 = rv[m & 1][2], s1 = rv[m & 1][3];
                        const float sg = fq ? 1.f : -1.f;
                        y00 = y00 * c0 + (p0 * s0) * sg; y01 = y01 * c1 + (p1 * s1) * sg;
                    }
                    const u32x4 w0 = pack8(y00 * osc, y01 * osc), w1 = pack8(y10 * osc, y11 * osc);
                    if (!meta) {
                        const bool odd = (fr & 1) != 0; const int row_e = row - (odd ? 1 : 0);
                        const size_t orow = isq ? (size_t)row_e : (size_t)((row_e >> 13) * SPAD + 64 + (row_e & 8191));
                        const u32x4 rcv = swap_lane1(odd ? w0 : w1);
                        bf16_t* p = dst + orow * 512 + colb + (odd ? 32 : 0);
                        *(u32x4*)p = odd ? rcv : w0; *(u32x4*)(p + 512) = odd ? w1 : rcv;
                    } else {
#pragma unroll 1
                        for (int b = 0; b < 4; ++b) { const size_t orow = (size_t)(b * SPAD + fr); *(u32x4*)(dst + orow * 512 + colb) = w0; *(u32x4*)(dst + orow * 512 + colb + 32) = w1; }
                    }
                }
              }
            }
        } else if (pn < 6) {
            const int colb = (pn - 4) * 256 + wc * 64 + 8 * fq;
#pragma unroll
            for (int ai = 0; ai < 2; ++ai)
#pragma unroll
                for (int m = 0; m < 4; ++m) {
                    if (meta && (ai || m)) continue;
                    const int row = rbase + ai * HALF + m * 16;
                    const u32x4 w0 = pack8(acc[ai][0][m][0], acc[ai][0][m][1]), w1 = pack8(acc[ai][1][m][0], acc[ai][1][m][1]);
                    if (!meta) {
                        const bool odd = (fr & 1) != 0; const int row_e = row - (odd ? 1 : 0);
                        const size_t orow = (size_t)((row_e >> 13) * SPAD + 64 + (row_e & 8191));
                        const u32x4 rcv = swap_lane1(odd ? w0 : w1);
                        bf16_t* p = V + orow * 512 + colb + (odd ? 32 : 0);
                        *(u32x4*)p = odd ? rcv : w0; *(u32x4*)(p + 512) = odd ? w1 : rcv;
                    } else {
#pragma unroll 1
                        for (int b = 0; b < 4; ++b) { const size_t orow = (size_t)(b * SPAD + fr); *(u32x4*)(V + orow * 512 + colb) = w0; *(u32x4*)(V + orow * 512 + colb + HALF) = w1; }
                    }
                }
        } else {
            const int colb = (pn - 6) * 128 + wc * 32 + 8 * fq;
#pragma unroll
            for (int ai = 0; ai < 2; ++ai)
#pragma unroll
                for (int m = 0; m < 4; ++m) {
                    if (meta && (ai || m)) continue;
                    const int row = rbase + ai * HALF + m * 16;
                    f32x4 h[2];
#pragma unroll
                    for (int n = 0; n < 2; ++n) { const f32x4 a = acc[ai][0][m][n], g = acc[ai][1][m][n];
#pragma unroll
                        for (int e = 0; e < 4; ++e) h[n][e] = a[e] * __builtin_amdgcn_rcpf(1.0f + __builtin_amdgcn_exp2f(-1.4426950408889634f * g[e])); }
                    const u32x4 w0 = pack8(h[0], h[1]);
                    if (!meta) {
                        const size_t orow = (size_t)((row >> 13) * SPAD + 64 + (row & 8191));
                        *(u32x4*)(G + orow * 512 + colb) = w0;
                    } else {
#pragma unroll 1
                        for (int b = 0; b < 4; ++b) { const size_t orow = (size_t)(b * SPAD + 48 + fr); *(u32x4*)(G + orow * 512 + colb) = w0; }
                    }
                }
        }
    }
};
struct EpiOut {
    static constexpr bool PERM = true, AFTER_DRAIN = false;
    const bf16_t* xn; const float* rn; const float* g1; bf16_t* hb; float* ssq;
    __device__ __forceinline__ void operator()(const f32x4 (&acc)[2][2][4][2], const Unit& u, int wr, int wc, int fr, int fq) const {
        const int rbase = u.pm * BM + wr * 64 + fr, colb = u.pn * BM + wc * 64 + 8 * fq;
        const bool odd = (fr & 1) != 0;
        f32x4 ig[2][2];
#pragma unroll
        for (int bj = 0; bj < 2; ++bj)
#pragma unroll
            for (int n = 0; n < 2; ++n) { const f32x4 g = *(const f32x4*)(g1 + colb + bj * 32 + 4 * n);
#pragma unroll
                for (int e = 0; e < 4; ++e) ig[bj][n][e] = __builtin_amdgcn_rcpf(g[e]); }
#pragma unroll
        for (int ai = 0; ai < 2; ++ai) {
            u32x4 xv[4][2]; float rv[4];
#pragma unroll
            for (int m = 0; m < 4; ++m) { const int row = rbase + ai * HALF + m * 16; rv[m] = rn[row];
#pragma unroll
                for (int bj = 0; bj < 2; ++bj) xv[m][bj] = *(const u32x4*)(xn + (size_t)row * 1024 + colb + bj * 32); }
            asm volatile("" ::: "memory");
#pragma unroll
            for (int m = 0; m < 4; ++m) {
                const int row = rbase + ai * HALF + m * 16, row_e = row - (odd ? 1 : 0); float ss = 0.f;
                u32x4 wv[2];
#pragma unroll
                for (int bj = 0; bj < 2; ++bj) { const u32x4 w = xv[m][bj];
                    f32x4 x0, x1;
                    x0[0] = __uint_as_float(w.x << 16); x0[1] = __uint_as_float(w.x & 0xffff0000u); x0[2] = __uint_as_float(w.y << 16); x0[3] = __uint_as_float(w.y & 0xffff0000u);
                    x1[0] = __uint_as_float(w.z << 16); x1[1] = __uint_as_float(w.z & 0xffff0000u); x1[2] = __uint_as_float(w.w << 16); x1[3] = __uint_as_float(w.w & 0xffff0000u);
                    const f32x4 h0 = x0 * rv[m] * ig[bj][0] + acc[ai][bj][m][0], h1 = x1 * rv[m] * ig[bj][1] + acc[ai][bj][m][1];
                    wv[bj] = pack8(h0, h1);
                    ss += (h0[0] * h0[0] + h0[1] * h0[1]) + (h0[2] * h0[2] + h0[3] * h0[3]) + (h1[0] * h1[0] + h1[1] * h1[1]) + (h1[2] * h1[2] + h1[3] * h1[3]); }
                const u32x4 snd = odd ? wv[0] : wv[1]; u32x4 rcv;
                rcv.x = (unsigned)__builtin_amdgcn_update_dpp(0, (int)snd.x, 0xB1, 0xF, 0xF, true); rcv.y = (unsigned)__builtin_amdgcn_update_dpp(0, (int)snd.y, 0xB1, 0xF, 0xF, true);
                rcv.z = (unsigned)__builtin_amdgcn_update_dpp(0, (int)snd.z, 0xB1, 0xF, 0xF, true); rcv.w = (unsigned)__builtin_amdgcn_update_dpp(0, (int)snd.w, 0xB1, 0xF, 0xF, true);
                bf16_t* p = hb + (size_t)row_e * 1024 + colb + (odd ? 32 : 0);
                *(u32x4*)p = odd ? rcv : wv[0];
                *(u32x4*)(p + 1024) = odd ? wv[1] : rcv;
                ss += __shfl_xor(ss, 16); ss += __shfl_xor(ss, 32);
                if (fq == 0) ssq[(size_t)row * 16 + u.pn * 4 + wc] = ss;
            }
        }
    }
};
struct EpiUp {
    static constexpr bool PERM = true, AFTER_DRAIN = false;
    bf16_t* hb; const float* ssq;
    __device__ __forceinline__ void operator()(const f32x4 (&acc)[2][2][4][2], const Unit& u, int wr, int wc, int fr, int fq) const {
        const int rbase = u.pm * BM + wr * 64 + fr, colb = u.pn * BM + wc * 64 + 8 * fq;
        const bool odd = (fr & 1) != 0;
#pragma unroll
        for (int ai = 0; ai < 2; ++ai) {
            f32x4 sv[4][4];
#pragma unroll
            for (int m = 0; m < 4; ++m) { const f32x4* sp = (const f32x4*)(ssq + (size_t)(rbase + ai * HALF + m * 16) * 16);
#pragma unroll
                for (int k = 0; k < 4; ++k) sv[m][k] = sp[k]; }
            asm volatile("" ::: "memory");
#pragma unroll
            for (int m = 0; m < 4; ++m) {
                const int row = rbase + ai * HALF + m * 16, row_e = row - (odd ? 1 : 0);
                const f32x4 s0 = sv[m][0], s1 = sv[m][1], s2 = sv[m][2], s3 = sv[m][3];
                const float tot = ((s0[0] + s0[1]) + (s0[2] + s0[3])) + ((s1[0] + s1[1]) + (s1[2] + s1[3])) + ((s2[0] + s2[1]) + (s2[2] + s2[3])) + ((s3[0] + s3[1]) + (s3[2] + s3[3]));
                const float rs = __builtin_amdgcn_rsqf(tot * (1.0f / 1024.0f) + 1e-6f);
                u32x4 w[2];
#pragma unroll
                for (int bj = 0; bj < 2; ++bj) { f32x4 a0 = acc[ai][bj][m][0] * rs, a1 = acc[ai][bj][m][1] * rs;
#pragma unroll
                    for (int e = 0; e < 4; ++e) { const float p = fmaxf(a0[e], 0.f), q = fmaxf(a1[e], 0.f); a0[e] = p * p; a1[e] = q * q; }
                    w[bj] = pack8(a0, a1); }
                const u32x4 snd = odd ? w[0] : w[1]; u32x4 rcv;
                rcv.x = (unsigned)__builtin_amdgcn_update_dpp(0, (int)snd.x, 0xB1, 0xF, 0xF, true); rcv.y = (unsigned)__builtin_amdgcn_update_dpp(0, (int)snd.y, 0xB1, 0xF, 0xF, true);
                rcv.z = (unsigned)__builtin_amdgcn_update_dpp(0, (int)snd.z, 0xB1, 0xF, 0xF, true); rcv.w = (unsigned)__builtin_amdgcn_update_dpp(0, (int)snd.w, 0xB1, 0xF, 0xF, true);
                bf16_t* p = hb + (size_t)row_e * 4096 + colb + (odd ? 32 : 0);
                __builtin_nontemporal_store(odd ? rcv : w[0], (u32x4*)p);
                __builtin_nontemporal_store(odd ? w[1] : rcv, (u32x4*)(p + 4096));
            }
        }
    }
};
struct EpiDown {
    static constexpr bool PERM = false, AFTER_DRAIN = false;
    const bf16_t* h1; float* out;
    __device__ __forceinline__ void operator()(const f32x4 (&acc)[2][2][4][2], const Unit& u, int wr, int wc, int fr, int fq) const {
        typedef unsigned u32x2 __attribute__((ext_vector_type(2)));
        const int rbase = u.pm * BM + wr * 64 + fr, colb = u.pn * BM + wc * 32 + 4 * fq;
        const bool odd = (fr & 1) != 0;
#pragma unroll
        for (int ai = 0; ai < 2; ++ai) {
            u32x2 hv[4][2][2];
#pragma unroll
            for (int m = 0; m < 4; ++m)
#pragma unroll
                for (int bj = 0; bj < 2; ++bj)
#pragma unroll
                    for (int n = 0; n < 2; ++n) hv[m][bj][n] = *(const u32x2*)(h1 + (size_t)(rbase + ai * HALF + m * 16) * 1024 + colb + bj * HALF + 16 * n);
            asm volatile("" ::: "memory");
#pragma unroll
            for (int m = 0; m < 4; ++m) {
                const int row = rbase + ai * HALF + m * 16, row_e = row - (odd ? 1 : 0);
#pragma unroll
                for (int bj = 0; bj < 2; ++bj) {
                    f32x4 a[2];
#pragma unroll
                    for (int n = 0; n < 2; ++n) { const u32x2 w = hv[m][bj][n];
                        f32x4 r; r[0] = __uint_as_float(w.x << 16); r[1] = __uint_as_float(w.x & 0xffff0000u); r[2] = __uint_as_float(w.y << 16); r[3] = __uint_as_float(w.y & 0xffff0000u);
                        a[n] = r + acc[ai][bj][m][n]; }
                    const f32x4 snd = odd ? a[0] : a[1]; f32x4 rcv;
#pragma unroll
                    for (int e = 0; e < 4; ++e) rcv[e] = __int_as_float(__builtin_amdgcn_update_dpp(0, __float_as_int(snd[e]), 0xB1, 0xF, 0xF, true));
                    const size_t off = (size_t)row_e * 1024 + colb + bj * HALF + (odd ? 16 : 0);
                    __builtin_nontemporal_store(odd ? rcv : a[0], (f32x4*)(out + off));
                    __builtin_nontemporal_store(odd ? a[1] : rcv, (f32x4*)(out + off + 1024)); }
            }
        }
    }
};


template <class Epi, class Sched, bool ALIGN_EPI = false, bool SP2 = false>
__device__ __forceinline__ void gemm_phase(PG8_LAS unsigned char* lds, const Gemm g, const Sched& S, const Epi& E) {
    int tid_ = threadIdx.x; asm volatile("" : "+v"(tid_));
    const int tid = tid_, wid = __builtin_amdgcn_readfirstlane(tid >> 6), lane = tid & 63, wr = wid >> 2, wc = wid & 3, fr = lane & 15, fq = lane >> 4;
    const int K = g.K, nt = K / BK;
    unsigned voffA[2], voffB[2];
#pragma unroll
    for (int i = 0; i < 2; ++i) { int R, C; stage_rc(tid * 16 + i * 8192, R, C); const int Rb = Epi::PERM ? ((R & ~31) + perm32(R & 31)) : R;
        voffA[i] = (unsigned)(R * K + C) * 2u; voffB[i] = (unsigned)(Rb * K + C) * 2u; }
    const size_t kstep = (size_t)(BK * 2);
    const size_t hstep = (size_t)HALF * K * 2;
    const size_t tstep = 2 * hstep;
    const unsigned ldsw = (unsigned)wid * 1024u;
    const int aoff = lds_byte(wr * 64 + fr, fq * 8), boff = lds_byte(wc * 32 + fr, fq * 8);
#define PG8_SA(b, h) (((b) * 2 + (h)) * HTB)
#define PG8_SB(b, h) ((4 + (b) * 2 + (h)) * HTB)
#define PG8_STAGE(bufoff, gbase, voff) do { _Pragma("unroll") for (int _i = 0; _i < 2; ++_i) \
        __builtin_amdgcn_global_load_lds((const unsigned*)((const char*)(gbase) + (voff)[_i]), (PG8_LAS unsigned*)(lds + (bufoff) + ldsw + _i * 8192), 16, 0, 0); } while (0)
#define PG8_LDA(dst, b, h) do { _Pragma("unroll") for (int m = 0; m < 4; ++m) _Pragma("unroll") for (int k = 0; k < 2; ++k) dst[m][k] = *(const PG8_LAS bf16x8*)(lds + PG8_SA(b, h) + aoff + m * 2048 + k * 1024); } while (0)
#define PG8_LDB(dst, b, h) do { _Pragma("unroll") for (int n = 0; n < 2; ++n) _Pragma("unroll") for (int k = 0; k < 2; ++k) dst[n][k] = *(const PG8_LAS bf16x8*)(lds + PG8_SB(b, h) + boff + n * 2048 + k * 1024); } while (0)
#define PG8_MMA(ai, bj, At, Bt) do { __builtin_amdgcn_s_setprio(1); _Pragma("unroll") for (int m = 0; m < 4; ++m) _Pragma("unroll") for (int n = 0; n < 2; ++n) _Pragma("unroll") for (int k = 0; k < 2; ++k) \
        acc[ai][bj][m][n] = __builtin_amdgcn_mfma_f32_16x16x32_bf16(Bt[n][k], At[m][k], acc[ai][bj][m][n], 0, 0, 0); __builtin_amdgcn_s_setprio(0); } while (0)
#define PG8_WAIT_V(n) asm volatile("s_waitcnt vmcnt(" #n ")" ::: "memory")
#define PG8_WAIT_L(n) asm volatile("s_waitcnt lgkmcnt(" #n ")" ::: "memory")
#define PG8_BAR __builtin_amdgcn_s_barrier()
#define PG8_SCHED __builtin_amdgcn_sched_barrier(0)
    Unit cur, nxt; int ui = 0;
    if (!S.next(0, cur)) return;
    f32x4 acc[2][2][4][2];
#pragma unroll
    for (int a = 0; a < 2; ++a)
#pragma unroll
        for (int b = 0; b < 2; ++b)
#pragma unroll
            for (int m = 0; m < 4; ++m)
#pragma unroll
                for (int n = 0; n < 2; ++n) acc[a][b][m][n] = (f32x4){0.f, 0.f, 0.f, 0.f};
    bf16x8 At[4][2], B0[2][2], B1[2][2];
    const char* cA = (const char*)g.A + (size_t)cur.pm * tstep; const char* cB = (const char*)g.Bt + (size_t)cur.pn * tstep;
    S.a_ready(cur);
    if constexpr (SP2) {
        PG8_STAGE(PG8_SB(0, 0), cB, voffB); PG8_STAGE(PG8_SB(0, 1), cB + hstep, voffB); PG8_STAGE(PG8_SA(0, 0), cA, voffA); PG8_STAGE(PG8_SA(0, 1), cA + hstep, voffA);
        if (wr == 1) PG8_BAR;
        PG8_WAIT_V(2); PG8_BAR;
        PG8_STAGE(PG8_SB(1, 0), cB + kstep, voffB); PG8_STAGE(PG8_SA(1, 0), cA + kstep, voffA); PG8_STAGE(PG8_SB(1, 1), cB + hstep + kstep, voffB);
        PG8_WAIT_V(6); PG8_BAR;
    } else {
        PG8_STAGE(PG8_SB(0, 0), cB, voffB); PG8_STAGE(PG8_SA(0, 0), cA, voffA); PG8_STAGE(PG8_SB(0, 1), cB + hstep, voffB); PG8_STAGE(PG8_SA(0, 1), cA + hstep, voffA);
        if (wr == 1) PG8_BAR;
        PG8_WAIT_V(4); PG8_BAR;
        PG8_STAGE(PG8_SB(1, 0), cB + kstep, voffB); PG8_STAGE(PG8_SA(1, 0), cA + kstep, voffA); PG8_STAGE(PG8_SB(1, 1), cB + hstep + kstep, voffB);
        PG8_WAIT_V(6); PG8_BAR;
    }
    for (;;) {
        const bool has_next = S.next(ui + 1, nxt);
        const char* nA = has_next ? (const char*)g.A + (size_t)nxt.pm * tstep : cA; const char* nB = has_next ? (const char*)g.Bt + (size_t)nxt.pn * tstep : cB;
        for (int t = 0; t < nt; t += 2) {
            const bool last = (t == nt - 2);
            const char* a1 = cA + (size_t)(t + 1) * kstep;
            const char* a2 = last ? nA : cA + (size_t)(t + 2) * kstep; const char* b2 = last ? nB : cB + (size_t)(t + 2) * kstep;
            const char* a3 = a2 + kstep; const char* b3 = b2 + kstep;
            if (last && has_next) S.a_ready(nxt);
            if constexpr (SP2) {
            PG8_LDB(B0, 0, 0); PG8_LDB(B1, 0, 1); PG8_SCHED; PG8_LDA(At, 0, 0); PG8_STAGE(PG8_SA(1, 1), a1 + hstep, voffA);
            PG8_WAIT_V(8); PG8_WAIT_L(0); PG8_BAR; PG8_MMA(0, 0, At, B0); PG8_MMA(0, 1, At, B1); PG8_BAR; PG8_SCHED;
            PG8_LDA(At, 0, 1); PG8_STAGE(PG8_SB(0, 0), b2, voffB); PG8_STAGE(PG8_SB(0, 1), b2 + hstep, voffB); PG8_STAGE(PG8_SA(0, 0), a2, voffA);
            PG8_WAIT_V(8); PG8_WAIT_L(0); PG8_BAR; PG8_MMA(1, 0, At, B0); PG8_MMA(1, 1, At, B1); PG8_BAR; PG8_SCHED;
            PG8_LDB(B0, 1, 0); PG8_LDB(B1, 1, 1); PG8_SCHED; PG8_LDA(At, 1, 0); PG8_STAGE(PG8_SA(0, 1), a2 + hstep, voffA);
            PG8_WAIT_V(8); PG8_WAIT_L(0); PG8_BAR; PG8_MMA(0, 0, At, B0); PG8_MMA(0, 1, At, B1); PG8_BAR; PG8_SCHED;
            PG8_LDA(At, 1, 1); PG8_STAGE(PG8_SB(1, 0), b3, voffB); PG8_STAGE(PG8_SB(1, 1), b3 + hstep, voffB); PG8_STAGE(PG8_SA(1, 0), a3, voffA);
            PG8_WAIT_V(8); PG8_WAIT_L(0); PG8_BAR; PG8_MMA(1, 0, At, B0); PG8_MMA(1, 1, At, B1); PG8_BAR; PG8_SCHED;
            } else {
            PG8_LDB(B0, 0, 0); PG8_SCHED; PG8_LDA(At, 0, 0); PG8_STAGE(PG8_SA(1, 1), a1 + hstep, voffA);
            PG8_WAIT_L(8); PG8_BAR; PG8_WAIT_L(0); PG8_MMA(0, 0, At, B0); PG8_BAR; PG8_SCHED;
            PG8_LDB(B1, 0, 1); PG8_STAGE(PG8_SB(0, 0), b2, voffB);
            PG8_BAR; PG8_WAIT_L(0); PG8_MMA(0, 1, At, B1); PG8_BAR;
            PG8_LDA(At, 0, 1); PG8_STAGE(PG8_SA(0, 0), a2, voffA);
            PG8_BAR; PG8_WAIT_L(0); PG8_MMA(1, 0, At, B0); PG8_BAR; PG8_SCHED;
            PG8_STAGE(PG8_SB(0, 1), b2 + hstep, voffB);
            PG8_WAIT_V(6); PG8_BAR; PG8_MMA(1, 1, At, B1); PG8_BAR;
            PG8_LDB(B0, 1, 0); PG8_SCHED; PG8_LDA(At, 1, 0); PG8_STAGE(PG8_SA(0, 1), a2 + hstep, voffA);
            PG8_WAIT_L(8); PG8_BAR; PG8_WAIT_L(0); PG8_MMA(0, 0, At, B0); PG8_BAR; PG8_SCHED;
            PG8_LDB(B1, 1, 1); PG8_STAGE(PG8_SB(1, 0), b3, voffB);
            PG8_BAR; PG8_WAIT_L(0); PG8_MMA(0, 1, At, B1); PG8_BAR;
            PG8_LDA(At, 1, 1); PG8_STAGE(PG8_SA(1, 0), a3, voffA);
            PG8_BAR; PG8_WAIT_L(0); PG8_MMA(1, 0, At, B0); PG8_BAR; PG8_SCHED;
            PG8_STAGE(PG8_SB(1, 1), b3 + hstep, voffB);
            PG8_WAIT_V(6); PG8_BAR; PG8_MMA(1, 1, At, B1); PG8_BAR;
            }
        }
        if constexpr (ALIGN_EPI) { if (wr == 0) PG8_BAR; }
        if constexpr (!Epi::AFTER_DRAIN) { E(acc, cur, wr, wc, fr, fq); S.done(cur); }
        if (!has_next) break;
#pragma unroll
        for (int a = 0; a < 2; ++a)
#pragma unroll
            for (int b = 0; b < 2; ++b)
#pragma unroll
                for (int m = 0; m < 4; ++m)
#pragma unroll
                    for (int n = 0; n < 2; ++n) acc[a][b][m][n] = (f32x4){0.f, 0.f, 0.f, 0.f};
        cur = nxt; cA = nA; cB = nB; ++ui;
        if constexpr (ALIGN_EPI) { if (wr == 1) PG8_BAR; }
    }
    PG8_WAIT_V(0);
    if constexpr (!ALIGN_EPI) { if (wr == 0) PG8_BAR; }
    PG8_BAR;
    if constexpr (Epi::AFTER_DRAIN) { E.fused(acc, cur, wr, wc, fr, fq, lds, wid, lane); S.done(cur); }
#undef PG8_SA
#undef PG8_SB
#undef PG8_STAGE
#undef PG8_LDA
#undef PG8_LDB
#undef PG8_MMA
#undef PG8_WAIT_V
#undef PG8_WAIT_L
#undef PG8_BAR
#undef PG8_SCHED
}
}

#ifndef PG8_SP2
#define PG8_SP2 true
#endif
#ifndef PG8_ALIGN
#define PG8_ALIGN true
#endif
#include <hip/hip_bf16.h>
#include <cmath>
namespace attn_body {
using bf16=__hip_bfloat16;
using bf16x8=__attribute__((ext_vector_type(8)))short;
using s16x4=__attribute__((ext_vector_type(4)))short;
using f32x16=__attribute__((ext_vector_type(16)))float;
using u32x4=__attribute__((ext_vector_type(4)))unsigned;
constexpr int SEQ=8192,D=64,PQ=512,PO=1024;
constexpr int NW=8,QBLK=32,QB=QBLK*NW,KVBLK=64,NQB=SEQ/QB;
constexpr int ATTN_UNIT_ROWS=QB;
__device__ __forceinline__ int crow(int r,int hi){return (r&3)+8*(r>>2)+4*hi;}
#define SBAR() __builtin_amdgcn_sched_barrier(0)
__device__ __forceinline__ void cmask(f32x16&p0,f32x16&p1,int jb,int qrel,int hi){
  const float NEG=-INFINITY; int kb=64*jb+4*hi;
  #pragma unroll
  for(int r=0;r<16;++r){int kv=kb+(r&3)+8*(r>>2); if(kv>qrel)p0[r]=NEG; if(kv+32>qrel)p1[r]=NEG;}
}

constexpr int NSLOT=3, SLOTB=8192;
constexpr int LDS_K=0, LDS_V=NSLOT*SLOTB, LDS_WS=2*NSLOT*SLOTB, LDS_OST=LDS_WS+NW*64*4, LDS_BYTES=LDS_OST+NW*4096;
constexpr float C2=0.125f*1.4426950408889634f;
__device__ __forceinline__ void glds16(const void*gsrc,unsigned lds_dst){unsigned keep;
  asm volatile("s_mov_b32 %0, m0\n\ts_mov_b32 m0, %2\n\ts_nop 0\n\tglobal_load_lds_dwordx4 %1, off\n\ts_mov_b32 m0, %0":"=&s"(keep):"v"(gsrc),"s"(lds_dst):"memory");}
__device__ __forceinline__ float max3f(float a,float b,float c){float r;asm("v_max3_f32 %0, %1, %2, %3":"=v"(r):"v"(a),"v"(b),"v"(c));return r;}
__device__ __forceinline__ float max2f(float a,float b){float r;asm("v_max_f32_e32 %0, %1, %2":"=v"(r):"v"(a),"v"(b));return r;}
__device__ __forceinline__ float fadd_s(float a,float b){float r;asm("v_add_f32_e32 %0, %1, %2":"=v"(r):"v"(a),"v"(b));return r;}
__device__ __forceinline__ float fsub_s(float a,float b){float r;asm("v_sub_f32_e32 %0, %1, %2":"=v"(r):"v"(a),"v"(b));return r;}
typedef float f32x2_t __attribute__((ext_vector_type(2))); typedef __bf16 bf16x2_t __attribute__((ext_vector_type(2)));
__device__ __forceinline__ unsigned cvtpk_s(float lo,float hi){f32x2_t v={lo,hi};bf16x2_t b=__builtin_convertvector(v,bf16x2_t);return __builtin_bit_cast(unsigned,b);}
#define WAIT_BAR(N) asm volatile("s_waitcnt vmcnt(" #N ") lgkmcnt(0)\n\ts_barrier":::"memory")

__device__ __forceinline__ void qkt(f32x16&p0,f32x16&p1,const char*Kslot,const bf16x8*qr,const f32x16&negm,int r32,int hi){
  const char*kb=Kslot+hi*1024+r32*16;
  #pragma unroll
  for(int d0=0;d0<4;++d0){
    const bf16x8 b0=*reinterpret_cast<const bf16x8*>(kb+d0*2048);
    const bf16x8 b1=*reinterpret_cast<const bf16x8*>(kb+d0*2048+512);
    if(d0==0){p0=__builtin_amdgcn_mfma_f32_32x32x16_bf16(b0,qr[0],negm,0,0,0);p1=__builtin_amdgcn_mfma_f32_32x32x16_bf16(b1,qr[0],negm,0,0,0);}
    else{p0=__builtin_amdgcn_mfma_f32_32x32x16_bf16(b0,qr[d0],p0,0,0,0);p1=__builtin_amdgcn_mfma_f32_32x32x16_bf16(b1,qr[d0],p1,0,0,0);}}
}
typedef __attribute__((address_space(3))) const char* lds_cptr;
typedef short v4i16_t __attribute__((ext_vector_type(4)));
__device__ __forceinline__ void kload8(bf16x8*kf,lds_cptr kp){
  kf[0]=*(const __attribute__((address_space(3))) bf16x8*)(kp);      kf[1]=*(const __attribute__((address_space(3))) bf16x8*)(kp+512);
  kf[2]=*(const __attribute__((address_space(3))) bf16x8*)(kp+2048); kf[3]=*(const __attribute__((address_space(3))) bf16x8*)(kp+2560);
  kf[4]=*(const __attribute__((address_space(3))) bf16x8*)(kp+4096); kf[5]=*(const __attribute__((address_space(3))) bf16x8*)(kp+4608);
  kf[6]=*(const __attribute__((address_space(3))) bf16x8*)(kp+6144); kf[7]=*(const __attribute__((address_space(3))) bf16x8*)(kp+6656);
}
__device__ __forceinline__ void kload2(bf16x8*kf,lds_cptr kp,int j){ kf[2*j]=*(const __attribute__((address_space(3))) bf16x8*)(kp+j*2048); kf[2*j+1]=*(const __attribute__((address_space(3))) bf16x8*)(kp+j*2048+512); }
__device__ __forceinline__ s16x4 vtr(lds_cptr p){ return __builtin_bit_cast(s16x4,__builtin_amdgcn_ds_read_tr16_b64_v4i16((__attribute__((address_space(3))) v4i16_t*)p)); }
__device__ __forceinline__ float rowmax(const f32x16&p0,const f32x16&p1){
  float a=max3f(p0[0],p0[1],p1[0]),b=max3f(p0[2],p0[3],p1[1]);a=max3f(a,p1[2],p1[3]);
  #pragma unroll
  for(int r=4;r<16;r+=4){a=max3f(a,p0[r],p0[r+1]);b=max3f(b,p0[r+2],p0[r+3]);a=max3f(a,p1[r],p1[r+1]);b=max3f(b,p1[r+2],p1[r+3]);}
  const float m=max2f(a,b);
  auto rr=__builtin_amdgcn_permlane32_swap(__float_as_uint(m),__float_as_uint(m),false,false);
  return max2f(__uint_as_float(rr[0]),__uint_as_float(rr[1]));
}
__device__ __forceinline__ void pv(f32x16*o,int vb,bf16x8 pa0,bf16x8 pa1,bf16x8 pa2,bf16x8 pa3){
  #pragma unroll
  for(int d0=0;d0<2;++d0){s16x4 lo[4],hi[4];
    #pragma unroll
    for(int ks=0;ks<4;++ks){
      asm volatile("ds_read_b64_tr_b16 %0,%1 offset:%c2":"=&v"(lo[ks]):"v"(vb),"i"(d0*4096+ks*1024):"memory");
      asm volatile("ds_read_b64_tr_b16 %0,%1 offset:%c2":"=&v"(hi[ks]):"v"(vb),"i"(d0*4096+ks*1024+512):"memory");}
    asm volatile("s_waitcnt lgkmcnt(0)":::"memory");SBAR();
    #define PK(k) (bf16x8){lo[k][0],lo[k][1],lo[k][2],lo[k][3],hi[k][0],hi[k][1],hi[k][2],hi[k][3]}
    o[d0]=__builtin_amdgcn_mfma_f32_32x32x16_bf16(pa0,PK(0),o[d0],0,0,0);
    o[d0]=__builtin_amdgcn_mfma_f32_32x32x16_bf16(pa1,PK(1),o[d0],0,0,0);
    o[d0]=__builtin_amdgcn_mfma_f32_32x32x16_bf16(pa2,PK(2),o[d0],0,0,0);
    o[d0]=__builtin_amdgcn_mfma_f32_32x32x16_bf16(pa3,PK(3),o[d0],0,0,0);
    #undef PK
  }
}

#ifndef ATTN_STORE16
#define ATTN_STORE16(p,v) (*(u32x4*)(p)=(v))
#endif
template<int THRL> __device__ __forceinline__ void attn_unit(int q0,const bf16*Qu,const bf16*__restrict__ Kh,const bf16*__restrict__ Vh,bf16*Ou,char*shm){
  int tid_=threadIdx.x; asm volatile("":"+v"(tid_)); const int tid=tid_,lane=tid&63,r32=lane&31,hi=lane>>5; const int wid=__builtin_amdgcn_readfirstlane(tid>>6);
  const bf16*Qw=Qu+(long)(wid*QBLK)*PQ;
  const unsigned lds0=(unsigned)(uintptr_t)shm;
  float*wsf=(float*)(shm+LDS_WS)+wid*64;
  const bf16*ksrc=Kh+(long)lane*PQ+wid*8;
  const bf16*vsrc=Vh+(long)(16*(wid&3)+(lane>>2))*PQ+(wid>>2)*32+(lane&3)*8;
  const unsigned kdst=lds0+LDS_K+wid*1024, vdst=lds0+LDS_V+wid*1024;
  #define DMA_K(t,slot) glds16(ksrc+(long)(t)*KVBLK*PQ,(unsigned)__builtin_amdgcn_readfirstlane(kdst+(slot)))
  #define DMA_V(t,slot) glds16(vsrc+(long)(t)*KVBLK*PQ,(unsigned)__builtin_amdgcn_readfirstlane(vdst+(slot)))
  const int vb0=(int)(lds0+LDS_V)+((lane>>4)&1)*32+(lane&3)*8+(4*hi+((lane&15)>>2))*64;
  const char*Kbase=shm+LDS_K; bf16x8 kf[8];
  const lds_cptr shm3=(lds_cptr)shm; const lds_cptr kp0=shm3+LDS_K+hi*1024+r32*16; const lds_cptr vp0=shm3+LDS_V+((lane>>4)&1)*32+(lane&3)*8+(4*hi+((lane&15)>>2))*64;
  const int NT=(q0+QB)/KVBLK+1;
  DMA_K(0,0);DMA_V(0,0);DMA_K(1,SLOTB);
  bf16x8 qr[4];
  #pragma unroll
  for(int d0=0;d0<4;++d0)qr[d0]=*reinterpret_cast<const bf16x8*>(&Qw[(long)r32*PQ+d0*16+hi*8]);
  float mhat=0.f,l_reg=0.f;f32x16 o[2];o[0]=f32x16{};o[1]=f32x16{};f32x16 negm=f32x16{};asm volatile("":"+v"(negm));
  const int qrel=wid*QBLK+r32;
  #define CMASK(P0,P1,t) do{int jb_=(t)-(NT-4); if(jb_>=0)cmask(P0,P1,jb_,qrel,hi);}while(0)
  bool resc=false;
  #define START(P0,P1) do{ const float rm=rowmax(P0,P1); resc=false; \
    { const float dl=rm; mhat=fadd_s(mhat,dl); \
      _Pragma("unroll") for(int r=0;r<16;++r){P0[r]=fsub_s(P0[r],dl);P1[r]=fsub_s(P1[r],dl);} \
      _Pragma("unroll") for(int r=0;r<16;++r)negm[r]=-mhat; asm volatile("":"+v"(negm)); } \
    _Pragma("unroll") for(int r=0;r<16;++r)P0[r]=__builtin_amdgcn_exp2f(P0[r]); }while(0)
  #define RESC() do{ if(resc){ asm volatile("s_waitcnt lgkmcnt(0)":::"memory"); \
      _Pragma("unroll") for(int d_=0;d_<2;++d_) _Pragma("unroll") for(int r=0;r<16;++r)o[d_][r]*=wsf[crow(r,hi)]; } }while(0)
  f32x16 pA0,pA1,pB0,pB1;
  int sl_prev=0,sl_cur=0,sl_next=SLOTB;
  #define ROT() do{sl_prev=sl_cur;sl_cur=sl_next;sl_next=(sl_next==(NSLOT-1)*SLOTB)?0:sl_next+SLOTB;}while(0)
  DMA_K(2,2*SLOTB);
  WAIT_BAR(3);
  qkt(pA0,pA1,Kbase,qr,negm,r32,hi);asm volatile("s_nop 15\n\ts_nop 7":"+v"(pA0),"+v"(pA1));
  { const float NEGI=-INFINITY; _Pragma("unroll") for(int r=8;r<16;++r)pA0[r]=NEGI; _Pragma("unroll") for(int r=0;r<16;++r)pA1[r]=NEGI; }
  START(pA0,pA1);
  _Pragma("unroll") for(int r=0;r<16;++r)pA1[r]=__builtin_amdgcn_exp2f(pA1[r]);
  WAIT_BAR(0);
  DMA_K(3,0);DMA_V(1,SLOTB);
  ROT();
  kload8(kf,kp0+sl_cur);
  WAIT_BAR(2);
  s16x4 vlo[8],vhi[8]; u32x4 pw0,pw1,pw2,pw3;
  #define PKW(P,B) cvtpk_s(P[B],P[B+1])
  #define PAF(k) __builtin_bit_cast(bf16x8,pw##k)
  #define VFR(i) (bf16x8){vlo[i][0],vlo[i][1],vlo[i][2],vlo[i][3],vhi[i][0],vhi[i][1],vhi[i][2],vhi[i][3]}
  #define PIN(x) asm volatile("":"+v"(x))
  #define MX3(a,b,c) __builtin_fmaxf(__builtin_fmaxf((a),(b)),(c))
  #define GAPA(MF,A0,A1,A2,A3,W0,W1,PW) do{ MF; sacc+=A0; sacc+=A1; sacc+=A2; sacc+=A3; PIN(sacc); W0; W1; PIN(PW); SBAR(); }while(0)
  #define EX(v) __builtin_amdgcn_exp2f(v)
  #define GAPB(MF,X,B) do{ MF; X[B]=EX(X[B]); X[B+1]=EX(X[B+1]); X[B+2]=EX(X[B+2]); X[B+3]=EX(X[B+3]); PIN(X); SBAR(); }while(0)
  #define VRD(i) do{ vlo[i]=vtr(vp_+(((i)>>2)*4096+((i)&3)*1024)); vhi[i]=vtr(vp_+(((i)>>2)*4096+((i)&3)*1024+512)); }while(0)
  #define KRD(G,j) do{ if(G){ kload2(kf,kp0+sl_next,j); SBAR(); } }while(0)
  #define STEP(C0,C1,P0,P1,t,GK,GV,GL) do{ SBAR(); \
    const lds_cptr vp_=vp0+sl_prev; \
    VRD(0); SBAR(); float sacc=(P0[0]+P0[1]); \
    GAPA(C0=__builtin_amdgcn_mfma_f32_32x32x16_bf16(kf[0],qr[0],negm,0,0,0), P0[2],P0[3],P0[4],P0[5],     pw0[0]=PKW(P0,0), pw0[1]=PKW(P0,2), pw0); \
    VRD(4); SBAR(); GAPA(C1=__builtin_amdgcn_mfma_f32_32x32x16_bf16(kf[1],qr[0],negm,0,0,0), P0[6],P0[7],P0[8],P0[9],     pw0[2]=PKW(P0,4), pw0[3]=PKW(P0,6), pw0); \
    VRD(1); SBAR(); GAPA(C0=__builtin_amdgcn_mfma_f32_32x32x16_bf16(kf[2],qr[1],C0,0,0,0),   P0[10],P0[11],P0[12],P0[13], pw1[0]=PKW(P0,8), pw1[1]=PKW(P0,10), pw1); \
    VRD(5); SBAR(); GAPA(C1=__builtin_amdgcn_mfma_f32_32x32x16_bf16(kf[3],qr[1],C1,0,0,0),   P0[14],P0[15],P1[0],P1[1],   pw1[2]=PKW(P0,12),pw1[3]=PKW(P0,14), pw1); \
    VRD(2); SBAR(); GAPA(C0=__builtin_amdgcn_mfma_f32_32x32x16_bf16(kf[4],qr[2],C0,0,0,0),   P1[2],P1[3],P1[4],P1[5],     pw2[0]=PKW(P1,0), pw2[1]=PKW(P1,2), pw2); \
    VRD(6); SBAR(); GAPA(C1=__builtin_amdgcn_mfma_f32_32x32x16_bf16(kf[5],qr[2],C1,0,0,0),   P1[6],P1[7],P1[8],P1[9],     pw2[2]=PKW(P1,4), pw2[3]=PKW(P1,6), pw2); \
    VRD(3); SBAR(); GAPA(C0=__builtin_amdgcn_mfma_f32_32x32x16_bf16(kf[6],qr[3],C0,0,0,0),   P1[10],P1[11],P1[12],P1[13], pw3[0]=PKW(P1,8), pw3[1]=PKW(P1,10), pw3); \
    VRD(7); SBAR(); GAPA(C1=__builtin_amdgcn_mfma_f32_32x32x16_bf16(kf[7],qr[3],C1,0,0,0),   P1[14],P1[15],0.f,0.f,       pw3[2]=PKW(P1,12),pw3[3]=PKW(P1,14), pw3); \
    l_reg+=sacc; \
    if(GK){DMA_K((t)+3,sl_cur);} if(GV){DMA_V((t)+1,sl_next);} \
    CMASK(C0,C1,t); \
    { float a=MX3(C0[0],C0[1],C1[0]),b=MX3(C0[2],C0[3],C1[1]); a=MX3(a,C1[2],C1[3]); \
      _Pragma("unroll") for(int r=4;r<16;r+=4){a=MX3(a,C0[r],C0[r+1]);b=MX3(b,C0[r+2],C0[r+3]);a=MX3(a,C1[r],C1[r+1]);b=MX3(b,C1[r+2],C1[r+3]);} \
      float rm=__builtin_fmaxf(a,b); { auto rr=__builtin_amdgcn_permlane32_swap(__float_as_uint(rm),__float_as_uint(rm),false,false); rm=__builtin_fmaxf(__uint_as_float(rr[0]),__uint_as_float(rr[1])); } \
      resc=false; \
      if(__builtin_expect(__any(rm>(float)THRL),0)){ const float dl=__builtin_fmaxf(rm,0.f); mhat+=dl; \
        _Pragma("unroll") for(int r=0;r<16;++r){C0[r]-=dl;C1[r]-=dl;} \
        _Pragma("unroll") for(int r=0;r<16;++r)negm[r]=-mhat; asm volatile("":"+v"(negm)); \
        const float f=__builtin_amdgcn_exp2f(-dl); l_reg*=f; if(hi==0)wsf[r32]=f; resc=true; } } \
    SBAR(); \
    GAPB(o[0]=__builtin_amdgcn_mfma_f32_32x32x16_bf16(PAF(0),VFR(0),o[0],0,0,0), C0,0); \
    GAPB(o[1]=__builtin_amdgcn_mfma_f32_32x32x16_bf16(PAF(0),VFR(4),o[1],0,0,0), C0,4); \
    KRD(GL,0); GAPB(o[0]=__builtin_amdgcn_mfma_f32_32x32x16_bf16(PAF(1),VFR(1),o[0],0,0,0), C0,8); \
    KRD(GL,1); GAPB(o[1]=__builtin_amdgcn_mfma_f32_32x32x16_bf16(PAF(1),VFR(5),o[1],0,0,0), C0,12); \
    KRD(GL,2); GAPB(o[0]=__builtin_amdgcn_mfma_f32_32x32x16_bf16(PAF(2),VFR(2),o[0],0,0,0), C1,0); \
    KRD(GL,3); GAPB(o[1]=__builtin_amdgcn_mfma_f32_32x32x16_bf16(PAF(2),VFR(6),o[1],0,0,0), C1,4); \
    GAPB(o[0]=__builtin_amdgcn_mfma_f32_32x32x16_bf16(PAF(3),VFR(3),o[0],0,0,0), C1,8); \
    GAPB(o[1]=__builtin_amdgcn_mfma_f32_32x32x16_bf16(PAF(3),VFR(7),o[1],0,0,0), C1,12); \
    }while(0)
  int t=1;
  #undef CMASK
  #define CMASK(P0,P1,t) do{}while(0)
  for(;t+5<NT;t+=2){
    STEP(pB0,pB1,pA0,pA1,t,true,true,true);     WAIT_BAR(2); RESC(); ROT();
    STEP(pA0,pA1,pB0,pB1,t+1,true,true,true);   WAIT_BAR(2); RESC(); ROT();
  }
  #undef CMASK
  #define CMASK(P0,P1,t) do{int jb_=(t)-(NT-4); if(jb_>=0)cmask(P0,P1,jb_,qrel,hi);}while(0)
  #define ENDW(tt) do{ if((tt)+3<NT){WAIT_BAR(2);} else if((tt)+2<NT){WAIT_BAR(1);} else {WAIT_BAR(0);} }while(0)
  for(;t+1<NT;t+=2){
    STEP(pB0,pB1,pA0,pA1,t,(t+3<NT),(t+1<NT),(t+1<NT));       ENDW(t);   RESC(); ROT();
    STEP(pA0,pA1,pB0,pB1,t+1,(t+4<NT),(t+2<NT),(t+2<NT));     ENDW(t+1); RESC(); ROT();
  }
  { float sacc=pA0[0]+pA0[1]; _Pragma("unroll") for(int r=2;r<16;++r)sacc+=pA0[r]; _Pragma("unroll") for(int r=0;r<16;++r)sacc+=pA1[r]; l_reg+=sacc;
    pw0=(u32x4){PKW(pA0,0),PKW(pA0,2),PKW(pA0,4),PKW(pA0,6)};pw1=(u32x4){PKW(pA0,8),PKW(pA0,10),PKW(pA0,12),PKW(pA0,14)};pw2=(u32x4){PKW(pA1,0),PKW(pA1,2),PKW(pA1,4),PKW(pA1,6)};pw3=(u32x4){PKW(pA1,8),PKW(pA1,10),PKW(pA1,12),PKW(pA1,14)};
    SBAR(); pv(o,vb0+sl_prev,PAF(0),PAF(1),PAF(2),PAF(3)); }
  #undef PKW
  #undef PAF
  #undef VFR
  #undef PIN
  #undef MX3
  #undef GAPA
  #undef GAPB
  #undef EX
  #undef VRD
  #undef KRD
  #undef STEP
  #undef ENDW
  {auto rr=__builtin_amdgcn_permlane32_swap(__float_as_uint(l_reg),__float_as_uint(l_reg),false,false);l_reg=__uint_as_float(rr[0])+__uint_as_float(rr[1]);}
  if(hi==0)wsf[32+r32]=l_reg;asm volatile("s_waitcnt lgkmcnt(0)":::"memory");
  float rli[16];
  #pragma unroll
  for(int r=0;r<16;++r)rli[r]=__builtin_amdgcn_rcpf(wsf[32+crow(r,hi)]);
  bf16*Ow=Ou+(long)(wid*QBLK)*PO;
  { bf16*stg=(bf16*)(shm+LDS_OST)+wid*2048;
    #pragma unroll
    for(int r=0;r<16;++r){const int orow=crow(r,hi);
      #pragma unroll
      for(int d0=0;d0<2;++d0)stg[orow*64+d0*32+r32]=__float2bfloat16(o[d0][r]*rli[r]);}
    asm volatile("s_waitcnt lgkmcnt(0)":::"memory");
    #pragma unroll
    for(int i=0;i<4;++i){const int row=i*8+(lane>>3),ch=lane&7; const u32x4 v=*(const u32x4*)(stg+row*64+ch*8); ATTN_STORE16(Ow+(long)row*PO+ch*8,v);} }
  asm volatile("s_waitcnt lgkmcnt(0)\n\ts_barrier":::"memory");
  #undef DMA_K
  #undef DMA_V
  #undef CMASK
  #undef START
  #undef RESC
  #undef ROT
}
constexpr int ATTN_LDS_BYTES=LDS_BYTES;
#undef SBAR
#undef WAIT_BAR
typedef float f32x4v __attribute__((ext_vector_type(4)));
constexpr int V2_SLOTV=16384, V2_LDS_K=0, V2_LDS_V=NSLOT*SLOTB, V2_LDS_WS=V2_LDS_V+NSLOT*V2_SLOTV, V2_LDS_OST=V2_LDS_WS+NW*64*4, V2_LDS_BYTES=V2_LDS_OST+NW*8192;
#define SBAR() __builtin_amdgcn_sched_barrier(0)
#define WAIT_BAR(N) asm volatile("s_waitcnt vmcnt(" #N ") lgkmcnt(0)\n\ts_barrier":::"memory")
__device__ __forceinline__ void pv4(f32x16*o,int vb,bf16x8 pa0,bf16x8 pa1,bf16x8 pa2,bf16x8 pa3){
  #pragma unroll
  for(int d0=0;d0<4;++d0){s16x4 lo[4],hi[4];
    #pragma unroll
    for(int ks=0;ks<4;++ks){
      asm volatile("ds_read_b64_tr_b16 %0,%1 offset:%c2":"=&v"(lo[ks]):"v"(vb),"i"(d0*4096+ks*1024):"memory");
      asm volatile("ds_read_b64_tr_b16 %0,%1 offset:%c2":"=&v"(hi[ks]):"v"(vb),"i"(d0*4096+ks*1024+512):"memory");}
    asm volatile("s_waitcnt lgkmcnt(0)":::"memory");SBAR();
    #define PK(k) (bf16x8){lo[k][0],lo[k][1],lo[k][2],lo[k][3],hi[k][0],hi[k][1],hi[k][2],hi[k][3]}
    o[d0]=__builtin_amdgcn_mfma_f32_32x32x16_bf16(pa0,PK(0),o[d0],0,0,0);
    o[d0]=__builtin_amdgcn_mfma_f32_32x32x16_bf16(pa1,PK(1),o[d0],0,0,0);
    o[d0]=__builtin_amdgcn_mfma_f32_32x32x16_bf16(pa2,PK(2),o[d0],0,0,0);
    o[d0]=__builtin_amdgcn_mfma_f32_32x32x16_bf16(pa3,PK(3),o[d0],0,0,0);
    #undef PK
  }
}
template<int MODE> __device__ __forceinline__ void attn_unit128(int q0,const bf16*Qu,const bf16*__restrict__ Kh,const bf16*__restrict__ Vh,bf16*Ou,char*shm,float lam,float oscale,const float*subg){
  int tid_=threadIdx.x; asm volatile("":"+v"(tid_)); const int tid=tid_,lane=tid&63,r32=lane&31,hi=lane>>5; const int wid=__builtin_amdgcn_readfirstlane(tid>>6);
  const bf16*Qw=Qu+(long)(wid*QBLK)*PQ;
  const unsigned lds0=(unsigned)(uintptr_t)shm;
  float*wsf=(float*)(shm+V2_LDS_WS)+wid*64;
  const bf16*ksrc=Kh+(long)lane*PQ+wid*8;
  const bf16*vsrc=Vh+(long)(16*(wid&3)+(lane>>2))*PQ+(wid>>2)*32+(lane&3)*8;
  const unsigned kdst=lds0+V2_LDS_K+wid*1024, vdst=lds0+V2_LDS_V+wid*1024;
  #define DMA_K(t,slot) glds16(ksrc+(long)(t)*KVBLK*PQ,(unsigned)__builtin_amdgcn_readfirstlane(kdst+(slot)))
  #define DMA_V(t,slot) do{ glds16(vsrc+(long)(t)*KVBLK*PQ,(unsigned)__builtin_amdgcn_readfirstlane(vdst+2*(slot))); glds16(vsrc+(long)(t)*KVBLK*PQ+64,(unsigned)__builtin_amdgcn_readfirstlane(vdst+2*(slot)+8192)); }while(0)
  const int vb0=(int)(lds0+V2_LDS_V)+((lane>>4)&1)*32+(lane&3)*8+(4*hi+((lane&15)>>2))*64;
  const char*Kbase=shm+V2_LDS_K; bf16x8 kf[8];
  const lds_cptr shm3=(lds_cptr)shm; const lds_cptr kp0=shm3+V2_LDS_K+hi*1024+r32*16; const lds_cptr vp0=shm3+V2_LDS_V+((lane>>4)&1)*32+(lane&3)*8+(4*hi+((lane&15)>>2))*64;
  const int NT=(q0+QB)/KVBLK+1;
  DMA_K(0,0);DMA_V(0,0);DMA_K(1,SLOTB);
  bf16x8 qr[4];
  #pragma unroll
  for(int d0=0;d0<4;++d0)qr[d0]=*reinterpret_cast<const bf16x8*>(&Qw[(long)r32*PQ+d0*16+hi*8]);
  float l_reg=0.f;f32x16 o[4];o[0]=f32x16{};o[1]=f32x16{};o[2]=f32x16{};o[3]=f32x16{};
  const f32x16 zero16=f32x16{};
  const int qrel=wid*QBLK+r32;
  #define CMASK(P0,P1,t) do{int jb_=(t)-(NT-4); if(jb_>=0)cmask(P0,P1,jb_,qrel,hi);}while(0)
  f32x16 pA0,pA1,pB0,pB1;
  int sl_prev=0,sl_cur=0,sl_next=SLOTB;
  #define ROT() do{sl_prev=sl_cur;sl_cur=sl_next;sl_next=(sl_next==(NSLOT-1)*SLOTB)?0:sl_next+SLOTB;}while(0)
  DMA_K(2,2*SLOTB);
  WAIT_BAR(3);
  qkt(pA0,pA1,Kbase,qr,zero16,r32,hi);asm volatile("s_nop 15\n\ts_nop 7":"+v"(pA0),"+v"(pA1));
  { const float NEGI=-INFINITY; _Pragma("unroll") for(int r=8;r<16;++r)pA0[r]=NEGI; _Pragma("unroll") for(int r=0;r<16;++r)pA1[r]=NEGI; }
  _Pragma("unroll") for(int r=0;r<16;++r){pA0[r]=__builtin_amdgcn_exp2f(pA0[r]);pA1[r]=__builtin_amdgcn_exp2f(pA1[r]);}
  WAIT_BAR(0);
  DMA_K(3,0);DMA_V(1,SLOTB);
  ROT();
  kload8(kf,kp0+sl_cur);
  WAIT_BAR(3);
  s16x4 vlo[8],vhi[8]; u32x4 pw0,pw1,pw2,pw3;
  #define PKW(P,B) cvtpk_s(P[B],P[B+1])
  #define PAF(k) __builtin_bit_cast(bf16x8,pw##k)
  #define VFR(i) (bf16x8){vlo[i][0],vlo[i][1],vlo[i][2],vlo[i][3],vhi[i][0],vhi[i][1],vhi[i][2],vhi[i][3]}
  #define PIN(x) asm volatile("":"+v"(x))
  #define GAPA(MF,A0,A1,A2,A3,W0,W1,PW) do{ MF; sacc+=A0; sacc+=A1; sacc+=A2; sacc+=A3; PIN(sacc); W0; W1; PIN(PW); SBAR(); }while(0)
  #define EX(v) __builtin_amdgcn_exp2f(v)
  #define GAPB(MF,X,B) do{ MF; X[B]=EX(X[B]); X[B+1]=EX(X[B+1]); PIN(X); SBAR(); }while(0)
  #define VRD(i) do{ vlo[i]=vtr(vp_+(((i)>>2)*4096+((i)&3)*1024)); vhi[i]=vtr(vp_+(((i)>>2)*4096+((i)&3)*1024+512)); }while(0)
  #define VRD2(i) do{ vlo[i]=vtr(vp_+(8192+((i)>>2)*4096+((i)&3)*1024)); vhi[i]=vtr(vp_+(8192+((i)>>2)*4096+((i)&3)*1024+512)); SBAR(); }while(0)
  #define KRD(G,j) do{ if(G){ kload2(kf,kp0+sl_next,j); SBAR(); } }while(0)
  #define MF32(a,b,c) __builtin_amdgcn_mfma_f32_32x32x16_bf16(a,b,c,0,0,0)
  #define STEP(C0,C1,P0,P1,t,GK,GV,GL) do{ SBAR(); \
    const lds_cptr vp_=vp0+2*sl_prev; \
    VRD(0); SBAR(); float sacc=(P0[0]+P0[1]); \
    GAPA(C0=MF32(kf[0],qr[0],zero16), P0[2],P0[3],P0[4],P0[5],     pw0[0]=PKW(P0,0), pw0[1]=PKW(P0,2), pw0); \
    VRD(4); SBAR(); GAPA(C1=MF32(kf[1],qr[0],zero16), P0[6],P0[7],P0[8],P0[9],     pw0[2]=PKW(P0,4), pw0[3]=PKW(P0,6), pw0); \
    VRD(1); SBAR(); GAPA(C0=MF32(kf[2],qr[1],C0),   P0[10],P0[11],P0[12],P0[13], pw1[0]=PKW(P0,8), pw1[1]=PKW(P0,10), pw1); \
    VRD(5); SBAR(); GAPA(C1=MF32(kf[3],qr[1],C1),   P0[14],P0[15],P1[0],P1[1],   pw1[2]=PKW(P0,12),pw1[3]=PKW(P0,14), pw1); \
    VRD(2); SBAR(); GAPA(C0=MF32(kf[4],qr[2],C0),   P1[2],P1[3],P1[4],P1[5],     pw2[0]=PKW(P1,0), pw2[1]=PKW(P1,2), pw2); \
    VRD(6); SBAR(); GAPA(C1=MF32(kf[5],qr[2],C1),   P1[6],P1[7],P1[8],P1[9],     pw2[2]=PKW(P1,4), pw2[3]=PKW(P1,6), pw2); \
    VRD(3); SBAR(); GAPA(C0=MF32(kf[6],qr[3],C0),   P1[10],P1[11],P1[12],P1[13], pw3[0]=PKW(P1,8), pw3[1]=PKW(P1,10), pw3); \
    VRD(7); SBAR(); GAPA(C1=MF32(kf[7],qr[3],C1),   P1[14],P1[15],0.f,0.f,       pw3[2]=PKW(P1,12),pw3[3]=PKW(P1,14), pw3); \
    l_reg+=sacc; \
    if(GK){DMA_K((t)+3,sl_cur);} if(GV){DMA_V((t)+1,sl_next);} \
    CMASK(C0,C1,t); \
    SBAR(); \
    GAPB(o[0]=MF32(PAF(0),VFR(0),o[0]), C0,0);  VRD2(0); \
    GAPB(o[1]=MF32(PAF(0),VFR(4),o[1]), C0,2);  VRD2(4); \
    KRD(GL,0); GAPB(o[0]=MF32(PAF(1),VFR(1),o[0]), C0,4);  VRD2(1); \
    KRD(GL,1); GAPB(o[1]=MF32(PAF(1),VFR(5),o[1]), C0,6);  VRD2(5); \
    KRD(GL,2); GAPB(o[0]=MF32(PAF(2),VFR(2),o[0]), C0,8);  VRD2(2); \
    KRD(GL,3); GAPB(o[1]=MF32(PAF(2),VFR(6),o[1]), C0,10); VRD2(6); \
    GAPB(o[0]=MF32(PAF(3),VFR(3),o[0]), C0,12); VRD2(3); \
    GAPB(o[1]=MF32(PAF(3),VFR(7),o[1]), C0,14); VRD2(7); \
    GAPB(o[2]=MF32(PAF(0),VFR(0),o[2]), C1,0); \
    GAPB(o[3]=MF32(PAF(0),VFR(4),o[3]), C1,2); \
    GAPB(o[2]=MF32(PAF(1),VFR(1),o[2]), C1,4); \
    GAPB(o[3]=MF32(PAF(1),VFR(5),o[3]), C1,6); \
    GAPB(o[2]=MF32(PAF(2),VFR(2),o[2]), C1,8); \
    GAPB(o[3]=MF32(PAF(2),VFR(6),o[3]), C1,10); \
    GAPB(o[2]=MF32(PAF(3),VFR(3),o[2]), C1,12); \
    GAPB(o[3]=MF32(PAF(3),VFR(7),o[3]), C1,14); \
    }while(0)
  int t=1;
  #undef CMASK
  #define CMASK(P0,P1,t) do{}while(0)
  for(;t+5<NT;t+=2){
    STEP(pB0,pB1,pA0,pA1,t,true,true,true);     WAIT_BAR(3); ROT();
    STEP(pA0,pA1,pB0,pB1,t+1,true,true,true);   WAIT_BAR(3); ROT();
  }
  #undef CMASK
  #define CMASK(P0,P1,t) do{int jb_=(t)-(NT-4); if(jb_>=0)cmask(P0,P1,jb_,qrel,hi);}while(0)
  #define ENDW(tt) do{ if((tt)+3<NT){WAIT_BAR(3);} else if((tt)+2<NT){WAIT_BAR(2);} else {WAIT_BAR(0);} }while(0)
  for(;t+1<NT;t+=2){
    STEP(pB0,pB1,pA0,pA1,t,(t+3<NT),(t+1<NT),(t+1<NT));       ENDW(t);   ROT();
    STEP(pA0,pA1,pB0,pB1,t+1,(t+4<NT),(t+2<NT),(t+2<NT));     ENDW(t+1); ROT();
  }
  { float sacc=pA0[0]+pA0[1]; _Pragma("unroll") for(int r=2;r<16;++r)sacc+=pA0[r]; _Pragma("unroll") for(int r=0;r<16;++r)sacc+=pA1[r]; l_reg+=sacc;
    pw0=(u32x4){PKW(pA0,0),PKW(pA0,2),PKW(pA0,4),PKW(pA0,6)};pw1=(u32x4){PKW(pA0,8),PKW(pA0,10),PKW(pA0,12),PKW(pA0,14)};pw2=(u32x4){PKW(pA1,0),PKW(pA1,2),PKW(pA1,4),PKW(pA1,6)};pw3=(u32x4){PKW(pA1,8),PKW(pA1,10),PKW(pA1,12),PKW(pA1,14)};
    SBAR(); pv4(o,vb0+2*sl_prev,PAF(0),PAF(1),PAF(2),PAF(3)); }
  #undef PKW
  #undef PAF
  #undef VFR
  #undef PIN
  #undef GAPA
  #undef GAPB
  #undef EX
  #undef VRD
  #undef VRD2
  #undef KRD
  #undef MF32
  #undef STEP
  #undef ENDW
  {auto rr=__builtin_amdgcn_permlane32_swap(__float_as_uint(l_reg),__float_as_uint(l_reg),false,false);l_reg=__uint_as_float(rr[0])+__uint_as_float(rr[1]);}
  if(hi==0)wsf[32+r32]=l_reg;asm volatile("s_waitcnt lgkmcnt(0)":::"memory");
  float rli[16];
  #pragma unroll
  for(int r=0;r<16;++r)rli[r]=__builtin_amdgcn_rcpf(wsf[32+crow(r,hi)]);
  { bf16*park=(bf16*)(shm+V2_LDS_OST)+wid*4096;
    if(MODE==0){
      #pragma unroll
      for(int r=0;r<16;++r){const int orow=crow(r,hi);
        #pragma unroll
        for(int d0=0;d0<4;++d0)park[orow*128+d0*32+r32]=__float2bfloat16(o[d0][r]*rli[r]);}
      asm volatile("s_waitcnt lgkmcnt(0)":::"memory");
    } else {
      #pragma unroll
      for(int r=0;r<16;++r){const int orow=crow(r,hi);
        #pragma unroll
        for(int d0=0;d0<4;++d0){const float o1=__bfloat162float(park[orow*128+d0*32+r32]); park[orow*128+d0*32+r32]=__float2bfloat16(o1-lam*(o[d0][r]*rli[r]));}}
      asm volatile("s_waitcnt lgkmcnt(0)":::"memory");
      bf16*Ow=Ou+(long)(wid*QBLK)*PO;
      const int ch=lane&15; const f32x4v g0=*(const f32x4v*)(subg+8*ch), g1=*(const f32x4v*)(subg+8*ch+4);
      #pragma unroll
      for(int i=0;i<8;++i){const int row=i*4+(lane>>4); const u32x4 v=*(const u32x4*)(park+row*128+ch*8);
        float d[8]; d[0]=__uint_as_float(v.x<<16);d[1]=__uint_as_float(v.x&0xffff0000u);d[2]=__uint_as_float(v.y<<16);d[3]=__uint_as_float(v.y&0xffff0000u);d[4]=__uint_as_float(v.z<<16);d[5]=__uint_as_float(v.z&0xffff0000u);d[6]=__uint_as_float(v.w<<16);d[7]=__uint_as_float(v.w&0xffff0000u);
        float ss=(d[0]*d[0]+d[1]*d[1])+(d[2]*d[2]+d[3]*d[3])+(d[4]*d[4]+d[5]*d[5])+(d[6]*d[6]+d[7]*d[7]);
        ss+=__shfl_xor(ss,1);ss+=__shfl_xor(ss,2);ss+=__shfl_xor(ss,4);ss+=__shfl_xor(ss,8);
        const float rs=__builtin_amdgcn_rsqf(ss*(1.0f/128.0f)+1e-6f)*oscale;
        u32x4 w; w.x=cvtpk_s(d[0]*rs*g0[0],d[1]*rs*g0[1]); w.y=cvtpk_s(d[2]*rs*g0[2],d[3]*rs*g0[3]); w.z=cvtpk_s(d[4]*rs*g1[0],d[5]*rs*g1[1]); w.w=cvtpk_s(d[6]*rs*g1[2],d[7]*rs*g1[3]);
        ATTN_STORE16(Ow+(long)row*PO+ch*8,w);}
      asm volatile("s_waitcnt lgkmcnt(0)":::"memory");
    } }
  asm volatile("s_waitcnt lgkmcnt(0)\n\ts_barrier":::"memory");
  #undef DMA_K
  #undef DMA_V
  #undef CMASK
  #undef ROT
}
#undef SBAR
#undef WAIT_BAR

}
namespace cg = cooperative_groups;
constexpr int NWAVES = 8;
constexpr int NB = 4, SEQ = 8192, DM = 1024, NMETA = 16, DIN = 2560, DFF = 4096, DCONV = 512, CONVW = 31;
constexpr int MX = NB * SEQ;
constexpr int MP = MX + 256;
constexpr int SPAD = pg8::SPAD;
constexpr float EPS = 1e-6f;
constexpr size_t MiB = 1u << 20;
constexpr size_t WS_CTL = 0, WS_WIN = 1 * MiB, WS_WOUT = 6 * MiB, WS_WUP = 8 * MiB, WS_WDN = 16 * MiB, WS_ROPE = 24 * MiB, WS_SSQ = 25 * MiB, WS_RN = 27 * MiB,
                 WS_H1B = 28 * MiB, WS_MIX = 92 * MiB, WS_HB = 156 * MiB, WS_XN = 156 * MiB, WS_O = 156 * MiB, WS_Q = 222 * MiB, WS_K = 254 * MiB, WS_V = 287 * MiB, WS_G = 320 * MiB,
                 WS_END = 412 * MiB;
static_assert(WS_XN + (size_t)MP * DM * 2 <= WS_Q && WS_K + (size_t)NB * SPAD * 512 * 2 <= WS_V && WS_G + (size_t)NB * SPAD * 512 * 2 <= WS_HB + (size_t)MX * DFF * 2 && WS_HB + (size_t)MX * DFF * 2 <= WS_END, "d_ws map");
constexpr int RING_BYTES = 131072, LDS_BYTES = 147456;
#ifndef WGM_P1
#define WGM_P1 4
#endif
#ifndef WGM_P4
#define WGM_P4 4
#endif
#ifndef WGM_P35
#define WGM_P35 4
#endif

#define LAS __attribute__((address_space(3)))
typedef unsigned short bf16;
typedef unsigned v4u __attribute__((ext_vector_type(4)));
typedef float f32x4 __attribute__((ext_vector_type(4)));
typedef float f32x2 __attribute__((ext_vector_type(2)));
#define LDS_WAIT() asm volatile("s_waitcnt lgkmcnt(0)" ::: "memory")
__device__ __forceinline__ unsigned pk2(float lo, float hi) { return pg8::cvt_pk_bf16(lo, hi); }
__device__ __forceinline__ float bf_lo(unsigned u) { return __uint_as_float(u << 16); }
__device__ __forceinline__ float bf_hi(unsigned u) { return __uint_as_float(u & 0xffff0000u); }
__device__ __forceinline__ float wave_sum(float v) {
#pragma unroll
    for (int o = 1; o < 64; o <<= 1) v += __shfl_xor(v, o);
    return v;
}

#define XB_TMO      128
#define XB_XCNT(j)  (256  + 64 * (j))
#define XB_XSUB(j)  (1280 + 64 * (j))
#define XB_XGEN(j)  (2304 + 64 * (j))
#define XB_TOP      3328
#define XB_TOPGEN   3392
#define XCD_BAR_WORDS 3456
#define XB_SPIN_CAP (1u << 18)

__device__ __forceinline__ unsigned xb_ld(unsigned* p)              { return __hip_atomic_load(p, __ATOMIC_RELAXED, __HIP_MEMORY_SCOPE_AGENT); }
__device__ __forceinline__ unsigned xb_add(unsigned* p, unsigned v) { return __hip_atomic_fetch_add(p, v, __ATOMIC_RELAXED, __HIP_MEMORY_SCOPE_AGENT); }
__device__ __forceinline__ unsigned xb_xcc_id() { return (unsigned)__builtin_amdgcn_s_getreg((3 << 11) | 20) & 0xFu; }
#define XB_SPIN(cond, bar) do { unsigned _sp = 0; while (cond) { __builtin_amdgcn_s_sleep(1); \
    if ((++_sp & 255u) == 0u) { if (xb_ld(&(bar)[XB_TMO])) break; if (_sp > XB_SPIN_CAP) { atomicAdd(&(bar)[XB_TMO], 1u); break; } } } } while (0)

struct XcdBarrier {
    unsigned* bar; unsigned x;
    volatile LAS unsigned* st;
};

__device__ __forceinline__ XcdBarrier xcd_barrier_post(unsigned* bar, volatile LAS unsigned* st) {
    XcdBarrier b; b.bar = bar; b.x = xb_xcc_id(); b.st = st;
    if (threadIdx.x == 0) (void)xb_add(&bar[XB_XCNT(b.x)], 1u);
    return b;
}
__device__ __forceinline__ void xcd_barrier_complete(unsigned* bar, unsigned x, unsigned& nloc, unsigned& nx) {
    const unsigned G = gridDim.x * gridDim.y * gridDim.z;
    unsigned sum, cnt, mine, sp = 0u;
    for (;;) {
        sum = 0u; cnt = 0u; mine = 0u;
#pragma unroll
        for (unsigned j = 0; j < 16; ++j) { const unsigned c = xb_ld(&bar[XB_XCNT(j)]); sum += c; cnt += (c > 0u) ? 1u : 0u; mine = (j == x) ? c : mine; }
        if (sum == G) break;
        __builtin_amdgcn_s_sleep(1);
        if ((++sp & 255u) == 0u) { if (xb_ld(&bar[XB_TMO])) break; if (sp > XB_SPIN_CAP) { atomicAdd(&bar[XB_TMO], 1u); break; } }
    }
    nloc = mine > 0u ? mine : 1u; nx = cnt > 0u ? cnt : 1u;
}

__device__ __forceinline__ void xcd_barrier(const XcdBarrier& b) {
    asm volatile("s_waitcnt vmcnt(0)" ::: "memory");
    __syncthreads();
    if (threadIdx.x == 0) {
        unsigned* bar = b.bar;
        __builtin_amdgcn_s_waitcnt(0);
        unsigned nloc = b.st[0], nx = b.st[1];
        if (nloc == 0u) { xcd_barrier_complete(bar, b.x, nloc, nx); b.st[0] = nloc; b.st[1] = nx; }
        const unsigned old = xb_add(&bar[XB_XSUB(b.x)], 1u);
        const unsigned gen = old / nloc;
        if (old + 1u == (gen + 1u) * nloc) {
            __builtin_amdgcn_fence(__ATOMIC_RELEASE, "agent");
            asm volatile("s_waitcnt vmcnt(0)" ::: "memory");
            const unsigned og = xb_add(&bar[XB_TOP], 1u);
            const unsigned tg = og / nx;
            if (og + 1u == (tg + 1u) * nx) xb_add(&bar[XB_TOPGEN], 1u);
            else XB_SPIN(xb_ld(&bar[XB_TOPGEN]) == tg, bar);
            __builtin_amdgcn_fence(__ATOMIC_ACQUIRE, "agent");
            xb_add(&bar[XB_XGEN(b.x)], 1u);
            asm volatile("s_waitcnt vmcnt(0)" ::: "memory");
        } else {
            XB_SPIN(xb_ld(&bar[XB_XGEN(b.x)]) == gen, bar);
            __builtin_amdgcn_fence(__ATOMIC_ACQUIRE, "agent");
            asm volatile("s_waitcnt vmcnt(0)" ::: "memory");
        }
    }
    __syncthreads();
}

__device__ __forceinline__ float dpp_add(float v, const int ctrl_sel) {
    int t;
    if (ctrl_sel == 0) t = __builtin_amdgcn_update_dpp(0, __float_as_int(v), 0xB1, 0xF, 0xF, true);
    else if (ctrl_sel == 1) t = __builtin_amdgcn_update_dpp(0, __float_as_int(v), 0x4E, 0xF, 0xF, true);
    else if (ctrl_sel == 2) t = __builtin_amdgcn_update_dpp(0, __float_as_int(v), 0x141, 0xF, 0xF, true);
    else t = __builtin_amdgcn_update_dpp(0, __float_as_int(v), 0x140, 0xF, 0xF, true);
    return v + __int_as_float(t);
}
__device__ __forceinline__ float wave_sum_fast(float v) {
    v = dpp_add(v, 0); v = dpp_add(v, 1); v = dpp_add(v, 2); v = dpp_add(v, 3);
    { auto rr = __builtin_amdgcn_permlane16_swap(__float_as_uint(v), __float_as_uint(v), false, false); v = __uint_as_float(rr[0]) + __uint_as_float(rr[1]); }
    { auto rr = __builtin_amdgcn_permlane32_swap(__float_as_uint(v), __float_as_uint(v), false, false); v = __uint_as_float(rr[0]) + __uint_as_float(rr[1]); }
    return v;
}

struct Args { const float* in[19]; float* out; unsigned char* ws; float inv_freq[8]; };
enum { I_X = 0, I_META, I_G1, I_WIN, I_QG, I_KG, I_LQ1, I_LK1, I_LQ2, I_LK2, I_SUBLN, I_CW, I_CB, I_CLG, I_CLB, I_WOUT, I_G2, I_WUP, I_WDN };

__device__ __forceinline__ void p0_transpose_item(const float* W, int K, int N, bf16* WT, int out_row0, int n0, int k0, const float* kscale, LAS float* scr, int lane) {
    float tv[32], ts[32];
#pragma unroll
    for (int i = 0; i < 32; ++i) { const int kk = 2 * i + (lane >> 5); tv[i] = W[(size_t)(k0 + kk) * N + n0 + (lane & 31)]; ts[i] = kscale ? kscale[k0 + kk] : 1.0f; }
#pragma unroll
    for (int i = 0; i < 32; ++i) { const int kk = 2 * i + (lane >> 5); scr[kk * 33 + (lane & 31)] = tv[i] * ts[i]; }
    LDS_WAIT(); asm volatile("" ::: "memory");
    const int c = lane & 7;
#pragma unroll
    for (int j = 0; j < 4; ++j) { const int n = (lane >> 3) + 8 * j; const LAS float* s = scr + (8 * c) * 33 + n;
        v4u o; o.x = pk2(s[0 * 33], s[1 * 33]); o.y = pk2(s[2 * 33], s[3 * 33]); o.z = pk2(s[4 * 33], s[5 * 33]); o.w = pk2(s[6 * 33], s[7 * 33]);
        *(v4u*)(WT + (size_t)(out_row0 + n) * K + k0 + 8 * c) = o; }
    LDS_WAIT(); asm volatile("" ::: "memory");
}
__device__ __forceinline__ int wup_pcol(int lc) { const int l = lc & 255; return (lc & ~255) + 128 * ((l >> 5) & 1) + 32 * (l >> 6); }
__device__ __forceinline__ int win_pcol(int lc) {
    if (lc < 1536) { const int l = lc & 255; return (lc & ~255) + 128 * ((l >> 5) & 1) + 32 * (l >> 6) + (l & 31); }
    if (lc < 2048) { const int ch = lc - 1536; return 1536 + 256 * (ch >> 7) + (ch & 127); }
    const int ch = lc - 2048; return 1536 + 256 * (ch >> 7) + 128 + (ch & 127);
}

__device__ __forceinline__ void p0_prologue(const Args& A, unsigned char* ws, LAS unsigned char* lds, int vcu, int G, int wave, int lane) {
    LAS float* scr = (LAS float*)(lds + wave * 16384);
    const int gw = vcu * NWAVES + wave, NGW = G * NWAVES;
    bf16* Win_t = (bf16*)(ws + WS_WIN); bf16* Wout_t = (bf16*)(ws + WS_WOUT); bf16* Wup_t = (bf16*)(ws + WS_WUP); bf16* Wdn_t = (bf16*)(ws + WS_WDN);
    constexpr int I_IN = (DM / 64) * (DIN / 32);
    for (int it = gw; it < I_IN; it += NGW) { const int nblk = DIN / 32, kb = it / nblk, nb = it % nblk; p0_transpose_item(A.in[I_WIN], DM, DIN, Win_t, win_pcol(32 * nb), 32 * nb, 64 * kb, nullptr, scr, lane); }
    {
        bf16* XN = (bf16*)(ws + WS_XN);
        f32x4 g[4];
#pragma unroll
        for (int j = 0; j < 4; ++j) g[j] = ((const f32x4*)A.in[I_G1])[lane + 64 * j];
        for (int m0 = gw; m0 < MX + NMETA; m0 += 4 * NGW) {
            f32x4 v[4][4];
#pragma unroll
            for (int q = 0; q < 4; ++q) { const int m = m0 + q * NGW; const bool ok = m < MX + NMETA;
                const float* src = !ok ? A.in[I_X] : (m < MX) ? A.in[I_X] + (size_t)m * DM : A.in[I_META] + (size_t)(m - MX) * DM;
                const f32x4* xr = (const f32x4*)src + lane;
#pragma unroll
                for (int j = 0; j < 4; ++j) v[q][j] = __builtin_nontemporal_load(xr + 64 * j); }
#pragma unroll
            for (int q = 0; q < 4; ++q) { const int m = m0 + q * NGW; if (m >= MX + NMETA) continue;
                float s = 0.f;
#pragma unroll
                for (int j = 0; j < 4; ++j) s += (v[q][j].x * v[q][j].x + v[q][j].y * v[q][j].y) + (v[q][j].z * v[q][j].z + v[q][j].w * v[q][j].w);
                const float ms = wave_sum_fast(s) * (1.f / DM) + EPS; const float rs = __builtin_amdgcn_rsqf(ms);
                if (lane == 0 && m < MX) ((float*)(ws + WS_RN))[m] = ms * rs;
                unsigned long long* o8 = (unsigned long long*)(XN + (size_t)m * DM) + lane;
#pragma unroll
                for (int j = 0; j < 4; ++j) { const f32x4 y = v[q][j] * rs * g[j]; o8[64 * j] = (unsigned long long)pk2(y.x, y.y) | ((unsigned long long)pk2(y.z, y.w) << 32); } }
        }
    }
    {
        float* rope = (float*)(ws + WS_ROPE);
        const int pos = gw * 64 + lane;
        if (pos < SEQ + NMETA) {
#pragma unroll
            for (int i = 0; i < 8; ++i) {
                const float angf = (float)pos * A.inv_freq[i];
                const double rev = (double)angf * 0.15915494309189533577; const double fr = rev - __builtin_rint(rev);
                const float f = (float)fr;
                rope[pos * 16 + i] = __builtin_amdgcn_cosf(f); rope[pos * 16 + 8 + i] = __builtin_amdgcn_sinf(f); } }
    }
    {
        bf16* KB = (bf16*)(ws + WS_K); bf16* VB = (bf16*)(ws + WS_V); bf16* GB = (bf16*)(ws + WS_G);
        for (int it = gw; it < NB * 48 * 3; it += NGW) { const int which = it / (NB * 48), r = it % (NB * 48), b = r / 48, rr = r % 48;
            bf16* p = which == 0 ? KB + (size_t)(b * SPAD + 16 + rr) * 512 : which == 1 ? VB + (size_t)(b * SPAD + 16 + rr) * 512 : GB + (size_t)(b * SPAD + rr) * 512;
            ((v4u*)p)[lane] = (v4u){0u, 0u, 0u, 0u}; }
    }
}

__device__ __forceinline__ void meta_proj(const Args& A, unsigned char* ws, LAS unsigned char* lds, int vcu, int wave, int lane) {
    typedef short bf16x8 __attribute__((ext_vector_type(8)));
    const int fr = lane & 15, fq = lane >> 4;
    const int item = vcu * 2 + (wave >> 2), kc = wave & 3;
    const int kind = item < 8 ? 0 : item < 16 ? 1 : 2, g = kind == 2 ? item - 16 : (item & 7);
    const bf16* XNm = (const bf16*)(ws + WS_XN) + (size_t)(MX + fr) * DM + 8 * fq + 256 * kc;
    const bf16* Wt = (const bf16*)(ws + WS_WIN);
    const bf16* brow[4];
#pragma unroll
    for (int nb = 0; nb < 4; ++nb) { const int lc = kind == 0 ? 512 + 64 * g + 16 * nb + fr : kind == 1 ? 1024 + 64 * g + 16 * nb + fr : (nb < 2 ? 1536 + 32 * g + 16 * nb + fr : 2048 + 32 * g + 16 * (nb - 2) + fr);
        brow[nb] = Wt + (size_t)(win_pcol(lc & ~31) + (lc & 31)) * DM + 8 * fq + 256 * kc; }
    bf16x8 af[8], bf[8][4];
#pragma unroll
    for (int ks = 0; ks < 8; ++ks) { af[ks] = *(const bf16x8*)(XNm + 32 * ks);
#pragma unroll
        for (int nb = 0; nb < 4; ++nb) bf[ks][nb] = *(const bf16x8*)(brow[nb] + 32 * ks); }
    asm volatile("" ::: "memory");
    f32x4 acc[4];
#pragma unroll
    for (int nb = 0; nb < 4; ++nb) acc[nb] = (f32x4){0.f, 0.f, 0.f, 0.f};
#pragma unroll
    for (int ks = 0; ks < 8; ++ks)
#pragma unroll
        for (int nb = 0; nb < 4; ++nb) acc[nb] = __builtin_amdgcn_mfma_f32_16x16x32_bf16(bf[ks][nb], af[ks], acc[nb], 0, 0, 0);
    LAS f32x4* red = (LAS f32x4*)lds;
#pragma unroll
    for (int nb = 0; nb < 4; ++nb) red[(wave * 4 + nb) * 64 + lane] = acc[nb];
    __syncthreads();
    if (kc == 0) {
#pragma unroll
        for (int nb = 0; nb < 4; ++nb) acc[nb] = (red[((wave + 0) * 4 + nb) * 64 + lane] + red[((wave + 1) * 4 + nb) * 64 + lane]) + (red[((wave + 2) * 4 + nb) * 64 + lane] + red[((wave + 3) * 4 + nb) * 64 + lane]);
        if (kind == 0) {
            float ss = 0.f;
#pragma unroll
            for (int nb = 0; nb < 4; ++nb) ss += (acc[nb][0] * acc[nb][0] + acc[nb][1] * acc[nb][1]) + (acc[nb][2] * acc[nb][2] + acc[nb][3] * acc[nb][3]);
            ss += __shfl_xor(ss, 16); ss += __shfl_xor(ss, 32);
            const float rs = __builtin_amdgcn_rsqf(ss * (1.0f / 64.0f) + EPS);
#pragma unroll
            for (int nb = 0; nb < 4; ++nb) acc[nb] = acc[nb] * rs * *(const f32x4*)(A.in[I_KG] + 16 * nb + 4 * fq);
            f32x4 p; p[0] = __shfl_xor(acc[0][0], 32); p[1] = __shfl_xor(acc[0][1], 32); p[2] = __shfl_xor(acc[0][2], 32); p[3] = __shfl_xor(acc[0][3], 32);
            const float* rp = (const float*)(ws + WS_ROPE) + fr * 16 + 4 * (fq & 1);
            const f32x4 c = *(const f32x4*)rp, s = *(const f32x4*)(rp + 8);
            const float sg = (fq & 2) ? 1.f : -1.f;
            acc[0] = acc[0] * c + (p * s) * sg;
        }
        if (kind == 2) {
#pragma unroll
            for (int nb = 0; nb < 2; ++nb)
#pragma unroll
                for (int e = 0; e < 4; ++e) acc[nb][e] = acc[nb][e] * __builtin_amdgcn_rcpf(1.0f + __builtin_amdgcn_exp2f(-1.4426950408889634f * acc[nb + 2][e]));
        }
        bf16* dst = kind == 0 ? (bf16*)(ws + WS_K) : kind == 1 ? (bf16*)(ws + WS_V) : (bf16*)(ws + WS_G);
        const int r0 = kind == 2 ? 48 + fr : fr, c0 = (kind == 2 ? 32 * g : 64 * g) + 4 * fq, nnb = kind == 2 ? 2 : 4;
#pragma unroll 1
        for (int b = 0; b < NB; ++b) { bf16* o = dst + (size_t)(b * SPAD + r0) * 512 + c0;
#pragma unroll
            for (int nb = 0; nb < 4; ++nb) if (nb < nnb) *(unsigned long long*)(o + 16 * nb) = (unsigned long long)pk2(acc[nb][0], acc[nb][1]) | ((unsigned long long)pk2(acc[nb][2], acc[nb][3]) << 32); }
    }
    __syncthreads();
}

__device__ __forceinline__ void wconv_phase(const Args& A, unsigned char* ws, LAS unsigned char* lds, int wave, int lane) {
    LAS float* scr = (LAS float*)(lds + wave * 16384);
    bf16* Wout_t = (bf16*)(ws + WS_WOUT); bf16* Wup_t = (bf16*)(ws + WS_WUP); bf16* Wdn_t = (bf16*)(ws + WS_WDN);
    constexpr int I_OUT = (DM / 64) * (DM / 32), I_UP = (DM / 64) * (DFF / 32), I_DN = (DFF / 64) * (DM / 32), NIT = I_OUT + I_UP + I_DN;
    unsigned* wq = (unsigned*)(ws + WS_CTL) + 96;
    volatile LAS unsigned* TK = (volatile LAS unsigned*)(lds + LDS_BYTES - 256 + 64);
    for (;;) {
        if (wave == 0 && lane == 0) TK[0] = __hip_atomic_fetch_add(wq, 1u, __ATOMIC_RELAXED, __HIP_MEMORY_SCOPE_AGENT);
        __syncthreads();
        const int t = (int)TK[0];
        __syncthreads();
        if (t * NWAVES >= NIT) break;
        int r = t * NWAVES + wave;
        if (r >= NIT) continue;
        if (r < I_OUT) { const int nblk = DM / 32, kb = r / nblk, nb = r % nblk; p0_transpose_item(A.in[I_WOUT], DM, DM, Wout_t, wup_pcol(32 * nb), 32 * nb, 64 * kb, nullptr, scr, lane); continue; } r -= I_OUT;
        if (r < I_UP) { const int nblk = DFF / 32, kb = r / nblk, nb = r % nblk; p0_transpose_item(A.in[I_WUP], DM, DFF, Wup_t, wup_pcol(32 * nb), 32 * nb, 64 * kb, A.in[I_G2], scr, lane); continue; } r -= I_UP;
        { const int nblk = DM / 32, kb = r / nblk, nb = r % nblk; p0_transpose_item(A.in[I_WDN], DFF, DM, Wdn_t, 32 * nb, 32 * nb, 64 * kb, nullptr, scr, lane); }
    }
}

constexpr int CONV_R = 32;
__device__ __forceinline__ void conv_phase(const Args& A, unsigned char* ws, LAS unsigned char* lds, int vcu, int G, int wave, int lane) {
    LAS float* cbuf = (LAS float*)lds;
    const bf16* GB = (const bf16*)(ws + WS_G); bf16* MIX = (bf16*)(ws + WS_MIX);
    const int cp = (wave & 3) * 64 + lane, half = wave >> 2;
    f32x2 w[CONVW];
#pragma unroll
    for (int j = 0; j < CONVW; ++j) w[j] = *(const f32x2*)(A.in[I_CW] + j * DCONV + 2 * cp);
    const f32x2 bias = *(const f32x2*)(A.in[I_CB] + 2 * cp);
    const f32x4 lg0 = *(const f32x4*)(A.in[I_CLG] + lane * 8), lg1 = *(const f32x4*)(A.in[I_CLG] + lane * 8 + 4), lb0 = *(const f32x4*)(A.in[I_CLB] + lane * 8), lb1 = *(const f32x4*)(A.in[I_CLB] + lane * 8 + 4);
    constexpr int NITEMS = MX / (2 * CONV_R);
    unsigned* cq = (unsigned*)(ws + WS_CTL) + 32;
    volatile LAS unsigned* TK = (volatile LAS unsigned*)(lds + LDS_BYTES - 256 + 64);
    if (wave == 0 && lane == 0) { TK[0] = __hip_atomic_fetch_add(cq, 1u, __ATOMIC_RELAXED, __HIP_MEMORY_SCOPE_AGENT); TK[1] = __hip_atomic_fetch_add(cq, 1u, __ATOMIC_RELAXED, __HIP_MEMORY_SCOPE_AGENT); }
    __syncthreads();
    int it = (int)TK[0], nxt = (int)TK[1];
    __syncthreads();
#define CONV_SRC(item, sub) (GB + (size_t)(((((item) * 2 * CONV_R + half * CONV_R + (sub) * 16) >> 13) * SPAD) + 34 + (((item) * 2 * CONV_R + half * CONV_R + (sub) * 16) & 8191)) * 512 + 2 * cp)
#define CONV_LOAD(buf, item, sub) do { const bf16* gs_ = CONV_SRC(item, sub); _Pragma("unroll") for (int i = 0; i < 46; ++i) buf[i] = *(const unsigned*)(gs_ + (size_t)i * 512); } while (0)
#define CONV_FMA(buf, sub) do { f32x2 acc[16]; _Pragma("unroll") for (int o = 0; o < 16; ++o) acc[o] = bias; \
        _Pragma("unroll") for (int i = 0; i < 46; ++i) { const f32x2 x = {bf_lo(buf[i]), bf_hi(buf[i])}; _Pragma("unroll") for (int o = 0; o < 16; ++o) { const int j = i - o; if (j >= 0 && j < CONVW) acc[o] += w[j] * x; } } \
        _Pragma("unroll") for (int o = 0; o < 16; ++o) *(LAS f32x2*)(cbuf + (half * CONV_R + (sub) * 16 + o) * DCONV + 2 * cp) = acc[o]; } while (0)
    unsigned bufA[46], bufB[46];
    if (it < NITEMS) CONV_LOAD(bufA, it, 0);
#pragma unroll 1
    while (it < NITEMS) {
        if (wave == 0 && lane == 0) TK[0] = __hip_atomic_fetch_add(cq, 1u, __ATOMIC_RELAXED, __HIP_MEMORY_SCOPE_AGENT);
        CONV_LOAD(bufB, it, 1);
        CONV_FMA(bufA, 0);
        if (nxt < NITEMS) CONV_LOAD(bufA, nxt, 0);
        CONV_FMA(bufB, 1);
        __syncthreads();
        const int nn = (int)TK[0];
#pragma unroll
        for (int rr = 0; rr < 8; ++rr) { const int lr = wave * 8 + rr;
            f32x4 x0 = *(const LAS f32x4*)(cbuf + lr * DCONV + lane * 8), x1 = *(const LAS f32x4*)(cbuf + lr * DCONV + lane * 8 + 4);
            const float mu = wave_sum_fast((x0[0] + x0[1]) + (x0[2] + x0[3]) + (x1[0] + x1[1]) + (x1[2] + x1[3])) * (1.f / DCONV);
            x0 = x0 - mu; x1 = x1 - mu;
            const float var = wave_sum_fast((x0[0] * x0[0] + x0[1] * x0[1]) + (x0[2] * x0[2] + x0[3] * x0[3]) + (x1[0] * x1[0] + x1[1] * x1[1]) + (x1[2] * x1[2] + x1[3] * x1[3])) * (1.f / DCONV);
            const float rs = __builtin_amdgcn_rsqf(var + EPS);
            x0 = x0 * rs * lg0 + lb0; x1 = x1 * rs * lg1 + lb1;
#pragma unroll
            for (int e = 0; e < 4; ++e) { x0[e] = x0[e] * __builtin_amdgcn_rcpf(1.0f + __builtin_amdgcn_exp2f(-1.4426950408889634f * x0[e])); x1[e] = x1[e] * __builtin_amdgcn_rcpf(1.0f + __builtin_amdgcn_exp2f(-1.4426950408889634f * x1[e])); }
            *(v4u*)(MIX + (size_t)(it * 2 * CONV_R + lr) * DM + 512 + lane * 8) = pg8::pack8(x0, x1); }
        __syncthreads();
        it = nxt; nxt = nn;
    }
#undef CONV_SRC
#undef CONV_LOAD
#undef CONV_FMA
}

__device__ __forceinline__ void combine_phase(const Args& A, unsigned char* ws, int vcu, int G, int wave, int lane) {
    const bf16* OB = (const bf16*)(ws + WS_O); bf16* MIX = (bf16*)(ws + WS_MIX);
    const float d1 = wave_sum(A.in[I_LQ1][lane] * A.in[I_LK1][lane]), d2 = wave_sum(A.in[I_LQ2][lane] * A.in[I_LK2][lane]);
    const float lam_init = 0.2f;
    const float lam = __builtin_amdgcn_exp2f(d1 * 1.4426950408889634f) - __builtin_amdgcn_exp2f(d2 * 1.4426950408889634f) + lam_init;
    const int h = lane >> 4, q = lane & 15;
    const f32x4 sg0 = *(const f32x4*)(A.in[I_SUBLN] + 8 * q), sg1 = *(const f32x4*)(A.in[I_SUBLN] + 8 * q + 4);
    const int gw = vcu * NWAVES + wave, NGW = G * NWAVES;
    for (int row = gw; row < MX; row += NGW) {
        const bf16* o1 = OB + (size_t)row * 1024 + h * 256 + 8 * q;
        const v4u a = *(const v4u*)o1, bq = *(const v4u*)(o1 + 128);
        f32x4 d0, d1v;
        d0[0] = bf_lo(a.x) - lam * bf_lo(bq.x); d0[1] = bf_hi(a.x) - lam * bf_hi(bq.x); d0[2] = bf_lo(a.y) - lam * bf_lo(bq.y); d0[3] = bf_hi(a.y) - lam * bf_hi(bq.y);
        d1v[0] = bf_lo(a.z) - lam * bf_lo(bq.z); d1v[1] = bf_hi(a.z) - lam * bf_hi(bq.z); d1v[2] = bf_lo(a.w) - lam * bf_lo(bq.w); d1v[3] = bf_hi(a.w) - lam * bf_hi(bq.w);
        float ss = (d0[0] * d0[0] + d0[1] * d0[1]) + (d0[2] * d0[2] + d0[3] * d0[3]) + (d1v[0] * d1v[0] + d1v[1] * d1v[1]) + (d1v[2] * d1v[2] + d1v[3] * d1v[3]);
        ss += __shfl_xor(ss, 1); ss += __shfl_xor(ss, 2); ss += __shfl_xor(ss, 4); ss += __shfl_xor(ss, 8);
        const float rs = __builtin_amdgcn_rsqf(ss * (1.f / 128.f) + EPS) * (1.0f - lam_init);
        *(v4u*)(MIX + (size_t)row * DM + h * 128 + 8 * q) = pg8::pack8(d0 * rs * sg0, d1v * rs * sg1);
    }
}

__global__ void __launch_bounds__(NWAVES * 64, 2) hymba_fwd(Args args) {
    extern __shared__ __attribute__((aligned(16))) unsigned char lds[];
    cg::grid_group grid = cg::this_grid();
    LAS unsigned char* ldsl = (LAS unsigned char*)lds;
    volatile LAS unsigned* MISC = (volatile LAS unsigned*)(ldsl + LDS_BYTES - 256);
    if (threadIdx.x < 32) MISC[threadIdx.x] = 0u;
    __syncthreads();
    const XcdBarrier bar = xcd_barrier_post((unsigned*)(args.ws + WS_CTL) + 4096, MISC + 8);
    const int G = gridDim.x; const int bx = blockIdx.x; const int vcu = (G % 8 == 0) ? (bx % 8) * (G / 8) + bx / 8 : bx;
#ifndef PROBE_DUP
#define PROBE_DUP 0
#endif
#define REP(mask) for (int rep_ = 0; rep_ < (((PROBE_DUP) & (mask)) ? 2 : 1); ++rep_)
#define PHASE_VARS() unsigned char* ws = args.ws; int tid_ = threadIdx.x; asm volatile("" : "+v"(tid_)); const int lane = tid_ & 63, wave = __builtin_amdgcn_readfirstlane(tid_ >> 6); (void)lane; (void)wave

    REP(1) { PHASE_VARS(); p0_prologue(args, ws, ldsl, vcu, G, wave, lane); }
    if (args.ws == nullptr) grid.sync();
    xcd_barrier(bar);

    REP(2) {
        PHASE_VARS();
        pg8::Gemm g{(bf16*)(ws + WS_XN), (bf16*)(ws + WS_WIN), MX, DIN, DM}; pg8::StaticOrder S; S.init(MX, DIN, G, bx, WGM_P1);
        pg8::EpiInProj E{(bf16*)(ws + WS_Q), (bf16*)(ws + WS_K), (bf16*)(ws + WS_V), (bf16*)(ws + WS_G), args.in[I_QG], args.in[I_KG], (const float*)(ws + WS_ROPE)};
        pg8::gemm_phase<pg8::EpiInProj, pg8::StaticOrder, PG8_ALIGN, PG8_SP2>(ldsl, g, S, E);
    }
    {
        PHASE_VARS();
        unsigned* mq = (unsigned*)(ws + WS_CTL) + 160;
        volatile LAS unsigned* TK = (volatile LAS unsigned*)(ldsl + LDS_BYTES - 256 + 64);
        for (;;) {
            if (tid_ == 0) TK[0] = __hip_atomic_fetch_add(mq, 1u, __ATOMIC_RELAXED, __HIP_MEMORY_SCOPE_AGENT);
            __syncthreads();
            const int t = (int)TK[0];
            __syncthreads();
            if (t >= 16) break;
            meta_proj(args, ws, ldsl, t, wave, lane);
        }
    }
    xcd_barrier(bar);

    REP(8) {
        PHASE_VARS();
        static_assert(attn_body::V2_LDS_BYTES <= LDS_BYTES - 256, "attention LDS");
        const float dq1 = wave_sum(args.in[I_LQ1][lane] * args.in[I_LK1][lane]), dq2 = wave_sum(args.in[I_LQ2][lane] * args.in[I_LK2][lane]);
        const float lam_init = 0.2f;
        const float lam = __builtin_amdgcn_exp2f(dq1 * 1.4426950408889634f) - __builtin_amdgcn_exp2f(dq2 * 1.4426950408889634f) + lam_init;
        for (int vv = vcu; vv < 256; vv += G) {
            const int bh = vv >> 4, s = vv & 15;
            const int b = bh >> 2, head = bh & 3;
            const attn_body::bf16* Kh = (const attn_body::bf16*)(ws + WS_K) + (size_t)(b * SPAD) * 512 + head * 128;
            const attn_body::bf16* Vh = (const attn_body::bf16*)(ws + WS_V) + (size_t)(b * SPAD) * 512 + head * 128;
            for (int i = 0; i < 2; ++i) {
                const int qb = i ? 31 - s : s;
                const int q0 = qb * 256;
                const attn_body::bf16* Qu = (const attn_body::bf16*)(ws + WS_Q) + (size_t)(b * SEQ + q0) * 512 + head * 128;
                attn_body::bf16* Mu = (attn_body::bf16*)(ws + WS_MIX) + (size_t)(b * SEQ + q0) * 1024 + head * 128;
                attn_body::attn_unit128<0>(q0, Qu, Kh, Vh, Mu, (char*)lds, lam, 1.0f - lam_init, args.in[I_SUBLN]);
                attn_body::attn_unit128<1>(q0, Qu + 64, Kh + 64, Vh, Mu, (char*)lds, lam, 1.0f - lam_init, args.in[I_SUBLN]);
            }
        }
    }
    REP(4) { PHASE_VARS(); conv_phase(args, ws, ldsl, vcu, G, wave, lane); }
    { PHASE_VARS(); wconv_phase(args, ws, ldsl, wave, lane); }
    xcd_barrier(bar);

    REP(32) {
        PHASE_VARS();
        pg8::Gemm g{(bf16*)(ws + WS_MIX), (bf16*)(ws + WS_WOUT), MX, DM, DM}; pg8::StaticOrder S; S.init(MX, DM, G, bx, WGM_P35);
        pg8::EpiOut E{(const bf16*)(ws + WS_XN), (const float*)(ws + WS_RN), args.in[I_G1], (bf16*)(ws + WS_H1B), (float*)(ws + WS_SSQ)};
        pg8::gemm_phase<pg8::EpiOut, pg8::StaticOrder, PG8_ALIGN, PG8_SP2>(ldsl, g, S, E);
    }
    xcd_barrier(bar);

    REP(64) {
        PHASE_VARS();
        pg8::Gemm g{(bf16*)(ws + WS_H1B), (bf16*)(ws + WS_WUP), MX, DFF, DM}; pg8::StaticOrder S; S.init(MX, DFF, G, bx, WGM_P4);
        pg8::EpiUp E{(bf16*)(ws + WS_HB), (const float*)(ws + WS_SSQ)};
        pg8::gemm_phase<pg8::EpiUp, pg8::StaticOrder, PG8_ALIGN, PG8_SP2>(ldsl, g, S, E);
    }
    xcd_barrier(bar);

    {
        PHASE_VARS();
        pg8::Gemm g{(bf16*)(ws + WS_HB), (bf16*)(ws + WS_WDN), MX, DM, DFF}; pg8::StaticOrder S; S.init(MX, DM, G, bx, WGM_P35);
        pg8::EpiDown E{(const bf16*)(ws + WS_H1B), args.out};
        pg8::gemm_phase<pg8::EpiDown, pg8::StaticOrder, PG8_ALIGN, PG8_SP2>(ldsl, g, S, E);
    }
#undef PHASE_VARS
#undef REP
}

extern "C" void kernel_launch(void* const* d_in, const int* in_sizes, int n_in, void* d_out, int out_size, void* d_ws, size_t ws_size, hipStream_t stream) {
    static int grid = 0;
    if (grid == 0) {
        if (n_in != 19 || in_sizes[0] != MX * DM || out_size != MX * DM || ws_size < WS_END) { fprintf(stderr, "kernel_launch: unexpected shapes: n_in %d, in0 %d, out %d, ws %zu (need %zu); nothing launched\n", n_in, n_in > 0 ? in_sizes[0] : -1, out_size, ws_size, (size_t)WS_END); grid = -1; return; }
        int dev = 0, cus = 0, per_cu = 0;
        if (hipGetDevice(&dev) != hipSuccess || hipDeviceGetAttribute(&cus, hipDeviceAttributeMultiprocessorCount, dev) != hipSuccess) { fprintf(stderr, "kernel_launch: device query failed\n"); grid = -1; return; }
        if (hipFuncSetAttribute((const void*)hymba_fwd, hipFuncAttributeMaxDynamicSharedMemorySize, LDS_BYTES) != hipSuccess) { fprintf(stderr, "kernel_launch: hipFuncSetAttribute failed\n"); grid = -1; return; }
        if (hipOccupancyMaxActiveBlocksPerMultiprocessor(&per_cu, (const void*)hymba_fwd, NWAVES * 64, LDS_BYTES) != hipSuccess || per_cu < 1) { fprintf(stderr, "kernel_launch: occupancy query says %d\n", per_cu); per_cu = 1; }
        (void)hipGetLastError();
        grid = cus * 1;
        fprintf(stderr, "kernel_launch: grid %d (occupancy query %d per CU)\n", grid, per_cu);
    }
    if (grid < 0) return;
    Args a{};
    for (int i = 0; i < 19; ++i) a.in[i] = (const float*)d_in[i];
    a.out = (float*)d_out; a.ws = (unsigned char*)d_ws;
    for (int i = 0; i < 8; ++i) a.inv_freq[i] = (float)pow(500000.0, -(double)i / 8.0);
    if (hipMemsetAsync((char*)d_ws + WS_CTL, 0, 65536, stream) != hipSuccess) { fprintf(stderr, "kernel_launch: hipMemsetAsync failed\n"); return; }
    void* kargs[] = {&a};
    const hipError_t le = hipLaunchCooperativeKernel((const void*)hymba_fwd, dim3(grid), dim3(NWAVES * 64), kargs, LDS_BYTES, stream);
    if (le != hipSuccess) fprintf(stderr, "kernel_launch: cooperative launch failed: %s (grid %d)\n", hipGetErrorName(le), grid);
}
```

```cpp
#include <hip/hip_cooperative_groups.h>
#include <cmath>
#include <hip/hip_runtime.h>
#include <cstdio>
#include <cstdint>
namespace pg8 {
#define PG8_LAS __attribute__((address_space(3)))
typedef unsigned short bf16_t;
typedef short bf16x8 __attribute__((ext_vector_type(8)));
typedef float f32x4 __attribute__((ext_vector_type(4)));
typedef unsigned u32x4 __attribute__((ext_vector_type(4)));
constexpr int BM = 256, BK = 64, HALF = 128, HTB = HALF * BK * 2  , STAGE_BYTES = 8 * HTB, NXCD = 8, WGM = 8;

__host__ __device__ __forceinline__ int lds_byte(int r, int c) { const int st = (r >> 4) * 2 + (c >> 5), rr = r & 15, cc = c & 31, ob = rr * 64 + cc * 2; return st * 1024 + (ob ^ (((ob >> 9) & 1) << 5)); }
__host__ __device__ __forceinline__ void stage_rc(int b, int& R, int& C) { const int st = b / 1024, sb = b % 1024, swz = sb ^ (((sb >> 9) & 1) << 5); R = (st >> 1) * 16 + swz / 64; C = (st & 1) * 32 + (swz % 64) / 2; }
__host__ __device__ __forceinline__ int perm32(int rho) { const int n = rho >> 4, i = rho & 15; return 8 * (i >> 2) + 4 * n + (i & 3); }

struct Unit { int pm, pn; };
struct Gemm { const bf16_t* A; const bf16_t* Bt; int M, N, K; };

struct StaticOrder {
    int nM, nN, nwg, G, c, wgm;
    __host__ __device__ void init(int M, int N, int G_, int c_, int wgm_ = WGM) { nM = M / BM; nN = N / BM; nwg = nM * nN; G = G_; c = c_; wgm = wgm_; }
    __host__ __device__ bool next(int i, Unit& u) const {
        const long L = (long)i * G + c; if (L >= nwg) return false;
        int wgid = (int)L; { const int q = nwg / NXCD, r = nwg % NXCD, xcd = wgid % NXCD, off = wgid / NXCD; wgid = (xcd < r ? xcd * (q + 1) : r * (q + 1) + (xcd - r) * q) + off; }
        const int nig = wgm * nN, gid = wgid / nig, fm = gid * wgm, gsz = (nM - fm) < wgm ? (nM - fm) : wgm;
        u.pm = fm + ((wgid % nig) % gsz); u.pn = (wgid % nig) / gsz; return true;
    }
    __device__ __forceinline__ void a_ready(const Unit&) const {}
    __device__ __forceinline__ void done(const Unit&) const {}
};

__device__ __forceinline__ unsigned cvt_pk_bf16(float lo, float hi) { unsigned r; asm volatile("v_cvt_pk_bf16_f32 %0, %1, %2" : "=v"(r) : "v"(lo), "v"(hi)); return r; }
typedef float f32x2 __attribute__((ext_vector_type(2)));
__device__ __forceinline__ f32x2 gelu_pk(f32x2 v) {
    const f32x2 av = __builtin_elementwise_abs(v), d = av * 0.2316418882f + 1.0f;
    f32x2 t; t.x = __builtin_amdgcn_rcpf(d.x); t.y = __builtin_amdgcn_rcpf(d.y);
    f32x2 q = t * 0.5307027145f + (-0.7265760135f); q = q * t + 0.7107068705f; q = q * t + (-0.142248368f); q = q * t + 0.127414796f; q = q * t;
    const f32x2 s = (v * v) * (-0.72134752044f);
    f32x2 e; e.x = __builtin_amdgcn_exp2f(s.x); e.y = __builtin_amdgcn_exp2f(s.y);
    const f32x2 m = v * (q * e), r = v - m;
    f32x2 o; o.x = v.x < 0.f ? m.x : r.x; o.y = v.y < 0.f ? m.y : r.y; return o;
}

template <int ACT  > struct EpiBf16 {
    static constexpr bool PERM = true, AFTER_DRAIN = false; static_assert(ACT == 0 || ACT == 1, "EpiBf16: ACT is 0 (none) or 1 (gelu_pk)");
    bf16_t* O; int ldc; const float* bias; int split_cols; size_t split_stride; float scale0;
    __device__ __forceinline__ void operator()(const f32x4 (&acc)[2][2][4][2], const Unit& u, int wr, int wc, int fr, int fq) const {
        const int row0 = u.pm * BM + wr * 64 + fr; int colt = u.pn * BM; bf16_t* base = O;
        float sc = 1.f; if (split_cols) { const int t = colt / split_cols; base += (size_t)t * split_stride; colt -= t * split_cols; if (t == 0) sc = scale0; }
        const int col0 = colt + wc * 32 + 8 * fq, bcol0 = u.pn * BM + wc * 32 + 8 * fq;
        f32x4 bv[2][2];
#pragma unroll
        for (int bj = 0; bj < 2; ++bj)
#pragma unroll
            for (int n = 0; n < 2; ++n) bv[bj][n] = bias ? *(const f32x4*)(bias + bcol0 + bj * HALF + 4 * n) : (f32x4){0.f, 0.f, 0.f, 0.f};
#pragma unroll
        for (int ai = 0; ai < 2; ++ai)
#pragma unroll
            for (int m = 0; m < 4; ++m) { bf16_t* rowp = base + (size_t)(row0 + ai * HALF + m * 16) * ldc + col0;
#pragma unroll
                for (int bj = 0; bj < 2; ++bj) { f32x4 v0 = acc[ai][bj][m][0] + bv[bj][0], v1 = acc[ai][bj][m][1] + bv[bj][1];
                    if (ACT == 1) { f32x2 a = gelu_pk((f32x2){v0[0], v0[1]}), b = gelu_pk((f32x2){v0[2], v0[3]}), c = gelu_pk((f32x2){v1[0], v1[1]}), d = gelu_pk((f32x2){v1[2], v1[3]});
                        v0 = (f32x4){a.x, a.y, b.x, b.y}; v1 = (f32x4){c.x, c.y, d.x, d.y}; }
                    v0 = v0 * sc; v1 = v1 * sc; u32x4 w; w.x = cvt_pk_bf16(v0[0], v0[1]); w.y = cvt_pk_bf16(v0[2], v0[3]); w.z = cvt_pk_bf16(v1[0], v1[1]); w.w = cvt_pk_bf16(v1[2], v1[3]);
                    *(u32x4*)(rowp + bj * HALF) = w; } }
    }
};

constexpr int XROWS = 32768, SPAD = 8256;
constexpr float QSCALE = 0.125f * 1.4426950408889634f;
__device__ __forceinline__ f32x4 shfl_xor4(f32x4 v, int m) { f32x4 r; r[0] = __shfl_xor(v[0], m); r[1] = __shfl_xor(v[1], m); r[2] = __shfl_xor(v[2], m); r[3] = __shfl_xor(v[3], m); return r; }
__device__ __forceinline__ u32x4 pack8(f32x4 a, f32x4 b) { u32x4 w; w.x = cvt_pk_bf16(a[0], a[1]); w.y = cvt_pk_bf16(a[2], a[3]); w.z = cvt_pk_bf16(b[0], b[1]); w.w = cvt_pk_bf16(b[2], b[3]); return w; }
__device__ __forceinline__ u32x4 swap_lane1(u32x4 v) { u32x4 r; r.x = (unsigned)__builtin_amdgcn_update_dpp(0, (int)v.x, 0xB1, 0xF, 0xF, true); r.y = (unsigned)__builtin_amdgcn_update_dpp(0, (int)v.y, 0xB1, 0xF, 0xF, true);
    r.z = (unsigned)__builtin_amdgcn_update_dpp(0, (int)v.z, 0xB1, 0xF, 0xF, true); r.w = (unsigned)__builtin_amdgcn_update_dpp(0, (int)v.w, 0xB1, 0xF, 0xF, true); return r; }
struct EpiInProj {
    static constexpr bool PERM = true, AFTER_DRAIN = false;
    bf16_t *Q, *K, *V, *G; const float *qg, *kg, *rope;
    __device__ __forceinline__ void operator()(const f32x4 (&acc)[2][2][4][2], const Unit& u, int wr, int wc, int fr, int fq) const {
        const int pn = u.pn; constexpr bool meta = false;
        if (meta && (wr != 0 || pn < 2)) return;
        const int rbase = u.pm * BM + wr * 64 + fr;
        if (pn < 4) {
            const bool isq = pn < 2; const float* gp = isq ? qg : kg; const float osc = isq ? QSCALE : 1.f;
            f32x4 gv[2][2];
#pragma unroll
            for (int bj = 0; bj < 2; ++bj)
#pragma unroll
                for (int n = 0; n < 2; ++n) gv[bj][n] = *(const f32x4*)(gp + 32 * bj + 8 * fq + 4 * n);
            const int colb = (pn & 1) * 256 + wc * 64 + 8 * fq;
            bf16_t* dst = isq ? Q : K;
#pragma unroll
            for (int ai = 0; ai < 2; ++ai) {
                if (meta && ai) continue;
#pragma unroll
              for (int mh = 0; mh < 2; ++mh) {
                if (meta && mh) continue;
                f32x4 rv[2][4];
                if (fq < 2) {
#pragma unroll
                    for (int m2 = 0; m2 < 2; ++m2) { const int row = rbase + ai * HALF + (2 * mh + m2) * 16; const int pos = meta ? (row - XROWS) : ((row & 8191) + 16); const f32x4* rp = (const f32x4*)(rope + (size_t)pos * 16);
#pragma unroll
                        for (int k = 0; k < 4; ++k) rv[m2][k] = rp[k]; }
                }
                asm volatile("" ::: "memory");
#pragma unroll
                for (int m = 2 * mh; m < 2 * mh + 2; ++m) {
                    if (meta && m) continue;
                    const int row = rbase + ai * HALF + m * 16;
                    float ss = 0.f;
#pragma unroll
                    for (int bj = 0; bj < 2; ++bj)
#pragma unroll
                        for (int n = 0; n < 2; ++n) { const f32x4 x = acc[ai][bj][m][n]; ss += (x[0] * x[0] + x[1] * x[1]) + (x[2] * x[2] + x[3] * x[3]); }
                    ss += __shfl_xor(ss, 16); ss += __shfl_xor(ss, 32);
                    const float rs = __builtin_amdgcn_rsqf(ss * (1.0f / 64.0f) + 1e-6f);
                    f32x4 y00 = acc[ai][0][m][0] * rs * gv[0][0], y01 = acc[ai][0][m][1] * rs * gv[0][1], y10 = acc[ai][1][m][0] * rs * gv[1][0], y11 = acc[ai][1][m][1] * rs * gv[1][1];
                    const f32x4 p0 = shfl_xor4(y00, 16), p1 = shfl_xor4(y01, 16);
                    if (fq < 2) {
                        const f32x4 c0 = rv[m & 1][0], c1 = rv[m & 1][1], s0 = rv[m & 1][2], s1 = rv[m & 1][3];
                        const float sg = fq ? 1.f : -1.f;
                        y00 = y00 * c0 + (p0 * s0) * sg; y01 = y01 * c1 + (p1 * s1) * sg;
                    }
                    const u32x4 w0 = pack8(y00 * osc, y01 * osc), w1 = pack8(y10 * osc, y11 * osc);
                    if (!meta) {
                        const bool odd = (fr & 1) != 0; const int row_e = row - (odd ? 1 : 0);
                        const size_t orow = isq ? (size_t)row_e : (size_t)((row_e >> 13) * SPAD + 64 + (row_e & 8191));
                        const u32x4 rcv = swap_lane1(odd ? w0 : w1);
                        bf16_t* p = dst + orow * 512 + colb + (odd ? 32 : 0);
                        *(u32x4*)p = odd ? rcv : w0; *(u32x4*)(p + 512) = odd ? w1 : rcv;
                    } else {
#pragma unroll 1
                        for (int b = 0; b < 4; ++b) { const size_t orow = (size_t)(b * SPAD + fr); *(u32x4*)(dst + orow * 512 + colb) = w0; *(u32x4*)(dst + orow * 512 + colb + 32) = w1; }
                    }
                }
              }
            }
        } else if (pn < 6) {
            const int colb = (pn - 4) * 256 + wc * 64 + 8 * fq;
#pragma unroll
            for (int ai = 0; ai < 2; ++ai)
#pragma unroll
                for (int m = 0; m < 4; ++m) {
                    if (meta && (ai || m)) continue;
                    const int row = rbase + ai * HALF + m * 16;
                    const u32x4 w0 = pack8(acc[ai][0][m][0], acc[ai][0][m][1]), w1 = pack8(acc[ai][1][m][0], acc[ai][1][m][1]);
                    if (!meta) {
                        const bool odd = (fr & 1) != 0; const int row_e = row - (odd ? 1 : 0);
                        const size_t orow = (size_t)((row_e >> 13) * SPAD + 64 + (row_e & 8191));
                        const u32x4 rcv = swap_lane1(odd ? w0 : w1);
                        bf16_t* p = V + orow * 512 + colb + (odd ? 32 : 0);
                        *(u32x4*)p = odd ? rcv : w0; *(u32x4*)(p + 512) = odd ? w1 : rcv;
                    } else {
#pragma unroll 1
                        for (int b = 0; b < 4; ++b) { const size_t orow = (size_t)(b * SPAD + fr); *(u32x4*)(V + orow * 512 + colb) = w0; *(u32x4*)(V + orow * 512 + colb + HALF) = w1; }
                    }
                }
        } else {
            const int colb = (pn - 6) * 128 + wc * 32 + 8 * fq;
#pragma unroll
            for (int ai = 0; ai < 2; ++ai)
#pragma unroll
                for (int m = 0; m < 4; ++m) {
                    if (meta && (ai || m)) continue;
                    const int row = rbase + ai * HALF + m * 16;
                    f32x4 h[2];
#pragma unroll
                    for (int n = 0; n < 2; ++n) { const f32x4 a = acc[ai][0][m][n], g = acc[ai][1][m][n];
#pragma unroll
                        for (int e = 0; e < 4; ++e) h[n][e] = a[e] * __builtin_amdgcn_rcpf(1.0f + __builtin_amdgcn_exp2f(-1.4426950408889634f * g[e])); }
                    const u32x4 w0 = pack8(h[0], h[1]);
                    if (!meta) {
                        const size_t orow = (size_t)((row >> 13) * SPAD + 64 + (row & 8191));
                        *(u32x4*)(G + orow * 512 + colb) = w0;
                    } else {
#pragma unroll 1
                        for (int b = 0; b < 4; ++b) { const size_t orow = (size_t)(b * SPAD + 48 + fr); *(u32x4*)(G + orow * 512 + colb) = w0; }
                    }
                }
        }
    }
};
struct EpiOut {
    static constexpr bool PERM = true, AFTER_DRAIN = false;
    const bf16_t* xn; const float* rn; const float* g1; bf16_t* hb; float* ssq;
    __device__ __forceinline__ void operator()(const f32x4 (&acc)[2][2][4][2], const Unit& u, int wr, int wc, int fr, int fq) const {
        const int rbase = u.pm * BM + wr * 64 + fr, colb = u.pn * BM + wc * 64 + 8 * fq;
        const bool odd = (fr & 1) != 0;
        f32x4 ig[2][2];
#pragma unroll
        for (int bj = 0; bj < 2; ++bj)
#pragma unroll
            for (int n = 0; n < 2; ++n) { const f32x4 g = *(const f32x4*)(g1 + colb + bj * 32 + 4 * n);
#pragma unroll
                for (int e = 0; e < 4; ++e) ig[bj][n][e] = __builtin_amdgcn_rcpf(g[e]); }
#pragma unroll
        for (int ai = 0; ai < 2; ++ai) {
            u32x4 xv[4][2]; float rv[4];
#pragma unroll
            for (int m = 0; m < 4; ++m) { const int row = rbase + ai * HALF + m * 16; rv[m] = rn[row];
#pragma unroll
                for (int bj = 0; bj < 2; ++bj) xv[m][bj] = *(const u32x4*)(xn + (size_t)row * 1024 + colb + bj * 32); }
            asm volatile("" ::: "memory");
#pragma unroll
            for (int m = 0; m < 4; ++m) {
                const int row = rbase + ai * HALF + m * 16, row_e = row - (odd ? 1 : 0); float ss = 0.f;
                u32x4 wv[2];
#pragma unroll
                for (int bj = 0; bj < 2; ++bj) { const u32x4 w = xv[m][bj];
                    f32x4 x0, x1;
                    x0[0] = __uint_as_float(w.x << 16); x0[1] = __uint_as_float(w.x & 0xffff0000u); x0[2] = __uint_as_float(w.y << 16); x0[3] = __uint_as_float(w.y & 0xffff0000u);
                    x1[0] = __uint_as_float(w.z << 16); x1[1] = __uint_as_float(w.z & 0xffff0000u); x1[2] = __uint_as_float(w.w << 16); x1[3] = __uint_as_float(w.w & 0xffff0000u);
                    const f32x4 h0 = x0 * rv[m] * ig[bj][0] + acc[ai][bj][m][0], h1 = x1 * rv[m] * ig[bj][1] + acc[ai][bj][m][1];
                    wv[bj] = pack8(h0, h1);
                    ss += (h0[0] * h0[0] + h0[1] * h0[1]) + (h0[2] * h0[2] + h0[3] * h0[3]) + (h1[0] * h1[0] + h1[1] * h1[1]) + (h1[2] * h1[2] + h1[3] * h1[3]); }
                const u32x4 snd = odd ? wv[0] : wv[1]; u32x4 rcv;
                rcv.x = (unsigned)__builtin_amdgcn_update_dpp(0, (int)snd.x, 0xB1, 0xF, 0xF, true); rcv.y = (unsigned)__builtin_amdgcn_update_dpp(0, (int)snd.y, 0xB1, 0xF, 0xF, true);
                rcv.z = (unsigned)__builtin_amdgcn_update_dpp(0, (int)snd.z, 0xB1, 0xF, 0xF, true); rcv.w = (unsigned)__builtin_amdgcn_update_dpp(0, (int)snd.w, 0xB1, 0xF, 0xF, true);
                bf16_t* p = hb + (size_t)row_e * 1024 + colb + (odd ? 32 : 0);
                *(u32x4*)p = odd ? rcv : wv[0];
                *(u32x4*)(p + 1024) = odd ? wv[1] : rcv;
                ss += __shfl_xor(ss, 16); ss += __shfl_xor(ss, 32);
                if (fq == 0) ssq[(size_t)row * 16 + u.pn * 4 + wc] = ss;
            }
        }
    }
};
struct EpiUp {
    static constexpr bool PERM = true, AFTER_DRAIN = false;
    bf16_t* hb; const PG8_LAS float* rl;
    __device__ __forceinline__ void operator()(const f32x4 (&acc)[2][2][4][2], const Unit& u, int wr, int wc, int fr, int fq) const {
        const int rbase = u.pm * BM + wr * 64 + fr, colb = u.pn * BM + wc * 64 + 8 * fq;
        const bool odd = (fr & 1) != 0;
        const PG8_LAS float* rp = rl + ((u.pm >> 2) & 3) * 256 + wr * 64 + fr;
#pragma unroll
        for (int ai = 0; ai < 2; ++ai) {
#pragma unroll
            for (int m = 0; m < 4; ++m) {
                const int row = rbase + ai * HALF + m * 16, row_e = row - (odd ? 1 : 0);
                const float rs = rp[ai * HALF + m * 16];
                u32x4 w[2];
#pragma unroll
                for (int bj = 0; bj < 2; ++bj) { f32x4 a0 = acc[ai][bj][m][0] * rs, a1 = acc[ai][bj][m][1] * rs;
#pragma unroll
                    for (int e = 0; e < 4; ++e) { const float p = fmaxf(a0[e], 0.f), q = fmaxf(a1[e], 0.f); a0[e] = p * p; a1[e] = q * q; }
                    w[bj] = pack8(a0, a1); }
                const u32x4 rcv = swap_lane1(odd ? w[0] : w[1]);
                bf16_t* p = hb + (size_t)row_e * 4096 + colb + (odd ? 32 : 0);
                __builtin_nontemporal_store(odd ? rcv : w[0], (u32x4*)p);
                __builtin_nontemporal_store(odd ? w[1] : rcv, (u32x4*)(p + 4096));
            }
        }
    }
};
struct EpiDown {
    static constexpr bool PERM = false, AFTER_DRAIN = false;
    const bf16_t* h1; float* out;
    __device__ __forceinline__ void operator()(const f32x4 (&acc)[2][2][4][2], const Unit& u, int wr, int wc, int fr, int fq) const {
        typedef unsigned u32x2 __attribute__((ext_vector_type(2)));
        const int rbase = u.pm * BM + wr * 64 + fr, colb = u.pn * BM + wc * 32 + 4 * fq;
        const bool odd = (fr & 1) != 0;
#pragma unroll
        for (int ai = 0; ai < 2; ++ai) {
            u32x2 hv[4][2][2];
#pragma unroll
            for (int m = 0; m < 4; ++m)
#pragma unroll
                for (int bj = 0; bj < 2; ++bj)
#pragma unroll
                    for (int n = 0; n < 2; ++n) hv[m][bj][n] = *(const u32x2*)(h1 + (size_t)(rbase + ai * HALF + m * 16) * 1024 + colb + bj * HALF + 16 * n);
            asm volatile("" ::: "memory");
#pragma unroll
            for (int m = 0; m < 4; ++m) {
                const int row = rbase + ai * HALF + m * 16, row_e = row - (odd ? 1 : 0);
#pragma unroll
                for (int bj = 0; bj < 2; ++bj) {
                    f32x4 a[2];
#pragma unroll
                    for (int n = 0; n < 2; ++n) { const u32x2 w = hv[m][bj][n];
                        f32x4 r; r[0] = __uint_as_float(w.x << 16); r[1] = __uint_as_float(w.x & 0xffff0000u); r[2] = __uint_as_float(w.y << 16); r[3] = __uint_as_float(w.y & 0xffff0000u);
                        a[n] = r + acc[ai][bj][m][n]; }
                    const f32x4 snd = odd ? a[0] : a[1]; f32x4 rcv;
#pragma unroll
                    for (int e = 0; e < 4; ++e) rcv[e] = __int_as_float(__builtin_amdgcn_update_dpp(0, __float_as_int(snd[e]), 0xB1, 0xF, 0xF, true));
                    const size_t off = (size_t)row_e * 1024 + colb + bj * HALF + (odd ? 16 : 0);
                    __builtin_nontemporal_store(odd ? rcv : a[0], (f32x4*)(out + off));
                    __builtin_nontemporal_store(odd ? a[1] : rcv, (f32x4*)(out + off + 1024)); }
            }
        }
    }
};


template <class Epi, class Sched, bool ALIGN_EPI = false, bool SP2 = false>
__device__ __forceinline__ void gemm_phase(PG8_LAS unsigned char* lds, const Gemm g, const Sched& S, const Epi& E) {
    int tid_ = threadIdx.x; asm volatile("" : "+v"(tid_));
    const int tid = tid_, wid = __builtin_amdgcn_readfirstlane(tid >> 6), lane = tid & 63, wr = wid >> 2, wc = wid & 3, fr = lane & 15, fq = lane >> 4;
    const int K = g.K, nt = K / BK;
    unsigned voffA[2], voffB[2];
#pragma unroll
    for (int i = 0; i < 2; ++i) { int R, C; stage_rc(tid * 16 + i * 8192, R, C); const int Rb = Epi::PERM ? ((R & ~31) + perm32(R & 31)) : R;
        voffA[i] = (unsigned)(R * K + C) * 2u; voffB[i] = (unsigned)(Rb * K + C) * 2u; }
    const size_t kstep = (size_t)(BK * 2);
    const size_t hstep = (size_t)HALF * K * 2;
    const size_t tstep = 2 * hstep;
    const unsigned ldsw = (unsigned)wid * 1024u;
    const int aoff = lds_byte(wr * 64 + fr, fq * 8), boff = lds_byte(wc * 32 + fr, fq * 8);
#define PG8_SA(b, h) (((b) * 2 + (h)) * HTB)
#define PG8_SB(b, h) ((4 + (b) * 2 + (h)) * HTB)
#define PG8_STAGE(bufoff, gbase, voff) do { _Pragma("unroll") for (int _i = 0; _i < 2; ++_i) \
        __builtin_amdgcn_global_load_lds((const unsigned*)((const char*)(gbase) + (voff)[_i]), (PG8_LAS unsigned*)(lds + (bufoff) + ldsw + _i * 8192), 16, 0, 0); } while (0)
#define PG8_LDA(dst, b, h) do { _Pragma("unroll") for (int m = 0; m < 4; ++m) _Pragma("unroll") for (int k = 0; k < 2; ++k) dst[m][k] = *(const PG8_LAS bf16x8*)(lds + PG8_SA(b, h) + aoff + m * 2048 + k * 1024); } while (0)
#define PG8_LDB(dst, b, h) do { _Pragma("unroll") for (int n = 0; n < 2; ++n) _Pragma("unroll") for (int k = 0; k < 2; ++k) dst[n][k] = *(const PG8_LAS bf16x8*)(lds + PG8_SB(b, h) + boff + n * 2048 + k * 1024); } while (0)
#define PG8_MMA(ai, bj, At, Bt) do { __builtin_amdgcn_s_setprio(1); _Pragma("unroll") for (int m = 0; m < 4; ++m) _Pragma("unroll") for (int n = 0; n < 2; ++n) _Pragma("unroll") for (int k = 0; k < 2; ++k) \
        acc[ai][bj][m][n] = __builtin_amdgcn_mfma_f32_16x16x32_bf16(Bt[n][k], At[m][k], acc[ai][bj][m][n], 0, 0, 0); __builtin_amdgcn_s_setprio(0); } while (0)
#define PG8_WAIT_V(n) asm volatile("s_waitcnt vmcnt(" #n ")" ::: "memory")
#define PG8_WAIT_L(n) asm volatile("s_waitcnt lgkmcnt(" #n ")" ::: "memory")
#define PG8_BAR __builtin_amdgcn_s_barrier()
#define PG8_SCHED __builtin_amdgcn_sched_barrier(0)
    Unit cur, nxt; int ui = 0;
    if (!S.next(0, cur)) return;
    f32x4 acc[2][2][4][2];
#pragma unroll
    for (int a = 0; a < 2; ++a)
#pragma unroll
        for (int b = 0; b < 2; ++b)
#pragma unroll
            for (int m = 0; m < 4; ++m)
#pragma unroll
                for (int n = 0; n < 2; ++n) acc[a][b][m][n] = (f32x4){0.f, 0.f, 0.f, 0.f};
    bf16x8 At[4][2], B0[2][2], B1[2][2];
    const char* cA = (const char*)g.A + (size_t)cur.pm * tstep; const char* cB = (const char*)g.Bt + (size_t)cur.pn * tstep;
    S.a_ready(cur);
    if constexpr (SP2) {
        PG8_STAGE(PG8_SB(0, 0), cB, voffB); PG8_STAGE(PG8_SB(0, 1), cB + hstep, voffB); PG8_STAGE(PG8_SA(0, 0), cA, voffA); PG8_STAGE(PG8_SA(0, 1), cA + hstep, voffA);
        if (wr == 1) PG8_BAR;
        PG8_WAIT_V(2); PG8_BAR;
        PG8_STAGE(PG8_SB(1, 0), cB + kstep, voffB); PG8_STAGE(PG8_SA(1, 0), cA + kstep, voffA); PG8_STAGE(PG8_SB(1, 1), cB + hstep + kstep, voffB);
        PG8_WAIT_V(6); PG8_BAR;
    } else {
        PG8_STAGE(PG8_SB(0, 0), cB, voffB); PG8_STAGE(PG8_SA(0, 0), cA, voffA); PG8_STAGE(PG8_SB(0, 1), cB + hstep, voffB); PG8_STAGE(PG8_SA(0, 1), cA + hstep, voffA);
        if (wr == 1) PG8_BAR;
        PG8_WAIT_V(4); PG8_BAR;
        PG8_STAGE(PG8_SB(1, 0), cB + kstep, voffB); PG8_STAGE(PG8_SA(1, 0), cA + kstep, voffA); PG8_STAGE(PG8_SB(1, 1), cB + hstep + kstep, voffB);
        PG8_WAIT_V(6); PG8_BAR;
    }
    for (;;) {
        const bool has_next = S.next(ui + 1, nxt);
        const char* nA = has_next ? (const char*)g.A + (size_t)nxt.pm * tstep : cA; const char* nB = has_next ? (const char*)g.Bt + (size_t)nxt.pn * tstep : cB;
        for (int t = 0; t < nt; t += 2) {
            const bool last = (t == nt - 2);
            const char* a1 = cA + (size_t)(t + 1) * kstep;
            const char* a2 = last ? nA : cA + (size_t)(t + 2) * kstep; const char* b2 = last ? nB : cB + (size_t)(t + 2) * kstep;
            const char* a3 = a2 + kstep; const char* b3 = b2 + kstep;
            if (last && has_next) S.a_ready(nxt);
            if constexpr (SP2) {
            PG8_LDB(B0, 0, 0); PG8_LDB(B1, 0, 1); PG8_SCHED; PG8_LDA(At, 0, 0); PG8_STAGE(PG8_SA(1, 1), a1 + hstep, voffA);
            PG8_WAIT_V(8); PG8_WAIT_L(0); PG8_BAR; PG8_MMA(0, 0, At, B0); PG8_MMA(0, 1, At, B1); PG8_BAR; PG8_SCHED;
            PG8_LDA(At, 0, 1); PG8_STAGE(PG8_SB(0, 0), b2, voffB); PG8_STAGE(PG8_SB(0, 1), b2 + hstep, voffB); PG8_STAGE(PG8_SA(0, 0), a2, voffA);
            PG8_WAIT_V(8); PG8_WAIT_L(0); PG8_BAR; PG8_MMA(1, 0, At, B0); PG8_MMA(1, 1, At, B1); PG8_BAR; PG8_SCHED;
            PG8_LDB(B0, 1, 0); PG8_LDB(B1, 1, 1); PG8_SCHED; PG8_LDA(At, 1, 0); PG8_STAGE(PG8_SA(0, 1), a2 + hstep, voffA);
            PG8_WAIT_V(8); PG8_WAIT_L(0); PG8_BAR; PG8_MMA(0, 0, At, B0); PG8_MMA(0, 1, At, B1); PG8_BAR; PG8_SCHED;
            PG8_LDA(At, 1, 1); PG8_STAGE(PG8_SB(1, 0), b3, voffB); PG8_STAGE(PG8_SB(1, 1), b3 + hstep, voffB); PG8_STAGE(PG8_SA(1, 0), a3, voffA);
            PG8_WAIT_V(8); PG8_WAIT_L(0); PG8_BAR; PG8_MMA(1, 0, At, B0); PG8_MMA(1, 1, At, B1); PG8_BAR; PG8_SCHED;
            } else {
            PG8_LDB(B0, 0, 0); PG8_SCHED; PG8_LDA(At, 0, 0); PG8_STAGE(PG8_SA(1, 1), a1 + hstep, voffA);
            PG8_WAIT_L(8); PG8_BAR; PG8_WAIT_L(0); PG8_MMA(0, 0, At, B0); PG8_BAR; PG8_SCHED;
            PG8_LDB(B1, 0, 1); PG8_STAGE(PG8_SB(0, 0), b2, voffB);
            PG8_BAR; PG8_WAIT_L(0); PG8_MMA(0, 1, At, B1); PG8_BAR;
            PG8_LDA(At, 0, 1); PG8_STAGE(PG8_SA(0, 0), a2, voffA);
            PG8_BAR; PG8_WAIT_L(0); PG8_MMA(1, 0, At, B0); PG8_BAR; PG8_SCHED;
            PG8_STAGE(PG8_SB(0, 1), b2 + hstep, voffB);
            PG8_WAIT_V(6); PG8_BAR; PG8_MMA(1, 1, At, B1); PG8_BAR;
            PG8_LDB(B0, 1, 0); PG8_SCHED; PG8_LDA(At, 1, 0); PG8_STAGE(PG8_SA(0, 1), a2 + hstep, voffA);
            PG8_WAIT_L(8); PG8_BAR; PG8_WAIT_L(0); PG8_MMA(0, 0, At, B0); PG8_BAR; PG8_SCHED;
            PG8_LDB(B1, 1, 1); PG8_STAGE(PG8_SB(1, 0), b3, voffB);
            PG8_BAR; PG8_WAIT_L(0); PG8_MMA(0, 1, At, B1); PG8_BAR;
            PG8_LDA(At, 1, 1); PG8_STAGE(PG8_SA(1, 0), a3, voffA);
            PG8_BAR; PG8_WAIT_L(0); PG8_MMA(1, 0, At, B0); PG8_BAR; PG8_SCHED;
            PG8_STAGE(PG8_SB(1, 1), b3 + hstep, voffB);
            PG8_WAIT_V(6); PG8_BAR; PG8_MMA(1, 1, At, B1); PG8_BAR;
            }
        }
        if constexpr (ALIGN_EPI) { if (wr == 0) PG8_BAR; }
        if constexpr (!Epi::AFTER_DRAIN) { E(acc, cur, wr, wc, fr, fq); S.done(cur); }
        if (!has_next) break;
#pragma unroll
        for (int a = 0; a < 2; ++a)
#pragma unroll
            for (int b = 0; b < 2; ++b)
#pragma unroll
                for (int m = 0; m < 4; ++m)
#pragma unroll
                    for (int n = 0; n < 2; ++n) acc[a][b][m][n] = (f32x4){0.f, 0.f, 0.f, 0.f};
        cur = nxt; cA = nA; cB = nB; ++ui;
        if constexpr (ALIGN_EPI) { if (wr == 1) PG8_BAR; }
    }
    PG8_WAIT_V(0);
    if constexpr (!ALIGN_EPI) { if (wr == 0) PG8_BAR; }
    PG8_BAR;
    if constexpr (Epi::AFTER_DRAIN) { E.fused(acc, cur, wr, wc, fr, fq, lds, wid, lane); S.done(cur); }
#undef PG8_SA
#undef PG8_SB
#undef PG8_STAGE
#undef PG8_LDA
#undef PG8_LDB
#undef PG8_MMA
#undef PG8_WAIT_V
#undef PG8_WAIT_L
#undef PG8_BAR
#undef PG8_SCHED
}
}

#ifndef PG8_SP2
#define PG8_SP2 true
#endif
#ifndef PG8_ALIGN
#define PG8_ALIGN true
#endif
#include <hip/hip_bf16.h>
#include <cmath>
namespace attn_body {
using bf16=__hip_bfloat16;
using bf16x8=__attribute__((ext_vector_type(8)))short;
using s16x4=__attribute__((ext_vector_type(4)))short;
using f32x16=__attribute__((ext_vector_type(16)))float;
using u32x4=__attribute__((ext_vector_type(4)))unsigned;
constexpr int SEQ=8192,D=64,PQ=512,PO=1024;
constexpr int NW=8,QBLK=32,QB=QBLK*NW,KVBLK=64,NQB=SEQ/QB;
constexpr int ATTN_UNIT_ROWS=QB;
__device__ __forceinline__ int crow(int r,int hi){return (r&3)+8*(r>>2)+4*hi;}
#define SBAR() __builtin_amdgcn_sched_barrier(0)
__device__ __forceinline__ void cmask(f32x16&p0,f32x16&p1,int jb,int qrel,int hi){
  const float NEG=-INFINITY; int kb=64*jb+4*hi;
  #pragma unroll
  for(int r=0;r<16;++r){int kv=kb+(r&3)+8*(r>>2); if(kv>qrel)p0[r]=NEG; if(kv+32>qrel)p1[r]=NEG;}
}

constexpr int NSLOT=3, SLOTB=8192;
constexpr int LDS_K=0, LDS_V=NSLOT*SLOTB, LDS_WS=2*NSLOT*SLOTB, LDS_OST=LDS_WS+NW*64*4, LDS_BYTES=LDS_OST+NW*4096;
constexpr float C2=0.125f*1.4426950408889634f;
__device__ __forceinline__ void glds16(const void*gsrc,unsigned lds_dst){unsigned keep;
  asm volatile("s_mov_b32 %0, m0\n\ts_mov_b32 m0, %2\n\ts_nop 0\n\tglobal_load_lds_dwordx4 %1, off\n\ts_mov_b32 m0, %0":"=&s"(keep):"v"(gsrc),"s"(lds_dst):"memory");}
__device__ __forceinline__ float max3f(float a,float b,float c){float r;asm("v_max3_f32 %0, %1, %2, %3":"=v"(r):"v"(a),"v"(b),"v"(c));return r;}
__device__ __forceinline__ float max2f(float a,float b){float r;asm("v_max_f32_e32 %0, %1, %2":"=v"(r):"v"(a),"v"(b));return r;}
__device__ __forceinline__ float fadd_s(float a,float b){float r;asm("v_add_f32_e32 %0, %1, %2":"=v"(r):"v"(a),"v"(b));return r;}
__device__ __forceinline__ float fsub_s(float a,float b){float r;asm("v_sub_f32_e32 %0, %1, %2":"=v"(r):"v"(a),"v"(b));return r;}
typedef float f32x2_t __attribute__((ext_vector_type(2))); typedef __bf16 bf16x2_t __attribute__((ext_vector_type(2)));
__device__ __forceinline__ unsigned cvtpk_s(float lo,float hi){f32x2_t v={lo,hi};bf16x2_t b=__builtin_convertvector(v,bf16x2_t);return __builtin_bit_cast(unsigned,b);}
#define WAIT_BAR(N) asm volatile("s_waitcnt vmcnt(" #N ") lgkmcnt(0)\n\ts_barrier":::"memory")

__device__ __forceinline__ void qkt(f32x16&p0,f32x16&p1,const char*Kslot,const bf16x8*qr,const f32x16&negm,int r32,int hi){
  const char*kb=Kslot+hi*1024+r32*16;
  #pragma unroll
  for(int d0=0;d0<4;++d0){
    const bf16x8 b0=*reinterpret_cast<const bf16x8*>(kb+d0*2048);
    const bf16x8 b1=*reinterpret_cast<const bf16x8*>(kb+d0*2048+512);
    if(d0==0){p0=__builtin_amdgcn_mfma_f32_32x32x16_bf16(b0,qr[0],negm,0,0,0);p1=__builtin_amdgcn_mfma_f32_32x32x16_bf16(b1,qr[0],negm,0,0,0);}
    else{p0=__builtin_amdgcn_mfma_f32_32x32x16_bf16(b0,qr[d0],p0,0,0,0);p1=__builtin_amdgcn_mfma_f32_32x32x16_bf16(b1,qr[d0],p1,0,0,0);}}
}
typedef __attribute__((address_space(3))) const char* lds_cptr;
typedef short v4i16_t __attribute__((ext_vector_type(4)));
__device__ __forceinline__ void kload8(bf16x8*kf,lds_cptr kp){
  kf[0]=*(const __attribute__((address_space(3))) bf16x8*)(kp);      kf[1]=*(const __attribute__((address_space(3))) bf16x8*)(kp+512);
  kf[2]=*(const __attribute__((address_space(3))) bf16x8*)(kp+2048); kf[3]=*(const __attribute__((address_space(3))) bf16x8*)(kp+2560);
  kf[4]=*(const __attribute__((address_space(3))) bf16x8*)(kp+4096); kf[5]=*(const __attribute__((address_space(3))) bf16x8*)(kp+4608);
  kf[6]=*(const __attribute__((address_space(3))) bf16x8*)(kp+6144); kf[7]=*(const __attribute__((address_space(3))) bf16x8*)(kp+6656);
}
__device__ __forceinline__ void kload2(bf16x8*kf,lds_cptr kp,int j){ kf[2*j]=*(const __attribute__((address_space(3))) bf16x8*)(kp+j*2048); kf[2*j+1]=*(const __attribute__((address_space(3))) bf16x8*)(kp+j*2048+512); }
__device__ __forceinline__ s16x4 vtr(lds_cptr p){ return __builtin_bit_cast(s16x4,__builtin_amdgcn_ds_read_tr16_b64_v4i16((__attribute__((address_space(3))) v4i16_t*)p)); }
__device__ __forceinline__ float rowmax(const f32x16&p0,const f32x16&p1){
  float a=max3f(p0[0],p0[1],p1[0]),b=max3f(p0[2],p0[3],p1[1]);a=max3f(a,p1[2],p1[3]);
  #pragma unroll
  for(int r=4;r<16;r+=4){a=max3f(a,p0[r],p0[r+1]);b=max3f(b,p0[r+2],p0[r+3]);a=max3f(a,p1[r],p1[r+1]);b=max3f(b,p1[r+2],p1[r+3]);}
  const float m=max2f(a,b);
  auto rr=__builtin_amdgcn_permlane32_swap(__float_as_uint(m),__float_as_uint(m),false,false);
  return max2f(__uint_as_float(rr[0]),__uint_as_float(rr[1]));
}
__device__ __forceinline__ void pv(f32x16*o,int vb,bf16x8 pa0,bf16x8 pa1,bf16x8 pa2,bf16x8 pa3){
  #pragma unroll
  for(int d0=0;d0<2;++d0){s16x4 lo[4],hi[4];
    #pragma unroll
    for(int ks=0;ks<4;++ks){
      asm volatile("ds_read_b64_tr_b16 %0,%1 offset:%c2":"=&v"(lo[ks]):"v"(vb),"i"(d0*4096+ks*1024):"memory");
      asm volatile("ds_read_b64_tr_b16 %0,%1 offset:%c2":"=&v"(hi[ks]):"v"(vb),"i"(d0*4096+ks*1024+512):"memory");}
    asm volatile("s_waitcnt lgkmcnt(0)":::"memory");SBAR();
    #define PK(k) (bf16x8){lo[k][0],lo[k][1],lo[k][2],lo[k][3],hi[k][0],hi[k][1],hi[k][2],hi[k][3]}
    o[d0]=__builtin_amdgcn_mfma_f32_32x32x16_bf16(pa0,PK(0),o[d0],0,0,0);
    o[d0]=__builtin_amdgcn_mfma_f32_32x32x16_bf16(pa1,PK(1),o[d0],0,0,0);
    o[d0]=__builtin_amdgcn_mfma_f32_32x32x16_bf16(pa2,PK(2),o[d0],0,0,0);
    o[d0]=__builtin_amdgcn_mfma_f32_32x32x16_bf16(pa3,PK(3),o[d0],0,0,0);
    #undef PK
  }
}

#ifndef ATTN_STORE16
#define ATTN_STORE16(p,v) (*(u32x4*)(p)=(v))
#endif
template<int THRL> __device__ __forceinline__ void attn_unit(int q0,const bf16*Qu,const bf16*__restrict__ Kh,const bf16*__restrict__ Vh,bf16*Ou,char*shm){
  int tid_=threadIdx.x; asm volatile("":"+v"(tid_)); const int tid=tid_,lane=tid&63,r32=lane&31,hi=lane>>5; const int wid=__builtin_amdgcn_readfirstlane(tid>>6);
  const bf16*Qw=Qu+(long)(wid*QBLK)*PQ;
  const unsigned lds0=(unsigned)(uintptr_t)shm;
  float*wsf=(float*)(shm+LDS_WS)+wid*64;
  const bf16*ksrc=Kh+(long)lane*PQ+wid*8;
  const bf16*vsrc=Vh+(long)(16*(wid&3)+(lane>>2))*PQ+(wid>>2)*32+(lane&3)*8;
  const unsigned kdst=lds0+LDS_K+wid*1024, vdst=lds0+LDS_V+wid*1024;
  #define DMA_K(t,slot) glds16(ksrc+(long)(t)*KVBLK*PQ,(unsigned)__builtin_amdgcn_readfirstlane(kdst+(slot)))
  #define DMA_V(t,slot) glds16(vsrc+(long)(t)*KVBLK*PQ,(unsigned)__builtin_amdgcn_readfirstlane(vdst+(slot)))
  const int vb0=(int)(lds0+LDS_V)+((lane>>4)&1)*32+(lane&3)*8+(4*hi+((lane&15)>>2))*64;
  const char*Kbase=shm+LDS_K; bf16x8 kf[8];
  const lds_cptr shm3=(lds_cptr)shm; const lds_cptr kp0=shm3+LDS_K+hi*1024+r32*16; const lds_cptr vp0=shm3+LDS_V+((lane>>4)&1)*32+(lane&3)*8+(4*hi+((lane&15)>>2))*64;
  const int NT=(q0+QB)/KVBLK+1;
  DMA_K(0,0);DMA_V(0,0);DMA_K(1,SLOTB);
  bf16x8 qr[4];
  #pragma unroll
  for(int d0=0;d0<4;++d0)qr[d0]=*reinterpret_cast<const bf16x8*>(&Qw[(long)r32*PQ+d0*16+hi*8]);
  float mhat=0.f,l_reg=0.f;f32x16 o[2];o[0]=f32x16{};o[1]=f32x16{};f32x16 negm=f32x16{};asm volatile("":"+v"(negm));
  const int qrel=wid*QBLK+r32;
  #define CMASK(P0,P1,t) do{int jb_=(t)-(NT-4); if(jb_>=0)cmask(P0,P1,jb_,qrel,hi);}while(0)
  bool resc=false;
  #define START(P0,P1) do{ const float rm=rowmax(P0,P1); resc=false; \
    { const float dl=rm; mhat=fadd_s(mhat,dl); \
      _Pragma("unroll") for(int r=0;r<16;++r){P0[r]=fsub_s(P0[r],dl);P1[r]=fsub_s(P1[r],dl);} \
      _Pragma("unroll") for(int r=0;r<16;++r)negm[r]=-mhat; asm volatile("":"+v"(negm)); } \
    _Pragma("unroll") for(int r=0;r<16;++r)P0[r]=__builtin_amdgcn_exp2f(P0[r]); }while(0)
  #define RESC() do{ if(resc){ asm volatile("s_waitcnt lgkmcnt(0)":::"memory"); \
      _Pragma("unroll") for(int d_=0;d_<2;++d_) _Pragma("unroll") for(int r=0;r<16;++r)o[d_][r]*=wsf[crow(r,hi)]; } }while(0)
  f32x16 pA0,pA1,pB0,pB1;
  int sl_prev=0,sl_cur=0,sl_next=SLOTB;
  #define ROT() do{sl_prev=sl_cur;sl_cur=sl_next;sl_next=(sl_next==(NSLOT-1)*SLOTB)?0:sl_next+SLOTB;}while(0)
  DMA_K(2,2*SLOTB);
  WAIT_BAR(3);
  qkt(pA0,pA1,Kbase,qr,negm,r32,hi);asm volatile("s_nop 15\n\ts_nop 7":"+v"(pA0),"+v"(pA1));
  { const float NEGI=-INFINITY; _Pragma("unroll") for(int r=8;r<16;++r)pA0[r]=NEGI; _Pragma("unroll") for(int r=0;r<16;++r)pA1[r]=NEGI; }
  START(pA0,pA1);
  _Pragma("unroll") for(int r=0;r<16;++r)pA1[r]=__builtin_amdgcn_exp2f(pA1[r]);
  WAIT_BAR(0);
  DMA_K(3,0);DMA_V(1,SLOTB);
  ROT();
  kload8(kf,kp0+sl_cur);
  WAIT_BAR(2);
  s16x4 vlo[8],vhi[8]; u32x4 pw0,pw1,pw2,pw3;
  #define PKW(P,B) cvtpk_s(P[B],P[B+1])
  #define PAF(k) __builtin_bit_cast(bf16x8,pw##k)
  #define VFR(i) (bf16x8){vlo[i][0],vlo[i][1],vlo[i][2],vlo[i][3],vhi[i][0],vhi[i][1],vhi[i][2],vhi[i][3]}
  #define PIN(x) asm volatile("":"+v"(x))
  #define MX3(a,b,c) __builtin_fmaxf(__builtin_fmaxf((a),(b)),(c))
  #define GAPA(MF,A0,A1,A2,A3,W0,W1,PW) do{ MF; sacc+=A0; sacc+=A1; sacc+=A2; sacc+=A3; PIN(sacc); W0; W1; PIN(PW); SBAR(); }while(0)
  #define EX(v) __builtin_amdgcn_exp2f(v)
  #define GAPB(MF,X,B) do{ MF; X[B]=EX(X[B]); X[B+1]=EX(X[B+1]); X[B+2]=EX(X[B+2]); X[B+3]=EX(X[B+3]); PIN(X); SBAR(); }while(0)
  #define VRD(i) do{ vlo[i]=vtr(vp_+(((i)>>2)*4096+((i)&3)*1024)); vhi[i]=vtr(vp_+(((i)>>2)*4096+((i)&3)*1024+512)); }while(0)
  #define KRD(G,j) do{ if(G){ kload2(kf,kp0+sl_next,j); SBAR(); } }while(0)
  #define STEP(C0,C1,P0,P1,t,GK,GV,GL) do{ SBAR(); \
    const lds_cptr vp_=vp0+sl_prev; \
    VRD(0); SBAR(); float sacc=(P0[0]+P0[1]); \
    GAPA(C0=__builtin_amdgcn_mfma_f32_32x32x16_bf16(kf[0],qr[0],negm,0,0,0), P0[2],P0[3],P0[4],P0[5],     pw0[0]=PKW(P0,0), pw0[1]=PKW(P0,2), pw0); \
    VRD(4); SBAR(); GAPA(C1=__builtin_amdgcn_mfma_f32_32x32x16_bf16(kf[1],qr[0],negm,0,0,0), P0[6],P0[7],P0[8],P0[9],     pw0[2]=PKW(P0,4), pw0[3]=PKW(P0,6), pw0); \
    VRD(1); SBAR(); GAPA(C0=__builtin_amdgcn_mfma_f32_32x32x16_bf16(kf[2],qr[1],C0,0,0,0),   P0[10],P0[11],P0[12],P0[13], pw1[0]=PKW(P0,8), pw1[1]=PKW(P0,10), pw1); \
    VRD(5); SBAR(); GAPA(C1=__builtin_amdgcn_mfma_f32_32x32x16_bf16(kf[3],qr[1],C1,0,0,0),   P0[14],P0[15],P1[0],P1[1],   pw1[2]=PKW(P0,12),pw1[3]=PKW(P0,14), pw1); \
    VRD(2); SBAR(); GAPA(C0=__builtin_amdgcn_mfma_f32_32x32x16_bf16(kf[4],qr[2],C0,0,0,0),   P1[2],P1[3],P1[4],P1[5],     pw2[0]=PKW(P1,0), pw2[1]=PKW(P1,2), pw2); \
    VRD(6); SBAR(); GAPA(C1=__builtin_amdgcn_mfma_f32_32x32x16_bf16(kf[5],qr[2],C1,0,0,0),   P1[6],P1[7],P1[8],P1[9],     pw2[2]=PKW(P1,4), pw2[3]=PKW(P1,6), pw2); \
    VRD(3); SBAR(); GAPA(C0=__builtin_amdgcn_mfma_f32_32x32x16_bf16(kf[6],qr[3],C0,0,0,0),   P1[10],P1[11],P1[12],P1[13], pw3[0]=PKW(P1,8), pw3[1]=PKW(P1,10), pw3); \
    VRD(7); SBAR(); GAPA(C1=__builtin_amdgcn_mfma_f32_32x32x16_bf16(kf[7],qr[3],C1,0,0,0),   P1[14],P1[15],0.f,0.f,       pw3[2]=PKW(P1,12),pw3[3]=PKW(P1,14), pw3); \
    l_reg+=sacc; \
    if(GK){DMA_K((t)+3,sl_cur);} if(GV){DMA_V((t)+1,sl_next);} \
    CMASK(C0,C1,t); \
    { float a=MX3(C0[0],C0[1],C1[0]),b=MX3(C0[2],C0[3],C1[1]); a=MX3(a,C1[2],C1[3]); \
      _Pragma("unroll") for(int r=4;r<16;r+=4){a=MX3(a,C0[r],C0[r+1]);b=MX3(b,C0[r+2],C0[r+3]);a=MX3(a,C1[r],C1[r+1]);b=MX3(b,C1[r+2],C1[r+3]);} \
      float rm=__builtin_fmaxf(a,b); { auto rr=__builtin_amdgcn_permlane32_swap(__float_as_uint(rm),__float_as_uint(rm),false,false); rm=__builtin_fmaxf(__uint_as_float(rr[0]),__uint_as_float(rr[1])); } \
      resc=false; \
      if(__builtin_expect(__any(rm>(float)THRL),0)){ const float dl=__builtin_fmaxf(rm,0.f); mhat+=dl; \
        _Pragma("unroll") for(int r=0;r<16;++r){C0[r]-=dl;C1[r]-=dl;} \
        _Pragma("unroll") for(int r=0;r<16;++r)negm[r]=-mhat; asm volatile("":"+v"(negm)); \
        const float f=__builtin_amdgcn_exp2f(-dl); l_reg*=f; if(hi==0)wsf[r32]=f; resc=true; } } \
    SBAR(); \
    GAPB(o[0]=__builtin_amdgcn_mfma_f32_32x32x16_bf16(PAF(0),VFR(0),o[0],0,0,0), C0,0); \
    GAPB(o[1]=__builtin_amdgcn_mfma_f32_32x32x16_bf16(PAF(0),VFR(4),o[1],0,0,0), C0,4); \
    KRD(GL,0); GAPB(o[0]=__builtin_amdgcn_mfma_f32_32x32x16_bf16(PAF(1),VFR(1),o[0],0,0,0), C0,8); \
    KRD(GL,1); GAPB(o[1]=__builtin_amdgcn_mfma_f32_32x32x16_bf16(PAF(1),VFR(5),o[1],0,0,0), C0,12); \
    KRD(GL,2); GAPB(o[0]=__builtin_amdgcn_mfma_f32_32x32x16_bf16(PAF(2),VFR(2),o[0],0,0,0), C1,0); \
    KRD(GL,3); GAPB(o[1]=__builtin_amdgcn_mfma_f32_32x32x16_bf16(PAF(2),VFR(6),o[1],0,0,0), C1,4); \
    GAPB(o[0]=__builtin_amdgcn_mfma_f32_32x32x16_bf16(PAF(3),VFR(3),o[0],0,0,0), C1,8); \
    GAPB(o[1]=__builtin_amdgcn_mfma_f32_32x32x16_bf16(PAF(3),VFR(7),o[1],0,0,0), C1,12); \
    }while(0)
  int t=1;
  #undef CMASK
  #define CMASK(P0,P1,t) do{}while(0)
  for(;t+5<NT;t+=2){
    STEP(pB0,pB1,pA0,pA1,t,true,true,true);     WAIT_BAR(2); RESC(); ROT();
    STEP(pA0,pA1,pB0,pB1,t+1,true,true,true);   WAIT_BAR(2); RESC(); ROT();
  }
  #undef CMASK
  #define CMASK(P0,P1,t) do{int jb_=(t)-(NT-4); if(jb_>=0)cmask(P0,P1,jb_,qrel,hi);}while(0)
  #define ENDW(tt) do{ if((tt)+3<NT){WAIT_BAR(2);} else if((tt)+2<NT){WAIT_BAR(1);} else {WAIT_BAR(0);} }while(0)
  for(;t+1<NT;t+=2){
    STEP(pB0,pB1,pA0,pA1,t,(t+3<NT),(t+1<NT),(t+1<NT));       ENDW(t);   RESC(); ROT();
    STEP(pA0,pA1,pB0,pB1,t+1,(t+4<NT),(t+2<NT),(t+2<NT));     ENDW(t+1); RESC(); ROT();
  }
  { float sacc=pA0[0]+pA0[1]; _Pragma("unroll") for(int r=2;r<16;++r)sacc+=pA0[r]; _Pragma("unroll") for(int r=0;r<16;++r)sacc+=pA1[r]; l_reg+=sacc;
    pw0=(u32x4){PKW(pA0,0),PKW(pA0,2),PKW(pA0,4),PKW(pA0,6)};pw1=(u32x4){PKW(pA0,8),PKW(pA0,10),PKW(pA0,12),PKW(pA0,14)};pw2=(u32x4){PKW(pA1,0),PKW(pA1,2),PKW(pA1,4),PKW(pA1,6)};pw3=(u32x4){PKW(pA1,8),PKW(pA1,10),PKW(pA1,12),PKW(pA1,14)};
    SBAR(); pv(o,vb0+sl_prev,PAF(0),PAF(1),PAF(2),PAF(3)); }
  #undef PKW
  #undef PAF
  #undef VFR
  #undef PIN
  #undef MX3
  #undef GAPA
  #undef GAPB
  #undef EX
  #undef VRD
  #undef KRD
  #undef STEP
  #undef ENDW
  {auto rr=__builtin_amdgcn_permlane32_swap(__float_as_uint(l_reg),__float_as_uint(l_reg),false,false);l_reg=__uint_as_float(rr[0])+__uint_as_float(rr[1]);}
  if(hi==0)wsf[32+r32]=l_reg;asm volatile("s_waitcnt lgkmcnt(0)":::"memory");
  float rli[16];
  #pragma unroll
  for(int r=0;r<16;++r)rli[r]=__builtin_amdgcn_rcpf(wsf[32+crow(r,hi)]);
  bf16*Ow=Ou+(long)(wid*QBLK)*PO;
  { bf16*stg=(bf16*)(shm+LDS_OST)+wid*2048;
    #pragma unroll
    for(int r=0;r<16;++r){const int orow=crow(r,hi);
      #pragma unroll
      for(int d0=0;d0<2;++d0)stg[orow*64+d0*32+r32]=__float2bfloat16(o[d0][r]*rli[r]);}
    asm volatile("s_waitcnt lgkmcnt(0)":::"memory");
    #pragma unroll
    for(int i=0;i<4;++i){const int row=i*8+(lane>>3),ch=lane&7; const u32x4 v=*(const u32x4*)(stg+row*64+ch*8); ATTN_STORE16(Ow+(long)row*PO+ch*8,v);} }
  asm volatile("s_waitcnt lgkmcnt(0)\n\ts_barrier":::"memory");
  #undef DMA_K
  #undef DMA_V
  #undef CMASK
  #undef START
  #undef RESC
  #undef ROT
}
constexpr int ATTN_LDS_BYTES=LDS_BYTES;
#undef SBAR
#undef WAIT_BAR
typedef float f32x4v __attribute__((ext_vector_type(4)));
constexpr int V2_SLOTV=16384, V2_LDS_K=0, V2_LDS_V=NSLOT*SLOTB, V2_LDS_WS=V2_LDS_V+NSLOT*V2_SLOTV, V2_LDS_OST=V2_LDS_WS+NW*64*4, V2_LDS_BYTES=V2_LDS_OST+NW*8192;
#define SBAR() __builtin_amdgcn_sched_barrier(0)
#define WAIT_BAR(N) asm volatile("s_waitcnt vmcnt(" #N ") lgkmcnt(0)\n\ts_barrier":::"memory")
__device__ __forceinline__ void pv4(f32x16*o,int vb,bf16x8 pa0,bf16x8 pa1,bf16x8 pa2,bf16x8 pa3){
  #pragma unroll
  for(int d0=0;d0<4;++d0){s16x4 lo[4],hi[4];
    #pragma unroll
    for(int ks=0;ks<4;++ks){
      asm volatile("ds_read_b64_tr_b16 %0,%1 offset:%c2":"=&v"(lo[ks]):"v"(vb),"i"(d0*4096+ks*1024):"memory");
      asm volatile("ds_read_b64_tr_b16 %0,%1 offset:%c2":"=&v"(hi[ks]):"v"(vb),"i"(d0*4096+ks*1024+512):"memory");}
    asm volatile("s_waitcnt lgkmcnt(0)":::"memory");SBAR();
    #define PK(k) (bf16x8){lo[k][0],lo[k][1],lo[k][2],lo[k][3],hi[k][0],hi[k][1],hi[k][2],hi[k][3]}
    o[d0]=__builtin_amdgcn_mfma_f32_32x32x16_bf16(pa0,PK(0),o[d0],0,0,0);
    o[d0]=__builtin_amdgcn_mfma_f32_32x32x16_bf16(pa1,PK(1),o[d0],0,0,0);
    o[d0]=__builtin_amdgcn_mfma_f32_32x32x16_bf16(pa2,PK(2),o[d0],0,0,0);
    o[d0]=__builtin_amdgcn_mfma_f32_32x32x16_bf16(pa3,PK(3),o[d0],0,0,0);
    #undef PK
  }
}
template<int MODE> __device__ __forceinline__ void attn_unit128(int q0,const bf16*Qu,const bf16*__restrict__ Kh,const bf16*__restrict__ Vh,bf16*Ou,char*shm,float lam,float oscale,const float*subg){
  int tid_=threadIdx.x; asm volatile("":"+v"(tid_)); const int tid=tid_,lane=tid&63,r32=lane&31,hi=lane>>5; const int wid=__builtin_amdgcn_readfirstlane(tid>>6);
  const bf16*Qw=Qu+(long)(wid*QBLK)*PQ;
  const unsigned lds0=(unsigned)(uintptr_t)shm;
  float*wsf=(float*)(shm+V2_LDS_WS)+wid*64;
  const bf16*ksrc=Kh+(long)lane*PQ+wid*8;
  const bf16*vsrc=Vh+(long)(16*(wid&3)+(lane>>2))*PQ+(wid>>2)*32+(lane&3)*8;
  const unsigned kdst=lds0+V2_LDS_K+wid*1024, vdst=lds0+V2_LDS_V+wid*1024;
  #define DMA_K(t,slot) glds16(ksrc+(long)(t)*KVBLK*PQ,(unsigned)__builtin_amdgcn_readfirstlane(kdst+(slot)))
  #define DMA_V(t,slot) do{ glds16(vsrc+(long)(t)*KVBLK*PQ,(unsigned)__builtin_amdgcn_readfirstlane(vdst+2*(slot))); glds16(vsrc+(long)(t)*KVBLK*PQ+64,(unsigned)__builtin_amdgcn_readfirstlane(vdst+2*(slot)+8192)); }while(0)
  const int vb0=(int)(lds0+V2_LDS_V)+((lane>>4)&1)*32+(lane&3)*8+(4*hi+((lane&15)>>2))*64;
  const char*Kbase=shm+V2_LDS_K; bf16x8 kf[8];
  const lds_cptr shm3=(lds_cptr)shm; const lds_cptr kp0=shm3+V2_LDS_K+hi*1024+r32*16; const lds_cptr vp0=shm3+V2_LDS_V+((lane>>4)&1)*32+(lane&3)*8+(4*hi+((lane&15)>>2))*64;
  const int NT=(q0+QB)/KVBLK+1;
  DMA_K(0,0);DMA_V(0,0);DMA_K(1,SLOTB);
  bf16x8 qr[4];
  #pragma unroll
  for(int d0=0;d0<4;++d0)qr[d0]=*reinterpret_cast<const bf16x8*>(&Qw[(long)r32*PQ+d0*16+hi*8]);
  float l_reg=0.f;f32x16 o[4];o[0]=f32x16{};o[1]=f32x16{};o[2]=f32x16{};o[3]=f32x16{};
  const f32x16 zero16=f32x16{};
  const int qrel=wid*QBLK+r32;
  #define CMASK(P0,P1,t) do{int jb_=(t)-(NT-4); if(jb_>=0)cmask(P0,P1,jb_,qrel,hi);}while(0)
  f32x16 pA0,pA1,pB0,pB1;
  int sl_prev=0,sl_cur=0,sl_next=SLOTB;
  #define ROT() do{sl_prev=sl_cur;sl_cur=sl_next;sl_next=(sl_next==(NSLOT-1)*SLOTB)?0:sl_next+SLOTB;}while(0)
  DMA_K(2,2*SLOTB);
  WAIT_BAR(3);
  qkt(pA0,pA1,Kbase,qr,zero16,r32,hi);asm volatile("s_nop 15\n\ts_nop 7":"+v"(pA0),"+v"(pA1));
  { const float NEGI=-INFINITY; _Pragma("unroll") for(int r=8;r<16;++r)pA0[r]=NEGI; _Pragma("unroll") for(int r=0;r<16;++r)pA1[r]=NEGI; }
  _Pragma("unroll") for(int r=0;r<16;++r){pA0[r]=__builtin_amdgcn_exp2f(pA0[r]);pA1[r]=__builtin_amdgcn_exp2f(pA1[r]);}
  WAIT_BAR(0);
  DMA_K(3,0);DMA_V(1,SLOTB);
  ROT();
  kload8(kf,kp0+sl_cur);
  WAIT_BAR(3);
  s16x4 vlo[8],vhi[8]; u32x4 pw0,pw1,pw2,pw3;
  #define PKW(P,B) cvtpk_s(P[B],P[B+1])
  #define PAF(k) __builtin_bit_cast(bf16x8,pw##k)
  #define VFR(i) (bf16x8){vlo[i][0],vlo[i][1],vlo[i][2],vlo[i][3],vhi[i][0],vhi[i][1],vhi[i][2],vhi[i][3]}
  #define PIN(x) asm volatile("":"+v"(x))
  #define GAPA(MF,A0,A1,A2,A3,W0,W1,PW) do{ MF; sacc+=A0; sacc+=A1; sacc+=A2; sacc+=A3; PIN(sacc); W0; W1; PIN(PW); SBAR(); }while(0)
  #define EX(v) __builtin_amdgcn_exp2f(v)
  #define GAPB(MF,X,B) do{ MF; X[B]=EX(X[B]); X[B+1]=EX(X[B+1]); PIN(X); SBAR(); }while(0)
  #define VRD(i) do{ vlo[i]=vtr(vp_+(((i)>>2)*4096+((i)&3)*1024)); vhi[i]=vtr(vp_+(((i)>>2)*4096+((i)&3)*1024+512)); }while(0)
  #define VRD2(i) do{ vlo[i]=vtr(vp_+(8192+((i)>>2)*4096+((i)&3)*1024)); vhi[i]=vtr(vp_+(8192+((i)>>2)*4096+((i)&3)*1024+512)); SBAR(); }while(0)
  #define KRD(G,j) do{ if(G){ kload2(kf,kp0+sl_next,j); SBAR(); } }while(0)
  #define MF32(a,b,c) __builtin_amdgcn_mfma_f32_32x32x16_bf16(a,b,c,0,0,0)
  #define STEP(C0,C1,P0,P1,t,GK,GV,GL) do{ SBAR(); \
    const lds_cptr vp_=vp0+2*sl_prev; \
    VRD(0); SBAR(); float sacc=(P0[0]+P0[1]); \
    GAPA(C0=MF32(kf[0],qr[0],zero16), P0[2],P0[3],P0[4],P0[5],     pw0[0]=PKW(P0,0), pw0[1]=PKW(P0,2), pw0); \
    VRD(4); SBAR(); GAPA(C1=MF32(kf[1],qr[0],zero16), P0[6],P0[7],P0[8],P0[9],     pw0[2]=PKW(P0,4), pw0[3]=PKW(P0,6), pw0); \
    VRD(1); SBAR(); GAPA(C0=MF32(kf[2],qr[1],C0),   P0[10],P0[11],P0[12],P0[13], pw1[0]=PKW(P0,8), pw1[1]=PKW(P0,10), pw1); \
    VRD(5); SBAR(); GAPA(C1=MF32(kf[3],qr[1],C1),   P0[14],P0[15],P1[0],P1[1],   pw1[2]=PKW(P0,12),pw1[3]=PKW(P0,14), pw1); \
    VRD(2); SBAR(); GAPA(C0=MF32(kf[4],qr[2],C0),   P1[2],P1[3],P1[4],P1[5],     pw2[0]=PKW(P1,0), pw2[1]=PKW(P1,2), pw2); \
    VRD(6); SBAR(); GAPA(C1=MF32(kf[5],qr[2],C1),   P1[6],P1[7],P1[8],P1[9],     pw2[2]=PKW(P1,4), pw2[3]=PKW(P1,6), pw2); \
    VRD(3); SBAR(); GAPA(C0=MF32(kf[6],qr[3],C0),   P1[10],P1[11],P1[12],P1[13], pw3[0]=PKW(P1,8), pw3[1]=PKW(P1,10), pw3); \
    VRD(7); SBAR(); GAPA(C1=MF32(kf[7],qr[3],C1),   P1[14],P1[15],0.f,0.f,       pw3[2]=PKW(P1,12),pw3[3]=PKW(P1,14), pw3); \
    l_reg+=sacc; \
    if(GK){DMA_K((t)+3,sl_cur);} if(GV){DMA_V((t)+1,sl_next);} \
    CMASK(C0,C1,t); \
    SBAR(); \
    GAPB(o[0]=MF32(PAF(0),VFR(0),o[0]), C0,0);  VRD2(0); \
    GAPB(o[1]=MF32(PAF(0),VFR(4),o[1]), C0,2);  VRD2(4); \
    KRD(GL,0); GAPB(o[0]=MF32(PAF(1),VFR(1),o[0]), C0,4);  VRD2(1); \
    KRD(GL,1); GAPB(o[1]=MF32(PAF(1),VFR(5),o[1]), C0,6);  VRD2(5); \
    KRD(GL,2); GAPB(o[0]=MF32(PAF(2),VFR(2),o[0]), C0,8);  VRD2(2); \
    KRD(GL,3); GAPB(o[1]=MF32(PAF(2),VFR(6),o[1]), C0,10); VRD2(6); \
    GAPB(o[0]=MF32(PAF(3),VFR(3),o[0]), C0,12); VRD2(3); \
    GAPB(o[1]=MF32(PAF(3),VFR(7),o[1]), C0,14); VRD2(7); \
    GAPB(o[2]=MF32(PAF(0),VFR(0),o[2]), C1,0); \
    GAPB(o[3]=MF32(PAF(0),VFR(4),o[3]), C1,2); \
    GAPB(o[2]=MF32(PAF(1),VFR(1),o[2]), C1,4); \
    GAPB(o[3]=MF32(PAF(1),VFR(5),o[3]), C1,6); \
    GAPB(o[2]=MF32(PAF(2),VFR(2),o[2]), C1,8); \
    GAPB(o[3]=MF32(PAF(2),VFR(6),o[3]), C1,10); \
    GAPB(o[2]=MF32(PAF(3),VFR(3),o[2]), C1,12); \
    GAPB(o[3]=MF32(PAF(3),VFR(7),o[3]), C1,14); \
    }while(0)
  int t=1;
  #undef CMASK
  #define CMASK(P0,P1,t) do{}while(0)
  for(;t+5<NT;t+=2){
    STEP(pB0,pB1,pA0,pA1,t,true,true,true);     WAIT_BAR(3); ROT();
    STEP(pA0,pA1,pB0,pB1,t+1,true,true,true);   WAIT_BAR(3); ROT();
  }
  #undef CMASK
  #define CMASK(P0,P1,t) do{int jb_=(t)-(NT-4); if(jb_>=0)cmask(P0,P1,jb_,qrel,hi);}while(0)
  #define ENDW(tt) do{ if((tt)+3<NT){WAIT_BAR(3);} else if((tt)+2<NT){WAIT_BAR(2);} else {WAIT_BAR(0);} }while(0)
  for(;t+1<NT;t+=2){
    STEP(pB0,pB1,pA0,pA1,t,(t+3<NT),(t+1<NT),(t+1<NT));       ENDW(t);   ROT();
    STEP(pA0,pA1,pB0,pB1,t+1,(t+4<NT),(t+2<NT),(t+2<NT));     ENDW(t+1); ROT();
  }
  { float sacc=pA0[0]+pA0[1]; _Pragma("unroll") for(int r=2;r<16;++r)sacc+=pA0[r]; _Pragma("unroll") for(int r=0;r<16;++r)sacc+=pA1[r]; l_reg+=sacc;
    pw0=(u32x4){PKW(pA0,0),PKW(pA0,2),PKW(pA0,4),PKW(pA0,6)};pw1=(u32x4){PKW(pA0,8),PKW(pA0,10),PKW(pA0,12),PKW(pA0,14)};pw2=(u32x4){PKW(pA1,0),PKW(pA1,2),PKW(pA1,4),PKW(pA1,6)};pw3=(u32x4){PKW(pA1,8),PKW(pA1,10),PKW(pA1,12),PKW(pA1,14)};
    SBAR(); pv4(o,vb0+2*sl_prev,PAF(0),PAF(1),PAF(2),PAF(3)); }
  #undef PKW
  #undef PAF
  #undef VFR
  #undef PIN
  #undef GAPA
  #undef GAPB
  #undef EX
  #undef VRD
  #undef VRD2
  #undef KRD
  #undef MF32
  #undef STEP
  #undef ENDW
  {auto rr=__builtin_amdgcn_permlane32_swap(__float_as_uint(l_reg),__float_as_uint(l_reg),false,false);l_reg=__uint_as_float(rr[0])+__uint_as_float(rr[1]);}
  if(hi==0)wsf[32+r32]=l_reg;asm volatile("s_waitcnt lgkmcnt(0)":::"memory");
  float rli[16];
  #pragma unroll
  for(int r=0;r<16;++r)rli[r]=__builtin_amdgcn_rcpf(wsf[32+crow(r,hi)]);
  { bf16*park=(bf16*)(shm+V2_LDS_OST)+wid*4096;
    if(MODE==0){
      #pragma unroll
      for(int r=0;r<16;++r){const int orow=crow(r,hi);
        #pragma unroll
        for(int d0=0;d0<4;++d0)park[orow*128+d0*32+r32]=__float2bfloat16(o[d0][r]*rli[r]);}
      asm volatile("s_waitcnt lgkmcnt(0)":::"memory");
    } else {
      #pragma unroll
      for(int r=0;r<16;++r){const int orow=crow(r,hi);
        #pragma unroll
        for(int d0=0;d0<4;++d0){const float o1=__bfloat162float(park[orow*128+d0*32+r32]); park[orow*128+d0*32+r32]=__float2bfloat16(o1-lam*(o[d0][r]*rli[r]));}}
      asm volatile("s_waitcnt lgkmcnt(0)":::"memory");
      bf16*Ow=Ou+(long)(wid*QBLK)*PO;
      const int ch=lane&15; const f32x4v g0=*(const f32x4v*)(subg+8*ch), g1=*(const f32x4v*)(subg+8*ch+4);
      #pragma unroll
      for(int i=0;i<8;++i){const int row=i*4+(lane>>4); const u32x4 v=*(const u32x4*)(park+row*128+ch*8);
        float d[8]; d[0]=__uint_as_float(v.x<<16);d[1]=__uint_as_float(v.x&0xffff0000u);d[2]=__uint_as_float(v.y<<16);d[3]=__uint_as_float(v.y&0xffff0000u);d[4]=__uint_as_float(v.z<<16);d[5]=__uint_as_float(v.z&0xffff0000u);d[6]=__uint_as_float(v.w<<16);d[7]=__uint_as_float(v.w&0xffff0000u);
        float ss=(d[0]*d[0]+d[1]*d[1])+(d[2]*d[2]+d[3]*d[3])+(d[4]*d[4]+d[5]*d[5])+(d[6]*d[6]+d[7]*d[7]);
        ss+=__shfl_xor(ss,1);ss+=__shfl_xor(ss,2);ss+=__shfl_xor(ss,4);ss+=__shfl_xor(ss,8);
        const float rs=__builtin_amdgcn_rsqf(ss*(1.0f/128.0f)+1e-6f)*oscale;
        u32x4 w; w.x=cvtpk_s(d[0]*rs*g0[0],d[1]*rs*g0[1]); w.y=cvtpk_s(d[2]*rs*g0[2],d[3]*rs*g0[3]); w.z=cvtpk_s(d[4]*rs*g1[0],d[5]*rs*g1[1]); w.w=cvtpk_s(d[6]*rs*g1[2],d[7]*rs*g1[3]);
        ATTN_STORE16(Ow+(long)row*PO+ch*8,w);}
      asm volatile("s_waitcnt lgkmcnt(0)":::"memory");
    } }
  asm volatile("s_waitcnt lgkmcnt(0)\n\ts_barrier":::"memory");
  #undef DMA_K
  #undef DMA_V
  #undef CMASK
  #undef ROT
}
#undef SBAR
#undef WAIT_BAR

}
namespace cg = cooperative_groups;
constexpr int NWAVES = 8;
constexpr int NB = 4, SEQ = 8192, DM = 1024, NMETA = 16, DIN = 2560, DFF = 4096, DCONV = 512, CONVW = 31;
constexpr int MX = NB * SEQ;
constexpr int MP = MX + 256;
constexpr int SPAD = pg8::SPAD;
constexpr float EPS = 1e-6f;
constexpr size_t MiB = 1u << 20;
constexpr size_t WS_CTL = 0, WS_WIN = 1 * MiB, WS_WOUT = 6 * MiB, WS_WUP = 8 * MiB, WS_WDN = 16 * MiB, WS_ROPE = 24 * MiB, WS_SSQ = 25 * MiB, WS_RN = 27 * MiB,
                 WS_H1B = 28 * MiB, WS_MIX = 92 * MiB, WS_HB = 156 * MiB, WS_XN = 156 * MiB, WS_O = 156 * MiB, WS_Q = 222 * MiB, WS_K = 254 * MiB, WS_V = 287 * MiB, WS_G = 320 * MiB,
                 WS_END = 412 * MiB;
static_assert(WS_XN + (size_t)MP * DM * 2 <= WS_Q && WS_K + (size_t)NB * SPAD * 512 * 2 <= WS_V && WS_G + (size_t)NB * SPAD * 512 * 2 <= WS_HB + (size_t)MX * DFF * 2 && WS_HB + (size_t)MX * DFF * 2 <= WS_END, "d_ws map");
constexpr int RING_BYTES = 131072, LDS_BYTES = 147456;
#ifndef WGM_P1
#define WGM_P1 4
#endif
#ifndef WGM_P4
#define WGM_P4 4
#endif
#ifndef WGM_P35
#define WGM_P35 4
#endif

#define LAS __attribute__((address_space(3)))
typedef unsigned short bf16;
typedef unsigned v4u __attribute__((ext_vector_type(4)));
typedef float f32x4 __attribute__((ext_vector_type(4)));
typedef float f32x2 __attribute__((ext_vector_type(2)));
#define LDS_WAIT() asm volatile("s_waitcnt lgkmcnt(0)" ::: "memory")
__device__ __forceinline__ unsigned pk2(float lo, float hi) { return pg8::cvt_pk_bf16(lo, hi); }
__device__ __forceinline__ float bf_lo(unsigned u) { return __uint_as_float(u << 16); }
__device__ __forceinline__ float bf_hi(unsigned u) { return __uint_as_float(u & 0xffff0000u); }
__device__ __forceinline__ float wave_sum(float v) {
#pragma unroll
    for (int o = 1; o < 64; o <<= 1) v += __shfl_xor(v, o);
    return v;
}

#define XB_TMO      128
#define XB_XCNT(j)  (256  + 64 * (j))
#define XB_XSUB(j)  (1280 + 64 * (j))
#define XB_XGEN(j)  (2304 + 64 * (j))
#define XB_TOP      3328
#define XB_TOPGEN   3392
#define XCD_BAR_WORDS 3456
#define XB_SPIN_CAP (1u << 18)

__device__ __forceinline__ unsigned xb_ld(unsigned* p)              { return __hip_atomic_load(p, __ATOMIC_RELAXED, __HIP_MEMORY_SCOPE_AGENT); }
__device__ __forceinline__ unsigned xb_add(unsigned* p, unsigned v) { return __hip_atomic_fetch_add(p, v, __ATOMIC_RELAXED, __HIP_MEMORY_SCOPE_AGENT); }
__device__ __forceinline__ unsigned xb_xcc_id() { return (unsigned)__builtin_amdgcn_s_getreg((3 << 11) | 20) & 0xFu; }
#define XB_SPIN(cond, bar) do { unsigned _sp = 0; while (cond) { __builtin_amdgcn_s_sleep(1); \
    if ((++_sp & 255u) == 0u) { if (xb_ld(&(bar)[XB_TMO])) break; if (_sp > XB_SPIN_CAP) { atomicAdd(&(bar)[XB_TMO], 1u); break; } } } } while (0)

struct XcdBarrier {
    unsigned* bar; unsigned x;
    volatile LAS unsigned* st;
};

__device__ __forceinline__ XcdBarrier xcd_barrier_post(unsigned* bar, volatile LAS unsigned* st) {
    XcdBarrier b; b.bar = bar; b.x = xb_xcc_id(); b.st = st;
    if (threadIdx.x == 0) (void)xb_add(&bar[XB_XCNT(b.x)], 1u);
    return b;
}
__device__ __forceinline__ void xcd_barrier_complete(unsigned* bar, unsigned x, unsigned& nloc, unsigned& nx) {
    const unsigned G = gridDim.x * gridDim.y * gridDim.z;
    unsigned sum, cnt, mine, sp = 0u;
    for (;;) {
        sum = 0u; cnt = 0u; mine = 0u;
#pragma unroll
        for (unsigned j = 0; j < 16; ++j) { const unsigned c = xb_ld(&bar[XB_XCNT(j)]); sum += c; cnt += (c > 0u) ? 1u : 0u; mine = (j == x) ? c : mine; }
        if (sum == G) break;
        __builtin_amdgcn_s_sleep(1);
        if ((++sp & 255u) == 0u) { if (xb_ld(&bar[XB_TMO])) break; if (sp > XB_SPIN_CAP) { atomicAdd(&bar[XB_TMO], 1u); break; } }
    }
    nloc = mine > 0u ? mine : 1u; nx = cnt > 0u ? cnt : 1u;
}

__device__ __forceinline__ void xcd_barrier(const XcdBarrier& b) {
    asm volatile("s_waitcnt vmcnt(0)" ::: "memory");
    __syncthreads();
    if (threadIdx.x == 0) {
        unsigned* bar = b.bar;
        __builtin_amdgcn_s_waitcnt(0);
        unsigned nloc = b.st[0], nx = b.st[1];
        if (nloc == 0u) { xcd_barrier_complete(bar, b.x, nloc, nx); b.st[0] = nloc; b.st[1] = nx; }
        const unsigned old = xb_add(&bar[XB_XSUB(b.x)], 1u);
        const unsigned gen = old / nloc;
        if (old + 1u == (gen + 1u) * nloc) {
            __builtin_amdgcn_fence(__ATOMIC_RELEASE, "agent");
            asm volatile("s_waitcnt vmcnt(0)" ::: "memory");
            const unsigned og = xb_add(&bar[XB_TOP], 1u);
            const unsigned tg = og / nx;
            if (og + 1u == (tg + 1u) * nx) xb_add(&bar[XB_TOPGEN], 1u);
            else XB_SPIN(xb_ld(&bar[XB_TOPGEN]) == tg, bar);
            __builtin_amdgcn_fence(__ATOMIC_ACQUIRE, "agent");
            xb_add(&bar[XB_XGEN(b.x)], 1u);
            asm volatile("s_waitcnt vmcnt(0)" ::: "memory");
        } else {
            XB_SPIN(xb_ld(&bar[XB_XGEN(b.x)]) == gen, bar);
            __builtin_amdgcn_fence(__ATOMIC_ACQUIRE, "agent");
            asm volatile("s_waitcnt vmcnt(0)" ::: "memory");
        }
    }
    __syncthreads();
}

__device__ __forceinline__ float dpp_add(float v, const int ctrl_sel) {
    int t;
    if (ctrl_sel == 0) t = __builtin_amdgcn_update_dpp(0, __float_as_int(v), 0xB1, 0xF, 0xF, true);
    else if (ctrl_sel == 1) t = __builtin_amdgcn_update_dpp(0, __float_as_int(v), 0x4E, 0xF, 0xF, true);
    else if (ctrl_sel == 2) t = __builtin_amdgcn_update_dpp(0, __float_as_int(v), 0x141, 0xF, 0xF, true);
    else t = __builtin_amdgcn_update_dpp(0, __float_as_int(v), 0x140, 0xF, 0xF, true);
    return v + __int_as_float(t);
}
__device__ __forceinline__ float wave_sum_fast(float v) {
    v = dpp_add(v, 0); v = dpp_add(v, 1); v = dpp_add(v, 2); v = dpp_add(v, 3);
    { auto rr = __builtin_amdgcn_permlane16_swap(__float_as_uint(v), __float_as_uint(v), false, false); v = __uint_as_float(rr[0]) + __uint_as_float(rr[1]); }
    { auto rr = __builtin_amdgcn_permlane32_swap(__float_as_uint(v), __float_as_uint(v), false, false); v = __uint_as_float(rr[0]) + __uint_as_float(rr[1]); }
    return v;
}

struct Args { const float* in[19]; float* out; unsigned char* ws; float inv_freq[8]; };
enum { I_X = 0, I_META, I_G1, I_WIN, I_QG, I_KG, I_LQ1, I_LK1, I_LQ2, I_LK2, I_SUBLN, I_CW, I_CB, I_CLG, I_CLB, I_WOUT, I_G2, I_WUP, I_WDN };

__device__ __forceinline__ void p0_transpose_item(const float* W, int K, int N, bf16* WT, int out_row0, int n0, int k0, const float* kscale, LAS float* scr, int lane) {
    float tv[32], ts[32];
#pragma unroll
    for (int i = 0; i < 32; ++i) { const int kk = 2 * i + (lane >> 5); tv[i] = W[(size_t)(k0 + kk) * N + n0 + (lane & 31)]; ts[i] = kscale ? kscale[k0 + kk] : 1.0f; }
#pragma unroll
    for (int i = 0; i < 32; ++i) { const int kk = 2 * i + (lane >> 5); scr[kk * 33 + (lane & 31)] = tv[i] * ts[i]; }
    LDS_WAIT(); asm volatile("" ::: "memory");
    const int c = lane & 7;
#pragma unroll
    for (int j = 0; j < 4; ++j) { const int n = (lane >> 3) + 8 * j; const LAS float* s = scr + (8 * c) * 33 + n;
        v4u o; o.x = pk2(s[0 * 33], s[1 * 33]); o.y = pk2(s[2 * 33], s[3 * 33]); o.z = pk2(s[4 * 33], s[5 * 33]); o.w = pk2(s[6 * 33], s[7 * 33]);
        *(v4u*)(WT + (size_t)(out_row0 + n) * K + k0 + 8 * c) = o; }
    LDS_WAIT(); asm volatile("" ::: "memory");
}
__device__ __forceinline__ int wup_pcol(int lc) { const int l = lc & 255; return (lc & ~255) + 128 * ((l >> 5) & 1) + 32 * (l >> 6); }
__device__ __forceinline__ int win_pcol(int lc) {
    if (lc < 1536) { const int l = lc & 255; return (lc & ~255) + 128 * ((l >> 5) & 1) + 32 * (l >> 6) + (l & 31); }
    if (lc < 2048) { const int ch = lc - 1536; return 1536 + 256 * (ch >> 7) + (ch & 127); }
    const int ch = lc - 2048; return 1536 + 256 * (ch >> 7) + 128 + (ch & 127);
}

__device__ __forceinline__ void p0_prologue(const Args& A, unsigned char* ws, LAS unsigned char* lds, int vcu, int G, int wave, int lane) {
    LAS float* scr = (LAS float*)(lds + wave * 16384);
    const int gw = vcu * NWAVES + wave, NGW = G * NWAVES;
    bf16* Win_t = (bf16*)(ws + WS_WIN); bf16* Wout_t = (bf16*)(ws + WS_WOUT); bf16* Wup_t = (bf16*)(ws + WS_WUP); bf16* Wdn_t = (bf16*)(ws + WS_WDN);
    constexpr int I_IN = (DM / 64) * (DIN / 32);
    for (int it = gw; it < I_IN; it += NGW) { const int nblk = DIN / 32, kb = it / nblk, nb = it % nblk; p0_transpose_item(A.in[I_WIN], DM, DIN, Win_t, win_pcol(32 * nb), 32 * nb, 64 * kb, nullptr, scr, lane); }
    {
        bf16* XN = (bf16*)(ws + WS_XN);
        f32x4 g[4];
#pragma unroll
        for (int j = 0; j < 4; ++j) g[j] = ((const f32x4*)A.in[I_G1])[lane + 64 * j];
        for (int m0 = gw; m0 < MX + NMETA; m0 += 4 * NGW) {
            f32x4 v[4][4];
#pragma unroll
            for (int q = 0; q < 4; ++q) { const int m = m0 + q * NGW; const bool ok = m < MX + NMETA;
                const float* src = !ok ? A.in[I_X] : (m < MX) ? A.in[I_X] + (size_t)m * DM : A.in[I_META] + (size_t)(m - MX) * DM;
                const f32x4* xr = (const f32x4*)src + lane;
#pragma unroll
                for (int j = 0; j < 4; ++j) v[q][j] = __builtin_nontemporal_load(xr + 64 * j); }
#pragma unroll
            for (int q = 0; q < 4; ++q) { const int m = m0 + q * NGW; if (m >= MX + NMETA) continue;
                float s = 0.f;
#pragma unroll
                for (int j = 0; j < 4; ++j) s += (v[q][j].x * v[q][j].x + v[q][j].y * v[q][j].y) + (v[q][j].z * v[q][j].z + v[q][j].w * v[q][j].w);
                const float ms = wave_sum_fast(s) * (1.f / DM) + EPS; const float rs = __builtin_amdgcn_rsqf(ms);
                if (lane == 0 && m < MX) ((float*)(ws + WS_RN))[m] = ms * rs;
                unsigned long long* o8 = (unsigned long long*)(XN + (size_t)m * DM) + lane;
#pragma unroll
                for (int j = 0; j < 4; ++j) { const f32x4 y = v[q][j] * rs * g[j]; o8[64 * j] = (unsigned long long)pk2(y.x, y.y) | ((unsigned long long)pk2(y.z, y.w) << 32); } }
        }
    }
    {
        float* rope = (float*)(ws + WS_ROPE);
        const int pos = gw * 64 + lane;
        if (pos < SEQ + NMETA) {
#pragma unroll
            for (int i = 0; i < 8; ++i) {
                const float angf = (float)pos * A.inv_freq[i];
                const double rev = (double)angf * 0.15915494309189533577; const double fr = rev - __builtin_rint(rev);
                const float f = (float)fr;
                rope[pos * 16 + i] = __builtin_amdgcn_cosf(f); rope[pos * 16 + 8 + i] = __builtin_amdgcn_sinf(f); } }
    }
    {
        bf16* KB = (bf16*)(ws + WS_K); bf16* VB = (bf16*)(ws + WS_V); bf16* GB = (bf16*)(ws + WS_G);
        for (int it = gw; it < NB * 48 * 3; it += NGW) { const int which = it / (NB * 48), r = it % (NB * 48), b = r / 48, rr = r % 48;
            bf16* p = which == 0 ? KB + (size_t)(b * SPAD + 16 + rr) * 512 : which == 1 ? VB + (size_t)(b * SPAD + 16 + rr) * 512 : GB + (size_t)(b * SPAD + rr) * 512;
            ((v4u*)p)[lane] = (v4u){0u, 0u, 0u, 0u}; }
    }
}

__device__ __forceinline__ void meta_proj(const Args& A, unsigned char* ws, LAS unsigned char* lds, int vcu, int wave, int lane) {
    typedef short bf16x8 __attribute__((ext_vector_type(8)));
    const int fr = lane & 15, fq = lane >> 4;
    const int item = vcu * 2 + (wave >> 2), kc = wave & 3;
    const int kind = item < 8 ? 0 : item < 16 ? 1 : 2, g = kind == 2 ? item - 16 : (item & 7);
    const bf16* XNm = (const bf16*)(ws + WS_XN) + (size_t)(MX + fr) * DM + 8 * fq + 256 * kc;
    const bf16* Wt = (const bf16*)(ws + WS_WIN);
    const bf16* brow[4];
#pragma unroll
    for (int nb = 0; nb < 4; ++nb) { const int lc = kind == 0 ? 512 + 64 * g + 16 * nb + fr : kind == 1 ? 1024 + 64 * g + 16 * nb + fr : (nb < 2 ? 1536 + 32 * g + 16 * nb + fr : 2048 + 32 * g + 16 * (nb - 2) + fr);
        brow[nb] = Wt + (size_t)(win_pcol(lc & ~31) + (lc & 31)) * DM + 8 * fq + 256 * kc; }
    bf16x8 af[8], bf[8][4];
#pragma unroll
    for (int ks = 0; ks < 8; ++ks) { af[ks] = *(const bf16x8*)(XNm + 32 * ks);
#pragma unroll
        for (int nb = 0; nb < 4; ++nb) bf[ks][nb] = *(const bf16x8*)(brow[nb] + 32 * ks); }
    asm volatile("" ::: "memory");
    f32x4 acc[4];
#pragma unroll
    for (int nb = 0; nb < 4; ++nb) acc[nb] = (f32x4){0.f, 0.f, 0.f, 0.f};
#pragma unroll
    for (int ks = 0; ks < 8; ++ks)
#pragma unroll
        for (int nb = 0; nb < 4; ++nb) acc[nb] = __builtin_amdgcn_mfma_f32_16x16x32_bf16(bf[ks][nb], af[ks], acc[nb], 0, 0, 0);
    LAS f32x4* red = (LAS f32x4*)lds;
#pragma unroll
    for (int nb = 0; nb < 4; ++nb) red[(wave * 4 + nb) * 64 + lane] = acc[nb];
    __syncthreads();
    if (kc == 0) {
#pragma unroll
        for (int nb = 0; nb < 4; ++nb) acc[nb] = (red[((wave + 0) * 4 + nb) * 64 + lane] + red[((wave + 1) * 4 + nb) * 64 + lane]) + (red[((wave + 2) * 4 + nb) * 64 + lane] + red[((wave + 3) * 4 + nb) * 64 + lane]);
        if (kind == 0) {
            float ss = 0.f;
#pragma unroll
            for (int nb = 0; nb < 4; ++nb) ss += (acc[nb][0] * acc[nb][0] + acc[nb][1] * acc[nb][1]) + (acc[nb][2] * acc[nb][2] + acc[nb][3] * acc[nb][3]);
            ss += __shfl_xor(ss, 16); ss += __shfl_xor(ss, 32);
            const float rs = __builtin_amdgcn_rsqf(ss * (1.0f / 64.0f) + EPS);
#pragma unroll
            for (int nb = 0; nb < 4; ++nb) acc[nb] = acc[nb] * rs * *(const f32x4*)(A.in[I_KG] + 16 * nb + 4 * fq);
            f32x4 p; p[0] = __shfl_xor(acc[0][0], 32); p[1] = __shfl_xor(acc[0][1], 32); p[2] = __shfl_xor(acc[0][2], 32); p[3] = __shfl_xor(acc[0][3], 32);
            const float* rp = (const float*)(ws + WS_ROPE) + fr * 16 + 4 * (fq & 1);
            const f32x4 c = *(const f32x4*)rp, s = *(const f32x4*)(rp + 8);
            const float sg = (fq & 2) ? 1.f : -1.f;
            acc[0] = acc[0] * c + (p * s) * sg;
        }
        if (kind == 2) {
#pragma unroll
            for (int nb = 0; nb < 2; ++nb)
#pragma unroll
                for (int e = 0; e < 4; ++e) acc[nb][e] = acc[nb][e] * __builtin_amdgcn_rcpf(1.0f + __builtin_amdgcn_exp2f(-1.4426950408889634f * acc[nb + 2][e]));
        }
        bf16* dst = kind == 0 ? (bf16*)(ws + WS_K) : kind == 1 ? (bf16*)(ws + WS_V) : (bf16*)(ws + WS_G);
        const int r0 = kind == 2 ? 48 + fr : fr, c0 = (kind == 2 ? 32 * g : 64 * g) + 4 * fq, nnb = kind == 2 ? 2 : 4;
#pragma unroll 1
        for (int b = 0; b < NB; ++b) { bf16* o = dst + (size_t)(b * SPAD + r0) * 512 + c0;
#pragma unroll
            for (int nb = 0; nb < 4; ++nb) if (nb < nnb) *(unsigned long long*)(o + 16 * nb) = (unsigned long long)pk2(acc[nb][0], acc[nb][1]) | ((unsigned long long)pk2(acc[nb][2], acc[nb][3]) << 32); }
    }
    __syncthreads();
}

__device__ __forceinline__ void wconv_phase(const Args& A, unsigned char* ws, LAS unsigned char* lds, int wave, int lane) {
    LAS float* scr = (LAS float*)(lds + wave * 16384);
    bf16* Wout_t = (bf16*)(ws + WS_WOUT); bf16* Wup_t = (bf16*)(ws + WS_WUP); bf16* Wdn_t = (bf16*)(ws + WS_WDN);
    constexpr int I_OUT = (DM / 64) * (DM / 32), I_UP = (DM / 64) * (DFF / 32), I_DN = (DFF / 64) * (DM / 32), NIT = I_OUT + I_UP + I_DN;
    unsigned* wq = (unsigned*)(ws + WS_CTL) + 96;
    volatile LAS unsigned* TK = (volatile LAS unsigned*)(lds + LDS_BYTES - 256 + 64);
    for (;;) {
        if (wave == 0 && lane == 0) TK[0] = __hip_atomic_fetch_add(wq, 1u, __ATOMIC_RELAXED, __HIP_MEMORY_SCOPE_AGENT);
        __syncthreads();
        const int t = (int)TK[0];
        __syncthreads();
        if (t * NWAVES >= NIT) break;
        int r = t * NWAVES + wave;
        if (r >= NIT) continue;
        if (r < I_OUT) { const int nblk = DM / 32, kb = r / nblk, nb = r % nblk; p0_transpose_item(A.in[I_WOUT], DM, DM, Wout_t, wup_pcol(32 * nb), 32 * nb, 64 * kb, nullptr, scr, lane); continue; } r -= I_OUT;
        if (r < I_UP) { const int nblk = DFF / 32, kb = r / nblk, nb = r % nblk; p0_transpose_item(A.in[I_WUP], DM, DFF, Wup_t, wup_pcol(32 * nb), 32 * nb, 64 * kb, A.in[I_G2], scr, lane); continue; } r -= I_UP;
        { const int nblk = DM / 32, kb = r / nblk, nb = r % nblk; p0_transpose_item(A.in[I_WDN], DFF, DM, Wdn_t, 32 * nb, 32 * nb, 64 * kb, nullptr, scr, lane); }
    }
}

constexpr int CONV_R = 32;
__device__ __forceinline__ void conv_phase(const Args& A, unsigned char* ws, LAS unsigned char* lds, int vcu, int G, int wave, int lane) {
    LAS float* cbuf = (LAS float*)lds;
    const bf16* GB = (const bf16*)(ws + WS_G); bf16* MIX = (bf16*)(ws + WS_MIX);
    const int cp = (wave & 3) * 64 + lane, half = wave >> 2;
    f32x2 w[CONVW];
#pragma unroll
    for (int j = 0; j < CONVW; ++j) w[j] = *(const f32x2*)(A.in[I_CW] + j * DCONV + 2 * cp);
    const f32x2 bias = *(const f32x2*)(A.in[I_CB] + 2 * cp);
    const f32x4 lg0 = *(const f32x4*)(A.in[I_CLG] + lane * 8), lg1 = *(const f32x4*)(A.in[I_CLG] + lane * 8 + 4), lb0 = *(const f32x4*)(A.in[I_CLB] + lane * 8), lb1 = *(const f32x4*)(A.in[I_CLB] + lane * 8 + 4);
    constexpr int NITEMS = MX / (2 * CONV_R);
    unsigned* cq = (unsigned*)(ws + WS_CTL) + 32;
    volatile LAS unsigned* TK = (volatile LAS unsigned*)(lds + LDS_BYTES - 256 + 64);
    if (wave == 0 && lane == 0) { TK[0] = __hip_atomic_fetch_add(cq, 1u, __ATOMIC_RELAXED, __HIP_MEMORY_SCOPE_AGENT); TK[1] = __hip_atomic_fetch_add(cq, 1u, __ATOMIC_RELAXED, __HIP_MEMORY_SCOPE_AGENT); }
    __syncthreads();
    int it = (int)TK[0], nxt = (int)TK[1];
    __syncthreads();
#define CONV_SRC(item, sub) (GB + (size_t)(((((item) * 2 * CONV_R + half * CONV_R + (sub) * 16) >> 13) * SPAD) + 34 + (((item) * 2 * CONV_R + half * CONV_R + (sub) * 16) & 8191)) * 512 + 2 * cp)
#define CONV_LOAD(buf, item, sub) do { const bf16* gs_ = CONV_SRC(item, sub); _Pragma("unroll") for (int i = 0; i < 46; ++i) buf[i] = *(const unsigned*)(gs_ + (size_t)i * 512); } while (0)
#define CONV_FMA(buf, sub) do { f32x2 acc[16]; _Pragma("unroll") for (int o = 0; o < 16; ++o) acc[o] = bias; \
        _Pragma("unroll") for (int i = 0; i < 46; ++i) { const f32x2 x = {bf_lo(buf[i]), bf_hi(buf[i])}; _Pragma("unroll") for (int o = 0; o < 16; ++o) { const int j = i - o; if (j >= 0 && j < CONVW) acc[o] += w[j] * x; } } \
        _Pragma("unroll") for (int o = 0; o < 16; ++o) *(LAS f32x2*)(cbuf + (half * CONV_R + (sub) * 16 + o) * DCONV + 2 * cp) = acc[o]; } while (0)
    unsigned bufA[46], bufB[46];
    if (it < NITEMS) CONV_LOAD(bufA, it, 0);
#pragma unroll 1
    while (it < NITEMS) {
        if (wave == 0 && lane == 0) TK[0] = __hip_atomic_fetch_add(cq, 1u, __ATOMIC_RELAXED, __HIP_MEMORY_SCOPE_AGENT);
        CONV_LOAD(bufB, it, 1);
        CONV_FMA(bufA, 0);
        if (nxt < NITEMS) CONV_LOAD(bufA, nxt, 0);
        CONV_FMA(bufB, 1);
        __syncthreads();
        const int nn = (int)TK[0];
#pragma unroll
        for (int rr = 0; rr < 8; ++rr) { const int lr = wave * 8 + rr;
            f32x4 x0 = *(const LAS f32x4*)(cbuf + lr * DCONV + lane * 8), x1 = *(const LAS f32x4*)(cbuf + lr * DCONV + lane * 8 + 4);
            const float mu = wave_sum_fast((x0[0] + x0[1]) + (x0[2] + x0[3]) + (x1[0] + x1[1]) + (x1[2] + x1[3])) * (1.f / DCONV);
            x0 = x0 - mu; x1 = x1 - mu;
            const float var = wave_sum_fast((x0[0] * x0[0] + x0[1] * x0[1]) + (x0[2] * x0[2] + x0[3] * x0[3]) + (x1[0] * x1[0] + x1[1] * x1[1]) + (x1[2] * x1[2] + x1[3] * x1[3])) * (1.f / DCONV);
            const float rs = __builtin_amdgcn_rsqf(var + EPS);
            x0 = x0 * rs * lg0 + lb0; x1 = x1 * rs * lg1 + lb1;
#pragma unroll
            for (int e = 0; e < 4; ++e) { x0[e] = x0[e] * __builtin_amdgcn_rcpf(1.0f + __builtin_amdgcn_exp2f(-1.4426950408889634f * x0[e])); x1[e] = x1[e] * __builtin_amdgcn_rcpf(1.0f + __builtin_amdgcn_exp2f(-1.4426950408889634f * x1[e])); }
            *(v4u*)(MIX + (size_t)(it * 2 * CONV_R + lr) * DM + 512 + lane * 8) = pg8::pack8(x0, x1); }
        __syncthreads();
        it = nxt; nxt = nn;
    }
#undef CONV_SRC
#undef CONV_LOAD
#undef CONV_FMA
}

__device__ __forceinline__ void combine_phase(const Args& A, unsigned char* ws, int vcu, int G, int wave, int lane) {
    const bf16* OB = (const bf16*)(ws + WS_O); bf16* MIX = (bf16*)(ws + WS_MIX);
    const float d1 = wave_sum(A.in[I_LQ1][lane] * A.in[I_LK1][lane]), d2 = wave_sum(A.in[I_LQ2][lane] * A.in[I_LK2][lane]);
    const float lam_init = 0.2f;
    const float lam = __builtin_amdgcn_exp2f(d1 * 1.4426950408889634f) - __builtin_amdgcn_exp2f(d2 * 1.4426950408889634f) + lam_init;
    const int h = lane >> 4, q = lane & 15;
    const f32x4 sg0 = *(const f32x4*)(A.in[I_SUBLN] + 8 * q), sg1 = *(const f32x4*)(A.in[I_SUBLN] + 8 * q + 4);
    const int gw = vcu * NWAVES + wave, NGW = G * NWAVES;
    for (int row = gw; row < MX; row += NGW) {
        const bf16* o1 = OB + (size_t)row * 1024 + h * 256 + 8 * q;
        const v4u a = *(const v4u*)o1, bq = *(const v4u*)(o1 + 128);
        f32x4 d0, d1v;
        d0[0] = bf_lo(a.x) - lam * bf_lo(bq.x); d0[1] = bf_hi(a.x) - lam * bf_hi(bq.x); d0[2] = bf_lo(a.y) - lam * bf_lo(bq.y); d0[3] = bf_hi(a.y) - lam * bf_hi(bq.y);
        d1v[0] = bf_lo(a.z) - lam * bf_lo(bq.z); d1v[1] = bf_hi(a.z) - lam * bf_hi(bq.z); d1v[2] = bf_lo(a.w) - lam * bf_lo(bq.w); d1v[3] = bf_hi(a.w) - lam * bf_hi(bq.w);
        float ss = (d0[0] * d0[0] + d0[1] * d0[1]) + (d0[2] * d0[2] + d0[3] * d0[3]) + (d1v[0] * d1v[0] + d1v[1] * d1v[1]) + (d1v[2] * d1v[2] + d1v[3] * d1v[3]);
        ss += __shfl_xor(ss, 1); ss += __shfl_xor(ss, 2); ss += __shfl_xor(ss, 4); ss += __shfl_xor(ss, 8);
        const float rs = __builtin_amdgcn_rsqf(ss * (1.f / 128.f) + EPS) * (1.0f - lam_init);
        *(v4u*)(MIX + (size_t)row * DM + h * 128 + 8 * q) = pg8::pack8(d0 * rs * sg0, d1v * rs * sg1);
    }
}

__global__ void __launch_bounds__(NWAVES * 64, 2) hymba_fwd(Args args) {
    extern __shared__ __attribute__((aligned(16))) unsigned char lds[];
    cg::grid_group grid = cg::this_grid();
    LAS unsigned char* ldsl = (LAS unsigned char*)lds;
    volatile LAS unsigned* MISC = (volatile LAS unsigned*)(ldsl + LDS_BYTES - 256);
    if (threadIdx.x < 32) MISC[threadIdx.x] = 0u;
    __syncthreads();
    const XcdBarrier bar = xcd_barrier_post((unsigned*)(args.ws + WS_CTL) + 4096, MISC + 8);
    const int G = gridDim.x; const int bx = blockIdx.x; const int vcu = (G % 8 == 0) ? (bx % 8) * (G / 8) + bx / 8 : bx;
#ifndef PROBE_DUP
#define PROBE_DUP 0
#endif
#define REP(mask) for (int rep_ = 0; rep_ < (((PROBE_DUP) & (mask)) ? 2 : 1); ++rep_)
#define PHASE_VARS() unsigned char* ws = args.ws; int tid_ = threadIdx.x; asm volatile("" : "+v"(tid_)); const int lane = tid_ & 63, wave = __builtin_amdgcn_readfirstlane(tid_ >> 6); (void)lane; (void)wave

    REP(1) { PHASE_VARS(); p0_prologue(args, ws, ldsl, vcu, G, wave, lane); }
    if (args.ws == nullptr) grid.sync();
    xcd_barrier(bar);

    REP(2) {
        PHASE_VARS();
        pg8::Gemm g{(bf16*)(ws + WS_XN), (bf16*)(ws + WS_WIN), MX, DIN, DM}; pg8::StaticOrder S; S.init(MX, DIN, G, bx, WGM_P1);
        pg8::EpiInProj E{(bf16*)(ws + WS_Q), (bf16*)(ws + WS_K), (bf16*)(ws + WS_V), (bf16*)(ws + WS_G), args.in[I_QG], args.in[I_KG], (const float*)(ws + WS_ROPE)};
        pg8::gemm_phase<pg8::EpiInProj, pg8::StaticOrder, PG8_ALIGN, PG8_SP2>(ldsl, g, S, E);
    }
    {
        PHASE_VARS();
        unsigned* mq = (unsigned*)(ws + WS_CTL) + 160;
        volatile LAS unsigned* TK = (volatile LAS unsigned*)(ldsl + LDS_BYTES - 256 + 64);
        for (;;) {
            if (tid_ == 0) TK[0] = __hip_atomic_fetch_add(mq, 1u, __ATOMIC_RELAXED, __HIP_MEMORY_SCOPE_AGENT);
            __syncthreads();
            const int t = (int)TK[0];
            __syncthreads();
            if (t >= 16) break;
            meta_proj(args, ws, ldsl, t, wave, lane);
        }
    }
    xcd_barrier(bar);

    REP(8) {
        PHASE_VARS();
        static_assert(attn_body::V2_LDS_BYTES <= LDS_BYTES - 256, "attention LDS");
        const float dq1 = wave_sum(args.in[I_LQ1][lane] * args.in[I_LK1][lane]), dq2 = wave_sum(args.in[I_LQ2][lane] * args.in[I_LK2][lane]);
        const float lam_init = 0.2f;
        const float lam = __builtin_amdgcn_exp2f(dq1 * 1.4426950408889634f) - __builtin_amdgcn_exp2f(dq2 * 1.4426950408889634f) + lam_init;
        for (int vv = vcu; vv < 256; vv += G) {
            const int bh = vv >> 4, s = vv & 15;
            const int b = bh >> 2, head = bh & 3;
            const attn_body::bf16* Kh = (const attn_body::bf16*)(ws + WS_K) + (size_t)(b * SPAD) * 512 + head * 128;
            const attn_body::bf16* Vh = (const attn_body::bf16*)(ws + WS_V) + (size_t)(b * SPAD) * 512 + head * 128;
            for (int i = 0; i < 2; ++i) {
                const int qb = i ? 31 - s : s;
                const int q0 = qb * 256;
                const attn_body::bf16* Qu = (const attn_body::bf16*)(ws + WS_Q) + (size_t)(b * SEQ + q0) * 512 + head * 128;
                attn_body::bf16* Mu = (attn_body::bf16*)(ws + WS_MIX) + (size_t)(b * SEQ + q0) * 1024 + head * 128;
                attn_body::attn_unit128<0>(q0, Qu, Kh, Vh, Mu, (char*)lds, lam, 1.0f - lam_init, args.in[I_SUBLN]);
                attn_body::attn_unit128<1>(q0, Qu + 64, Kh + 64, Vh, Mu, (char*)lds, lam, 1.0f - lam_init, args.in[I_SUBLN]);
            }
        }
    }
    REP(4) { PHASE_VARS(); conv_phase(args, ws, ldsl, vcu, G, wave, lane); }
    { PHASE_VARS(); wconv_phase(args, ws, ldsl, wave, lane); }
    xcd_barrier(bar);

    REP(32) {
        PHASE_VARS();
        pg8::Gemm g{(bf16*)(ws + WS_MIX), (bf16*)(ws + WS_WOUT), MX, DM, DM}; pg8::StaticOrder S; S.init(MX, DM, G, bx, WGM_P35);
        pg8::EpiOut E{(const bf16*)(ws + WS_XN), (const float*)(ws + WS_RN), args.in[I_G1], (bf16*)(ws + WS_H1B), (float*)(ws + WS_SSQ)};
        pg8::gemm_phase<pg8::EpiOut, pg8::StaticOrder, PG8_ALIGN, PG8_SP2>(ldsl, g, S, E);
    }
    xcd_barrier(bar);

    REP(64) {
        PHASE_VARS();
        pg8::Gemm g{(bf16*)(ws + WS_H1B), (bf16*)(ws + WS_WUP), MX, DFF, DM}; pg8::StaticOrder S; S.init(MX, DFF, G, bx, WGM_P4);
        LAS float* rl = (LAS float*)(ldsl + RING_BYTES);
        { const float* ssq = (const float*)(ws + WS_SSQ); const int r = tid_ & 255, s2 = tid_ >> 8;
          f32x4 sv[2][4]; int slot[2]; bool ok[2];
#pragma unroll
          for (int j = 0; j < 2; ++j) { pg8::Unit uu; ok[j] = S.next(2 * (2 * j + s2), uu); slot[j] = (uu.pm >> 2) & 3; const f32x4* sp = (const f32x4*)(ssq + (size_t)((ok[j] ? uu.pm : 0) * 256 + r) * 16);
#pragma unroll
              for (int k = 0; k < 4; ++k) sv[j][k] = sp[k]; }
#pragma unroll
          for (int j = 0; j < 2; ++j) { const f32x4 t = (sv[j][0] + sv[j][1]) + (sv[j][2] + sv[j][3]); const float tot = (t[0] + t[1]) + (t[2] + t[3]);
              if (ok[j]) rl[slot[j] * 256 + r] = __builtin_amdgcn_rsqf(tot * (1.0f / 1024.0f) + 1e-6f); }
          __syncthreads(); }
        pg8::EpiUp E{(bf16*)(ws + WS_HB), rl};
        pg8::gemm_phase<pg8::EpiUp, pg8::StaticOrder, PG8_ALIGN, PG8_SP2>(ldsl, g, S, E);
    }
    xcd_barrier(bar);

    {
        PHASE_VARS();
        pg8::Gemm g{(bf16*)(ws + WS_HB), (bf16*)(ws + WS_WDN), MX, DM, DFF}; pg8::StaticOrder S; S.init(MX, DM, G, bx, WGM_P35);
        pg8::EpiDown E{(const bf16*)(ws + WS_H1B), args.out};
        pg8::gemm_phase<pg8::EpiDown, pg8::StaticOrder, PG8_ALIGN, PG8_SP2>(ldsl, g, S, E);
    }
#undef PHASE_VARS
#undef REP
}

extern "C" void kernel_launch(void* const* d_in, const int* in_sizes, int n_in, void* d_out, int out_size, void* d_ws, size_t ws_size, hipStream_t stream) {
    static int grid = 0;
    if (grid == 0) {
        if (n_in != 19 || in_sizes[0] != MX * DM || out_size != MX * DM || ws_size < WS_END) { fprintf(stderr, "kernel_launch: unexpected shapes: n_in %d, in0 %d, out %d, ws %zu (need %zu); nothing launched\n", n_in, n_in > 0 ? in_sizes[0] : -1, out_size, ws_size, (size_t)WS_END); grid = -1; return; }
        int dev = 0, cus = 0, per_cu = 0;
        if (hipGetDevice(&dev) != hipSuccess || hipDeviceGetAttribute(&cus, hipDeviceAttributeMultiprocessorCount, dev) != hipSuccess) { fprintf(stderr, "kernel_launch: device query failed\n"); grid = -1; return; }
        if (hipFuncSetAttribute((const void*)hymba_fwd, hipFuncAttributeMaxDynamicSharedMemorySize, LDS_BYTES) != hipSuccess) { fprintf(stderr, "kernel_launch: hipFuncSetAttribute failed\n"); grid = -1; return; }
        if (hipOccupancyMaxActiveBlocksPerMultiprocessor(&per_cu, (const void*)hymba_fwd, NWAVES * 64, LDS_BYTES) != hipSuccess || per_cu < 1) { fprintf(stderr, "kernel_launch: occupancy query says %d\n", per_cu); per_cu = 1; }
        (void)hipGetLastError();
        grid = cus * 1;
        fprintf(stderr, "kernel_launch: grid %d (occupancy query %d per CU)\n", grid, per_cu);
    }
    if (grid < 0) return;
    Args a{};
    for (int i = 0; i < 19; ++i) a.in[i] = (const float*)d_in[i];
    a.out = (float*)d_out; a.ws = (unsigned char*)d_ws;
    for (int i = 0; i < 8; ++i) a.inv_freq[i] = (float)pow(500000.0, -(double)i / 8.0);
    if (hipMemsetAsync((char*)d_ws + WS_CTL, 0, 65536, stream) != hipSuccess) { fprintf(stderr, "kernel_launch: hipMemsetAsync failed\n"); return; }
    void* kargs[] = {&a};
    const hipError_t le = hipLaunchCooperativeKernel((const void*)hymba_fwd, dim3(grid), dim3(NWAVES * 64), kargs, LDS_BYTES, stream);
    if (le != hipSuccess) fprintf(stderr, "kernel_launch: cooperative launch failed: %s (grid %d)\n", hipGetErrorName(le), grid);
}
```

```cpp
#include <hip/hip_cooperative_groups.h>
#include <cmath>
#include <hip/hip_runtime.h>
#include <cstdio>
#include <cstdint>
namespace pg8 {
#define PG8_LAS __attribute__((address_space(3)))
typedef unsigned short bf16_t;
typedef short bf16x8 __attribute__((ext_vector_type(8)));
typedef float f32x4 __attribute__((ext_vector_type(4)));
typedef unsigned u32x4 __attribute__((ext_vector_type(4)));
constexpr int BM = 256, BK = 64, HALF = 128, HTB = HALF * BK * 2  , STAGE_BYTES = 8 * HTB, NXCD = 8, WGM = 8;

__host__ __device__ __forceinline__ int lds_byte(int r, int c) { const int st = (r >> 4) * 2 + (c >> 5), rr = r & 15, cc = c & 31, ob = rr * 64 + cc * 2; return st * 1024 + (ob ^ (((ob >> 9) & 1) << 5)); }
__host__ __device__ __forceinline__ void stage_rc(int b, int& R, int& C) { const int st = b / 1024, sb = b % 1024, swz = sb ^ (((sb >> 9) & 1) << 5); R = (st >> 1) * 16 + swz / 64; C = (st & 1) * 32 + (swz % 64) / 2; }
__host__ __device__ __forceinline__ int perm32(int rho) { const int n = rho >> 4, i = rho & 15; return 8 * (i >> 2) + 4 * n + (i & 3); }

struct Unit { int pm, pn; };
struct Gemm { const bf16_t* A; const bf16_t* Bt; int M, N, K; };

struct StaticOrder {
    int nM, nN, nwg, G, c, wgm;
    __host__ __device__ void init(int M, int N, int G_, int c_, int wgm_ = WGM) { nM = M / BM; nN = N / BM; nwg = nM * nN; G = G_; c = c_; wgm = wgm_; }
    __host__ __device__ bool next(int i, Unit& u) const {
        const long L = (long)i * G + c; if (L >= nwg) return false;
        int wgid = (int)L; { const int q = nwg / NXCD, r = nwg % NXCD, xcd = wgid % NXCD, off = wgid / NXCD; wgid = (xcd < r ? xcd * (q + 1) : r * (q + 1) + (xcd - r) * q) + off; }
        const int nig = wgm * nN, gid = wgid / nig, fm = gid * wgm, gsz = (nM - fm) < wgm ? (nM - fm) : wgm;
        u.pm = fm + ((wgid % nig) % gsz); u.pn = (wgid % nig) / gsz; return true;
    }
    __device__ __forceinline__ void a_ready(const Unit&) const {}
    __device__ __forceinline__ void done(const Unit&) const {}
};

__device__ __forceinline__ unsigned cvt_pk_bf16(float lo, float hi) { unsigned r; asm volatile("v_cvt_pk_bf16_f32 %0, %1, %2" : "=v"(r) : "v"(lo), "v"(hi)); return r; }
typedef float f32x2 __attribute__((ext_vector_type(2)));
__device__ __forceinline__ f32x2 gelu_pk(f32x2 v) {
    const f32x2 av = __builtin_elementwise_abs(v), d = av * 0.2316418882f + 1.0f;
    f32x2 t; t.x = __builtin_amdgcn_rcpf(d.x); t.y = __builtin_amdgcn_rcpf(d.y);
    f32x2 q = t * 0.5307027145f + (-0.7265760135f); q = q * t + 0.7107068705f; q = q * t + (-0.142248368f); q = q * t + 0.127414796f; q = q * t;
    const f32x2 s = (v * v) * (-0.72134752044f);
    f32x2 e; e.x = __builtin_amdgcn_exp2f(s.x); e.y = __builtin_amdgcn_exp2f(s.y);
    const f32x2 m = v * (q * e), r = v - m;
    f32x2 o; o.x = v.x < 0.f ? m.x : r.x; o.y = v.y < 0.f ? m.y : r.y; return o;
}

template <int ACT  > struct EpiBf16 {
    static constexpr bool PERM = true, AFTER_DRAIN = false; static_assert(ACT == 0 || ACT == 1, "EpiBf16: ACT is 0 (none) or 1 (gelu_pk)");
    bf16_t* O; int ldc; const float* bias; int split_cols; size_t split_stride; float scale0;
    __device__ __forceinline__ void operator()(const f32x4 (&acc)[2][2][4][2], const Unit& u, int wr, int wc, int fr, int fq) const {
        const int row0 = u.pm * BM + wr * 64 + fr; int colt = u.pn * BM; bf16_t* base = O;
        float sc = 1.f; if (split_cols) { const int t = colt / split_cols; base += (size_t)t * split_stride; colt -= t * split_cols; if (t == 0) sc = scale0; }
        const int col0 = colt + wc * 32 + 8 * fq, bcol0 = u.pn * BM + wc * 32 + 8 * fq;
        f32x4 bv[2][2];
#pragma unroll
        for (int bj = 0; bj < 2; ++bj)
#pragma unroll
            for (int n = 0; n < 2; ++n) bv[bj][n] = bias ? *(const f32x4*)(bias + bcol0 + bj * HALF + 4 * n) : (f32x4){0.f, 0.f, 0.f, 0.f};
#pragma unroll
        for (int ai = 0; ai < 2; ++ai)
#pragma unroll
            for (int m = 0; m < 4; ++m) { bf16_t* rowp = base + (size_t)(row0 + ai * HALF + m * 16) * ldc + col0;
#pragma unroll
                for (int bj = 0; bj < 2; ++bj) { f32x4 v0 = acc[ai][bj][m][0] + bv[bj][0], v1 = acc[ai][bj][m][1] + bv[bj][1];
                    if (ACT == 1) { f32x2 a = gelu_pk((f32x2){v0[0], v0[1]}), b = gelu_pk((f32x2){v0[2], v0[3]}), c = gelu_pk((f32x2){v1[0], v1[1]}), d = gelu_pk((f32x2){v1[2], v1[3]});
                        v0 = (f32x4){a.x, a.y, b.x, b.y}; v1 = (f32x4){c.x, c.y, d.x, d.y}; }
                    v0 = v0 * sc; v1 = v1 * sc; u32x4 w; w.x = cvt_pk_bf16(v0[0], v0[1]); w.y = cvt_pk_bf16(v0[2], v0[3]); w.z = cvt_pk_bf16(v1[0], v1[1]); w.w = cvt_pk_bf16(v1[2], v1[3]);
                    *(u32x4*)(rowp + bj * HALF) = w; } }
    }
};

constexpr int XROWS = 32768, SPAD = 8256;
constexpr float QSCALE = 0.125f * 1.4426950408889634f;
__device__ __forceinline__ f32x4 shfl_xor4(f32x4 v, int m) { f32x4 r; r[0] = __shfl_xor(v[0], m); r[1] = __shfl_xor(v[1], m); r[2] = __shfl_xor(v[2], m); r[3] = __shfl_xor(v[3], m); return r; }
__device__ __forceinline__ u32x4 pack8(f32x4 a, f32x4 b) { u32x4 w; w.x = cvt_pk_bf16(a[0], a[1]); w.y = cvt_pk_bf16(a[2], a[3]); w.z = cvt_pk_bf16(b[0], b[1]); w.w = cvt_pk_bf16(b[2], b[3]); return w; }
__device__ __forceinline__ u32x4 swap_lane1(u32x4 v) { u32x4 r; r.x = (unsigned)__builtin_amdgcn_update_dpp(0, (int)v.x, 0xB1, 0xF, 0xF, true); r.y = (unsigned)__builtin_amdgcn_update_dpp(0, (int)v.y, 0xB1, 0xF, 0xF, true);
    r.z = (unsigned)__builtin_amdgcn_update_dpp(0, (int)v.z, 0xB1, 0xF, 0xF, true); r.w = (unsigned)__builtin_amdgcn_update_dpp(0, (int)v.w, 0xB1, 0xF, 0xF, true); return r; }
struct EpiInProj {
    static constexpr bool PERM = true, AFTER_DRAIN = false;
    bf16_t *Q, *K, *V, *G; const float *qg, *kg, *rope;
    __device__ __forceinline__ void operator()(const f32x4 (&acc)[2][2][4][2], const Unit& u, int wr, int wc, int fr, int fq) const {
        const int pn = u.pn; constexpr bool meta = false;
        if (meta && (wr != 0 || pn < 2)) return;
        const int rbase = u.pm * BM + wr * 64 + fr;
        if (pn < 4) {
            const bool isq = pn < 2; const float* gp = isq ? qg : kg; const float osc = isq ? QSCALE : 1.f;
            f32x4 gv[2][2];
#pragma unroll
            for (int bj = 0; bj < 2; ++bj)
#pragma unroll
                for (int n = 0; n < 2; ++n) gv[bj][n] = *(const f32x4*)(gp + 32 * bj + 8 * fq + 4 * n);
            const int colb = (pn & 1) * 256 + wc * 64 + 8 * fq;
            bf16_t* dst = isq ? Q : K;
#pragma unroll
            for (int ai = 0; ai < 2; ++ai) {
                if (meta && ai) continue;
#pragma unroll
              for (int mh = 0; mh < 2; ++mh) {
                if (meta && mh) continue;
                f32x4 rv[2][4];
                if (fq < 2) {
#pragma unroll
                    for (int m2 = 0; m2 < 2; ++m2) { const int row = rbase + ai * HALF + (2 * mh + m2) * 16; const int pos = meta ? (row - XROWS) : ((row & 8191) + 16); const f32x4* rp = (const f32x4*)(rope + (size_t)pos * 16);
#pragma unroll
                        for (int k = 0; k < 4; ++k) rv[m2][k] = rp[k]; }
                }
                asm volatile("" ::: "memory");
#pragma unroll
                for (int m = 2 * mh; m < 2 * mh + 2; ++m) {
                    if (meta && m) continue;
                    const int row = rbase + ai * HALF + m * 16;
                    float ss = 0.f;
#pragma unroll
                    for (int bj = 0; bj < 2; ++bj)
#pragma unroll
                        for (int n = 0; n < 2; ++n) { const f32x4 x = acc[ai][bj][m][n]; ss += (x[0] * x[0] + x[1] * x[1]) + (x[2] * x[2] + x[3] * x[3]); }
                    ss += __shfl_xor(ss, 16); ss += __shfl_xor(ss, 32);
                    const float rs = __builtin_amdgcn_rsqf(ss * (1.0f / 64.0f) + 1e-6f);
                    f32x4 y00 = acc[ai][0][m][0] * rs * gv[0][0], y01 = acc[ai][0][m][1] * rs * gv[0][1], y10 = acc[ai][1][m][0] * rs * gv[1][0], y11 = acc[ai][1][m][1] * rs * gv[1][1];
                    const f32x4 p0 = shfl_xor4(y00, 16), p1 = shfl_xor4(y01, 16);
                    if (fq < 2) {
                        const f32x4 c0 = rv[m & 1][0], c1 = rv[m & 1][1], s0 = rv[m & 1][2], s1 = rv[m & 1][3];
                        const float sg = fq ? 1.f : -1.f;
                        y00 = y00 * c0 + (p0 * s0) * sg; y01 = y01 * c1 + (p1 * s1) * sg;
                    }
                    const u32x4 w0 = pack8(y00 * osc, y01 * osc), w1 = pack8(y10 * osc, y11 * osc);
                    if (!meta) {
                        const bool odd = (fr & 1) != 0; const int row_e = row - (odd ? 1 : 0);
                        const size_t orow = isq ? (size_t)row_e : (size_t)((row_e >> 13) * SPAD + 64 + (row_e & 8191));
                        const u32x4 rcv = swap_lane1(odd ? w0 : w1);
                        bf16_t* p = dst + orow * 512 + colb + (odd ? 32 : 0);
                        *(u32x4*)p = odd ? rcv : w0; *(u32x4*)(p + 512) = odd ? w1 : rcv;
                    } else {
#pragma unroll 1
                        for (int b = 0; b < 4; ++b) { const size_t orow = (size_t)(b * SPAD + fr); *(u32x4*)(dst + orow * 512 + colb) = w0; *(u32x4*)(dst + orow * 512 + colb + 32) = w1; }
                    }
                }
              }
            }
        } else if (pn < 6) {
            const int colb = (pn - 4) * 256 + wc * 64 + 8 * fq;
#pragma unroll
            for (int ai = 0; ai < 2; ++ai)
#pragma unroll
                for (int m = 0; m < 4; ++m) {
                    if (meta && (ai || m)) continue;
                    const int row = rbase + ai * HALF + m * 16;
                    const u32x4 w0 = pack8(acc[ai][0][m][0], acc[ai][0][m][1]), w1 = pack8(acc[ai][1][m][0], acc[ai][1][m][1]);
                    if (!meta) {
                        const bool odd = (fr & 1) != 0; const int row_e = row - (odd ? 1 : 0);
                        const size_t orow = (size_t)((row_e >> 13) * SPAD + 64 + (row_e & 8191));
                        const u32x4 rcv = swap_lane1(odd ? w0 : w1);
                        bf16_t* p = V + orow * 512 + colb + (odd ? 32 : 0);
                        *(u32x4*)p = odd ? rcv : w0; *(u32x4*)(p + 512) = odd ? w1 : rcv;
                    } else {
#pragma unroll 1
                        for (int b = 0; b < 4; ++b) { const size_t orow = (size_t)(b * SPAD + fr); *(u32x4*)(V + orow * 512 + colb) = w0; *(u32x4*)(V + orow * 512 + colb + HALF) = w1; }
                    }
                }
        } else {
            const int colb = (pn - 6) * 128 + wc * 32 + 8 * fq;
#pragma unroll
            for (int ai = 0; ai < 2; ++ai)
#pragma unroll
                for (int m = 0; m < 4; ++m) {
                    if (meta && (ai || m)) continue;
                    const int row = rbase + ai * HALF + m * 16;
                    f32x4 h[2];
#pragma unroll
                    for (int n = 0; n < 2; ++n) { const f32x4 a = acc[ai][0][m][n], g = acc[ai][1][m][n];
#pragma unroll
                        for (int e = 0; e < 4; ++e) h[n][e] = a[e] * __builtin_amdgcn_rcpf(1.0f + __builtin_amdgcn_exp2f(-1.4426950408889634f * g[e])); }
                    const u32x4 w0 = pack8(h[0], h[1]);
                    if (!meta) {
                        const size_t orow = (size_t)((row >> 13) * SPAD + 64 + (row & 8191));
                        *(u32x4*)(G + orow * 512 + colb) = w0;
                    } else {
#pragma unroll 1
                        for (int b = 0; b < 4; ++b) { const size_t orow = (size_t)(b * SPAD + 48 + fr); *(u32x4*)(G + orow * 512 + colb) = w0; }
                    }
                }
        }
    }
};
struct EpiOut {
    static constexpr bool PERM = true, AFTER_DRAIN = false;
    const bf16_t* xn; const float* rn; const float* g1; bf16_t* hb; float* ssq;
    __device__ __forceinline__ void operator()(const f32x4 (&acc)[2][2][4][2], const Unit& u, int wr, int wc, int fr, int fq) const {
        const int rbase = u.pm * BM + wr * 64 + fr, colb = u.pn * BM + wc * 64 + 8 * fq;
        const bool odd = (fr & 1) != 0;
        f32x4 ig[2][2];
#pragma unroll
        for (int bj = 0; bj < 2; ++bj)
#pragma unroll
            for (int n = 0; n < 2; ++n) { const f32x4 g = *(const f32x4*)(g1 + colb + bj * 32 + 4 * n);
#pragma unroll
                for (int e = 0; e < 4; ++e) ig[bj][n][e] = __builtin_amdgcn_rcpf(g[e]); }
#pragma unroll
        for (int ai = 0; ai < 2; ++ai) {
            u32x4 xv[4][2]; float rv[4];
#pragma unroll
            for (int m = 0; m < 4; ++m) { const int row = rbase + ai * HALF + m * 16; rv[m] = rn[row];
#pragma unroll
                for (int bj = 0; bj < 2; ++bj) xv[m][bj] = *(const u32x4*)(xn + (size_t)row * 1024 + colb + bj * 32); }
            asm volatile("" ::: "memory");
#pragma unroll
            for (int m = 0; m < 4; ++m) {
                const int row = rbase + ai * HALF + m * 16, row_e = row - (odd ? 1 : 0); float ss = 0.f;
                u32x4 wv[2];
#pragma unroll
                for (int bj = 0; bj < 2; ++bj) { const u32x4 w = xv[m][bj];
                    f32x4 x0, x1;
                    x0[0] = __uint_as_float(w.x << 16); x0[1] = __uint_as_float(w.x & 0xffff0000u); x0[2] = __uint_as_float(w.y << 16); x0[3] = __uint_as_float(w.y & 0xffff0000u);
                    x1[0] = __uint_as_float(w.z << 16); x1[1] = __uint_as_float(w.z & 0xffff0000u); x1[2] = __uint_as_float(w.w << 16); x1[3] = __uint_as_float(w.w & 0xffff0000u);
                    const f32x4 h0 = x0 * rv[m] * ig[bj][0] + acc[ai][bj][m][0], h1 = x1 * rv[m] * ig[bj][1] + acc[ai][bj][m][1];
                    wv[bj] = pack8(h0, h1);
                    ss += (h0[0] * h0[0] + h0[1] * h0[1]) + (h0[2] * h0[2] + h0[3] * h0[3]) + (h1[0] * h1[0] + h1[1] * h1[1]) + (h1[2] * h1[2] + h1[3] * h1[3]); }
                const u32x4 snd = odd ? wv[0] : wv[1]; u32x4 rcv;
                rcv.x = (unsigned)__builtin_amdgcn_update_dpp(0, (int)snd.x, 0xB1, 0xF, 0xF, true); rcv.y = (unsigned)__builtin_amdgcn_update_dpp(0, (int)snd.y, 0xB1, 0xF, 0xF, true);
                rcv.z = (unsigned)__builtin_amdgcn_update_dpp(0, (int)snd.z, 0xB1, 0xF, 0xF, true); rcv.w = (unsigned)__builtin_amdgcn_update_dpp(0, (int)snd.w, 0xB1, 0xF, 0xF, true);
                bf16_t* p = hb + (size_t)row_e * 1024 + colb + (odd ? 32 : 0);
                *(u32x4*)p = odd ? rcv : wv[0];
                *(u32x4*)(p + 1024) = odd ? wv[1] : rcv;
                ss += __shfl_xor(ss, 16); ss += __shfl_xor(ss, 32);
                if (fq == 0) ssq[(size_t)row * 16 + u.pn * 4 + wc] = ss;
            }
        }
    }
};
struct EpiUp {
    static constexpr bool PERM = true, AFTER_DRAIN = false;
    bf16_t* hb; const PG8_LAS float* rl;
    __device__ __forceinline__ void operator()(const f32x4 (&acc)[2][2][4][2], const Unit& u, int wr, int wc, int fr, int fq) const {
        const int rbase = u.pm * BM + wr * 64 + fr, colb = u.pn * BM + wc * 64 + 8 * fq;
        const bool odd = (fr & 1) != 0;
        const PG8_LAS float* rp = rl + ((u.pm >> 2) & 3) * 256 + wr * 64 + fr;
#pragma unroll
        for (int ai = 0; ai < 2; ++ai) {
#pragma unroll
            for (int m = 0; m < 4; ++m) {
                const int row = rbase + ai * HALF + m * 16, row_e = row - (odd ? 1 : 0);
                const float rs = rp[ai * HALF + m * 16];
                u32x4 w[2];
#pragma unroll
                for (int bj = 0; bj < 2; ++bj) { f32x4 a0 = acc[ai][bj][m][0] * rs, a1 = acc[ai][bj][m][1] * rs;
#pragma unroll
                    for (int e = 0; e < 4; ++e) { const float p = fmaxf(a0[e], 0.f), q = fmaxf(a1[e], 0.f); a0[e] = p * p; a1[e] = q * q; }
                    w[bj] = pack8(a0, a1); }
                const u32x4 rcv = swap_lane1(odd ? w[0] : w[1]);
                bf16_t* p = hb + (size_t)row_e * 4096 + colb + (odd ? 32 : 0);
                __builtin_nontemporal_store(odd ? rcv : w[0], (u32x4*)p);
                __builtin_nontemporal_store(odd ? w[1] : rcv, (u32x4*)(p + 4096));
            }
        }
    }
};
struct EpiDown {
    static constexpr bool PERM = false, AFTER_DRAIN = false;
    const bf16_t* h1; float* out;
    __device__ __forceinline__ void operator()(const f32x4 (&acc)[2][2][4][2], const Unit& u, int wr, int wc, int fr, int fq) const {
        typedef unsigned u32x2 __attribute__((ext_vector_type(2)));
        const int rbase = u.pm * BM + wr * 64 + fr, colb = u.pn * BM + wc * 32 + 4 * fq;
        const bool odd = (fr & 1) != 0;
        u32x2 hv[2][4][2][2];
#pragma unroll
        for (int ai = 0; ai < 2; ++ai)
#pragma unroll
            for (int m = 0; m < 4; ++m)
#pragma unroll
                for (int bj = 0; bj < 2; ++bj)
#pragma unroll
                    for (int n = 0; n < 2; ++n) hv[ai][m][bj][n] = *(const u32x2*)(h1 + (size_t)(rbase + ai * HALF + m * 16) * 1024 + colb + bj * HALF + 16 * n);
        asm volatile("" ::: "memory");
#pragma unroll
        for (int ai = 0; ai < 2; ++ai) {
#pragma unroll
            for (int m = 0; m < 4; ++m) {
                const int row = rbase + ai * HALF + m * 16, row_e = row - (odd ? 1 : 0);
#pragma unroll
                for (int bj = 0; bj < 2; ++bj) {
                    f32x4 a[2];
#pragma unroll
                    for (int n = 0; n < 2; ++n) { const u32x2 w = hv[ai][m][bj][n];
                        f32x4 r; r[0] = __uint_as_float(w.x << 16); r[1] = __uint_as_float(w.x & 0xffff0000u); r[2] = __uint_as_float(w.y << 16); r[3] = __uint_as_float(w.y & 0xffff0000u);
                        a[n] = r + acc[ai][bj][m][n]; }
                    const f32x4 snd = odd ? a[0] : a[1]; f32x4 rcv;
#pragma unroll
                    for (int e = 0; e < 4; ++e) rcv[e] = __int_as_float(__builtin_amdgcn_update_dpp(0, __float_as_int(snd[e]), 0xB1, 0xF, 0xF, true));
                    const size_t off = (size_t)row_e * 1024 + colb + bj * HALF + (odd ? 16 : 0);
                    __builtin_nontemporal_store(odd ? rcv : a[0], (f32x4*)(out + off));
                    __builtin_nontemporal_store(odd ? a[1] : rcv, (f32x4*)(out + off + 1024)); }
            }
        }
    }
};


template <class Epi, class Sched, bool ALIGN_EPI = false, bool SP2 = false>
__device__ __forceinline__ void gemm_phase(PG8_LAS unsigned char* lds, const Gemm g, const Sched& S, const Epi& E) {
    int tid_ = threadIdx.x; asm volatile("" : "+v"(tid_));
    const int tid = tid_, wid = __builtin_amdgcn_readfirstlane(tid >> 6), lane = tid & 63, wr = wid >> 2, wc = wid & 3, fr = lane & 15, fq = lane >> 4;
    const int K = g.K, nt = K / BK;
    unsigned voffA[2], voffB[2];
#pragma unroll
    for (int i = 0; i < 2; ++i) { int R, C; stage_rc(tid * 16 + i * 8192, R, C); const int Rb = Epi::PERM ? ((R & ~31) + perm32(R & 31)) : R;
        voffA[i] = (unsigned)(R * K + C) * 2u; voffB[i] = (unsigned)(Rb * K + C) * 2u; }
    const size_t kstep = (size_t)(BK * 2);
    const size_t hstep = (size_t)HALF * K * 2;
    const size_t tstep = 2 * hstep;
    const unsigned ldsw = (unsigned)wid * 1024u;
    const int aoff = lds_byte(wr * 64 + fr, fq * 8), boff = lds_byte(wc * 32 + fr, fq * 8);
#define PG8_SA(b, h) (((b) * 2 + (h)) * HTB)
#define PG8_SB(b, h) ((4 + (b) * 2 + (h)) * HTB)
#define PG8_STAGE(bufoff, gbase, voff) do { _Pragma("unroll") for (int _i = 0; _i < 2; ++_i) \
        __builtin_amdgcn_global_load_lds((const unsigned*)((const char*)(gbase) + (voff)[_i]), (PG8_LAS unsigned*)(lds + (bufoff) + ldsw + _i * 8192), 16, 0, 0); } while (0)
#define PG8_LDA(dst, b, h) do { _Pragma("unroll") for (int m = 0; m < 4; ++m) _Pragma("unroll") for (int k = 0; k < 2; ++k) dst[m][k] = *(const PG8_LAS bf16x8*)(lds + PG8_SA(b, h) + aoff + m * 2048 + k * 1024); } while (0)
#define PG8_LDB(dst, b, h) do { _Pragma("unroll") for (int n = 0; n < 2; ++n) _Pragma("unroll") for (int k = 0; k < 2; ++k) dst[n][k] = *(const PG8_LAS bf16x8*)(lds + PG8_SB(b, h) + boff + n * 2048 + k * 1024); } while (0)
#define PG8_MMA(ai, bj, At, Bt) do { __builtin_amdgcn_s_setprio(1); _Pragma("unroll") for (int m = 0; m < 4; ++m) _Pragma("unroll") for (int n = 0; n < 2; ++n) _Pragma("unroll") for (int k = 0; k < 2; ++k) \
        acc[ai][bj][m][n] = __builtin_amdgcn_mfma_f32_16x16x32_bf16(Bt[n][k], At[m][k], acc[ai][bj][m][n], 0, 0, 0); __builtin_amdgcn_s_setprio(0); } while (0)
#define PG8_WAIT_V(n) asm volatile("s_waitcnt vmcnt(" #n ")" ::: "memory")
#define PG8_WAIT_L(n) asm volatile("s_waitcnt lgkmcnt(" #n ")" ::: "memory")
#define PG8_BAR __builtin_amdgcn_s_barrier()
#define PG8_SCHED __builtin_amdgcn_sched_barrier(0)
    Unit cur, nxt; int ui = 0;
    if (!S.next(0, cur)) return;
    f32x4 acc[2][2][4][2];
#pragma unroll
    for (int a = 0; a < 2; ++a)
#pragma unroll
        for (int b = 0; b < 2; ++b)
#pragma unroll
            for (int m = 0; m < 4; ++m)
#pragma unroll
                for (int n = 0; n < 2; ++n) acc[a][b][m][n] = (f32x4){0.f, 0.f, 0.f, 0.f};
    bf16x8 At[4][2], B0[2][2], B1[2][2];
    const char* cA = (const char*)g.A + (size_t)cur.pm * tstep; const char* cB = (const char*)g.Bt + (size_t)cur.pn * tstep;
    S.a_ready(cur);
    if constexpr (SP2) {
        PG8_STAGE(PG8_SB(0, 0), cB, voffB); PG8_STAGE(PG8_SB(0, 1), cB + hstep, voffB); PG8_STAGE(PG8_SA(0, 0), cA, voffA); PG8_STAGE(PG8_SA(0, 1), cA + hstep, voffA);
        if (wr == 1) PG8_BAR;
        PG8_WAIT_V(2); PG8_BAR;
        PG8_STAGE(PG8_SB(1, 0), cB + kstep, voffB); PG8_STAGE(PG8_SA(1, 0), cA + kstep, voffA); PG8_STAGE(PG8_SB(1, 1), cB + hstep + kstep, voffB);
        PG8_WAIT_V(6); PG8_BAR;
    } else {
        PG8_STAGE(PG8_SB(0, 0), cB, voffB); PG8_STAGE(PG8_SA(0, 0), cA, voffA); PG8_STAGE(PG8_SB(0, 1), cB + hstep, voffB); PG8_STAGE(PG8_SA(0, 1), cA + hstep, voffA);
        if (wr == 1) PG8_BAR;
        PG8_WAIT_V(4); PG8_BAR;
        PG8_STAGE(PG8_SB(1, 0), cB + kstep, voffB); PG8_STAGE(PG8_SA(1, 0), cA + kstep, voffA); PG8_STAGE(PG8_SB(1, 1), cB + hstep + kstep, voffB);
        PG8_WAIT_V(6); PG8_BAR;
    }
    for (;;) {
        const bool has_next = S.next(ui + 1, nxt);
        const char* nA = has_next ? (const char*)g.A + (size_t)nxt.pm * tstep : cA; const char* nB = has_next ? (const char*)g.Bt + (size_t)nxt.pn * tstep : cB;
        for (int t = 0; t < nt; t += 2) {
            const bool last = (t == nt - 2);
            const char* a1 = cA + (size_t)(t + 1) * kstep;
            const char* a2 = last ? nA : cA + (size_t)(t + 2) * kstep; const char* b2 = last ? nB : cB + (size_t)(t + 2) * kstep;
            const char* a3 = a2 + kstep; const char* b3 = b2 + kstep;
            if (last && has_next) S.a_ready(nxt);
            if constexpr (SP2) {
            PG8_LDB(B0, 0, 0); PG8_LDB(B1, 0, 1); PG8_SCHED; PG8_LDA(At, 0, 0); PG8_STAGE(PG8_SA(1, 1), a1 + hstep, voffA);
            PG8_WAIT_V(8); PG8_WAIT_L(0); PG8_BAR; PG8_MMA(0, 0, At, B0); PG8_MMA(0, 1, At, B1); PG8_BAR; PG8_SCHED;
            PG8_LDA(At, 0, 1); PG8_STAGE(PG8_SB(0, 0), b2, voffB); PG8_STAGE(PG8_SB(0, 1), b2 + hstep, voffB); PG8_STAGE(PG8_SA(0, 0), a2, voffA);
            PG8_WAIT_V(8); PG8_WAIT_L(0); PG8_BAR; PG8_MMA(1, 0, At, B0); PG8_MMA(1, 1, At, B1); PG8_BAR; PG8_SCHED;
            PG8_LDB(B0, 1, 0); PG8_LDB(B1, 1, 1); PG8_SCHED; PG8_LDA(At, 1, 0); PG8_STAGE(PG8_SA(0, 1), a2 + hstep, voffA);
            PG8_WAIT_V(8); PG8_WAIT_L(0); PG8_BAR; PG8_MMA(0, 0, At, B0); PG8_MMA(0, 1, At, B1); PG8_BAR; PG8_SCHED;
            PG8_LDA(At, 1, 1); PG8_STAGE(PG8_SB(1, 0), b3, voffB); PG8_STAGE(PG8_SB(1, 1), b3 + hstep, voffB); PG8_STAGE(PG8_SA(1, 0), a3, voffA);
            PG8_WAIT_V(8); PG8_WAIT_L(0); PG8_BAR; PG8_MMA(1, 0, At, B0); PG8_MMA(1, 1, At, B1); PG8_BAR; PG8_SCHED;
            } else {
            PG8_LDB(B0, 0, 0); PG8_SCHED; PG8_LDA(At, 0, 0); PG8_STAGE(PG8_SA(1, 1), a1 + hstep, voffA);
            PG8_WAIT_L(8); PG8_BAR; PG8_WAIT_L(0); PG8_MMA(0, 0, At, B0); PG8_BAR; PG8_SCHED;
            PG8_LDB(B1, 0, 1); PG8_STAGE(PG8_SB(0, 0), b2, voffB);
            PG8_BAR; PG8_WAIT_L(0); PG8_MMA(0, 1, At, B1); PG8_BAR;
            PG8_LDA(At, 0, 1); PG8_STAGE(PG8_SA(0, 0), a2, voffA);
            PG8_BAR; PG8_WAIT_L(0); PG8_MMA(1, 0, At, B0); PG8_BAR; PG8_SCHED;
            PG8_STAGE(PG8_SB(0, 1), b2 + hstep, voffB);
            PG8_WAIT_V(6); PG8_BAR; PG8_MMA(1, 1, At, B1); PG8_BAR;
            PG8_LDB(B0, 1, 0); PG8_SCHED; PG8_LDA(At, 1, 0); PG8_STAGE(PG8_SA(0, 1), a2 + hstep, voffA);
            PG8_WAIT_L(8); PG8_BAR; PG8_WAIT_L(0); PG8_MMA(0, 0, At, B0); PG8_BAR; PG8_SCHED;
            PG8_LDB(B1, 1, 1); PG8_STAGE(PG8_SB(1, 0), b3, voffB);
            PG8_BAR; PG8_WAIT_L(0); PG8_MMA(0, 1, At, B1); PG8_BAR;
            PG8_LDA(At, 1, 1); PG8_STAGE(PG8_SA(1, 0), a3, voffA);
            PG8_BAR; PG8_WAIT_L(0); PG8_MMA(1, 0, At, B0); PG8_BAR; PG8_SCHED;
            PG8_STAGE(PG8_SB(1, 1), b3 + hstep, voffB);
            PG8_WAIT_V(6); PG8_BAR; PG8_MMA(1, 1, At, B1); PG8_BAR;
            }
        }
        if constexpr (ALIGN_EPI) { if (wr == 0) PG8_BAR; }
        if constexpr (!Epi::AFTER_DRAIN) { E(acc, cur, wr, wc, fr, fq); S.done(cur); }
        if (!has_next) break;
#pragma unroll
        for (int a = 0; a < 2; ++a)
#pragma unroll
            for (int b = 0; b < 2; ++b)
#pragma unroll
                for (int m = 0; m < 4; ++m)
#pragma unroll
                    for (int n = 0; n < 2; ++n) acc[a][b][m][n] = (f32x4){0.f, 0.f, 0.f, 0.f};
        cur = nxt; cA = nA; cB = nB; ++ui;
        if constexpr (ALIGN_EPI) { if (wr == 1) PG8_BAR; }
    }
    PG8_WAIT_V(0);
    if constexpr (!ALIGN_EPI) { if (wr == 0) PG8_BAR; }
    PG8_BAR;
    if constexpr (Epi::AFTER_DRAIN) { E.fused(acc, cur, wr, wc, fr, fq, lds, wid, lane); S.done(cur); }
#undef PG8_SA
#undef PG8_SB
#undef PG8_STAGE
#undef PG8_LDA
#undef PG8_LDB
#undef PG8_MMA
#undef PG8_WAIT_V
#undef PG8_WAIT_L
#undef PG8_BAR
#undef PG8_SCHED
}
}

#ifndef PG8_SP2
#define PG8_SP2 true
#endif
#ifndef PG8_ALIGN
#define PG8_ALIGN true
#endif
#include <hip/hip_bf16.h>
#include <cmath>
namespace attn_body {
using bf16=__hip_bfloat16;
using bf16x8=__attribute__((ext_vector_type(8)))short;
using s16x4=__attribute__((ext_vector_type(4)))short;
using f32x16=__attribute__((ext_vector_type(16)))float;
using u32x4=__attribute__((ext_vector_type(4)))unsigned;
constexpr int SEQ=8192,D=64,PQ=512,PO=1024;
constexpr int NW=8,QBLK=32,QB=QBLK*NW,KVBLK=64,NQB=SEQ/QB;
constexpr int ATTN_UNIT_ROWS=QB;
__device__ __forceinline__ int crow(int r,int hi){return (r&3)+8*(r>>2)+4*hi;}
#define SBAR() __builtin_amdgcn_sched_barrier(0)
__device__ __forceinline__ void cmask(f32x16&p0,f32x16&p1,int jb,int qrel,int hi){
  const float NEG=-INFINITY; int kb=64*jb+4*hi;
  #pragma unroll
  for(int r=0;r<16;++r){int kv=kb+(r&3)+8*(r>>2); if(kv>qrel)p0[r]=NEG; if(kv+32>qrel)p1[r]=NEG;}
}

constexpr int NSLOT=3, SLOTB=8192;
constexpr int LDS_K=0, LDS_V=NSLOT*SLOTB, LDS_WS=2*NSLOT*SLOTB, LDS_OST=LDS_WS+NW*64*4, LDS_BYTES=LDS_OST+NW*4096;
constexpr float C2=0.125f*1.4426950408889634f;
__device__ __forceinline__ void glds16(const void*gsrc,unsigned lds_dst){unsigned keep;
  asm volatile("s_mov_b32 %0, m0\n\ts_mov_b32 m0, %2\n\ts_nop 0\n\tglobal_load_lds_dwordx4 %1, off\n\ts_mov_b32 m0, %0":"=&s"(keep):"v"(gsrc),"s"(lds_dst):"memory");}
__device__ __forceinline__ float max3f(float a,float b,float c){float r;asm("v_max3_f32 %0, %1, %2, %3":"=v"(r):"v"(a),"v"(b),"v"(c));return r;}
__device__ __forceinline__ float max2f(float a,float b){float r;asm("v_max_f32_e32 %0, %1, %2":"=v"(r):"v"(a),"v"(b));return r;}
__device__ __forceinline__ float fadd_s(float a,float b){float r;asm("v_add_f32_e32 %0, %1, %2":"=v"(r):"v"(a),"v"(b));return r;}
__device__ __forceinline__ float fsub_s(float a,float b){float r;asm("v_sub_f32_e32 %0, %1, %2":"=v"(r):"v"(a),"v"(b));return r;}
typedef float f32x2_t __attribute__((ext_vector_type(2))); typedef __bf16 bf16x2_t __attribute__((ext_vector_type(2)));
__device__ __forceinline__ unsigned cvtpk_s(float lo,float hi){f32x2_t v={lo,hi};bf16x2_t b=__builtin_convertvector(v,bf16x2_t);return __builtin_bit_cast(unsigned,b);}
#define WAIT_BAR(N) asm volatile("s_waitcnt vmcnt(" #N ") lgkmcnt(0)\n\ts_barrier":::"memory")

__device__ __forceinline__ void qkt(f32x16&p0,f32x16&p1,const char*Kslot,const bf16x8*qr,const f32x16&negm,int r32,int hi){
  const char*kb=Kslot+hi*1024+r32*16;
  #pragma unroll
  for(int d0=0;d0<4;++d0){
    const bf16x8 b0=*reinterpret_cast<const bf16x8*>(kb+d0*2048);
    const bf16x8 b1=*reinterpret_cast<const bf16x8*>(kb+d0*2048+512);
    if(d0==0){p0=__builtin_amdgcn_mfma_f32_32x32x16_bf16(b0,qr[0],negm,0,0,0);p1=__builtin_amdgcn_mfma_f32_32x32x16_bf16(b1,qr[0],negm,0,0,0);}
    else{p0=__builtin_amdgcn_mfma_f32_32x32x16_bf16(b0,qr[d0],p0,0,0,0);p1=__builtin_amdgcn_mfma_f32_32x32x16_bf16(b1,qr[d0],p1,0,0,0);}}
}
typedef __attribute__((address_space(3))) const char* lds_cptr;
typedef short v4i16_t __attribute__((ext_vector_type(4)));
__device__ __forceinline__ void kload8(bf16x8*kf,lds_cptr kp){
  kf[0]=*(const __attribute__((address_space(3))) bf16x8*)(kp);      kf[1]=*(const __attribute__((address_space(3))) bf16x8*)(kp+512);
  kf[2]=*(const __attribute__((address_space(3))) bf16x8*)(kp+2048); kf[3]=*(const __attribute__((address_space(3))) bf16x8*)(kp+2560);
  kf[4]=*(const __attribute__((address_space(3))) bf16x8*)(kp+4096); kf[5]=*(const __attribute__((address_space(3))) bf16x8*)(kp+4608);
  kf[6]=*(const __attribute__((address_space(3))) bf16x8*)(kp+6144); kf[7]=*(const __attribute__((address_space(3))) bf16x8*)(kp+6656);
}
__device__ __forceinline__ void kload2(bf16x8*kf,lds_cptr kp,int j){ kf[2*j]=*(const __attribute__((address_space(3))) bf16x8*)(kp+j*2048); kf[2*j+1]=*(const __attribute__((address_space(3))) bf16x8*)(kp+j*2048+512); }
__device__ __forceinline__ s16x4 vtr(lds_cptr p){ return __builtin_bit_cast(s16x4,__builtin_amdgcn_ds_read_tr16_b64_v4i16((__attribute__((address_space(3))) v4i16_t*)p)); }
__device__ __forceinline__ float rowmax(const f32x16&p0,const f32x16&p1){
  float a=max3f(p0[0],p0[1],p1[0]),b=max3f(p0[2],p0[3],p1[1]);a=max3f(a,p1[2],p1[3]);
  #pragma unroll
  for(int r=4;r<16;r+=4){a=max3f(a,p0[r],p0[r+1]);b=max3f(b,p0[r+2],p0[r+3]);a=max3f(a,p1[r],p1[r+1]);b=max3f(b,p1[r+2],p1[r+3]);}
  const float m=max2f(a,b);
  auto rr=__builtin_amdgcn_permlane32_swap(__float_as_uint(m),__float_as_uint(m),false,false);
  return max2f(__uint_as_float(rr[0]),__uint_as_float(rr[1]));
}
__device__ __forceinline__ void pv(f32x16*o,int vb,bf16x8 pa0,bf16x8 pa1,bf16x8 pa2,bf16x8 pa3){
  #pragma unroll
  for(int d0=0;d0<2;++d0){s16x4 lo[4],hi[4];
    #pragma unroll
    for(int ks=0;ks<4;++ks){
      asm volatile("ds_read_b64_tr_b16 %0,%1 offset:%c2":"=&v"(lo[ks]):"v"(vb),"i"(d0*4096+ks*1024):"memory");
      asm volatile("ds_read_b64_tr_b16 %0,%1 offset:%c2":"=&v"(hi[ks]):"v"(vb),"i"(d0*4096+ks*1024+512):"memory");}
    asm volatile("s_waitcnt lgkmcnt(0)":::"memory");SBAR();
    #define PK(k) (bf16x8){lo[k][0],lo[k][1],lo[k][2],lo[k][3],hi[k][0],hi[k][1],hi[k][2],hi[k][3]}
    o[d0]=__builtin_amdgcn_mfma_f32_32x32x16_bf16(pa0,PK(0),o[d0],0,0,0);
    o[d0]=__builtin_amdgcn_mfma_f32_32x32x16_bf16(pa1,PK(1),o[d0],0,0,0);
    o[d0]=__builtin_amdgcn_mfma_f32_32x32x16_bf16(pa2,PK(2),o[d0],0,0,0);
    o[d0]=__builtin_amdgcn_mfma_f32_32x32x16_bf16(pa3,PK(3),o[d0],0,0,0);
    #undef PK
  }
}

#ifndef ATTN_STORE16
#define ATTN_STORE16(p,v) (*(u32x4*)(p)=(v))
#endif
template<int THRL> __device__ __forceinline__ void attn_unit(int q0,const bf16*Qu,const bf16*__restrict__ Kh,const bf16*__restrict__ Vh,bf16*Ou,char*shm){
  int tid_=threadIdx.x; asm volatile("":"+v"(tid_)); const int tid=tid_,lane=tid&63,r32=lane&31,hi=lane>>5; const int wid=__builtin_amdgcn_readfirstlane(tid>>6);
  const bf16*Qw=Qu+(long)(wid*QBLK)*PQ;
  const unsigned lds0=(unsigned)(uintptr_t)shm;
  float*wsf=(float*)(shm+LDS_WS)+wid*64;
  const bf16*ksrc=Kh+(long)lane*PQ+wid*8;
  const bf16*vsrc=Vh+(long)(16*(wid&3)+(lane>>2))*PQ+(wid>>2)*32+(lane&3)*8;
  const unsigned kdst=lds0+LDS_K+wid*1024, vdst=lds0+LDS_V+wid*1024;
  #define DMA_K(t,slot) glds16(ksrc+(long)(t)*KVBLK*PQ,(unsigned)__builtin_amdgcn_readfirstlane(kdst+(slot)))
  #define DMA_V(t,slot) glds16(vsrc+(long)(t)*KVBLK*PQ,(unsigned)__builtin_amdgcn_readfirstlane(vdst+(slot)))
  const int vb0=(int)(lds0+LDS_V)+((lane>>4)&1)*32+(lane&3)*8+(4*hi+((lane&15)>>2))*64;
  const char*Kbase=shm+LDS_K; bf16x8 kf[8];
  const lds_cptr shm3=(lds_cptr)shm; const lds_cptr kp0=shm3+LDS_K+hi*1024+r32*16; const lds_cptr vp0=shm3+LDS_V+((lane>>4)&1)*32+(lane&3)*8+(4*hi+((lane&15)>>2))*64;
  const int NT=(q0+QB)/KVBLK+1;
  DMA_K(0,0);DMA_V(0,0);DMA_K(1,SLOTB);
  bf16x8 qr[4];
  #pragma unroll
  for(int d0=0;d0<4;++d0)qr[d0]=*reinterpret_cast<const bf16x8*>(&Qw[(long)r32*PQ+d0*16+hi*8]);
  float mhat=0.f,l_reg=0.f;f32x16 o[2];o[0]=f32x16{};o[1]=f32x16{};f32x16 negm=f32x16{};asm volatile("":"+v"(negm));
  const int qrel=wid*QBLK+r32;
  #define CMASK(P0,P1,t) do{int jb_=(t)-(NT-4); if(jb_>=0)cmask(P0,P1,jb_,qrel,hi);}while(0)
  bool resc=false;
  #define START(P0,P1) do{ const float rm=rowmax(P0,P1); resc=false; \
    { const float dl=rm; mhat=fadd_s(mhat,dl); \
      _Pragma("unroll") for(int r=0;r<16;++r){P0[r]=fsub_s(P0[r],dl);P1[r]=fsub_s(P1[r],dl);} \
      _Pragma("unroll") for(int r=0;r<16;++r)negm[r]=-mhat; asm volatile("":"+v"(negm)); } \
    _Pragma("unroll") for(int r=0;r<16;++r)P0[r]=__builtin_amdgcn_exp2f(P0[r]); }while(0)
  #define RESC() do{ if(resc){ asm volatile("s_waitcnt lgkmcnt(0)":::"memory"); \
      _Pragma("unroll") for(int d_=0;d_<2;++d_) _Pragma("unroll") for(int r=0;r<16;++r)o[d_][r]*=wsf[crow(r,hi)]; } }while(0)
  f32x16 pA0,pA1,pB0,pB1;
  int sl_prev=0,sl_cur=0,sl_next=SLOTB;
  #define ROT() do{sl_prev=sl_cur;sl_cur=sl_next;sl_next=(sl_next==(NSLOT-1)*SLOTB)?0:sl_next+SLOTB;}while(0)
  DMA_K(2,2*SLOTB);
  WAIT_BAR(3);
  qkt(pA0,pA1,Kbase,qr,negm,r32,hi);asm volatile("s_nop 15\n\ts_nop 7":"+v"(pA0),"+v"(pA1));
  { const float NEGI=-INFINITY; _Pragma("unroll") for(int r=8;r<16;++r)pA0[r]=NEGI; _Pragma("unroll") for(int r=0;r<16;++r)pA1[r]=NEGI; }
  START(pA0,pA1);
  _Pragma("unroll") for(int r=0;r<16;++r)pA1[r]=__builtin_amdgcn_exp2f(pA1[r]);
  WAIT_BAR(0);
  DMA_K(3,0);DMA_V(1,SLOTB);
  ROT();
  kload8(kf,kp0+sl_cur);
  WAIT_BAR(2);
  s16x4 vlo[8],vhi[8]; u32x4 pw0,pw1,pw2,pw3;
  #define PKW(P,B) cvtpk_s(P[B],P[B+1])
  #define PAF(k) __builtin_bit_cast(bf16x8,pw##k)
  #define VFR(i) (bf16x8){vlo[i][0],vlo[i][1],vlo[i][2],vlo[i][3],vhi[i][0],vhi[i][1],vhi[i][2],vhi[i][3]}
  #define PIN(x) asm volatile("":"+v"(x))
  #define MX3(a,b,c) __builtin_fmaxf(__builtin_fmaxf((a),(b)),(c))
  #define GAPA(MF,A0,A1,A2,A3,W0,W1,PW) do{ MF; sacc+=A0; sacc+=A1; sacc+=A2; sacc+=A3; PIN(sacc); W0; W1; PIN(PW); SBAR(); }while(0)
  #define EX(v) __builtin_amdgcn_exp2f(v)
  #define GAPB(MF,X,B) do{ MF; X[B]=EX(X[B]); X[B+1]=EX(X[B+1]); X[B+2]=EX(X[B+2]); X[B+3]=EX(X[B+3]); PIN(X); SBAR(); }while(0)
  #define VRD(i) do{ vlo[i]=vtr(vp_+(((i)>>2)*4096+((i)&3)*1024)); vhi[i]=vtr(vp_+(((i)>>2)*4096+((i)&3)*1024+512)); }while(0)
  #define KRD(G,j) do{ if(G){ kload2(kf,kp0+sl_next,j); SBAR(); } }while(0)
  #define STEP(C0,C1,P0,P1,t,GK,GV,GL) do{ SBAR(); \
    const lds_cptr vp_=vp0+sl_prev; \
    VRD(0); SBAR(); float sacc=(P0[0]+P0[1]); \
    GAPA(C0=__builtin_amdgcn_mfma_f32_32x32x16_bf16(kf[0],qr[0],negm,0,0,0), P0[2],P0[3],P0[4],P0[5],     pw0[0]=PKW(P0,0), pw0[1]=PKW(P0,2), pw0); \
    VRD(4); SBAR(); GAPA(C1=__builtin_amdgcn_mfma_f32_32x32x16_bf16(kf[1],qr[0],negm,0,0,0), P0[6],P0[7],P0[8],P0[9],     pw0[2]=PKW(P0,4), pw0[3]=PKW(P0,6), pw0); \
    VRD(1); SBAR(); GAPA(C0=__builtin_amdgcn_mfma_f32_32x32x16_bf16(kf[2],qr[1],C0,0,0,0),   P0[10],P0[11],P0[12],P0[13], pw1[0]=PKW(P0,8), pw1[1]=PKW(P0,10), pw1); \
    VRD(5); SBAR(); GAPA(C1=__builtin_amdgcn_mfma_f32_32x32x16_bf16(kf[3],qr[1],C1,0,0,0),   P0[14],P0[15],P1[0],P1[1],   pw1[2]=PKW(P0,12),pw1[3]=PKW(P0,14), pw1); \
    VRD(2); SBAR(); GAPA(C0=__builtin_amdgcn_mfma_f32_32x32x16_bf16(kf[4],qr[2],C0,0,0,0),   P1[2],P1[3],P1[4],P1[5],     pw2[0]=PKW(P1,0), pw2[1]=PKW(P1,2), pw2); \
    VRD(6); SBAR(); GAPA(C1=__builtin_amdgcn_mfma_f32_32x32x16_bf16(kf[5],qr[2],C1,0,0,0),   P1[6],P1[7],P1[8],P1[9],     pw2[2]=PKW(P1,4), pw2[3]=PKW(P1,6), pw2); \
    VRD(3); SBAR(); GAPA(C0=__builtin_amdgcn_mfma_f32_32x32x16_bf16(kf[6],qr[3],C0,0,0,0),   P1[10],P1[11],P1[12],P1[13], pw3[0]=PKW(P1,8), pw3[1]=PKW(P1,10), pw3); \
    VRD(7); SBAR(); GAPA(C1=__builtin_amdgcn_mfma_f32_32x32x16_bf16(kf[7],qr[3],C1,0,0,0),   P1[14],P1[15],0.f,0.f,       pw3[2]=PKW(P1,12),pw3[3]=PKW(P1,14), pw3); \
    l_reg+=sacc; \
    if(GK){DMA_K((t)+3,sl_cur);} if(GV){DMA_V((t)+1,sl_next);} \
    CMASK(C0,C1,t); \
    { float a=MX3(C0[0],C0[1],C1[0]),b=MX3(C0[2],C0[3],C1[1]); a=MX3(a,C1[2],C1[3]); \
      _Pragma("unroll") for(int r=4;r<16;r+=4){a=MX3(a,C0[r],C0[r+1]);b=MX3(b,C0[r+2],C0[r+3]);a=MX3(a,C1[r],C1[r+1]);b=MX3(b,C1[r+2],C1[r+3]);} \
      float rm=__builtin_fmaxf(a,b); { auto rr=__builtin_amdgcn_permlane32_swap(__float_as_uint(rm),__float_as_uint(rm),false,false); rm=__builtin_fmaxf(__uint_as_float(rr[0]),__uint_as_float(rr[1])); } \
      resc=false; \
      if(__builtin_expect(__any(rm>(float)THRL),0)){ const float dl=__builtin_fmaxf(rm,0.f); mhat+=dl; \
        _Pragma("unroll") for(int r=0;r<16;++r){C0[r]-=dl;C1[r]-=dl;} \
        _Pragma("unroll") for(int r=0;r<16;++r)negm[r]=-mhat; asm volatile("":"+v"(negm)); \
        const float f=__builtin_amdgcn_exp2f(-dl); l_reg*=f; if(hi==0)wsf[r32]=f; resc=true; } } \
    SBAR(); \
    GAPB(o[0]=__builtin_amdgcn_mfma_f32_32x32x16_bf16(PAF(0),VFR(0),o[0],0,0,0), C0,0); \
    GAPB(o[1]=__builtin_amdgcn_mfma_f32_32x32x16_bf16(PAF(0),VFR(4),o[1],0,0,0), C0,4); \
    KRD(GL,0); GAPB(o[0]=__builtin_amdgcn_mfma_f32_32x32x16_bf16(PAF(1),VFR(1),o[0],0,0,0), C0,8); \
    KRD(GL,1); GAPB(o[1]=__builtin_amdgcn_mfma_f32_32x32x16_bf16(PAF(1),VFR(5),o[1],0,0,0), C0,12); \
    KRD(GL,2); GAPB(o[0]=__builtin_amdgcn_mfma_f32_32x32x16_bf16(PAF(2),VFR(2),o[0],0,0,0), C1,0); \
    KRD(GL,3); GAPB(o[1]=__builtin_amdgcn_mfma_f32_32x32x16_bf16(PAF(2),VFR(6),o[1],0,0,0), C1,4); \
    GAPB(o[0]=__builtin_amdgcn_mfma_f32_32x32x16_bf16(PAF(3),VFR(3),o[0],0,0,0), C1,8); \
    GAPB(o[1]=__builtin_amdgcn_mfma_f32_32x32x16_bf16(PAF(3),VFR(7),o[1],0,0,0), C1,12); \
    }while(0)
  int t=1;
  #undef CMASK
  #define CMASK(P0,P1,t) do{}while(0)
  for(;t+5<NT;t+=2){
    STEP(pB0,pB1,pA0,pA1,t,true,true,true);     WAIT_BAR(2); RESC(); ROT();
    STEP(pA0,pA1,pB0,pB1,t+1,true,true,true);   WAIT_BAR(2); RESC(); ROT();
  }
  #undef CMASK
  #define CMASK(P0,P1,t) do{int jb_=(t)-(NT-4); if(jb_>=0)cmask(P0,P1,jb_,qrel,hi);}while(0)
  #define ENDW(tt) do{ if((tt)+3<NT){WAIT_BAR(2);} else if((tt)+2<NT){WAIT_BAR(1);} else {WAIT_BAR(0);} }while(0)
  for(;t+1<NT;t+=2){
    STEP(pB0,pB1,pA0,pA1,t,(t+3<NT),(t+1<NT),(t+1<NT));       ENDW(t);   RESC(); ROT();
    STEP(pA0,pA1,pB0,pB1,t+1,(t+4<NT),(t+2<NT),(t+2<NT));     ENDW(t+1); RESC(); ROT();
  }
  { float sacc=pA0[0]+pA0[1]; _Pragma("unroll") for(int r=2;r<16;++r)sacc+=pA0[r]; _Pragma("unroll") for(int r=0;r<16;++r)sacc+=pA1[r]; l_reg+=sacc;
    pw0=(u32x4){PKW(pA0,0),PKW(pA0,2),PKW(pA0,4),PKW(pA0,6)};pw1=(u32x4){PKW(pA0,8),PKW(pA0,10),PKW(pA0,12),PKW(pA0,14)};pw2=(u32x4){PKW(pA1,0),PKW(pA1,2),PKW(pA1,4),PKW(pA1,6)};pw3=(u32x4){PKW(pA1,8),PKW(pA1,10),PKW(pA1,12),PKW(pA1,14)};
    SBAR(); pv(o,vb0+sl_prev,PAF(0),PAF(1),PAF(2),PAF(3)); }
  #undef PKW
  #undef PAF
  #undef VFR
  #undef PIN
  #undef MX3
  #undef GAPA
  #undef GAPB
  #undef EX
  #undef VRD
  #undef KRD
  #undef STEP
  #undef ENDW
  {auto rr=__builtin_amdgcn_permlane32_swap(__float_as_uint(l_reg),__float_as_uint(l_reg),false,false);l_reg=__uint_as_float(rr[0])+__uint_as_float(rr[1]);}
  if(hi==0)wsf[32+r32]=l_reg;asm volatile("s_waitcnt lgkmcnt(0)":::"memory");
  float rli[16];
  #pragma unroll
  for(int r=0;r<16;++r)rli[r]=__builtin_amdgcn_rcpf(wsf[32+crow(r,hi)]);
  bf16*Ow=Ou+(long)(wid*QBLK)*PO;
  { bf16*stg=(bf16*)(shm+LDS_OST)+wid*2048;
    #pragma unroll
    for(int r=0;r<16;++r){const int orow=crow(r,hi);
      #pragma unroll
      for(int d0=0;d0<2;++d0)stg[orow*64+d0*32+r32]=__float2bfloat16(o[d0][r]*rli[r]);}
    asm volatile("s_waitcnt lgkmcnt(0)":::"memory");
    #pragma unroll
    for(int i=0;i<4;++i){const int row=i*8+(lane>>3),ch=lane&7; const u32x4 v=*(const u32x4*)(stg+row*64+ch*8); ATTN_STORE16(Ow+(long)row*PO+ch*8,v);} }
  asm volatile("s_waitcnt lgkmcnt(0)\n\ts_barrier":::"memory");
  #undef DMA_K
  #undef DMA_V
  #undef CMASK
  #undef START
  #undef RESC
  #undef ROT
}
constexpr int ATTN_LDS_BYTES=LDS_BYTES;
#undef SBAR
#undef WAIT_BAR
typedef float f32x4v __attribute__((ext_vector_type(4)));
constexpr int V2_SLOTV=16384, V2_LDS_K=0, V2_LDS_V=NSLOT*SLOTB, V2_LDS_WS=V2_LDS_V+NSLOT*V2_SLOTV, V2_LDS_OST=V2_LDS_WS+NW*64*4, V2_LDS_BYTES=V2_LDS_OST+NW*8192;
#define SBAR() __builtin_amdgcn_sched_barrier(0)
#define WAIT_BAR(N) asm volatile("s_waitcnt vmcnt(" #N ") lgkmcnt(0)\n\ts_barrier":::"memory")
__device__ __forceinline__ void pv4(f32x16*o,int vb,bf16x8 pa0,bf16x8 pa1,bf16x8 pa2,bf16x8 pa3){
  #pragma unroll
  for(int d0=0;d0<4;++d0){s16x4 lo[4],hi[4];
    #pragma unroll
    for(int ks=0;ks<4;++ks){
      asm volatile("ds_read_b64_tr_b16 %0,%1 offset:%c2":"=&v"(lo[ks]):"v"(vb),"i"(d0*4096+ks*1024):"memory");
      asm volatile("ds_read_b64_tr_b16 %0,%1 offset:%c2":"=&v"(hi[ks]):"v"(vb),"i"(d0*4096+ks*1024+512):"memory");}
    asm volatile("s_waitcnt lgkmcnt(0)":::"memory");SBAR();
    #define PK(k) (bf16x8){lo[k][0],lo[k][1],lo[k][2],lo[k][3],hi[k][0],hi[k][1],hi[k][2],hi[k][3]}
    o[d0]=__builtin_amdgcn_mfma_f32_32x32x16_bf16(pa0,PK(0),o[d0],0,0,0);
    o[d0]=__builtin_amdgcn_mfma_f32_32x32x16_bf16(pa1,PK(1),o[d0],0,0,0);
    o[d0]=__builtin_amdgcn_mfma_f32_32x32x16_bf16(pa2,PK(2),o[d0],0,0,0);
    o[d0]=__builtin_amdgcn_mfma_f32_32x32x16_bf16(pa3,PK(3),o[d0],0,0,0);
    #undef PK
  }
}
template<int MODE> __device__ __forceinline__ void attn_unit128(int q0,const bf16*Qu,const bf16*__restrict__ Kh,const bf16*__restrict__ Vh,bf16*Ou,char*shm,float lam,float oscale,const float*subg){
  int tid_=threadIdx.x; asm volatile("":"+v"(tid_)); const int tid=tid_,lane=tid&63,r32=lane&31,hi=lane>>5; const int wid=__builtin_amdgcn_readfirstlane(tid>>6);
  const bf16*Qw=Qu+(long)(wid*QBLK)*PQ;
  const unsigned lds0=(unsigned)(uintptr_t)shm;
  float*wsf=(float*)(shm+V2_LDS_WS)+wid*64;
  const bf16*ksrc=Kh+(long)lane*PQ+wid*8;
  const bf16*vsrc=Vh+(long)(16*(wid&3)+(lane>>2))*PQ+(wid>>2)*32+(lane&3)*8;
  const unsigned kdst=lds0+V2_LDS_K+wid*1024, vdst=lds0+V2_LDS_V+wid*1024;
  #define DMA_K(t,slot) glds16(ksrc+(long)(t)*KVBLK*PQ,(unsigned)__builtin_amdgcn_readfirstlane(kdst+(slot)))
  #define DMA_V(t,slot) do{ glds16(vsrc+(long)(t)*KVBLK*PQ,(unsigned)__builtin_amdgcn_readfirstlane(vdst+2*(slot))); glds16(vsrc+(long)(t)*KVBLK*PQ+64,(unsigned)__builtin_amdgcn_readfirstlane(vdst+2*(slot)+8192)); }while(0)
  const int vb0=(int)(lds0+V2_LDS_V)+((lane>>4)&1)*32+(lane&3)*8+(4*hi+((lane&15)>>2))*64;
  const char*Kbase=shm+V2_LDS_K; bf16x8 kf[8];
  const lds_cptr shm3=(lds_cptr)shm; const lds_cptr kp0=shm3+V2_LDS_K+hi*1024+r32*16; const lds_cptr vp0=shm3+V2_LDS_V+((lane>>4)&1)*32+(lane&3)*8+(4*hi+((lane&15)>>2))*64;
  const int NT=(q0+QB)/KVBLK+1;
  DMA_K(0,0);DMA_V(0,0);DMA_K(1,SLOTB);
  bf16x8 qr[4];
  #pragma unroll
  for(int d0=0;d0<4;++d0)qr[d0]=*reinterpret_cast<const bf16x8*>(&Qw[(long)r32*PQ+d0*16+hi*8]);
  float l_reg=0.f;f32x16 o[4];o[0]=f32x16{};o[1]=f32x16{};o[2]=f32x16{};o[3]=f32x16{};
  const f32x16 zero16=f32x16{};
  const int qrel=wid*QBLK+r32;
  #define CMASK(P0,P1,t) do{int jb_=(t)-(NT-4); if(jb_>=0)cmask(P0,P1,jb_,qrel,hi);}while(0)
  f32x16 pA0,pA1,pB0,pB1;
  int sl_prev=0,sl_cur=0,sl_next=SLOTB;
  #define ROT() do{sl_prev=sl_cur;sl_cur=sl_next;sl_next=(sl_next==(NSLOT-1)*SLOTB)?0:sl_next+SLOTB;}while(0)
  DMA_K(2,2*SLOTB);
  WAIT_BAR(3);
  qkt(pA0,pA1,Kbase,qr,zero16,r32,hi);asm volatile("s_nop 15\n\ts_nop 7":"+v"(pA0),"+v"(pA1));
  { const float NEGI=-INFINITY; _Pragma("unroll") for(int r=8;r<16;++r)pA0[r]=NEGI; _Pragma("unroll") for(int r=0;r<16;++r)pA1[r]=NEGI; }
  _Pragma("unroll") for(int r=0;r<16;++r){pA0[r]=__builtin_amdgcn_exp2f(pA0[r]);pA1[r]=__builtin_amdgcn_exp2f(pA1[r]);}
  WAIT_BAR(0);
  DMA_K(3,0);DMA_V(1,SLOTB);
  ROT();
  kload8(kf,kp0+sl_cur);
  WAIT_BAR(3);
  s16x4 vlo[8],vhi[8]; u32x4 pw0,pw1,pw2,pw3;
  #define PKW(P,B) cvtpk_s(P[B],P[B+1])
  #define PAF(k) __builtin_bit_cast(bf16x8,pw##k)
  #define VFR(i) (bf16x8){vlo[i][0],vlo[i][1],vlo[i][2],vlo[i][3],vhi[i][0],vhi[i][1],vhi[i][2],vhi[i][3]}
  #define PIN(x) asm volatile("":"+v"(x))
  #define GAPA(MF,A0,A1,A2,A3,W0,W1,PW) do{ MF; sacc+=A0; sacc+=A1; sacc+=A2; sacc+=A3; PIN(sacc); W0; W1; PIN(PW); SBAR(); }while(0)
  #define EX(v) __builtin_amdgcn_exp2f(v)
  #define GAPB(MF,X,B) do{ MF; X[B]=EX(X[B]); X[B+1]=EX(X[B+1]); PIN(X); SBAR(); }while(0)
  #define VRD(i) do{ vlo[i]=vtr(vp_+(((i)>>2)*4096+((i)&3)*1024)); vhi[i]=vtr(vp_+(((i)>>2)*4096+((i)&3)*1024+512)); }while(0)
  #define VRD2(i) do{ vlo[i]=vtr(vp_+(8192+((i)>>2)*4096+((i)&3)*1024)); vhi[i]=vtr(vp_+(8192+((i)>>2)*4096+((i)&3)*1024+512)); SBAR(); }while(0)
  #define KRD(G,j) do{ if(G){ kload2(kf,kp0+sl_next,j); SBAR(); } }while(0)
  #define MF32(a,b,c) __builtin_amdgcn_mfma_f32_32x32x16_bf16(a,b,c,0,0,0)
  #define STEP(C0,C1,P0,P1,t,GK,GV,GL) do{ SBAR(); \
    const lds_cptr vp_=vp0+2*sl_prev; \
    VRD(0); SBAR(); float sacc=(P0[0]+P0[1]); \
    GAPA(C0=MF32(kf[0],qr[0],zero16), P0[2],P0[3],P0[4],P0[5],     pw0[0]=PKW(P0,0), pw0[1]=PKW(P0,2), pw0); \
    VRD(4); SBAR(); GAPA(C1=MF32(kf[1],qr[0],zero16), P0[6],P0[7],P0[8],P0[9],     pw0[2]=PKW(P0,4), pw0[3]=PKW(P0,6), pw0); \
    VRD(1); SBAR(); GAPA(C0=MF32(kf[2],qr[1],C0),   P0[10],P0[11],P0[12],P0[13], pw1[0]=PKW(P0,8), pw1[1]=PKW(P0,10), pw1); \
    VRD(5); SBAR(); GAPA(C1=MF32(kf[3],qr[1],C1),   P0[14],P0[15],P1[0],P1[1],   pw1[2]=PKW(P0,12),pw1[3]=PKW(P0,14), pw1); \
    VRD(2); SBAR(); GAPA(C0=MF32(kf[4],qr[2],C0),   P1[2],P1[3],P1[4],P1[5],     pw2[0]=PKW(P1,0), pw2[1]=PKW(P1,2), pw2); \
    VRD(6); SBAR(); GAPA(C1=MF32(kf[5],qr[2],C1),   P1[6],P1[7],P1[8],P1[9],     pw2[2]=PKW(P1,4), pw2[3]=PKW(P1,6), pw2); \
    VRD(3); SBAR(); GAPA(C0=MF32(kf[6],qr[3],C0),   P1[10],P1[11],P1[12],P1[13], pw3[0]=PKW(P1,8), pw3[1]=PKW(P1,10), pw3); \
    VRD(7); SBAR(); GAPA(C1=MF32(kf[7],qr[3],C1),   P1[14],P1[15],0.f,0.f,       pw3[2]=PKW(P1,12),pw3[3]=PKW(P1,14), pw3); \
    l_reg+=sacc; \
    if(GK){DMA_K((t)+3,sl_cur);} if(GV){DMA_V((t)+1,sl_next);} \
    CMASK(C0,C1,t); \
    SBAR(); \
    GAPB(o[0]=MF32(PAF(0),VFR(0),o[0]), C0,0);  VRD2(0); \
    GAPB(o[1]=MF32(PAF(0),VFR(4),o[1]), C0,2);  VRD2(4); \
    KRD(GL,0); GAPB(o[0]=MF32(PAF(1),VFR(1),o[0]), C0,4);  VRD2(1); \
    KRD(GL,1); GAPB(o[1]=MF32(PAF(1),VFR(5),o[1]), C0,6);  VRD2(5); \
    KRD(GL,2); GAPB(o[0]=MF32(PAF(2),VFR(2),o[0]), C0,8);  VRD2(2); \
    KRD(GL,3); GAPB(o[1]=MF32(PAF(2),VFR(6),o[1]), C0,10); VRD2(6); \
    GAPB(o[0]=MF32(PAF(3),VFR(3),o[0]), C0,12); VRD2(3); \
    GAPB(o[1]=MF32(PAF(3),VFR(7),o[1]), C0,14); VRD2(7); \
    GAPB(o[2]=MF32(PAF(0),VFR(0),o[2]), C1,0); \
    GAPB(o[3]=MF32(PAF(0),VFR(4),o[3]), C1,2); \
    GAPB(o[2]=MF32(PAF(1),VFR(1),o[2]), C1,4); \
    GAPB(o[3]=MF32(PAF(1),VFR(5),o[3]), C1,6); \
    GAPB(o[2]=MF32(PAF(2),VFR(2),o[2]), C1,8); \
    GAPB(o[3]=MF32(PAF(2),VFR(6),o[3]), C1,10); \
    GAPB(o[2]=MF32(PAF(3),VFR(3),o[2]), C1,12); \
    GAPB(o[3]=MF32(PAF(3),VFR(7),o[3]), C1,14); \
    }while(0)
  int t=1;
  #undef CMASK
  #define CMASK(P0,P1,t) do{}while(0)
  for(;t+5<NT;t+=2){
    STEP(pB0,pB1,pA0,pA1,t,true,true,true);     WAIT_BAR(3); ROT();
    STEP(pA0,pA1,pB0,pB1,t+1,true,true,true);   WAIT_BAR(3); ROT();
  }
  #undef CMASK
  #define CMASK(P0,P1,t) do{int jb_=(t)-(NT-4); if(jb_>=0)cmask(P0,P1,jb_,qrel,hi);}while(0)
  #define ENDW(tt) do{ if((tt)+3<NT){WAIT_BAR(3);} else if((tt)+2<NT){WAIT_BAR(2);} else {WAIT_BAR(0);} }while(0)
  for(;t+1<NT;t+=2){
    STEP(pB0,pB1,pA0,pA1,t,(t+3<NT),(t+1<NT),(t+1<NT));       ENDW(t);   ROT();
    STEP(pA0,pA1,pB0,pB1,t+1,(t+4<NT),(t+2<NT),(t+2<NT));     ENDW(t+1); ROT();
  }
  { float sacc=pA0[0]+pA0[1]; _Pragma("unroll") for(int r=2;r<16;++r)sacc+=pA0[r]; _Pragma("unroll") for(int r=0;r<16;++r)sacc+=pA1[r]; l_reg+=sacc;
    pw0=(u32x4){PKW(pA0,0),PKW(pA0,2),PKW(pA0,4),PKW(pA0,6)};pw1=(u32x4){PKW(pA0,8),PKW(pA0,10),PKW(pA0,12),PKW(pA0,14)};pw2=(u32x4){PKW(pA1,0),PKW(pA1,2),PKW(pA1,4),PKW(pA1,6)};pw3=(u32x4){PKW(pA1,8),PKW(pA1,10),PKW(pA1,12),PKW(pA1,14)};
    SBAR(); pv4(o,vb0+2*sl_prev,PAF(0),PAF(1),PAF(2),PAF(3)); }
  #undef PKW
  #undef PAF
  #undef VFR
  #undef PIN
  #undef GAPA
  #undef GAPB
  #undef EX
  #undef VRD
  #undef VRD2
  #undef KRD
  #undef MF32
  #undef STEP
  #undef ENDW
  {auto rr=__builtin_amdgcn_permlane32_swap(__float_as_uint(l_reg),__float_as_uint(l_reg),false,false);l_reg=__uint_as_float(rr[0])+__uint_as_float(rr[1]);}
  if(hi==0)wsf[32+r32]=l_reg;asm volatile("s_waitcnt lgkmcnt(0)":::"memory");
  float rli[16];
  #pragma unroll
  for(int r=0;r<16;++r)rli[r]=__builtin_amdgcn_rcpf(wsf[32+crow(r,hi)]);
  { bf16*park=(bf16*)(shm+V2_LDS_OST)+wid*4096;
    if(MODE==0){
      #pragma unroll
      for(int r=0;r<16;++r){const int orow=crow(r,hi);
        #pragma unroll
        for(int d0=0;d0<4;++d0)park[orow*128+d0*32+r32]=__float2bfloat16(o[d0][r]*rli[r]);}
      asm volatile("s_waitcnt lgkmcnt(0)":::"memory");
    } else {
      #pragma unroll
      for(int r=0;r<16;++r){const int orow=crow(r,hi);
        #pragma unroll
        for(int d0=0;d0<4;++d0){const float o1=__bfloat162float(park[orow*128+d0*32+r32]); park[orow*128+d0*32+r32]=__float2bfloat16(o1-lam*(o[d0][r]*rli[r]));}}
      asm volatile("s_waitcnt lgkmcnt(0)":::"memory");
      bf16*Ow=Ou+(long)(wid*QBLK)*PO;
      const int ch=lane&15; const f32x4v g0=*(const f32x4v*)(subg+8*ch), g1=*(const f32x4v*)(subg+8*ch+4);
      #pragma unroll
      for(int i=0;i<8;++i){const int row=i*4+(lane>>4); const u32x4 v=*(const u32x4*)(park+row*128+ch*8);
        float d[8]; d[0]=__uint_as_float(v.x<<16);d[1]=__uint_as_float(v.x&0xffff0000u);d[2]=__uint_as_float(v.y<<16);d[3]=__uint_as_float(v.y&0xffff0000u);d[4]=__uint_as_float(v.z<<16);d[5]=__uint_as_float(v.z&0xffff0000u);d[6]=__uint_as_float(v.w<<16);d[7]=__uint_as_float(v.w&0xffff0000u);
        float ss=(d[0]*d[0]+d[1]*d[1])+(d[2]*d[2]+d[3]*d[3])+(d[4]*d[4]+d[5]*d[5])+(d[6]*d[6]+d[7]*d[7]);
        ss+=__shfl_xor(ss,1);ss+=__shfl_xor(ss,2);ss+=__shfl_xor(ss,4);ss+=__shfl_xor(ss,8);
        const float rs=__builtin_amdgcn_rsqf(ss*(1.0f/128.0f)+1e-6f)*oscale;
        u32x4 w; w.x=cvtpk_s(d[0]*rs*g0[0],d[1]*rs*g0[1]); w.y=cvtpk_s(d[2]*rs*g0[2],d[3]*rs*g0[3]); w.z=cvtpk_s(d[4]*rs*g1[0],d[5]*rs*g1[1]); w.w=cvtpk_s(d[6]*rs*g1[2],d[7]*rs*g1[3]);
        ATTN_STORE16(Ow+(long)row*PO+ch*8,w);}
      asm volatile("s_waitcnt lgkmcnt(0)":::"memory");
    } }
  asm volatile("s_waitcnt lgkmcnt(0)\n\ts_barrier":::"memory");
  #undef DMA_K
  #undef DMA_V
  #undef CMASK
  #undef ROT
}
#undef SBAR
#undef WAIT_BAR

}
namespace cg = cooperative_groups;
constexpr int NWAVES = 8;
constexpr int NB = 4, SEQ = 8192, DM = 1024, NMETA = 16, DIN = 2560, DFF = 4096, DCONV = 512, CONVW = 31;
constexpr int MX = NB * SEQ;
constexpr int MP = MX + 256;
constexpr int SPAD = pg8::SPAD;
constexpr float EPS = 1e-6f;
constexpr size_t MiB = 1u << 20;
constexpr size_t WS_CTL = 0, WS_WIN = 1 * MiB, WS_WOUT = 6 * MiB, WS_WUP = 8 * MiB, WS_WDN = 16 * MiB, WS_ROPE = 24 * MiB, WS_SSQ = 25 * MiB, WS_RN = 27 * MiB,
                 WS_H1B = 28 * MiB, WS_MIX = 92 * MiB, WS_HB = 156 * MiB, WS_XN = 156 * MiB, WS_O = 156 * MiB, WS_Q = 222 * MiB, WS_K = 254 * MiB, WS_V = 287 * MiB, WS_G = 320 * MiB,
                 WS_END = 412 * MiB;
static_assert(WS_XN + (size_t)MP * DM * 2 <= WS_Q && WS_K + (size_t)NB * SPAD * 512 * 2 <= WS_V && WS_G + (size_t)NB * SPAD * 512 * 2 <= WS_HB + (size_t)MX * DFF * 2 && WS_HB + (size_t)MX * DFF * 2 <= WS_END, "d_ws map");
constexpr int RING_BYTES = 131072, LDS_BYTES = 147456;
#ifndef WGM_P1
#define WGM_P1 4
#endif
#ifndef WGM_P4
#define WGM_P4 4
#endif
#ifndef WGM_P35
#define WGM_P35 4
#endif

#define LAS __attribute__((address_space(3)))
typedef unsigned short bf16;
typedef unsigned v4u __attribute__((ext_vector_type(4)));
typedef float f32x4 __attribute__((ext_vector_type(4)));
typedef float f32x2 __attribute__((ext_vector_type(2)));
#define LDS_WAIT() asm volatile("s_waitcnt lgkmcnt(0)" ::: "memory")
__device__ __forceinline__ unsigned pk2(float lo, float hi) { return pg8::cvt_pk_bf16(lo, hi); }
__device__ __forceinline__ float bf_lo(unsigned u) { return __uint_as_float(u << 16); }
__device__ __forceinline__ float bf_hi(unsigned u) { return __uint_as_float(u & 0xffff0000u); }
__device__ __forceinline__ float wave_sum(float v) {
#pragma unroll
    for (int o = 1; o < 64; o <<= 1) v += __shfl_xor(v, o);
    return v;
}

#define XB_TMO      128
#define XB_XCNT(j)  (256  + 64 * (j))
#define XB_XSUB(j)  (1280 + 64 * (j))
#define XB_XGEN(j)  (2304 + 64 * (j))
#define XB_TOP      3328
#define XB_TOPGEN   3392
#define XCD_BAR_WORDS 3456
#define XB_SPIN_CAP (1u << 18)

__device__ __forceinline__ unsigned xb_ld(unsigned* p)              { return __hip_atomic_load(p, __ATOMIC_RELAXED, __HIP_MEMORY_SCOPE_AGENT); }
__device__ __forceinline__ unsigned xb_add(unsigned* p, unsigned v) { return __hip_atomic_fetch_add(p, v, __ATOMIC_RELAXED, __HIP_MEMORY_SCOPE_AGENT); }
__device__ __forceinline__ unsigned xb_xcc_id() { return (unsigned)__builtin_amdgcn_s_getreg((3 << 11) | 20) & 0xFu; }
#define XB_SPIN(cond, bar) do { unsigned _sp = 0; while (cond) { __builtin_amdgcn_s_sleep(1); \
    if ((++_sp & 255u) == 0u) { if (xb_ld(&(bar)[XB_TMO])) break; if (_sp > XB_SPIN_CAP) { atomicAdd(&(bar)[XB_TMO], 1u); break; } } } } while (0)

struct XcdBarrier {
    unsigned* bar; unsigned x;
    volatile LAS unsigned* st;
};

__device__ __forceinline__ XcdBarrier xcd_barrier_post(unsigned* bar, volatile LAS unsigned* st) {
    XcdBarrier b; b.bar = bar; b.x = xb_xcc_id(); b.st = st;
    if (threadIdx.x == 0) (void)xb_add(&bar[XB_XCNT(b.x)], 1u);
    return b;
}
__device__ __forceinline__ void xcd_barrier_complete(unsigned* bar, unsigned x, unsigned& nloc, unsigned& nx) {
    const unsigned G = gridDim.x * gridDim.y * gridDim.z;
    unsigned sum, cnt, mine, sp = 0u;
    for (;;) {
        sum = 0u; cnt = 0u; mine = 0u;
#pragma unroll
        for (unsigned j = 0; j < 16; ++j) { const unsigned c = xb_ld(&bar[XB_XCNT(j)]); sum += c; cnt += (c > 0u) ? 1u : 0u; mine = (j == x) ? c : mine; }
        if (sum == G) break;
        __builtin_amdgcn_s_sleep(1);
        if ((++sp & 255u) == 0u) { if (xb_ld(&bar[XB_TMO])) break; if (sp > XB_SPIN_CAP) { atomicAdd(&bar[XB_TMO], 1u); break; } }
    }
    nloc = mine > 0u ? mine : 1u; nx = cnt > 0u ? cnt : 1u;
}

__device__ __forceinline__ void xcd_barrier(const XcdBarrier& b) {
    asm volatile("s_waitcnt vmcnt(0)" ::: "memory");
    __syncthreads();
    if (threadIdx.x == 0) {
        unsigned* bar = b.bar;
        __builtin_amdgcn_s_waitcnt(0);
        unsigned nloc = b.st[0], nx = b.st[1];
        if (nloc == 0u) { xcd_barrier_complete(bar, b.x, nloc, nx); b.st[0] = nloc; b.st[1] = nx; }
        const unsigned old = xb_add(&bar[XB_XSUB(b.x)], 1u);
        const unsigned gen = old / nloc;
        if (old + 1u == (gen + 1u) * nloc) {
            __builtin_amdgcn_fence(__ATOMIC_RELEASE, "agent");
            asm volatile("s_waitcnt vmcnt(0)" ::: "memory");
            const unsigned og = xb_add(&bar[XB_TOP], 1u);
            const unsigned tg = og / nx;
            if (og + 1u == (tg + 1u) * nx) xb_add(&bar[XB_TOPGEN], 1u);
            else XB_SPIN(xb_ld(&bar[XB_TOPGEN]) == tg, bar);
            __builtin_amdgcn_fence(__ATOMIC_ACQUIRE, "agent");
            xb_add(&bar[XB_XGEN(b.x)], 1u);
            asm volatile("s_waitcnt vmcnt(0)" ::: "memory");
        } else {
            XB_SPIN(xb_ld(&bar[XB_XGEN(b.x)]) == gen, bar);
            __builtin_amdgcn_fence(__ATOMIC_ACQUIRE, "agent");
            asm volatile("s_waitcnt vmcnt(0)" ::: "memory");
        }
    }
    __syncthreads();
}

__device__ __forceinline__ float dpp_add(float v, const int ctrl_sel) {
    int t;
    if (ctrl_sel == 0) t = __builtin_amdgcn_update_dpp(0, __float_as_int(v), 0xB1, 0xF, 0xF, true);
    else if (ctrl_sel == 1) t = __builtin_amdgcn_update_dpp(0, __float_as_int(v), 0x4E, 0xF, 0xF, true);
    else if (ctrl_sel == 2) t = __builtin_amdgcn_update_dpp(0, __float_as_int(v), 0x141, 0xF, 0xF, true);
    else t = __builtin_amdgcn_update_dpp(0, __float_as_int(v), 0x140, 0xF, 0xF, true);
    return v + __int_as_float(t);
}
__device__ __forceinline__ float wave_sum_fast(float v) {
    v = dpp_add(v, 0); v = dpp_add(v, 1); v = dpp_add(v, 2); v = dpp_add(v, 3);
    { auto rr = __builtin_amdgcn_permlane16_swap(__float_as_uint(v), __float_as_uint(v), false, false); v = __uint_as_float(rr[0]) + __uint_as_float(rr[1]); }
    { auto rr = __builtin_amdgcn_permlane32_swap(__float_as_uint(v), __float_as_uint(v), false, false); v = __uint_as_float(rr[0]) + __uint_as_float(rr[1]); }
    return v;
}

struct Args { const float* in[19]; float* out; unsigned char* ws; float inv_freq[8]; };
enum { I_X = 0, I_META, I_G1, I_WIN, I_QG, I_KG, I_LQ1, I_LK1, I_LQ2, I_LK2, I_SUBLN, I_CW, I_CB, I_CLG, I_CLB, I_WOUT, I_G2, I_WUP, I_WDN };

__device__ __forceinline__ void p0_transpose_item(const float* W, int K, int N, bf16* WT, int out_row0, int n0, int k0, const float* kscale, LAS float* scr, int lane) {
    float tv[32], ts[32];
#pragma unroll
    for (int i = 0; i < 32; ++i) { const int kk = 2 * i + (lane >> 5); tv[i] = W[(size_t)(k0 + kk) * N + n0 + (lane & 31)]; ts[i] = kscale ? kscale[k0 + kk] : 1.0f; }
#pragma unroll
    for (int i = 0; i < 32; ++i) { const int kk = 2 * i + (lane >> 5); scr[kk * 33 + (lane & 31)] = tv[i] * ts[i]; }
    LDS_WAIT(); asm volatile("" ::: "memory");
    const int c = lane & 7;
#pragma unroll
    for (int j = 0; j < 4; ++j) { const int n = (lane >> 3) + 8 * j; const LAS float* s = scr + (8 * c) * 33 + n;
        v4u o; o.x = pk2(s[0 * 33], s[1 * 33]); o.y = pk2(s[2 * 33], s[3 * 33]); o.z = pk2(s[4 * 33], s[5 * 33]); o.w = pk2(s[6 * 33], s[7 * 33]);
        *(v4u*)(WT + (size_t)(out_row0 + n) * K + k0 + 8 * c) = o; }
    LDS_WAIT(); asm volatile("" ::: "memory");
}
__device__ __forceinline__ int wup_pcol(int lc) { const int l = lc & 255; return (lc & ~255) + 128 * ((l >> 5) & 1) + 32 * (l >> 6); }
__device__ __forceinline__ int win_pcol(int lc) {
    if (lc < 1536) { const int l = lc & 255; return (lc & ~255) + 128 * ((l >> 5) & 1) + 32 * (l >> 6) + (l & 31); }
    if (lc < 2048) { const int ch = lc - 1536; return 1536 + 256 * (ch >> 7) + (ch & 127); }
    const int ch = lc - 2048; return 1536 + 256 * (ch >> 7) + 128 + (ch & 127);
}

__device__ __forceinline__ void p0_prologue(const Args& A, unsigned char* ws, LAS unsigned char* lds, int vcu, int G, int wave, int lane) {
    LAS float* scr = (LAS float*)(lds + wave * 16384);
    const int gw = vcu * NWAVES + wave, NGW = G * NWAVES;
    bf16* Win_t = (bf16*)(ws + WS_WIN); bf16* Wout_t = (bf16*)(ws + WS_WOUT); bf16* Wup_t = (bf16*)(ws + WS_WUP); bf16* Wdn_t = (bf16*)(ws + WS_WDN);
    constexpr int I_IN = (DM / 64) * (DIN / 32);
    for (int it = gw; it < I_IN; it += NGW) { const int nblk = DIN / 32, kb = it / nblk, nb = it % nblk; p0_transpose_item(A.in[I_WIN], DM, DIN, Win_t, win_pcol(32 * nb), 32 * nb, 64 * kb, nullptr, scr, lane); }
    {
        bf16* XN = (bf16*)(ws + WS_XN);
        f32x4 g[4];
#pragma unroll
        for (int j = 0; j < 4; ++j) g[j] = ((const f32x4*)A.in[I_G1])[lane + 64 * j];
        for (int m0 = gw; m0 < MX + NMETA; m0 += 4 * NGW) {
            f32x4 v[4][4];
#pragma unroll
            for (int q = 0; q < 4; ++q) { const int m = m0 + q * NGW; const bool ok = m < MX + NMETA;
                const float* src = !ok ? A.in[I_X] : (m < MX) ? A.in[I_X] + (size_t)m * DM : A.in[I_META] + (size_t)(m - MX) * DM;
                const f32x4* xr = (const f32x4*)src + lane;
#pragma unroll
                for (int j = 0; j < 4; ++j) v[q][j] = __builtin_nontemporal_load(xr + 64 * j); }
#pragma unroll
            for (int q = 0; q < 4; ++q) { const int m = m0 + q * NGW; if (m >= MX + NMETA) continue;
                float s = 0.f;
#pragma unroll
                for (int j = 0; j < 4; ++j) s += (v[q][j].x * v[q][j].x + v[q][j].y * v[q][j].y) + (v[q][j].z * v[q][j].z + v[q][j].w * v[q][j].w);
                const float ms = wave_sum_fast(s) * (1.f / DM) + EPS; const float rs = __builtin_amdgcn_rsqf(ms);
                if (lane == 0 && m < MX) ((float*)(ws + WS_RN))[m] = ms * rs;
                unsigned long long* o8 = (unsigned long long*)(XN + (size_t)m * DM) + lane;
#pragma unroll
                for (int j = 0; j < 4; ++j) { const f32x4 y = v[q][j] * rs * g[j]; o8[64 * j] = (unsigned long long)pk2(y.x, y.y) | ((unsigned long long)pk2(y.z, y.w) << 32); } }
        }
    }
    {
        float* rope = (float*)(ws + WS_ROPE);
        const int pos = gw * 64 + lane;
        if (pos < SEQ + NMETA) {
#pragma unroll
            for (int i = 0; i < 8; ++i) {
                const float angf = (float)pos * A.inv_freq[i];
                const double rev = (double)angf * 0.15915494309189533577; const double fr = rev - __builtin_rint(rev);
                const float f = (float)fr;
                rope[pos * 16 + i] = __builtin_amdgcn_cosf(f); rope[pos * 16 + 8 + i] = __builtin_amdgcn_sinf(f); } }
    }
    {
        bf16* KB = (bf16*)(ws + WS_K); bf16* VB = (bf16*)(ws + WS_V); bf16* GB = (bf16*)(ws + WS_G);
        for (int it = gw; it < NB * 48 * 3; it += NGW) { const int which = it / (NB * 48), r = it % (NB * 48), b = r / 48, rr = r % 48;
            bf16* p = which == 0 ? KB + (size_t)(b * SPAD + 16 + rr) * 512 : which == 1 ? VB + (size_t)(b * SPAD + 16 + rr) * 512 : GB + (size_t)(b * SPAD + rr) * 512;
            ((v4u*)p)[lane] = (v4u){0u, 0u, 0u, 0u}; }
    }
}

__device__ __forceinline__ void meta_proj(const Args& A, unsigned char* ws, LAS unsigned char* lds, int vcu, int wave, int lane) {
    typedef short bf16x8 __attribute__((ext_vector_type(8)));
    const int fr = lane & 15, fq = lane >> 4;
    const int item = vcu * 2 + (wave >> 2), kc = wave & 3;
    const int kind = item < 8 ? 0 : item < 16 ? 1 : 2, g = kind == 2 ? item - 16 : (item & 7);
    const bf16* XNm = (const bf16*)(ws + WS_XN) + (size_t)(MX + fr) * DM + 8 * fq + 256 * kc;
    const bf16* Wt = (const bf16*)(ws + WS_WIN);
    const bf16* brow[4];
#pragma unroll
    for (int nb = 0; nb < 4; ++nb) { const int lc = kind == 0 ? 512 + 64 * g + 16 * nb + fr : kind == 1 ? 1024 + 64 * g + 16 * nb + fr : (nb < 2 ? 1536 + 32 * g + 16 * nb + fr : 2048 + 32 * g + 16 * (nb - 2) + fr);
        brow[nb] = Wt + (size_t)(win_pcol(lc & ~31) + (lc & 31)) * DM + 8 * fq + 256 * kc; }
    bf16x8 af[8], bf[8][4];
#pragma unroll
    for (int ks = 0; ks < 8; ++ks) { af[ks] = *(const bf16x8*)(XNm + 32 * ks);
#pragma unroll
        for (int nb = 0; nb < 4; ++nb) bf[ks][nb] = *(const bf16x8*)(brow[nb] + 32 * ks); }
    asm volatile("" ::: "memory");
    f32x4 acc[4];
#pragma unroll
    for (int nb = 0; nb < 4; ++nb) acc[nb] = (f32x4){0.f, 0.f, 0.f, 0.f};
#pragma unroll
    for (int ks = 0; ks < 8; ++ks)
#pragma unroll
        for (int nb = 0; nb < 4; ++nb) acc[nb] = __builtin_amdgcn_mfma_f32_16x16x32_bf16(bf[ks][nb], af[ks], acc[nb], 0, 0, 0);
    LAS f32x4* red = (LAS f32x4*)lds;
#pragma unroll
    for (int nb = 0; nb < 4; ++nb) red[(wave * 4 + nb) * 64 + lane] = acc[nb];
    __syncthreads();
    if (kc == 0) {
#pragma unroll
        for (int nb = 0; nb < 4; ++nb) acc[nb] = (red[((wave + 0) * 4 + nb) * 64 + lane] + red[((wave + 1) * 4 + nb) * 64 + lane]) + (red[((wave + 2) * 4 + nb) * 64 + lane] + red[((wave + 3) * 4 + nb) * 64 + lane]);
        if (kind == 0) {
            float ss = 0.f;
#pragma unroll
            for (int nb = 0; nb < 4; ++nb) ss += (acc[nb][0] * acc[nb][0] + acc[nb][1] * acc[nb][1]) + (acc[nb][2] * acc[nb][2] + acc[nb][3] * acc[nb][3]);
            ss += __shfl_xor(ss, 16); ss += __shfl_xor(ss, 32);
            const float rs = __builtin_amdgcn_rsqf(ss * (1.0f / 64.0f) + EPS);
#pragma unroll
            for (int nb = 0; nb < 4; ++nb) acc[nb] = acc[nb] * rs * *(const f32x4*)(A.in[I_KG] + 16 * nb + 4 * fq);
            f32x4 p; p[0] = __shfl_xor(acc[0][0], 32); p[1] = __shfl_xor(acc[0][1], 32); p[2] = __shfl_xor(acc[0][2], 32); p[3] = __shfl_xor(acc[0][3], 32);
            const float* rp = (const float*)(ws + WS_ROPE) + fr * 16 + 4 * (fq & 1);
            const f32x4 c = *(const f32x4*)rp, s = *(const f32x4*)(rp + 8);
            const float sg = (fq & 2) ? 1.f : -1.f;
            acc[0] = acc[0] * c + (p * s) * sg;
        }
        if (kind == 2) {
#pragma unroll
            for (int nb = 0; nb < 2; ++nb)
#pragma unroll
                for (int e = 0; e < 4; ++e) acc[nb][e] = acc[nb][e] * __builtin_amdgcn_rcpf(1.0f + __builtin_amdgcn_exp2f(-1.4426950408889634f * acc[nb + 2][e]));
        }
        bf16* dst = kind == 0 ? (bf16*)(ws + WS_K) : kind == 1 ? (bf16*)(ws + WS_V) : (bf16*)(ws + WS_G);
        const int r0 = kind == 2 ? 48 + fr : fr, c0 = (kind == 2 ? 32 * g : 64 * g) + 4 * fq, nnb = kind == 2 ? 2 : 4;
#pragma unroll 1
        for (int b = 0; b < NB; ++b) { bf16* o = dst + (size_t)(b * SPAD + r0) * 512 + c0;
#pragma unroll
            for (int nb = 0; nb < 4; ++nb) if (nb < nnb) *(unsigned long long*)(o + 16 * nb) = (unsigned long long)pk2(acc[nb][0], acc[nb][1]) | ((unsigned long long)pk2(acc[nb][2], acc[nb][3]) << 32); }
    }
    __syncthreads();
}

__device__ __forceinline__ void wconv_phase(const Args& A, unsigned char* ws, LAS unsigned char* lds, int wave, int lane) {
    LAS float* scr = (LAS float*)(lds + wave * 16384);
    bf16* Wout_t = (bf16*)(ws + WS_WOUT); bf16* Wup_t = (bf16*)(ws + WS_WUP); bf16* Wdn_t = (bf16*)(ws + WS_WDN);
    constexpr int I_OUT = (DM / 64) * (DM / 32), I_UP = (DM / 64) * (DFF / 32), I_DN = (DFF / 64) * (DM / 32), NIT = I_OUT + I_UP + I_DN;
    unsigned* wq = (unsigned*)(ws + WS_CTL) + 96;
    volatile LAS unsigned* TK = (volatile LAS unsigned*)(lds + LDS_BYTES - 256 + 64);
    for (;;) {
        if (wave == 0 && lane == 0) TK[0] = __hip_atomic_fetch_add(wq, 1u, __ATOMIC_RELAXED, __HIP_MEMORY_SCOPE_AGENT);
        __syncthreads();
        const int t = (int)TK[0];
        __syncthreads();
        if (t * NWAVES >= NIT) break;
        int r = t * NWAVES + wave;
        if (r >= NIT) continue;
        if (r < I_OUT) { const int nblk = DM / 32, kb = r / nblk, nb = r % nblk; p0_transpose_item(A.in[I_WOUT], DM, DM, Wout_t, wup_pcol(32 * nb), 32 * nb, 64 * kb, nullptr, scr, lane); continue; } r -= I_OUT;
        if (r < I_UP) { const int nblk = DFF / 32, kb = r / nblk, nb = r % nblk; p0_transpose_item(A.in[I_WUP], DM, DFF, Wup_t, wup_pcol(32 * nb), 32 * nb, 64 * kb, A.in[I_G2], scr, lane); continue; } r -= I_UP;
        { const int nblk = DM / 32, kb = r / nblk, nb = r % nblk; p0_transpose_item(A.in[I_WDN], DFF, DM, Wdn_t, 32 * nb, 32 * nb, 64 * kb, nullptr, scr, lane); }
    }
}

constexpr int CONV_R = 32;
__device__ __forceinline__ void conv_phase(const Args& A, unsigned char* ws, LAS unsigned char* lds, int vcu, int G, int wave, int lane) {
    LAS float* cbuf = (LAS float*)lds;
    const bf16* GB = (const bf16*)(ws + WS_G); bf16* MIX = (bf16*)(ws + WS_MIX);
    const int cp = (wave & 3) * 64 + lane, half = wave >> 2;
    f32x2 w[CONVW];
#pragma unroll
    for (int j = 0; j < CONVW; ++j) w[j] = *(const f32x2*)(A.in[I_CW] + j * DCONV + 2 * cp);
    const f32x2 bias = *(const f32x2*)(A.in[I_CB] + 2 * cp);
    const f32x4 lg0 = *(const f32x4*)(A.in[I_CLG] + lane * 8), lg1 = *(const f32x4*)(A.in[I_CLG] + lane * 8 + 4), lb0 = *(const f32x4*)(A.in[I_CLB] + lane * 8), lb1 = *(const f32x4*)(A.in[I_CLB] + lane * 8 + 4);
    constexpr int NITEMS = MX / (2 * CONV_R);
    unsigned* cq = (unsigned*)(ws + WS_CTL) + 32;
    volatile LAS unsigned* TK = (volatile LAS unsigned*)(lds + LDS_BYTES - 256 + 64);
    if (wave == 0 && lane == 0) { TK[0] = __hip_atomic_fetch_add(cq, 1u, __ATOMIC_RELAXED, __HIP_MEMORY_SCOPE_AGENT); TK[1] = __hip_atomic_fetch_add(cq, 1u, __ATOMIC_RELAXED, __HIP_MEMORY_SCOPE_AGENT); }
    __syncthreads();
    int it = (int)TK[0], nxt = (int)TK[1];
    __syncthreads();
#define CONV_SRC(item, sub) (GB + (size_t)(((((item) * 2 * CONV_R + half * CONV_R + (sub) * 16) >> 13) * SPAD) + 34 + (((item) * 2 * CONV_R + half * CONV_R + (sub) * 16) & 8191)) * 512 + 2 * cp)
#define CONV_LOAD(buf, item, sub) do { const bf16* gs_ = CONV_SRC(item, sub); _Pragma("unroll") for (int i = 0; i < 46; ++i) buf[i] = *(const unsigned*)(gs_ + (size_t)i * 512); } while (0)
#define CONV_FMA(buf, sub) do { f32x2 acc[16]; _Pragma("unroll") for (int o = 0; o < 16; ++o) acc[o] = bias; \
        _Pragma("unroll") for (int i = 0; i < 46; ++i) { const f32x2 x = {bf_lo(buf[i]), bf_hi(buf[i])}; _Pragma("unroll") for (int o = 0; o < 16; ++o) { const int j = i - o; if (j >= 0 && j < CONVW) acc[o] += w[j] * x; } } \
        _Pragma("unroll") for (int o = 0; o < 16; ++o) *(LAS f32x2*)(cbuf + (half * CONV_R + (sub) * 16 + o) * DCONV + 2 * cp) = acc[o]; } while (0)
    unsigned bufA[46], bufB[46];
    if (it < NITEMS) CONV_LOAD(bufA, it, 0);
#pragma unroll 1
    while (it < NITEMS) {
        if (wave == 0 && lane == 0) TK[0] = __hip_atomic_fetch_add(cq, 1u, __ATOMIC_RELAXED, __HIP_MEMORY_SCOPE_AGENT);
        CONV_LOAD(bufB, it, 1);
        CONV_FMA(bufA, 0);
        if (nxt < NITEMS) CONV_LOAD(bufA, nxt, 0);
        CONV_FMA(bufB, 1);
        __syncthreads();
        const int nn = (int)TK[0];
#pragma unroll
        for (int rr = 0; rr < 8; ++rr) { const int lr = wave * 8 + rr;
            f32x4 x0 = *(const LAS f32x4*)(cbuf + lr * DCONV + lane * 8), x1 = *(const LAS f32x4*)(cbuf + lr * DCONV + lane * 8 + 4);
            const float mu = wave_sum_fast((x0[0] + x0[1]) + (x0[2] + x0[3]) + (x1[0] + x1[1]) + (x1[2] + x1[3])) * (1.f / DCONV);
            x0 = x0 - mu; x1 = x1 - mu;
            const float var = wave_sum_fast((x0[0] * x0[0] + x0[1] * x0[1]) + (x0[2] * x0[2] + x0[3] * x0[3]) + (x1[0] * x1[0] + x1[1] * x1[1]) + (x1[2] * x1[2] + x1[3] * x1[3])) * (1.f / DCONV);
            const float rs = __builtin_amdgcn_rsqf(var + EPS);
            x0 = x0 * rs * lg0 + lb0; x1 = x1 * rs * lg1 + lb1;
#pragma unroll
            for (int e = 0; e < 4; ++e) { x0[e] = x0[e] * __builtin_amdgcn_rcpf(1.0f + __builtin_amdgcn_exp2f(-1.4426950408889634f * x0[e])); x1[e] = x1[e] * __builtin_amdgcn_rcpf(1.0f + __builtin_amdgcn_exp2f(-1.4426950408889634f * x1[e])); }
            *(v4u*)(MIX + (size_t)(it * 2 * CONV_R + lr) * DM + 512 + lane * 8) = pg8::pack8(x0, x1); }
        __syncthreads();
        it = nxt; nxt = nn;
    }
#undef CONV_SRC
#undef CONV_LOAD
#undef CONV_FMA
}

__device__ __forceinline__ void combine_phase(const Args& A, unsigned char* ws, int vcu, int G, int wave, int lane) {
    const bf16* OB = (const bf16*)(ws + WS_O); bf16* MIX = (bf16*)(ws + WS_MIX);
    const float d1 = wave_sum(A.in[I_LQ1][lane] * A.in[I_LK1][lane]), d2 = wave_sum(A.in[I_LQ2][lane] * A.in[I_LK2][lane]);
    const float lam_init = 0.2f;
    const float lam = __builtin_amdgcn_exp2f(d1 * 1.4426950408889634f) - __builtin_amdgcn_exp2f(d2 * 1.4426950408889634f) + lam_init;
    const int h = lane >> 4, q = lane & 15;
    const f32x4 sg0 = *(const f32x4*)(A.in[I_SUBLN] + 8 * q), sg1 = *(const f32x4*)(A.in[I_SUBLN] + 8 * q + 4);
    const int gw = vcu * NWAVES + wave, NGW = G * NWAVES;
    for (int row = gw; row < MX; row += NGW) {
        const bf16* o1 = OB + (size_t)row * 1024 + h * 256 + 8 * q;
        const v4u a = *(const v4u*)o1, bq = *(const v4u*)(o1 + 128);
        f32x4 d0, d1v;
        d0[0] = bf_lo(a.x) - lam * bf_lo(bq.x); d0[1] = bf_hi(a.x) - lam * bf_hi(bq.x); d0[2] = bf_lo(a.y) - lam * bf_lo(bq.y); d0[3] = bf_hi(a.y) - lam * bf_hi(bq.y);
        d1v[0] = bf_lo(a.z) - lam * bf_lo(bq.z); d1v[1] = bf_hi(a.z) - lam * bf_hi(bq.z); d1v[2] = bf_lo(a.w) - lam * bf_lo(bq.w); d1v[3] = bf_hi(a.w) - lam * bf_hi(bq.w);
        float ss = (d0[0] * d0[0] + d0[1] * d0[1]) + (d0[2] * d0[2] + d0[3] * d0[3]) + (d1v[0] * d1v[0] + d1v[1] * d1v[1]) + (d1v[2] * d1v[2] + d1v[3] * d1v[3]);
        ss += __shfl_xor(ss, 1); ss += __shfl_xor(ss, 2); ss += __shfl_xor(ss, 4); ss += __shfl_xor(ss, 8);
        const float rs = __builtin_amdgcn_rsqf(ss * (1.f / 128.f) + EPS) * (1.0f - lam_init);
        *(v4u*)(MIX + (size_t)row * DM + h * 128 + 8 * q) = pg8::pack8(d0 * rs * sg0, d1v * rs * sg1);
    }
}

__global__ void __launch_bounds__(NWAVES * 64, 2) hymba_fwd(Args args) {
    extern __shared__ __attribute__((aligned(16))) unsigned char lds[];
    cg::grid_group grid = cg::this_grid();
    LAS unsigned char* ldsl = (LAS unsigned char*)lds;
    volatile LAS unsigned* MISC = (volatile LAS unsigned*)(ldsl + LDS_BYTES - 256);
    if (threadIdx.x < 32) MISC[threadIdx.x] = 0u;
    __syncthreads();
    const XcdBarrier bar = xcd_barrier_post((unsigned*)(args.ws + WS_CTL) + 4096, MISC + 8);
    const int G = gridDim.x; const int bx = blockIdx.x; const int vcu = (G % 8 == 0) ? (bx % 8) * (G / 8) + bx / 8 : bx;
#ifndef PROBE_DUP
#define PROBE_DUP 0
#endif
#define REP(mask) for (int rep_ = 0; rep_ < (((PROBE_DUP) & (mask)) ? 2 : 1); ++rep_)
#define PHASE_VARS() unsigned char* ws = args.ws; int tid_ = threadIdx.x; asm volatile("" : "+v"(tid_)); const int lane = tid_ & 63, wave = __builtin_amdgcn_readfirstlane(tid_ >> 6); (void)lane; (void)wave

    REP(1) { PHASE_VARS(); p0_prologue(args, ws, ldsl, vcu, G, wave, lane); }
    if (args.ws == nullptr) grid.sync();
    xcd_barrier(bar);

    REP(2) {
        PHASE_VARS();
        pg8::Gemm g{(bf16*)(ws + WS_XN), (bf16*)(ws + WS_WIN), MX, DIN, DM}; pg8::StaticOrder S; S.init(MX, DIN, G, bx, WGM_P1);
        pg8::EpiInProj E{(bf16*)(ws + WS_Q), (bf16*)(ws + WS_K), (bf16*)(ws + WS_V), (bf16*)(ws + WS_G), args.in[I_QG], args.in[I_KG], (const float*)(ws + WS_ROPE)};
        pg8::gemm_phase<pg8::EpiInProj, pg8::StaticOrder, PG8_ALIGN, PG8_SP2>(ldsl, g, S, E);
    }
    {
        PHASE_VARS();
        unsigned* mq = (unsigned*)(ws + WS_CTL) + 160;
        volatile LAS unsigned* TK = (volatile LAS unsigned*)(ldsl + LDS_BYTES - 256 + 64);
        for (;;) {
            if (tid_ == 0) TK[0] = __hip_atomic_fetch_add(mq, 1u, __ATOMIC_RELAXED, __HIP_MEMORY_SCOPE_AGENT);
            __syncthreads();
            const int t = (int)TK[0];
            __syncthreads();
            if (t >= 16) break;
            meta_proj(args, ws, ldsl, t, wave, lane);
        }
    }
    xcd_barrier(bar);

    REP(8) {
        PHASE_VARS();
        static_assert(attn_body::V2_LDS_BYTES <= LDS_BYTES - 256, "attention LDS");
        const float dq1 = wave_sum(args.in[I_LQ1][lane] * args.in[I_LK1][lane]), dq2 = wave_sum(args.in[I_LQ2][lane] * args.in[I_LK2][lane]);
        const float lam_init = 0.2f;
        const float lam = __builtin_amdgcn_exp2f(dq1 * 1.4426950408889634f) - __builtin_amdgcn_exp2f(dq2 * 1.4426950408889634f) + lam_init;
        for (int vv = vcu; vv < 256; vv += G) {
            const int bh = vv >> 4, s = vv & 15;
            const int b = bh >> 2, head = bh & 3;
            const attn_body::bf16* Kh = (const attn_body::bf16*)(ws + WS_K) + (size_t)(b * SPAD) * 512 + head * 128;
            const attn_body::bf16* Vh = (const attn_body::bf16*)(ws + WS_V) + (size_t)(b * SPAD) * 512 + head * 128;
            for (int i = 0; i < 2; ++i) {
                const int qb = i ? 31 - s : s;
                const int q0 = qb * 256;
                const attn_body::bf16* Qu = (const attn_body::bf16*)(ws + WS_Q) + (size_t)(b * SEQ + q0) * 512 + head * 128;
                attn_body::bf16* Mu = (attn_body::bf16*)(ws + WS_MIX) + (size_t)(b * SEQ + q0) * 1024 + head * 128;
                attn_body::attn_unit128<0>(q0, Qu, Kh, Vh, Mu, (char*)lds, lam, 1.0f - lam_init, args.in[I_SUBLN]);
                attn_body::attn_unit128<1>(q0, Qu + 64, Kh + 64, Vh, Mu, (char*)lds, lam, 1.0f - lam_init, args.in[I_SUBLN]);
            }
        }
    }
    REP(4) { PHASE_VARS(); conv_phase(args, ws, ldsl, vcu, G, wave, lane); }
    { PHASE_VARS(); wconv_phase(args, ws, ldsl, wave, lane); }
    xcd_barrier(bar);

    REP(32) {
        PHASE_VARS();
        pg8::Gemm g{(bf16*)(ws + WS_MIX), (bf16*)(ws + WS_WOUT), MX, DM, DM}; pg8::StaticOrder S; S.init(MX, DM, G, bx, WGM_P35);
        pg8::EpiOut E{(const bf16*)(ws + WS_XN), (const float*)(ws + WS_RN), args.in[I_G1], (bf16*)(ws + WS_H1B), (float*)(ws + WS_SSQ)};
        pg8::gemm_phase<pg8::EpiOut, pg8::StaticOrder, PG8_ALIGN, PG8_SP2>(ldsl, g, S, E);
    }
    xcd_barrier(bar);

    REP(64) {
        PHASE_VARS();
        pg8::Gemm g{(bf16*)(ws + WS_H1B), (bf16*)(ws + WS_WUP), MX, DFF, DM}; pg8::StaticOrder S; S.init(MX, DFF, G, bx, WGM_P4);
        LAS float* rl = (LAS float*)(ldsl + RING_BYTES);
        { const float* ssq = (const float*)(ws + WS_SSQ); const int r = tid_ & 255, s2 = tid_ >> 8;
          f32x4 sv[2][4]; int slot[2]; bool ok[2];
#pragma unroll
          for (int j = 0; j < 2; ++j) { pg8::Unit uu; ok[j] = S.next(2 * (2 * j + s2), uu); slot[j] = (uu.pm >> 2) & 3; const f32x4* sp = (const f32x4*)(ssq + (size_t)((ok[j] ? uu.pm : 0) * 256 + r) * 16);
#pragma unroll
              for (int k = 0; k < 4; ++k) sv[j][k] = sp[k]; }
#pragma unroll
          for (int j = 0; j < 2; ++j) { const f32x4 t = (sv[j][0] + sv[j][1]) + (sv[j][2] + sv[j][3]); const float tot = (t[0] + t[1]) + (t[2] + t[3]);
              if (ok[j]) rl[slot[j] * 256 + r] = __builtin_amdgcn_rsqf(tot * (1.0f / 1024.0f) + 1e-6f); }
          __syncthreads(); }
        pg8::EpiUp E{(bf16*)(ws + WS_HB), rl};
        pg8::gemm_phase<pg8::EpiUp, pg8::StaticOrder, PG8_ALIGN, PG8_SP2>(ldsl, g, S, E);
    }
    xcd_barrier(bar);

    {
        PHASE_VARS();
        pg8::Gemm g{(bf16*)(ws + WS_HB), (bf16*)(ws + WS_WDN), MX, DM, DFF}; pg8::StaticOrder S; S.init(MX, DM, G, bx, WGM_P35);
        pg8::EpiDown E{(const bf16*)(ws + WS_H1B), args.out};
        pg8::gemm_phase<pg8::EpiDown, pg8::StaticOrder, PG8_ALIGN, PG8_SP2>(ldsl, g, S, E);
    }
#undef PHASE_VARS
#undef REP
}

extern "C" void kernel_launch(void* const* d_in, const int* in_sizes, int n_in, void* d_out, int out_size, void* d_ws, size_t ws_size, hipStream_t stream) {
    static int grid = 0;
    if (grid == 0) {
        if (n_in != 19 || in_sizes[0] != MX * DM || out_size != MX * DM || ws_size < WS_END) { fprintf(stderr, "kernel_launch: unexpected shapes: n_in %d, in0 %d, out %d, ws %zu (need %zu); nothing launched\n", n_in, n_in > 0 ? in_sizes[0] : -1, out_size, ws_size, (size_t)WS_END); grid = -1; return; }
        int dev = 0, cus = 0, per_cu = 0;
        if (hipGetDevice(&dev) != hipSuccess || hipDeviceGetAttribute(&cus, hipDeviceAttributeMultiprocessorCount, dev) != hipSuccess) { fprintf(stderr, "kernel_launch: device query failed\n"); grid = -1; return; }
        if (hipFuncSetAttribute((const void*)hymba_fwd, hipFuncAttributeMaxDynamicSharedMemorySize, LDS_BYTES) != hipSuccess) { fprintf(stderr, "kernel_launch: hipFuncSetAttribute failed\n"); grid = -1; return; }
        if (hipOccupancyMaxActiveBlocksPerMultiprocessor(&per_cu, (const void*)hymba_fwd, NWAVES * 64, LDS_BYTES) != hipSuccess || per_cu < 1) { fprintf(stderr, "kernel_launch: occupancy query says %d\n", per_cu); per_cu = 1; }
        (void)hipGetLastError();
        grid = cus * 1;
        fprintf(stderr, "kernel_launch: grid %d (occupancy query %d per CU)\n", grid, per_cu);
    }
    if (grid < 0) return;
    Args a{};
    for (int i = 0; i < 19; ++i) a.in[i] = (const float*)d_in[i];
    a.out = (float*)d_out; a.ws = (unsigned char*)d_ws;
    for (int i = 0; i < 8; ++i) a.inv_freq[i] = (float)pow(500000.0, -(double)i / 8.0);
    if (hipMemsetAsync((char*)d_ws + WS_CTL, 0, 65536, stream) != hipSuccess) { fprintf(stderr, "kernel_launch: hipMemsetAsync failed\n"); return; }
    void* kargs[] = {&a};
    const hipError_t le = hipLaunchCooperativeKernel((const void*)hymba_fwd, dim3(grid), dim3(NWAVES * 64), kargs, LDS_BYTES, stream);
    if (le != hipSuccess) fprintf(stderr, "kernel_launch: cooperative launch failed: %s (grid %d)\n", hipGetErrorName(le), grid);
}
```
